# Optimizing an MI355X kernel written in HIP

```python
import math
import jax, jax.numpy as jnp
from jax import lax
import numpy as np

D_MODEL = 1024
BATCH = 16
SEQ = 2048
DEPTH = 1

CTX_LEN = 256
GRID_W = 64
MIX_WIDTH = D_MODEL
HY_WIDTH = MIX_WIDTH // 2
HG_WIDTH = MIX_WIDTH - HY_WIDTH
HG_HEADS = 4
HG_HEAD_DIM = HG_WIDTH // HG_HEADS
HY_ORDER = 2
HY_SHORT = 3
HY_BANDS = 16
HY_POS_DIM = 2 * HY_BANDS + 1
HY_FILTER_HIDDEN = 64
HY_DECAY_TARGET = 1e-2
HY_FAST_DECAY = 0.3
HY_SLOW_DECAY = 1.5
HY_WINDOW_SHIFT = 0.05
CHUNK = 64
N_EXPERTS = 16
CAPACITY_FACTOR = 2
EXPERT_FF = 2 * D_MODEL
IN_COLS = 3 * HY_WIDTH + 5 * HG_WIDTH
EPS = 1e-6

kernel_name = "hyena_hgrn2_ec_moe_prefix_dit_block"


def rmsnorm(x, g):
    xf = x.astype(jnp.float32)
    y = xf * lax.rsqrt(jnp.mean(xf * xf, axis=-1, keepdims=True) + EPS)
    return (y * g.astype(jnp.float32)).astype(x.dtype)


def modulate(h, shift, scale):
    return h * (1 + scale) + shift


def short_conv(u, w, b, n_rows):
    bn, L, C = u.shape
    row_len = L // n_rows
    pad = HY_SHORT // 2
    up = jnp.pad(u.reshape(bn, n_rows, row_len, C), ((0, 0), (0, 0), (pad, pad), (0, 0)))
    y = b + sum(up[:, :, j:j + row_len] * w[j] for j in range(HY_SHORT))
    return y.reshape(bn, L, C)


def hyena_filter_freqs(L, w1, b1, fr1, w2, b2, fr2, w3):
    C = w3.shape[1] // (HY_ORDER * 2)
    t = jnp.linspace(0.0, 1.0, L, dtype=jnp.float32)[:, None]
    w = 2.0 * math.pi * jnp.arange(L, dtype=jnp.float32)[:, None] / L
    f = jnp.linspace(1e-4, HY_BANDS - 1, HY_BANDS, dtype=jnp.float32)[None, :]
    z = jnp.concatenate([t, jnp.cos(f * w), -jnp.sin(f * w)], axis=-1)
    h = jnp.sin(fr1.astype(jnp.float32) * (z @ w1.astype(jnp.float32) + b1.astype(jnp.float32)))
    h = jnp.sin(fr2.astype(jnp.float32) * (h @ w2.astype(jnp.float32) + b2.astype(jnp.float32)))
    h = (h @ w3.astype(jnp.float32)).reshape(L, HY_ORDER, 2, C)
    min_decay = math.log(HY_DECAY_TARGET) / HY_SLOW_DECAY
    max_decay = math.log(HY_DECAY_TARGET) / HY_FAST_DECAY
    deltas = jnp.abs(jnp.linspace(min_decay, max_decay, C, dtype=jnp.float32))
    window = jnp.exp(-t * deltas[None, :]) + HY_WINDOW_SHIFT
    h = h * window[:, None, None, :]
    full = jnp.concatenate([h[:, :, 0], jnp.zeros((1, HY_ORDER, C), jnp.float32), h[:0:-1, :, 1]], axis=0)
    full = full / (jnp.sum(jnp.abs(full), axis=0, keepdims=True) + EPS)
    return jnp.fft.rfft(full, axis=0)


def long_conv(u, hf, bias):
    L = u.shape[1]
    U = jnp.fft.rfft(u, n=2 * L, axis=1)
    y = jnp.fft.irfft(U * hf[None], n=2 * L, axis=1)[:, :L]
    return y + u * bias.astype(jnp.float32)


def hyena_mixer(p, n_rows, conv_w, conv_b, filt, bias):
    L = p.shape[1]
    u = short_conv(p, conv_w, conv_b, n_rows).astype(jnp.float32)
    v, x1, x2 = jnp.split(u, 3, axis=-1)
    hf = hyena_filter_freqs(L, *filt)
    z = x1 * long_conv(v, hf[:, 0], bias[0])
    y = x2 * long_conv(z, hf[:, 1], bias[1])
    return y.astype(p.dtype)


def chunk_scan(q, k, v, logf, s0):
    bn, L, H, K = q.shape
    n = L // CHUNK

    def blocks(a):
        return a.reshape(bn, n, CHUNK, H, a.shape[-1]).swapaxes(0, 1)

    earlier_or_same = jnp.tril(jnp.ones((CHUNK, CHUNK), dtype=bool))[None, :, :, None, None]

    def step(S, inp):
        qb, kb, vb, gb = inp
        G = jnp.cumsum(gb, axis=1)
        o_inter = jnp.einsum('bthk,bhkv->bthv', qb * jnp.exp(G), S)
        decay = jnp.exp(jnp.where(earlier_or_same, G[:, :, None] - G[:, None, :], -jnp.inf))
        A = jnp.einsum('bthk,bshk,btshk->bhts', qb, kb, decay)
        o_intra = jnp.einsum('bhts,bshv->bthv', A, vb)
        G_last = G[:, -1]
        S_new = jnp.exp(G_last)[..., None] * S + jnp.einsum('bshk,bshv->bhkv', kb * jnp.exp(G_last[:, None] - G), vb)
        return S_new, o_inter + o_intra

    S_fin, o = lax.scan(step, s0, (blocks(q), blocks(k), blocks(v), blocks(logf)))
    return o.swapaxes(0, 1).reshape(bn, L, H, v.shape[-1]), S_fin


def hgrn_project(p, lb):
    bn, L, _ = p.shape
    q, i, zf, zb, g = jnp.split(p, 5, axis=-1)

    def heads(a):
        return a.reshape(bn, L, HG_HEADS, HG_HEAD_DIM)

    q = heads(jax.nn.silu(q.astype(jnp.float32)) * HG_HEAD_DIM ** -0.5)
    v = heads(i.astype(jnp.float32))

    def gate(z, lb_d):
        f = lb_d + (1.0 - lb_d) * jax.nn.sigmoid(z.astype(jnp.float32))
        return heads(1.0 - f), heads(jnp.log(f))

    return q, v, gate(zf, lb[0]), gate(zb, lb[1]), g


def hgrn_readout(o, g, norm_g):
    bn, L = o.shape[:2]
    o = rmsnorm(o, norm_g).reshape(bn, L, HG_WIDTH)
    return (o * jax.nn.silu(g.astype(jnp.float32))).astype(g.dtype)


def hgrn_mixer(p_lat, p_ctx, lb, norm_g, need_ctx):
    ql, vl, (kfl, gfl), (kbl, gbl), g_lat = hgrn_project(p_lat, lb)
    qc, vc, (kfc, gfc), (kbc, gbc), g_ctx = hgrn_project(p_ctx, lb)
    s0 = jnp.zeros((p_lat.shape[0], HG_HEADS, HG_HEAD_DIM, HG_HEAD_DIM), jnp.float32)
    flip = lambda a: a[:, ::-1]
    oc_f, S_f = chunk_scan(qc, kfc, vc, gfc, s0)
    oc_b, S_b = chunk_scan(flip(qc), flip(kbc), flip(vc), flip(gbc), s0)
    ol_f, _ = chunk_scan(ql, kfl, vl, gfl, S_f)
    ol_b, _ = chunk_scan(flip(ql), flip(kbl), flip(vl), flip(gbl), S_b)
    out_lat = hgrn_readout(ol_f + flip(ol_b), g_lat, norm_g)
    out_ctx = hgrn_readout(oc_f + flip(oc_b), g_ctx, norm_g) if need_ctx else None
    return out_lat, out_ctx


def ec_moe(h, router_w, w1, w3, w2):
    bn, N, D = h.shape
    cap = CAPACITY_FACTOR * N // N_EXPERTS
    aff = jax.nn.softmax(jnp.einsum('bnd,de->bne', h, router_w).astype(jnp.float32), axis=-1)
    gates, idx = lax.top_k(jnp.swapaxes(aff, 1, 2), cap)
    xg = jax.vmap(lambda hb, ib: hb[ib])(h, idx)
    a = jnp.einsum('becd,edf->becf', xg, w1)
    b = jnp.einsum('becd,edf->becf', xg, w3)
    y = jnp.einsum('becf,efd->becd', jax.nn.silu(a) * b, w2)
    y = y * gates[..., None].astype(y.dtype)
    return jax.vmap(lambda yb, ib: jnp.zeros((N, D), yb.dtype).at[ib.reshape(-1)].add(yb.reshape(-1, D)))(y, idx)


def setup_inputs(seed: int = 0) -> dict:
    key = jax.random.key(seed)
    ks = jax.random.split(key, 28)

    def nrm(k, shape, s):
        return jax.random.normal(k, shape, jnp.float32) * s

    D, L_ = D_MODEL, DEPTH
    return {
        "x": nrm(ks[0], (BATCH, SEQ, D), 1.0),
        "c": nrm(ks[1], (BATCH, D), 1.0),
        "ctx": nrm(ks[2], (BATCH, CTX_LEN, D), 1.0),
        "c_ctx": nrm(ks[3], (D,), 1.0),
        "ada_w": nrm(ks[4], (L_, D, 6 * D), 0.5 * D ** -0.5),
        "ada_b": nrm(ks[5], (L_, 6 * D), 0.02),
        "norm1_g": 1.0 + nrm(ks[6], (L_, D), 0.05),
        "w_in": nrm(ks[7], (L_, D, IN_COLS), D ** -0.5),
        "hy_conv_w": nrm(ks[8], (L_, HY_SHORT, 3 * HY_WIDTH), HY_SHORT ** -0.5),
        "hy_conv_b": nrm(ks[9], (L_, 3 * HY_WIDTH), 0.02),
        "hy_pos_w1": nrm(ks[10], (L_, HY_POS_DIM, HY_FILTER_HIDDEN), HY_POS_DIM ** -0.5),
        "hy_pos_b1": nrm(ks[11], (L_, HY_FILTER_HIDDEN), 0.1),
        "hy_freq1": 1.0 + nrm(ks[12], (L_, HY_FILTER_HIDDEN), 0.1),
        "hy_pos_w2": nrm(ks[13], (L_, HY_FILTER_HIDDEN, HY_FILTER_HIDDEN), HY_FILTER_HIDDEN ** -0.5),
        "hy_pos_b2": nrm(ks[14], (L_, HY_FILTER_HIDDEN), 0.1),
        "hy_freq2": 1.0 + nrm(ks[15], (L_, HY_FILTER_HIDDEN), 0.1),
        "hy_pos_w3": nrm(ks[16], (L_, HY_FILTER_HIDDEN, HY_ORDER * 2 * HY_WIDTH), HY_FILTER_HIDDEN ** -0.5),
        "hy_bias": nrm(ks[17], (L_, HY_ORDER, HY_WIDTH), 0.5),
        "hy_norm_g": 1.0 + nrm(ks[18], (L_, HY_WIDTH), 0.05),
        "hg_lb": nrm(ks[19], (L_ + 1, 2, HG_WIDTH), 1.0),
        "hg_norm_g": 1.0 + nrm(ks[20], (L_, HG_HEAD_DIM), 0.05),
        "w_out": nrm(ks[21], (L_, MIX_WIDTH, D), MIX_WIDTH ** -0.5),
        "norm2_g": 1.0 + nrm(ks[22], (L_, D), 0.05),
        "router_w": nrm(ks[23], (L_, D, N_EXPERTS), D ** -0.5),
        "exp_w1": nrm(ks[24], (L_, N_EXPERTS, D, EXPERT_FF), D ** -0.5),
        "exp_w3": nrm(ks[25], (L_, N_EXPERTS, D, EXPERT_FF), D ** -0.5),
        "exp_w2": nrm(ks[26], (L_, N_EXPERTS, EXPERT_FF, D), EXPERT_FF ** -0.5),
        "final_g": 1.0 + nrm(ks[27], (D,), 0.05),
    }


def reference(x, c, ctx, c_ctx, ada_w, ada_b, norm1_g, w_in, hy_conv_w, hy_conv_b, hy_pos_w1, hy_pos_b1,
              hy_freq1, hy_pos_w2, hy_pos_b2, hy_freq2, hy_pos_w3, hy_bias, hy_norm_g, hg_lb, hg_norm_g,
              w_out, norm2_g, router_w, exp_w1, exp_w3, exp_w2, final_g):
    rows = x.shape[1] // GRID_W
    lb_all = jnp.cumsum(jax.nn.softmax(hg_lb.astype(jnp.float32), axis=0), axis=0)
    xc = ctx
    s_lat = jax.nn.silu(c)
    s_ctx = jax.nn.silu(c_ctx)
    for l in range(DEPTH):
        last = l == DEPTH - 1
        sh1, sc1, g1, sh2, sc2, g2 = jnp.split((s_lat @ ada_w[l] + ada_b[l])[:, None, :], 6, axis=-1)
        sh1c, sc1c, g1c, sh2c, sc2c, g2c = jnp.split(s_ctx @ ada_w[l] + ada_b[l], 6, axis=-1)

        h = modulate(rmsnorm(x, norm1_g[l]), sh1, sc1)
        hc = modulate(rmsnorm(xc, norm1_g[l]), sh1c, sc1c)
        p = h @ w_in[l]
        pc = hc @ w_in[l]
        filt = (hy_pos_w1[l], hy_pos_b1[l], hy_freq1[l], hy_pos_w2[l], hy_pos_b2[l], hy_freq2[l], hy_pos_w3[l])
        y_hy = hyena_mixer(p[..., :3 * HY_WIDTH], rows, hy_conv_w[l], hy_conv_b[l], filt, hy_bias[l])
        y_hg, y_hg_c = hgrn_mixer(p[..., 3 * HY_WIDTH:], pc[..., 3 * HY_WIDTH:], lb_all[l], hg_norm_g[l], not last)
        mix = jnp.concatenate([rmsnorm(y_hy, hy_norm_g[l]).astype(x.dtype), y_hg.astype(x.dtype)], axis=-1) @ w_out[l]
        x = x + g1 * mix
        if not last:
            y_hy_c = hyena_mixer(pc[..., :3 * HY_WIDTH], 1, hy_conv_w[l], hy_conv_b[l], filt, hy_bias[l])
            mix_c = jnp.concatenate([rmsnorm(y_hy_c, hy_norm_g[l]).astype(xc.dtype), y_hg_c.astype(xc.dtype)], axis=-1) @ w_out[l]
            xc = xc + g1c * mix_c

        h2 = modulate(rmsnorm(x, norm2_g[l]), sh2, sc2)
        x = x + g2 * ec_moe(h2, router_w[l], exp_w1[l], exp_w3[l], exp_w2[l])
        if not last:
            h2c = modulate(rmsnorm(xc, norm2_g[l]), sh2c, sc2c)
            xc = xc + g2c * ec_moe(h2c, router_w[l], exp_w1[l], exp_w3[l], exp_w2[l])
    return rmsnorm(x, final_g)
```

```cpp
#include <hip/hip_runtime.h>
#include <cstdio>
#include <cstdint>

constexpr int D = 1024, NB = 16, SEQ = 2048, CTXL = 256;
constexpr int NTOK = NB * SEQ;
constexpr int NCTX = NB * CTXL;
constexpr int HYW = 512, HGW = 512, HEADS = 4, HD = 128;
constexpr int INC = 4096;
constexpr int NE = 16, CAP = 256, FF = 2048;
constexpr int NT = 512;
constexpr int LDS_BYTES = 147456;
constexpr float EPS = 1e-6f;

constexpr size_t MiB = 1u << 20;
constexpr size_t WS_CTL = 0;
constexpr size_t WS_ADA = 1 * MiB;
constexpr size_t WS_LB = WS_ADA + 512 * 1024;
constexpr size_t WS_HID2 = 2 * MiB;
constexpr size_t WS_AFF = 3 * MiB;
constexpr size_t WS_IDX = 5 * MiB;
constexpr size_t WS_GATE = 5 * MiB + 512 * 1024;
constexpr size_t WS_HF = 6 * MiB;
constexpr size_t WS_SCTX = 22 * MiB;
constexpr size_t WS_HC = 30 * MiB;
constexpr size_t WS_PC = 46 * MiB;
constexpr size_t WS_BIG = 70 * MiB;
constexpr size_t WS_MIX = 406 * MiB;
constexpr size_t WS_END = 534 * MiB;

struct P {
    const float *x, *c, *ctx, *c_ctx, *ada_w, *ada_b, *norm1_g, *w_in, *hy_conv_w, *hy_conv_b, *pos_w1, *pos_b1, *freq1, *pos_w2, *pos_b2,
        *freq2, *pos_w3, *hy_bias, *hy_norm_g, *hg_lb, *hg_norm_g, *w_out, *norm2_g, *router_w, *exp_w1, *exp_w3, *exp_w2, *final_g;
    float* out;
    unsigned char* ws;
    int ph_lo, ph_hi;
};

__device__ __forceinline__ float wave_sum(float v) {
#pragma unroll
    for (int o = 1; o < 64; o <<= 1) v += __shfl_xor(v, o);
    return v;
}
__device__ __forceinline__ float sigmoidf_(float z) { return 1.f / (1.f + expf(-z)); }
__device__ __forceinline__ float siluf_(float z) { return z / (1.f + expf(-z)); }

__device__ void ph_prep(const P& p, float* lds) {
    const int tid = threadIdx.x, G = gridDim.x;
    float* ADA = (float*)(p.ws + WS_ADA);
    float* LB = (float*)(p.ws + WS_LB);
    float* HID2 = (float*)(p.ws + WS_HID2);
    {
        float* s = lds;
        float* red = lds + 17 * 1024;
        for (int i = tid; i < 17 * 1024; i += NT) {
            const int r = i >> 10, d = i & 1023;
            const float cv = r < 16 ? p.c[r * 1024 + d] : p.c_ctx[d];
            s[i] = siluf_(cv);
        }
        __syncthreads();
        for (int item = blockIdx.x; item < 96; item += G) {
            const int jj = tid & 63, ks = tid >> 6, j = item * 64 + jj;
            float acc[17];
#pragma unroll
            for (int r = 0; r < 17; ++r) acc[r] = 0.f;
            for (int d = ks * 128; d < ks * 128 + 128; ++d) {
                const float w = p.ada_w[(size_t)d * 6144 + j];
#pragma unroll
                for (int r = 0; r < 17; ++r) acc[r] += s[r * 1024 + d] * w;
            }
#pragma unroll
            for (int r = 0; r < 17; ++r) red[(ks * 17 + r) * 64 + jj] = acc[r];
            __syncthreads();
            for (int i = tid; i < 17 * 64; i += NT) {
                const int r = i >> 6, j2 = i & 63;
                float sum = 0.f;
#pragma unroll
                for (int k = 0; k < 8; ++k) sum += red[(k * 17 + r) * 64 + j2];
                ADA[r * 6144 + item * 64 + j2] = sum + p.ada_b[item * 64 + j2];
            }
            __syncthreads();
        }
    }
    if (blockIdx.x == 0) {
        for (int i = tid; i < 1024; i += NT) {
            const float a0 = p.hg_lb[i], a1 = p.hg_lb[1024 + i];
            LB[i] = 1.f / (1.f + expf(a1 - a0));
        }
    }
    {
        float* zl = lds;
        float* h1 = lds + 512;
        __syncthreads();
        for (int it = blockIdx.x; it < SEQ / 8; it += G) {
            const int lt = tid >> 6, j = tid & 63, t = it * 8 + lt;
            const float w = 6.283185307179586f * (float)t / 2048.0f;
            if (j == 0) zl[lt * 64] = (float)t / 2047.0f;
            if (j >= 1 && j < 17) { const float f = 1e-4f + (float)(j - 1) * ((15.0f - 1e-4f) / 15.0f); zl[lt * 64 + j] = cosf(f * w); }
            if (j >= 17 && j < 33) { const float f = 1e-4f + (float)(j - 17) * ((15.0f - 1e-4f) / 15.0f); zl[lt * 64 + j] = -sinf(f * w); }
            __syncthreads();
            float a = p.pos_b1[j];
            for (int i = 0; i < 33; ++i) a += zl[lt * 64 + i] * p.pos_w1[i * 64 + j];
            h1[lt * 64 + j] = sinf(p.freq1[j] * a);
            __syncthreads();
            float b = p.pos_b2[j];
            for (int i = 0; i < 64; ++i) b += h1[lt * 64 + i] * p.pos_w2[i * 64 + j];
            HID2[t * 64 + j] = sinf(p.freq2[j] * b);
            __syncthreads();
        }
    }
}

__device__ void ph_norm1(const P& p) {
    const int tid = threadIdx.x, lane = tid & 63, wv = tid >> 6, G = gridDim.x;
    const float* ADA = (const float*)(p.ws + WS_ADA);
    float* H = p.out;
    float* HC = (float*)(p.ws + WS_HC);
    const int gw = blockIdx.x * 8 + wv, NGW = G * 8;
    for (int r = gw; r < NTOK + NCTX; r += NGW) {
        const float* src; float* dst; int ar;
        if (r < NTOK) { src = p.x + (size_t)r * D; dst = H + (size_t)r * D; ar = r / SEQ; }
        else { const int rc = r - NTOK; src = p.ctx + (size_t)rc * D; dst = HC + (size_t)rc * D; ar = 16; }
        float4 v[4]; float ss = 0.f;
#pragma unroll
        for (int j = 0; j < 4; ++j) { v[j] = ((const float4*)src)[lane + 64 * j]; ss += v[j].x * v[j].x + v[j].y * v[j].y + v[j].z * v[j].z + v[j].w * v[j].w; }
        ss = wave_sum(ss);
        const float rstd = rsqrtf(ss * (1.f / D) + EPS);
        const float* sh = ADA + ar * 6144, *sc = sh + 1024;
#pragma unroll
        for (int j = 0; j < 4; ++j) {
            const int d4 = lane + 64 * j;
            const float4 g = ((const float4*)p.norm1_g)[d4], s1 = ((const float4*)sc)[d4], h1 = ((const float4*)sh)[d4];
            float4 o;
            o.x = v[j].x * rstd * g.x * (1.f + s1.x) + h1.x; o.y = v[j].y * rstd * g.y * (1.f + s1.y) + h1.y;
            o.z = v[j].z * rstd * g.z * (1.f + s1.z) + h1.z; o.w = v[j].w * rstd * g.w * (1.f + s1.w) + h1.w;
            ((float4*)dst)[d4] = o;
        }
    }
}

__device__ void ph_filter(const P& p, float* lds) {
    const int tid = threadIdx.x, G = gridDim.x;
    const float* HID2 = (const float*)(p.ws + WS_HID2);
    float* HF = (float*)(p.ws + WS_HF);
    float* w3c = lds;
    float* red = lds + 128;
    const float min_decay = logf(1e-2f) / 1.5f, max_decay = logf(1e-2f) / 0.3f;
    for (int item = blockIdx.x; item < 1024; item += G) {
        const int o = item >> 9, c = item & 511;
        if (tid < 128) { const int dir = tid >> 6, i = tid & 63; w3c[tid] = p.pos_w3[i * 2048 + o * 1024 + dir * 512 + c]; }
        __syncthreads();
        const float delta = fabsf(min_decay + (float)c * ((max_decay - min_decay) / 511.0f));
        float hv[4][2]; float asum = 0.f;
#pragma unroll
        for (int j = 0; j < 4; ++j) {
            const int t = tid + NT * j;
            float r0 = 0.f, r1 = 0.f;
            const float4* hp = (const float4*)(HID2 + t * 64);
#pragma unroll
            for (int i4 = 0; i4 < 16; ++i4) {
                const float4 h = hp[i4];
                r0 += h.x * w3c[i4 * 4 + 0] + h.y * w3c[i4 * 4 + 1] + h.z * w3c[i4 * 4 + 2] + h.w * w3c[i4 * 4 + 3];
                r1 += h.x * w3c[64 + i4 * 4 + 0] + h.y * w3c[64 + i4 * 4 + 1] + h.z * w3c[64 + i4 * 4 + 2] + h.w * w3c[64 + i4 * 4 + 3];
            }
            const float win = expf(-((float)t / 2047.0f) * delta) + 0.05f;
            hv[j][0] = r0 * win; hv[j][1] = r1 * win;
            asum += fabsf(hv[j][0]) + (t >= 1 ? fabsf(hv[j][1]) : 0.f);
        }
        asum = wave_sum(asum);
        if ((tid & 63) == 0) red[tid >> 6] = asum;
        __syncthreads();
        float tot = 0.f;
#pragma unroll
        for (int k = 0; k < 8; ++k) tot += red[k];
        const float inv = 1.f / (tot + EPS);
        float* dst = HF + (size_t)item * 4096;
#pragma unroll
        for (int j = 0; j < 4; ++j) {
            const int t = tid + NT * j;
            float v0 = hv[j][0] * inv;
            if (t == 0) v0 += p.hy_bias[o * 512 + c];
            dst[2047 + t] = v0;
            if (t >= 1) dst[2047 - t] = hv[j][1] * inv;
        }
        if (tid == 0) dst[4095] = 0.f;
        __syncthreads();
    }
}

template <int NBM, class AR, class EP>
__device__ __forceinline__ void sgemm_tile(float* lds, int K, AR arow, const float* B0, const float* B1, int ldb, EP epi) {
    const int tid = threadIdx.x;
    float* As = lds;
    float* Bs0 = lds + 16 * 132;
    float* Bs1 = lds + 32 * 132;
    const int ar = tid >> 2, ak = (tid & 3) * 4;
    const int bk = tid >> 5, bn = (tid & 31) * 4;
    const int ty = tid >> 5, tx = tid & 31;
    const float* ap = arow(ar) + ak;
    const float* bp0 = B0 + (size_t)bk * ldb + bn;
    const float* bp1 = (NBM == 2) ? (B1 + (size_t)bk * ldb + bn) : nullptr;
    float acc0[8][4], acc1[8][4];
#pragma unroll
    for (int i = 0; i < 8; ++i)
#pragma unroll
        for (int j = 0; j < 4; ++j) { acc0[i][j] = 0.f; acc1[i][j] = 0.f; }
    const int nk = K / 16;
    float4 ra = *(const float4*)ap, rb0 = *(const float4*)bp0, rb1 = make_float4(0.f, 0.f, 0.f, 0.f);
    if (NBM == 2) rb1 = *(const float4*)bp1;
    for (int kt = 0; kt < nk; ++kt) {
        As[(ak + 0) * 132 + ar] = ra.x; As[(ak + 1) * 132 + ar] = ra.y; As[(ak + 2) * 132 + ar] = ra.z; As[(ak + 3) * 132 + ar] = ra.w;
        *(float4*)&Bs0[bk * 132 + bn] = rb0;
        if (NBM == 2) *(float4*)&Bs1[bk * 132 + bn] = rb1;
        __syncthreads();
        if (kt + 1 < nk) {
            ra = *(const float4*)(ap + (kt + 1) * 16);
            rb0 = *(const float4*)(bp0 + (size_t)(kt + 1) * 16 * ldb);
            if (NBM == 2) rb1 = *(const float4*)(bp1 + (size_t)(kt + 1) * 16 * ldb);
        }
#pragma unroll
        for (int k = 0; k < 16; ++k) {
            const float4 a0 = *(const float4*)&As[k * 132 + ty * 8], a1 = *(const float4*)&As[k * 132 + ty * 8 + 4];
            const float4 b0 = *(const float4*)&Bs0[k * 132 + tx * 4];
            const float a[8] = {a0.x, a0.y, a0.z, a0.w, a1.x, a1.y, a1.z, a1.w};
            const float b[4] = {b0.x, b0.y, b0.z, b0.w};
#pragma unroll
            for (int i = 0; i < 8; ++i)
#pragma unroll
                for (int j = 0; j < 4; ++j) acc0[i][j] += a[i] * b[j];
            if (NBM == 2) {
                const float4 c0 = *(const float4*)&Bs1[k * 132 + tx * 4];
                const float cc[4] = {c0.x, c0.y, c0.z, c0.w};
#pragma unroll
                for (int i = 0; i < 8; ++i)
#pragma unroll
                    for (int j = 0; j < 4; ++j) acc1[i][j] += a[i] * cc[j];
            }
        }
        __syncthreads();
    }
#pragma unroll
    for (int i = 0; i < 8; ++i)
        epi(ty * 8 + i, tx * 4, make_float4(acc0[i][0], acc0[i][1], acc0[i][2], acc0[i][3]), make_float4(acc1[i][0], acc1[i][1], acc1[i][2], acc1[i][3]));
}

__device__ void ph_inproj_hy(const P& p, float* lds) {
    const float* H = p.out;
    float* PHY = (float*)(p.ws + WS_BIG);
    const int nN = 1536 / 128, nM = NTOK / 128;
    for (int tile = blockIdx.x; tile < nM * nN; tile += gridDim.x) {
        const int tm = tile / nN, tn = tile % nN;
        const float* A0 = H + (size_t)tm * 128 * D;
        float* C0 = PHY + (size_t)tm * 128 * 1536 + tn * 128;
        sgemm_tile<1>(lds, D, [&](int r) { return A0 + (size_t)r * D; }, p.w_in + tn * 128, nullptr, INC,
                      [&](int r, int c, float4 v0, float4) { *(float4*)(C0 + (size_t)r * 1536 + c) = v0; });
    }
}
__device__ void ph_inproj_hg(const P& p, float* lds) {
    const float* H = p.out;
    const float* HC = (const float*)(p.ws + WS_HC);
    float* PHG = (float*)(p.ws + WS_BIG);
    float* PC = (float*)(p.ws + WS_PC);
    const int nN = 2560 / 128, nM = NTOK / 128, nNc = 1536 / 128, nMc = NCTX / 128;
    const int T1 = nM * nN, T2 = nMc * nNc;
    for (int tile = blockIdx.x; tile < T1 + T2; tile += gridDim.x) {
        if (tile < T1) {
            const int tm = tile / nN, tn = tile % nN;
            const float* A0 = H + (size_t)tm * 128 * D;
            float* C0 = PHG + (size_t)tm * 128 * 2560 + tn * 128;
            sgemm_tile<1>(lds, D, [&](int r) { return A0 + (size_t)r * D; }, p.w_in + 1536 + tn * 128, nullptr, INC,
                          [&](int r, int c, float4 v0, float4) { *(float4*)(C0 + (size_t)r * 2560 + c) = v0; });
        } else {
            const int t2 = tile - T1, tm = t2 / nNc, tn = t2 % nNc;
            const float* A0 = HC + (size_t)tm * 128 * D;
            float* C0 = PC + (size_t)tm * 128 * 1536 + tn * 128;
            sgemm_tile<1>(lds, D, [&](int r) { return A0 + (size_t)r * D; }, p.w_in + 2048 + tn * 128, nullptr, INC,
                          [&](int r, int c, float4 v0, float4) { *(float4*)(C0 + (size_t)r * 1536 + c) = v0; });
        }
    }
}

__device__ __forceinline__ float shortconv_at(const P& p, const float* PHY, int b, int t, int ch) {
    const size_t base = ((size_t)b * SEQ + t) * 1536 + ch;
    const int tt = t & 63;
    float v = p.hy_conv_b[ch] + p.hy_conv_w[1536 + ch] * PHY[base];
    if (tt > 0) v += p.hy_conv_w[ch] * PHY[base - 1536];
    if (tt < 63) v += p.hy_conv_w[2 * 1536 + ch] * PHY[base + 1536];
    return v;
}
template <int ORDER>
__device__ void ph_longconv(const P& p, float* lds) {
    const int tid = threadIdx.x;
    float* PHY = (float*)(p.ws + WS_BIG);
    const float* HF = (const float*)(p.ws + WS_HF);
    float* vs = lds;
    float* hf = lds + 2048 * 8;
    for (int item = blockIdx.x; item < 1024; item += gridDim.x) {
        const int c = item >> 1, bh = item & 1;
        for (int i = tid; i < 8 * 2048; i += NT) {
            const int bb = i >> 11, t = i & 2047, b = bh * 8 + bb;
            float v;
            if (ORDER == 0) v = shortconv_at(p, PHY, b, t, c);
            else v = PHY[((size_t)b * SEQ + t) * 1536 + c];
            vs[t * 8 + bb] = v;
        }
        const float* hsrc = HF + (size_t)(ORDER * 512 + c) * 4096;
        for (int i = tid; i < 4096; i += NT) hf[1 + i] = hsrc[i];
        if (tid == 0) hf[0] = 0.f;
        __syncthreads();
        const int t0 = tid * 4;
        float acc[4][8];
#pragma unroll
        for (int j = 0; j < 4; ++j)
#pragma unroll
            for (int q = 0; q < 8; ++q) acc[j][q] = 0.f;
        const int base = t0 + 2047 + 1;
        float w0 = hf[base], w1 = hf[base + 1], w2 = hf[base + 2], w3 = hf[base + 3];
        for (int s = 0; s < SEQ; ++s) {
            const float4 va = *(const float4*)&vs[s * 8], vb = *(const float4*)&vs[s * 8 + 4];
            const float vv[8] = {va.x, va.y, va.z, va.w, vb.x, vb.y, vb.z, vb.w};
#pragma unroll
            for (int q = 0; q < 8; ++q) { acc[0][q] += w0 * vv[q]; acc[1][q] += w1 * vv[q]; acc[2][q] += w2 * vv[q]; acc[3][q] += w3 * vv[q]; }
            w3 = w2; w2 = w1; w1 = w0; w0 = hf[base - s - 1];
        }
        __syncthreads();
        const int gch = (ORDER == 0) ? (512 + c) : (1024 + c);
#pragma unroll
        for (int j = 0; j < 4; ++j)
#pragma unroll
            for (int q = 0; q < 8; ++q) {
                const int b = bh * 8 + q, t = t0 + j;
                const float gate = shortconv_at(p, PHY, b, t, gch);
                PHY[((size_t)b * SEQ + t) * 1536 + c] = gate * acc[j][q];
            }
    }
}

__device__ void ph_hynorm(const P& p) {
    const int tid = threadIdx.x, lane = tid & 63, wv = tid >> 6;
    const float* PHY = (const float*)(p.ws + WS_BIG);
    float* MIX = (float*)(p.ws + WS_MIX);
    for (int r = blockIdx.x * 8 + wv; r < NTOK; r += gridDim.x * 8) {
        const float4* src = (const float4*)(PHY + (size_t)r * 1536);
        float4 v[2]; float ss = 0.f;
#pragma unroll
        for (int j = 0; j < 2; ++j) { v[j] = src[lane + 64 * j]; ss += v[j].x * v[j].x + v[j].y * v[j].y + v[j].z * v[j].z + v[j].w * v[j].w; }
        ss = wave_sum(ss);
        const float rstd = rsqrtf(ss * (1.f / 512.f) + EPS);
#pragma unroll
        for (int j = 0; j < 2; ++j) {
            const float4 g = ((const float4*)p.hy_norm_g)[lane + 64 * j];
            ((float4*)(MIX + (size_t)r * 1024))[lane + 64 * j] = make_float4(v[j].x * rstd * g.x, v[j].y * rstd * g.y, v[j].z * rstd * g.z, v[j].w * rstd * g.w);
        }
    }
}

template <bool CTXMODE>
__device__ void ph_scan(const P& p, float* lds) {
    const int tid = threadIdx.x;
    const float* LB = (const float*)(p.ws + WS_LB);
    float* SCTX = (float*)(p.ws + WS_SCTX);
    const float* SRC = CTXMODE ? (const float*)(p.ws + WS_PC) : (const float*)(p.ws + WS_BIG);
    float* OFB = p.out;
    constexpr int T = CTXMODE ? CTXL : SEQ, LD = CTXMODE ? 1536 : 2560;
    constexpr int QOFF = 0, IOFF = CTXMODE ? 0 : 512, ZFOFF = CTXMODE ? 512 : 1024, ZBOFF = CTXMODE ? 1024 : 1536;
    constexpr int TC = 16;
    float* fL = lds, *kL = lds + TC * 128, *qL = lds + 2 * TC * 128, *vL = lds + 3 * TC * 128, *op = lds + 4 * TC * 128;
    const int v = tid & 127, kq = tid >> 7;
    for (int item = blockIdx.x; item < NB * HEADS * 2; item += gridDim.x) {
        const int dir = item & 1, h = (item >> 1) & 3, b = item >> 3;
        float S[32];
        float* sptr = SCTX + ((size_t)item * 128 + kq * 32) * 128 + v;
#pragma unroll
        for (int kk = 0; kk < 32; ++kk) S[kk] = CTXMODE ? 0.f : sptr[kk * 128];
        for (int t0 = 0; t0 < T; t0 += TC) {
            __syncthreads();
            for (int i = tid; i < TC * 128; i += NT) {
                const int st = i >> 7, k = i & 127;
                const int t = dir == 0 ? (t0 + st) : (T - 1 - (t0 + st));
                const float* row = SRC + ((size_t)b * T + t) * LD + h * 128 + k;
                const float z = row[dir == 0 ? ZFOFF : ZBOFF];
                const float lb = LB[dir * 512 + h * 128 + k];
                const float f = lb + (1.f - lb) * sigmoidf_(z);
                fL[i] = f; kL[i] = 1.f - f; vL[i] = row[IOFF];
                if (!CTXMODE) qL[i] = siluf_(row[QOFF]) * 0.08838834764831845f;
            }
            __syncthreads();
            for (int st = 0; st < TC; ++st) {
                const float vv = vL[st * 128 + v];
                float o = 0.f;
#pragma unroll
                for (int k4 = 0; k4 < 8; ++k4) {
                    const float4 f4 = *(const float4*)&fL[st * 128 + kq * 32 + k4 * 4], k4v = *(const float4*)&kL[st * 128 + kq * 32 + k4 * 4];
                    S[k4 * 4 + 0] = f4.x * S[k4 * 4 + 0] + k4v.x * vv; S[k4 * 4 + 1] = f4.y * S[k4 * 4 + 1] + k4v.y * vv;
                    S[k4 * 4 + 2] = f4.z * S[k4 * 4 + 2] + k4v.z * vv; S[k4 * 4 + 3] = f4.w * S[k4 * 4 + 3] + k4v.w * vv;
                    if (!CTXMODE) {
                        const float4 q4 = *(const float4*)&qL[st * 128 + kq * 32 + k4 * 4];
                        o += S[k4 * 4 + 0] * q4.x + S[k4 * 4 + 1] * q4.y + S[k4 * 4 + 2] * q4.z + S[k4 * 4 + 3] * q4.w;
                    }
                }
                if (!CTXMODE) op[(st * 4 + kq) * 128 + v] = o;
            }
            if (!CTXMODE) {
                __syncthreads();
                for (int i = tid; i < TC * 128; i += NT) {
                    const int st = i >> 7, vv = i & 127;
                    const int t = dir == 0 ? (t0 + st) : (T - 1 - (t0 + st));
                    const float sum = op[(st * 4 + 0) * 128 + vv] + op[(st * 4 + 1) * 128 + vv] + op[(st * 4 + 2) * 128 + vv] + op[(st * 4 + 3) * 128 + vv];
                    OFB[(size_t)dir * NTOK * 512 + ((size_t)b * SEQ + t) * 512 + h * 128 + vv] = sum;
                }
            }
        }
        if (CTXMODE) {
#pragma unroll
            for (int kk = 0; kk < 32; ++kk) sptr[kk * 128] = S[kk];
        }
        __syncthreads();
    }
}

__device__ void ph_readout(const P& p) {
    const int tid = threadIdx.x, lane = tid & 63, wv = tid >> 6;
    const float* OFB = p.out;
    const float* PHG = (const float*)(p.ws + WS_BIG);
    float* MIX = (float*)(p.ws + WS_MIX);
    for (int r = blockIdx.x * 8 + wv; r < NTOK; r += gridDim.x * 8) {
#pragma unroll
        for (int h = 0; h < HEADS; ++h) {
            const int k = lane * 2;
            const float2 a = *(const float2*)(OFB + (size_t)r * 512 + h * 128 + k);
            const float2 bq = *(const float2*)(OFB + (size_t)NTOK * 512 + (size_t)r * 512 + h * 128 + k);
            const float o0 = a.x + bq.x, o1 = a.y + bq.y;
            const float ss = wave_sum(o0 * o0 + o1 * o1);
            const float rstd = rsqrtf(ss * (1.f / 128.f) + EPS);
            const float2 g = *(const float2*)(PHG + (size_t)r * 2560 + 2048 + h * 128 + k);
            const float2 ng = *(const float2*)(p.hg_norm_g + k);
            *(float2*)(MIX + (size_t)r * 1024 + 512 + h * 128 + k) = make_float2(o0 * rstd * ng.x * siluf_(g.x), o1 * rstd * ng.y * siluf_(g.y));
        }
    }
}

__device__ void ph_outproj(const P& p, float* lds) {
    const float* MIX = (const float*)(p.ws + WS_MIX);
    const float* ADA = (const float*)(p.ws + WS_ADA);
    float* X1 = p.out;
    const int nN = D / 128, nM = NTOK / 128;
    for (int tile = blockIdx.x; tile < nM * nN; tile += gridDim.x) {
        const int tm = tile / nN, tn = tile % nN;
        const float* A0 = MIX + (size_t)tm * 128 * D;
        const int b = (tm * 128) / SEQ;
        const float* g1 = ADA + b * 6144 + 2048 + tn * 128;
        sgemm_tile<1>(lds, D, [&](int r) { return A0 + (size_t)r * D; }, p.w_out + tn * 128, nullptr, D,
                      [&](int r, int c, float4 v0, float4) {
                          const size_t off = (size_t)(tm * 128 + r) * D + tn * 128 + c;
                          const float4 xv = *(const float4*)(p.x + off), g = *(const float4*)(g1 + c);
                          *(float4*)(X1 + off) = make_float4(xv.x + g.x * v0.x, xv.y + g.y * v0.y, xv.z + g.z * v0.z, xv.w + g.w * v0.w);
                      });
    }
}

__device__ void ph_norm2_router(const P& p) {
    const int tid = threadIdx.x, lane = tid & 63, wv = tid >> 6;
    const float* ADA = (const float*)(p.ws + WS_ADA);
    const float* X1 = p.out;
    float* H2 = (float*)(p.ws + WS_MIX);
    float* AFF = (float*)(p.ws + WS_AFF);
    for (int r = blockIdx.x * 8 + wv; r < NTOK; r += gridDim.x * 8) {
        const int b = r / SEQ, t = r % SEQ;
        const float4* src = (const float4*)(X1 + (size_t)r * D);
        float4 v[4]; float ss = 0.f;
#pragma unroll
        for (int j = 0; j < 4; ++j) { v[j] = src[lane + 64 * j]; ss += v[j].x * v[j].x + v[j].y * v[j].y + v[j].z * v[j].z + v[j].w * v[j].w; }
        ss = wave_sum(ss);
        const float rstd = rsqrtf(ss * (1.f / D) + EPS);
        const float* sh = ADA + b * 6144 + 3072, *sc = ADA + b * 6144 + 4096;
        float lg[16];
#pragma unroll
        for (int e = 0; e < 16; ++e) lg[e] = 0.f;
#pragma unroll
        for (int j = 0; j < 4; ++j) {
            const int d4 = lane + 64 * j;
            const float4 g = ((const float4*)p.norm2_g)[d4], s1 = ((const float4*)sc)[d4], h1 = ((const float4*)sh)[d4];
            float4 o;
            o.x = v[j].x * rstd * g.x * (1.f + s1.x) + h1.x; o.y = v[j].y * rstd * g.y * (1.f + s1.y) + h1.y;
            o.z = v[j].z * rstd * g.z * (1.f + s1.z) + h1.z; o.w = v[j].w * rstd * g.w * (1.f + s1.w) + h1.w;
            ((float4*)(H2 + (size_t)r * D))[d4] = o;
            const float ov[4] = {o.x, o.y, o.z, o.w};
#pragma unroll
            for (int q = 0; q < 4; ++q) {
                const float4* rw = (const float4*)(p.router_w + (size_t)(d4 * 4 + q) * 16);
#pragma unroll
                for (int e4 = 0; e4 < 4; ++e4) {
                    const float4 w = rw[e4];
                    lg[e4 * 4 + 0] += ov[q] * w.x; lg[e4 * 4 + 1] += ov[q] * w.y; lg[e4 * 4 + 2] += ov[q] * w.z; lg[e4 * 4 + 3] += ov[q] * w.w;
                }
            }
        }
#pragma unroll
        for (int e = 0; e < 16; ++e) lg[e] = wave_sum(lg[e]);
        float mx = lg[0];
#pragma unroll
        for (int e = 1; e < 16; ++e) mx = fmaxf(mx, lg[e]);
        float den = 0.f;
#pragma unroll
        for (int e = 0; e < 16; ++e) { lg[e] = expf(lg[e] - mx); den += lg[e]; }
        const float inv = 1.f / den;
        if (lane < 16) {
            float val = 0.f;
#pragma unroll
            for (int e = 0; e < 16; ++e) val = (lane == e) ? lg[e] : val;
            AFF[((size_t)b * 16 + lane) * SEQ + t] = val * inv;
        }
    }
}

__device__ void ph_topk(const P& p, float* lds) {
    const int tid = threadIdx.x;
    const float* AFF = (const float*)(p.ws + WS_AFF);
    int* IDX = (int*)(p.ws + WS_IDX);
    float* GATE = (float*)(p.ws + WS_GATE);
    float4* ACC = (float4*)(p.ws + WS_BIG);
    for (size_t i = (size_t)blockIdx.x * NT + tid; i < (size_t)NTOK * D / 4; i += (size_t)gridDim.x * NT) ACC[i] = make_float4(0.f, 0.f, 0.f, 0.f);
    float* a = lds;
    for (int item = blockIdx.x; item < NB * NE; item += gridDim.x) {
        __syncthreads();
        for (int i = tid; i < SEQ; i += NT) a[i] = AFF[(size_t)item * SEQ + i];
        __syncthreads();
        float ai[4]; int rank[4];
#pragma unroll
        for (int j = 0; j < 4; ++j) { ai[j] = a[tid + NT * j]; rank[j] = 0; }
        for (int j2 = 0; j2 < SEQ; j2 += 4) {
            const float4 o4 = *(const float4*)&a[j2];
            const float ov[4] = {o4.x, o4.y, o4.z, o4.w};
#pragma unroll
            for (int q = 0; q < 4; ++q)
#pragma unroll
                for (int j = 0; j < 4; ++j) rank[j] += (ov[q] > ai[j] || (ov[q] == ai[j] && (j2 + q) < (tid + NT * j))) ? 1 : 0;
        }
#pragma unroll
        for (int j = 0; j < 4; ++j)
            if (rank[j] < CAP) { IDX[item * CAP + rank[j]] = tid + NT * j; GATE[item * CAP + rank[j]] = ai[j]; }
    }
}

__device__ void ph_moe_up(const P& p, float* lds, int g) {
    const float* H2 = (const float*)(p.ws + WS_MIX);
    const int* IDX = (const int*)(p.ws + WS_IDX);
    float* HMID = (float*)(p.ws + WS_BIG + 128 * MiB);
    for (int tile = blockIdx.x; tile < 4 * 16 * 2 * 16; tile += gridDim.x) {
        const int nt = tile & 15, mh = (tile >> 4) & 1, b = (tile >> 5) & 15, el = tile >> 9, e = g * 4 + el;
        const int* idx = IDX + (b * 16 + e) * CAP + mh * 128;
        const float* Ab = H2 + (size_t)b * SEQ * D;
        float* C0 = HMID + ((size_t)(el * 16 + b) * 256 + mh * 128) * FF + nt * 128;
        sgemm_tile<2>(lds, D, [&](int r) { return Ab + (size_t)idx[r] * D; }, p.exp_w1 + (size_t)e * D * FF + nt * 128, p.exp_w3 + (size_t)e * D * FF + nt * 128, FF,
                      [&](int r, int c, float4 a, float4 bb) {
                          *(float4*)(C0 + (size_t)r * FF + c) = make_float4(siluf_(a.x) * bb.x, siluf_(a.y) * bb.y, siluf_(a.z) * bb.z, siluf_(a.w) * bb.w);
                      });
    }
}
__device__ void ph_moe_down(const P& p, float* lds, int g) {
    const int* IDX = (const int*)(p.ws + WS_IDX);
    const float* GATE = (const float*)(p.ws + WS_GATE);
    const float* HMID = (const float*)(p.ws + WS_BIG + 128 * MiB);
    float* ACC = (float*)(p.ws + WS_BIG);
    for (int tile = blockIdx.x; tile < 4 * 16 * 2 * 8; tile += gridDim.x) {
        const int nt = tile & 7, mh = (tile >> 3) & 1, b = (tile >> 4) & 15, el = tile >> 8, e = g * 4 + el;
        const int* idx = IDX + (b * 16 + e) * CAP + mh * 128;
        const float* gate = GATE + (b * 16 + e) * CAP + mh * 128;
        const float* A0 = HMID + ((size_t)(el * 16 + b) * 256 + mh * 128) * FF;
        sgemm_tile<1>(lds, FF, [&](int r) { return A0 + (size_t)r * FF; }, p.exp_w2 + (size_t)e * FF * D + nt * 128, nullptr, D,
                      [&](int r, int c, float4 v0, float4) {
                          const float gt = gate[r];
                          float* dst = ACC + ((size_t)b * SEQ + idx[r]) * D + nt * 128 + c;
                          atomicAdd(dst + 0, v0.x * gt); atomicAdd(dst + 1, v0.y * gt); atomicAdd(dst + 2, v0.z * gt); atomicAdd(dst + 3, v0.w * gt);
                      });
    }
}

__device__ void ph_final(const P& p) {
    const int tid = threadIdx.x, lane = tid & 63, wv = tid >> 6;
    const float* ADA = (const float*)(p.ws + WS_ADA);
    const float* ACC = (const float*)(p.ws + WS_BIG);
    float* X = p.out;
    for (int r = blockIdx.x * 8 + wv; r < NTOK; r += gridDim.x * 8) {
        const int b = r / SEQ;
        const float* g2 = ADA + b * 6144 + 5120;
        float4 v[4]; float ss = 0.f;
#pragma unroll
        for (int j = 0; j < 4; ++j) {
            const int d4 = lane + 64 * j;
            const float4 xv = ((const float4*)(X + (size_t)r * D))[d4], av = ((const float4*)(ACC + (size_t)r * D))[d4], g = ((const float4*)g2)[d4];
            v[j] = make_float4(xv.x + g.x * av.x, xv.y + g.y * av.y, xv.z + g.z * av.z, xv.w + g.w * av.w);
            ss += v[j].x * v[j].x + v[j].y * v[j].y + v[j].z * v[j].z + v[j].w * v[j].w;
        }
        ss = wave_sum(ss);
        const float rstd = rsqrtf(ss * (1.f / D) + EPS);
#pragma unroll
        for (int j = 0; j < 4; ++j) {
            const int d4 = lane + 64 * j;
            const float4 g = ((const float4*)p.final_g)[d4];
            ((float4*)(X + (size_t)r * D))[d4] = make_float4(v[j].x * rstd * g.x, v[j].y * rstd * g.y, v[j].z * rstd * g.z, v[j].w * rstd * g.w);
        }
    }
}

constexpr int N_PHASES = 23;
template <int PH>
__device__ __forceinline__ void run_phase(const P& p, float* lds) {
    if constexpr (PH == 0) ph_prep(p, lds);
    else if constexpr (PH == 1) ph_norm1(p);
    else if constexpr (PH == 2) ph_filter(p, lds);
    else if constexpr (PH == 3) ph_inproj_hy(p, lds);
    else if constexpr (PH == 4) ph_longconv<0>(p, lds);
    else if constexpr (PH == 5) ph_longconv<1>(p, lds);
    else if constexpr (PH == 6) ph_hynorm(p);
    else if constexpr (PH == 7) ph_inproj_hg(p, lds);
    else if constexpr (PH == 8) ph_scan<true>(p, lds);
    else if constexpr (PH == 9) ph_scan<false>(p, lds);
    else if constexpr (PH == 10) ph_readout(p);
    else if constexpr (PH == 11) ph_outproj(p, lds);
    else if constexpr (PH == 12) ph_norm2_router(p);
    else if constexpr (PH == 13) ph_topk(p, lds);
    else if constexpr (PH >= 14 && PH <= 21 && ((PH - 14) & 1) == 0) ph_moe_up(p, lds, (PH - 14) >> 1);
    else if constexpr (PH >= 14 && PH <= 21) ph_moe_down(p, lds, (PH - 14) >> 1);
    else if constexpr (PH == 22) ph_final(p);
}
template <int PH>
__global__ void __launch_bounds__(NT) fwd_ph(P p) {
    extern __shared__ __attribute__((aligned(16))) unsigned char lds_raw[];
    run_phase<PH>(p, (float*)lds_raw);
}

template <int PH>
static void launch_phase(const P& p, int grid, hipStream_t stream) {
    static bool attr = false;
    if (!attr) { (void)hipFuncSetAttribute((const void*)fwd_ph<PH>, hipFuncAttributeMaxDynamicSharedMemorySize, LDS_BYTES); attr = true; }
    hipLaunchKernelGGL(fwd_ph<PH>, dim3(grid), dim3(NT), LDS_BYTES, stream, p);
}
template <int PH>
static void launch_all(const P& p, int grid, hipStream_t stream) {
    if constexpr (PH < N_PHASES) { launch_phase<PH>(p, grid, stream); launch_all<PH + 1>(p, grid, stream); }
}

extern "C" void kernel_launch(void* const* d_in, const int* in_sizes, int n_in, void* d_out, int out_size, void* d_ws, size_t ws_size, hipStream_t stream) {
    static int grid = 0;
    if (grid == 0) {
        int dev = 0, cus = 0;
        (void)hipGetDevice(&dev);
        (void)hipDeviceGetAttribute(&cus, hipDeviceAttributeMultiprocessorCount, dev);
        grid = cus > 0 ? cus : 256;
        if (ws_size < WS_END) fprintf(stderr, "kernel_launch: workspace too small: %zu < %zu\n", ws_size, (size_t)WS_END);
    }
    P p{};
    const float** f = (const float**)&p;
    for (int i = 0; i < 28; ++i) f[i] = (const float*)d_in[i];
    p.out = (float*)d_out;
    p.ws = (unsigned char*)d_ws;
    p.ph_lo = 0; p.ph_hi = N_PHASES;
    launch_all<0>(p, grid, stream);
}
```

```cpp
#include <hip/hip_runtime.h>
#include <hip/hip_cooperative_groups.h>
namespace cg = cooperative_groups;
#include <cstdio>
#include <cstdint>

constexpr int D = 1024, NB = 16, SEQ = 2048, CTXL = 256;
constexpr int NTOK = NB * SEQ;
constexpr int NCTX = NB * CTXL;
constexpr int HYW = 512, HGW = 512, HEADS = 4, HD = 128;
constexpr int INC = 4096;
constexpr int NE = 16, CAP = 256, FF = 2048;
constexpr int NT = 512;
constexpr int LDS_BYTES = 147456;
constexpr float EPS = 1e-6f;

constexpr size_t MiB = 1u << 20;
constexpr size_t WS_CTL = 0;
constexpr size_t WS_ADA = 1 * MiB;
constexpr size_t WS_LB = WS_ADA + 512 * 1024;
constexpr size_t WS_HID2 = 2 * MiB;
constexpr size_t WS_AFF = 3 * MiB;
constexpr size_t WS_IDX = 5 * MiB;
constexpr size_t WS_GATE = 5 * MiB + 512 * 1024;
constexpr size_t WS_HF = 6 * MiB;
constexpr size_t WS_SCTX = 22 * MiB;
constexpr size_t WS_HC = 30 * MiB;
constexpr size_t WS_PC = 46 * MiB;
constexpr size_t WS_BIG = 70 * MiB;
constexpr size_t WS_MIX = 406 * MiB;
constexpr size_t WS_END = 534 * MiB;

struct P {
    const float *x, *c, *ctx, *c_ctx, *ada_w, *ada_b, *norm1_g, *w_in, *hy_conv_w, *hy_conv_b, *pos_w1, *pos_b1, *freq1, *pos_w2, *pos_b2,
        *freq2, *pos_w3, *hy_bias, *hy_norm_g, *hg_lb, *hg_norm_g, *w_out, *norm2_g, *router_w, *exp_w1, *exp_w3, *exp_w2, *final_g;
    float* out;
    unsigned char* ws;
    int ph_lo, ph_hi;
};

__device__ __forceinline__ float wave_sum(float v) {
#pragma unroll
    for (int o = 1; o < 64; o <<= 1) v += __shfl_xor(v, o);
    return v;
}
__device__ __forceinline__ float sigmoidf_(float z) { return 1.f / (1.f + expf(-z)); }
__device__ __forceinline__ float siluf_(float z) { return z / (1.f + expf(-z)); }

__device__ __forceinline__ void ph_prep(const P& p, float* lds) {
    const int tid = threadIdx.x, G = gridDim.x;
    float* ADA = (float*)(p.ws + WS_ADA);
    float* LB = (float*)(p.ws + WS_LB);
    float* HID2 = (float*)(p.ws + WS_HID2);
    {
        float* s = lds;
        float* red = lds + 17 * 1024;
        for (int i = tid; i < 17 * 1024; i += NT) {
            const int r = i >> 10, d = i & 1023;
            const float cv = r < 16 ? p.c[r * 1024 + d] : p.c_ctx[d];
            s[i] = siluf_(cv);
        }
        __syncthreads();
        for (int item = blockIdx.x; item < 96; item += G) {
            const int jj = tid & 63, ks = tid >> 6, j = item * 64 + jj;
            float acc[17];
#pragma unroll
            for (int r = 0; r < 17; ++r) acc[r] = 0.f;
#pragma unroll 4
            for (int d = ks * 128; d < ks * 128 + 128; ++d) {
                const float w = p.ada_w[(size_t)d * 6144 + j];
#pragma unroll
                for (int r = 0; r < 17; ++r) acc[r] += s[r * 1024 + d] * w;
            }
#pragma unroll
            for (int r = 0; r < 17; ++r) red[(ks * 17 + r) * 64 + jj] = acc[r];
            __syncthreads();
            for (int i = tid; i < 17 * 64; i += NT) {
                const int r = i >> 6, j2 = i & 63;
                float sum = 0.f;
#pragma unroll
                for (int k = 0; k < 8; ++k) sum += red[(k * 17 + r) * 64 + j2];
                ADA[r * 6144 + item * 64 + j2] = sum + p.ada_b[item * 64 + j2];
            }
            __syncthreads();
        }
    }
    if (blockIdx.x == 0) {
        for (int i = tid; i < 1024; i += NT) {
            const float a0 = p.hg_lb[i], a1 = p.hg_lb[1024 + i];
            LB[i] = 1.f / (1.f + expf(a1 - a0));
        }
    }
    {
        float* zl = lds;
        float* h1 = lds + 512;
        __syncthreads();
        for (int it = blockIdx.x; it < SEQ / 8; it += G) {
            const int lt = tid >> 6, j = tid & 63, t = it * 8 + lt;
            const float w = 6.283185307179586f * (float)t / 2048.0f;
            if (j == 0) zl[lt * 64] = (float)t / 2047.0f;
            if (j >= 1 && j < 17) { const float f = 1e-4f + (float)(j - 1) * ((15.0f - 1e-4f) / 15.0f); zl[lt * 64 + j] = cosf(f * w); }
            if (j >= 17 && j < 33) { const float f = 1e-4f + (float)(j - 17) * ((15.0f - 1e-4f) / 15.0f); zl[lt * 64 + j] = -sinf(f * w); }
            __syncthreads();
            float a = p.pos_b1[j];
            for (int i = 0; i < 33; ++i) a += zl[lt * 64 + i] * p.pos_w1[i * 64 + j];
            h1[lt * 64 + j] = sinf(p.freq1[j] * a);
            __syncthreads();
            float b = p.pos_b2[j];
            for (int i = 0; i < 64; ++i) b += h1[lt * 64 + i] * p.pos_w2[i * 64 + j];
            HID2[t * 64 + j] = sinf(p.freq2[j] * b);
            __syncthreads();
        }
    }
}

__device__ __forceinline__ void ph_norm1(const P& p) {
    const int tid = threadIdx.x, lane = tid & 63, wv = tid >> 6, G = gridDim.x;
    const float* ADA = (const float*)(p.ws + WS_ADA);
    float* H = p.out;
    float* HC = (float*)(p.ws + WS_HC);
    const int gw = blockIdx.x * 8 + wv, NGW = G * 8;
    for (int r = gw; r < NTOK + NCTX; r += NGW) {
        const float* src; float* dst; int ar;
        if (r < NTOK) { src = p.x + (size_t)r * D; dst = H + (size_t)r * D; ar = r / SEQ; }
        else { const int rc = r - NTOK; src = p.ctx + (size_t)rc * D; dst = HC + (size_t)rc * D; ar = 16; }
        float4 v[4]; float ss = 0.f;
#pragma unroll
        for (int j = 0; j < 4; ++j) { v[j] = ((const float4*)src)[lane + 64 * j]; ss += v[j].x * v[j].x + v[j].y * v[j].y + v[j].z * v[j].z + v[j].w * v[j].w; }
        ss = wave_sum(ss);
        const float rstd = rsqrtf(ss * (1.f / D) + EPS);
        const float* sh = ADA + ar * 6144, *sc = sh + 1024;
#pragma unroll
        for (int j = 0; j < 4; ++j) {
            const int d4 = lane + 64 * j;
            const float4 g = ((const float4*)p.norm1_g)[d4], s1 = ((const float4*)sc)[d4], h1 = ((const float4*)sh)[d4];
            float4 o;
            o.x = v[j].x * rstd * g.x * (1.f + s1.x) + h1.x; o.y = v[j].y * rstd * g.y * (1.f + s1.y) + h1.y;
            o.z = v[j].z * rstd * g.z * (1.f + s1.z) + h1.z; o.w = v[j].w * rstd * g.w * (1.f + s1.w) + h1.w;
            ((float4*)dst)[d4] = o;
        }
    }
}

__device__ __forceinline__ void ph_filter(const P& p, float* lds) {
    const int tid = threadIdx.x, G = gridDim.x;
    const float* HID2 = (const float*)(p.ws + WS_HID2);
    float* HF = (float*)(p.ws + WS_HF);
    float* w3c = lds;
    float* red = lds + 128;
    const float min_decay = logf(1e-2f) / 1.5f, max_decay = logf(1e-2f) / 0.3f;
    for (int item = blockIdx.x; item < 1024; item += G) {
        const int o = item >> 9, c = item & 511;
        if (tid < 128) { const int dir = tid >> 6, i = tid & 63; w3c[tid] = p.pos_w3[i * 2048 + o * 1024 + dir * 512 + c]; }
        __syncthreads();
        const float delta = fabsf(min_decay + (float)c * ((max_decay - min_decay) / 511.0f));
        float hv[4][2]; float asum = 0.f;
#pragma unroll
        for (int j = 0; j < 4; ++j) {
            const int t = tid + NT * j;
            float r0 = 0.f, r1 = 0.f;
            const float4* hp = (const float4*)(HID2 + t * 64);
#pragma unroll 4
            for (int i4 = 0; i4 < 16; ++i4) {
                const float4 h = hp[i4];
                r0 += h.x * w3c[i4 * 4 + 0] + h.y * w3c[i4 * 4 + 1] + h.z * w3c[i4 * 4 + 2] + h.w * w3c[i4 * 4 + 3];
                r1 += h.x * w3c[64 + i4 * 4 + 0] + h.y * w3c[64 + i4 * 4 + 1] + h.z * w3c[64 + i4 * 4 + 2] + h.w * w3c[64 + i4 * 4 + 3];
            }
            const float win = expf(-((float)t / 2047.0f) * delta) + 0.05f;
            hv[j][0] = r0 * win; hv[j][1] = r1 * win;
            asum += fabsf(hv[j][0]) + (t >= 1 ? fabsf(hv[j][1]) : 0.f);
        }
        asum = wave_sum(asum);
        if ((tid & 63) == 0) red[tid >> 6] = asum;
        __syncthreads();
        float tot = 0.f;
#pragma unroll
        for (int k = 0; k < 8; ++k) tot += red[k];
        const float inv = 1.f / (tot + EPS);
        float* dst = HF + (size_t)item * 4096;
#pragma unroll
        for (int j = 0; j < 4; ++j) {
            const int t = tid + NT * j;
            float v0 = hv[j][0] * inv;
            if (t == 0) v0 += p.hy_bias[o * 512 + c];
            dst[2047 + t] = v0;
            if (t >= 1) dst[2047 - t] = hv[j][1] * inv;
        }
        if (tid == 0) dst[4095] = 0.f;
        __syncthreads();
    }
}

template <int NBM, class AR, class EP>
__device__ __forceinline__ void sgemm_tile(float* lds, int K, AR arow, const float* B0, const float* B1, int ldb, EP epi) {
    const int tid = threadIdx.x;
    float* As = lds;
    float* Bs0 = lds + 16 * 132;
    float* Bs1 = lds + 32 * 132;
    const int ar = tid >> 2, ak = (tid & 3) * 4;
    const int bk = tid >> 5, bn = (tid & 31) * 4;
    const int ty = tid >> 5, tx = tid & 31;
    const float* ap = arow(ar) + ak;
    const float* bp0 = B0 + (size_t)bk * ldb + bn;
    const float* bp1 = (NBM == 2) ? (B1 + (size_t)bk * ldb + bn) : nullptr;
    float acc0[8][4], acc1[8][4];
#pragma unroll
    for (int i = 0; i < 8; ++i)
#pragma unroll
        for (int j = 0; j < 4; ++j) { acc0[i][j] = 0.f; acc1[i][j] = 0.f; }
    const int nk = K / 16;
    float4 ra = *(const float4*)ap, rb0 = *(const float4*)bp0, rb1 = make_float4(0.f, 0.f, 0.f, 0.f);
    if (NBM == 2) rb1 = *(const float4*)bp1;
    for (int kt = 0; kt < nk; ++kt) {
        As[(ak + 0) * 132 + ar] = ra.x; As[(ak + 1) * 132 + ar] = ra.y; As[(ak + 2) * 132 + ar] = ra.z; As[(ak + 3) * 132 + ar] = ra.w;
        *(float4*)&Bs0[bk * 132 + bn] = rb0;
        if (NBM == 2) *(float4*)&Bs1[bk * 132 + bn] = rb1;
        __syncthreads();
        if (kt + 1 < nk) {
            ra = *(const float4*)(ap + (kt + 1) * 16);
            rb0 = *(const float4*)(bp0 + (size_t)(kt + 1) * 16 * ldb);
            if (NBM == 2) rb1 = *(const float4*)(bp1 + (size_t)(kt + 1) * 16 * ldb);
        }
#pragma unroll 4
        for (int k = 0; k < 16; ++k) {
            const float4 a0 = *(const float4*)&As[k * 132 + ty * 8], a1 = *(const float4*)&As[k * 132 + ty * 8 + 4];
            const float4 b0 = *(const float4*)&Bs0[k * 132 + tx * 4];
            const float a[8] = {a0.x, a0.y, a0.z, a0.w, a1.x, a1.y, a1.z, a1.w};
            const float b[4] = {b0.x, b0.y, b0.z, b0.w};
#pragma unroll
            for (int i = 0; i < 8; ++i)
#pragma unroll
                for (int j = 0; j < 4; ++j) acc0[i][j] += a[i] * b[j];
            if (NBM == 2) {
                const float4 c0 = *(const float4*)&Bs1[k * 132 + tx * 4];
                const float cc[4] = {c0.x, c0.y, c0.z, c0.w};
#pragma unroll
                for (int i = 0; i < 8; ++i)
#pragma unroll
                    for (int j = 0; j < 4; ++j) acc1[i][j] += a[i] * cc[j];
            }
        }
        __syncthreads();
    }
#pragma unroll
    for (int i = 0; i < 8; ++i)
        epi(ty * 8 + i, tx * 4, make_float4(acc0[i][0], acc0[i][1], acc0[i][2], acc0[i][3]), make_float4(acc1[i][0], acc1[i][1], acc1[i][2], acc1[i][3]));
}

__device__ __forceinline__ void ph_inproj_hy(const P& p, float* lds) {
    const float* H = p.out;
    float* PHY = (float*)(p.ws + WS_BIG);
    const int nN = 1536 / 128, nM = NTOK / 128;
    for (int tile = blockIdx.x; tile < nM * nN; tile += gridDim.x) {
        const int tm = tile / nN, tn = tile % nN;
        const float* A0 = H + (size_t)tm * 128 * D;
        float* C0 = PHY + (size_t)tm * 128 * 1536 + tn * 128;
        sgemm_tile<1>(lds, D, [&](int r) { return A0 + (size_t)r * D; }, p.w_in + tn * 128, nullptr, INC,
                      [&](int r, int c, float4 v0, float4) { *(float4*)(C0 + (size_t)r * 1536 + c) = v0; });
    }
}
__device__ __forceinline__ void ph_inproj_hg(const P& p, float* lds) {
    const float* H = p.out;
    const float* HC = (const float*)(p.ws + WS_HC);
    float* PHG = (float*)(p.ws + WS_BIG);
    float* PC = (float*)(p.ws + WS_PC);
    const int nN = 2560 / 128, nM = NTOK / 128, nNc = 1536 / 128, nMc = NCTX / 128;
    const int T1 = nM * nN, T2 = nMc * nNc;
    for (int tile = blockIdx.x; tile < T1 + T2; tile += gridDim.x) {
        if (tile < T1) {
            const int tm = tile / nN, tn = tile % nN;
            const float* A0 = H + (size_t)tm * 128 * D;
            float* C0 = PHG + (size_t)tm * 128 * 2560 + tn * 128;
            sgemm_tile<1>(lds, D, [&](int r) { return A0 + (size_t)r * D; }, p.w_in + 1536 + tn * 128, nullptr, INC,
                          [&](int r, int c, float4 v0, float4) { *(float4*)(C0 + (size_t)r * 2560 + c) = v0; });
        } else {
            const int t2 = tile - T1, tm = t2 / nNc, tn = t2 % nNc;
            const float* A0 = HC + (size_t)tm * 128 * D;
            float* C0 = PC + (size_t)tm * 128 * 1536 + tn * 128;
            sgemm_tile<1>(lds, D, [&](int r) { return A0 + (size_t)r * D; }, p.w_in + 2048 + tn * 128, nullptr, INC,
                          [&](int r, int c, float4 v0, float4) { *(float4*)(C0 + (size_t)r * 1536 + c) = v0; });
        }
    }
}

__device__ __forceinline__ float shortconv_at(const P& p, const float* PHY, int b, int t, int ch) {
    const size_t base = ((size_t)b * SEQ + t) * 1536 + ch;
    const int tt = t & 63;
    float v = p.hy_conv_b[ch] + p.hy_conv_w[1536 + ch] * PHY[base];
    if (tt > 0) v += p.hy_conv_w[ch] * PHY[base - 1536];
    if (tt < 63) v += p.hy_conv_w[2 * 1536 + ch] * PHY[base + 1536];
    return v;
}
template <int ORDER>
__device__ __forceinline__ void ph_longconv(const P& p, float* lds) {
    const int tid = threadIdx.x;
    float* PHY = (float*)(p.ws + WS_BIG);
    const float* HF = (const float*)(p.ws + WS_HF);
    float* vs = lds;
    float* hf = lds + 2048 * 8;
    for (int item = blockIdx.x; item < 1024; item += gridDim.x) {
        const int c = item >> 1, bh = item & 1;
        for (int i = tid; i < 8 * 2048; i += NT) {
            const int bb = i >> 11, t = i & 2047, b = bh * 8 + bb;
            float v;
            if (ORDER == 0) v = shortconv_at(p, PHY, b, t, c);
            else v = PHY[((size_t)b * SEQ + t) * 1536 + c];
            vs[t * 8 + bb] = v;
        }
        const float* hsrc = HF + (size_t)(ORDER * 512 + c) * 4096;
        for (int i = tid; i < 4096; i += NT) hf[1 + i] = hsrc[i];
        if (tid == 0) hf[0] = 0.f;
        __syncthreads();
        const int t0 = tid * 4;
        float acc[4][8];
#pragma unroll
        for (int j = 0; j < 4; ++j)
#pragma unroll
            for (int q = 0; q < 8; ++q) acc[j][q] = 0.f;
        const int base = t0 + 2047 + 1;
        float w0 = hf[base], w1 = hf[base + 1], w2 = hf[base + 2], w3 = hf[base + 3];
        for (int s = 0; s < SEQ; ++s) {
            const float4 va = *(const float4*)&vs[s * 8], vb = *(const float4*)&vs[s * 8 + 4];
            const float vv[8] = {va.x, va.y, va.z, va.w, vb.x, vb.y, vb.z, vb.w};
#pragma unroll
            for (int q = 0; q < 8; ++q) { acc[0][q] += w0 * vv[q]; acc[1][q] += w1 * vv[q]; acc[2][q] += w2 * vv[q]; acc[3][q] += w3 * vv[q]; }
            w3 = w2; w2 = w1; w1 = w0; w0 = hf[base - s - 1];
        }
        __syncthreads();
        const int gch = (ORDER == 0) ? (512 + c) : (1024 + c);
#pragma unroll
        for (int j = 0; j < 4; ++j)
#pragma unroll
            for (int q = 0; q < 8; ++q) {
                const int b = bh * 8 + q, t = t0 + j;
                const float gate = shortconv_at(p, PHY, b, t, gch);
                PHY[((size_t)b * SEQ + t) * 1536 + c] = gate * acc[j][q];
            }
    }
}

__device__ __forceinline__ void ph_hynorm(const P& p) {
    const int tid = threadIdx.x, lane = tid & 63, wv = tid >> 6;
    const float* PHY = (const float*)(p.ws + WS_BIG);
    float* MIX = (float*)(p.ws + WS_MIX);
    for (int r = blockIdx.x * 8 + wv; r < NTOK; r += gridDim.x * 8) {
        const float4* src = (const float4*)(PHY + (size_t)r * 1536);
        float4 v[2]; float ss = 0.f;
#pragma unroll
        for (int j = 0; j < 2; ++j) { v[j] = src[lane + 64 * j]; ss += v[j].x * v[j].x + v[j].y * v[j].y + v[j].z * v[j].z + v[j].w * v[j].w; }
        ss = wave_sum(ss);
        const float rstd = rsqrtf(ss * (1.f / 512.f) + EPS);
#pragma unroll
        for (int j = 0; j < 2; ++j) {
            const float4 g = ((const float4*)p.hy_norm_g)[lane + 64 * j];
            ((float4*)(MIX + (size_t)r * 1024))[lane + 64 * j] = make_float4(v[j].x * rstd * g.x, v[j].y * rstd * g.y, v[j].z * rstd * g.z, v[j].w * rstd * g.w);
        }
    }
}

template <bool CTXMODE>
__device__ __forceinline__ void ph_scan(const P& p, float* lds) {
    const int tid = threadIdx.x;
    const float* LB = (const float*)(p.ws + WS_LB);
    float* SCTX = (float*)(p.ws + WS_SCTX);
    const float* SRC = CTXMODE ? (const float*)(p.ws + WS_PC) : (const float*)(p.ws + WS_BIG);
    float* OFB = p.out;
    constexpr int T = CTXMODE ? CTXL : SEQ, LD = CTXMODE ? 1536 : 2560;
    constexpr int QOFF = 0, IOFF = CTXMODE ? 0 : 512, ZFOFF = CTXMODE ? 512 : 1024, ZBOFF = CTXMODE ? 1024 : 1536;
    constexpr int TC = 16;
    float* fL = lds, *kL = lds + TC * 128, *qL = lds + 2 * TC * 128, *vL = lds + 3 * TC * 128, *op = lds + 4 * TC * 128;
    const int v = tid & 127, kq = tid >> 7;
    for (int item = blockIdx.x; item < NB * HEADS * 2; item += gridDim.x) {
        const int dir = item & 1, h = (item >> 1) & 3, b = item >> 3;
        float S[32];
        float* sptr = SCTX + ((size_t)item * 128 + kq * 32) * 128 + v;
#pragma unroll
        for (int kk = 0; kk < 32; ++kk) S[kk] = CTXMODE ? 0.f : sptr[kk * 128];
        for (int t0 = 0; t0 < T; t0 += TC) {
            __syncthreads();
            for (int i = tid; i < TC * 128; i += NT) {
                const int st = i >> 7, k = i & 127;
                const int t = dir == 0 ? (t0 + st) : (T - 1 - (t0 + st));
                const float* row = SRC + ((size_t)b * T + t) * LD + h * 128 + k;
                const float z = row[dir == 0 ? ZFOFF : ZBOFF];
                const float lb = LB[dir * 512 + h * 128 + k];
                const float f = lb + (1.f - lb) * sigmoidf_(z);
                fL[i] = f; kL[i] = 1.f - f; vL[i] = row[IOFF];
                if (!CTXMODE) qL[i] = siluf_(row[QOFF]) * 0.08838834764831845f;
            }
            __syncthreads();
            for (int st = 0; st < TC; ++st) {
                const float vv = vL[st * 128 + v];
                float o = 0.f;
#pragma unroll
                for (int k4 = 0; k4 < 8; ++k4) {
                    const float4 f4 = *(const float4*)&fL[st * 128 + kq * 32 + k4 * 4], k4v = *(const float4*)&kL[st * 128 + kq * 32 + k4 * 4];
                    S[k4 * 4 + 0] = f4.x * S[k4 * 4 + 0] + k4v.x * vv; S[k4 * 4 + 1] = f4.y * S[k4 * 4 + 1] + k4v.y * vv;
                    S[k4 * 4 + 2] = f4.z * S[k4 * 4 + 2] + k4v.z * vv; S[k4 * 4 + 3] = f4.w * S[k4 * 4 + 3] + k4v.w * vv;
                    if (!CTXMODE) {
                        const float4 q4 = *(const float4*)&qL[st * 128 + kq * 32 + k4 * 4];
                        o += S[k4 * 4 + 0] * q4.x + S[k4 * 4 + 1] * q4.y + S[k4 * 4 + 2] * q4.z + S[k4 * 4 + 3] * q4.w;
                    }
                }
                if (!CTXMODE) op[(st * 4 + kq) * 128 + v] = o;
            }
            if (!CTXMODE) {
                __syncthreads();
                for (int i = tid; i < TC * 128; i += NT) {
                    const int st = i >> 7, vv = i & 127;
                    const int t = dir == 0 ? (t0 + st) : (T - 1 - (t0 + st));
                    const float sum = op[(st * 4 + 0) * 128 + vv] + op[(st * 4 + 1) * 128 + vv] + op[(st * 4 + 2) * 128 + vv] + op[(st * 4 + 3) * 128 + vv];
                    OFB[(size_t)dir * NTOK * 512 + ((size_t)b * SEQ + t) * 512 + h * 128 + vv] = sum;
                }
            }
        }
        if (CTXMODE) {
#pragma unroll
            for (int kk = 0; kk < 32; ++kk) sptr[kk * 128] = S[kk];
        }
        __syncthreads();
    }
}

__device__ __forceinline__ void ph_readout(const P& p) {
    const int tid = threadIdx.x, lane = tid & 63, wv = tid >> 6;
    const float* OFB = p.out;
    const float* PHG = (const float*)(p.ws + WS_BIG);
    float* MIX = (float*)(p.ws + WS_MIX);
    for (int r = blockIdx.x * 8 + wv; r < NTOK; r += gridDim.x * 8) {
#pragma unroll
        for (int h = 0; h < HEADS; ++h) {
            const int k = lane * 2;
            const float2 a = *(const float2*)(OFB + (size_t)r * 512 + h * 128 + k);
            const float2 bq = *(const float2*)(OFB + (size_t)NTOK * 512 + (size_t)r * 512 + h * 128 + k);
            const float o0 = a.x + bq.x, o1 = a.y + bq.y;
            const float ss = wave_sum(o0 * o0 + o1 * o1);
            const float rstd = rsqrtf(ss * (1.f / 128.f) + EPS);
            const float2 g = *(const float2*)(PHG + (size_t)r * 2560 + 2048 + h * 128 + k);
            const float2 ng = *(const float2*)(p.hg_norm_g + k);
            *(float2*)(MIX + (size_t)r * 1024 + 512 + h * 128 + k) = make_float2(o0 * rstd * ng.x * siluf_(g.x), o1 * rstd * ng.y * siluf_(g.y));
        }
    }
}

__device__ __forceinline__ void ph_outproj(const P& p, float* lds) {
    const float* MIX = (const float*)(p.ws + WS_MIX);
    const float* ADA = (const float*)(p.ws + WS_ADA);
    float* X1 = p.out;
    const int nN = D / 128, nM = NTOK / 128;
    for (int tile = blockIdx.x; tile < nM * nN; tile += gridDim.x) {
        const int tm = tile / nN, tn = tile % nN;
        const float* A0 = MIX + (size_t)tm * 128 * D;
        const int b = (tm * 128) / SEQ;
        const float* g1 = ADA + b * 6144 + 2048 + tn * 128;
        sgemm_tile<1>(lds, D, [&](int r) { return A0 + (size_t)r * D; }, p.w_out + tn * 128, nullptr, D,
                      [&](int r, int c, float4 v0, float4) {
                          const size_t off = (size_t)(tm * 128 + r) * D + tn * 128 + c;
                          const float4 xv = *(const float4*)(p.x + off), g = *(const float4*)(g1 + c);
                          *(float4*)(X1 + off) = make_float4(xv.x + g.x * v0.x, xv.y + g.y * v0.y, xv.z + g.z * v0.z, xv.w + g.w * v0.w);
                      });
    }
}

__device__ __forceinline__ void ph_norm2_router(const P& p) {
    const int tid = threadIdx.x, lane = tid & 63, wv = tid >> 6;
    const float* ADA = (const float*)(p.ws + WS_ADA);
    const float* X1 = p.out;
    float* H2 = (float*)(p.ws + WS_MIX);
    float* AFF = (float*)(p.ws + WS_AFF);
    for (int r = blockIdx.x * 8 + wv; r < NTOK; r += gridDim.x * 8) {
        const int b = r / SEQ, t = r % SEQ;
        const float4* src = (const float4*)(X1 + (size_t)r * D);
        float4 v[4]; float ss = 0.f;
#pragma unroll
        for (int j = 0; j < 4; ++j) { v[j] = src[lane + 64 * j]; ss += v[j].x * v[j].x + v[j].y * v[j].y + v[j].z * v[j].z + v[j].w * v[j].w; }
        ss = wave_sum(ss);
        const float rstd = rsqrtf(ss * (1.f / D) + EPS);
        const float* sh = ADA + b * 6144 + 3072, *sc = ADA + b * 6144 + 4096;
        float lg[16];
#pragma unroll
        for (int e = 0; e < 16; ++e) lg[e] = 0.f;
#pragma unroll
        for (int j = 0; j < 4; ++j) {
            const int d4 = lane + 64 * j;
            const float4 g = ((const float4*)p.norm2_g)[d4], s1 = ((const float4*)sc)[d4], h1 = ((const float4*)sh)[d4];
            float4 o;
            o.x = v[j].x * rstd * g.x * (1.f + s1.x) + h1.x; o.y = v[j].y * rstd * g.y * (1.f + s1.y) + h1.y;
            o.z = v[j].z * rstd * g.z * (1.f + s1.z) + h1.z; o.w = v[j].w * rstd * g.w * (1.f + s1.w) + h1.w;
            ((float4*)(H2 + (size_t)r * D))[d4] = o;
            const float ov[4] = {o.x, o.y, o.z, o.w};
#pragma unroll
            for (int q = 0; q < 4; ++q) {
                const float4* rw = (const float4*)(p.router_w + (size_t)(d4 * 4 + q) * 16);
#pragma unroll
                for (int e4 = 0; e4 < 4; ++e4) {
                    const float4 w = rw[e4];
                    lg[e4 * 4 + 0] += ov[q] * w.x; lg[e4 * 4 + 1] += ov[q] * w.y; lg[e4 * 4 + 2] += ov[q] * w.z; lg[e4 * 4 + 3] += ov[q] * w.w;
                }
            }
        }
#pragma unroll
        for (int e = 0; e < 16; ++e) lg[e] = wave_sum(lg[e]);
        float mx = lg[0];
#pragma unroll
        for (int e = 1; e < 16; ++e) mx = fmaxf(mx, lg[e]);
        float den = 0.f;
#pragma unroll
        for (int e = 0; e < 16; ++e) { lg[e] = expf(lg[e] - mx); den += lg[e]; }
        const float inv = 1.f / den;
        if (lane < 16) {
            float val = 0.f;
#pragma unroll
            for (int e = 0; e < 16; ++e) val = (lane == e) ? lg[e] : val;
            AFF[((size_t)b * 16 + lane) * SEQ + t] = val * inv;
        }
    }
}

__device__ __forceinline__ void ph_topk(const P& p, float* lds) {
    const int tid = threadIdx.x;
    const float* AFF = (const float*)(p.ws + WS_AFF);
    int* IDX = (int*)(p.ws + WS_IDX);
    float* GATE = (float*)(p.ws + WS_GATE);
    float4* ACC = (float4*)(p.ws + WS_BIG);
    for (size_t i = (size_t)blockIdx.x * NT + tid; i < (size_t)NTOK * D / 4; i += (size_t)gridDim.x * NT) ACC[i] = make_float4(0.f, 0.f, 0.f, 0.f);
    float* a = lds;
    for (int item = blockIdx.x; item < NB * NE; item += gridDim.x) {
        __syncthreads();
        for (int i = tid; i < SEQ; i += NT) a[i] = AFF[(size_t)item * SEQ + i];
        __syncthreads();
        float ai[4]; int rank[4];
#pragma unroll
        for (int j = 0; j < 4; ++j) { ai[j] = a[tid + NT * j]; rank[j] = 0; }
        for (int j2 = 0; j2 < SEQ; j2 += 4) {
            const float4 o4 = *(const float4*)&a[j2];
            const float ov[4] = {o4.x, o4.y, o4.z, o4.w};
#pragma unroll
            for (int q = 0; q < 4; ++q)
#pragma unroll
                for (int j = 0; j < 4; ++j) rank[j] += (ov[q] > ai[j] || (ov[q] == ai[j] && (j2 + q) < (tid + NT * j))) ? 1 : 0;
        }
#pragma unroll
        for (int j = 0; j < 4; ++j)
            if (rank[j] < CAP) { IDX[item * CAP + rank[j]] = tid + NT * j; GATE[item * CAP + rank[j]] = ai[j]; }
    }
}

__device__ __forceinline__ void ph_moe_up(const P& p, float* lds, int g) {
    const float* H2 = (const float*)(p.ws + WS_MIX);
    const int* IDX = (const int*)(p.ws + WS_IDX);
    float* HMID = (float*)(p.ws + WS_BIG + 128 * MiB);
    for (int tile = blockIdx.x; tile < 4 * 16 * 2 * 16; tile += gridDim.x) {
        const int nt = tile & 15, mh = (tile >> 4) & 1, b = (tile >> 5) & 15, el = tile >> 9, e = g * 4 + el;
        const int* idx = IDX + (b * 16 + e) * CAP + mh * 128;
        const float* Ab = H2 + (size_t)b * SEQ * D;
        float* C0 = HMID + ((size_t)(el * 16 + b) * 256 + mh * 128) * FF + nt * 128;
        sgemm_tile<2>(lds, D, [&](int r) { return Ab + (size_t)idx[r] * D; }, p.exp_w1 + (size_t)e * D * FF + nt * 128, p.exp_w3 + (size_t)e * D * FF + nt * 128, FF,
                      [&](int r, int c, float4 a, float4 bb) {
                          *(float4*)(C0 + (size_t)r * FF + c) = make_float4(siluf_(a.x) * bb.x, siluf_(a.y) * bb.y, siluf_(a.z) * bb.z, siluf_(a.w) * bb.w);
                      });
    }
}
__device__ __forceinline__ void ph_moe_down(const P& p, float* lds, int g) {
    const int* IDX = (const int*)(p.ws + WS_IDX);
    const float* GATE = (const float*)(p.ws + WS_GATE);
    const float* HMID = (const float*)(p.ws + WS_BIG + 128 * MiB);
    float* ACC = (float*)(p.ws + WS_BIG);
    for (int tile = blockIdx.x; tile < 4 * 16 * 2 * 8; tile += gridDim.x) {
        const int nt = tile & 7, mh = (tile >> 3) & 1, b = (tile >> 4) & 15, el = tile >> 8, e = g * 4 + el;
        const int* idx = IDX + (b * 16 + e) * CAP + mh * 128;
        const float* gate = GATE + (b * 16 + e) * CAP + mh * 128;
        const float* A0 = HMID + ((size_t)(el * 16 + b) * 256 + mh * 128) * FF;
        sgemm_tile<1>(lds, FF, [&](int r) { return A0 + (size_t)r * FF; }, p.exp_w2 + (size_t)e * FF * D + nt * 128, nullptr, D,
                      [&](int r, int c, float4 v0, float4) {
                          const float gt = gate[r];
                          float* dst = ACC + ((size_t)b * SEQ + idx[r]) * D + nt * 128 + c;
                          atomicAdd(dst + 0, v0.x * gt); atomicAdd(dst + 1, v0.y * gt); atomicAdd(dst + 2, v0.z * gt); atomicAdd(dst + 3, v0.w * gt);
                      });
    }
}

__device__ __forceinline__ void ph_final(const P& p) {
    const int tid = threadIdx.x, lane = tid & 63, wv = tid >> 6;
    const float* ADA = (const float*)(p.ws + WS_ADA);
    const float* ACC = (const float*)(p.ws + WS_BIG);
    float* X = p.out;
    for (int r = blockIdx.x * 8 + wv; r < NTOK; r += gridDim.x * 8) {
        const int b = r / SEQ;
        const float* g2 = ADA + b * 6144 + 5120;
        float4 v[4]; float ss = 0.f;
#pragma unroll
        for (int j = 0; j < 4; ++j) {
            const int d4 = lane + 64 * j;
            const float4 xv = ((const float4*)(X + (size_t)r * D))[d4], av = ((const float4*)(ACC + (size_t)r * D))[d4], g = ((const float4*)g2)[d4];
            v[j] = make_float4(xv.x + g.x * av.x, xv.y + g.y * av.y, xv.z + g.z * av.z, xv.w + g.w * av.w);
            ss += v[j].x * v[j].x + v[j].y * v[j].y + v[j].z * v[j].z + v[j].w * v[j].w;
        }
        ss = wave_sum(ss);
        const float rstd = rsqrtf(ss * (1.f / D) + EPS);
#pragma unroll
        for (int j = 0; j < 4; ++j) {
            const int d4 = lane + 64 * j;
            const float4 g = ((const float4*)p.final_g)[d4];
            ((float4*)(X + (size_t)r * D))[d4] = make_float4(v[j].x * rstd * g.x, v[j].y * rstd * g.y, v[j].z * rstd * g.z, v[j].w * rstd * g.w);
        }
    }
}

constexpr int N_PHASES = 23;
template <int PH>
__device__ __forceinline__ void run_phase(const P& p, float* lds) {
    if constexpr (PH == 0) ph_prep(p, lds);
    else if constexpr (PH == 1) ph_norm1(p);
    else if constexpr (PH == 2) ph_filter(p, lds);
    else if constexpr (PH == 3) ph_inproj_hy(p, lds);
    else if constexpr (PH == 4) ph_longconv<0>(p, lds);
    else if constexpr (PH == 5) ph_longconv<1>(p, lds);
    else if constexpr (PH == 6) ph_hynorm(p);
    else if constexpr (PH == 7) ph_inproj_hg(p, lds);
    else if constexpr (PH == 8) ph_scan<true>(p, lds);
    else if constexpr (PH == 9) ph_scan<false>(p, lds);
    else if constexpr (PH == 10) ph_readout(p);
    else if constexpr (PH == 11) ph_outproj(p, lds);
    else if constexpr (PH == 12) ph_norm2_router(p);
    else if constexpr (PH == 13) ph_topk(p, lds);
    else if constexpr (PH >= 14 && PH <= 21 && ((PH - 14) & 1) == 0) ph_moe_up(p, lds, (PH - 14) >> 1);
    else if constexpr (PH >= 14 && PH <= 21) ph_moe_down(p, lds, (PH - 14) >> 1);
    else if constexpr (PH == 22) ph_final(p);
}
template <int PH>
__device__ __forceinline__ void phase_ni(const P* pp, float* lds) { run_phase<PH>(*pp, lds); }

template <int PH>
__device__ __forceinline__ void run_from(const P* pp, float* lds, cg::grid_group& grid) {
    if constexpr (PH < N_PHASES) {
        phase_ni<PH>(pp, lds);
        if constexpr (PH + 1 < N_PHASES) { grid.sync(); }
        run_from<PH + 1>(pp, lds, grid);
    }
}

__global__ void __launch_bounds__(NT) fwd_all(P p) {
    extern __shared__ __attribute__((aligned(16))) unsigned char lds_raw[];
    cg::grid_group grid = cg::this_grid();
    const P* pp = (const P*)__builtin_amdgcn_kernarg_segment_ptr();
    run_from<0>(pp, (float*)lds_raw, grid);
}

extern "C" void kernel_launch(void* const* d_in, const int* in_sizes, int n_in, void* d_out, int out_size, void* d_ws, size_t ws_size, hipStream_t stream) {
    static int grid = 0;
    if (grid == 0) {
        int dev = 0, cus = 0, per_cu = 0;
        (void)hipGetDevice(&dev);
        (void)hipDeviceGetAttribute(&cus, hipDeviceAttributeMultiprocessorCount, dev);
        (void)hipFuncSetAttribute((const void*)fwd_all, hipFuncAttributeMaxDynamicSharedMemorySize, LDS_BYTES);
        (void)hipOccupancyMaxActiveBlocksPerMultiprocessor(&per_cu, (const void*)fwd_all, NT, LDS_BYTES);
        if (per_cu < 1) { fprintf(stderr, "kernel_launch: occupancy query says %d blocks/CU\n", per_cu); per_cu = 1; }
        grid = (cus > 0 ? cus : 256) * 1;
        if (ws_size < WS_END) fprintf(stderr, "kernel_launch: workspace too small: %zu < %zu\n", ws_size, (size_t)WS_END);
    }
    P p{};
    const float** f = (const float**)&p;
    for (int i = 0; i < 28; ++i) f[i] = (const float*)d_in[i];
    p.out = (float*)d_out;
    p.ws = (unsigned char*)d_ws;
    p.ph_lo = 0; p.ph_hi = N_PHASES;
    void* args[] = {&p};
    hipError_t e = hipLaunchCooperativeKernel((const void*)fwd_all, dim3(grid), dim3(NT), args, LDS_BYTES, stream);
    if (e != hipSuccess) fprintf(stderr, "cooperative launch failed: %s (grid %d)\n", hipGetErrorString(e), grid);
}
```

```cpp
#include <hip/hip_runtime.h>
#include <hip/hip_cooperative_groups.h>
#include <cstdio>
#include <cstdint>
namespace cg = cooperative_groups;

constexpr int D = 1024, NB = 16, SEQ = 2048, CTXL = 256;
constexpr int NTOK = NB * SEQ;
constexpr int NCTX = NB * CTXL;
constexpr int HEADS = 4;
constexpr int INC = 4096;
constexpr int NE = 16, CAP = 256, FF = 2048;
constexpr int NT = 512;
constexpr int LDS_BYTES = 147456;
constexpr float EPS = 1e-6f;
typedef unsigned short bf16_t;

constexpr size_t MiB = 1u << 20;
constexpr size_t WS_CTL = 0;
constexpr size_t WS_ADA = 1 * MiB;
constexpr size_t WS_LB = WS_ADA + 512 * 1024;
constexpr size_t WS_HID2 = 2 * MiB;
constexpr size_t WS_AFF = 3 * MiB;
constexpr size_t WS_IDX = 5 * MiB;
constexpr size_t WS_GATE = 5 * MiB + 512 * 1024;
constexpr size_t WS_INV = 6 * MiB;
constexpr size_t WS_W13T = 8 * MiB;
constexpr size_t WS_YS = WS_W13T;
constexpr size_t WS_W2T = 136 * MiB;
constexpr size_t WS_R = 200 * MiB;
constexpr size_t WS_H = WS_R;
constexpr size_t WS_MIXA = WS_R;
constexpr size_t WS_HC = WS_R + 64 * MiB;
constexpr size_t WS_PC = WS_R + 72 * MiB;
constexpr size_t WS_OFB = WS_R + 84 * MiB;
constexpr size_t WS_WOUTT = WS_R + 148 * MiB;
constexpr size_t WS_PHG = WS_R + 152 * MiB;
constexpr size_t WS_HMID = WS_R;
constexpr size_t WS_H2 = WS_R + 256 * MiB;
constexpr size_t WS_END = WS_R + 320 * MiB;
constexpr size_t DO_PHYT = 0;
constexpr size_t DO_HF = 96 * MiB;
constexpr size_t DO_SCTX = 112 * MiB;
constexpr size_t DO_WINT = 120 * MiB;

struct P {
    const float *x, *c, *ctx, *c_ctx, *ada_w, *ada_b, *norm1_g, *w_in, *hy_conv_w, *hy_conv_b, *pos_w1, *pos_b1, *freq1, *pos_w2, *pos_b2,
        *freq2, *pos_w3, *hy_bias, *hy_norm_g, *hg_lb, *hg_norm_g, *w_out, *norm2_g, *router_w, *exp_w1, *exp_w3, *exp_w2, *final_g;
    float* out;
    unsigned char* ws;
    int ph_lo, ph_hi;
};

__device__ __forceinline__ float wave_sum(float v) {
#pragma unroll
    for (int o = 1; o < 64; o <<= 1) v += __shfl_xor(v, o);
    return v;
}
__device__ __forceinline__ float sigmoidf_(float z) { return 1.f / (1.f + expf(-z)); }
__device__ __forceinline__ float siluf_(float z) { return z / (1.f + expf(-z)); }
__device__ __forceinline__ float bf2f(bf16_t h) { return __uint_as_float((unsigned)h << 16); }
__device__ __forceinline__ unsigned f2bf(float f) { unsigned u = __float_as_uint(f); return (u + 0x7fffu + ((u >> 16) & 1u)) >> 16; }
__device__ __forceinline__ unsigned pk2(float lo, float hi) { return f2bf(lo) | (f2bf(hi) << 16); }

namespace pg8 {
#define PG8_LAS __attribute__((address_space(3)))
typedef unsigned short bf16_t;
typedef short bf16x8 __attribute__((ext_vector_type(8)));
typedef float f32x4 __attribute__((ext_vector_type(4)));
typedef unsigned u32x4 __attribute__((ext_vector_type(4)));
constexpr int BM = 256, BK = 64, HALF = 128, HTB = HALF * BK * 2  , STAGE_BYTES = 8 * HTB, NXCD = 8, WGM = 8;

__host__ __device__ __forceinline__ int lds_byte(int r, int c) { const int st = (r >> 4) * 2 + (c >> 5), rr = r & 15, cc = c & 31, ob = rr * 64 + cc * 2; return st * 1024 + (ob ^ (((ob >> 9) & 1) << 5)); }
__host__ __device__ __forceinline__ void stage_rc(int b, int& R, int& C) { const int st = b / 1024, sb = b % 1024, swz = sb ^ (((sb >> 9) & 1) << 5); R = (st >> 1) * 16 + swz / 64; C = (st & 1) * 32 + (swz % 64) / 2; }
__host__ __device__ __forceinline__ int perm32(int rho) { const int n = rho >> 4, i = rho & 15; return 8 * (i >> 2) + 4 * n + (i & 3); }

struct Unit { const char* a; const char* b; bf16_t* c; const float* aux; const int* gidx; int ldc, row0, col0; };
__device__ __forceinline__ unsigned cvt_pk_bf16(float lo, float hi) { unsigned r; asm volatile("v_cvt_pk_bf16_f32 %0, %1, %2" : "=v"(r) : "v"(lo), "v"(hi)); return r; }

__device__ __forceinline__ void tile_of(int L, int nM, int nN, int& pm, int& pn) {
    const int nwg = nM * nN; int wgid = L;
    { const int q = nwg / NXCD, r = nwg % NXCD, xcd = wgid % NXCD, off = wgid / NXCD; wgid = (xcd < r ? xcd * (q + 1) : r * (q + 1) + (xcd - r) * q) + off; }
    const int nig = WGM * nN, gid = wgid / nig, fm = gid * WGM, gsz = (nM - fm) < WGM ? (nM - fm) : WGM;
    pm = fm + ((wgid % nig) % gsz); pn = (wgid % nig) / gsz;
}

struct EpiStoreBf16 {
    static constexpr bool PERM = true, AFTER_DRAIN = false;
    __device__ __forceinline__ void operator()(const f32x4 (&acc)[2][2][4][2], const Unit& u, int wr, int wc, int fr, int fq) const {
        bf16_t* base = u.c + (size_t)(wr * 64 + fr) * u.ldc + wc * 32 + 8 * fq;
#pragma unroll
        for (int ai = 0; ai < 2; ++ai)
#pragma unroll
            for (int m = 0; m < 4; ++m) { bf16_t* rowp = base + (size_t)(ai * HALF + m * 16) * u.ldc;
#pragma unroll
                for (int bj = 0; bj < 2; ++bj) { const f32x4 v0 = acc[ai][bj][m][0], v1 = acc[ai][bj][m][1];
                    u32x4 w; w.x = cvt_pk_bf16(v0[0], v0[1]); w.y = cvt_pk_bf16(v0[2], v0[3]); w.z = cvt_pk_bf16(v1[0], v1[1]); w.w = cvt_pk_bf16(v1[2], v1[3]);
                    *(u32x4*)(rowp + bj * HALF) = w; } }
    }
};
struct EpiOutProj {
    static constexpr bool PERM = false, AFTER_DRAIN = false;
    const float* x; const float* ada; float* x1;
    __device__ __forceinline__ void operator()(const f32x4 (&acc)[2][2][4][2], const Unit& u, int wr, int wc, int fr, int fq) const {
        const float* g1 = ada + (u.row0 >> 11) * 6144 + 2048;
#pragma unroll
        for (int bj = 0; bj < 2; ++bj)
#pragma unroll
            for (int n = 0; n < 2; ++n) { const int col = u.col0 + bj * HALF + wc * 32 + n * 16 + 4 * fq; const f32x4 g = *(const f32x4*)(g1 + col);
#pragma unroll
                for (int ai = 0; ai < 2; ++ai)
#pragma unroll
                    for (int m = 0; m < 4; ++m) { const size_t off = (size_t)(u.row0 + ai * HALF + wr * 64 + m * 16 + fr) * D + col;
                        const f32x4 xv = *(const f32x4*)(x + off); *(f32x4*)(x1 + off) = xv + g * acc[ai][bj][m][n]; } }
    }
};
__device__ __forceinline__ float silu_fast(float a) { return a * __builtin_amdgcn_rcpf(1.0f + __builtin_amdgcn_exp2f(-1.4426950408889634f * a)); }
struct EpiSwiGLU {
    static constexpr bool PERM = true, AFTER_DRAIN = false;
    __device__ __forceinline__ void operator()(const f32x4 (&acc)[2][2][4][2], const Unit& u, int wr, int wc, int fr, int fq) const {
        bf16_t* base = u.c + (size_t)(wr * 64 + fr) * FF + wc * 32 + 8 * fq;
#pragma unroll
        for (int ai = 0; ai < 2; ++ai)
#pragma unroll
            for (int m = 0; m < 4; ++m) { const f32x4 a0 = acc[ai][0][m][0], a1 = acc[ai][0][m][1], b0 = acc[ai][1][m][0], b1 = acc[ai][1][m][1];
                u32x4 w; w.x = cvt_pk_bf16(silu_fast(a0[0]) * b0[0], silu_fast(a0[1]) * b0[1]); w.y = cvt_pk_bf16(silu_fast(a0[2]) * b0[2], silu_fast(a0[3]) * b0[3]);
                w.z = cvt_pk_bf16(silu_fast(a1[0]) * b1[0], silu_fast(a1[1]) * b1[1]); w.w = cvt_pk_bf16(silu_fast(a1[2]) * b1[2], silu_fast(a1[3]) * b1[3]);
                *(u32x4*)(base + (size_t)(ai * HALF + m * 16) * FF) = w; }
    }
};
struct EpiDown {
    static constexpr bool PERM = true, AFTER_DRAIN = false;
    __device__ __forceinline__ void operator()(const f32x4 (&acc)[2][2][4][2], const Unit& u, int wr, int wc, int fr, int fq) const {
        bf16_t* base = u.c + (size_t)(wr * 64 + fr) * D + wc * 32 + 8 * fq;
#pragma unroll
        for (int ai = 0; ai < 2; ++ai)
#pragma unroll
            for (int m = 0; m < 4; ++m) { const float gt = u.aux[ai * HALF + wr * 64 + m * 16 + fr]; bf16_t* rowp = base + (size_t)(ai * HALF + m * 16) * D;
#pragma unroll
                for (int bj = 0; bj < 2; ++bj) { const f32x4 v0 = acc[ai][bj][m][0] * gt, v1 = acc[ai][bj][m][1] * gt;
                    u32x4 w; w.x = cvt_pk_bf16(v0[0], v0[1]); w.y = cvt_pk_bf16(v0[2], v0[3]); w.z = cvt_pk_bf16(v1[0], v1[1]); w.w = cvt_pk_bf16(v1[2], v1[3]);
                    *(u32x4*)(rowp + bj * HALF) = w; } }
    }
};

template <class Epi, class Sched, bool ALIGN_EPI = false, bool SP2 = false, bool GATHER = false>
__device__ __forceinline__ void gemm_phase(PG8_LAS unsigned char* lds, const int K, const Sched& S, const Epi& E) {
    const int tid = threadIdx.x, wid = __builtin_amdgcn_readfirstlane(tid >> 6), lane = tid & 63, wr = wid >> 2, wc = wid & 3, fr = lane & 15, fq = lane >> 4;
    const int nt = K / BK;
    unsigned voffA[2], voffB[2];
#pragma unroll
    for (int i = 0; i < 2; ++i) { int R, C; stage_rc(tid * 16 + i * 8192, R, C); const int Rb = Epi::PERM ? ((R & ~31) + perm32(R & 31)) : R;
        voffA[i] = (unsigned)(R * K + C) * 2u; voffB[i] = (unsigned)(Rb * K + C) * 2u; }
    const size_t kstep = (size_t)(BK * 2);
    const size_t hstep = (size_t)HALF * K * 2;
    const unsigned ldsw = (unsigned)wid * 1024u;
    const int aoff = lds_byte(wr * 64 + fr, fq * 8), boff = lds_byte(wc * 32 + fr, fq * 8);
#define PG8_SA(b, h) (((b) * 2 + (h)) * HTB)
#define PG8_SB(b, h) ((4 + (b) * 2 + (h)) * HTB)
#define PG8_STAGE(bufoff, gbase, voff) do { _Pragma("unroll") for (int _i = 0; _i < 2; ++_i) \
        __builtin_amdgcn_global_load_lds((const unsigned*)((const char*)(gbase) + (voff)[_i]), (PG8_LAS unsigned*)(lds + (bufoff) + ldsw + _i * 8192), 16, 0, 0); } while (0)
#define PG8_STAGE_A(bufoff, gbase, h) do { _Pragma("unroll") for (int _i = 0; _i < 2; ++_i) \
        __builtin_amdgcn_global_load_lds((const unsigned*)((const char*)(gbase) + voffAh[h][_i]), (PG8_LAS unsigned*)(lds + (bufoff) + ldsw + _i * 8192), 16, 0, 0); } while (0)
#define PG8_LDA(dst, b, h) do { _Pragma("unroll") for (int m = 0; m < 4; ++m) _Pragma("unroll") for (int k = 0; k < 2; ++k) dst[m][k] = *(const PG8_LAS bf16x8*)(lds + PG8_SA(b, h) + aoff + m * 2048 + k * 1024); } while (0)
#define PG8_LDB(dst, b, h) do { _Pragma("unroll") for (int n = 0; n < 2; ++n) _Pragma("unroll") for (int k = 0; k < 2; ++k) dst[n][k] = *(const PG8_LAS bf16x8*)(lds + PG8_SB(b, h) + boff + n * 2048 + k * 1024); } while (0)
#define PG8_MMA(ai, bj, At, Bt) do { __builtin_amdgcn_s_setprio(1); _Pragma("unroll") for (int m = 0; m < 4; ++m) _Pragma("unroll") for (int n = 0; n < 2; ++n) _Pragma("unroll") for (int k = 0; k < 2; ++k) \
        acc[ai][bj][m][n] = __builtin_amdgcn_mfma_f32_16x16x32_bf16(Bt[n][k], At[m][k], acc[ai][bj][m][n], 0, 0, 0); __builtin_amdgcn_s_setprio(0); } while (0)
#define PG8_WAIT_V(n) asm volatile("s_waitcnt vmcnt(" #n ")" ::: "memory")
#define PG8_WAIT_L(n) asm volatile("s_waitcnt lgkmcnt(" #n ")" ::: "memory")
#define PG8_BAR __builtin_amdgcn_s_barrier()
#define PG8_SCHED __builtin_amdgcn_sched_barrier(0)
    Unit cur, nxt; int ui = 0;
    if (!S.next(0, cur)) return;
    unsigned voffAh[2][2];
#pragma unroll
    for (int h = 0; h < 2; ++h)
#pragma unroll
        for (int i = 0; i < 2; ++i) {
            if constexpr (GATHER) { int R, C; stage_rc(tid * 16 + i * 8192, R, C); voffAh[h][i] = ((unsigned)cur.gidx[h * HALF + R] * (unsigned)K + (unsigned)C) * 2u; }
            else voffAh[h][i] = voffA[i] + (unsigned)h * (unsigned)hstep;
        }
    f32x4 acc[2][2][4][2];
#pragma unroll
    for (int a = 0; a < 2; ++a)
#pragma unroll
        for (int b = 0; b < 2; ++b)
#pragma unroll
            for (int m = 0; m < 4; ++m)
#pragma unroll
                for (int n = 0; n < 2; ++n) acc[a][b][m][n] = (f32x4){0.f, 0.f, 0.f, 0.f};
    bf16x8 At[4][2], B0[2][2], B1[2][2];
    const char* cA = cur.a; const char* cB = cur.b;
    S.a_ready(cur);
    if constexpr (SP2) {
        PG8_STAGE(PG8_SB(0, 0), cB, voffB); PG8_STAGE(PG8_SB(0, 1), cB + hstep, voffB); PG8_STAGE_A(PG8_SA(0, 0), cA, 0); PG8_STAGE_A(PG8_SA(0, 1), cA, 1);
        if (wr == 1) PG8_BAR;
        PG8_WAIT_V(2); PG8_BAR;
        PG8_STAGE(PG8_SB(1, 0), cB + kstep, voffB); PG8_STAGE_A(PG8_SA(1, 0), cA + kstep, 0); PG8_STAGE(PG8_SB(1, 1), cB + hstep + kstep, voffB);
        PG8_WAIT_V(6); PG8_BAR;
    } else {
        PG8_STAGE(PG8_SB(0, 0), cB, voffB); PG8_STAGE_A(PG8_SA(0, 0), cA, 0); PG8_STAGE(PG8_SB(0, 1), cB + hstep, voffB); PG8_STAGE_A(PG8_SA(0, 1), cA, 1);
        if (wr == 1) PG8_BAR;
        PG8_WAIT_V(4); PG8_BAR;
        PG8_STAGE(PG8_SB(1, 0), cB + kstep, voffB); PG8_STAGE_A(PG8_SA(1, 0), cA + kstep, 0); PG8_STAGE(PG8_SB(1, 1), cB + hstep + kstep, voffB);
        PG8_WAIT_V(6); PG8_BAR;
    }
    for (;;) {
        const bool has_next = S.next(ui + 1, nxt);
        const char* nA = has_next ? nxt.a : cA; const char* nB = has_next ? nxt.b : cB;
        for (int t = 0; t < nt; t += 2) {
            const bool last = (t == nt - 2);
            const char* a1 = cA + (size_t)(t + 1) * kstep;
            const char* a2 = last ? nA : cA + (size_t)(t + 2) * kstep; const char* b2 = last ? nB : cB + (size_t)(t + 2) * kstep;
            const char* a3 = a2 + kstep; const char* b3 = b2 + kstep;
            if (last && has_next) S.a_ready(nxt);
            if constexpr (SP2) {
            PG8_LDB(B0, 0, 0); PG8_LDB(B1, 0, 1); PG8_SCHED; PG8_LDA(At, 0, 0); PG8_STAGE_A(PG8_SA(1, 1), a1, 1);
            PG8_WAIT_V(8); PG8_WAIT_L(0); PG8_BAR; PG8_MMA(0, 0, At, B0); PG8_MMA(0, 1, At, B1); PG8_BAR; PG8_SCHED;
            PG8_LDA(At, 0, 1); PG8_STAGE(PG8_SB(0, 0), b2, voffB); PG8_STAGE(PG8_SB(0, 1), b2 + hstep, voffB); PG8_STAGE_A(PG8_SA(0, 0), a2, 0);
            PG8_WAIT_V(8); PG8_WAIT_L(0); PG8_BAR; PG8_MMA(1, 0, At, B0); PG8_MMA(1, 1, At, B1); PG8_BAR; PG8_SCHED;
            PG8_LDB(B0, 1, 0); PG8_LDB(B1, 1, 1); PG8_SCHED; PG8_LDA(At, 1, 0); PG8_STAGE_A(PG8_SA(0, 1), a2, 1);
            PG8_WAIT_V(8); PG8_WAIT_L(0); PG8_BAR; PG8_MMA(0, 0, At, B0); PG8_MMA(0, 1, At, B1); PG8_BAR; PG8_SCHED;
            PG8_LDA(At, 1, 1); PG8_STAGE(PG8_SB(1, 0), b3, voffB); PG8_STAGE(PG8_SB(1, 1), b3 + hstep, voffB); PG8_STAGE_A(PG8_SA(1, 0), a3, 0);
            PG8_WAIT_V(8); PG8_WAIT_L(0); PG8_BAR; PG8_MMA(1, 0, At, B0); PG8_MMA(1, 1, At, B1); PG8_BAR; PG8_SCHED;
            } else {
            PG8_LDB(B0, 0, 0); PG8_SCHED; PG8_LDA(At, 0, 0); PG8_STAGE_A(PG8_SA(1, 1), a1, 1);
            PG8_WAIT_L(8); PG8_BAR; PG8_WAIT_L(0); PG8_MMA(0, 0, At, B0); PG8_BAR; PG8_SCHED;
            PG8_LDB(B1, 0, 1); PG8_STAGE(PG8_SB(0, 0), b2, voffB);
            PG8_BAR; PG8_WAIT_L(0); PG8_MMA(0, 1, At, B1); PG8_BAR;
            PG8_LDA(At, 0, 1); PG8_STAGE_A(PG8_SA(0, 0), a2, 0);
            PG8_BAR; PG8_WAIT_L(0); PG8_MMA(1, 0, At, B0); PG8_BAR; PG8_SCHED;
            PG8_STAGE(PG8_SB(0, 1), b2 + hstep, voffB);
            PG8_WAIT_V(6); PG8_BAR; PG8_MMA(1, 1, At, B1); PG8_BAR;
            PG8_LDB(B0, 1, 0); PG8_SCHED; PG8_LDA(At, 1, 0); PG8_STAGE_A(PG8_SA(0, 1), a2, 1);
            PG8_WAIT_L(8); PG8_BAR; PG8_WAIT_L(0); PG8_MMA(0, 0, At, B0); PG8_BAR; PG8_SCHED;
            PG8_LDB(B1, 1, 1); PG8_STAGE(PG8_SB(1, 0), b3, voffB);
            PG8_BAR; PG8_WAIT_L(0); PG8_MMA(0, 1, At, B1); PG8_BAR;
            PG8_LDA(At, 1, 1); PG8_STAGE_A(PG8_SA(1, 0), a3, 0);
            PG8_BAR; PG8_WAIT_L(0); PG8_MMA(1, 0, At, B0); PG8_BAR; PG8_SCHED;
            PG8_STAGE(PG8_SB(1, 1), b3 + hstep, voffB);
            PG8_WAIT_V(6); PG8_BAR; PG8_MMA(1, 1, At, B1); PG8_BAR;
            }
        }
        if constexpr (ALIGN_EPI) { if (wr == 0) PG8_BAR; }
        if constexpr (!Epi::AFTER_DRAIN) { E(acc, cur, wr, wc, fr, fq); S.done(cur); }
        if (!has_next) break;
#pragma unroll
        for (int a = 0; a < 2; ++a)
#pragma unroll
            for (int b = 0; b < 2; ++b)
#pragma unroll
                for (int m = 0; m < 4; ++m)
#pragma unroll
                    for (int n = 0; n < 2; ++n) acc[a][b][m][n] = (f32x4){0.f, 0.f, 0.f, 0.f};
        cur = nxt; cA = nA; cB = nB; ++ui;
        if constexpr (ALIGN_EPI) { if (wr == 1) PG8_BAR; }
    }
    PG8_WAIT_V(0);
    if constexpr (!ALIGN_EPI) { if (wr == 0) PG8_BAR; }
    PG8_BAR;
    if constexpr (Epi::AFTER_DRAIN) { E.fused(acc, cur, wr, wc, fr, fq, lds, wid, lane); S.done(cur); }
#undef PG8_SA
#undef PG8_SB
#undef PG8_STAGE
#undef PG8_LDA
#undef PG8_LDB
#undef PG8_MMA
#undef PG8_WAIT_V
#undef PG8_WAIT_L
#undef PG8_BAR
#undef PG8_SCHED
}
}
using pg8::Unit; using pg8::tile_of;

__device__ __forceinline__ void ph_prep(const P& p, float* lds) {
    const int tid = threadIdx.x, G = gridDim.x;
    float* ADA = (float*)(p.ws + WS_ADA);
    float* LB = (float*)(p.ws + WS_LB);
    float* HID2 = (float*)(p.ws + WS_HID2);
    {
        float* s = lds;
        float* red = lds + 17 * 1024;
        if (blockIdx.x < 96) {
            for (int i = tid; i < 17 * 1024; i += NT) {
                const int r = i >> 10, d = i & 1023;
                const float cv = r < 16 ? p.c[r * 1024 + d] : p.c_ctx[d];
                s[i] = siluf_(cv);
            }
        }
        __syncthreads();
        for (int item = blockIdx.x; item < 96; item += G) {
            const int jj = tid & 63, ks = tid >> 6, j = item * 64 + jj;
            float acc[17];
#pragma unroll
            for (int r = 0; r < 17; ++r) acc[r] = 0.f;
#pragma unroll 4
            for (int d = ks * 128; d < ks * 128 + 128; ++d) {
                const float w = p.ada_w[(size_t)d * 6144 + j];
#pragma unroll
                for (int r = 0; r < 17; ++r) acc[r] += s[r * 1024 + d] * w;
            }
#pragma unroll
            for (int r = 0; r < 17; ++r) red[(ks * 17 + r) * 64 + jj] = acc[r];
            __syncthreads();
            for (int i = tid; i < 17 * 64; i += NT) {
                const int r = i >> 6, j2 = i & 63;
                float sum = 0.f;
#pragma unroll
                for (int k = 0; k < 8; ++k) sum += red[(k * 17 + r) * 64 + j2];
                ADA[r * 6144 + item * 64 + j2] = sum + p.ada_b[item * 64 + j2];
            }
            __syncthreads();
        }
    }
    if (blockIdx.x == G - 1) {
        for (int i = tid; i < 1024; i += NT) {
            const float a0 = p.hg_lb[i], a1 = p.hg_lb[1024 + i];
            LB[i] = 1.f / (1.f + expf(a1 - a0));
        }
    }
    {
        float* zl = lds;
        float* h1 = lds + 512;
        __syncthreads();
        for (int it = (G - 1 - blockIdx.x); it < SEQ / 8; it += G) {
            const int lt = tid >> 6, j = tid & 63, t = it * 8 + lt;
            const float w = 6.283185307179586f * (float)t / 2048.0f;
            if (j == 0) zl[lt * 64] = (float)t / 2047.0f;
            if (j >= 1 && j < 17) { const float f = 1e-4f + (float)(j - 1) * ((15.0f - 1e-4f) / 15.0f); zl[lt * 64 + j] = cosf(f * w); }
            if (j >= 17 && j < 33) { const float f = 1e-4f + (float)(j - 17) * ((15.0f - 1e-4f) / 15.0f); zl[lt * 64 + j] = -sinf(f * w); }
            __syncthreads();
            float a = p.pos_b1[j];
            for (int i = 0; i < 33; ++i) a += zl[lt * 64 + i] * p.pos_w1[i * 64 + j];
            h1[lt * 64 + j] = sinf(p.freq1[j] * a);
            __syncthreads();
            float b = p.pos_b2[j];
            for (int i = 0; i < 64; ++i) b += h1[lt * 64 + i] * p.pos_w2[i * 64 + j];
            HID2[t * 64 + j] = sinf(p.freq2[j] * b);
            __syncthreads();
        }
    }
}
__device__ __forceinline__ void conv_item(const float* W, int N, int k0, int n0, bf16_t* dst, int KD, float* scr, int lane) {
#pragma unroll 8
    for (int i = 0; i < 32; ++i) { const int kk = 2 * i + (lane >> 5); scr[kk * 33 + (lane & 31)] = W[(size_t)(k0 + kk) * N + n0 + (lane & 31)]; }
    asm volatile("s_waitcnt lgkmcnt(0)" ::: "memory");
    const int c = lane & 7;
#pragma unroll
    for (int j = 0; j < 4; ++j) { const int n = (lane >> 3) + 8 * j; const float* s = scr + (8 * c) * 33 + n;
        uint4 o; o.x = pk2(s[0 * 33], s[1 * 33]); o.y = pk2(s[2 * 33], s[3 * 33]); o.z = pk2(s[4 * 33], s[5 * 33]); o.w = pk2(s[6 * 33], s[7 * 33]);
        *(uint4*)(dst + (size_t)n * KD + k0 + 8 * c) = o; }
    asm volatile("s_waitcnt lgkmcnt(0)" ::: "memory");
}
__device__ __forceinline__ void ph_convert(const P& p, float* lds) {
    const int tid = threadIdx.x, lane = tid & 63, wv = tid >> 6;
    float* scr = lds + wv * (64 * 33);
    bf16_t* WinT = (bf16_t*)((unsigned char*)p.out + DO_WINT);
    bf16_t* WoutT = (bf16_t*)(p.ws + WS_WOUTT);
    bf16_t* W13T = (bf16_t*)(p.ws + WS_W13T);
    bf16_t* W2T = (bf16_t*)(p.ws + WS_W2T);
    constexpr int I_IN = 16 * 128, I_OUT = 16 * 32, I_W1 = 16 * 16 * 64, I_W2 = 16 * 32 * 32;
    constexpr int NITEMS = I_IN + I_OUT + 2 * I_W1 + I_W2;
    __syncthreads();
    for (int it = blockIdx.x * 8 + wv; it < NITEMS; it += gridDim.x * 8) {
        int r = it;
        if (r < I_IN) { const int kb = r / 128, nb = r % 128; conv_item(p.w_in, INC, kb * 64, nb * 32, WinT + (size_t)(nb * 32) * D, D, scr, lane); continue; }
        r -= I_IN;
        if (r < I_OUT) { const int kb = r / 32, nb = r % 32; conv_item(p.w_out, D, kb * 64, nb * 32, WoutT + (size_t)(nb * 32) * D, D, scr, lane); continue; }
        r -= I_OUT;
        if (r < 2 * I_W1) {
            const int which = r / I_W1; r %= I_W1;
            const int e = r / 1024, r2 = r % 1024, kb = r2 / 64, nb = r2 % 64, n0 = nb * 32;
            const float* W = (which == 0 ? p.exp_w1 : p.exp_w3) + (size_t)e * D * FF;
            const int row = (n0 >> 7) * 256 + which * 128 + (n0 & 127);
            conv_item(W, FF, kb * 64, n0, W13T + ((size_t)e * 4096 + row) * D, D, scr, lane); continue;
        }
        r -= 2 * I_W1;
        { const int e = r / 1024, r2 = r % 1024, kb = r2 / 32, nb = r2 % 32;
          conv_item(p.exp_w2 + (size_t)e * FF * D, D, kb * 64, nb * 32, W2T + ((size_t)e * 1024 + nb * 32) * FF, FF, scr, lane); }
    }
}

__device__ __forceinline__ void ph_norm1(const P& p) {
    const int tid = threadIdx.x, lane = tid & 63, wv = tid >> 6, G = gridDim.x;
    const float* ADA = (const float*)(p.ws + WS_ADA);
    bf16_t* H = (bf16_t*)(p.ws + WS_H);
    bf16_t* HC = (bf16_t*)(p.ws + WS_HC);
    const int gw = blockIdx.x * 8 + wv, NGW = G * 8;
    for (int r = gw; r < NTOK + NCTX; r += NGW) {
        const float* src; bf16_t* dst; int ar;
        if (r < NTOK) { src = p.x + (size_t)r * D; dst = H + (size_t)r * D; ar = r / SEQ; }
        else { const int rc = r - NTOK; src = p.ctx + (size_t)rc * D; dst = HC + (size_t)rc * D; ar = 16; }
        float4 v[4]; float ss = 0.f;
#pragma unroll
        for (int j = 0; j < 4; ++j) { v[j] = ((const float4*)src)[lane + 64 * j]; ss += v[j].x * v[j].x + v[j].y * v[j].y + v[j].z * v[j].z + v[j].w * v[j].w; }
        ss = wave_sum(ss);
        const float rstd = rsqrtf(ss * (1.f / D) + EPS);
        const float* sh = ADA + ar * 6144, *sc = sh + 1024;
#pragma unroll
        for (int j = 0; j < 4; ++j) {
            const int d4 = lane + 64 * j;
            const float4 g = ((const float4*)p.norm1_g)[d4], s1 = ((const float4*)sc)[d4], h1 = ((const float4*)sh)[d4];
            float4 o;
            o.x = v[j].x * rstd * g.x * (1.f + s1.x) + h1.x; o.y = v[j].y * rstd * g.y * (1.f + s1.y) + h1.y;
            o.z = v[j].z * rstd * g.z * (1.f + s1.z) + h1.z; o.w = v[j].w * rstd * g.w * (1.f + s1.w) + h1.w;
            ((uint2*)dst)[d4] = make_uint2(pk2(o.x, o.y), pk2(o.z, o.w));
        }
    }
}
__device__ __forceinline__ void ph_filter(const P& p, float* lds) {
    const int tid = threadIdx.x, G = gridDim.x;
    const float* HID2 = (const float*)(p.ws + WS_HID2);
    float* HF = (float*)((unsigned char*)p.out + DO_HF);
    float* w3c = lds;
    float* red = lds + 128;
    const float min_decay = logf(1e-2f) / 1.5f, max_decay = logf(1e-2f) / 0.3f;
    __syncthreads();
    for (int item = blockIdx.x; item < 1024; item += G) {
        const int o = item >> 9, c = item & 511;
        if (tid < 128) { const int dir = tid >> 6, i = tid & 63; w3c[tid] = p.pos_w3[i * 2048 + o * 1024 + dir * 512 + c]; }
        __syncthreads();
        const float delta = fabsf(min_decay + (float)c * ((max_decay - min_decay) / 511.0f));
        float hv[4][2]; float asum = 0.f;
#pragma unroll
        for (int j = 0; j < 4; ++j) {
            const int t = tid + NT * j;
            float r0 = 0.f, r1 = 0.f;
            const float4* hp = (const float4*)(HID2 + t * 64);
#pragma unroll 4
            for (int i4 = 0; i4 < 16; ++i4) {
                const float4 h = hp[i4];
                r0 += h.x * w3c[i4 * 4 + 0] + h.y * w3c[i4 * 4 + 1] + h.z * w3c[i4 * 4 + 2] + h.w * w3c[i4 * 4 + 3];
                r1 += h.x * w3c[64 + i4 * 4 + 0] + h.y * w3c[64 + i4 * 4 + 1] + h.z * w3c[64 + i4 * 4 + 2] + h.w * w3c[64 + i4 * 4 + 3];
            }
            const float win = expf(-((float)t / 2047.0f) * delta) + 0.05f;
            hv[j][0] = r0 * win; hv[j][1] = r1 * win;
            asum += fabsf(hv[j][0]) + (t >= 1 ? fabsf(hv[j][1]) : 0.f);
        }
        asum = wave_sum(asum);
        if ((tid & 63) == 0) red[tid >> 6] = asum;
        __syncthreads();
        float tot = 0.f;
#pragma unroll
        for (int k = 0; k < 8; ++k) tot += red[k];
        const float inv = 1.f / (tot + EPS);
        float* dst = HF + (size_t)item * 4096;
#pragma unroll
        for (int j = 0; j < 4; ++j) {
            const int t = tid + NT * j;
            float v0 = hv[j][0] * inv;
            if (t == 0) v0 += p.hy_bias[o * 512 + c];
            dst[2047 + t] = v0;
            if (t >= 1) dst[2047 - t] = hv[j][1] * inv;
        }
        if (tid == 0) dst[4095] = 0.f;
        __syncthreads();
    }
}

struct InprojSched {
    int G, c; const bf16_t *WinT, *H, *HC; bf16_t *PHYT, *PHG, *PC;
    __device__ __forceinline__ bool next(int i, Unit& u) const {
        int L = i * G + c; int pm, pn;
        u.aux = nullptr; u.gidx = nullptr; u.row0 = 0; u.col0 = 0;
        if (L < 768) { tile_of(L, 6, 128, pm, pn); u.a = (const char*)(WinT + (size_t)pm * 256 * D); u.b = (const char*)(H + (size_t)pn * 256 * D); u.c = PHYT + (size_t)pm * 256 * NTOK + pn * 256; u.ldc = NTOK; return true; }
        L -= 768;
        if (L < 1280) { tile_of(L, 128, 10, pm, pn); u.a = (const char*)(H + (size_t)pm * 256 * D); u.b = (const char*)(WinT + (size_t)(1536 + pn * 256) * D); u.c = PHG + (size_t)pm * 256 * 2560 + pn * 256; u.ldc = 2560; return true; }
        L -= 1280;
        if (L < 96) { tile_of(L, 16, 6, pm, pn); u.a = (const char*)(HC + (size_t)pm * 256 * D); u.b = (const char*)(WinT + (size_t)(2048 + pn * 256) * D); u.c = PC + (size_t)pm * 256 * 1536 + pn * 256; u.ldc = 1536; return true; }
        return false;
    }
    __device__ __forceinline__ void a_ready(const Unit&) const {}
    __device__ __forceinline__ void done(const Unit&) const {}
};
__device__ __forceinline__ void ph_inproj(const P& p, unsigned char* lds) {
    InprojSched S{(int)gridDim.x, (int)blockIdx.x, (const bf16_t*)((unsigned char*)p.out + DO_WINT), (const bf16_t*)(p.ws + WS_H), (const bf16_t*)(p.ws + WS_HC),
                  (bf16_t*)((unsigned char*)p.out + DO_PHYT), (bf16_t*)(p.ws + WS_PHG), (bf16_t*)(p.ws + WS_PC)};
    pg8::EpiStoreBf16 E;
    pg8::gemm_phase<pg8::EpiStoreBf16, InprojSched, true, true, false>((PG8_LAS unsigned char*)lds, D, S, E);
}

__device__ __forceinline__ float shortconv_at(const P& p, const bf16_t* rowp, int t, int ch) {
    const int tt = t & 63;
    float v = p.hy_conv_b[ch] + p.hy_conv_w[1536 + ch] * bf2f(rowp[t]);
    if (tt > 0) v += p.hy_conv_w[ch] * bf2f(rowp[t - 1]);
    if (tt < 63) v += p.hy_conv_w[2 * 1536 + ch] * bf2f(rowp[t + 1]);
    return v;
}
template <int ORDER>
__device__ __forceinline__ void ph_longconv(const P& p, float* lds) {
    const int tid = threadIdx.x;
    bf16_t* PHYT = (bf16_t*)((unsigned char*)p.out + DO_PHYT);
    const float* HF = (const float*)((unsigned char*)p.out + DO_HF);
    float* vs = lds;
    float* hf = lds + 2048 * 8;
    for (int item = blockIdx.x; item < 1024; item += gridDim.x) {
        const int c = item >> 1, bh = item & 1;
        __syncthreads();
        for (int i = tid; i < 8 * 2048; i += NT) {
            const int bb = i >> 11, t = i & 2047, b = bh * 8 + bb;
            const bf16_t* rowp = PHYT + (size_t)c * NTOK + b * SEQ;
            vs[t * 8 + bb] = (ORDER == 0) ? shortconv_at(p, rowp, t, c) : bf2f(rowp[t]);
        }
        const float* hsrc = HF + (size_t)(ORDER * 512 + c) * 4096;
        for (int i = tid; i < 4096; i += NT) hf[1 + i] = hsrc[i];
        if (tid == 0) hf[0] = 0.f;
        __syncthreads();
        const int t0 = tid * 4;
        float acc[4][8];
#pragma unroll
        for (int j = 0; j < 4; ++j)
#pragma unroll
            for (int q = 0; q < 8; ++q) acc[j][q] = 0.f;
        const int base = t0 + 2047 + 1;
        float w0 = hf[base], w1 = hf[base + 1], w2 = hf[base + 2], w3 = hf[base + 3];
        for (int s = 0; s < SEQ; ++s) {
            const float4 va = *(const float4*)&vs[s * 8], vb = *(const float4*)&vs[s * 8 + 4];
            const float vv[8] = {va.x, va.y, va.z, va.w, vb.x, vb.y, vb.z, vb.w};
#pragma unroll
            for (int q = 0; q < 8; ++q) { acc[0][q] += w0 * vv[q]; acc[1][q] += w1 * vv[q]; acc[2][q] += w2 * vv[q]; acc[3][q] += w3 * vv[q]; }
            w3 = w2; w2 = w1; w1 = w0; w0 = hf[base - s - 1];
        }
        __syncthreads();
        const int gch = (ORDER == 0) ? (512 + c) : (1024 + c);
#pragma unroll
        for (int q = 0; q < 8; ++q) {
            const int b = bh * 8 + q;
            const bf16_t* grow = PHYT + (size_t)gch * NTOK + b * SEQ;
            float o[4];
#pragma unroll
            for (int j = 0; j < 4; ++j) o[j] = shortconv_at(p, grow, t0 + j, gch) * acc[j][q];
            *(uint2*)(PHYT + (size_t)c * NTOK + b * SEQ + t0) = make_uint2(pk2(o[0], o[1]), pk2(o[2], o[3]));
        }
    }
}
template <bool CTXMODE>
__device__ __forceinline__ void ph_scan(const P& p, float* lds) {
    const int tid = threadIdx.x;
    const float* LB = (const float*)(p.ws + WS_LB);
    float* SCTX = (float*)((unsigned char*)p.out + DO_SCTX);
    const bf16_t* SRC = CTXMODE ? (const bf16_t*)(p.ws + WS_PC) : (const bf16_t*)(p.ws + WS_PHG);
    bf16_t* OFB = (bf16_t*)(p.ws + WS_OFB);
    constexpr int T = CTXMODE ? CTXL : SEQ, LD = CTXMODE ? 1536 : 2560;
    constexpr int QOFF = 0, IOFF = CTXMODE ? 0 : 512, ZFOFF = CTXMODE ? 512 : 1024, ZBOFF = CTXMODE ? 1024 : 1536;
    constexpr int TC = 16;
    float* fL = lds, *kL = lds + TC * 128, *qL = lds + 2 * TC * 128, *vL = lds + 3 * TC * 128, *op = lds + 4 * TC * 128;
    const int v = tid & 127, kq = tid >> 7;
    for (int item = blockIdx.x; item < NB * HEADS * 2; item += gridDim.x) {
        const int dir = item & 1, h = (item >> 1) & 3, b = item >> 3;
        float S[32];
        float* sptr = SCTX + ((size_t)item * 128 + kq * 32) * 128 + v;
#pragma unroll
        for (int kk = 0; kk < 32; ++kk) S[kk] = CTXMODE ? 0.f : sptr[kk * 128];
        for (int t0 = 0; t0 < T; t0 += TC) {
            __syncthreads();
            for (int i = tid; i < TC * 128; i += NT) {
                const int st = i >> 7, k = i & 127;
                const int t = dir == 0 ? (t0 + st) : (T - 1 - (t0 + st));
                const bf16_t* row = SRC + ((size_t)b * T + t) * LD + h * 128 + k;
                const float z = bf2f(row[dir == 0 ? ZFOFF : ZBOFF]);
                const float lb = LB[dir * 512 + h * 128 + k];
                const float f = lb + (1.f - lb) * sigmoidf_(z);
                fL[i] = f; kL[i] = 1.f - f; vL[i] = bf2f(row[IOFF]);
                if (!CTXMODE) qL[i] = siluf_(bf2f(row[QOFF])) * 0.08838834764831845f;
            }
            __syncthreads();
            for (int st = 0; st < TC; ++st) {
                const float vv = vL[st * 128 + v];
                float o = 0.f;
#pragma unroll
                for (int k4 = 0; k4 < 8; ++k4) {
                    const float4 f4 = *(const float4*)&fL[st * 128 + kq * 32 + k4 * 4], k4v = *(const float4*)&kL[st * 128 + kq * 32 + k4 * 4];
                    S[k4 * 4 + 0] = f4.x * S[k4 * 4 + 0] + k4v.x * vv; S[k4 * 4 + 1] = f4.y * S[k4 * 4 + 1] + k4v.y * vv;
                    S[k4 * 4 + 2] = f4.z * S[k4 * 4 + 2] + k4v.z * vv; S[k4 * 4 + 3] = f4.w * S[k4 * 4 + 3] + k4v.w * vv;
                    if (!CTXMODE) {
                        const float4 q4 = *(const float4*)&qL[st * 128 + kq * 32 + k4 * 4];
                        o += S[k4 * 4 + 0] * q4.x + S[k4 * 4 + 1] * q4.y + S[k4 * 4 + 2] * q4.z + S[k4 * 4 + 3] * q4.w;
                    }
                }
                if (!CTXMODE) op[(st * 4 + kq) * 128 + v] = o;
            }
            if (!CTXMODE) {
                __syncthreads();
                for (int i = tid; i < TC * 128; i += NT) {
                    const int st = i >> 7, vv = i & 127;
                    const int t = dir == 0 ? (t0 + st) : (T - 1 - (t0 + st));
                    const float sum = op[(st * 4 + 0) * 128 + vv] + op[(st * 4 + 1) * 128 + vv] + op[(st * 4 + 2) * 128 + vv] + op[(st * 4 + 3) * 128 + vv];
                    OFB[(size_t)dir * NTOK * 512 + ((size_t)b * SEQ + t) * 512 + h * 128 + vv] = (bf16_t)f2bf(sum);
                }
            }
        }
        if (CTXMODE) {
#pragma unroll
            for (int kk = 0; kk < 32; ++kk) sptr[kk * 128] = S[kk];
        }
        __syncthreads();
    }
}

__device__ __forceinline__ void ph_mixprep(const P& p, float* lds) {
    const int tid = threadIdx.x, lane = tid & 63, wv = tid >> 6;
    const bf16_t* YT = (const bf16_t*)((unsigned char*)p.out + DO_PHYT);
    bf16_t* MIXA = (bf16_t*)(p.ws + WS_MIXA);
    bf16_t* yl = (bf16_t*)lds;
    float* part = lds + (512 * 72 * 2) / 4;
    for (int tile = blockIdx.x; tile < NTOK / 64; tile += gridDim.x) {
        const int tok0 = tile * 64;
        __syncthreads();
        for (int i = tid; i < 512 * 8; i += NT) { const int row = i >> 3, ch = i & 7; *(uint4*)(yl + row * 72 + ch * 8) = *(const uint4*)(YT + (size_t)row * NTOK + tok0 + ch * 8); }
        __syncthreads();
        const int tok = tid & 63, pt = tid >> 6;
        float ss = 0.f;
        for (int c = pt * 64; c < pt * 64 + 64; ++c) { const float v = bf2f(yl[c * 72 + tok]); ss += v * v; }
        part[pt * 64 + tok] = ss;
        __syncthreads();
        float tot = 0.f;
#pragma unroll
        for (int k = 0; k < 8; ++k) tot += part[k * 64 + tok];
        const float rstd = rsqrtf(tot * (1.f / 512.f) + EPS);
        bf16_t* dst = MIXA + (size_t)(tok0 + tok) * D + pt * 64;
#pragma unroll
        for (int j = 0; j < 8; ++j) {
            float o[8];
#pragma unroll
            for (int q = 0; q < 8; ++q) { const int c = pt * 64 + j * 8 + q; o[q] = bf2f(yl[c * 72 + tok]) * rstd * p.hy_norm_g[c]; }
            *(uint4*)(dst + j * 8) = make_uint4(pk2(o[0], o[1]), pk2(o[2], o[3]), pk2(o[4], o[5]), pk2(o[6], o[7]));
        }
    }
    const bf16_t* OFB = (const bf16_t*)(p.ws + WS_OFB);
    const bf16_t* PHG = (const bf16_t*)(p.ws + WS_PHG);
    for (int r = blockIdx.x * 8 + wv; r < NTOK; r += gridDim.x * 8) {
#pragma unroll
        for (int h = 0; h < HEADS; ++h) {
            const int k = lane * 2;
            const unsigned a = *(const unsigned*)(OFB + (size_t)r * 512 + h * 128 + k);
            const unsigned bq = *(const unsigned*)(OFB + (size_t)NTOK * 512 + (size_t)r * 512 + h * 128 + k);
            const float o0 = __uint_as_float(a << 16) + __uint_as_float(bq << 16), o1 = __uint_as_float(a & 0xffff0000u) + __uint_as_float(bq & 0xffff0000u);
            const float ss = wave_sum(o0 * o0 + o1 * o1);
            const float rstd = rsqrtf(ss * (1.f / 128.f) + EPS);
            const unsigned g = *(const unsigned*)(PHG + (size_t)r * 2560 + 2048 + h * 128 + k);
            const float2 ng = *(const float2*)(p.hg_norm_g + k);
            *(unsigned*)(MIXA + (size_t)r * D + 512 + h * 128 + k) = pk2(o0 * rstd * ng.x * siluf_(__uint_as_float(g << 16)), o1 * rstd * ng.y * siluf_(__uint_as_float(g & 0xffff0000u)));
        }
    }
}

struct OutprojSched {
    int G, c; const bf16_t *A, *Bt;
    __device__ __forceinline__ bool next(int i, Unit& u) const {
        const int L = i * G + c; if (L >= 512) return false; int pm, pn; tile_of(L, 128, 4, pm, pn);
        u.a = (const char*)(A + (size_t)pm * 256 * D); u.b = (const char*)(Bt + (size_t)pn * 256 * D); u.c = nullptr; u.aux = nullptr; u.gidx = nullptr; u.ldc = D; u.row0 = pm * 256; u.col0 = pn * 256; return true;
    }
    __device__ __forceinline__ void a_ready(const Unit&) const {}
    __device__ __forceinline__ void done(const Unit&) const {}
};
__device__ __forceinline__ void ph_outproj(const P& p, unsigned char* lds) {
    OutprojSched S{(int)gridDim.x, (int)blockIdx.x, (const bf16_t*)(p.ws + WS_MIXA), (const bf16_t*)(p.ws + WS_WOUTT)};
    pg8::EpiOutProj E{p.x, (const float*)(p.ws + WS_ADA), p.out};
    pg8::gemm_phase<pg8::EpiOutProj, OutprojSched, true, true, false>((PG8_LAS unsigned char*)lds, D, S, E);
}

__device__ __forceinline__ void ph_norm2_router(const P& p) {
    const int tid = threadIdx.x, lane = tid & 63, wv = tid >> 6;
    const float* ADA = (const float*)(p.ws + WS_ADA);
    const float* X1 = p.out;
    bf16_t* H2 = (bf16_t*)(p.ws + WS_H2);
    float* AFF = (float*)(p.ws + WS_AFF);
    for (int r = blockIdx.x * 8 + wv; r < NTOK; r += gridDim.x * 8) {
        const int b = r / SEQ, t = r % SEQ;
        const float4* src = (const float4*)(X1 + (size_t)r * D);
        float4 v[4]; float ss = 0.f;
#pragma unroll
        for (int j = 0; j < 4; ++j) { v[j] = src[lane + 64 * j]; ss += v[j].x * v[j].x + v[j].y * v[j].y + v[j].z * v[j].z + v[j].w * v[j].w; }
        ss = wave_sum(ss);
        const float rstd = rsqrtf(ss * (1.f / D) + EPS);
        const float* sh = ADA + b * 6144 + 3072, *sc = ADA + b * 6144 + 4096;
        float lg[16];
#pragma unroll
        for (int e = 0; e < 16; ++e) lg[e] = 0.f;
#pragma unroll
        for (int j = 0; j < 4; ++j) {
            const int d4 = lane + 64 * j;
            const float4 g = ((const float4*)p.norm2_g)[d4], s1 = ((const float4*)sc)[d4], h1 = ((const float4*)sh)[d4];
            float4 o;
            o.x = v[j].x * rstd * g.x * (1.f + s1.x) + h1.x; o.y = v[j].y * rstd * g.y * (1.f + s1.y) + h1.y;
            o.z = v[j].z * rstd * g.z * (1.f + s1.z) + h1.z; o.w = v[j].w * rstd * g.w * (1.f + s1.w) + h1.w;
            ((uint2*)(H2 + (size_t)r * D))[d4] = make_uint2(pk2(o.x, o.y), pk2(o.z, o.w));
            const float ov[4] = {o.x, o.y, o.z, o.w};
#pragma unroll
            for (int q = 0; q < 4; ++q) {
                const float4* rw = (const float4*)(p.router_w + (size_t)(d4 * 4 + q) * 16);
#pragma unroll
                for (int e4 = 0; e4 < 4; ++e4) {
                    const float4 w = rw[e4];
                    lg[e4 * 4 + 0] += ov[q] * w.x; lg[e4 * 4 + 1] += ov[q] * w.y; lg[e4 * 4 + 2] += ov[q] * w.z; lg[e4 * 4 + 3] += ov[q] * w.w;
                }
            }
        }
#pragma unroll
        for (int e = 0; e < 16; ++e) lg[e] = wave_sum(lg[e]);
        float mx = lg[0];
#pragma unroll
        for (int e = 1; e < 16; ++e) mx = fmaxf(mx, lg[e]);
        float den = 0.f;
#pragma unroll
        for (int e = 0; e < 16; ++e) { lg[e] = expf(lg[e] - mx); den += lg[e]; }
        const float inv = 1.f / den;
        if (lane < 16) {
            float val = 0.f;
#pragma unroll
            for (int e = 0; e < 16; ++e) val = (lane == e) ? lg[e] : val;
            AFF[((size_t)b * 16 + lane) * SEQ + t] = val * inv;
        }
    }
}

__device__ __forceinline__ void ph_topk(const P& p, float* lds) {
    const int tid = threadIdx.x;
    const float* AFF = (const float*)(p.ws + WS_AFF);
    int* IDX = (int*)(p.ws + WS_IDX);
    float* GATE = (float*)(p.ws + WS_GATE);
    int* INV = (int*)(p.ws + WS_INV);
    float* a = lds;
    int* sel = (int*)(lds + 2048);
    for (int item = blockIdx.x; item < NB * NE; item += gridDim.x) {
        const int b = item >> 4, e = item & 15;
        __syncthreads();
        for (int i = tid; i < SEQ; i += NT) a[i] = AFF[(size_t)item * SEQ + i];
        __syncthreads();
        float ai[4]; int rank[4];
#pragma unroll
        for (int j = 0; j < 4; ++j) { ai[j] = a[tid + NT * j]; rank[j] = 0; }
        for (int j2 = 0; j2 < SEQ; j2 += 4) {
            const float4 o4 = *(const float4*)&a[j2];
            const float ov[4] = {o4.x, o4.y, o4.z, o4.w};
#pragma unroll
            for (int q = 0; q < 4; ++q)
#pragma unroll
                for (int j = 0; j < 4; ++j) rank[j] += (ov[q] > ai[j] || (ov[q] == ai[j] && (j2 + q) < (tid + NT * j))) ? 1 : 0;
        }
#pragma unroll
        for (int j = 0; j < 4; ++j) {
            const int t = tid + NT * j;
            if (rank[j] < CAP) { IDX[item * CAP + rank[j]] = t; GATE[item * CAP + rank[j]] = ai[j]; sel[rank[j]] = t; }
            INV[((size_t)b * SEQ + t) * 16 + e] = rank[j] < CAP ? rank[j] : -1;
        }
    }
}

struct MoeUpSched {
    int G, c; const bf16_t *H2, *W13T; bf16_t* HMID; const int* IDX;
    __device__ __forceinline__ bool next(int i, Unit& u) const {
        if (i >= 16 || c >= 256) return false;
        const int item = c, b = item >> 4, e = item & 15, nt = i;
        u.a = (const char*)(H2 + (size_t)b * SEQ * D); u.b = (const char*)(W13T + ((size_t)e * 4096 + nt * 256) * D); u.c = HMID + (size_t)item * CAP * FF + nt * 128;
        u.aux = nullptr; u.gidx = IDX + item * CAP; u.ldc = FF; u.row0 = 0; u.col0 = 0; return true;
    }
    __device__ __forceinline__ void a_ready(const Unit&) const {}
    __device__ __forceinline__ void done(const Unit&) const {}
};
struct MoeDownSched {
    int G, c; const bf16_t *HMID, *W2T; bf16_t* YS; const float* GATE;
    __device__ __forceinline__ bool next(int i, Unit& u) const {
        if (i >= 4 || c >= 256) return false;
        const int item = c, e = item & 15, nt = i;
        u.a = (const char*)(HMID + (size_t)item * CAP * FF); u.b = (const char*)(W2T + ((size_t)e * 1024 + nt * 256) * FF); u.c = YS + (size_t)item * CAP * D + nt * 256;
        u.aux = GATE + item * CAP; u.gidx = nullptr; u.ldc = D; u.row0 = 0; u.col0 = 0; return true;
    }
    __device__ __forceinline__ void a_ready(const Unit&) const {}
    __device__ __forceinline__ void done(const Unit&) const {}
};
__device__ __forceinline__ void ph_moe_up(const P& p, unsigned char* lds) {
    MoeUpSched S{(int)gridDim.x, (int)blockIdx.x, (const bf16_t*)(p.ws + WS_H2), (const bf16_t*)(p.ws + WS_W13T), (bf16_t*)(p.ws + WS_HMID), (const int*)(p.ws + WS_IDX)};
    pg8::EpiSwiGLU E;
    pg8::gemm_phase<pg8::EpiSwiGLU, MoeUpSched, true, true, true>((PG8_LAS unsigned char*)lds, D, S, E);
}
__device__ __forceinline__ void ph_moe_down(const P& p, unsigned char* lds) {
    MoeDownSched S{(int)gridDim.x, (int)blockIdx.x, (const bf16_t*)(p.ws + WS_HMID), (const bf16_t*)(p.ws + WS_W2T), (bf16_t*)(p.ws + WS_YS), (const float*)(p.ws + WS_GATE)};
    pg8::EpiDown E;
    pg8::gemm_phase<pg8::EpiDown, MoeDownSched, true, true, false>((PG8_LAS unsigned char*)lds, FF, S, E);
}

__device__ __forceinline__ void ph_final(const P& p) {
    const int tid = threadIdx.x, lane = tid & 63, wv = tid >> 6;
    const float* ADA = (const float*)(p.ws + WS_ADA);
    const bf16_t* YS = (const bf16_t*)(p.ws + WS_YS);
    const int* INV = (const int*)(p.ws + WS_INV);
    float* X = p.out;
    for (int r = blockIdx.x * 8 + wv; r < NTOK; r += gridDim.x * 8) {
        const int b = r / SEQ;
        const float* g2 = ADA + b * 6144 + 5120;
        float4 acc[4];
#pragma unroll
        for (int j = 0; j < 4; ++j) acc[j] = make_float4(0.f, 0.f, 0.f, 0.f);
        const int myinv = INV[(size_t)r * 16 + (lane & 15)];
#pragma unroll
        for (int e = 0; e < 16; ++e) {
            const int slot = __shfl(myinv, e);
            if (slot >= 0) {
                const uint2* yr = (const uint2*)(YS + ((size_t)(b * 16 + e) * CAP + slot) * D);
#pragma unroll
                for (int j = 0; j < 4; ++j) { const uint2 w = yr[lane + 64 * j];
                    acc[j].x += __uint_as_float(w.x << 16); acc[j].y += __uint_as_float(w.x & 0xffff0000u); acc[j].z += __uint_as_float(w.y << 16); acc[j].w += __uint_as_float(w.y & 0xffff0000u); }
            }
        }
        float4 v[4]; float ss = 0.f;
#pragma unroll
        for (int j = 0; j < 4; ++j) {
            const int d4 = lane + 64 * j;
            const float4 xv = ((const float4*)(X + (size_t)r * D))[d4], g = ((const float4*)g2)[d4];
            v[j] = make_float4(xv.x + g.x * acc[j].x, xv.y + g.y * acc[j].y, xv.z + g.z * acc[j].z, xv.w + g.w * acc[j].w);
            ss += v[j].x * v[j].x + v[j].y * v[j].y + v[j].z * v[j].z + v[j].w * v[j].w;
        }
        ss = wave_sum(ss);
        const float rstd = rsqrtf(ss * (1.f / D) + EPS);
#pragma unroll
        for (int j = 0; j < 4; ++j) {
            const int d4 = lane + 64 * j;
            const float4 g = ((const float4*)p.final_g)[d4];
            ((float4*)(X + (size_t)r * D))[d4] = make_float4(v[j].x * rstd * g.x, v[j].y * rstd * g.y, v[j].z * rstd * g.z, v[j].w * rstd * g.w);
        }
    }
}

constexpr int N_PHASES = 12;
template <int PH>
__device__ __forceinline__ void run_phase(const P& p, unsigned char* ldsb) {
    float* lds = (float*)ldsb;
    if constexpr (PH == 0) { ph_prep(p, lds); ph_convert(p, lds); }
    else if constexpr (PH == 1) { ph_norm1(p); ph_filter(p, lds); }
    else if constexpr (PH == 2) ph_inproj(p, ldsb);
    else if constexpr (PH == 3) { ph_longconv<0>(p, lds); ph_scan<true>(p, lds); }
    else if constexpr (PH == 4) { ph_longconv<1>(p, lds); ph_scan<false>(p, lds); }
    else if constexpr (PH == 5) ph_mixprep(p, lds);
    else if constexpr (PH == 6) ph_outproj(p, ldsb);
    else if constexpr (PH == 7) ph_norm2_router(p);
    else if constexpr (PH == 8) ph_topk(p, lds);
    else if constexpr (PH == 9) ph_moe_up(p, ldsb);
    else if constexpr (PH == 10) ph_moe_down(p, ldsb);
    else if constexpr (PH == 11) ph_final(p);
}
template <int PH>
__device__ __forceinline__ void run_from(const P& p, unsigned char* lds, cg::grid_group& grid) {
    if constexpr (PH < N_PHASES) {
        if (PH >= p.ph_lo && PH < p.ph_hi) {
            run_phase<PH>(p, lds);
            if (PH + 1 < p.ph_hi) { __syncthreads(); grid.sync(); }
        }
        run_from<PH + 1>(p, lds, grid);
    }
}
__global__ void __launch_bounds__(NT, 2) fwd_all(P p) {
    extern __shared__ __attribute__((aligned(16))) unsigned char lds_raw[];
    cg::grid_group grid = cg::this_grid();
    run_from<0>(p, lds_raw, grid);
}

extern "C" void kernel_launch(void* const* d_in, const int* in_sizes, int n_in, void* d_out, int out_size, void* d_ws, size_t ws_size, hipStream_t stream) {
    static int grid = 0;
    if (grid == 0) {
        int dev = 0, cus = 0, per_cu = 0;
        (void)hipGetDevice(&dev);
        (void)hipDeviceGetAttribute(&cus, hipDeviceAttributeMultiprocessorCount, dev);
        (void)hipFuncSetAttribute((const void*)fwd_all, hipFuncAttributeMaxDynamicSharedMemorySize, LDS_BYTES);
        (void)hipOccupancyMaxActiveBlocksPerMultiprocessor(&per_cu, (const void*)fwd_all, NT, LDS_BYTES);
        if (per_cu < 1) fprintf(stderr, "kernel_launch: occupancy query says %d blocks/CU\n", per_cu);
        grid = (cus > 0 ? cus : 256);
        if (ws_size < WS_END) fprintf(stderr, "kernel_launch: workspace too small: %zu < %zu\n", ws_size, (size_t)WS_END);
    }
    P p{};
    const float** f = (const float**)&p;
    for (int i = 0; i < 28; ++i) f[i] = (const float*)d_in[i];
    p.out = (float*)d_out;
    p.ws = (unsigned char*)d_ws;
    p.ph_lo = 0; p.ph_hi = N_PHASES;
    void* args[] = {&p};
    hipError_t e = hipLaunchCooperativeKernel((const void*)fwd_all, dim3(grid), dim3(NT), args, LDS_BYTES, stream);
    if (e != hipSuccess) fprintf(stderr, "cooperative launch failed: %s (grid %d)\n", hipGetErrorString(e), grid);
}
```

```cpp
#include <hip/hip_runtime.h>
#include <hip/hip_cooperative_groups.h>
#include <cstdio>
#include <cstdint>
namespace cg = cooperative_groups;

constexpr int D = 1024, NB = 16, SEQ = 2048, CTXL = 256;
constexpr int NTOK = NB * SEQ;
constexpr int NCTX = NB * CTXL;
constexpr int HEADS = 4;
constexpr int INC = 4096;
constexpr int NE = 16, CAP = 256, FF = 2048;
constexpr int NT = 512;
constexpr int LDS_BYTES = 147456;
constexpr float EPS = 1e-6f;
typedef unsigned short bf16_t;

constexpr size_t MiB = 1u << 20;
constexpr size_t WS_CTL = 0;
constexpr size_t WS_ADA = 1 * MiB;
constexpr size_t WS_LB = WS_ADA + 512 * 1024;
constexpr size_t WS_HID2 = 2 * MiB;
constexpr size_t WS_AFF = 3 * MiB;
constexpr size_t WS_IDX = 5 * MiB;
constexpr size_t WS_GATE = 5 * MiB + 512 * 1024;
constexpr size_t WS_INV = 6 * MiB;
constexpr size_t WS_W13T = 8 * MiB;
constexpr size_t WS_YS = WS_W13T;
constexpr size_t WS_W2T = 136 * MiB;
constexpr size_t WS_R = 200 * MiB;
constexpr size_t WS_H = WS_R;
constexpr size_t WS_MIXA = WS_R;
constexpr size_t WS_HC = WS_R + 64 * MiB;
constexpr size_t WS_PC = WS_R + 72 * MiB;
constexpr size_t WS_OFB = WS_R + 84 * MiB;
constexpr size_t WS_WOUTT = WS_R + 148 * MiB;
constexpr size_t WS_PHG = WS_R + 152 * MiB;
constexpr size_t WS_HMID = WS_R;
constexpr size_t WS_H2 = WS_R + 256 * MiB;
constexpr size_t WS_END = WS_R + 320 * MiB;
constexpr size_t DO_PHYT = 0;
constexpr size_t DO_HF = 96 * MiB;
constexpr size_t DO_SCTX = 112 * MiB;
constexpr size_t DO_WINT = 120 * MiB;

struct P {
    const float *x, *c, *ctx, *c_ctx, *ada_w, *ada_b, *norm1_g, *w_in, *hy_conv_w, *hy_conv_b, *pos_w1, *pos_b1, *freq1, *pos_w2, *pos_b2,
        *freq2, *pos_w3, *hy_bias, *hy_norm_g, *hg_lb, *hg_norm_g, *w_out, *norm2_g, *router_w, *exp_w1, *exp_w3, *exp_w2, *final_g;
    float* out;
    unsigned char* ws;
    int ph_lo, ph_hi;
};

__device__ __forceinline__ float wave_sum(float v) {
#pragma unroll
    for (int o = 1; o < 64; o <<= 1) v += __shfl_xor(v, o);
    return v;
}
__device__ __forceinline__ float sigmoidf_(float z) { return 1.f / (1.f + expf(-z)); }
__device__ __forceinline__ float siluf_(float z) { return z / (1.f + expf(-z)); }
__device__ __forceinline__ float bf2f(bf16_t h) { return __uint_as_float((unsigned)h << 16); }
__device__ __forceinline__ unsigned f2bf(float f) { unsigned u = __float_as_uint(f); return (u + 0x7fffu + ((u >> 16) & 1u)) >> 16; }
__device__ __forceinline__ unsigned pk2(float lo, float hi) { return f2bf(lo) | (f2bf(hi) << 16); }

namespace pg8 {
#define PG8_LAS __attribute__((address_space(3)))
typedef unsigned short bf16_t;
typedef short bf16x8 __attribute__((ext_vector_type(8)));
typedef float f32x4 __attribute__((ext_vector_type(4)));
typedef unsigned u32x4 __attribute__((ext_vector_type(4)));
constexpr int BM = 256, BK = 64, HALF = 128, HTB = HALF * BK * 2  , STAGE_BYTES = 8 * HTB, NXCD = 8, WGM = 8;

__host__ __device__ __forceinline__ int lds_byte(int r, int c) { const int st = (r >> 4) * 2 + (c >> 5), rr = r & 15, cc = c & 31, ob = rr * 64 + cc * 2; return st * 1024 + (ob ^ (((ob >> 9) & 1) << 5)); }
__host__ __device__ __forceinline__ void stage_rc(int b, int& R, int& C) { const int st = b / 1024, sb = b % 1024, swz = sb ^ (((sb >> 9) & 1) << 5); R = (st >> 1) * 16 + swz / 64; C = (st & 1) * 32 + (swz % 64) / 2; }
__host__ __device__ __forceinline__ int perm32(int rho) { const int n = rho >> 4, i = rho & 15; return 8 * (i >> 2) + 4 * n + (i & 3); }

struct Unit { const char* a; const char* b; bf16_t* c; const float* aux; const int* gidx; int ldc, row0, col0; };
__device__ __forceinline__ unsigned cvt_pk_bf16(float lo, float hi) { unsigned r; asm volatile("v_cvt_pk_bf16_f32 %0, %1, %2" : "=v"(r) : "v"(lo), "v"(hi)); return r; }

__device__ __forceinline__ void tile_of(int L, int nM, int nN, int& pm, int& pn) {
    const int nwg = nM * nN; int wgid = L;
    { const int q = nwg / NXCD, r = nwg % NXCD, xcd = wgid % NXCD, off = wgid / NXCD; wgid = (xcd < r ? xcd * (q + 1) : r * (q + 1) + (xcd - r) * q) + off; }
    const int nig = WGM * nN, gid = wgid / nig, fm = gid * WGM, gsz = (nM - fm) < WGM ? (nM - fm) : WGM;
    pm = fm + ((wgid % nig) % gsz); pn = (wgid % nig) / gsz;
}

struct EpiStoreBf16 {
    static constexpr bool PERM = true, AFTER_DRAIN = false;
    __device__ __forceinline__ void operator()(const f32x4 (&acc)[2][2][4][2], const Unit& u, int wr, int wc, int fr, int fq) const {
        bf16_t* base = u.c + (size_t)(wr * 64 + fr) * u.ldc + wc * 32 + 8 * fq;
#pragma unroll
        for (int ai = 0; ai < 2; ++ai)
#pragma unroll
            for (int m = 0; m < 4; ++m) { bf16_t* rowp = base + (size_t)(ai * HALF + m * 16) * u.ldc;
#pragma unroll
                for (int bj = 0; bj < 2; ++bj) { const f32x4 v0 = acc[ai][bj][m][0], v1 = acc[ai][bj][m][1];
                    u32x4 w; w.x = cvt_pk_bf16(v0[0], v0[1]); w.y = cvt_pk_bf16(v0[2], v0[3]); w.z = cvt_pk_bf16(v1[0], v1[1]); w.w = cvt_pk_bf16(v1[2], v1[3]);
                    *(u32x4*)(rowp + bj * HALF) = w; } }
    }
};
struct EpiOutProj {
    static constexpr bool PERM = false, AFTER_DRAIN = false;
    const float* x; const float* ada; float* x1;
    __device__ __forceinline__ void operator()(const f32x4 (&acc)[2][2][4][2], const Unit& u, int wr, int wc, int fr, int fq) const {
        const float* g1 = ada + (u.row0 >> 11) * 6144 + 2048;
#pragma unroll
        for (int bj = 0; bj < 2; ++bj)
#pragma unroll
            for (int n = 0; n < 2; ++n) { const int col = u.col0 + bj * HALF + wc * 32 + n * 16 + 4 * fq; const f32x4 g = *(const f32x4*)(g1 + col);
#pragma unroll
                for (int ai = 0; ai < 2; ++ai)
#pragma unroll
                    for (int m = 0; m < 4; ++m) { const size_t off = (size_t)(u.row0 + ai * HALF + wr * 64 + m * 16 + fr) * D + col;
                        const f32x4 xv = *(const f32x4*)(x + off); *(f32x4*)(x1 + off) = xv + g * acc[ai][bj][m][n]; } }
    }
};
__device__ __forceinline__ float silu_fast(float a) { return a * __builtin_amdgcn_rcpf(1.0f + __builtin_amdgcn_exp2f(-1.4426950408889634f * a)); }
struct EpiSwiGLU {
    static constexpr bool PERM = true, AFTER_DRAIN = false;
    __device__ __forceinline__ void operator()(const f32x4 (&acc)[2][2][4][2], const Unit& u, int wr, int wc, int fr, int fq) const {
        bf16_t* base = u.c + (size_t)(wr * 64 + fr) * FF + wc * 32 + 8 * fq;
#pragma unroll
        for (int ai = 0; ai < 2; ++ai)
#pragma unroll
            for (int m = 0; m < 4; ++m) { const f32x4 a0 = acc[ai][0][m][0], a1 = acc[ai][0][m][1], b0 = acc[ai][1][m][0], b1 = acc[ai][1][m][1];
                u32x4 w; w.x = cvt_pk_bf16(silu_fast(a0[0]) * b0[0], silu_fast(a0[1]) * b0[1]); w.y = cvt_pk_bf16(silu_fast(a0[2]) * b0[2], silu_fast(a0[3]) * b0[3]);
                w.z = cvt_pk_bf16(silu_fast(a1[0]) * b1[0], silu_fast(a1[1]) * b1[1]); w.w = cvt_pk_bf16(silu_fast(a1[2]) * b1[2], silu_fast(a1[3]) * b1[3]);
                *(u32x4*)(base + (size_t)(ai * HALF + m * 16) * FF) = w; }
    }
};
struct EpiDown {
    static constexpr bool PERM = true, AFTER_DRAIN = false;
    __device__ __forceinline__ void operator()(const f32x4 (&acc)[2][2][4][2], const Unit& u, int wr, int wc, int fr, int fq) const {
        bf16_t* base = u.c + (size_t)(wr * 64 + fr) * D + wc * 32 + 8 * fq;
#pragma unroll
        for (int ai = 0; ai < 2; ++ai)
#pragma unroll
            for (int m = 0; m < 4; ++m) { const float gt = u.aux[ai * HALF + wr * 64 + m * 16 + fr]; bf16_t* rowp = base + (size_t)(ai * HALF + m * 16) * D;
#pragma unroll
                for (int bj = 0; bj < 2; ++bj) { const f32x4 v0 = acc[ai][bj][m][0] * gt, v1 = acc[ai][bj][m][1] * gt;
                    u32x4 w; w.x = cvt_pk_bf16(v0[0], v0[1]); w.y = cvt_pk_bf16(v0[2], v0[3]); w.z = cvt_pk_bf16(v1[0], v1[1]); w.w = cvt_pk_bf16(v1[2], v1[3]);
                    *(u32x4*)(rowp + bj * HALF) = w; } }
    }
};

template <class Epi, class Sched, bool ALIGN_EPI = false, bool SP2 = false, bool GATHER = false>
__device__ __forceinline__ void gemm_phase(PG8_LAS unsigned char* lds, const int K, const Sched& S, const Epi& E) {
    const int tid = threadIdx.x, wid = __builtin_amdgcn_readfirstlane(tid >> 6), lane = tid & 63, wr = wid >> 2, wc = wid & 3, fr = lane & 15, fq = lane >> 4;
    const int nt = K / BK;
    unsigned voffA[2], voffB[2];
#pragma unroll
    for (int i = 0; i < 2; ++i) { int R, C; stage_rc(tid * 16 + i * 8192, R, C); const int Rb = Epi::PERM ? ((R & ~31) + perm32(R & 31)) : R;
        voffA[i] = (unsigned)(R * K + C) * 2u; voffB[i] = (unsigned)(Rb * K + C) * 2u; }
    const size_t kstep = (size_t)(BK * 2);
    const size_t hstep = (size_t)HALF * K * 2;
    const unsigned ldsw = (unsigned)wid * 1024u;
    const int aoff = lds_byte(wr * 64 + fr, fq * 8), boff = lds_byte(wc * 32 + fr, fq * 8);
#define PG8_SA(b, h) (((b) * 2 + (h)) * HTB)
#define PG8_SB(b, h) ((4 + (b) * 2 + (h)) * HTB)
#define PG8_STAGE(bufoff, gbase, voff) do { _Pragma("unroll") for (int _i = 0; _i < 2; ++_i) \
        __builtin_amdgcn_global_load_lds((const unsigned*)((const char*)(gbase) + (voff)[_i]), (PG8_LAS unsigned*)(lds + (bufoff) + ldsw + _i * 8192), 16, 0, 0); } while (0)
#define PG8_STAGE_A(bufoff, gbase, h) do { _Pragma("unroll") for (int _i = 0; _i < 2; ++_i) \
        __builtin_amdgcn_global_load_lds((const unsigned*)((const char*)(gbase) + voffAh[h][_i]), (PG8_LAS unsigned*)(lds + (bufoff) + ldsw + _i * 8192), 16, 0, 0); } while (0)
#define PG8_LDA(dst, b, h) do { _Pragma("unroll") for (int m = 0; m < 4; ++m) _Pragma("unroll") for (int k = 0; k < 2; ++k) dst[m][k] = *(const PG8_LAS bf16x8*)(lds + PG8_SA(b, h) + aoff + m * 2048 + k * 1024); } while (0)
#define PG8_LDB(dst, b, h) do { _Pragma("unroll") for (int n = 0; n < 2; ++n) _Pragma("unroll") for (int k = 0; k < 2; ++k) dst[n][k] = *(const PG8_LAS bf16x8*)(lds + PG8_SB(b, h) + boff + n * 2048 + k * 1024); } while (0)
#define PG8_MMA(ai, bj, At, Bt) do { __builtin_amdgcn_s_setprio(1); _Pragma("unroll") for (int m = 0; m < 4; ++m) _Pragma("unroll") for (int n = 0; n < 2; ++n) _Pragma("unroll") for (int k = 0; k < 2; ++k) \
        acc[ai][bj][m][n] = __builtin_amdgcn_mfma_f32_16x16x32_bf16(Bt[n][k], At[m][k], acc[ai][bj][m][n], 0, 0, 0); __builtin_amdgcn_s_setprio(0); } while (0)
#define PG8_WAIT_V(n) asm volatile("s_waitcnt vmcnt(" #n ")" ::: "memory")
#define PG8_WAIT_L(n) asm volatile("s_waitcnt lgkmcnt(" #n ")" ::: "memory")
#define PG8_BAR __builtin_amdgcn_s_barrier()
#define PG8_SCHED __builtin_amdgcn_sched_barrier(0)
    Unit cur, nxt; int ui = 0;
    if (!S.next(0, cur)) return;
    unsigned voffAh[2][2];
#pragma unroll
    for (int h = 0; h < 2; ++h)
#pragma unroll
        for (int i = 0; i < 2; ++i) {
            if constexpr (GATHER) { int R, C; stage_rc(tid * 16 + i * 8192, R, C); voffAh[h][i] = ((unsigned)cur.gidx[h * HALF + R] * (unsigned)K + (unsigned)C) * 2u; }
            else voffAh[h][i] = voffA[i] + (unsigned)h * (unsigned)hstep;
        }
    f32x4 acc[2][2][4][2];
#pragma unroll
    for (int a = 0; a < 2; ++a)
#pragma unroll
        for (int b = 0; b < 2; ++b)
#pragma unroll
            for (int m = 0; m < 4; ++m)
#pragma unroll
                for (int n = 0; n < 2; ++n) acc[a][b][m][n] = (f32x4){0.f, 0.f, 0.f, 0.f};
    bf16x8 At[4][2], B0[2][2], B1[2][2];
    const char* cA = cur.a; const char* cB = cur.b;
    S.a_ready(cur);
    if constexpr (SP2) {
        PG8_STAGE(PG8_SB(0, 0), cB, voffB); PG8_STAGE(PG8_SB(0, 1), cB + hstep, voffB); PG8_STAGE_A(PG8_SA(0, 0), cA, 0); PG8_STAGE_A(PG8_SA(0, 1), cA, 1);
        if (wr == 1) PG8_BAR;
        PG8_WAIT_V(2); PG8_BAR;
        PG8_STAGE(PG8_SB(1, 0), cB + kstep, voffB); PG8_STAGE_A(PG8_SA(1, 0), cA + kstep, 0); PG8_STAGE(PG8_SB(1, 1), cB + hstep + kstep, voffB);
        PG8_WAIT_V(6); PG8_BAR;
    } else {
        PG8_STAGE(PG8_SB(0, 0), cB, voffB); PG8_STAGE_A(PG8_SA(0, 0), cA, 0); PG8_STAGE(PG8_SB(0, 1), cB + hstep, voffB); PG8_STAGE_A(PG8_SA(0, 1), cA, 1);
        if (wr == 1) PG8_BAR;
        PG8_WAIT_V(4); PG8_BAR;
        PG8_STAGE(PG8_SB(1, 0), cB + kstep, voffB); PG8_STAGE_A(PG8_SA(1, 0), cA + kstep, 0); PG8_STAGE(PG8_SB(1, 1), cB + hstep + kstep, voffB);
        PG8_WAIT_V(6); PG8_BAR;
    }
    for (;;) {
        const bool has_next = S.next(ui + 1, nxt);
        const char* nA = has_next ? nxt.a : cA; const char* nB = has_next ? nxt.b : cB;
        for (int t = 0; t < nt; t += 2) {
            const bool last = (t == nt - 2);
            const char* a1 = cA + (size_t)(t + 1) * kstep;
            const char* a2 = last ? nA : cA + (size_t)(t + 2) * kstep; const char* b2 = last ? nB : cB + (size_t)(t + 2) * kstep;
            const char* a3 = a2 + kstep; const char* b3 = b2 + kstep;
            if (last && has_next) S.a_ready(nxt);
            if constexpr (SP2) {
            PG8_LDB(B0, 0, 0); PG8_LDB(B1, 0, 1); PG8_SCHED; PG8_LDA(At, 0, 0); PG8_STAGE_A(PG8_SA(1, 1), a1, 1);
            PG8_WAIT_V(8); PG8_WAIT_L(0); PG8_BAR; PG8_MMA(0, 0, At, B0); PG8_MMA(0, 1, At, B1); PG8_BAR; PG8_SCHED;
            PG8_LDA(At, 0, 1); PG8_STAGE(PG8_SB(0, 0), b2, voffB); PG8_STAGE(PG8_SB(0, 1), b2 + hstep, voffB); PG8_STAGE_A(PG8_SA(0, 0), a2, 0);
            PG8_WAIT_V(8); PG8_WAIT_L(0); PG8_BAR; PG8_MMA(1, 0, At, B0); PG8_MMA(1, 1, At, B1); PG8_BAR; PG8_SCHED;
            PG8_LDB(B0, 1, 0); PG8_LDB(B1, 1, 1); PG8_SCHED; PG8_LDA(At, 1, 0); PG8_STAGE_A(PG8_SA(0, 1), a2, 1);
            PG8_WAIT_V(8); PG8_WAIT_L(0); PG8_BAR; PG8_MMA(0, 0, At, B0); PG8_MMA(0, 1, At, B1); PG8_BAR; PG8_SCHED;
            PG8_LDA(At, 1, 1); PG8_STAGE(PG8_SB(1, 0), b3, voffB); PG8_STAGE(PG8_SB(1, 1), b3 + hstep, voffB); PG8_STAGE_A(PG8_SA(1, 0), a3, 0);
            PG8_WAIT_V(8); PG8_WAIT_L(0); PG8_BAR; PG8_MMA(1, 0, At, B0); PG8_MMA(1, 1, At, B1); PG8_BAR; PG8_SCHED;
            } else {
            PG8_LDB(B0, 0, 0); PG8_SCHED; PG8_LDA(At, 0, 0); PG8_STAGE_A(PG8_SA(1, 1), a1, 1);
            PG8_WAIT_L(8); PG8_BAR; PG8_WAIT_L(0); PG8_MMA(0, 0, At, B0); PG8_BAR; PG8_SCHED;
            PG8_LDB(B1, 0, 1); PG8_STAGE(PG8_SB(0, 0), b2, voffB);
            PG8_BAR; PG8_WAIT_L(0); PG8_MMA(0, 1, At, B1); PG8_BAR;
            PG8_LDA(At, 0, 1); PG8_STAGE_A(PG8_SA(0, 0), a2, 0);
            PG8_BAR; PG8_WAIT_L(0); PG8_MMA(1, 0, At, B0); PG8_BAR; PG8_SCHED;
            PG8_STAGE(PG8_SB(0, 1), b2 + hstep, voffB);
            PG8_WAIT_V(6); PG8_BAR; PG8_MMA(1, 1, At, B1); PG8_BAR;
            PG8_LDB(B0, 1, 0); PG8_SCHED; PG8_LDA(At, 1, 0); PG8_STAGE_A(PG8_SA(0, 1), a2, 1);
            PG8_WAIT_L(8); PG8_BAR; PG8_WAIT_L(0); PG8_MMA(0, 0, At, B0); PG8_BAR; PG8_SCHED;
            PG8_LDB(B1, 1, 1); PG8_STAGE(PG8_SB(1, 0), b3, voffB);
            PG8_BAR; PG8_WAIT_L(0); PG8_MMA(0, 1, At, B1); PG8_BAR;
            PG8_LDA(At, 1, 1); PG8_STAGE_A(PG8_SA(1, 0), a3, 0);
            PG8_BAR; PG8_WAIT_L(0); PG8_MMA(1, 0, At, B0); PG8_BAR; PG8_SCHED;
            PG8_STAGE(PG8_SB(1, 1), b3 + hstep, voffB);
            PG8_WAIT_V(6); PG8_BAR; PG8_MMA(1, 1, At, B1); PG8_BAR;
            }
        }
        if constexpr (ALIGN_EPI) { if (wr == 0) PG8_BAR; }
        if constexpr (!Epi::AFTER_DRAIN) { E(acc, cur, wr, wc, fr, fq); S.done(cur); }
        if (!has_next) break;
#pragma unroll
        for (int a = 0; a < 2; ++a)
#pragma unroll
            for (int b = 0; b < 2; ++b)
#pragma unroll
                for (int m = 0; m < 4; ++m)
#pragma unroll
                    for (int n = 0; n < 2; ++n) acc[a][b][m][n] = (f32x4){0.f, 0.f, 0.f, 0.f};
        cur = nxt; cA = nA; cB = nB; ++ui;
        if constexpr (ALIGN_EPI) { if (wr == 1) PG8_BAR; }
    }
    PG8_WAIT_V(0);
    if constexpr (!ALIGN_EPI) { if (wr == 0) PG8_BAR; }
    PG8_BAR;
    if constexpr (Epi::AFTER_DRAIN) { E.fused(acc, cur, wr, wc, fr, fq, lds, wid, lane); S.done(cur); }
#undef PG8_SA
#undef PG8_SB
#undef PG8_STAGE
#undef PG8_LDA
#undef PG8_LDB
#undef PG8_MMA
#undef PG8_WAIT_V
#undef PG8_WAIT_L
#undef PG8_BAR
#undef PG8_SCHED
}
}
using pg8::Unit; using pg8::tile_of;

__device__ __forceinline__ void ph_prep(const P& p, float* lds) {
    const int tid = threadIdx.x, G = gridDim.x;
    float* ADA = (float*)(p.ws + WS_ADA);
    float* LB = (float*)(p.ws + WS_LB);
    float* HID2 = (float*)(p.ws + WS_HID2);
    {
        float* s = lds;
        float* red = lds + 17 * 1024;
        if (blockIdx.x < 96) {
            for (int i = tid; i < 17 * 1024; i += NT) {
                const int r = i >> 10, d = i & 1023;
                const float cv = r < 16 ? p.c[r * 1024 + d] : p.c_ctx[d];
                s[i] = siluf_(cv);
            }
        }
        __syncthreads();
        for (int item = blockIdx.x; item < 96; item += G) {
            const int jj = tid & 63, ks = tid >> 6, j = item * 64 + jj;
            float acc[17];
#pragma unroll
            for (int r = 0; r < 17; ++r) acc[r] = 0.f;
#pragma unroll 4
            for (int d = ks * 128; d < ks * 128 + 128; ++d) {
                const float w = p.ada_w[(size_t)d * 6144 + j];
#pragma unroll
                for (int r = 0; r < 17; ++r) acc[r] += s[r * 1024 + d] * w;
            }
#pragma unroll
            for (int r = 0; r < 17; ++r) red[(ks * 17 + r) * 64 + jj] = acc[r];
            __syncthreads();
            for (int i = tid; i < 17 * 64; i += NT) {
                const int r = i >> 6, j2 = i & 63;
                float sum = 0.f;
#pragma unroll
                for (int k = 0; k < 8; ++k) sum += red[(k * 17 + r) * 64 + j2];
                ADA[r * 6144 + item * 64 + j2] = sum + p.ada_b[item * 64 + j2];
            }
            __syncthreads();
        }
    }
    if (blockIdx.x == G - 1) {
        for (int i = tid; i < 1024; i += NT) {
            const float a0 = p.hg_lb[i], a1 = p.hg_lb[1024 + i];
            LB[i] = 1.f / (1.f + expf(a1 - a0));
        }
    }
    {
        float* zl = lds;
        float* h1 = lds + 512;
        __syncthreads();
        for (int it = (G - 1 - blockIdx.x); it < SEQ / 8; it += G) {
            const int lt = tid >> 6, j = tid & 63, t = it * 8 + lt;
            const float w = 6.283185307179586f * (float)t / 2048.0f;
            if (j == 0) zl[lt * 64] = (float)t / 2047.0f;
            if (j >= 1 && j < 17) { const float f = 1e-4f + (float)(j - 1) * ((15.0f - 1e-4f) / 15.0f); zl[lt * 64 + j] = cosf(f * w); }
            if (j >= 17 && j < 33) { const float f = 1e-4f + (float)(j - 17) * ((15.0f - 1e-4f) / 15.0f); zl[lt * 64 + j] = -sinf(f * w); }
            __syncthreads();
            float a = p.pos_b1[j];
            for (int i = 0; i < 33; ++i) a += zl[lt * 64 + i] * p.pos_w1[i * 64 + j];
            h1[lt * 64 + j] = sinf(p.freq1[j] * a);
            __syncthreads();
            float b = p.pos_b2[j];
            for (int i = 0; i < 64; ++i) b += h1[lt * 64 + i] * p.pos_w2[i * 64 + j];
            HID2[t * 64 + j] = sinf(p.freq2[j] * b);
            __syncthreads();
        }
    }
}
__device__ __forceinline__ void conv_item(const float* W, int N, int k0, int n0, bf16_t* dst, int KD, float* scr, int lane) {
#pragma unroll 8
    for (int i = 0; i < 32; ++i) { const int kk = 2 * i + (lane >> 5); scr[kk * 33 + (lane & 31)] = W[(size_t)(k0 + kk) * N + n0 + (lane & 31)]; }
    asm volatile("s_waitcnt lgkmcnt(0)" ::: "memory");
    const int c = lane & 7;
#pragma unroll
    for (int j = 0; j < 4; ++j) { const int n = (lane >> 3) + 8 * j; const float* s = scr + (8 * c) * 33 + n;
        uint4 o; o.x = pk2(s[0 * 33], s[1 * 33]); o.y = pk2(s[2 * 33], s[3 * 33]); o.z = pk2(s[4 * 33], s[5 * 33]); o.w = pk2(s[6 * 33], s[7 * 33]);
        *(uint4*)(dst + (size_t)n * KD + k0 + 8 * c) = o; }
    asm volatile("s_waitcnt lgkmcnt(0)" ::: "memory");
}
__device__ __forceinline__ void ph_convert(const P& p, float* lds) {
    const int tid = threadIdx.x, lane = tid & 63, wv = tid >> 6;
    float* scr = lds + wv * (64 * 33);
    bf16_t* WinT = (bf16_t*)((unsigned char*)p.out + DO_WINT);
    bf16_t* WoutT = (bf16_t*)(p.ws + WS_WOUTT);
    bf16_t* W13T = (bf16_t*)(p.ws + WS_W13T);
    bf16_t* W2T = (bf16_t*)(p.ws + WS_W2T);
    constexpr int I_IN = 16 * 128, I_OUT = 16 * 32, I_W1 = 16 * 16 * 64, I_W2 = 16 * 32 * 32;
    constexpr int NITEMS = I_IN + I_OUT + 2 * I_W1 + I_W2;
    __syncthreads();
    for (int it = blockIdx.x * 8 + wv; it < NITEMS; it += gridDim.x * 8) {
        int r = it;
        if (r < I_IN) { const int kb = r / 128, nb = r % 128; conv_item(p.w_in, INC, kb * 64, nb * 32, WinT + (size_t)(nb * 32) * D, D, scr, lane); continue; }
        r -= I_IN;
        if (r < I_OUT) { const int kb = r / 32, nb = r % 32; conv_item(p.w_out, D, kb * 64, nb * 32, WoutT + (size_t)(nb * 32) * D, D, scr, lane); continue; }
        r -= I_OUT;
        if (r < 2 * I_W1) {
            const int which = r / I_W1; r %= I_W1;
            const int e = r / 1024, r2 = r % 1024, kb = r2 / 64, nb = r2 % 64, n0 = nb * 32;
            const float* W = (which == 0 ? p.exp_w1 : p.exp_w3) + (size_t)e * D * FF;
            const int row = (n0 >> 7) * 256 + which * 128 + (n0 & 127);
            conv_item(W, FF, kb * 64, n0, W13T + ((size_t)e * 4096 + row) * D, D, scr, lane); continue;
        }
        r -= 2 * I_W1;
        { const int e = r / 1024, r2 = r % 1024, kb = r2 / 32, nb = r2 % 32;
          conv_item(p.exp_w2 + (size_t)e * FF * D, D, kb * 64, nb * 32, W2T + ((size_t)e * 1024 + nb * 32) * FF, FF, scr, lane); }
    }
}

__device__ __forceinline__ void ph_norm1(const P& p) {
    const int tid = threadIdx.x, lane = tid & 63, wv = tid >> 6, G = gridDim.x;
    const float* ADA = (const float*)(p.ws + WS_ADA);
    bf16_t* H = (bf16_t*)(p.ws + WS_H);
    bf16_t* HC = (bf16_t*)(p.ws + WS_HC);
    const int gw = blockIdx.x * 8 + wv, NGW = G * 8;
    for (int r = gw; r < NTOK + NCTX; r += NGW) {
        const float* src; bf16_t* dst; int ar;
        if (r < NTOK) { src = p.x + (size_t)r * D; dst = H + (size_t)r * D; ar = r / SEQ; }
        else { const int rc = r - NTOK; src = p.ctx + (size_t)rc * D; dst = HC + (size_t)rc * D; ar = 16; }
        float4 v[4]; float ss = 0.f;
#pragma unroll
        for (int j = 0; j < 4; ++j) { v[j] = ((const float4*)src)[lane + 64 * j]; ss += v[j].x * v[j].x + v[j].y * v[j].y + v[j].z * v[j].z + v[j].w * v[j].w; }
        ss = wave_sum(ss);
        const float rstd = rsqrtf(ss * (1.f / D) + EPS);
        const float* sh = ADA + ar * 6144, *sc = sh + 1024;
#pragma unroll
        for (int j = 0; j < 4; ++j) {
            const int d4 = lane + 64 * j;
            const float4 g = ((const float4*)p.norm1_g)[d4], s1 = ((const float4*)sc)[d4], h1 = ((const float4*)sh)[d4];
            float4 o;
            o.x = v[j].x * rstd * g.x * (1.f + s1.x) + h1.x; o.y = v[j].y * rstd * g.y * (1.f + s1.y) + h1.y;
            o.z = v[j].z * rstd * g.z * (1.f + s1.z) + h1.z; o.w = v[j].w * rstd * g.w * (1.f + s1.w) + h1.w;
            ((uint2*)dst)[d4] = make_uint2(pk2(o.x, o.y), pk2(o.z, o.w));
        }
    }
}
__device__ __forceinline__ void ph_filter(const P& p, float* lds) {
    const int tid = threadIdx.x, G = gridDim.x;
    const float* HID2 = (const float*)(p.ws + WS_HID2);
    float* HF = (float*)((unsigned char*)p.out + DO_HF);
    float* w3c = lds;
    float* red = lds + 128;
    const float min_decay = logf(1e-2f) / 1.5f, max_decay = logf(1e-2f) / 0.3f;
    __syncthreads();
    for (int item = blockIdx.x; item < 1024; item += G) {
        const int o = item >> 9, c = item & 511;
        if (tid < 128) { const int dir = tid >> 6, i = tid & 63; w3c[tid] = p.pos_w3[i * 2048 + o * 1024 + dir * 512 + c]; }
        __syncthreads();
        const float delta = fabsf(min_decay + (float)c * ((max_decay - min_decay) / 511.0f));
        float hv[4][2]; float asum = 0.f;
#pragma unroll
        for (int j = 0; j < 4; ++j) {
            const int t = tid + NT * j;
            float r0 = 0.f, r1 = 0.f;
            const float4* hp = (const float4*)(HID2 + t * 64);
#pragma unroll 4
            for (int i4 = 0; i4 < 16; ++i4) {
                const float4 h = hp[i4];
                r0 += h.x * w3c[i4 * 4 + 0] + h.y * w3c[i4 * 4 + 1] + h.z * w3c[i4 * 4 + 2] + h.w * w3c[i4 * 4 + 3];
                r1 += h.x * w3c[64 + i4 * 4 + 0] + h.y * w3c[64 + i4 * 4 + 1] + h.z * w3c[64 + i4 * 4 + 2] + h.w * w3c[64 + i4 * 4 + 3];
            }
            const float win = expf(-((float)t / 2047.0f) * delta) + 0.05f;
            hv[j][0] = r0 * win; hv[j][1] = r1 * win;
            asum += fabsf(hv[j][0]) + (t >= 1 ? fabsf(hv[j][1]) : 0.f);
        }
        asum = wave_sum(asum);
        if ((tid & 63) == 0) red[tid >> 6] = asum;
        __syncthreads();
        float tot = 0.f;
#pragma unroll
        for (int k = 0; k < 8; ++k) tot += red[k];
        const float inv = 1.f / (tot + EPS);
        float* dst = HF + (size_t)item * 4096;
#pragma unroll
        for (int j = 0; j < 4; ++j) {
            const int t = tid + NT * j;
            dst[2047 + t] = hv[j][0] * inv;
            if (t >= 1) dst[2047 - t] = hv[j][1] * inv;
        }
        if (tid == 0) dst[4095] = 0.f;
        __syncthreads();
    }
}

struct InprojSched {
    int G, c; const bf16_t *WinT, *H, *HC; bf16_t *PHYT, *PHG, *PC;
    __device__ __forceinline__ bool next(int i, Unit& u) const {
        int L = i * G + c; int pm, pn;
        u.aux = nullptr; u.gidx = nullptr; u.row0 = 0; u.col0 = 0;
        if (L < 768) { tile_of(L, 6, 128, pm, pn); u.a = (const char*)(WinT + (size_t)pm * 256 * D); u.b = (const char*)(H + (size_t)pn * 256 * D); u.c = PHYT + (size_t)pm * 256 * NTOK + pn * 256; u.ldc = NTOK; return true; }
        L -= 768;
        if (L < 1280) { tile_of(L, 128, 10, pm, pn); u.a = (const char*)(H + (size_t)pm * 256 * D); u.b = (const char*)(WinT + (size_t)(1536 + pn * 256) * D); u.c = PHG + (size_t)pm * 256 * 2560 + pn * 256; u.ldc = 2560; return true; }
        L -= 1280;
        if (L < 96) { tile_of(L, 16, 6, pm, pn); u.a = (const char*)(HC + (size_t)pm * 256 * D); u.b = (const char*)(WinT + (size_t)(2048 + pn * 256) * D); u.c = PC + (size_t)pm * 256 * 1536 + pn * 256; u.ldc = 1536; return true; }
        return false;
    }
    __device__ __forceinline__ void a_ready(const Unit&) const {}
    __device__ __forceinline__ void done(const Unit&) const {}
};
__device__ __forceinline__ void ph_inproj(const P& p, unsigned char* lds) {
    InprojSched S{(int)gridDim.x, (int)blockIdx.x, (const bf16_t*)((unsigned char*)p.out + DO_WINT), (const bf16_t*)(p.ws + WS_H), (const bf16_t*)(p.ws + WS_HC),
                  (bf16_t*)((unsigned char*)p.out + DO_PHYT), (bf16_t*)(p.ws + WS_PHG), (bf16_t*)(p.ws + WS_PC)};
    pg8::EpiStoreBf16 E;
    pg8::gemm_phase<pg8::EpiStoreBf16, InprojSched, true, true, false>((PG8_LAS unsigned char*)lds, D, S, E);
}

__device__ __forceinline__ float shortconv_at(const P& p, const bf16_t* rowp, int t, int ch) {
    const int tt = t & 63;
    float v = p.hy_conv_b[ch] + p.hy_conv_w[1536 + ch] * bf2f(rowp[t]);
    if (tt > 0) v += p.hy_conv_w[ch] * bf2f(rowp[t - 1]);
    if (tt < 63) v += p.hy_conv_w[2 * 1536 + ch] * bf2f(rowp[t + 1]);
    return v;
}
template <int ORDER>
__device__ __forceinline__ void ph_longconv(const P& p, float* lds) {
    const int tid = threadIdx.x;
    bf16_t* PHYT = (bf16_t*)((unsigned char*)p.out + DO_PHYT);
    const float* HF = (const float*)((unsigned char*)p.out + DO_HF);
    float* vs = lds;
    float* hf = lds + 2048 * 8;
    for (int item = blockIdx.x; item < 1024; item += gridDim.x) {
        const int c = item >> 1, bh = item & 1;
        __syncthreads();
        for (int i = tid; i < 8 * 2048; i += NT) {
            const int bb = i >> 11, t = i & 2047, b = bh * 8 + bb;
            const bf16_t* rowp = PHYT + (size_t)c * NTOK + b * SEQ;
            vs[t * 8 + bb] = (ORDER == 0) ? shortconv_at(p, rowp, t, c) : bf2f(rowp[t]);
        }
        const float* hsrc = HF + (size_t)(ORDER * 512 + c) * 4096;
        for (int i = tid; i < 4096; i += NT) hf[1 + i] = hsrc[i];
        if (tid == 0) hf[0] = 0.f;
        __syncthreads();
        const int t0 = tid * 4;
        float acc[4][8];
#pragma unroll
        for (int j = 0; j < 4; ++j)
#pragma unroll
            for (int q = 0; q < 8; ++q) acc[j][q] = 0.f;
        const int base = t0 + 2047 + 1;
        float w0 = hf[base], w1 = hf[base + 1], w2 = hf[base + 2], w3 = hf[base + 3];
        for (int s = 0; s < SEQ; ++s) {
            const float4 va = *(const float4*)&vs[s * 8], vb = *(const float4*)&vs[s * 8 + 4];
            const float vv[8] = {va.x, va.y, va.z, va.w, vb.x, vb.y, vb.z, vb.w};
#pragma unroll
            for (int q = 0; q < 8; ++q) { acc[0][q] += w0 * vv[q]; acc[1][q] += w1 * vv[q]; acc[2][q] += w2 * vv[q]; acc[3][q] += w3 * vv[q]; }
            w3 = w2; w2 = w1; w1 = w0; w0 = hf[base - s - 1];
        }
        __syncthreads();
        const int gch = (ORDER == 0) ? (512 + c) : (1024 + c);
#pragma unroll
        for (int q = 0; q < 8; ++q) {
            const int b = bh * 8 + q;
            const bf16_t* grow = PHYT + (size_t)gch * NTOK + b * SEQ;
            float o[4];
#pragma unroll
            for (int j = 0; j < 4; ++j) o[j] = shortconv_at(p, grow, t0 + j, gch) * acc[j][q];
            *(uint2*)(PHYT + (size_t)c * NTOK + b * SEQ + t0) = make_uint2(pk2(o[0], o[1]), pk2(o[2], o[3]));
        }
    }
}
template <bool CTXMODE>
__device__ __forceinline__ void ph_scan(const P& p, float* lds) {
    const int tid = threadIdx.x;
    const float* LB = (const float*)(p.ws + WS_LB);
    float* SCTX = (float*)((unsigned char*)p.out + DO_SCTX);
    const bf16_t* SRC = CTXMODE ? (const bf16_t*)(p.ws + WS_PC) : (const bf16_t*)(p.ws + WS_PHG);
    bf16_t* OFB = (bf16_t*)(p.ws + WS_OFB);
    constexpr int T = CTXMODE ? CTXL : SEQ, LD = CTXMODE ? 1536 : 2560;
    constexpr int QOFF = 0, IOFF = CTXMODE ? 0 : 512, ZFOFF = CTXMODE ? 512 : 1024, ZBOFF = CTXMODE ? 1024 : 1536;
    constexpr int TC = 16;
    float* fL = lds, *kL = lds + TC * 128, *qL = lds + 2 * TC * 128, *vL = lds + 3 * TC * 128, *op = lds + 4 * TC * 128;
    const int v = tid & 127, kq = tid >> 7;
    for (int item = blockIdx.x; item < NB * HEADS * 2; item += gridDim.x) {
        const int dir = item & 1, h = (item >> 1) & 3, b = item >> 3;
        float S[32];
        float* sptr = SCTX + ((size_t)item * 128 + kq * 32) * 128 + v;
#pragma unroll
        for (int kk = 0; kk < 32; ++kk) S[kk] = CTXMODE ? 0.f : sptr[kk * 128];
        for (int t0 = 0; t0 < T; t0 += TC) {
            __syncthreads();
            for (int i = tid; i < TC * 128; i += NT) {
                const int st = i >> 7, k = i & 127;
                const int t = dir == 0 ? (t0 + st) : (T - 1 - (t0 + st));
                const bf16_t* row = SRC + ((size_t)b * T + t) * LD + h * 128 + k;
                const float z = bf2f(row[dir == 0 ? ZFOFF : ZBOFF]);
                const float lb = LB[dir * 512 + h * 128 + k];
                const float f = lb + (1.f - lb) * sigmoidf_(z);
                fL[i] = f; kL[i] = 1.f - f; vL[i] = bf2f(row[IOFF]);
                if (!CTXMODE) qL[i] = siluf_(bf2f(row[QOFF])) * 0.08838834764831845f;
            }
            __syncthreads();
            for (int st = 0; st < TC; ++st) {
                const float vv = vL[st * 128 + v];
                float o = 0.f;
#pragma unroll
                for (int k4 = 0; k4 < 8; ++k4) {
                    const float4 f4 = *(const float4*)&fL[st * 128 + kq * 32 + k4 * 4], k4v = *(const float4*)&kL[st * 128 + kq * 32 + k4 * 4];
                    S[k4 * 4 + 0] = f4.x * S[k4 * 4 + 0] + k4v.x * vv; S[k4 * 4 + 1] = f4.y * S[k4 * 4 + 1] + k4v.y * vv;
                    S[k4 * 4 + 2] = f4.z * S[k4 * 4 + 2] + k4v.z * vv; S[k4 * 4 + 3] = f4.w * S[k4 * 4 + 3] + k4v.w * vv;
                    if (!CTXMODE) {
                        const float4 q4 = *(const float4*)&qL[st * 128 + kq * 32 + k4 * 4];
                        o += S[k4 * 4 + 0] * q4.x + S[k4 * 4 + 1] * q4.y + S[k4 * 4 + 2] * q4.z + S[k4 * 4 + 3] * q4.w;
                    }
                }
                if (!CTXMODE) op[(st * 4 + kq) * 128 + v] = o;
            }
            if (!CTXMODE) {
                __syncthreads();
                for (int i = tid; i < TC * 128; i += NT) {
                    const int st = i >> 7, vv = i & 127;
                    const int t = dir == 0 ? (t0 + st) : (T - 1 - (t0 + st));
                    const float sum = op[(st * 4 + 0) * 128 + vv] + op[(st * 4 + 1) * 128 + vv] + op[(st * 4 + 2) * 128 + vv] + op[(st * 4 + 3) * 128 + vv];
                    OFB[(size_t)dir * NTOK * 512 + ((size_t)b * SEQ + t) * 512 + h * 128 + vv] = (bf16_t)f2bf(sum);
                }
            }
        }
        if (CTXMODE) {
#pragma unroll
            for (int kk = 0; kk < 32; ++kk) sptr[kk * 128] = S[kk];
        }
        __syncthreads();
    }
}


namespace hy {
#define HY_LAS __attribute__((address_space(3)))
typedef short bf16x8 __attribute__((ext_vector_type(8)));
typedef float f32x4 __attribute__((ext_vector_type(4)));
typedef unsigned u32x4 __attribute__((ext_vector_type(4)));
typedef unsigned u32x2 __attribute__((ext_vector_type(2)));
constexpr int U_STRIDE = 4112, UIMG = 0, U_BYTES = 16 * U_STRIDE;
constexpr int FILT = U_BYTES, F_STRIDE = 8288, F_BYTES = 8 * F_STRIDE;
constexpr int SCR = FILT + F_BYTES;
static_assert(SCR + 8192 <= LDS_BYTES, "hyena LDS map");

__device__ __forceinline__ float uni(float v) { return __uint_as_float(__builtin_amdgcn_readfirstlane(__float_as_uint(v))); }
struct ConvW { float w0, w1, w2, b; };
__device__ __forceinline__ ConvW load_convw(const P& p, int ch) { ConvW c; c.w0 = uni(p.hy_conv_w[ch]); c.w1 = uni(p.hy_conv_w[1536 + ch]); c.w2 = uni(p.hy_conv_w[3072 + ch]); c.b = uni(p.hy_conv_b[ch]); return c; }
__device__ __forceinline__ void load_u_image(const ConvW cw, HY_LAS unsigned char* L, const bf16_t* row, int tid) {
    const float cw0 = cw.w0, cw1 = cw.w1, cw2 = cw.w2, cb = cw.b;
#pragma unroll 2
    for (int k = 0; k < 8; ++k) {
        const int idx = tid + NT * k, b = idx >> 8, t8 = (idx & 255) * 8;
        const bf16_t* src = row + b * SEQ + t8;
        const u32x4 raw = *(const u32x4*)src;
        float x[10];
        x[0] = (t8 & 63) ? bf2f(src[-1]) : 0.f;
        x[9] = ((t8 + 8) & 63) ? bf2f(src[8]) : 0.f;
        x[1] = __uint_as_float(raw.x << 16); x[2] = __uint_as_float(raw.x & 0xffff0000u); x[3] = __uint_as_float(raw.y << 16); x[4] = __uint_as_float(raw.y & 0xffff0000u);
        x[5] = __uint_as_float(raw.z << 16); x[6] = __uint_as_float(raw.z & 0xffff0000u); x[7] = __uint_as_float(raw.w << 16); x[8] = __uint_as_float(raw.w & 0xffff0000u);
        float o[8];
#pragma unroll
        for (int e = 0; e < 8; ++e) o[e] = cb + cw1 * x[e + 1] + cw0 * x[e] + cw2 * x[e + 2];
        *(HY_LAS u32x4*)(L + UIMG + b * U_STRIDE + t8 * 2) = (u32x4){pk2(o[0], o[1]), pk2(o[2], o[3]), pk2(o[4], o[5]), pk2(o[6], o[7])};
    }
}
__device__ __forceinline__ void stage_raw_rows(HY_LAS unsigned char* L, const bf16_t* row, int tid) {
#pragma unroll 2
    for (int k = 0; k < 8; ++k) {
        const int idx = tid + NT * k, b = idx >> 8, t8 = (idx & 255) * 8;
        const u32x4 raw = *(const u32x4*)(row + b * SEQ + t8);
        HY_LAS unsigned char* d = L + FILT + b * U_STRIDE + 8 + t8 * 2;
        *(HY_LAS u32x2*)d = (u32x2){raw.x, raw.y}; *(HY_LAS u32x2*)(d + 8) = (u32x2){raw.z, raw.w};
    }
}
__device__ __forceinline__ void load_filter_scr(HY_LAS unsigned char* L, const float* hf, int tid) {
    const float4 a = ((const float4*)hf)[tid * 2], b = ((const float4*)hf)[tid * 2 + 1];
    *(HY_LAS u32x4*)(L + SCR + tid * 16) = (u32x4){pk2(a.x, a.y), pk2(a.z, a.w), pk2(b.x, b.y), pk2(b.z, b.w)};
}
__device__ __forceinline__ void build_filter_copies(HY_LAS unsigned char* L, int tid) {
    const HY_LAS bf16_t* sc = (const HY_LAS bf16_t*)(L + SCR);
    for (int gi = tid; gi < 8 * 518; gi += NT) {
        const int d = gi / 518, qg = gi - d * 518;
        const int top = 4095 + d - 8 * qg;
        unsigned v[8];
#pragma unroll
        for (int e = 0; e < 8; ++e) { const int ix = top - e; v[e] = (ix >= 0 && ix <= 4094) ? (unsigned)sc[ix] : 0u; }
        *(HY_LAS u32x4*)(L + FILT + d * F_STRIDE + qg * 16) = (u32x4){v[0] | (v[1] << 16), v[2] | (v[3] << 16), v[4] | (v[5] << 16), v[6] | (v[7] << 16)};
    }
}
__device__ __forceinline__ void conv_loop(HY_LAS unsigned char* L, f32x4 (&acc)[16], int w, int lane) {
    const int i = lane & 15, g = lane >> 4;
    const HY_LAS unsigned char* aBase = L + FILT + (i & 7) * F_STRIDE + 2 * (2048 + 8 * g - (i & ~7)) - 32 * (16 * w);
    const HY_LAS unsigned char* bBase = L + UIMG + i * U_STRIDE + 16 * g;
    bf16x8 ring[16];
#pragma unroll
    for (int s = 0; s < 16; ++s) ring[s] = *(const HY_LAS bf16x8*)(aBase - 32 * s);
#pragma unroll
    for (int m = 0; m < 16; ++m) acc[m] = (f32x4){0.f, 0.f, 0.f, 0.f};
    bf16x8 bfrag = *(const HY_LAS bf16x8*)(bBase);
    for (int k8 = 0; k8 < 8; ++k8) {
        const HY_LAS unsigned char* aK = aBase + 512 * k8;
        const HY_LAS unsigned char* bK = bBase + 512 * k8;
#pragma unroll
        for (int u = 0; u < 8; ++u) {
            bf16x8 bnext = bfrag;
            if (u < 7 || k8 < 7) bnext = *(const HY_LAS bf16x8*)(bK + 64 * (u + 1));
            acc[14] = __builtin_amdgcn_mfma_f32_16x16x32_bf16(ring[(14 - 2 * u) & 15], bfrag, acc[14], 0, 0, 0);
            acc[15] = __builtin_amdgcn_mfma_f32_16x16x32_bf16(ring[(15 - 2 * u) & 15], bfrag, acc[15], 0, 0, 0);
            if (u < 7 || k8 < 7) {
                ring[(14 - 2 * u) & 15] = *(const HY_LAS bf16x8*)(aK + 64 * u + 64);
                ring[(15 - 2 * u) & 15] = *(const HY_LAS bf16x8*)(aK + 64 * u + 32);
            }
#pragma unroll
            for (int m = 0; m < 14; ++m) acc[m] = __builtin_amdgcn_mfma_f32_16x16x32_bf16(ring[(m - 2 * u) & 15], bfrag, acc[m], 0, 0, 0);
            bfrag = bnext;
            __builtin_amdgcn_sched_barrier(0);
        }
    }
}
__device__ __forceinline__ void gate_acc(const ConvW cw, HY_LAS unsigned char* L, f32x4 (&acc)[16], float bias, int w, int lane) {
    const int j = lane & 15, g = lane >> 4;
    const float cw0 = cw.w0, cw1 = cw.w1, cw2 = cw.w2, cb = cw.b;
#pragma unroll
    for (int m = 0; m < 16; ++m) {
        const int t4 = 256 * w + 16 * m + 4 * g, tt0 = t4 & 63;
        const u32x2 uu = *(const HY_LAS u32x2*)(L + UIMG + j * U_STRIDE + t4 * 2);
        const HY_LAS unsigned char* xb = L + FILT + j * U_STRIDE + 8 + t4 * 2;
        const u32x2 xx = *(const HY_LAS u32x2*)xb;
        const float xl = tt0 > 0 ? bf2f(*(const HY_LAS bf16_t*)(xb - 2)) : 0.f;
        const float xr = tt0 < 60 ? bf2f(*(const HY_LAS bf16_t*)(xb + 8)) : 0.f;
        const float x0 = __uint_as_float(xx.x << 16), x1 = __uint_as_float(xx.x & 0xffff0000u), x2 = __uint_as_float(xx.y << 16), x3 = __uint_as_float(xx.y & 0xffff0000u);
        const float u0 = __uint_as_float(uu.x << 16), u1 = __uint_as_float(uu.x & 0xffff0000u), u2 = __uint_as_float(uu.y << 16), u3 = __uint_as_float(uu.y & 0xffff0000u);
        const float g0 = cb + cw1 * x0 + cw0 * xl + cw2 * x1, g1 = cb + cw1 * x1 + cw0 * x0 + cw2 * x2, g2 = cb + cw1 * x2 + cw0 * x1 + cw2 * x3, g3 = cb + cw1 * x3 + cw0 * x2 + cw2 * xr;
        acc[m][0] = g0 * (acc[m][0] + bias * u0); acc[m][1] = g1 * (acc[m][1] + bias * u1); acc[m][2] = g2 * (acc[m][2] + bias * u2); acc[m][3] = g3 * (acc[m][3] + bias * u3);
        if ((m & 3) == 3) __builtin_amdgcn_sched_barrier(0);
    }
}
__device__ __forceinline__ void store_acc_uimg(HY_LAS unsigned char* L, const f32x4 (&acc)[16], int w, int lane) {
    const int j = lane & 15, g = lane >> 4;
#pragma unroll
    for (int m = 0; m < 16; ++m) {
        const int t4 = 256 * w + 16 * m + 4 * g;
        *(HY_LAS u32x2*)(L + UIMG + j * U_STRIDE + t4 * 2) = (u32x2){pk2(acc[m][0], acc[m][1]), pk2(acc[m][2], acc[m][3])};
    }
}
}

__device__ __forceinline__ void ph_hyena(const P& p, unsigned char* ldsb) {
    const int w = __builtin_amdgcn_readfirstlane(threadIdx.x >> 6);
    bf16_t* PHYT = (bf16_t*)((unsigned char*)p.out + DO_PHYT);
    const float* HF = (const float*)((unsigned char*)p.out + DO_HF);
    HY_LAS unsigned char* L = (HY_LAS unsigned char*)ldsb;
    for (int c = blockIdx.x; c < 512; c += gridDim.x) {
        int tid = threadIdx.x; asm volatile("" : "+v"(tid));
        const int lane = tid & 63;
        hy::f32x4 acc[16];
        const hy::ConvW cwv = hy::load_convw(p, c), cwx1 = hy::load_convw(p, 512 + c), cwx2 = hy::load_convw(p, 1024 + c);
        const float bias0 = hy::uni(p.hy_bias[c]), bias1 = hy::uni(p.hy_bias[512 + c]);
        __syncthreads();
        hy::load_u_image(cwv, L, PHYT + (size_t)c * NTOK, tid);
        hy::load_filter_scr(L, HF + (size_t)c * 4096, tid);
        __syncthreads();
        hy::build_filter_copies(L, tid);
        __syncthreads();
        hy::conv_loop(L, acc, w, lane);
        __syncthreads();
        hy::stage_raw_rows(L, PHYT + (size_t)(512 + c) * NTOK, tid);
        hy::load_filter_scr(L, HF + (size_t)(512 + c) * 4096, tid);
        __syncthreads();
        hy::gate_acc(cwx1, L, acc, bias0, w, lane);
        __syncthreads();
        hy::store_acc_uimg(L, acc, w, lane);
        hy::build_filter_copies(L, tid);
        __syncthreads();
        hy::conv_loop(L, acc, w, lane);
        __syncthreads();
        hy::stage_raw_rows(L, PHYT + (size_t)(1024 + c) * NTOK, tid);
        __syncthreads();
        hy::gate_acc(cwx2, L, acc, bias1, w, lane);
        hy::store_acc_uimg(L, acc, w, lane);
        __syncthreads();
#pragma unroll 2
        for (int k = 0; k < 8; ++k) {
            const int idx = tid + NT * k, b = idx >> 8, t8 = (idx & 255) * 8;
            *(hy::u32x4*)(PHYT + (size_t)c * NTOK + b * SEQ + t8) = *(const HY_LAS hy::u32x4*)(L + hy::UIMG + b * hy::U_STRIDE + t8 * 2);
        }
    }
}

__device__ __forceinline__ void ph_mixprep(const P& p, float* lds) {
    const int tid = threadIdx.x, lane = tid & 63, wv = tid >> 6;
    const bf16_t* YT = (const bf16_t*)((unsigned char*)p.out + DO_PHYT);
    bf16_t* MIXA = (bf16_t*)(p.ws + WS_MIXA);
    bf16_t* yl = (bf16_t*)lds;
    float* part = lds + (512 * 72 * 2) / 4;
    for (int tile = blockIdx.x; tile < NTOK / 64; tile += gridDim.x) {
        const int tok0 = tile * 64;
        __syncthreads();
        for (int i = tid; i < 512 * 8; i += NT) { const int row = i >> 3, ch = i & 7; *(uint4*)(yl + row * 72 + ch * 8) = *(const uint4*)(YT + (size_t)row * NTOK + tok0 + ch * 8); }
        __syncthreads();
        const int tok = tid & 63, pt = tid >> 6;
        float ss = 0.f;
        for (int c = pt * 64; c < pt * 64 + 64; ++c) { const float v = bf2f(yl[c * 72 + tok]); ss += v * v; }
        part[pt * 64 + tok] = ss;
        __syncthreads();
        float tot = 0.f;
#pragma unroll
        for (int k = 0; k < 8; ++k) tot += part[k * 64 + tok];
        const float rstd = rsqrtf(tot * (1.f / 512.f) + EPS);
        bf16_t* dst = MIXA + (size_t)(tok0 + tok) * D + pt * 64;
#pragma unroll
        for (int j = 0; j < 8; ++j) {
            float o[8];
#pragma unroll
            for (int q = 0; q < 8; ++q) { const int c = pt * 64 + j * 8 + q; o[q] = bf2f(yl[c * 72 + tok]) * rstd * p.hy_norm_g[c]; }
            *(uint4*)(dst + j * 8) = make_uint4(pk2(o[0], o[1]), pk2(o[2], o[3]), pk2(o[4], o[5]), pk2(o[6], o[7]));
        }
    }
    const bf16_t* OFB = (const bf16_t*)(p.ws + WS_OFB);
    const bf16_t* PHG = (const bf16_t*)(p.ws + WS_PHG);
    for (int r = blockIdx.x * 8 + wv; r < NTOK; r += gridDim.x * 8) {
#pragma unroll
        for (int h = 0; h < HEADS; ++h) {
            const int k = lane * 2;
            const unsigned a = *(const unsigned*)(OFB + (size_t)r * 512 + h * 128 + k);
            const unsigned bq = *(const unsigned*)(OFB + (size_t)NTOK * 512 + (size_t)r * 512 + h * 128 + k);
            const float o0 = __uint_as_float(a << 16) + __uint_as_float(bq << 16), o1 = __uint_as_float(a & 0xffff0000u) + __uint_as_float(bq & 0xffff0000u);
            const float ss = wave_sum(o0 * o0 + o1 * o1);
            const float rstd = rsqrtf(ss * (1.f / 128.f) + EPS);
            const unsigned g = *(const unsigned*)(PHG + (size_t)r * 2560 + 2048 + h * 128 + k);
            const float2 ng = *(const float2*)(p.hg_norm_g + k);
            *(unsigned*)(MIXA + (size_t)r * D + 512 + h * 128 + k) = pk2(o0 * rstd * ng.x * siluf_(__uint_as_float(g << 16)), o1 * rstd * ng.y * siluf_(__uint_as_float(g & 0xffff0000u)));
        }
    }
}

struct OutprojSched {
    int G, c; const bf16_t *A, *Bt;
    __device__ __forceinline__ bool next(int i, Unit& u) const {
        const int L = i * G + c; if (L >= 512) return false; int pm, pn; tile_of(L, 128, 4, pm, pn);
        u.a = (const char*)(A + (size_t)pm * 256 * D); u.b = (const char*)(Bt + (size_t)pn * 256 * D); u.c = nullptr; u.aux = nullptr; u.gidx = nullptr; u.ldc = D; u.row0 = pm * 256; u.col0 = pn * 256; return true;
    }
    __device__ __forceinline__ void a_ready(const Unit&) const {}
    __device__ __forceinline__ void done(const Unit&) const {}
};
__device__ __forceinline__ void ph_outproj(const P& p, unsigned char* lds) {
    OutprojSched S{(int)gridDim.x, (int)blockIdx.x, (const bf16_t*)(p.ws + WS_MIXA), (const bf16_t*)(p.ws + WS_WOUTT)};
    pg8::EpiOutProj E{p.x, (const float*)(p.ws + WS_ADA), p.out};
    pg8::gemm_phase<pg8::EpiOutProj, OutprojSched, true, true, false>((PG8_LAS unsigned char*)lds, D, S, E);
}

__device__ __forceinline__ void ph_norm2_router(const P& p) {
    const int tid = threadIdx.x, lane = tid & 63, wv = tid >> 6;
    const float* ADA = (const float*)(p.ws + WS_ADA);
    const float* X1 = p.out;
    bf16_t* H2 = (bf16_t*)(p.ws + WS_H2);
    float* AFF = (float*)(p.ws + WS_AFF);
    for (int r = blockIdx.x * 8 + wv; r < NTOK; r += gridDim.x * 8) {
        const int b = r / SEQ, t = r % SEQ;
        const float4* src = (const float4*)(X1 + (size_t)r * D);
        float4 v[4]; float ss = 0.f;
#pragma unroll
        for (int j = 0; j < 4; ++j) { v[j] = src[lane + 64 * j]; ss += v[j].x * v[j].x + v[j].y * v[j].y + v[j].z * v[j].z + v[j].w * v[j].w; }
        ss = wave_sum(ss);
        const float rstd = rsqrtf(ss * (1.f / D) + EPS);
        const float* sh = ADA + b * 6144 + 3072, *sc = ADA + b * 6144 + 4096;
        float lg[16];
#pragma unroll
        for (int e = 0; e < 16; ++e) lg[e] = 0.f;
#pragma unroll
        for (int j = 0; j < 4; ++j) {
            const int d4 = lane + 64 * j;
            const float4 g = ((const float4*)p.norm2_g)[d4], s1 = ((const float4*)sc)[d4], h1 = ((const float4*)sh)[d4];
            float4 o;
            o.x = v[j].x * rstd * g.x * (1.f + s1.x) + h1.x; o.y = v[j].y * rstd * g.y * (1.f + s1.y) + h1.y;
            o.z = v[j].z * rstd * g.z * (1.f + s1.z) + h1.z; o.w = v[j].w * rstd * g.w * (1.f + s1.w) + h1.w;
            ((uint2*)(H2 + (size_t)r * D))[d4] = make_uint2(pk2(o.x, o.y), pk2(o.z, o.w));
            const float ov[4] = {o.x, o.y, o.z, o.w};
#pragma unroll
            for (int q = 0; q < 4; ++q) {
                const float4* rw = (const float4*)(p.router_w + (size_t)(d4 * 4 + q) * 16);
#pragma unroll
                for (int e4 = 0; e4 < 4; ++e4) {
                    const float4 w = rw[e4];
                    lg[e4 * 4 + 0] += ov[q] * w.x; lg[e4 * 4 + 1] += ov[q] * w.y; lg[e4 * 4 + 2] += ov[q] * w.z; lg[e4 * 4 + 3] += ov[q] * w.w;
                }
            }
        }
#pragma unroll
        for (int e = 0; e < 16; ++e) lg[e] = wave_sum(lg[e]);
        float mx = lg[0];
#pragma unroll
        for (int e = 1; e < 16; ++e) mx = fmaxf(mx, lg[e]);
        float den = 0.f;
#pragma unroll
        for (int e = 0; e < 16; ++e) { lg[e] = expf(lg[e] - mx); den += lg[e]; }
        const float inv = 1.f / den;
        if (lane < 16) {
            float val = 0.f;
#pragma unroll
            for (int e = 0; e < 16; ++e) val = (lane == e) ? lg[e] : val;
            AFF[((size_t)b * 16 + lane) * SEQ + t] = val * inv;
        }
    }
}

__device__ __forceinline__ void ph_topk(const P& p, float* lds) {
    const int tid = threadIdx.x;
    const float* AFF = (const float*)(p.ws + WS_AFF);
    int* IDX = (int*)(p.ws + WS_IDX);
    float* GATE = (float*)(p.ws + WS_GATE);
    int* INV = (int*)(p.ws + WS_INV);
    float* a = lds;
    int* sel = (int*)(lds + 2048);
    for (int item = blockIdx.x; item < NB * NE; item += gridDim.x) {
        const int b = item >> 4, e = item & 15;
        __syncthreads();
        for (int i = tid; i < SEQ; i += NT) a[i] = AFF[(size_t)item * SEQ + i];
        __syncthreads();
        float ai[4]; int rank[4];
#pragma unroll
        for (int j = 0; j < 4; ++j) { ai[j] = a[tid + NT * j]; rank[j] = 0; }
        for (int j2 = 0; j2 < SEQ; j2 += 4) {
            const float4 o4 = *(const float4*)&a[j2];
            const float ov[4] = {o4.x, o4.y, o4.z, o4.w};
#pragma unroll
            for (int q = 0; q < 4; ++q)
#pragma unroll
                for (int j = 0; j < 4; ++j) rank[j] += (ov[q] > ai[j] || (ov[q] == ai[j] && (j2 + q) < (tid + NT * j))) ? 1 : 0;
        }
#pragma unroll
        for (int j = 0; j < 4; ++j) {
            const int t = tid + NT * j;
            if (rank[j] < CAP) { IDX[item * CAP + rank[j]] = t; GATE[item * CAP + rank[j]] = ai[j]; sel[rank[j]] = t; }
            INV[((size_t)b * SEQ + t) * 16 + e] = rank[j] < CAP ? rank[j] : -1;
        }
    }
}

struct MoeUpSched {
    int G, c; const bf16_t *H2, *W13T; bf16_t* HMID; const int* IDX;
    __device__ __forceinline__ bool next(int i, Unit& u) const {
        if (i >= 16 || c >= 256) return false;
        const int item = c, b = item >> 4, e = item & 15, nt = i;
        u.a = (const char*)(H2 + (size_t)b * SEQ * D); u.b = (const char*)(W13T + ((size_t)e * 4096 + nt * 256) * D); u.c = HMID + (size_t)item * CAP * FF + nt * 128;
        u.aux = nullptr; u.gidx = IDX + item * CAP; u.ldc = FF; u.row0 = 0; u.col0 = 0; return true;
    }
    __device__ __forceinline__ void a_ready(const Unit&) const {}
    __device__ __forceinline__ void done(const Unit&) const {}
};
struct MoeDownSched {
    int G, c; const bf16_t *HMID, *W2T; bf16_t* YS; const float* GATE;
    __device__ __forceinline__ bool next(int i, Unit& u) const {
        if (i >= 4 || c >= 256) return false;
        const int item = c, e = item & 15, nt = i;
        u.a = (const char*)(HMID + (size_t)item * CAP * FF); u.b = (const char*)(W2T + ((size_t)e * 1024 + nt * 256) * FF); u.c = YS + (size_t)item * CAP * D + nt * 256;
        u.aux = GATE + item * CAP; u.gidx = nullptr; u.ldc = D; u.row0 = 0; u.col0 = 0; return true;
    }
    __device__ __forceinline__ void a_ready(const Unit&) const {}
    __device__ __forceinline__ void done(const Unit&) const {}
};
__device__ __forceinline__ void ph_moe_up(const P& p, unsigned char* lds) {
    MoeUpSched S{(int)gridDim.x, (int)blockIdx.x, (const bf16_t*)(p.ws + WS_H2), (const bf16_t*)(p.ws + WS_W13T), (bf16_t*)(p.ws + WS_HMID), (const int*)(p.ws + WS_IDX)};
    pg8::EpiSwiGLU E;
    pg8::gemm_phase<pg8::EpiSwiGLU, MoeUpSched, true, true, true>((PG8_LAS unsigned char*)lds, D, S, E);
}
__device__ __forceinline__ void ph_moe_down(const P& p, unsigned char* lds) {
    MoeDownSched S{(int)gridDim.x, (int)blockIdx.x, (const bf16_t*)(p.ws + WS_HMID), (const bf16_t*)(p.ws + WS_W2T), (bf16_t*)(p.ws + WS_YS), (const float*)(p.ws + WS_GATE)};
    pg8::EpiDown E;
    pg8::gemm_phase<pg8::EpiDown, MoeDownSched, true, true, false>((PG8_LAS unsigned char*)lds, FF, S, E);
}

__device__ __forceinline__ void ph_final(const P& p) {
    const int tid = threadIdx.x, lane = tid & 63, wv = tid >> 6;
    const float* ADA = (const float*)(p.ws + WS_ADA);
    const bf16_t* YS = (const bf16_t*)(p.ws + WS_YS);
    const int* INV = (const int*)(p.ws + WS_INV);
    float* X = p.out;
    for (int r = blockIdx.x * 8 + wv; r < NTOK; r += gridDim.x * 8) {
        const int b = r / SEQ;
        const float* g2 = ADA + b * 6144 + 5120;
        float4 acc[4];
#pragma unroll
        for (int j = 0; j < 4; ++j) acc[j] = make_float4(0.f, 0.f, 0.f, 0.f);
        const int myinv = INV[(size_t)r * 16 + (lane & 15)];
#pragma unroll
        for (int e = 0; e < 16; ++e) {
            const int slot = __shfl(myinv, e);
            if (slot >= 0) {
                const uint2* yr = (const uint2*)(YS + ((size_t)(b * 16 + e) * CAP + slot) * D);
#pragma unroll
                for (int j = 0; j < 4; ++j) { const uint2 w = yr[lane + 64 * j];
                    acc[j].x += __uint_as_float(w.x << 16); acc[j].y += __uint_as_float(w.x & 0xffff0000u); acc[j].z += __uint_as_float(w.y << 16); acc[j].w += __uint_as_float(w.y & 0xffff0000u); }
            }
        }
        float4 v[4]; float ss = 0.f;
#pragma unroll
        for (int j = 0; j < 4; ++j) {
            const int d4 = lane + 64 * j;
            const float4 xv = ((const float4*)(X + (size_t)r * D))[d4], g = ((const float4*)g2)[d4];
            v[j] = make_float4(xv.x + g.x * acc[j].x, xv.y + g.y * acc[j].y, xv.z + g.z * acc[j].z, xv.w + g.w * acc[j].w);
            ss += v[j].x * v[j].x + v[j].y * v[j].y + v[j].z * v[j].z + v[j].w * v[j].w;
        }
        ss = wave_sum(ss);
        const float rstd = rsqrtf(ss * (1.f / D) + EPS);
#pragma unroll
        for (int j = 0; j < 4; ++j) {
            const int d4 = lane + 64 * j;
            const float4 g = ((const float4*)p.final_g)[d4];
            ((float4*)(X + (size_t)r * D))[d4] = make_float4(v[j].x * rstd * g.x, v[j].y * rstd * g.y, v[j].z * rstd * g.z, v[j].w * rstd * g.w);
        }
    }
}

constexpr int N_PHASES = 12;
template <int PH>
__device__ __forceinline__ void run_phase(const P& p, unsigned char* ldsb) {
    float* lds = (float*)ldsb;
    if constexpr (PH == 0) { ph_prep(p, lds); ph_convert(p, lds); }
    else if constexpr (PH == 1) { ph_norm1(p); ph_filter(p, lds); }
    else if constexpr (PH == 2) ph_inproj(p, ldsb);
    else if constexpr (PH == 3) { ph_hyena(p, ldsb); ph_scan<true>(p, lds); }
    else if constexpr (PH == 4) { ph_scan<false>(p, lds); }
    else if constexpr (PH == 5) ph_mixprep(p, lds);
    else if constexpr (PH == 6) ph_outproj(p, ldsb);
    else if constexpr (PH == 7) ph_norm2_router(p);
    else if constexpr (PH == 8) ph_topk(p, lds);
    else if constexpr (PH == 9) ph_moe_up(p, ldsb);
    else if constexpr (PH == 10) ph_moe_down(p, ldsb);
    else if constexpr (PH == 11) ph_final(p);
}
template <int PH>
__device__ __forceinline__ void run_from(const P& p, unsigned char* lds, cg::grid_group& grid) {
    if constexpr (PH < N_PHASES) {
        if (PH >= p.ph_lo && PH < p.ph_hi) {
            run_phase<PH>(p, lds);
            if (PH + 1 < p.ph_hi) { __syncthreads(); grid.sync(); }
        }
        run_from<PH + 1>(p, lds, grid);
    }
}
__global__ void __launch_bounds__(NT, 2) fwd_all(P p) {
    extern __shared__ __attribute__((aligned(16))) unsigned char lds_raw[];
    cg::grid_group grid = cg::this_grid();
    run_from<0>(p, lds_raw, grid);
}

extern "C" void kernel_launch(void* const* d_in, const int* in_sizes, int n_in, void* d_out, int out_size, void* d_ws, size_t ws_size, hipStream_t stream) {
    static int grid = 0;
    if (grid == 0) {
        int dev = 0, cus = 0, per_cu = 0;
        (void)hipGetDevice(&dev);
        (void)hipDeviceGetAttribute(&cus, hipDeviceAttributeMultiprocessorCount, dev);
        (void)hipFuncSetAttribute((const void*)fwd_all, hipFuncAttributeMaxDynamicSharedMemorySize, LDS_BYTES);
        (void)hipOccupancyMaxActiveBlocksPerMultiprocessor(&per_cu, (const void*)fwd_all, NT, LDS_BYTES);
        if (per_cu < 1) fprintf(stderr, "kernel_launch: occupancy query says %d blocks/CU\n", per_cu);
        grid = (cus > 0 ? cus : 256);
        if (ws_size < WS_END) fprintf(stderr, "kernel_launch: workspace too small: %zu < %zu\n", ws_size, (size_t)WS_END);
    }
    P p{};
    const float** f = (const float**)&p;
    for (int i = 0; i < 28; ++i) f[i] = (const float*)d_in[i];
    p.out = (float*)d_out;
    p.ws = (unsigned char*)d_ws;
    p.ph_lo = 0; p.ph_hi = N_PHASES;
    void* args[] = {&p};
    hipError_t e = hipLaunchCooperativeKernel((const void*)fwd_all, dim3(grid), dim3(NT), args, LDS_BYTES, stream);
    if (e != hipSuccess) fprintf(stderr, "cooperative launch failed: %s (grid %d)\n", hipGetErrorString(e), grid);
}
```

```cpp
#include <hip/hip_runtime.h>
#include <cstdio>
#include <cstdint>

constexpr int D = 1024, NB = 16, SEQ = 2048, CTXL = 256;
constexpr int NTOK = NB * SEQ;
constexpr int NCTX = NB * CTXL;
constexpr int HEADS = 4;
constexpr int INC = 4096;
constexpr int NE = 16, CAP = 256, FF = 2048;
constexpr int NT = 512;
constexpr int LDS_BYTES = 147456;
constexpr float EPS = 1e-6f;
typedef unsigned short bf16_t;

constexpr size_t MiB = 1u << 20;
constexpr size_t WS_CTL = 0;
constexpr size_t WS_ADA = 1 * MiB;
constexpr size_t WS_LB = WS_ADA + 512 * 1024;
constexpr size_t WS_HID2 = 2 * MiB;
constexpr size_t WS_AFF = 3 * MiB;
constexpr size_t WS_IDX = 5 * MiB;
constexpr size_t WS_GATE = 5 * MiB + 512 * 1024;
constexpr size_t WS_INV = 6 * MiB;
constexpr size_t WS_W13T = 8 * MiB;
constexpr size_t WS_YS = WS_W13T;
constexpr size_t WS_W2T = 136 * MiB;
constexpr size_t WS_R = 200 * MiB;
constexpr size_t WS_H = WS_R;
constexpr size_t WS_MIXA = WS_R;
constexpr size_t WS_HC = WS_R + 64 * MiB;
constexpr size_t WS_PC = WS_R + 72 * MiB;
constexpr size_t WS_OFB = WS_R + 84 * MiB;
constexpr size_t WS_WOUTT = WS_R + 148 * MiB;
constexpr size_t WS_PHG = WS_R + 152 * MiB;
constexpr size_t WS_HMID = WS_R;
constexpr size_t WS_H2 = WS_R + 256 * MiB;
constexpr size_t WS_END = WS_R + 320 * MiB;
constexpr int CW_QHEAD = 64;
constexpr int CW_BAR = 4096;
constexpr size_t CTL_ZERO_BYTES = 65536;
constexpr size_t DO_PHYT = 0;
constexpr size_t DO_HF = 96 * MiB;
constexpr size_t DO_SCTX = 112 * MiB;
constexpr size_t DO_WINT = 120 * MiB;

struct P {
    const float *x, *c, *ctx, *c_ctx, *ada_w, *ada_b, *norm1_g, *w_in, *hy_conv_w, *hy_conv_b, *pos_w1, *pos_b1, *freq1, *pos_w2, *pos_b2,
        *freq2, *pos_w3, *hy_bias, *hy_norm_g, *hg_lb, *hg_norm_g, *w_out, *norm2_g, *router_w, *exp_w1, *exp_w3, *exp_w2, *final_g;
    float* out;
    unsigned char* ws;
    int ph_lo, ph_hi;
};

__device__ __forceinline__ int opaque_tid() { int t = threadIdx.x; asm volatile("" : "+v"(t)); return t; }
__device__ __forceinline__ float wave_sum(float v) {
#pragma unroll
    for (int o = 1; o < 64; o <<= 1) v += __shfl_xor(v, o);
    return v;
}
__device__ __forceinline__ float sigmoidf_(float z) { return 1.f / (1.f + expf(-z)); }
__device__ __forceinline__ float siluf_(float z) { return z / (1.f + expf(-z)); }
__device__ __forceinline__ float bf2f(bf16_t h) { return __uint_as_float((unsigned)h << 16); }
__device__ __forceinline__ unsigned f2bf(float f) { unsigned u = __float_as_uint(f); return (u + 0x7fffu + ((u >> 16) & 1u)) >> 16; }
__device__ __forceinline__ unsigned pk2(float lo, float hi) { return f2bf(lo) | (f2bf(hi) << 16); }

namespace pg8 {
#define PG8_LAS __attribute__((address_space(3)))
typedef unsigned short bf16_t;
typedef short bf16x8 __attribute__((ext_vector_type(8)));
typedef float f32x4 __attribute__((ext_vector_type(4)));
typedef unsigned u32x4 __attribute__((ext_vector_type(4)));
constexpr int BM = 256, BK = 64, HALF = 128, HTB = HALF * BK * 2  , STAGE_BYTES = 8 * HTB, NXCD = 8, WGM = 8;

__host__ __device__ __forceinline__ int lds_byte(int r, int c) { const int st = (r >> 4) * 2 + (c >> 5), rr = r & 15, cc = c & 31, ob = rr * 64 + cc * 2; return st * 1024 + (ob ^ (((ob >> 9) & 1) << 5)); }
__host__ __device__ __forceinline__ void stage_rc(int b, int& R, int& C) { const int st = b / 1024, sb = b % 1024, swz = sb ^ (((sb >> 9) & 1) << 5); R = (st >> 1) * 16 + swz / 64; C = (st & 1) * 32 + (swz % 64) / 2; }
__host__ __device__ __forceinline__ int perm32(int rho) { const int n = rho >> 4, i = rho & 15; return 8 * (i >> 2) + 4 * n + (i & 3); }

struct Unit { const char* a; const char* b; bf16_t* c; const float* aux; const int* gidx; int ldc, row0, col0; };
__device__ __forceinline__ unsigned cvt_pk_bf16(float lo, float hi) { unsigned r; asm volatile("v_cvt_pk_bf16_f32 %0, %1, %2" : "=v"(r) : "v"(lo), "v"(hi)); return r; }

__device__ __forceinline__ void tile_of(int L, int nM, int nN, int& pm, int& pn) {
    const int nwg = nM * nN; int wgid = L;
    { const int q = nwg / NXCD, r = nwg % NXCD, xcd = wgid % NXCD, off = wgid / NXCD; wgid = (xcd < r ? xcd * (q + 1) : r * (q + 1) + (xcd - r) * q) + off; }
    const int nig = WGM * nN, gid = wgid / nig, fm = gid * WGM, gsz = (nM - fm) < WGM ? (nM - fm) : WGM;
    pm = fm + ((wgid % nig) % gsz); pn = (wgid % nig) / gsz;
}

struct EpiStoreBf16 {
    static constexpr bool PERM = true, AFTER_DRAIN = false;
    __device__ __forceinline__ void operator()(const f32x4 (&acc)[2][2][4][2], const Unit& u, int wr, int wc, int fr, int fq) const {
        bf16_t* base = u.c + (size_t)(wr * 64 + fr) * u.ldc + wc * 32 + 8 * fq;
#pragma unroll
        for (int ai = 0; ai < 2; ++ai)
#pragma unroll
            for (int m = 0; m < 4; ++m) { bf16_t* rowp = base + (size_t)(ai * HALF + m * 16) * u.ldc;
#pragma unroll
                for (int bj = 0; bj < 2; ++bj) { const f32x4 v0 = acc[ai][bj][m][0], v1 = acc[ai][bj][m][1];
                    u32x4 w; w.x = cvt_pk_bf16(v0[0], v0[1]); w.y = cvt_pk_bf16(v0[2], v0[3]); w.z = cvt_pk_bf16(v1[0], v1[1]); w.w = cvt_pk_bf16(v1[2], v1[3]);
                    *(u32x4*)(rowp + bj * HALF) = w; } }
    }
};
struct EpiOutProj {
    static constexpr bool PERM = false, AFTER_DRAIN = false;
    const float* x; const float* ada; float* x1;
    __device__ __forceinline__ void operator()(const f32x4 (&acc)[2][2][4][2], const Unit& u, int wr, int wc, int fr, int fq) const {
        const float* g1 = ada + (u.row0 >> 11) * 6144 + 2048;
#pragma unroll
        for (int bj = 0; bj < 2; ++bj)
#pragma unroll
            for (int n = 0; n < 2; ++n) { const int col = u.col0 + bj * HALF + wc * 32 + n * 16 + 4 * fq; const f32x4 g = *(const f32x4*)(g1 + col);
#pragma unroll
                for (int ai = 0; ai < 2; ++ai)
#pragma unroll
                    for (int m = 0; m < 4; ++m) { const size_t off = (size_t)(u.row0 + ai * HALF + wr * 64 + m * 16 + fr) * D + col;
                        const f32x4 xv = *(const f32x4*)(x + off); *(f32x4*)(x1 + off) = xv + g * acc[ai][bj][m][n]; } }
    }
};
__device__ __forceinline__ float silu_fast(float a) { return a * __builtin_amdgcn_rcpf(1.0f + __builtin_amdgcn_exp2f(-1.4426950408889634f * a)); }
struct EpiSwiGLU {
    static constexpr bool PERM = true, AFTER_DRAIN = false;
    __device__ __forceinline__ void operator()(const f32x4 (&acc)[2][2][4][2], const Unit& u, int wr, int wc, int fr, int fq) const {
        bf16_t* base = u.c + (size_t)(wr * 64 + fr) * FF + wc * 32 + 8 * fq;
#pragma unroll
        for (int ai = 0; ai < 2; ++ai)
#pragma unroll
            for (int m = 0; m < 4; ++m) { const f32x4 a0 = acc[ai][0][m][0], a1 = acc[ai][0][m][1], b0 = acc[ai][1][m][0], b1 = acc[ai][1][m][1];
                u32x4 w; w.x = cvt_pk_bf16(silu_fast(a0[0]) * b0[0], silu_fast(a0[1]) * b0[1]); w.y = cvt_pk_bf16(silu_fast(a0[2]) * b0[2], silu_fast(a0[3]) * b0[3]);
                w.z = cvt_pk_bf16(silu_fast(a1[0]) * b1[0], silu_fast(a1[1]) * b1[1]); w.w = cvt_pk_bf16(silu_fast(a1[2]) * b1[2], silu_fast(a1[3]) * b1[3]);
                *(u32x4*)(base + (size_t)(ai * HALF + m * 16) * FF) = w; }
    }
};
struct EpiDown {
    static constexpr bool PERM = true, AFTER_DRAIN = false;
    __device__ __forceinline__ void operator()(const f32x4 (&acc)[2][2][4][2], const Unit& u, int wr, int wc, int fr, int fq) const {
        bf16_t* base = u.c + (size_t)(wr * 64 + fr) * D + wc * 32 + 8 * fq;
#pragma unroll
        for (int ai = 0; ai < 2; ++ai)
#pragma unroll
            for (int m = 0; m < 4; ++m) { const float gt = u.aux[ai * HALF + wr * 64 + m * 16 + fr]; bf16_t* rowp = base + (size_t)(ai * HALF + m * 16) * D;
#pragma unroll
                for (int bj = 0; bj < 2; ++bj) { const f32x4 v0 = acc[ai][bj][m][0] * gt, v1 = acc[ai][bj][m][1] * gt;
                    u32x4 w; w.x = cvt_pk_bf16(v0[0], v0[1]); w.y = cvt_pk_bf16(v0[2], v0[3]); w.z = cvt_pk_bf16(v1[0], v1[1]); w.w = cvt_pk_bf16(v1[2], v1[3]);
                    *(u32x4*)(rowp + bj * HALF) = w; } }
    }
};

template <class Epi, class Sched, bool ALIGN_EPI = false, bool SP2 = false, bool GATHER = false>
__device__ __forceinline__ void gemm_phase(PG8_LAS unsigned char* lds, const int K, const Sched& S, const Epi& E) {
    const int tid = opaque_tid(), wid = __builtin_amdgcn_readfirstlane(tid >> 6), lane = tid & 63, wr = wid >> 2, wc = wid & 3, fr = lane & 15, fq = lane >> 4;
    const int nt = K / BK;
    unsigned voffA[2], voffB[2];
#pragma unroll
    for (int i = 0; i < 2; ++i) { int R, C; stage_rc(tid * 16 + i * 8192, R, C); const int Rb = Epi::PERM ? ((R & ~31) + perm32(R & 31)) : R;
        voffA[i] = (unsigned)(R * K + C) * 2u; voffB[i] = (unsigned)(Rb * K + C) * 2u; }
    const size_t kstep = (size_t)(BK * 2);
    const size_t hstep = (size_t)HALF * K * 2;
    const unsigned ldsw = (unsigned)wid * 1024u;
    const int aoff = lds_byte(wr * 64 + fr, fq * 8), boff = lds_byte(wc * 32 + fr, fq * 8);
#define PG8_SA(b, h) (((b) * 2 + (h)) * HTB)
#define PG8_SB(b, h) ((4 + (b) * 2 + (h)) * HTB)
#define PG8_STAGE(bufoff, gbase, voff) do { _Pragma("unroll") for (int _i = 0; _i < 2; ++_i) \
        __builtin_amdgcn_global_load_lds((const unsigned*)((const char*)(gbase) + (voff)[_i]), (PG8_LAS unsigned*)(lds + (bufoff) + ldsw + _i * 8192), 16, 0, 0); } while (0)
#define PG8_STAGE_A(bufoff, gbase, h) do { _Pragma("unroll") for (int _i = 0; _i < 2; ++_i) \
        __builtin_amdgcn_global_load_lds((const unsigned*)((const char*)(gbase) + voffAh[h][_i]), (PG8_LAS unsigned*)(lds + (bufoff) + ldsw + _i * 8192), 16, 0, 0); } while (0)
#define PG8_LDA(dst, b, h) do { _Pragma("unroll") for (int m = 0; m < 4; ++m) _Pragma("unroll") for (int k = 0; k < 2; ++k) dst[m][k] = *(const PG8_LAS bf16x8*)(lds + PG8_SA(b, h) + aoff + m * 2048 + k * 1024); } while (0)
#define PG8_LDB(dst, b, h) do { _Pragma("unroll") for (int n = 0; n < 2; ++n) _Pragma("unroll") for (int k = 0; k < 2; ++k) dst[n][k] = *(const PG8_LAS bf16x8*)(lds + PG8_SB(b, h) + boff + n * 2048 + k * 1024); } while (0)
#define PG8_MMA(ai, bj, At, Bt) do { __builtin_amdgcn_s_setprio(1); _Pragma("unroll") for (int m = 0; m < 4; ++m) _Pragma("unroll") for (int n = 0; n < 2; ++n) _Pragma("unroll") for (int k = 0; k < 2; ++k) \
        acc[ai][bj][m][n] = __builtin_amdgcn_mfma_f32_16x16x32_bf16(Bt[n][k], At[m][k], acc[ai][bj][m][n], 0, 0, 0); __builtin_amdgcn_s_setprio(0); } while (0)
#define PG8_WAIT_V(n) asm volatile("s_waitcnt vmcnt(" #n ")" ::: "memory")
#define PG8_WAIT_L(n) asm volatile("s_waitcnt lgkmcnt(" #n ")" ::: "memory")
#define PG8_BAR __builtin_amdgcn_s_barrier()
#define PG8_SCHED __builtin_amdgcn_sched_barrier(0)
    Unit cur, nxt; int ui = 0;
    if (!S.next(0, cur)) return;
    unsigned voffAh[2][2];
#pragma unroll
    for (int h = 0; h < 2; ++h)
#pragma unroll
        for (int i = 0; i < 2; ++i) {
            if constexpr (GATHER) { int R, C; stage_rc(tid * 16 + i * 8192, R, C); voffAh[h][i] = ((unsigned)cur.gidx[h * HALF + R] * (unsigned)K + (unsigned)C) * 2u; }
            else voffAh[h][i] = voffA[i] + (unsigned)h * (unsigned)hstep;
        }
    f32x4 acc[2][2][4][2];
#pragma unroll
    for (int a = 0; a < 2; ++a)
#pragma unroll
        for (int b = 0; b < 2; ++b)
#pragma unroll
            for (int m = 0; m < 4; ++m)
#pragma unroll
                for (int n = 0; n < 2; ++n) acc[a][b][m][n] = (f32x4){0.f, 0.f, 0.f, 0.f};
    bf16x8 At[4][2], B0[2][2], B1[2][2];
    const char* cA = cur.a; const char* cB = cur.b;
    S.a_ready(cur);
    if constexpr (SP2) {
        PG8_STAGE(PG8_SB(0, 0), cB, voffB); PG8_STAGE(PG8_SB(0, 1), cB + hstep, voffB); PG8_STAGE_A(PG8_SA(0, 0), cA, 0); PG8_STAGE_A(PG8_SA(0, 1), cA, 1);
        if (wr == 1) PG8_BAR;
        PG8_WAIT_V(2); PG8_BAR;
        PG8_STAGE(PG8_SB(1, 0), cB + kstep, voffB); PG8_STAGE_A(PG8_SA(1, 0), cA + kstep, 0); PG8_STAGE(PG8_SB(1, 1), cB + hstep + kstep, voffB);
        PG8_WAIT_V(6); PG8_BAR;
    } else {
        PG8_STAGE(PG8_SB(0, 0), cB, voffB); PG8_STAGE_A(PG8_SA(0, 0), cA, 0); PG8_STAGE(PG8_SB(0, 1), cB + hstep, voffB); PG8_STAGE_A(PG8_SA(0, 1), cA, 1);
        if (wr == 1) PG8_BAR;
        PG8_WAIT_V(4); PG8_BAR;
        PG8_STAGE(PG8_SB(1, 0), cB + kstep, voffB); PG8_STAGE_A(PG8_SA(1, 0), cA + kstep, 0); PG8_STAGE(PG8_SB(1, 1), cB + hstep + kstep, voffB);
        PG8_WAIT_V(6); PG8_BAR;
    }
    for (;;) {
        const bool has_next = S.next(ui + 1, nxt);
        const char* nA = has_next ? nxt.a : cA; const char* nB = has_next ? nxt.b : cB;
        for (int t = 0; t < nt; t += 2) {
            const bool last = (t == nt - 2);
            const char* a1 = cA + (size_t)(t + 1) * kstep;
            const char* a2 = last ? nA : cA + (size_t)(t + 2) * kstep; const char* b2 = last ? nB : cB + (size_t)(t + 2) * kstep;
            const char* a3 = a2 + kstep; const char* b3 = b2 + kstep;
            if (last && has_next) S.a_ready(nxt);
            if constexpr (SP2) {
            PG8_LDB(B0, 0, 0); PG8_LDB(B1, 0, 1); PG8_SCHED; PG8_LDA(At, 0, 0); PG8_STAGE_A(PG8_SA(1, 1), a1, 1);
            PG8_WAIT_V(8); PG8_WAIT_L(0); PG8_BAR; PG8_MMA(0, 0, At, B0); PG8_MMA(0, 1, At, B1); PG8_BAR; PG8_SCHED;
            PG8_LDA(At, 0, 1); PG8_STAGE(PG8_SB(0, 0), b2, voffB); PG8_STAGE(PG8_SB(0, 1), b2 + hstep, voffB); PG8_STAGE_A(PG8_SA(0, 0), a2, 0);
            PG8_WAIT_V(8); PG8_WAIT_L(0); PG8_BAR; PG8_MMA(1, 0, At, B0); PG8_MMA(1, 1, At, B1); PG8_BAR; PG8_SCHED;
            PG8_LDB(B0, 1, 0); PG8_LDB(B1, 1, 1); PG8_SCHED; PG8_LDA(At, 1, 0); PG8_STAGE_A(PG8_SA(0, 1), a2, 1);
            PG8_WAIT_V(8); PG8_WAIT_L(0); PG8_BAR; PG8_MMA(0, 0, At, B0); PG8_MMA(0, 1, At, B1); PG8_BAR; PG8_SCHED;
            PG8_LDA(At, 1, 1); PG8_STAGE(PG8_SB(1, 0), b3, voffB); PG8_STAGE(PG8_SB(1, 1), b3 + hstep, voffB); PG8_STAGE_A(PG8_SA(1, 0), a3, 0);
            PG8_WAIT_V(8); PG8_WAIT_L(0); PG8_BAR; PG8_MMA(1, 0, At, B0); PG8_MMA(1, 1, At, B1); PG8_BAR; PG8_SCHED;
            } else {
            PG8_LDB(B0, 0, 0); PG8_SCHED; PG8_LDA(At, 0, 0); PG8_STAGE_A(PG8_SA(1, 1), a1, 1);
            PG8_WAIT_L(8); PG8_BAR; PG8_WAIT_L(0); PG8_MMA(0, 0, At, B0); PG8_BAR; PG8_SCHED;
            PG8_LDB(B1, 0, 1); PG8_STAGE(PG8_SB(0, 0), b2, voffB);
            PG8_BAR; PG8_WAIT_L(0); PG8_MMA(0, 1, At, B1); PG8_BAR;
            PG8_LDA(At, 0, 1); PG8_STAGE_A(PG8_SA(0, 0), a2, 0);
            PG8_BAR; PG8_WAIT_L(0); PG8_MMA(1, 0, At, B0); PG8_BAR; PG8_SCHED;
            PG8_STAGE(PG8_SB(0, 1), b2 + hstep, voffB);
            PG8_WAIT_V(6); PG8_BAR; PG8_MMA(1, 1, At, B1); PG8_BAR;
            PG8_LDB(B0, 1, 0); PG8_SCHED; PG8_LDA(At, 1, 0); PG8_STAGE_A(PG8_SA(0, 1), a2, 1);
            PG8_WAIT_L(8); PG8_BAR; PG8_WAIT_L(0); PG8_MMA(0, 0, At, B0); PG8_BAR; PG8_SCHED;
            PG8_LDB(B1, 1, 1); PG8_STAGE(PG8_SB(1, 0), b3, voffB);
            PG8_BAR; PG8_WAIT_L(0); PG8_MMA(0, 1, At, B1); PG8_BAR;
            PG8_LDA(At, 1, 1); PG8_STAGE_A(PG8_SA(1, 0), a3, 0);
            PG8_BAR; PG8_WAIT_L(0); PG8_MMA(1, 0, At, B0); PG8_BAR; PG8_SCHED;
            PG8_STAGE(PG8_SB(1, 1), b3 + hstep, voffB);
            PG8_WAIT_V(6); PG8_BAR; PG8_MMA(1, 1, At, B1); PG8_BAR;
            }
        }
        if constexpr (ALIGN_EPI) { if (wr == 0) PG8_BAR; }
        if constexpr (!Epi::AFTER_DRAIN) { E(acc, cur, wr, wc, fr, fq); S.done(cur); }
        if (!has_next) break;
#pragma unroll
        for (int a = 0; a < 2; ++a)
#pragma unroll
            for (int b = 0; b < 2; ++b)
#pragma unroll
                for (int m = 0; m < 4; ++m)
#pragma unroll
                    for (int n = 0; n < 2; ++n) acc[a][b][m][n] = (f32x4){0.f, 0.f, 0.f, 0.f};
        cur = nxt; cA = nA; cB = nB; ++ui;
        if constexpr (ALIGN_EPI) { if (wr == 1) PG8_BAR; }
    }
    PG8_WAIT_V(0);
    if constexpr (!ALIGN_EPI) { if (wr == 0) PG8_BAR; }
    PG8_BAR;
    if constexpr (Epi::AFTER_DRAIN) { E.fused(acc, cur, wr, wc, fr, fq, lds, wid, lane); S.done(cur); }
#undef PG8_SA
#undef PG8_SB
#undef PG8_STAGE
#undef PG8_LDA
#undef PG8_LDB
#undef PG8_MMA
#undef PG8_WAIT_V
#undef PG8_WAIT_L
#undef PG8_BAR
#undef PG8_SCHED
}
}
using pg8::Unit; using pg8::tile_of;

__device__ __forceinline__ void ph_prep(const P& p, float* lds) {
    const int tid = opaque_tid(), G = gridDim.x;
    float* ADA = (float*)(p.ws + WS_ADA);
    float* LB = (float*)(p.ws + WS_LB);
    float* HID2 = (float*)(p.ws + WS_HID2);
    {
        float* s = lds;
        float* red = lds + 17 * 1024;
        if (blockIdx.x < 96) {
            for (int i = tid; i < 17 * 1024; i += NT) {
                const int r = i >> 10, d = i & 1023;
                const float cv = r < 16 ? p.c[r * 1024 + d] : p.c_ctx[d];
                s[i] = siluf_(cv);
            }
        }
        __syncthreads();
        for (int item = blockIdx.x; item < 96; item += G) {
            const int jj = tid & 63, ks = tid >> 6, j = item * 64 + jj;
            float acc[17];
#pragma unroll
            for (int r = 0; r < 17; ++r) acc[r] = 0.f;
#pragma unroll 4
            for (int d = ks * 128; d < ks * 128 + 128; ++d) {
                const float w = p.ada_w[(size_t)d * 6144 + j];
#pragma unroll
                for (int r = 0; r < 17; ++r) acc[r] += s[r * 1024 + d] * w;
            }
#pragma unroll
            for (int r = 0; r < 17; ++r) red[(ks * 17 + r) * 64 + jj] = acc[r];
            __syncthreads();
            for (int i = tid; i < 17 * 64; i += NT) {
                const int r = i >> 6, j2 = i & 63;
                float sum = 0.f;
#pragma unroll
                for (int k = 0; k < 8; ++k) sum += red[(k * 17 + r) * 64 + j2];
                ADA[r * 6144 + item * 64 + j2] = sum + p.ada_b[item * 64 + j2];
            }
            __syncthreads();
        }
    }
    if (blockIdx.x == G - 1) {
        for (int i = tid; i < 1024; i += NT) {
            const float a0 = p.hg_lb[i], a1 = p.hg_lb[1024 + i];
            LB[i] = 1.f / (1.f + expf(a1 - a0));
        }
    }
    {
        float* zl = lds;
        float* h1 = lds + 512;
        __syncthreads();
        for (int it = (G - 1 - blockIdx.x); it < SEQ / 8; it += G) {
            const int lt = tid >> 6, j = tid & 63, t = it * 8 + lt;
            const float w = 6.283185307179586f * (float)t / 2048.0f;
            if (j == 0) zl[lt * 64] = (float)t / 2047.0f;
            if (j >= 1 && j < 17) { const float f = 1e-4f + (float)(j - 1) * ((15.0f - 1e-4f) / 15.0f); zl[lt * 64 + j] = cosf(f * w); }
            if (j >= 17 && j < 33) { const float f = 1e-4f + (float)(j - 17) * ((15.0f - 1e-4f) / 15.0f); zl[lt * 64 + j] = -sinf(f * w); }
            __syncthreads();
            float a = p.pos_b1[j];
            for (int i = 0; i < 33; ++i) a += zl[lt * 64 + i] * p.pos_w1[i * 64 + j];
            h1[lt * 64 + j] = sinf(p.freq1[j] * a);
            __syncthreads();
            float b = p.pos_b2[j];
            for (int i = 0; i < 64; ++i) b += h1[lt * 64 + i] * p.pos_w2[i * 64 + j];
            HID2[t * 64 + j] = sinf(p.freq2[j] * b);
            __syncthreads();
        }
    }
}
__device__ __forceinline__ void conv_item(const float* W, int N, int k0, int n0, bf16_t* dst, int KD, float* scr, int lane) {
#pragma unroll 8
    for (int i = 0; i < 32; ++i) { const int kk = 2 * i + (lane >> 5); scr[kk * 33 + (lane & 31)] = W[(size_t)(k0 + kk) * N + n0 + (lane & 31)]; }
    asm volatile("s_waitcnt lgkmcnt(0)" ::: "memory");
    const int c = lane & 7;
#pragma unroll
    for (int j = 0; j < 4; ++j) { const int n = (lane >> 3) + 8 * j; const float* s = scr + (8 * c) * 33 + n;
        uint4 o; o.x = pk2(s[0 * 33], s[1 * 33]); o.y = pk2(s[2 * 33], s[3 * 33]); o.z = pk2(s[4 * 33], s[5 * 33]); o.w = pk2(s[6 * 33], s[7 * 33]);
        *(uint4*)(dst + (size_t)n * KD + k0 + 8 * c) = o; }
    asm volatile("s_waitcnt lgkmcnt(0)" ::: "memory");
}
__device__ __forceinline__ void ph_convert(const P& p, float* lds) {
    const int tid = opaque_tid(), lane = tid & 63, wv = tid >> 6;
    float* scr = lds + wv * (64 * 33);
    bf16_t* WinT = (bf16_t*)((unsigned char*)p.out + DO_WINT);
    bf16_t* WoutT = (bf16_t*)(p.ws + WS_WOUTT);
    bf16_t* W13T = (bf16_t*)(p.ws + WS_W13T);
    bf16_t* W2T = (bf16_t*)(p.ws + WS_W2T);
    constexpr int I_IN = 16 * 128, I_OUT = 16 * 32, I_W1 = 16 * 16 * 64, I_W2 = 16 * 32 * 32;
    constexpr int NITEMS = I_IN + I_OUT + 2 * I_W1 + I_W2;
    __syncthreads();
    for (int it = blockIdx.x * 8 + wv; it < NITEMS; it += gridDim.x * 8) {
        int r = it;
        if (r < I_IN) { const int kb = r / 128, nb = r % 128; conv_item(p.w_in, INC, kb * 64, nb * 32, WinT + (size_t)(nb * 32) * D, D, scr, lane); continue; }
        r -= I_IN;
        if (r < I_OUT) { const int kb = r / 32, nb = r % 32; conv_item(p.w_out, D, kb * 64, nb * 32, WoutT + (size_t)(nb * 32) * D, D, scr, lane); continue; }
        r -= I_OUT;
        if (r < 2 * I_W1) {
            const int which = r / I_W1; r %= I_W1;
            const int e = r / 1024, r2 = r % 1024, kb = r2 / 64, nb = r2 % 64, n0 = nb * 32;
            const float* W = (which == 0 ? p.exp_w1 : p.exp_w3) + (size_t)e * D * FF;
            const int row = (n0 >> 7) * 256 + which * 128 + (n0 & 127);
            conv_item(W, FF, kb * 64, n0, W13T + ((size_t)e * 4096 + row) * D, D, scr, lane); continue;
        }
        r -= 2 * I_W1;
        { const int e = r / 1024, r2 = r % 1024, kb = r2 / 32, nb = r2 % 32;
          conv_item(p.exp_w2 + (size_t)e * FF * D, D, kb * 64, nb * 32, W2T + ((size_t)e * 1024 + nb * 32) * FF, FF, scr, lane); }
    }
}

__device__ __forceinline__ void ph_norm1(const P& p) {
    const int tid = opaque_tid(), lane = tid & 63, wv = tid >> 6, G = gridDim.x;
    const float* ADA = (const float*)(p.ws + WS_ADA);
    bf16_t* H = (bf16_t*)(p.ws + WS_H);
    bf16_t* HC = (bf16_t*)(p.ws + WS_HC);
    const int gw = blockIdx.x * 8 + wv, NGW = G * 8;
    for (int r = gw; r < NTOK + NCTX; r += NGW) {
        const float* src; bf16_t* dst; int ar;
        if (r < NTOK) { src = p.x + (size_t)r * D; dst = H + (size_t)r * D; ar = r / SEQ; }
        else { const int rc = r - NTOK; src = p.ctx + (size_t)rc * D; dst = HC + (size_t)rc * D; ar = 16; }
        float4 v[4]; float ss = 0.f;
#pragma unroll
        for (int j = 0; j < 4; ++j) { v[j] = ((const float4*)src)[lane + 64 * j]; ss += v[j].x * v[j].x + v[j].y * v[j].y + v[j].z * v[j].z + v[j].w * v[j].w; }
        ss = wave_sum(ss);
        const float rstd = rsqrtf(ss * (1.f / D) + EPS);
        const float* sh = ADA + ar * 6144, *sc = sh + 1024;
#pragma unroll
        for (int j = 0; j < 4; ++j) {
            const int d4 = lane + 64 * j;
            const float4 g = ((const float4*)p.norm1_g)[d4], s1 = ((const float4*)sc)[d4], h1 = ((const float4*)sh)[d4];
            float4 o;
            o.x = v[j].x * rstd * g.x * (1.f + s1.x) + h1.x; o.y = v[j].y * rstd * g.y * (1.f + s1.y) + h1.y;
            o.z = v[j].z * rstd * g.z * (1.f + s1.z) + h1.z; o.w = v[j].w * rstd * g.w * (1.f + s1.w) + h1.w;
            ((uint2*)dst)[d4] = make_uint2(pk2(o.x, o.y), pk2(o.z, o.w));
        }
    }
}
__device__ __forceinline__ void ph_filter(const P& p, float* lds) {
    const int tid = opaque_tid(), G = gridDim.x;
    const float* HID2 = (const float*)(p.ws + WS_HID2);
    float* HF = (float*)((unsigned char*)p.out + DO_HF);
    float* w3c = lds;
    float* red = lds + 128;
    const float min_decay = logf(1e-2f) / 1.5f, max_decay = logf(1e-2f) / 0.3f;
    __syncthreads();
    for (int item = blockIdx.x; item < 1024; item += G) {
        const int o = item >> 9, c = item & 511;
        if (tid < 128) { const int dir = tid >> 6, i = tid & 63; w3c[tid] = p.pos_w3[i * 2048 + o * 1024 + dir * 512 + c]; }
        __syncthreads();
        const float delta = fabsf(min_decay + (float)c * ((max_decay - min_decay) / 511.0f));
        float hv[4][2]; float asum = 0.f;
#pragma unroll
        for (int j = 0; j < 4; ++j) {
            const int t = tid + NT * j;
            float r0 = 0.f, r1 = 0.f;
            const float4* hp = (const float4*)(HID2 + t * 64);
#pragma unroll 4
            for (int i4 = 0; i4 < 16; ++i4) {
                const float4 h = hp[i4];
                r0 += h.x * w3c[i4 * 4 + 0] + h.y * w3c[i4 * 4 + 1] + h.z * w3c[i4 * 4 + 2] + h.w * w3c[i4 * 4 + 3];
                r1 += h.x * w3c[64 + i4 * 4 + 0] + h.y * w3c[64 + i4 * 4 + 1] + h.z * w3c[64 + i4 * 4 + 2] + h.w * w3c[64 + i4 * 4 + 3];
            }
            const float win = expf(-((float)t / 2047.0f) * delta) + 0.05f;
            hv[j][0] = r0 * win; hv[j][1] = r1 * win;
            asum += fabsf(hv[j][0]) + (t >= 1 ? fabsf(hv[j][1]) : 0.f);
        }
        asum = wave_sum(asum);
        if ((tid & 63) == 0) red[tid >> 6] = asum;
        __syncthreads();
        float tot = 0.f;
#pragma unroll
        for (int k = 0; k < 8; ++k) tot += red[k];
        const float inv = 1.f / (tot + EPS);
        float* dst = HF + (size_t)item * 4096;
#pragma unroll
        for (int j = 0; j < 4; ++j) {
            const int t = tid + NT * j;
            dst[2047 + t] = hv[j][0] * inv;
            if (t >= 1) dst[2047 - t] = hv[j][1] * inv;
        }
        if (tid == 0) dst[4095] = 0.f;
        __syncthreads();
    }
}

struct InprojSched {
    int G, c; const bf16_t *WinT, *H, *HC; bf16_t *PHYT, *PHG, *PC;
    __device__ __forceinline__ bool next(int i, Unit& u) const {
        int L = i * G + c; int pm, pn;
        u.aux = nullptr; u.gidx = nullptr; u.row0 = 0; u.col0 = 0;
        if (L < 768) { tile_of(L, 6, 128, pm, pn); u.a = (const char*)(WinT + (size_t)pm * 256 * D); u.b = (const char*)(H + (size_t)pn * 256 * D); u.c = PHYT + (size_t)pm * 256 * NTOK + pn * 256; u.ldc = NTOK; return true; }
        L -= 768;
        if (L < 1280) { tile_of(L, 128, 10, pm, pn); u.a = (const char*)(H + (size_t)pm * 256 * D); u.b = (const char*)(WinT + (size_t)(1536 + pn * 256) * D); u.c = PHG + (size_t)pm * 256 * 2560 + pn * 256; u.ldc = 2560; return true; }
        L -= 1280;
        if (L < 96) { tile_of(L, 16, 6, pm, pn); u.a = (const char*)(HC + (size_t)pm * 256 * D); u.b = (const char*)(WinT + (size_t)(2048 + pn * 256) * D); u.c = PC + (size_t)pm * 256 * 1536 + pn * 256; u.ldc = 1536; return true; }
        return false;
    }
    __device__ __forceinline__ void a_ready(const Unit&) const {}
    __device__ __forceinline__ void done(const Unit&) const {}
};
__device__ __forceinline__ void ph_inproj(const P& p, unsigned char* lds) {
    InprojSched S{(int)gridDim.x, (int)blockIdx.x, (const bf16_t*)((unsigned char*)p.out + DO_WINT), (const bf16_t*)(p.ws + WS_H), (const bf16_t*)(p.ws + WS_HC),
                  (bf16_t*)((unsigned char*)p.out + DO_PHYT), (bf16_t*)(p.ws + WS_PHG), (bf16_t*)(p.ws + WS_PC)};
    pg8::EpiStoreBf16 E;
    pg8::gemm_phase<pg8::EpiStoreBf16, InprojSched, true, true, false>((PG8_LAS unsigned char*)lds, D, S, E);
}

namespace hy {
#define HY_LAS __attribute__((address_space(3)))
typedef short bf16x8 __attribute__((ext_vector_type(8)));
typedef float f32x4 __attribute__((ext_vector_type(4)));
typedef unsigned u32x4 __attribute__((ext_vector_type(4)));
typedef unsigned u32x2 __attribute__((ext_vector_type(2)));
constexpr int U_STRIDE = 4112, UIMG = 0, U_BYTES = 16 * U_STRIDE;
constexpr int FILT = U_BYTES, F_STRIDE = 8288, F_BYTES = 8 * F_STRIDE;
constexpr int SCR = FILT + F_BYTES;
static_assert(SCR + 8192 <= LDS_BYTES, "hyena LDS map");

__device__ __forceinline__ float uni(float v) { return __uint_as_float(__builtin_amdgcn_readfirstlane(__float_as_uint(v))); }
struct ConvW { float w0, w1, w2, b; };
__device__ __forceinline__ ConvW load_convw(const P& p, int ch) { ConvW c; c.w0 = uni(p.hy_conv_w[ch]); c.w1 = uni(p.hy_conv_w[1536 + ch]); c.w2 = uni(p.hy_conv_w[3072 + ch]); c.b = uni(p.hy_conv_b[ch]); return c; }
__device__ __forceinline__ void load_u_image(const ConvW cw, HY_LAS unsigned char* L, const bf16_t* row, int tid) {
    const float cw0 = cw.w0, cw1 = cw.w1, cw2 = cw.w2, cb = cw.b;
#pragma unroll 2
    for (int k = 0; k < 8; ++k) {
        const int idx = tid + NT * k, b = idx >> 8, t8 = (idx & 255) * 8;
        const bf16_t* src = row + b * SEQ + t8;
        const u32x4 raw = *(const u32x4*)src;
        float x[10];
        x[0] = (t8 & 63) ? bf2f(src[-1]) : 0.f;
        x[9] = ((t8 + 8) & 63) ? bf2f(src[8]) : 0.f;
        x[1] = __uint_as_float(raw.x << 16); x[2] = __uint_as_float(raw.x & 0xffff0000u); x[3] = __uint_as_float(raw.y << 16); x[4] = __uint_as_float(raw.y & 0xffff0000u);
        x[5] = __uint_as_float(raw.z << 16); x[6] = __uint_as_float(raw.z & 0xffff0000u); x[7] = __uint_as_float(raw.w << 16); x[8] = __uint_as_float(raw.w & 0xffff0000u);
        float o[8];
#pragma unroll
        for (int e = 0; e < 8; ++e) o[e] = cb + cw1 * x[e + 1] + cw0 * x[e] + cw2 * x[e + 2];
        *(HY_LAS u32x4*)(L + UIMG + b * U_STRIDE + t8 * 2) = (u32x4){pk2(o[0], o[1]), pk2(o[2], o[3]), pk2(o[4], o[5]), pk2(o[6], o[7])};
    }
}
__device__ __forceinline__ void stage_raw_rows(HY_LAS unsigned char* L, const bf16_t* row, int tid) {
#pragma unroll 2
    for (int k = 0; k < 8; ++k) {
        const int idx = tid + NT * k, b = idx >> 8, t8 = (idx & 255) * 8;
        const u32x4 raw = *(const u32x4*)(row + b * SEQ + t8);
        HY_LAS unsigned char* d = L + FILT + b * U_STRIDE + 8 + t8 * 2;
        *(HY_LAS u32x2*)d = (u32x2){raw.x, raw.y}; *(HY_LAS u32x2*)(d + 8) = (u32x2){raw.z, raw.w};
    }
}
__device__ __forceinline__ void load_filter_scr(HY_LAS unsigned char* L, const float* hf, int tid) {
    const float4 a = ((const float4*)hf)[tid * 2], b = ((const float4*)hf)[tid * 2 + 1];
    *(HY_LAS u32x4*)(L + SCR + tid * 16) = (u32x4){pk2(a.x, a.y), pk2(a.z, a.w), pk2(b.x, b.y), pk2(b.z, b.w)};
}
__device__ __forceinline__ void build_filter_copies(HY_LAS unsigned char* L, int tid) {
    const HY_LAS bf16_t* sc = (const HY_LAS bf16_t*)(L + SCR);
    for (int gi = tid; gi < 8 * 518; gi += NT) {
        const int d = gi / 518, qg = gi - d * 518;
        const int top = 4095 + d - 8 * qg;
        unsigned v[8];
#pragma unroll
        for (int e = 0; e < 8; ++e) { const int ix = top - e; v[e] = (ix >= 0 && ix <= 4094) ? (unsigned)sc[ix] : 0u; }
        *(HY_LAS u32x4*)(L + FILT + d * F_STRIDE + qg * 16) = (u32x4){v[0] | (v[1] << 16), v[2] | (v[3] << 16), v[4] | (v[5] << 16), v[6] | (v[7] << 16)};
    }
}
__device__ __forceinline__ void conv_loop(HY_LAS unsigned char* L, f32x4 (&acc)[16], int w, int lane) {
    const int i = lane & 15, g = lane >> 4;
    const HY_LAS unsigned char* aBase = L + FILT + (i & 7) * F_STRIDE + 2 * (2048 + 8 * g - (i & ~7)) - 32 * (16 * w);
    const HY_LAS unsigned char* bBase = L + UIMG + i * U_STRIDE + 16 * g;
    bf16x8 ring[16];
#pragma unroll
    for (int s = 0; s < 16; ++s) ring[s] = *(const HY_LAS bf16x8*)(aBase - 32 * s);
#pragma unroll
    for (int m = 0; m < 16; ++m) acc[m] = (f32x4){0.f, 0.f, 0.f, 0.f};
    bf16x8 bfrag = *(const HY_LAS bf16x8*)(bBase);
    for (int k8 = 0; k8 < 8; ++k8) {
        const HY_LAS unsigned char* aK = aBase + 512 * k8;
        const HY_LAS unsigned char* bK = bBase + 512 * k8;
#pragma unroll
        for (int u = 0; u < 8; ++u) {
            bf16x8 bnext = bfrag;
            if (u < 7 || k8 < 7) bnext = *(const HY_LAS bf16x8*)(bK + 64 * (u + 1));
            acc[14] = __builtin_amdgcn_mfma_f32_16x16x32_bf16(ring[(14 - 2 * u) & 15], bfrag, acc[14], 0, 0, 0);
            acc[15] = __builtin_amdgcn_mfma_f32_16x16x32_bf16(ring[(15 - 2 * u) & 15], bfrag, acc[15], 0, 0, 0);
            if (u < 7 || k8 < 7) {
                ring[(14 - 2 * u) & 15] = *(const HY_LAS bf16x8*)(aK + 64 * u + 64);
                ring[(15 - 2 * u) & 15] = *(const HY_LAS bf16x8*)(aK + 64 * u + 32);
            }
#pragma unroll
            for (int m = 0; m < 14; ++m) acc[m] = __builtin_amdgcn_mfma_f32_16x16x32_bf16(ring[(m - 2 * u) & 15], bfrag, acc[m], 0, 0, 0);
            bfrag = bnext;
            __builtin_amdgcn_sched_barrier(0);
        }
    }
}
__device__ __forceinline__ void gate_acc(const ConvW cw, HY_LAS unsigned char* L, f32x4 (&acc)[16], float bias, int w, int lane) {
    const int j = lane & 15, g = lane >> 4;
    const float cw0 = cw.w0, cw1 = cw.w1, cw2 = cw.w2, cb = cw.b;
#pragma unroll
    for (int m = 0; m < 16; ++m) {
        const int t4 = 256 * w + 16 * m + 4 * g, tt0 = t4 & 63;
        const u32x2 uu = *(const HY_LAS u32x2*)(L + UIMG + j * U_STRIDE + t4 * 2);
        const HY_LAS unsigned char* xb = L + FILT + j * U_STRIDE + 8 + t4 * 2;
        const u32x2 xx = *(const HY_LAS u32x2*)xb;
        const float xl = tt0 > 0 ? bf2f(*(const HY_LAS bf16_t*)(xb - 2)) : 0.f;
        const float xr = tt0 < 60 ? bf2f(*(const HY_LAS bf16_t*)(xb + 8)) : 0.f;
        const float x0 = __uint_as_float(xx.x << 16), x1 = __uint_as_float(xx.x & 0xffff0000u), x2 = __uint_as_float(xx.y << 16), x3 = __uint_as_float(xx.y & 0xffff0000u);
        const float u0 = __uint_as_float(uu.x << 16), u1 = __uint_as_float(uu.x & 0xffff0000u), u2 = __uint_as_float(uu.y << 16), u3 = __uint_as_float(uu.y & 0xffff0000u);
        const float g0 = cb + cw1 * x0 + cw0 * xl + cw2 * x1, g1 = cb + cw1 * x1 + cw0 * x0 + cw2 * x2, g2 = cb + cw1 * x2 + cw0 * x1 + cw2 * x3, g3 = cb + cw1 * x3 + cw0 * x2 + cw2 * xr;
        acc[m][0] = g0 * (acc[m][0] + bias * u0); acc[m][1] = g1 * (acc[m][1] + bias * u1); acc[m][2] = g2 * (acc[m][2] + bias * u2); acc[m][3] = g3 * (acc[m][3] + bias * u3);
        if ((m & 3) == 3) __builtin_amdgcn_sched_barrier(0);
    }
}
__device__ __forceinline__ void store_acc_uimg(HY_LAS unsigned char* L, const f32x4 (&acc)[16], int w, int lane) {
    const int j = lane & 15, g = lane >> 4;
#pragma unroll
    for (int m = 0; m < 16; ++m) {
        const int t4 = 256 * w + 16 * m + 4 * g;
        *(HY_LAS u32x2*)(L + UIMG + j * U_STRIDE + t4 * 2) = (u32x2){pk2(acc[m][0], acc[m][1]), pk2(acc[m][2], acc[m][3])};
    }
}
}

__device__ __forceinline__ void ph_hyena_task(const P& p, unsigned char* ldsb, int c) {
    const int w = __builtin_amdgcn_readfirstlane(threadIdx.x >> 6);
    bf16_t* PHYT = (bf16_t*)((unsigned char*)p.out + DO_PHYT);
    const float* HF = (const float*)((unsigned char*)p.out + DO_HF);
    HY_LAS unsigned char* L = (HY_LAS unsigned char*)ldsb;
    {
        const int tid = opaque_tid();
        const int lane = tid & 63;
        hy::f32x4 acc[16];
        const hy::ConvW cwv = hy::load_convw(p, c), cwx1 = hy::load_convw(p, 512 + c), cwx2 = hy::load_convw(p, 1024 + c);
        const float bias0 = hy::uni(p.hy_bias[c]), bias1 = hy::uni(p.hy_bias[512 + c]);
        __syncthreads();
        hy::load_u_image(cwv, L, PHYT + (size_t)c * NTOK, tid);
        hy::load_filter_scr(L, HF + (size_t)c * 4096, tid);
        __syncthreads();
        hy::build_filter_copies(L, tid);
        __syncthreads();
        hy::conv_loop(L, acc, w, lane);
        __syncthreads();
        hy::stage_raw_rows(L, PHYT + (size_t)(512 + c) * NTOK, tid);
        hy::load_filter_scr(L, HF + (size_t)(512 + c) * 4096, tid);
        __syncthreads();
        hy::gate_acc(cwx1, L, acc, bias0, w, lane);
        __syncthreads();
        hy::store_acc_uimg(L, acc, w, lane);
        hy::build_filter_copies(L, tid);
        __syncthreads();
        hy::conv_loop(L, acc, w, lane);
        __syncthreads();
        hy::stage_raw_rows(L, PHYT + (size_t)(1024 + c) * NTOK, tid);
        __syncthreads();
        hy::gate_acc(cwx2, L, acc, bias1, w, lane);
        hy::store_acc_uimg(L, acc, w, lane);
        __syncthreads();
#pragma unroll 2
        for (int k = 0; k < 8; ++k) {
            const int idx = tid + NT * k, b = idx >> 8, t8 = (idx & 255) * 8;
            *(hy::u32x4*)(PHYT + (size_t)c * NTOK + b * SEQ + t8) = *(const HY_LAS hy::u32x4*)(L + hy::UIMG + b * hy::U_STRIDE + t8 * 2);
        }
    }
}


namespace hg {
#define HG_LAS __attribute__((address_space(3)))
typedef short bf16x8 __attribute__((ext_vector_type(8)));
typedef float f32x4 __attribute__((ext_vector_type(4)));
typedef unsigned u32x4 __attribute__((ext_vector_type(4)));
typedef unsigned u32x2 __attribute__((ext_vector_type(2)));
constexpr int QROW = 272, KROW = 40;
constexpr int O_QT = 0, O_KBAR = 16 * QROW, O_KHAT = 2 * 16 * QROW, O_VT = O_KHAT + 128 * KROW, O_BDEC = O_VT + 128 * KROW, SET_BYTES = O_BDEC + 512;
constexpr int NCH_CTX = CTXL / 16, NCH = NCH_CTX + SEQ / 16;
template <int CTRL> __device__ __forceinline__ float dpp_mul(float x) {
    return x * __uint_as_float(__builtin_amdgcn_update_dpp(0x3f800000u, __float_as_uint(x), CTRL, 0xf, 0xf, false));
}
struct Raw { unsigned short q[4], v[4], z[4]; };
}

__device__ __forceinline__ void ph_hgrn_task(const P& p, unsigned char* ldsb, int item) {
    using namespace hg;
    const int tid = opaque_tid();
    const int lane = tid & 63, w = __builtin_amdgcn_readfirstlane(tid >> 6), j = lane & 15, g = lane >> 4;
    const int dir = item & 1, h = (item >> 1) & 3, b = item >> 3;
    const float* LB = (const float*)(p.ws + WS_LB);
    const bf16_t* PC = (const bf16_t*)(p.ws + WS_PC);
    const bf16_t* PHG = (const bf16_t*)(p.ws + WS_PHG);
    bf16_t* OFB = (bf16_t*)(p.ws + WS_OFB) + (size_t)dir * NTOK * 512;
    HG_LAS unsigned char* L = (HG_LAS unsigned char*)ldsb;
    float lbv[4];
#pragma unroll
    for (int pp = 0; pp < 4; ++pp) lbv[pp] = LB[dir * 512 + h * 128 + 16 * w + 4 * pp + g];
    auto load_raw = [&](int n, Raw& r) {
        if (n < NCH_CTX) {
            const int tt = 16 * n + j, t = dir == 0 ? tt : (CTXL - 1 - tt);
            const bf16_t* row = PC + ((size_t)b * CTXL + t) * 1536 + h * 128 + 16 * w + g;
#pragma unroll
            for (int pp = 0; pp < 4; ++pp) { r.q[pp] = 0; r.v[pp] = row[4 * pp]; r.z[pp] = row[(dir == 0 ? 512 : 1024) + 4 * pp]; }
        } else {
            const int tt = 16 * (n - NCH_CTX) + j, t = dir == 0 ? tt : (SEQ - 1 - tt);
            const bf16_t* row = PHG + ((size_t)b * SEQ + t) * 2560 + h * 128 + 16 * w + g;
#pragma unroll
            for (int pp = 0; pp < 4; ++pp) { r.q[pp] = row[4 * pp]; r.v[pp] = row[512 + 4 * pp]; r.z[pp] = row[(dir == 0 ? 1024 : 1536) + 4 * pp]; }
        }
    };
    auto prep = [&](const Raw& r, HG_LAS unsigned char* S0) {
#pragma unroll
        for (int pp = 0; pp < 4; ++pp) {
            const int k = 16 * w + 4 * pp + g;
            const float z = bf2f(r.z[pp]), qr = bf2f(r.q[pp]);
            const float sg = __builtin_amdgcn_rcpf(1.0f + __builtin_amdgcn_exp2f(-1.4426950408889634f * z));
            const float f = lbv[pp] + (1.0f - lbv[pp]) * sg;
            float P = dpp_mul<0x111>(f); P = dpp_mul<0x112>(P); P = dpp_mul<0x114>(P); P = dpp_mul<0x118>(P);
            const float PC15 = __uint_as_float(__builtin_amdgcn_ds_bpermute(4 * (lane | 15), __float_as_uint(P)));
            const float invP = __builtin_amdgcn_rcpf(fmaxf(P, 1e-30f));
            const float kk = 1.0f - f;
            const float qv = qr * __builtin_amdgcn_rcpf(1.0f + __builtin_amdgcn_exp2f(-1.4426950408889634f * qr)) * 0.08838834764831845f * P;
            *(HG_LAS bf16_t*)(S0 + O_QT + j * QROW + 2 * k) = (bf16_t)f2bf(qv);
            *(HG_LAS bf16_t*)(S0 + O_KBAR + j * QROW + 2 * k) = (bf16_t)f2bf(kk * invP);
            *(HG_LAS bf16_t*)(S0 + O_KHAT + k * KROW + 2 * j) = (bf16_t)f2bf(kk * (PC15 * invP));
            *(HG_LAS bf16_t*)(S0 + O_VT + k * KROW + 2 * j) = r.v[pp];
            if (j == 15) *(HG_LAS float*)(S0 + O_BDEC + 4 * k) = P;
        }
    };
    f32x4 S[8];
#pragma unroll
    for (int t = 0; t < 8; ++t) S[t] = (f32x4){0.f, 0.f, 0.f, 0.f};
    Raw rcur, rnext;
    load_raw(0, rcur);
    __syncthreads();
    prep(rcur, L);
    load_raw(1, rcur);
    __syncthreads();
    for (int n = 0; n < NCH; ++n) {
        HG_LAS unsigned char* Sc = L + (n & 1) * SET_BYTES;
        HG_LAS unsigned char* Sn = L + ((n + 1) & 1) * SET_BYTES;
        if (n + 2 < NCH) load_raw(n + 2, rnext);
        if (n + 1 < NCH) prep(rcur, Sn);
        f32x4 sc = (f32x4){0.f, 0.f, 0.f, 0.f};
#pragma unroll
        for (int kp = 0; kp < 4; ++kp) {
            const bf16x8 a = *(const HG_LAS bf16x8*)(Sc + O_KBAR + j * QROW + 2 * (8 * g + 32 * kp));
            const bf16x8 bq = *(const HG_LAS bf16x8*)(Sc + O_QT + j * QROW + 2 * (8 * g + 32 * kp));
            sc = __builtin_amdgcn_mfma_f32_16x16x32_bf16(a, bq, sc, 0, 0, 0);
        }
        u32x4 pf;
        pf.x = pk2((4 * g + 0) <= j ? sc[0] : 0.f, (4 * g + 1) <= j ? sc[1] : 0.f);
        pf.y = pk2((4 * g + 2) <= j ? sc[2] : 0.f, (4 * g + 3) <= j ? sc[3] : 0.f);
        pf.z = 0u; pf.w = 0u;
        const u32x2 vraw = *(const HG_LAS u32x2*)(Sc + O_VT + (16 * w + j) * KROW + 8 * g);
        const u32x4 vf = (u32x4){vraw.x, vraw.y, 0u, 0u};
        f32x4 oT = (f32x4){0.f, 0.f, 0.f, 0.f};
#pragma unroll
        for (int pq = 0; pq < 4; ++pq) {
            u32x4 a; a.x = pk2(S[2 * pq][0], S[2 * pq][1]); a.y = pk2(S[2 * pq][2], S[2 * pq][3]); a.z = pk2(S[2 * pq + 1][0], S[2 * pq + 1][1]); a.w = pk2(S[2 * pq + 1][2], S[2 * pq + 1][3]);
            const u32x2 b0 = *(const HG_LAS u32x2*)(Sc + O_QT + j * QROW + 2 * (32 * pq + 4 * g));
            const u32x2 b1 = *(const HG_LAS u32x2*)(Sc + O_QT + j * QROW + 2 * (32 * pq + 16 + 4 * g));
            const u32x4 bb = (u32x4){b0.x, b0.y, b1.x, b1.y};
            oT = __builtin_amdgcn_mfma_f32_16x16x32_bf16(__builtin_bit_cast(bf16x8, a), __builtin_bit_cast(bf16x8, bb), oT, 0, 0, 0);
        }
        oT = __builtin_amdgcn_mfma_f32_16x16x32_bf16(__builtin_bit_cast(bf16x8, vf), __builtin_bit_cast(bf16x8, pf), oT, 0, 0, 0);
        if (n >= NCH_CTX) {
            const int tt = 16 * (n - NCH_CTX) + j, t = dir == 0 ? tt : (SEQ - 1 - tt);
            *(u32x2*)(OFB + ((size_t)b * SEQ + t) * 512 + h * 128 + 16 * w + 4 * g) = (u32x2){pk2(oT[0], oT[1]), pk2(oT[2], oT[3])};
        }
#pragma unroll
        for (int t = 0; t < 8; ++t) {
            const f32x4 bd = *(const HG_LAS f32x4*)(Sc + O_BDEC + 4 * (16 * t + 4 * g));
            const u32x2 kr = *(const HG_LAS u32x2*)(Sc + O_KHAT + (16 * t + j) * KROW + 8 * g);
            const u32x4 ka = (u32x4){kr.x, kr.y, 0u, 0u};
            S[t] = __builtin_amdgcn_mfma_f32_16x16x32_bf16(__builtin_bit_cast(bf16x8, ka), __builtin_bit_cast(bf16x8, vf), S[t] * bd, 0, 0, 0);
        }
        rcur = rnext;
        __syncthreads();
    }
}

__device__ __forceinline__ void ph_mixers(const P& p, unsigned char* ldsb) {
    unsigned* qhead = (unsigned*)(p.ws + WS_CTL) + CW_QHEAD;
    HG_LAS unsigned* bc = (HG_LAS unsigned*)(ldsb + LDS_BYTES - 16);
    if (blockIdx.x < NB * HEADS * 2) ph_hgrn_task(p, ldsb, blockIdx.x);
    for (;;) {
        __syncthreads();
        if (threadIdx.x == 0) *bc = atomicAdd(qhead, 1u);
        __syncthreads();
        const int c = (int)*bc;
        if (c >= 512) break;
        ph_hyena_task(p, ldsb, c);
    }
}

__device__ __forceinline__ void ph_mixprep(const P& p, float* lds) {
    const int tid = opaque_tid(), lane = tid & 63, wv = tid >> 6;
    const bf16_t* YT = (const bf16_t*)((unsigned char*)p.out + DO_PHYT);
    bf16_t* MIXA = (bf16_t*)(p.ws + WS_MIXA);
    bf16_t* yl = (bf16_t*)lds;
    float* part = lds + (512 * 72 * 2) / 4;
    for (int tile = blockIdx.x; tile < NTOK / 64; tile += gridDim.x) {
        const int tok0 = tile * 64;
        __syncthreads();
        for (int i = tid; i < 512 * 8; i += NT) { const int row = i >> 3, ch = i & 7; *(uint4*)(yl + row * 72 + ch * 8) = *(const uint4*)(YT + (size_t)row * NTOK + tok0 + ch * 8); }
        __syncthreads();
        const int tok = tid & 63, pt = tid >> 6;
        float ss = 0.f;
        for (int c = pt * 64; c < pt * 64 + 64; ++c) { const float v = bf2f(yl[c * 72 + tok]); ss += v * v; }
        part[pt * 64 + tok] = ss;
        __syncthreads();
        float tot = 0.f;
#pragma unroll
        for (int k = 0; k < 8; ++k) tot += part[k * 64 + tok];
        const float rstd = rsqrtf(tot * (1.f / 512.f) + EPS);
        bf16_t* dst = MIXA + (size_t)(tok0 + tok) * D + pt * 64;
#pragma unroll
        for (int j = 0; j < 8; ++j) {
            float o[8];
#pragma unroll
            for (int q = 0; q < 8; ++q) { const int c = pt * 64 + j * 8 + q; o[q] = bf2f(yl[c * 72 + tok]) * rstd * p.hy_norm_g[c]; }
            *(uint4*)(dst + j * 8) = make_uint4(pk2(o[0], o[1]), pk2(o[2], o[3]), pk2(o[4], o[5]), pk2(o[6], o[7]));
        }
    }
    const bf16_t* OFB = (const bf16_t*)(p.ws + WS_OFB);
    const bf16_t* PHG = (const bf16_t*)(p.ws + WS_PHG);
    for (int r = blockIdx.x * 8 + wv; r < NTOK; r += gridDim.x * 8) {
#pragma unroll
        for (int h = 0; h < HEADS; ++h) {
            const int k = lane * 2;
            const unsigned a = *(const unsigned*)(OFB + (size_t)r * 512 + h * 128 + k);
            const unsigned bq = *(const unsigned*)(OFB + (size_t)NTOK * 512 + (size_t)r * 512 + h * 128 + k);
            const float o0 = __uint_as_float(a << 16) + __uint_as_float(bq << 16), o1 = __uint_as_float(a & 0xffff0000u) + __uint_as_float(bq & 0xffff0000u);
            const float ss = wave_sum(o0 * o0 + o1 * o1);
            const float rstd = rsqrtf(ss * (1.f / 128.f) + EPS);
            const unsigned g = *(const unsigned*)(PHG + (size_t)r * 2560 + 2048 + h * 128 + k);
            const float2 ng = *(const float2*)(p.hg_norm_g + k);
            *(unsigned*)(MIXA + (size_t)r * D + 512 + h * 128 + k) = pk2(o0 * rstd * ng.x * siluf_(__uint_as_float(g << 16)), o1 * rstd * ng.y * siluf_(__uint_as_float(g & 0xffff0000u)));
        }
    }
}

struct OutprojSched {
    int G, c; const bf16_t *A, *Bt;
    __device__ __forceinline__ bool next(int i, Unit& u) const {
        const int L = i * G + c; if (L >= 512) return false; int pm, pn; tile_of(L, 128, 4, pm, pn);
        u.a = (const char*)(A + (size_t)pm * 256 * D); u.b = (const char*)(Bt + (size_t)pn * 256 * D); u.c = nullptr; u.aux = nullptr; u.gidx = nullptr; u.ldc = D; u.row0 = pm * 256; u.col0 = pn * 256; return true;
    }
    __device__ __forceinline__ void a_ready(const Unit&) const {}
    __device__ __forceinline__ void done(const Unit&) const {}
};
__device__ __forceinline__ void ph_outproj(const P& p, unsigned char* lds) {
    OutprojSched S{(int)gridDim.x, (int)blockIdx.x, (const bf16_t*)(p.ws + WS_MIXA), (const bf16_t*)(p.ws + WS_WOUTT)};
    pg8::EpiOutProj E{p.x, (const float*)(p.ws + WS_ADA), p.out};
    pg8::gemm_phase<pg8::EpiOutProj, OutprojSched, true, true, false>((PG8_LAS unsigned char*)lds, D, S, E);
}

__device__ __forceinline__ void ph_norm2_router(const P& p) {
    const int tid = opaque_tid(), lane = tid & 63, wv = tid >> 6;
    const float* ADA = (const float*)(p.ws + WS_ADA);
    const float* X1 = p.out;
    bf16_t* H2 = (bf16_t*)(p.ws + WS_H2);
    float* AFF = (float*)(p.ws + WS_AFF);
    for (int r = blockIdx.x * 8 + wv; r < NTOK; r += gridDim.x * 8) {
        const int b = r / SEQ, t = r % SEQ;
        const float4* src = (const float4*)(X1 + (size_t)r * D);
        float4 v[4]; float ss = 0.f;
#pragma unroll
        for (int j = 0; j < 4; ++j) { v[j] = src[lane + 64 * j]; ss += v[j].x * v[j].x + v[j].y * v[j].y + v[j].z * v[j].z + v[j].w * v[j].w; }
        ss = wave_sum(ss);
        const float rstd = rsqrtf(ss * (1.f / D) + EPS);
        const float* sh = ADA + b * 6144 + 3072, *sc = ADA + b * 6144 + 4096;
        float lg[16];
#pragma unroll
        for (int e = 0; e < 16; ++e) lg[e] = 0.f;
#pragma unroll
        for (int j = 0; j < 4; ++j) {
            const int d4 = lane + 64 * j;
            const float4 g = ((const float4*)p.norm2_g)[d4], s1 = ((const float4*)sc)[d4], h1 = ((const float4*)sh)[d4];
            float4 o;
            o.x = v[j].x * rstd * g.x * (1.f + s1.x) + h1.x; o.y = v[j].y * rstd * g.y * (1.f + s1.y) + h1.y;
            o.z = v[j].z * rstd * g.z * (1.f + s1.z) + h1.z; o.w = v[j].w * rstd * g.w * (1.f + s1.w) + h1.w;
            ((uint2*)(H2 + (size_t)r * D))[d4] = make_uint2(pk2(o.x, o.y), pk2(o.z, o.w));
            const float ov[4] = {o.x, o.y, o.z, o.w};
#pragma unroll
            for (int q = 0; q < 4; ++q) {
                const float4* rw = (const float4*)(p.router_w + (size_t)(d4 * 4 + q) * 16);
#pragma unroll
                for (int e4 = 0; e4 < 4; ++e4) {
                    const float4 w = rw[e4];
                    lg[e4 * 4 + 0] += ov[q] * w.x; lg[e4 * 4 + 1] += ov[q] * w.y; lg[e4 * 4 + 2] += ov[q] * w.z; lg[e4 * 4 + 3] += ov[q] * w.w;
                }
            }
        }
#pragma unroll
        for (int e = 0; e < 16; ++e) lg[e] = wave_sum(lg[e]);
        float mx = lg[0];
#pragma unroll
        for (int e = 1; e < 16; ++e) mx = fmaxf(mx, lg[e]);
        float den = 0.f;
#pragma unroll
        for (int e = 0; e < 16; ++e) { lg[e] = expf(lg[e] - mx); den += lg[e]; }
        const float inv = 1.f / den;
        if (lane < 16) {
            float val = 0.f;
#pragma unroll
            for (int e = 0; e < 16; ++e) val = (lane == e) ? lg[e] : val;
            AFF[((size_t)b * 16 + lane) * SEQ + t] = val * inv;
        }
    }
}

__device__ __forceinline__ void ph_topk(const P& p, float* lds) {
    const int tid = opaque_tid();
    const float* AFF = (const float*)(p.ws + WS_AFF);
    int* IDX = (int*)(p.ws + WS_IDX);
    float* GATE = (float*)(p.ws + WS_GATE);
    int* INV = (int*)(p.ws + WS_INV);
    float* a = lds;
    int* sel = (int*)(lds + 2048);
    for (int item = blockIdx.x; item < NB * NE; item += gridDim.x) {
        const int b = item >> 4, e = item & 15;
        __syncthreads();
        for (int i = tid; i < SEQ; i += NT) a[i] = AFF[(size_t)item * SEQ + i];
        __syncthreads();
        float ai[4]; int rank[4];
#pragma unroll
        for (int j = 0; j < 4; ++j) { ai[j] = a[tid + NT * j]; rank[j] = 0; }
        for (int j2 = 0; j2 < SEQ; j2 += 4) {
            const float4 o4 = *(const float4*)&a[j2];
            const float ov[4] = {o4.x, o4.y, o4.z, o4.w};
#pragma unroll
            for (int q = 0; q < 4; ++q)
#pragma unroll
                for (int j = 0; j < 4; ++j) rank[j] += (ov[q] > ai[j] || (ov[q] == ai[j] && (j2 + q) < (tid + NT * j))) ? 1 : 0;
        }
#pragma unroll
        for (int j = 0; j < 4; ++j) {
            const int t = tid + NT * j;
            if (rank[j] < CAP) { IDX[item * CAP + rank[j]] = t; GATE[item * CAP + rank[j]] = ai[j]; sel[rank[j]] = t; }
            INV[((size_t)b * SEQ + t) * 16 + e] = rank[j] < CAP ? rank[j] : -1;
        }
    }
}

struct MoeUpSched {
    int G, c; const bf16_t *H2, *W13T; bf16_t* HMID; const int* IDX;
    __device__ __forceinline__ bool next(int i, Unit& u) const {
        if (i >= 16 || c >= 256) return false;
        const int item = c, b = item >> 4, e = item & 15, nt = i;
        u.a = (const char*)(H2 + (size_t)b * SEQ * D); u.b = (const char*)(W13T + ((size_t)e * 4096 + nt * 256) * D); u.c = HMID + (size_t)item * CAP * FF + nt * 128;
        u.aux = nullptr; u.gidx = IDX + item * CAP; u.ldc = FF; u.row0 = 0; u.col0 = 0; return true;
    }
    __device__ __forceinline__ void a_ready(const Unit&) const {}
    __device__ __forceinline__ void done(const Unit&) const {}
};
struct MoeDownSched {
    int G, c; const bf16_t *HMID, *W2T; bf16_t* YS; const float* GATE;
    __device__ __forceinline__ bool next(int i, Unit& u) const {
        if (i >= 4 || c >= 256) return false;
        const int item = c, e = item & 15, nt = i;
        u.a = (const char*)(HMID + (size_t)item * CAP * FF); u.b = (const char*)(W2T + ((size_t)e * 1024 + nt * 256) * FF); u.c = YS + (size_t)item * CAP * D + nt * 256;
        u.aux = GATE + item * CAP; u.gidx = nullptr; u.ldc = D; u.row0 = 0; u.col0 = 0; return true;
    }
    __device__ __forceinline__ void a_ready(const Unit&) const {}
    __device__ __forceinline__ void done(const Unit&) const {}
};
__device__ __forceinline__ void ph_moe_up(const P& p, unsigned char* lds) {
    MoeUpSched S{(int)gridDim.x, (int)blockIdx.x, (const bf16_t*)(p.ws + WS_H2), (const bf16_t*)(p.ws + WS_W13T), (bf16_t*)(p.ws + WS_HMID), (const int*)(p.ws + WS_IDX)};
    pg8::EpiSwiGLU E;
    pg8::gemm_phase<pg8::EpiSwiGLU, MoeUpSched, true, true, true>((PG8_LAS unsigned char*)lds, D, S, E);
}
__device__ __forceinline__ void ph_moe_down(const P& p, unsigned char* lds) {
    MoeDownSched S{(int)gridDim.x, (int)blockIdx.x, (const bf16_t*)(p.ws + WS_HMID), (const bf16_t*)(p.ws + WS_W2T), (bf16_t*)(p.ws + WS_YS), (const float*)(p.ws + WS_GATE)};
    pg8::EpiDown E;
    pg8::gemm_phase<pg8::EpiDown, MoeDownSched, true, true, false>((PG8_LAS unsigned char*)lds, FF, S, E);
}

__device__ __forceinline__ void ph_final(const P& p) {
    const int tid = opaque_tid(), lane = tid & 63, wv = tid >> 6;
    const float* ADA = (const float*)(p.ws + WS_ADA);
    const bf16_t* YS = (const bf16_t*)(p.ws + WS_YS);
    const int* INV = (const int*)(p.ws + WS_INV);
    float* X = p.out;
    for (int r = blockIdx.x * 8 + wv; r < NTOK; r += gridDim.x * 8) {
        const int b = r / SEQ;
        const float* g2 = ADA + b * 6144 + 5120;
        float4 acc[4];
#pragma unroll
        for (int j = 0; j < 4; ++j) acc[j] = make_float4(0.f, 0.f, 0.f, 0.f);
        const int myinv = INV[(size_t)r * 16 + (lane & 15)];
#pragma unroll
        for (int e = 0; e < 16; ++e) {
            const int slot = __shfl(myinv, e);
            if (slot >= 0) {
                const uint2* yr = (const uint2*)(YS + ((size_t)(b * 16 + e) * CAP + slot) * D);
#pragma unroll
                for (int j = 0; j < 4; ++j) { const uint2 w = yr[lane + 64 * j];
                    acc[j].x += __uint_as_float(w.x << 16); acc[j].y += __uint_as_float(w.x & 0xffff0000u); acc[j].z += __uint_as_float(w.y << 16); acc[j].w += __uint_as_float(w.y & 0xffff0000u); }
            }
        }
        float4 v[4]; float ss = 0.f;
#pragma unroll
        for (int j = 0; j < 4; ++j) {
            const int d4 = lane + 64 * j;
            const float4 xv = ((const float4*)(X + (size_t)r * D))[d4], g = ((const float4*)g2)[d4];
            v[j] = make_float4(xv.x + g.x * acc[j].x, xv.y + g.y * acc[j].y, xv.z + g.z * acc[j].z, xv.w + g.w * acc[j].w);
            ss += v[j].x * v[j].x + v[j].y * v[j].y + v[j].z * v[j].z + v[j].w * v[j].w;
        }
        ss = wave_sum(ss);
        const float rstd = rsqrtf(ss * (1.f / D) + EPS);
#pragma unroll
        for (int j = 0; j < 4; ++j) {
            const int d4 = lane + 64 * j;
            const float4 g = ((const float4*)p.final_g)[d4];
            ((float4*)(X + (size_t)r * D))[d4] = make_float4(v[j].x * rstd * g.x, v[j].y * rstd * g.y, v[j].z * rstd * g.z, v[j].w * rstd * g.w);
        }
    }
}

#define LAS __attribute__((address_space(3)))
#define XB_TMO      128
#define XB_XCNT(j)  (256  + 64 * (j))
#define XB_XSUB(j)  (1280 + 64 * (j))
#define XB_XGEN(j)  (2304 + 64 * (j))
#define XB_TOP      3328
#define XB_TOPGEN   3392
#define XCD_BAR_WORDS 3456
#define XB_SPIN_CAP (1u << 18)

__device__ __forceinline__ unsigned xb_ld(unsigned* p)              { return __hip_atomic_load(p, __ATOMIC_RELAXED, __HIP_MEMORY_SCOPE_AGENT); }
__device__ __forceinline__ unsigned xb_add(unsigned* p, unsigned v) { return __hip_atomic_fetch_add(p, v, __ATOMIC_RELAXED, __HIP_MEMORY_SCOPE_AGENT); }
__device__ __forceinline__ unsigned xb_xcc_id() { return (unsigned)__builtin_amdgcn_s_getreg((3 << 11) | 20) & 0xFu; }
#define XB_SPIN(cond, bar) do { unsigned _sp = 0; while (cond) { __builtin_amdgcn_s_sleep(1); \
    if ((++_sp & 255u) == 0u) { if (xb_ld(&(bar)[XB_TMO])) break; if (_sp > XB_SPIN_CAP) { atomicAdd(&(bar)[XB_TMO], 1u); break; } } } } while (0)

struct XcdBarrier {
    unsigned* bar; unsigned x;
    volatile LAS unsigned* st;
};

__device__ __forceinline__ XcdBarrier xcd_barrier_post(unsigned* bar, volatile LAS unsigned* st) {
    XcdBarrier b; b.bar = bar; b.x = xb_xcc_id(); b.st = st;
    if (threadIdx.x == 0) (void)xb_add(&bar[XB_XCNT(b.x)], 1u);
    return b;
}
__device__ __forceinline__ void xcd_barrier_complete(unsigned* bar, unsigned x, unsigned& nloc, unsigned& nx) {
    const unsigned G = gridDim.x * gridDim.y * gridDim.z;
    unsigned sum, cnt, mine, sp = 0u;
    for (;;) {
        sum = 0u; cnt = 0u; mine = 0u;
#pragma unroll
        for (unsigned j = 0; j < 16; ++j) { const unsigned c = xb_ld(&bar[XB_XCNT(j)]); sum += c; cnt += (c > 0u) ? 1u : 0u; mine = (j == x) ? c : mine; }
        if (sum == G) break;
        __builtin_amdgcn_s_sleep(1);
        if ((++sp & 255u) == 0u) { if (xb_ld(&bar[XB_TMO])) break; if (sp > XB_SPIN_CAP) { atomicAdd(&bar[XB_TMO], 1u); break; } }
    }
    nloc = mine > 0u ? mine : 1u; nx = cnt > 0u ? cnt : 1u;
}

__device__ __forceinline__ void xcd_barrier(const XcdBarrier& b) {
    asm volatile("s_waitcnt vmcnt(0)" ::: "memory");
    __syncthreads();
    if (threadIdx.x == 0) {
        unsigned* bar = b.bar;
        __builtin_amdgcn_s_waitcnt(0);
        unsigned nloc = b.st[0], nx = b.st[1];
        if (nloc == 0u) { xcd_barrier_complete(bar, b.x, nloc, nx); b.st[0] = nloc; b.st[1] = nx; }
        const unsigned old = xb_add(&bar[XB_XSUB(b.x)], 1u);
        const unsigned gen = old / nloc;
        if (old + 1u == (gen + 1u) * nloc) {
            __builtin_amdgcn_fence(__ATOMIC_RELEASE, "agent");
            asm volatile("s_waitcnt vmcnt(0)" ::: "memory");
            const unsigned og = xb_add(&bar[XB_TOP], 1u);
            const unsigned tg = og / nx;
            if (og + 1u == (tg + 1u) * nx) xb_add(&bar[XB_TOPGEN], 1u);
            else XB_SPIN(xb_ld(&bar[XB_TOPGEN]) == tg, bar);
            __builtin_amdgcn_fence(__ATOMIC_ACQUIRE, "agent");
            xb_add(&bar[XB_XGEN(b.x)], 1u);
            asm volatile("s_waitcnt vmcnt(0)" ::: "memory");
        } else {
            XB_SPIN(xb_ld(&bar[XB_XGEN(b.x)]) == gen, bar);
            __builtin_amdgcn_fence(__ATOMIC_ACQUIRE, "agent");
            asm volatile("s_waitcnt vmcnt(0)" ::: "memory");
        }
    }
    __syncthreads();
}

constexpr int N_PHASES = 11;
template <int PH>
__device__ __forceinline__ void run_phase(const P& p, unsigned char* ldsb) {
    float* lds = (float*)ldsb;
    if constexpr (PH == 0) { ph_prep(p, lds); ph_convert(p, lds); }
    else if constexpr (PH == 1) { ph_norm1(p); ph_filter(p, lds); }
    else if constexpr (PH == 2) ph_inproj(p, ldsb);
    else if constexpr (PH == 3) ph_mixers(p, ldsb);
    else if constexpr (PH == 4) ph_mixprep(p, lds);
    else if constexpr (PH == 5) ph_outproj(p, ldsb);
    else if constexpr (PH == 6) ph_norm2_router(p);
    else if constexpr (PH == 7) ph_topk(p, lds);
    else if constexpr (PH == 8) ph_moe_up(p, ldsb);
    else if constexpr (PH == 9) ph_moe_down(p, ldsb);
    else if constexpr (PH == 10) ph_final(p);
}
template <int PH>
__device__ __forceinline__ void run_from(const P& p, unsigned char* lds, const XcdBarrier& bar) {
    if constexpr (PH < N_PHASES) {
        run_phase<PH>(p, lds);
        if constexpr (PH + 1 < N_PHASES) xcd_barrier(bar);
        run_from<PH + 1>(p, lds, bar);
    }
}
__global__ void __launch_bounds__(NT, 2) fwd_all(P p) {
    extern __shared__ __attribute__((aligned(16))) unsigned char lds_raw[];
    volatile LAS unsigned* st = (volatile LAS unsigned*)(lds_raw + LDS_BYTES - 32);
    if (threadIdx.x < 2) st[threadIdx.x] = 0u;
    __syncthreads();
    const XcdBarrier bar = xcd_barrier_post((unsigned*)(p.ws + WS_CTL) + CW_BAR, st);
    run_from<0>(p, lds_raw, bar);
}

extern "C" void kernel_launch(void* const* d_in, const int* in_sizes, int n_in, void* d_out, int out_size, void* d_ws, size_t ws_size, hipStream_t stream) {
    static int grid = 0;
    if (grid == 0) {
        int dev = 0, cus = 0, per_cu = 0;
        (void)hipGetDevice(&dev);
        (void)hipDeviceGetAttribute(&cus, hipDeviceAttributeMultiprocessorCount, dev);
        (void)hipFuncSetAttribute((const void*)fwd_all, hipFuncAttributeMaxDynamicSharedMemorySize, LDS_BYTES);
        (void)hipOccupancyMaxActiveBlocksPerMultiprocessor(&per_cu, (const void*)fwd_all, NT, LDS_BYTES);
        if (per_cu < 1) fprintf(stderr, "kernel_launch: occupancy query says %d blocks/CU\n", per_cu);
        grid = (cus > 0 ? cus : 256);
        if (ws_size < WS_END) fprintf(stderr, "kernel_launch: workspace too small: %zu < %zu\n", ws_size, (size_t)WS_END);
    }
    P p{};
    const float** f = (const float**)&p;
    for (int i = 0; i < 28; ++i) f[i] = (const float*)d_in[i];
    p.out = (float*)d_out;
    p.ws = (unsigned char*)d_ws;
    p.ph_lo = 0; p.ph_hi = N_PHASES;
    (void)hipMemsetAsync((unsigned char*)d_ws + WS_CTL, 0, CTL_ZERO_BYTES, stream);
    hipLaunchKernelGGL(fwd_all, dim3(grid), dim3(NT), LDS_BYTES, stream, p);
}
```

```cpp
#include <hip/hip_runtime.h>
#include <cstdio>
#include <cstdint>

constexpr int D = 1024, NB = 16, SEQ = 2048, CTXL = 256;
constexpr int NTOK = NB * SEQ;
constexpr int NCTX = NB * CTXL;
constexpr int HEADS = 4;
constexpr int INC = 4096;
constexpr int NE = 16, CAP = 256, FF = 2048;
constexpr int NT = 512;
constexpr int LDS_BYTES = 147456;
constexpr float EPS = 1e-6f;
typedef unsigned short bf16_t;

constexpr size_t MiB = 1u << 20;
constexpr size_t WS_CTL = 0;
constexpr size_t WS_ADA = 1 * MiB;
constexpr size_t WS_LB = WS_ADA + 512 * 1024;
constexpr size_t WS_HID2 = 2 * MiB;
constexpr size_t WS_AFF = 3 * MiB;
constexpr size_t WS_IDX = 5 * MiB;
constexpr size_t WS_GATE = 5 * MiB + 512 * 1024;
constexpr size_t WS_INV = 6 * MiB;
constexpr size_t WS_W13T = 8 * MiB;
constexpr size_t WS_YS = WS_W13T;
constexpr size_t WS_W2T = 136 * MiB;
constexpr size_t WS_R = 200 * MiB;
constexpr size_t WS_H = WS_R;
constexpr size_t WS_MIXA = WS_R;
constexpr size_t WS_HC = WS_R + 64 * MiB;
constexpr size_t WS_PC = WS_R + 72 * MiB;
constexpr size_t WS_OFB = WS_R + 84 * MiB;
constexpr size_t WS_WOUTT = WS_R + 148 * MiB;
constexpr size_t WS_PHG = WS_R + 152 * MiB;
constexpr size_t WS_HMID = WS_R;
constexpr size_t WS_H2 = WS_R + 256 * MiB;
constexpr size_t WS_END = WS_R + 320 * MiB;
constexpr int CW_QHEAD = 64;
constexpr int CW_BAR = 4096;
constexpr size_t CTL_ZERO_BYTES = 65536;
constexpr size_t DO_PHYT = 0;
constexpr size_t DO_HF = 96 * MiB;
constexpr size_t DO_SCTX = 112 * MiB;
constexpr size_t DO_WINT = 120 * MiB;

struct P {
    const float *x, *c, *ctx, *c_ctx, *ada_w, *ada_b, *norm1_g, *w_in, *hy_conv_w, *hy_conv_b, *pos_w1, *pos_b1, *freq1, *pos_w2, *pos_b2,
        *freq2, *pos_w3, *hy_bias, *hy_norm_g, *hg_lb, *hg_norm_g, *w_out, *norm2_g, *router_w, *exp_w1, *exp_w3, *exp_w2, *final_g;
    float* out;
    unsigned char* ws;
    int ph_lo, ph_hi;
};

__device__ __forceinline__ int opaque_tid() { int t = threadIdx.x; asm volatile("" : "+v"(t)); return t; }
__device__ __forceinline__ float wave_sum(float v) {
#pragma unroll
    for (int o = 1; o < 64; o <<= 1) v += __shfl_xor(v, o);
    return v;
}
__device__ __forceinline__ float sigmoidf_(float z) { return 1.f / (1.f + expf(-z)); }
__device__ __forceinline__ float siluf_(float z) { return z / (1.f + expf(-z)); }
__device__ __forceinline__ float bf2f(bf16_t h) { return __uint_as_float((unsigned)h << 16); }
__device__ __forceinline__ unsigned f2bf(float f) { unsigned u = __float_as_uint(f); return (u + 0x7fffu + ((u >> 16) & 1u)) >> 16; }
__device__ __forceinline__ unsigned pk2(float lo, float hi) { return f2bf(lo) | (f2bf(hi) << 16); }

namespace pg8 {
#define PG8_LAS __attribute__((address_space(3)))
typedef unsigned short bf16_t;
typedef short bf16x8 __attribute__((ext_vector_type(8)));
typedef float f32x4 __attribute__((ext_vector_type(4)));
typedef unsigned u32x4 __attribute__((ext_vector_type(4)));
constexpr int BM = 256, BK = 64, HALF = 128, HTB = HALF * BK * 2  , STAGE_BYTES = 8 * HTB, NXCD = 8, WGM = 8;

__host__ __device__ __forceinline__ int lds_byte(int r, int c) { const int st = (r >> 4) * 2 + (c >> 5), rr = r & 15, cc = c & 31, ob = rr * 64 + cc * 2; return st * 1024 + (ob ^ (((ob >> 9) & 1) << 5)); }
__host__ __device__ __forceinline__ void stage_rc(int b, int& R, int& C) { const int st = b / 1024, sb = b % 1024, swz = sb ^ (((sb >> 9) & 1) << 5); R = (st >> 1) * 16 + swz / 64; C = (st & 1) * 32 + (swz % 64) / 2; }
__host__ __device__ __forceinline__ int perm32(int rho) { const int n = rho >> 4, i = rho & 15; return 8 * (i >> 2) + 4 * n + (i & 3); }

struct Unit { const char* a; const char* b; bf16_t* c; const float* aux; const int* gidx; int ldc, row0, col0; };
__device__ __forceinline__ unsigned cvt_pk_bf16(float lo, float hi) { unsigned r; asm volatile("v_cvt_pk_bf16_f32 %0, %1, %2" : "=v"(r) : "v"(lo), "v"(hi)); return r; }

__device__ __forceinline__ void tile_of(int L, int nM, int nN, int& pm, int& pn) {
    const int nwg = nM * nN; int wgid = L;
    { const int q = nwg / NXCD, r = nwg % NXCD, xcd = wgid % NXCD, off = wgid / NXCD; wgid = (xcd < r ? xcd * (q + 1) : r * (q + 1) + (xcd - r) * q) + off; }
    const int nig = WGM * nN, gid = wgid / nig, fm = gid * WGM, gsz = (nM - fm) < WGM ? (nM - fm) : WGM;
    pm = fm + ((wgid % nig) % gsz); pn = (wgid % nig) / gsz;
}

struct EpiStoreBf16 {
    static constexpr bool PERM = true, AFTER_DRAIN = false;
    __device__ __forceinline__ void operator()(const f32x4 (&acc)[2][2][4][2], const Unit& u, int wr, int wc, int fr, int fq) const {
        bf16_t* base = u.c + (size_t)(wr * 64 + fr) * u.ldc + wc * 32 + 8 * fq;
#pragma unroll
        for (int ai = 0; ai < 2; ++ai)
#pragma unroll
            for (int m = 0; m < 4; ++m) { bf16_t* rowp = base + (size_t)(ai * HALF + m * 16) * u.ldc;
#pragma unroll
                for (int bj = 0; bj < 2; ++bj) { const f32x4 v0 = acc[ai][bj][m][0], v1 = acc[ai][bj][m][1];
                    u32x4 w; w.x = cvt_pk_bf16(v0[0], v0[1]); w.y = cvt_pk_bf16(v0[2], v0[3]); w.z = cvt_pk_bf16(v1[0], v1[1]); w.w = cvt_pk_bf16(v1[2], v1[3]);
                    *(u32x4*)(rowp + bj * HALF) = w; } }
    }
};
struct EpiOutProj {
    static constexpr bool PERM = false, AFTER_DRAIN = false;
    const float* x; const float* ada; float* x1;
    __device__ __forceinline__ void operator()(const f32x4 (&acc)[2][2][4][2], const Unit& u, int wr, int wc, int fr, int fq) const {
        const float* g1 = ada + (u.row0 >> 11) * 6144 + 2048;
#pragma unroll
        for (int bj = 0; bj < 2; ++bj)
#pragma unroll
            for (int n = 0; n < 2; ++n) { const int col = u.col0 + bj * HALF + wc * 32 + n * 16 + 4 * fq; const f32x4 g = *(const f32x4*)(g1 + col);
#pragma unroll
                for (int ai = 0; ai < 2; ++ai)
#pragma unroll
                    for (int m = 0; m < 4; ++m) { const size_t off = (size_t)(u.row0 + ai * HALF + wr * 64 + m * 16 + fr) * D + col;
                        const f32x4 xv = *(const f32x4*)(x + off); *(f32x4*)(x1 + off) = xv + g * acc[ai][bj][m][n]; } }
    }
};
__device__ __forceinline__ float silu_fast(float a) { return a * __builtin_amdgcn_rcpf(1.0f + __builtin_amdgcn_exp2f(-1.4426950408889634f * a)); }
struct EpiSwiGLU {
    static constexpr bool PERM = true, AFTER_DRAIN = false;
    __device__ __forceinline__ void operator()(const f32x4 (&acc)[2][2][4][2], const Unit& u, int wr, int wc, int fr, int fq) const {
        bf16_t* base = u.c + (size_t)(wr * 64 + fr) * FF + wc * 32 + 8 * fq;
#pragma unroll
        for (int ai = 0; ai < 2; ++ai)
#pragma unroll
            for (int m = 0; m < 4; ++m) { const f32x4 a0 = acc[ai][0][m][0], a1 = acc[ai][0][m][1], b0 = acc[ai][1][m][0], b1 = acc[ai][1][m][1];
                u32x4 w; w.x = cvt_pk_bf16(silu_fast(a0[0]) * b0[0], silu_fast(a0[1]) * b0[1]); w.y = cvt_pk_bf16(silu_fast(a0[2]) * b0[2], silu_fast(a0[3]) * b0[3]);
                w.z = cvt_pk_bf16(silu_fast(a1[0]) * b1[0], silu_fast(a1[1]) * b1[1]); w.w = cvt_pk_bf16(silu_fast(a1[2]) * b1[2], silu_fast(a1[3]) * b1[3]);
                *(u32x4*)(base + (size_t)(ai * HALF + m * 16) * FF) = w; }
    }
};
struct EpiDown {
    static constexpr bool PERM = true, AFTER_DRAIN = false;
    __device__ __forceinline__ void operator()(const f32x4 (&acc)[2][2][4][2], const Unit& u, int wr, int wc, int fr, int fq) const {
        bf16_t* base = u.c + (size_t)(wr * 64 + fr) * D + wc * 32 + 8 * fq;
#pragma unroll
        for (int ai = 0; ai < 2; ++ai)
#pragma unroll
            for (int m = 0; m < 4; ++m) { const float gt = u.aux[ai * HALF + wr * 64 + m * 16 + fr]; bf16_t* rowp = base + (size_t)(ai * HALF + m * 16) * D;
#pragma unroll
                for (int bj = 0; bj < 2; ++bj) { const f32x4 v0 = acc[ai][bj][m][0] * gt, v1 = acc[ai][bj][m][1] * gt;
                    u32x4 w; w.x = cvt_pk_bf16(v0[0], v0[1]); w.y = cvt_pk_bf16(v0[2], v0[3]); w.z = cvt_pk_bf16(v1[0], v1[1]); w.w = cvt_pk_bf16(v1[2], v1[3]);
                    *(u32x4*)(rowp + bj * HALF) = w; } }
    }
};

template <class Epi, class Sched, bool ALIGN_EPI = false, bool SP2 = false, bool GATHER = false>
__device__ __forceinline__ void gemm_phase(PG8_LAS unsigned char* lds, const int K, const Sched& S, const Epi& E) {
    const int tid = opaque_tid(), wid = __builtin_amdgcn_readfirstlane(tid >> 6), lane = tid & 63, wr = wid >> 2, wc = wid & 3, fr = lane & 15, fq = lane >> 4;
    const int nt = K / BK;
    unsigned voffA[2], voffB[2];
#pragma unroll
    for (int i = 0; i < 2; ++i) { int R, C; stage_rc(tid * 16 + i * 8192, R, C); const int Rb = Epi::PERM ? ((R & ~31) + perm32(R & 31)) : R;
        voffA[i] = (unsigned)(R * K + C) * 2u; voffB[i] = (unsigned)(Rb * K + C) * 2u; }
    const size_t kstep = (size_t)(BK * 2);
    const size_t hstep = (size_t)HALF * K * 2;
    const unsigned ldsw = (unsigned)wid * 1024u;
    const int aoff = lds_byte(wr * 64 + fr, fq * 8), boff = lds_byte(wc * 32 + fr, fq * 8);
#define PG8_SA(b, h) (((b) * 2 + (h)) * HTB)
#define PG8_SB(b, h) ((4 + (b) * 2 + (h)) * HTB)
#define PG8_STAGE(bufoff, gbase, voff) do { _Pragma("unroll") for (int _i = 0; _i < 2; ++_i) \
        __builtin_amdgcn_global_load_lds((const unsigned*)((const char*)(gbase) + (voff)[_i]), (PG8_LAS unsigned*)(lds + (bufoff) + ldsw + _i * 8192), 16, 0, 0); } while (0)
#define PG8_STAGE_A(bufoff, gbase, h) do { _Pragma("unroll") for (int _i = 0; _i < 2; ++_i) \
        __builtin_amdgcn_global_load_lds((const unsigned*)((const char*)(gbase) + voffAh[h][_i]), (PG8_LAS unsigned*)(lds + (bufoff) + ldsw + _i * 8192), 16, 0, 0); } while (0)
#define PG8_LDA(dst, b, h) do { _Pragma("unroll") for (int m = 0; m < 4; ++m) _Pragma("unroll") for (int k = 0; k < 2; ++k) dst[m][k] = *(const PG8_LAS bf16x8*)(lds + PG8_SA(b, h) + aoff + m * 2048 + k * 1024); } while (0)
#define PG8_LDB(dst, b, h) do { _Pragma("unroll") for (int n = 0; n < 2; ++n) _Pragma("unroll") for (int k = 0; k < 2; ++k) dst[n][k] = *(const PG8_LAS bf16x8*)(lds + PG8_SB(b, h) + boff + n * 2048 + k * 1024); } while (0)
#define PG8_MMA(ai, bj, At, Bt) do { __builtin_amdgcn_s_setprio(1); _Pragma("unroll") for (int m = 0; m < 4; ++m) _Pragma("unroll") for (int n = 0; n < 2; ++n) _Pragma("unroll") for (int k = 0; k < 2; ++k) \
        acc[ai][bj][m][n] = __builtin_amdgcn_mfma_f32_16x16x32_bf16(Bt[n][k], At[m][k], acc[ai][bj][m][n], 0, 0, 0); __builtin_amdgcn_s_setprio(0); } while (0)
#define PG8_WAIT_V(n) asm volatile("s_waitcnt vmcnt(" #n ")" ::: "memory")
#define PG8_WAIT_L(n) asm volatile("s_waitcnt lgkmcnt(" #n ")" ::: "memory")
#define PG8_BAR __builtin_amdgcn_s_barrier()
#define PG8_SCHED __builtin_amdgcn_sched_barrier(0)
    Unit cur, nxt; int ui = 0;
    if (!S.next(0, cur)) return;
    unsigned voffAh[2][2];
#pragma unroll
    for (int h = 0; h < 2; ++h)
#pragma unroll
        for (int i = 0; i < 2; ++i) {
            if constexpr (GATHER) { int R, C; stage_rc(tid * 16 + i * 8192, R, C); voffAh[h][i] = ((unsigned)cur.gidx[h * HALF + R] * (unsigned)K + (unsigned)C) * 2u; }
            else voffAh[h][i] = voffA[i] + (unsigned)h * (unsigned)hstep;
        }
    f32x4 acc[2][2][4][2];
#pragma unroll
    for (int a = 0; a < 2; ++a)
#pragma unroll
        for (int b = 0; b < 2; ++b)
#pragma unroll
            for (int m = 0; m < 4; ++m)
#pragma unroll
                for (int n = 0; n < 2; ++n) acc[a][b][m][n] = (f32x4){0.f, 0.f, 0.f, 0.f};
    bf16x8 At[4][2], B0[2][2], B1[2][2];
    const char* cA = cur.a; const char* cB = cur.b;
    S.a_ready(cur);
    if constexpr (SP2) {
        PG8_STAGE(PG8_SB(0, 0), cB, voffB); PG8_STAGE(PG8_SB(0, 1), cB + hstep, voffB); PG8_STAGE_A(PG8_SA(0, 0), cA, 0); PG8_STAGE_A(PG8_SA(0, 1), cA, 1);
        if (wr == 1) PG8_BAR;
        PG8_WAIT_V(2); PG8_BAR;
        PG8_STAGE(PG8_SB(1, 0), cB + kstep, voffB); PG8_STAGE_A(PG8_SA(1, 0), cA + kstep, 0); PG8_STAGE(PG8_SB(1, 1), cB + hstep + kstep, voffB);
        PG8_WAIT_V(6); PG8_BAR;
    } else {
        PG8_STAGE(PG8_SB(0, 0), cB, voffB); PG8_STAGE_A(PG8_SA(0, 0), cA, 0); PG8_STAGE(PG8_SB(0, 1), cB + hstep, voffB); PG8_STAGE_A(PG8_SA(0, 1), cA, 1);
        if (wr == 1) PG8_BAR;
        PG8_WAIT_V(4); PG8_BAR;
        PG8_STAGE(PG8_SB(1, 0), cB + kstep, voffB); PG8_STAGE_A(PG8_SA(1, 0), cA + kstep, 0); PG8_STAGE(PG8_SB(1, 1), cB + hstep + kstep, voffB);
        PG8_WAIT_V(6); PG8_BAR;
    }
    for (;;) {
        const bool has_next = S.next(ui + 1, nxt);
        const char* nA = has_next ? nxt.a : cA; const char* nB = has_next ? nxt.b : cB;
        for (int t = 0; t < nt; t += 2) {
            const bool last = (t == nt - 2);
            const char* a1 = cA + (size_t)(t + 1) * kstep;
            const char* a2 = last ? nA : cA + (size_t)(t + 2) * kstep; const char* b2 = last ? nB : cB + (size_t)(t + 2) * kstep;
            const char* a3 = a2 + kstep; const char* b3 = b2 + kstep;
            if (last && has_next) S.a_ready(nxt);
            if constexpr (SP2) {
            PG8_LDB(B0, 0, 0); PG8_LDB(B1, 0, 1); PG8_SCHED; PG8_LDA(At, 0, 0); PG8_STAGE_A(PG8_SA(1, 1), a1, 1);
            PG8_WAIT_V(8); PG8_WAIT_L(0); PG8_BAR; PG8_MMA(0, 0, At, B0); PG8_MMA(0, 1, At, B1); PG8_BAR; PG8_SCHED;
            PG8_LDA(At, 0, 1); PG8_STAGE(PG8_SB(0, 0), b2, voffB); PG8_STAGE(PG8_SB(0, 1), b2 + hstep, voffB); PG8_STAGE_A(PG8_SA(0, 0), a2, 0);
            PG8_WAIT_V(8); PG8_WAIT_L(0); PG8_BAR; PG8_MMA(1, 0, At, B0); PG8_MMA(1, 1, At, B1); PG8_BAR; PG8_SCHED;
            PG8_LDB(B0, 1, 0); PG8_LDB(B1, 1, 1); PG8_SCHED; PG8_LDA(At, 1, 0); PG8_STAGE_A(PG8_SA(0, 1), a2, 1);
            PG8_WAIT_V(8); PG8_WAIT_L(0); PG8_BAR; PG8_MMA(0, 0, At, B0); PG8_MMA(0, 1, At, B1); PG8_BAR; PG8_SCHED;
            PG8_LDA(At, 1, 1); PG8_STAGE(PG8_SB(1, 0), b3, voffB); PG8_STAGE(PG8_SB(1, 1), b3 + hstep, voffB); PG8_STAGE_A(PG8_SA(1, 0), a3, 0);
            PG8_WAIT_V(8); PG8_WAIT_L(0); PG8_BAR; PG8_MMA(1, 0, At, B0); PG8_MMA(1, 1, At, B1); PG8_BAR; PG8_SCHED;
            } else {
            PG8_LDB(B0, 0, 0); PG8_SCHED; PG8_LDA(At, 0, 0); PG8_STAGE_A(PG8_SA(1, 1), a1, 1);
            PG8_WAIT_L(8); PG8_BAR; PG8_WAIT_L(0); PG8_MMA(0, 0, At, B0); PG8_BAR; PG8_SCHED;
            PG8_LDB(B1, 0, 1); PG8_STAGE(PG8_SB(0, 0), b2, voffB);
            PG8_BAR; PG8_WAIT_L(0); PG8_MMA(0, 1, At, B1); PG8_BAR;
            PG8_LDA(At, 0, 1); PG8_STAGE_A(PG8_SA(0, 0), a2, 0);
            PG8_BAR; PG8_WAIT_L(0); PG8_MMA(1, 0, At, B0); PG8_BAR; PG8_SCHED;
            PG8_STAGE(PG8_SB(0, 1), b2 + hstep, voffB);
            PG8_WAIT_V(6); PG8_BAR; PG8_MMA(1, 1, At, B1); PG8_BAR;
            PG8_LDB(B0, 1, 0); PG8_SCHED; PG8_LDA(At, 1, 0); PG8_STAGE_A(PG8_SA(0, 1), a2, 1);
            PG8_WAIT_L(8); PG8_BAR; PG8_WAIT_L(0); PG8_MMA(0, 0, At, B0); PG8_BAR; PG8_SCHED;
            PG8_LDB(B1, 1, 1); PG8_STAGE(PG8_SB(1, 0), b3, voffB);
            PG8_BAR; PG8_WAIT_L(0); PG8_MMA(0, 1, At, B1); PG8_BAR;
            PG8_LDA(At, 1, 1); PG8_STAGE_A(PG8_SA(1, 0), a3, 0);
            PG8_BAR; PG8_WAIT_L(0); PG8_MMA(1, 0, At, B0); PG8_BAR; PG8_SCHED;
            PG8_STAGE(PG8_SB(1, 1), b3 + hstep, voffB);
            PG8_WAIT_V(6); PG8_BAR; PG8_MMA(1, 1, At, B1); PG8_BAR;
            }
        }
        if constexpr (ALIGN_EPI) { if (wr == 0) PG8_BAR; }
        if constexpr (!Epi::AFTER_DRAIN) { E(acc, cur, wr, wc, fr, fq); S.done(cur); }
        if (!has_next) break;
#pragma unroll
        for (int a = 0; a < 2; ++a)
#pragma unroll
            for (int b = 0; b < 2; ++b)
#pragma unroll
                for (int m = 0; m < 4; ++m)
#pragma unroll
                    for (int n = 0; n < 2; ++n) acc[a][b][m][n] = (f32x4){0.f, 0.f, 0.f, 0.f};
        cur = nxt; cA = nA; cB = nB; ++ui;
        if constexpr (ALIGN_EPI) { if (wr == 1) PG8_BAR; }
    }
    PG8_WAIT_V(0);
    if constexpr (!ALIGN_EPI) { if (wr == 0) PG8_BAR; }
    PG8_BAR;
    if constexpr (Epi::AFTER_DRAIN) { E.fused(acc, cur, wr, wc, fr, fq, lds, wid, lane); S.done(cur); }
#undef PG8_SA
#undef PG8_SB
#undef PG8_STAGE
#undef PG8_LDA
#undef PG8_LDB
#undef PG8_MMA
#undef PG8_WAIT_V
#undef PG8_WAIT_L
#undef PG8_BAR
#undef PG8_SCHED
}
}
using pg8::Unit; using pg8::tile_of;

__device__ __forceinline__ void ph_prep(const P& p, float* lds) {
    const int tid = opaque_tid(), G = gridDim.x;
    float* ADA = (float*)(p.ws + WS_ADA);
    float* LB = (float*)(p.ws + WS_LB);
    float* HID2 = (float*)(p.ws + WS_HID2);
    {
        float* s = lds;
        float* red = lds + 17 * 1024;
        if (blockIdx.x < 96) {
            for (int i = tid; i < 17 * 1024; i += NT) {
                const int r = i >> 10, d = i & 1023;
                const float cv = r < 16 ? p.c[r * 1024 + d] : p.c_ctx[d];
                s[i] = siluf_(cv);
            }
        }
        __syncthreads();
        for (int item = blockIdx.x; item < 96; item += G) {
            const int jj = tid & 63, ks = tid >> 6, j = item * 64 + jj;
            float acc[17];
#pragma unroll
            for (int r = 0; r < 17; ++r) acc[r] = 0.f;
#pragma unroll 4
            for (int d = ks * 128; d < ks * 128 + 128; ++d) {
                const float w = p.ada_w[(size_t)d * 6144 + j];
#pragma unroll
                for (int r = 0; r < 17; ++r) acc[r] += s[r * 1024 + d] * w;
            }
#pragma unroll
            for (int r = 0; r < 17; ++r) red[(ks * 17 + r) * 64 + jj] = acc[r];
            __syncthreads();
            for (int i = tid; i < 17 * 64; i += NT) {
                const int r = i >> 6, j2 = i & 63;
                float sum = 0.f;
#pragma unroll
                for (int k = 0; k < 8; ++k) sum += red[(k * 17 + r) * 64 + j2];
                ADA[r * 6144 + item * 64 + j2] = sum + p.ada_b[item * 64 + j2];
            }
            __syncthreads();
        }
    }
    if (blockIdx.x == G - 1) {
        for (int i = tid; i < 1024; i += NT) {
            const float a0 = p.hg_lb[i], a1 = p.hg_lb[1024 + i];
            LB[i] = 1.f / (1.f + expf(a1 - a0));
        }
    }
    {
        float* zl = lds;
        float* h1 = lds + 512;
        __syncthreads();
        for (int it = (G - 1 - blockIdx.x); it < SEQ / 8; it += G) {
            const int lt = tid >> 6, j = tid & 63, t = it * 8 + lt;
            const float w = 6.283185307179586f * (float)t / 2048.0f;
            if (j == 0) zl[lt * 64] = (float)t / 2047.0f;
            if (j >= 1 && j < 17) { const float f = 1e-4f + (float)(j - 1) * ((15.0f - 1e-4f) / 15.0f); zl[lt * 64 + j] = cosf(f * w); }
            if (j >= 17 && j < 33) { const float f = 1e-4f + (float)(j - 17) * ((15.0f - 1e-4f) / 15.0f); zl[lt * 64 + j] = -sinf(f * w); }
            __syncthreads();
            float a = p.pos_b1[j];
            for (int i = 0; i < 33; ++i) a += zl[lt * 64 + i] * p.pos_w1[i * 64 + j];
            h1[lt * 64 + j] = sinf(p.freq1[j] * a);
            __syncthreads();
            float b = p.pos_b2[j];
            for (int i = 0; i < 64; ++i) b += h1[lt * 64 + i] * p.pos_w2[i * 64 + j];
            HID2[t * 64 + j] = sinf(p.freq2[j] * b);
            __syncthreads();
        }
    }
}
__device__ __forceinline__ void conv_item(const float* W, int N, int k0, int n0, bf16_t* dst, int KD, float* scr, int lane) {
#pragma unroll 8
    for (int i = 0; i < 32; ++i) { const int kk = 2 * i + (lane >> 5); scr[kk * 33 + (lane & 31)] = W[(size_t)(k0 + kk) * N + n0 + (lane & 31)]; }
    asm volatile("s_waitcnt lgkmcnt(0)" ::: "memory");
    const int c = lane & 7;
#pragma unroll
    for (int j = 0; j < 4; ++j) { const int n = (lane >> 3) + 8 * j; const float* s = scr + (8 * c) * 33 + n;
        uint4 o; o.x = pk2(s[0 * 33], s[1 * 33]); o.y = pk2(s[2 * 33], s[3 * 33]); o.z = pk2(s[4 * 33], s[5 * 33]); o.w = pk2(s[6 * 33], s[7 * 33]);
        *(uint4*)(dst + (size_t)n * KD + k0 + 8 * c) = o; }
    asm volatile("s_waitcnt lgkmcnt(0)" ::: "memory");
}
__device__ __forceinline__ void ph_convert(const P& p, float* lds) {
    const int tid = opaque_tid(), lane = tid & 63, wv = tid >> 6;
    float* scr = lds + wv * (64 * 33);
    bf16_t* WinT = (bf16_t*)((unsigned char*)p.out + DO_WINT);
    bf16_t* WoutT = (bf16_t*)(p.ws + WS_WOUTT);
    bf16_t* W13T = (bf16_t*)(p.ws + WS_W13T);
    bf16_t* W2T = (bf16_t*)(p.ws + WS_W2T);
    constexpr int I_IN = 16 * 128, I_OUT = 16 * 32, I_W1 = 16 * 16 * 64, I_W2 = 16 * 32 * 32;
    constexpr int NITEMS = I_IN + I_OUT + 2 * I_W1 + I_W2;
    __syncthreads();
    for (int it = blockIdx.x * 8 + wv; it < NITEMS; it += gridDim.x * 8) {
        int r = it;
        if (r < I_IN) { const int kb = r / 128, nb = r % 128; conv_item(p.w_in, INC, kb * 64, nb * 32, WinT + (size_t)(nb * 32) * D, D, scr, lane); continue; }
        r -= I_IN;
        if (r < I_OUT) { const int kb = r / 32, nb = r % 32; conv_item(p.w_out, D, kb * 64, nb * 32, WoutT + (size_t)(nb * 32) * D, D, scr, lane); continue; }
        r -= I_OUT;
        if (r < 2 * I_W1) {
            const int which = r / I_W1; r %= I_W1;
            const int e = r / 1024, r2 = r % 1024, kb = r2 / 64, nb = r2 % 64, n0 = nb * 32;
            const float* W = (which == 0 ? p.exp_w1 : p.exp_w3) + (size_t)e * D * FF;
            const int row = (n0 >> 7) * 256 + which * 128 + (n0 & 127);
            conv_item(W, FF, kb * 64, n0, W13T + ((size_t)e * 4096 + row) * D, D, scr, lane); continue;
        }
        r -= 2 * I_W1;
        { const int e = r / 1024, r2 = r % 1024, kb = r2 / 32, nb = r2 % 32;
          conv_item(p.exp_w2 + (size_t)e * FF * D, D, kb * 64, nb * 32, W2T + ((size_t)e * 1024 + nb * 32) * FF, FF, scr, lane); }
    }
}

__device__ __forceinline__ void ph_norm1(const P& p) {
    const int tid = opaque_tid(), lane = tid & 63, wv = tid >> 6, G = gridDim.x;
    const float* ADA = (const float*)(p.ws + WS_ADA);
    bf16_t* H = (bf16_t*)(p.ws + WS_H);
    bf16_t* HC = (bf16_t*)(p.ws + WS_HC);
    const int gw = blockIdx.x * 8 + wv, NGW = G * 8;
    for (int r = gw; r < NTOK + NCTX; r += NGW) {
        const float* src; bf16_t* dst; int ar;
        if (r < NTOK) { src = p.x + (size_t)r * D; dst = H + (size_t)r * D; ar = r / SEQ; }
        else { const int rc = r - NTOK; src = p.ctx + (size_t)rc * D; dst = HC + (size_t)rc * D; ar = 16; }
        float4 v[4]; float ss = 0.f;
#pragma unroll
        for (int j = 0; j < 4; ++j) { v[j] = ((const float4*)src)[lane + 64 * j]; ss += v[j].x * v[j].x + v[j].y * v[j].y + v[j].z * v[j].z + v[j].w * v[j].w; }
        ss = wave_sum(ss);
        const float rstd = rsqrtf(ss * (1.f / D) + EPS);
        const float* sh = ADA + ar * 6144, *sc = sh + 1024;
#pragma unroll
        for (int j = 0; j < 4; ++j) {
            const int d4 = lane + 64 * j;
            const float4 g = ((const float4*)p.norm1_g)[d4], s1 = ((const float4*)sc)[d4], h1 = ((const float4*)sh)[d4];
            float4 o;
            o.x = v[j].x * rstd * g.x * (1.f + s1.x) + h1.x; o.y = v[j].y * rstd * g.y * (1.f + s1.y) + h1.y;
            o.z = v[j].z * rstd * g.z * (1.f + s1.z) + h1.z; o.w = v[j].w * rstd * g.w * (1.f + s1.w) + h1.w;
            ((uint2*)dst)[d4] = make_uint2(pk2(o.x, o.y), pk2(o.z, o.w));
        }
    }
}
__device__ __forceinline__ void ph_filter(const P& p, float* lds) {
    const int tid = opaque_tid(), G = gridDim.x;
    const float* HID2 = (const float*)(p.ws + WS_HID2);
    float* HF = (float*)((unsigned char*)p.out + DO_HF);
    float* w3c = lds;
    float* red = lds + 128;
    const float min_decay = logf(1e-2f) / 1.5f, max_decay = logf(1e-2f) / 0.3f;
    __syncthreads();
    for (int item = blockIdx.x; item < 1024; item += G) {
        const int o = item >> 9, c = item & 511;
        if (tid < 128) { const int dir = tid >> 6, i = tid & 63; w3c[tid] = p.pos_w3[i * 2048 + o * 1024 + dir * 512 + c]; }
        __syncthreads();
        const float delta = fabsf(min_decay + (float)c * ((max_decay - min_decay) / 511.0f));
        float hv[4][2]; float asum = 0.f;
#pragma unroll
        for (int j = 0; j < 4; ++j) {
            const int t = tid + NT * j;
            float r0 = 0.f, r1 = 0.f;
            const float4* hp = (const float4*)(HID2 + t * 64);
#pragma unroll 4
            for (int i4 = 0; i4 < 16; ++i4) {
                const float4 h = hp[i4];
                r0 += h.x * w3c[i4 * 4 + 0] + h.y * w3c[i4 * 4 + 1] + h.z * w3c[i4 * 4 + 2] + h.w * w3c[i4 * 4 + 3];
                r1 += h.x * w3c[64 + i4 * 4 + 0] + h.y * w3c[64 + i4 * 4 + 1] + h.z * w3c[64 + i4 * 4 + 2] + h.w * w3c[64 + i4 * 4 + 3];
            }
            const float win = expf(-((float)t / 2047.0f) * delta) + 0.05f;
            hv[j][0] = r0 * win; hv[j][1] = r1 * win;
            asum += fabsf(hv[j][0]) + (t >= 1 ? fabsf(hv[j][1]) : 0.f);
        }
        asum = wave_sum(asum);
        if ((tid & 63) == 0) red[tid >> 6] = asum;
        __syncthreads();
        float tot = 0.f;
#pragma unroll
        for (int k = 0; k < 8; ++k) tot += red[k];
        const float inv = 1.f / (tot + EPS);
        float* dst = HF + (size_t)item * 4096;
#pragma unroll
        for (int j = 0; j < 4; ++j) {
            const int t = tid + NT * j;
            dst[2047 + t] = hv[j][0] * inv;
            if (t >= 1) dst[2047 - t] = hv[j][1] * inv;
        }
        if (tid == 0) dst[4095] = 0.f;
        __syncthreads();
    }
}

struct InprojSched {
    int G, c; const bf16_t *WinT, *H, *HC; bf16_t *PHYT, *PHG, *PC;
    __device__ __forceinline__ bool next(int i, Unit& u) const {
        int L = i * G + c; int pm, pn;
        u.aux = nullptr; u.gidx = nullptr; u.row0 = 0; u.col0 = 0;
        if (L < 768) { tile_of(L, 6, 128, pm, pn); u.a = (const char*)(WinT + (size_t)pm * 256 * D); u.b = (const char*)(H + (size_t)pn * 256 * D); u.c = PHYT + (size_t)pm * 256 * NTOK + pn * 256; u.ldc = NTOK; return true; }
        L -= 768;
        if (L < 1280) { tile_of(L, 128, 10, pm, pn); u.a = (const char*)(H + (size_t)pm * 256 * D); u.b = (const char*)(WinT + (size_t)(1536 + pn * 256) * D); u.c = PHG + (size_t)pm * 256 * 2560 + pn * 256; u.ldc = 2560; return true; }
        L -= 1280;
        if (L < 96) { tile_of(L, 16, 6, pm, pn); u.a = (const char*)(HC + (size_t)pm * 256 * D); u.b = (const char*)(WinT + (size_t)(2048 + pn * 256) * D); u.c = PC + (size_t)pm * 256 * 1536 + pn * 256; u.ldc = 1536; return true; }
        return false;
    }
    __device__ __forceinline__ void a_ready(const Unit&) const {}
    __device__ __forceinline__ void done(const Unit&) const {}
};
__device__ __forceinline__ void ph_inproj(const P& p, unsigned char* lds) {
    InprojSched S{(int)gridDim.x, (int)blockIdx.x, (const bf16_t*)((unsigned char*)p.out + DO_WINT), (const bf16_t*)(p.ws + WS_H), (const bf16_t*)(p.ws + WS_HC),
                  (bf16_t*)((unsigned char*)p.out + DO_PHYT), (bf16_t*)(p.ws + WS_PHG), (bf16_t*)(p.ws + WS_PC)};
    pg8::EpiStoreBf16 E;
    pg8::gemm_phase<pg8::EpiStoreBf16, InprojSched, true, true, false>((PG8_LAS unsigned char*)lds, D, S, E);
}

namespace hy {
#define HY_LAS __attribute__((address_space(3)))
typedef short bf16x8 __attribute__((ext_vector_type(8)));
typedef float f32x4 __attribute__((ext_vector_type(4)));
typedef unsigned u32x4 __attribute__((ext_vector_type(4)));
typedef unsigned u32x2 __attribute__((ext_vector_type(2)));
constexpr int U_STRIDE = 4112, UIMG = 0, U_BYTES = 16 * U_STRIDE;
constexpr int FILT = U_BYTES, F_STRIDE = 8288, F_BYTES = 8 * F_STRIDE;
constexpr int SCR = FILT + F_BYTES;
static_assert(SCR + 8192 <= LDS_BYTES, "hyena LDS map");

__device__ __forceinline__ float uni(float v) { return __uint_as_float(__builtin_amdgcn_readfirstlane(__float_as_uint(v))); }
struct ConvW { float w0, w1, w2, b; };
__device__ __forceinline__ ConvW load_convw(const P& p, int ch) { ConvW c; c.w0 = uni(p.hy_conv_w[ch]); c.w1 = uni(p.hy_conv_w[1536 + ch]); c.w2 = uni(p.hy_conv_w[3072 + ch]); c.b = uni(p.hy_conv_b[ch]); return c; }
__device__ __forceinline__ void load_u_image(const ConvW cw, HY_LAS unsigned char* L, const bf16_t* row, int tid) {
    const float cw0 = cw.w0, cw1 = cw.w1, cw2 = cw.w2, cb = cw.b;
#pragma unroll 2
    for (int k = 0; k < 8; ++k) {
        const int idx = tid + NT * k, b = idx >> 8, t8 = (idx & 255) * 8;
        const bf16_t* src = row + b * SEQ + t8;
        const u32x4 raw = *(const u32x4*)src;
        float x[10];
        x[0] = (t8 & 63) ? bf2f(src[-1]) : 0.f;
        x[9] = ((t8 + 8) & 63) ? bf2f(src[8]) : 0.f;
        x[1] = __uint_as_float(raw.x << 16); x[2] = __uint_as_float(raw.x & 0xffff0000u); x[3] = __uint_as_float(raw.y << 16); x[4] = __uint_as_float(raw.y & 0xffff0000u);
        x[5] = __uint_as_float(raw.z << 16); x[6] = __uint_as_float(raw.z & 0xffff0000u); x[7] = __uint_as_float(raw.w << 16); x[8] = __uint_as_float(raw.w & 0xffff0000u);
        float o[8];
#pragma unroll
        for (int e = 0; e < 8; ++e) o[e] = cb + cw1 * x[e + 1] + cw0 * x[e] + cw2 * x[e + 2];
        *(HY_LAS u32x4*)(L + UIMG + b * U_STRIDE + t8 * 2) = (u32x4){pk2(o[0], o[1]), pk2(o[2], o[3]), pk2(o[4], o[5]), pk2(o[6], o[7])};
    }
}
__device__ __forceinline__ void stage_raw_rows(HY_LAS unsigned char* L, const bf16_t* row, int tid) {
#pragma unroll 2
    for (int k = 0; k < 8; ++k) {
        const int idx = tid + NT * k, b = idx >> 8, t8 = (idx & 255) * 8;
        const u32x4 raw = *(const u32x4*)(row + b * SEQ + t8);
        HY_LAS unsigned char* d = L + FILT + b * U_STRIDE + 8 + t8 * 2;
        *(HY_LAS u32x2*)d = (u32x2){raw.x, raw.y}; *(HY_LAS u32x2*)(d + 8) = (u32x2){raw.z, raw.w};
    }
}
__device__ __forceinline__ void load_filter_scr(HY_LAS unsigned char* L, const float* hf, int tid) {
    const float4 a = ((const float4*)hf)[tid * 2], b = ((const float4*)hf)[tid * 2 + 1];
    *(HY_LAS u32x4*)(L + SCR + tid * 16) = (u32x4){pk2(a.x, a.y), pk2(a.z, a.w), pk2(b.x, b.y), pk2(b.z, b.w)};
}
__device__ __forceinline__ void build_filter_copies(HY_LAS unsigned char* L, int tid) {
    const HY_LAS bf16_t* sc = (const HY_LAS bf16_t*)(L + SCR);
    for (int gi = tid; gi < 8 * 518; gi += NT) {
        const int d = gi / 518, qg = gi - d * 518;
        const int top = 4095 + d - 8 * qg;
        unsigned v[8];
#pragma unroll
        for (int e = 0; e < 8; ++e) { const int ix = top - e; v[e] = (ix >= 0 && ix <= 4094) ? (unsigned)sc[ix] : 0u; }
        *(HY_LAS u32x4*)(L + FILT + d * F_STRIDE + qg * 16) = (u32x4){v[0] | (v[1] << 16), v[2] | (v[3] << 16), v[4] | (v[5] << 16), v[6] | (v[7] << 16)};
    }
}
__device__ __forceinline__ void conv_loop(HY_LAS unsigned char* L, f32x4 (&acc)[16], int w, int lane) {
    const int i = lane & 15, g = lane >> 4;
    const HY_LAS unsigned char* aBase = L + FILT + (i & 7) * F_STRIDE + 2 * (2048 + 8 * g - (i & ~7)) - 32 * (16 * w);
    const HY_LAS unsigned char* bBase = L + UIMG + i * U_STRIDE + 16 * g;
    bf16x8 ring[16];
#pragma unroll
    for (int s = 0; s < 16; ++s) ring[s] = *(const HY_LAS bf16x8*)(aBase - 32 * s);
#pragma unroll
    for (int m = 0; m < 16; ++m) acc[m] = (f32x4){0.f, 0.f, 0.f, 0.f};
    bf16x8 bfrag = *(const HY_LAS bf16x8*)(bBase);
    for (int k8 = 0; k8 < 8; ++k8) {
        const HY_LAS unsigned char* aK = aBase + 512 * k8;
        const HY_LAS unsigned char* bK = bBase + 512 * k8;
#pragma unroll
        for (int u = 0; u < 8; ++u) {
            bf16x8 bnext = bfrag;
            if (u < 7 || k8 < 7) bnext = *(const HY_LAS bf16x8*)(bK + 64 * (u + 1));
            acc[14] = __builtin_amdgcn_mfma_f32_16x16x32_bf16(ring[(14 - 2 * u) & 15], bfrag, acc[14], 0, 0, 0);
            acc[15] = __builtin_amdgcn_mfma_f32_16x16x32_bf16(ring[(15 - 2 * u) & 15], bfrag, acc[15], 0, 0, 0);
            if (u < 7 || k8 < 7) {
                ring[(14 - 2 * u) & 15] = *(const HY_LAS bf16x8*)(aK + 64 * u + 64);
                ring[(15 - 2 * u) & 15] = *(const HY_LAS bf16x8*)(aK + 64 * u + 32);
            }
#pragma unroll
            for (int m = 0; m < 14; ++m) acc[m] = __builtin_amdgcn_mfma_f32_16x16x32_bf16(ring[(m - 2 * u) & 15], bfrag, acc[m], 0, 0, 0);
            bfrag = bnext;
            __builtin_amdgcn_sched_barrier(0);
        }
    }
}
__device__ __forceinline__ void gate_acc(const ConvW cw, HY_LAS unsigned char* L, f32x4 (&acc)[16], float bias, int w, int lane) {
    const int j = lane & 15, g = lane >> 4;
    const float cw0 = cw.w0, cw1 = cw.w1, cw2 = cw.w2, cb = cw.b;
#pragma unroll
    for (int m = 0; m < 16; ++m) {
        const int t4 = 256 * w + 16 * m + 4 * g, tt0 = t4 & 63;
        const u32x2 uu = *(const HY_LAS u32x2*)(L + UIMG + j * U_STRIDE + t4 * 2);
        const HY_LAS unsigned char* xb = L + FILT + j * U_STRIDE + 8 + t4 * 2;
        const u32x2 xx = *(const HY_LAS u32x2*)xb;
        const float xl = tt0 > 0 ? bf2f(*(const HY_LAS bf16_t*)(xb - 2)) : 0.f;
        const float xr = tt0 < 60 ? bf2f(*(const HY_LAS bf16_t*)(xb + 8)) : 0.f;
        const float x0 = __uint_as_float(xx.x << 16), x1 = __uint_as_float(xx.x & 0xffff0000u), x2 = __uint_as_float(xx.y << 16), x3 = __uint_as_float(xx.y & 0xffff0000u);
        const float u0 = __uint_as_float(uu.x << 16), u1 = __uint_as_float(uu.x & 0xffff0000u), u2 = __uint_as_float(uu.y << 16), u3 = __uint_as_float(uu.y & 0xffff0000u);
        const float g0 = cb + cw1 * x0 + cw0 * xl + cw2 * x1, g1 = cb + cw1 * x1 + cw0 * x0 + cw2 * x2, g2 = cb + cw1 * x2 + cw0 * x1 + cw2 * x3, g3 = cb + cw1 * x3 + cw0 * x2 + cw2 * xr;
        acc[m][0] = g0 * (acc[m][0] + bias * u0); acc[m][1] = g1 * (acc[m][1] + bias * u1); acc[m][2] = g2 * (acc[m][2] + bias * u2); acc[m][3] = g3 * (acc[m][3] + bias * u3);
        if ((m & 3) == 3) __builtin_amdgcn_sched_barrier(0);
    }
}
__device__ __forceinline__ void store_acc_uimg(HY_LAS unsigned char* L, const f32x4 (&acc)[16], int w, int lane) {
    const int j = lane & 15, g = lane >> 4;
#pragma unroll
    for (int m = 0; m < 16; ++m) {
        const int t4 = 256 * w + 16 * m + 4 * g;
        *(HY_LAS u32x2*)(L + UIMG + j * U_STRIDE + t4 * 2) = (u32x2){pk2(acc[m][0], acc[m][1]), pk2(acc[m][2], acc[m][3])};
    }
}
}

__device__ __forceinline__ void ph_hyena_task(const P& p, unsigned char* ldsb, int c) {
    const int w = __builtin_amdgcn_readfirstlane(threadIdx.x >> 6);
    bf16_t* PHYT = (bf16_t*)((unsigned char*)p.out + DO_PHYT);
    const float* HF = (const float*)((unsigned char*)p.out + DO_HF);
    HY_LAS unsigned char* L = (HY_LAS unsigned char*)ldsb;
    {
        const int tid = opaque_tid();
        const int lane = tid & 63;
        hy::f32x4 acc[16];
        const hy::ConvW cwv = hy::load_convw(p, c), cwx1 = hy::load_convw(p, 512 + c), cwx2 = hy::load_convw(p, 1024 + c);
        const float bias0 = hy::uni(p.hy_bias[c]), bias1 = hy::uni(p.hy_bias[512 + c]);
        __syncthreads();
        hy::load_u_image(cwv, L, PHYT + (size_t)c * NTOK, tid);
        hy::load_filter_scr(L, HF + (size_t)c * 4096, tid);
        __syncthreads();
        hy::build_filter_copies(L, tid);
        __syncthreads();
        hy::conv_loop(L, acc, w, lane);
        __syncthreads();
        hy::stage_raw_rows(L, PHYT + (size_t)(512 + c) * NTOK, tid);
        hy::load_filter_scr(L, HF + (size_t)(512 + c) * 4096, tid);
        __syncthreads();
        hy::gate_acc(cwx1, L, acc, bias0, w, lane);
        __syncthreads();
        hy::store_acc_uimg(L, acc, w, lane);
        hy::build_filter_copies(L, tid);
        __syncthreads();
        hy::conv_loop(L, acc, w, lane);
        __syncthreads();
        hy::stage_raw_rows(L, PHYT + (size_t)(1024 + c) * NTOK, tid);
        __syncthreads();
        hy::gate_acc(cwx2, L, acc, bias1, w, lane);
        hy::store_acc_uimg(L, acc, w, lane);
        __syncthreads();
#pragma unroll 2
        for (int k = 0; k < 8; ++k) {
            const int idx = tid + NT * k, b = idx >> 8, t8 = (idx & 255) * 8;
            *(hy::u32x4*)(PHYT + (size_t)c * NTOK + b * SEQ + t8) = *(const HY_LAS hy::u32x4*)(L + hy::UIMG + b * hy::U_STRIDE + t8 * 2);
        }
    }
}


namespace hg {
#define HG_LAS __attribute__((address_space(3)))
typedef short bf16x8 __attribute__((ext_vector_type(8)));
typedef float f32x4 __attribute__((ext_vector_type(4)));
typedef unsigned u32x4 __attribute__((ext_vector_type(4)));
typedef unsigned u32x2 __attribute__((ext_vector_type(2)));
constexpr int QROW = 272, KROW = 40;
constexpr int O_QT = 0, O_KBAR = 16 * QROW, O_KHAT = 2 * 16 * QROW, O_VT = O_KHAT + 128 * KROW, O_BDEC = O_VT + 128 * KROW, SET_BYTES = O_BDEC + 512;
constexpr int NCH_CTX = CTXL / 16, NCH = NCH_CTX + SEQ / 16;
template <int CTRL> __device__ __forceinline__ float dpp_mul(float x) {
    return x * __uint_as_float(__builtin_amdgcn_update_dpp(0x3f800000u, __float_as_uint(x), CTRL, 0xf, 0xf, false));
}
struct Raw { unsigned short q[4], v[4], z[4]; };
}

__device__ __forceinline__ void ph_hgrn_task(const P& p, unsigned char* ldsb, int item) {
    using namespace hg;
    const int tid = opaque_tid();
    const int lane = tid & 63, w = __builtin_amdgcn_readfirstlane(tid >> 6), j = lane & 15, g = lane >> 4;
    const int dir = item & 1, h = (item >> 1) & 3, b = item >> 3;
    const float* LB = (const float*)(p.ws + WS_LB);
    const bf16_t* PC = (const bf16_t*)(p.ws + WS_PC);
    const bf16_t* PHG = (const bf16_t*)(p.ws + WS_PHG);
    bf16_t* OFB = (bf16_t*)(p.ws + WS_OFB) + (size_t)dir * NTOK * 512;
    HG_LAS unsigned char* L = (HG_LAS unsigned char*)ldsb;
    float lbv[4];
#pragma unroll
    for (int pp = 0; pp < 4; ++pp) lbv[pp] = LB[dir * 512 + h * 128 + 16 * w + 4 * pp + g];
    auto load_raw = [&](int n, Raw& r) {
        if (n < NCH_CTX) {
            const int tt = 16 * n + j, t = dir == 0 ? tt : (CTXL - 1 - tt);
            const bf16_t* row = PC + ((size_t)b * CTXL + t) * 1536 + h * 128 + 16 * w + g;
#pragma unroll
            for (int pp = 0; pp < 4; ++pp) { r.q[pp] = 0; r.v[pp] = row[4 * pp]; r.z[pp] = row[(dir == 0 ? 512 : 1024) + 4 * pp]; }
        } else {
            const int tt = 16 * (n - NCH_CTX) + j, t = dir == 0 ? tt : (SEQ - 1 - tt);
            const bf16_t* row = PHG + ((size_t)b * SEQ + t) * 2560 + h * 128 + 16 * w + g;
#pragma unroll
            for (int pp = 0; pp < 4; ++pp) { r.q[pp] = row[4 * pp]; r.v[pp] = row[512 + 4 * pp]; r.z[pp] = row[(dir == 0 ? 1024 : 1536) + 4 * pp]; }
        }
    };
    auto prep = [&](const Raw& r, HG_LAS unsigned char* S0) {
#pragma unroll
        for (int pp = 0; pp < 4; ++pp) {
            const int k = 16 * w + 4 * pp + g;
            const float z = bf2f(r.z[pp]), qr = bf2f(r.q[pp]);
            const float sg = __builtin_amdgcn_rcpf(1.0f + __builtin_amdgcn_exp2f(-1.4426950408889634f * z));
            const float f = lbv[pp] + (1.0f - lbv[pp]) * sg;
            float P = dpp_mul<0x111>(f); P = dpp_mul<0x112>(P); P = dpp_mul<0x114>(P); P = dpp_mul<0x118>(P);
            const float PC15 = __uint_as_float(__builtin_amdgcn_ds_bpermute(4 * (lane | 15), __float_as_uint(P)));
            const float invP = __builtin_amdgcn_rcpf(fmaxf(P, 1e-30f));
            const float kk = 1.0f - f;
            const float qv = qr * __builtin_amdgcn_rcpf(1.0f + __builtin_amdgcn_exp2f(-1.4426950408889634f * qr)) * 0.08838834764831845f * P;
            *(HG_LAS bf16_t*)(S0 + O_QT + j * QROW + 2 * k) = (bf16_t)f2bf(qv);
            *(HG_LAS bf16_t*)(S0 + O_KBAR + j * QROW + 2 * k) = (bf16_t)f2bf(kk * invP);
            *(HG_LAS bf16_t*)(S0 + O_KHAT + k * KROW + 2 * j) = (bf16_t)f2bf(kk * (PC15 * invP));
            *(HG_LAS bf16_t*)(S0 + O_VT + k * KROW + 2 * j) = r.v[pp];
            if (j == 15) *(HG_LAS float*)(S0 + O_BDEC + 4 * k) = P;
        }
    };
    f32x4 S[8];
#pragma unroll
    for (int t = 0; t < 8; ++t) S[t] = (f32x4){0.f, 0.f, 0.f, 0.f};
    Raw rcur, rnext;
    load_raw(0, rcur);
    __syncthreads();
    prep(rcur, L);
    load_raw(1, rcur);
    __syncthreads();
    for (int n = 0; n < NCH; ++n) {
        HG_LAS unsigned char* Sc = L + (n & 1) * SET_BYTES;
        HG_LAS unsigned char* Sn = L + ((n + 1) & 1) * SET_BYTES;
        if (n + 2 < NCH) load_raw(n + 2, rnext);
        if (n + 1 < NCH) prep(rcur, Sn);
        f32x4 sc = (f32x4){0.f, 0.f, 0.f, 0.f};
#pragma unroll
        for (int kp = 0; kp < 4; ++kp) {
            const bf16x8 a = *(const HG_LAS bf16x8*)(Sc + O_KBAR + j * QROW + 2 * (8 * g + 32 * kp));
            const bf16x8 bq = *(const HG_LAS bf16x8*)(Sc + O_QT + j * QROW + 2 * (8 * g + 32 * kp));
            sc = __builtin_amdgcn_mfma_f32_16x16x32_bf16(a, bq, sc, 0, 0, 0);
        }
        u32x4 pf;
        pf.x = pk2((4 * g + 0) <= j ? sc[0] : 0.f, (4 * g + 1) <= j ? sc[1] : 0.f);
        pf.y = pk2((4 * g + 2) <= j ? sc[2] : 0.f, (4 * g + 3) <= j ? sc[3] : 0.f);
        pf.z = 0u; pf.w = 0u;
        const u32x2 vraw = *(const HG_LAS u32x2*)(Sc + O_VT + (16 * w + j) * KROW + 8 * g);
        const u32x4 vf = (u32x4){vraw.x, vraw.y, 0u, 0u};
        f32x4 oT = (f32x4){0.f, 0.f, 0.f, 0.f};
#pragma unroll
        for (int pq = 0; pq < 4; ++pq) {
            u32x4 a; a.x = pk2(S[2 * pq][0], S[2 * pq][1]); a.y = pk2(S[2 * pq][2], S[2 * pq][3]); a.z = pk2(S[2 * pq + 1][0], S[2 * pq + 1][1]); a.w = pk2(S[2 * pq + 1][2], S[2 * pq + 1][3]);
            const u32x2 b0 = *(const HG_LAS u32x2*)(Sc + O_QT + j * QROW + 2 * (32 * pq + 4 * g));
            const u32x2 b1 = *(const HG_LAS u32x2*)(Sc + O_QT + j * QROW + 2 * (32 * pq + 16 + 4 * g));
            const u32x4 bb = (u32x4){b0.x, b0.y, b1.x, b1.y};
            oT = __builtin_amdgcn_mfma_f32_16x16x32_bf16(__builtin_bit_cast(bf16x8, a), __builtin_bit_cast(bf16x8, bb), oT, 0, 0, 0);
        }
        oT = __builtin_amdgcn_mfma_f32_16x16x32_bf16(__builtin_bit_cast(bf16x8, vf), __builtin_bit_cast(bf16x8, pf), oT, 0, 0, 0);
        if (n >= NCH_CTX) {
            const int tt = 16 * (n - NCH_CTX) + j, t = dir == 0 ? tt : (SEQ - 1 - tt);
            *(u32x2*)(OFB + ((size_t)b * SEQ + t) * 512 + h * 128 + 16 * w + 4 * g) = (u32x2){pk2(oT[0], oT[1]), pk2(oT[2], oT[3])};
        }
#pragma unroll
        for (int t = 0; t < 8; ++t) {
            const f32x4 bd = *(const HG_LAS f32x4*)(Sc + O_BDEC + 4 * (16 * t + 4 * g));
            const u32x2 kr = *(const HG_LAS u32x2*)(Sc + O_KHAT + (16 * t + j) * KROW + 8 * g);
            const u32x4 ka = (u32x4){kr.x, kr.y, 0u, 0u};
            S[t] = __builtin_amdgcn_mfma_f32_16x16x32_bf16(__builtin_bit_cast(bf16x8, ka), __builtin_bit_cast(bf16x8, vf), S[t] * bd, 0, 0, 0);
        }
        rcur = rnext;
        __syncthreads();
    }
}

__device__ __forceinline__ void ph_mixers(const P& p, unsigned char* ldsb) {
    unsigned* qhead = (unsigned*)(p.ws + WS_CTL) + CW_QHEAD;
    HG_LAS unsigned* bc = (HG_LAS unsigned*)(ldsb + LDS_BYTES - 16);
    if (blockIdx.x < NB * HEADS * 2) ph_hgrn_task(p, ldsb, blockIdx.x);
    for (;;) {
        __syncthreads();
        if (threadIdx.x == 0) *bc = atomicAdd(qhead, 1u);
        __syncthreads();
        const int c = (int)*bc;
        if (c >= 512) break;
        ph_hyena_task(p, ldsb, c);
    }
}

__device__ __forceinline__ void ph_mixprep(const P& p, float* lds) {
    const int tid = opaque_tid(), lane = tid & 63, wv = tid >> 6;
    const bf16_t* YT = (const bf16_t*)((unsigned char*)p.out + DO_PHYT);
    bf16_t* MIXA = (bf16_t*)(p.ws + WS_MIXA);
    bf16_t* yl = (bf16_t*)lds;
    float* part = lds + (512 * 72 * 2) / 4;
    for (int tile = blockIdx.x; tile < NTOK / 64; tile += gridDim.x) {
        const int tok0 = tile * 64;
        __syncthreads();
        for (int i = tid; i < 512 * 8; i += NT) { const int row = i >> 3, ch = i & 7; *(uint4*)(yl + row * 72 + ch * 8) = *(const uint4*)(YT + (size_t)row * NTOK + tok0 + ch * 8); }
        __syncthreads();
        const int tok = tid & 63, pt = tid >> 6;
        float ss = 0.f;
        for (int c = pt * 64; c < pt * 64 + 64; ++c) { const float v = bf2f(yl[c * 72 + tok]); ss += v * v; }
        part[pt * 64 + tok] = ss;
        __syncthreads();
        float tot = 0.f;
#pragma unroll
        for (int k = 0; k < 8; ++k) tot += part[k * 64 + tok];
        const float rstd = rsqrtf(tot * (1.f / 512.f) + EPS);
        bf16_t* dst = MIXA + (size_t)(tok0 + tok) * D + pt * 64;
#pragma unroll
        for (int j = 0; j < 8; ++j) {
            float o[8];
#pragma unroll
            for (int q = 0; q < 8; ++q) { const int c = pt * 64 + j * 8 + q; o[q] = bf2f(yl[c * 72 + tok]) * rstd * p.hy_norm_g[c]; }
            *(uint4*)(dst + j * 8) = make_uint4(pk2(o[0], o[1]), pk2(o[2], o[3]), pk2(o[4], o[5]), pk2(o[6], o[7]));
        }
    }
    const bf16_t* OFB = (const bf16_t*)(p.ws + WS_OFB);
    const bf16_t* PHG = (const bf16_t*)(p.ws + WS_PHG);
    for (int r = blockIdx.x * 8 + wv; r < NTOK; r += gridDim.x * 8) {
#pragma unroll
        for (int h = 0; h < HEADS; ++h) {
            const int k = lane * 2;
            const unsigned a = *(const unsigned*)(OFB + (size_t)r * 512 + h * 128 + k);
            const unsigned bq = *(const unsigned*)(OFB + (size_t)NTOK * 512 + (size_t)r * 512 + h * 128 + k);
            const float o0 = __uint_as_float(a << 16) + __uint_as_float(bq << 16), o1 = __uint_as_float(a & 0xffff0000u) + __uint_as_float(bq & 0xffff0000u);
            const float ss = wave_sum(o0 * o0 + o1 * o1);
            const float rstd = rsqrtf(ss * (1.f / 128.f) + EPS);
            const unsigned g = *(const unsigned*)(PHG + (size_t)r * 2560 + 2048 + h * 128 + k);
            const float2 ng = *(const float2*)(p.hg_norm_g + k);
            *(unsigned*)(MIXA + (size_t)r * D + 512 + h * 128 + k) = pk2(o0 * rstd * ng.x * siluf_(__uint_as_float(g << 16)), o1 * rstd * ng.y * siluf_(__uint_as_float(g & 0xffff0000u)));
        }
    }
}

struct OutprojSched {
    int G, c; const bf16_t *A, *Bt;
    __device__ __forceinline__ bool next(int i, Unit& u) const {
        const int L = i * G + c; if (L >= 512) return false; int pm, pn; tile_of(L, 128, 4, pm, pn);
        u.a = (const char*)(A + (size_t)pm * 256 * D); u.b = (const char*)(Bt + (size_t)pn * 256 * D); u.c = nullptr; u.aux = nullptr; u.gidx = nullptr; u.ldc = D; u.row0 = pm * 256; u.col0 = pn * 256; return true;
    }
    __device__ __forceinline__ void a_ready(const Unit&) const {}
    __device__ __forceinline__ void done(const Unit&) const {}
};
__device__ __forceinline__ void ph_outproj(const P& p, unsigned char* lds) {
    OutprojSched S{(int)gridDim.x, (int)blockIdx.x, (const bf16_t*)(p.ws + WS_MIXA), (const bf16_t*)(p.ws + WS_WOUTT)};
    pg8::EpiOutProj E{p.x, (const float*)(p.ws + WS_ADA), p.out};
    pg8::gemm_phase<pg8::EpiOutProj, OutprojSched, true, true, false>((PG8_LAS unsigned char*)lds, D, S, E);
}

__device__ __forceinline__ void ph_norm2_router(const P& p, float* lds) {
    const int tid = opaque_tid(), lane = tid & 63, wv = tid >> 6;
    const float* ADA = (const float*)(p.ws + WS_ADA);
    const float* X1 = p.out;
    bf16_t* H2 = (bf16_t*)(p.ws + WS_H2);
    float* AFF = (float*)(p.ws + WS_AFF);
    __syncthreads();
    for (int i = tid; i < D * 4; i += NT) { const int d = i >> 2, e4 = i & 3; const float4 w = ((const float4*)p.router_w)[i];
        lds[(e4 * 4 + 0) * D + d] = w.x; lds[(e4 * 4 + 1) * D + d] = w.y; lds[(e4 * 4 + 2) * D + d] = w.z; lds[(e4 * 4 + 3) * D + d] = w.w; }
    __syncthreads();
    for (int r = blockIdx.x * 8 + wv; r < NTOK; r += gridDim.x * 8) {
        const int b = r / SEQ, t = r % SEQ;
        float4 v[4]; float ss = 0.f;
#pragma unroll
        for (int j = 0; j < 4; ++j) { v[j] = ((const float4*)(X1 + (size_t)r * D))[lane + 64 * j]; ss += v[j].x * v[j].x + v[j].y * v[j].y + v[j].z * v[j].z + v[j].w * v[j].w; }
        const float rstd = rsqrtf(wave_sum(ss) * (1.f / D) + EPS);
        const float* sh = ADA + b * 6144 + 3072, *sc = ADA + b * 6144 + 4096;
        float lg[16];
#pragma unroll
        for (int e = 0; e < 16; ++e) lg[e] = 0.f;
#pragma unroll
        for (int j = 0; j < 4; ++j) {
            const int d4 = lane + 64 * j;
            const float4 g = ((const float4*)p.norm2_g)[d4], s1 = ((const float4*)sc)[d4], h1 = ((const float4*)sh)[d4];
            float4 o;
            o.x = v[j].x * rstd * g.x * (1.f + s1.x) + h1.x; o.y = v[j].y * rstd * g.y * (1.f + s1.y) + h1.y;
            o.z = v[j].z * rstd * g.z * (1.f + s1.z) + h1.z; o.w = v[j].w * rstd * g.w * (1.f + s1.w) + h1.w;
            ((uint2*)(H2 + (size_t)r * D))[d4] = make_uint2(pk2(o.x, o.y), pk2(o.z, o.w));
#pragma unroll
            for (int e = 0; e < 16; ++e) {
                const float4 w = *(const float4*)&lds[e * D + d4 * 4];
                lg[e] += o.x * w.x + o.y * w.y + o.z * w.z + o.w * w.w;
            }
            __builtin_amdgcn_sched_barrier(0);
        }
#pragma unroll
        for (int e = 0; e < 16; ++e) lg[e] = wave_sum(lg[e]);
        float mx = lg[0];
#pragma unroll
        for (int e = 1; e < 16; ++e) mx = fmaxf(mx, lg[e]);
        float den = 0.f;
#pragma unroll
        for (int e = 0; e < 16; ++e) { lg[e] = expf(lg[e] - mx); den += lg[e]; }
        const float inv = 1.f / den;
        if (lane < 16) {
            float val = 0.f;
#pragma unroll
            for (int e = 0; e < 16; ++e) val = (lane == e) ? lg[e] : val;
            AFF[((size_t)b * 16 + lane) * SEQ + t] = val * inv;
        }
    }
}

__device__ __forceinline__ void ph_topk(const P& p, float* lds) {
    const int tid = opaque_tid(), lane = tid & 63, wv = tid >> 6;
    const float* AFF = (const float*)(p.ws + WS_AFF);
    int* IDX = (int*)(p.ws + WS_IDX);
    float* GATE = (float*)(p.ws + WS_GATE);
    int* INV = (int*)(p.ws + WS_INV);
    unsigned* hist = (unsigned*)lds;
    unsigned* ctl = hist + 256;
    unsigned* wtot = hist + 272;
    for (int item = blockIdx.x; item < NB * NE; item += gridDim.x) {
        const int b = item >> 4, e = item & 15;
        const uint4 kk = ((const uint4*)(AFF + (size_t)item * SEQ))[tid];
        const unsigned key[4] = {kk.x, kk.y, kk.z, kk.w};
        unsigned prefix = 0u, need = CAP;
#pragma unroll
        for (int pass = 3; pass >= 0; --pass) {
            __syncthreads();
            if (tid < 256) hist[tid] = 0u;
            __syncthreads();
#pragma unroll
            for (int q = 0; q < 4; ++q) {
                const bool in = (pass == 3) || ((key[q] >> (8 * (pass + 1))) == prefix);
                if (in) atomicAdd(&hist[(key[q] >> (8 * pass)) & 255u], 1u);
            }
            __syncthreads();
            if (wv == 0) {
                const uint4 h4 = ((const uint4*)hist)[lane];
                const unsigned loc = h4.x + h4.y + h4.z + h4.w;
                unsigned suf = loc;
#pragma unroll
                for (int o = 1; o < 64; o <<= 1) { const unsigned y = __shfl_down(suf, o); if (lane + o < 64) suf += y; }
                const unsigned above = suf - loc;
                unsigned c3 = above + h4.w, c2 = c3 + h4.z, c1 = c2 + h4.y, c0 = c1 + h4.x;
                int bin = -1; unsigned nneed = 0u;
                if (above < need && c0 >= need) {
                    if (c3 >= need) { bin = 4 * lane + 3; nneed = need - above; }
                    else if (c2 >= need) { bin = 4 * lane + 2; nneed = need - c3; }
                    else if (c1 >= need) { bin = 4 * lane + 1; nneed = need - c2; }
                    else { bin = 4 * lane; nneed = need - c1; }
                    ctl[0] = (prefix << 8) | (unsigned)bin; ctl[1] = nneed;
                }
            }
            __syncthreads();
            prefix = ctl[0]; need = ctl[1];
        }
        unsigned cgt = 0u, ceq = 0u;
#pragma unroll
        for (int q = 0; q < 4; ++q) { cgt += key[q] > prefix ? 1u : 0u; ceq += key[q] == prefix ? 1u : 0u; }
        unsigned sgt = cgt, seq = ceq;
#pragma unroll
        for (int o = 1; o < 64; o <<= 1) { const unsigned y1 = __shfl_up(sgt, o), y2 = __shfl_up(seq, o); if (lane >= o) { sgt += y1; seq += y2; } }
        if (lane == 63) { wtot[wv] = sgt; wtot[8 + wv] = seq; }
        __syncthreads();
        unsigned bgt = 0u, beq = 0u, ngt = 0u;
#pragma unroll
        for (int k = 0; k < 8; ++k) { const unsigned a = wtot[k], c = wtot[8 + k]; if (k < wv) { bgt += a; beq += c; } ngt += a; }
        unsigned rgt = bgt + sgt - cgt, req = beq + seq - ceq;
#pragma unroll
        for (int q = 0; q < 4; ++q) {
            const int t = 4 * tid + q; int slot = -1;
            if (key[q] > prefix) { slot = (int)rgt; ++rgt; }
            else if (key[q] == prefix) { if (req < need) slot = (int)(ngt + req); ++req; }
            if (slot >= 0) { IDX[item * CAP + slot] = t; GATE[item * CAP + slot] = __uint_as_float(key[q]); }
            INV[((size_t)b * SEQ + t) * 16 + e] = slot;
        }
    }
}

struct MoeUpSched {
    int G, c; const bf16_t *H2, *W13T; bf16_t* HMID; const int* IDX;
    __device__ __forceinline__ bool next(int i, Unit& u) const {
        if (i >= 16 || c >= 256) return false;
        const int item = c, b = item >> 4, e = item & 15, nt = i;
        u.a = (const char*)(H2 + (size_t)b * SEQ * D); u.b = (const char*)(W13T + ((size_t)e * 4096 + nt * 256) * D); u.c = HMID + (size_t)item * CAP * FF + nt * 128;
        u.aux = nullptr; u.gidx = IDX + item * CAP; u.ldc = FF; u.row0 = 0; u.col0 = 0; return true;
    }
    __device__ __forceinline__ void a_ready(const Unit&) const {}
    __device__ __forceinline__ void done(const Unit&) const {}
};
struct MoeDownSched {
    int G, c; const bf16_t *HMID, *W2T; bf16_t* YS; const float* GATE;
    __device__ __forceinline__ bool next(int i, Unit& u) const {
        if (i >= 4 || c >= 256) return false;
        const int item = c, e = item & 15, nt = i;
        u.a = (const char*)(HMID + (size_t)item * CAP * FF); u.b = (const char*)(W2T + ((size_t)e * 1024 + nt * 256) * FF); u.c = YS + (size_t)item * CAP * D + nt * 256;
        u.aux = GATE + item * CAP; u.gidx = nullptr; u.ldc = D; u.row0 = 0; u.col0 = 0; return true;
    }
    __device__ __forceinline__ void a_ready(const Unit&) const {}
    __device__ __forceinline__ void done(const Unit&) const {}
};
__device__ __forceinline__ void ph_moe_up(const P& p, unsigned char* lds) {
    MoeUpSched S{(int)gridDim.x, (int)blockIdx.x, (const bf16_t*)(p.ws + WS_H2), (const bf16_t*)(p.ws + WS_W13T), (bf16_t*)(p.ws + WS_HMID), (const int*)(p.ws + WS_IDX)};
    pg8::EpiSwiGLU E;
    pg8::gemm_phase<pg8::EpiSwiGLU, MoeUpSched, true, true, true>((PG8_LAS unsigned char*)lds, D, S, E);
}
__device__ __forceinline__ void ph_moe_down(const P& p, unsigned char* lds) {
    MoeDownSched S{(int)gridDim.x, (int)blockIdx.x, (const bf16_t*)(p.ws + WS_HMID), (const bf16_t*)(p.ws + WS_W2T), (bf16_t*)(p.ws + WS_YS), (const float*)(p.ws + WS_GATE)};
    pg8::EpiDown E;
    pg8::gemm_phase<pg8::EpiDown, MoeDownSched, true, true, false>((PG8_LAS unsigned char*)lds, FF, S, E);
}

__device__ __forceinline__ void ph_final(const P& p) {
    const int tid = opaque_tid(), lane = tid & 63, wv = tid >> 6;
    const float* ADA = (const float*)(p.ws + WS_ADA);
    const bf16_t* YS = (const bf16_t*)(p.ws + WS_YS);
    const int* INV = (const int*)(p.ws + WS_INV);
    float* X = p.out;
    for (int r = blockIdx.x * 8 + wv; r < NTOK; r += gridDim.x * 8) {
        const int b = r / SEQ;
        const float* g2 = ADA + b * 6144 + 5120;
        float4 acc[4];
#pragma unroll
        for (int j = 0; j < 4; ++j) acc[j] = make_float4(0.f, 0.f, 0.f, 0.f);
        const int myinv = INV[(size_t)r * 16 + (lane & 15)];
#pragma unroll
        for (int e = 0; e < 16; ++e) {
            const int slot = __shfl(myinv, e);
            if (slot >= 0) {
                const uint2* yr = (const uint2*)(YS + ((size_t)(b * 16 + e) * CAP + slot) * D);
#pragma unroll
                for (int j = 0; j < 4; ++j) { const uint2 w = yr[lane + 64 * j];
                    acc[j].x += __uint_as_float(w.x << 16); acc[j].y += __uint_as_float(w.x & 0xffff0000u); acc[j].z += __uint_as_float(w.y << 16); acc[j].w += __uint_as_float(w.y & 0xffff0000u); }
            }
        }
        float4 v[4]; float ss = 0.f;
#pragma unroll
        for (int j = 0; j < 4; ++j) {
            const int d4 = lane + 64 * j;
            const float4 xv = ((const float4*)(X + (size_t)r * D))[d4], g = ((const float4*)g2)[d4];
            v[j] = make_float4(xv.x + g.x * acc[j].x, xv.y + g.y * acc[j].y, xv.z + g.z * acc[j].z, xv.w + g.w * acc[j].w);
            ss += v[j].x * v[j].x + v[j].y * v[j].y + v[j].z * v[j].z + v[j].w * v[j].w;
        }
        ss = wave_sum(ss);
        const float rstd = rsqrtf(ss * (1.f / D) + EPS);
#pragma unroll
        for (int j = 0; j < 4; ++j) {
            const int d4 = lane + 64 * j;
            const float4 g = ((const float4*)p.final_g)[d4];
            ((float4*)(X + (size_t)r * D))[d4] = make_float4(v[j].x * rstd * g.x, v[j].y * rstd * g.y, v[j].z * rstd * g.z, v[j].w * rstd * g.w);
        }
    }
}

#define LAS __attribute__((address_space(3)))
#define XB_TMO      128
#define XB_XCNT(j)  (256  + 64 * (j))
#define XB_XSUB(j)  (1280 + 64 * (j))
#define XB_XGEN(j)  (2304 + 64 * (j))
#define XB_TOP      3328
#define XB_TOPGEN   3392
#define XCD_BAR_WORDS 3456
#define XB_SPIN_CAP (1u << 18)

__device__ __forceinline__ unsigned xb_ld(unsigned* p)              { return __hip_atomic_load(p, __ATOMIC_RELAXED, __HIP_MEMORY_SCOPE_AGENT); }
__device__ __forceinline__ unsigned xb_add(unsigned* p, unsigned v) { return __hip_atomic_fetch_add(p, v, __ATOMIC_RELAXED, __HIP_MEMORY_SCOPE_AGENT); }
__device__ __forceinline__ unsigned xb_xcc_id() { return (unsigned)__builtin_amdgcn_s_getreg((3 << 11) | 20) & 0xFu; }
#define XB_SPIN(cond, bar) do { unsigned _sp = 0; while (cond) { __builtin_amdgcn_s_sleep(1); \
    if ((++_sp & 255u) == 0u) { if (xb_ld(&(bar)[XB_TMO])) break; if (_sp > XB_SPIN_CAP) { atomicAdd(&(bar)[XB_TMO], 1u); break; } } } } while (0)

struct XcdBarrier {
    unsigned* bar; unsigned x;
    volatile LAS unsigned* st;
};

__device__ __forceinline__ XcdBarrier xcd_barrier_post(unsigned* bar, volatile LAS unsigned* st) {
    XcdBarrier b; b.bar = bar; b.x = xb_xcc_id(); b.st = st;
    if (threadIdx.x == 0) (void)xb_add(&bar[XB_XCNT(b.x)], 1u);
    return b;
}
__device__ __forceinline__ void xcd_barrier_complete(unsigned* bar, unsigned x, unsigned& nloc, unsigned& nx) {
    const unsigned G = gridDim.x * gridDim.y * gridDim.z;
    unsigned sum, cnt, mine, sp = 0u;
    for (;;) {
        sum = 0u; cnt = 0u; mine = 0u;
#pragma unroll
        for (unsigned j = 0; j < 16; ++j) { const unsigned c = xb_ld(&bar[XB_XCNT(j)]); sum += c; cnt += (c > 0u) ? 1u : 0u; mine = (j == x) ? c : mine; }
        if (sum == G) break;
        __builtin_amdgcn_s_sleep(1);
        if ((++sp & 255u) == 0u) { if (xb_ld(&bar[XB_TMO])) break; if (sp > XB_SPIN_CAP) { atomicAdd(&bar[XB_TMO], 1u); break; } }
    }
    nloc = mine > 0u ? mine : 1u; nx = cnt > 0u ? cnt : 1u;
}

__device__ __forceinline__ void xcd_barrier(const XcdBarrier& b) {
    asm volatile("s_waitcnt vmcnt(0)" ::: "memory");
    __syncthreads();
    if (threadIdx.x == 0) {
        unsigned* bar = b.bar;
        __builtin_amdgcn_s_waitcnt(0);
        unsigned nloc = b.st[0], nx = b.st[1];
        if (nloc == 0u) { xcd_barrier_complete(bar, b.x, nloc, nx); b.st[0] = nloc; b.st[1] = nx; }
        const unsigned old = xb_add(&bar[XB_XSUB(b.x)], 1u);
        const unsigned gen = old / nloc;
        if (old + 1u == (gen + 1u) * nloc) {
            __builtin_amdgcn_fence(__ATOMIC_RELEASE, "agent");
            asm volatile("s_waitcnt vmcnt(0)" ::: "memory");
            const unsigned og = xb_add(&bar[XB_TOP], 1u);
            const unsigned tg = og / nx;
            if (og + 1u == (tg + 1u) * nx) xb_add(&bar[XB_TOPGEN], 1u);
            else XB_SPIN(xb_ld(&bar[XB_TOPGEN]) == tg, bar);
            __builtin_amdgcn_fence(__ATOMIC_ACQUIRE, "agent");
            xb_add(&bar[XB_XGEN(b.x)], 1u);
            asm volatile("s_waitcnt vmcnt(0)" ::: "memory");
        } else {
            XB_SPIN(xb_ld(&bar[XB_XGEN(b.x)]) == gen, bar);
            __builtin_amdgcn_fence(__ATOMIC_ACQUIRE, "agent");
            asm volatile("s_waitcnt vmcnt(0)" ::: "memory");
        }
    }
    __syncthreads();
}

constexpr int N_PHASES = 11;
template <int PH>
__device__ __forceinline__ void run_phase(const P& p, unsigned char* ldsb) {
    float* lds = (float*)ldsb;
    if constexpr (PH == 0) { ph_prep(p, lds); ph_convert(p, lds); }
    else if constexpr (PH == 1) { ph_norm1(p); ph_filter(p, lds); }
    else if constexpr (PH == 2) ph_inproj(p, ldsb);
    else if constexpr (PH == 3) ph_mixers(p, ldsb);
    else if constexpr (PH == 4) ph_mixprep(p, lds);
    else if constexpr (PH == 5) ph_outproj(p, ldsb);
    else if constexpr (PH == 6) ph_norm2_router(p, lds);
    else if constexpr (PH == 7) ph_topk(p, lds);
    else if constexpr (PH == 8) ph_moe_up(p, ldsb);
    else if constexpr (PH == 9) ph_moe_down(p, ldsb);
    else if constexpr (PH == 10) ph_final(p);
}
template <int PH>
__device__ __forceinline__ void run_from(const P& p, unsigned char* lds, const XcdBarrier& bar) {
    if constexpr (PH < N_PHASES) {
        run_phase<PH>(p, lds);
        if constexpr (PH + 1 < N_PHASES) xcd_barrier(bar);
        run_from<PH + 1>(p, lds, bar);
    }
}
__global__ void __launch_bounds__(NT, 2) fwd_all(P p) {
    extern __shared__ __attribute__((aligned(16))) unsigned char lds_raw[];
    volatile LAS unsigned* st = (volatile LAS unsigned*)(lds_raw + LDS_BYTES - 32);
    if (threadIdx.x < 2) st[threadIdx.x] = 0u;
    __syncthreads();
    const XcdBarrier bar = xcd_barrier_post((unsigned*)(p.ws + WS_CTL) + CW_BAR, st);
    run_from<0>(p, lds_raw, bar);
}

extern "C" void kernel_launch(void* const* d_in, const int* in_sizes, int n_in, void* d_out, int out_size, void* d_ws, size_t ws_size, hipStream_t stream) {
    static int grid = 0;
    if (grid == 0) {
        int dev = 0, cus = 0, per_cu = 0;
        (void)hipGetDevice(&dev);
        (void)hipDeviceGetAttribute(&cus, hipDeviceAttributeMultiprocessorCount, dev);
        (void)hipFuncSetAttribute((const void*)fwd_all, hipFuncAttributeMaxDynamicSharedMemorySize, LDS_BYTES);
        (void)hipOccupancyMaxActiveBlocksPerMultiprocessor(&per_cu, (const void*)fwd_all, NT, LDS_BYTES);
        if (per_cu < 1) fprintf(stderr, "kernel_launch: occupancy query says %d blocks/CU\n", per_cu);
        grid = (cus > 0 ? cus : 256);
        if (ws_size < WS_END) fprintf(stderr, "kernel_launch: workspace too small: %zu < %zu\n", ws_size, (size_t)WS_END);
    }
    P p{};
    const float** f = (const float**)&p;
    for (int i = 0; i < 28; ++i) f[i] = (const float*)d_in[i];
    p.out = (float*)d_out;
    p.ws = (unsigned char*)d_ws;
    p.ph_lo = 0; p.ph_hi = N_PHASES;
    (void)hipMemsetAsync((unsigned char*)d_ws + WS_CTL, 0, CTL_ZERO_BYTES, stream);
    hipLaunchKernelGGL(fwd_all, dim3(grid), dim3(NT), LDS_BYTES, stream, p);
}
```

```cpp
#include <hip/hip_runtime.h>
#include <cstdio>
#include <cstdint>

constexpr int D = 1024, NB = 16, SEQ = 2048, CTXL = 256;
constexpr int NTOK = NB * SEQ;
constexpr int NCTX = NB * CTXL;
constexpr int HEADS = 4;
constexpr int INC = 4096;
constexpr int NE = 16, CAP = 256, FF = 2048;
constexpr int NT = 512;
constexpr int LDS_BYTES = 147456;
constexpr float EPS = 1e-6f;
typedef unsigned short bf16_t;

constexpr size_t MiB = 1u << 20;
constexpr size_t WS_CTL = 0;
constexpr size_t WS_ADA = 1 * MiB;
constexpr size_t WS_LB = WS_ADA + 512 * 1024;
constexpr size_t WS_HID2 = 2 * MiB;
constexpr size_t WS_AFF = 3 * MiB;
constexpr size_t WS_IDX = 5 * MiB;
constexpr size_t WS_GATE = 5 * MiB + 512 * 1024;
constexpr size_t WS_INV = 6 * MiB;
constexpr size_t WS_W13T = 8 * MiB;
constexpr size_t WS_YS = WS_W13T;
constexpr size_t WS_W2T = 136 * MiB;
constexpr size_t WS_R = 200 * MiB;
constexpr size_t WS_H = WS_R;
constexpr size_t WS_MIXA = WS_R;
constexpr size_t WS_HC = WS_R + 64 * MiB;
constexpr size_t WS_PC = WS_R + 72 * MiB;
constexpr size_t WS_OFB = WS_R + 84 * MiB;
constexpr size_t WS_WOUTT = WS_R + 148 * MiB;
constexpr size_t WS_PHG = WS_R + 152 * MiB;
constexpr size_t WS_HMID = WS_R;
constexpr size_t WS_H2 = WS_R + 256 * MiB;
constexpr size_t WS_YT = WS_R + 320 * MiB;
constexpr size_t WS_END = WS_YT + 32 * MiB;
constexpr int CW_QHEAD = 64;
constexpr int CW_BAR = 4096;
constexpr size_t CTL_ZERO_BYTES = 65536;
constexpr size_t DO_PHYT = 0;
constexpr size_t DO_HF = 96 * MiB;
constexpr size_t DO_SCTX = 112 * MiB;
constexpr size_t DO_WINT = 120 * MiB;

struct P {
    const float *x, *c, *ctx, *c_ctx, *ada_w, *ada_b, *norm1_g, *w_in, *hy_conv_w, *hy_conv_b, *pos_w1, *pos_b1, *freq1, *pos_w2, *pos_b2,
        *freq2, *pos_w3, *hy_bias, *hy_norm_g, *hg_lb, *hg_norm_g, *w_out, *norm2_g, *router_w, *exp_w1, *exp_w3, *exp_w2, *final_g;
    float* out;
    unsigned char* ws;
    int ph_lo, ph_hi;
};

__device__ __forceinline__ int opaque_tid() { int t = threadIdx.x; asm volatile("" : "+v"(t)); return t; }
__device__ __forceinline__ void lds_barrier() { asm volatile("s_waitcnt lgkmcnt(0)" ::: "memory"); __builtin_amdgcn_s_barrier(); asm volatile("" ::: "memory"); }
typedef float f32x4_t __attribute__((ext_vector_type(4)));
__device__ __forceinline__ float wave_sum(float v) {
#pragma unroll
    for (int o = 1; o < 64; o <<= 1) v += __shfl_xor(v, o);
    return v;
}
__device__ __forceinline__ float sigmoidf_(float z) { return 1.f / (1.f + expf(-z)); }
__device__ __forceinline__ float siluf_(float z) { return z / (1.f + expf(-z)); }
__device__ __forceinline__ float bf2f(bf16_t h) { return __uint_as_float((unsigned)h << 16); }
__device__ __forceinline__ unsigned f2bf(float f) { unsigned u = __float_as_uint(f); return (u + 0x7fffu + ((u >> 16) & 1u)) >> 16; }
typedef float f32x2_cv __attribute__((ext_vector_type(2))); typedef __bf16 bf16x2_cv __attribute__((ext_vector_type(2)));
__device__ __forceinline__ unsigned cvtpk(float lo, float hi) { const f32x2_cv v = {lo, hi}; const bf16x2_cv b = __builtin_convertvector(v, bf16x2_cv); return __builtin_bit_cast(unsigned, b); }
__device__ __forceinline__ unsigned pk2(float lo, float hi) { return f2bf(lo) | (f2bf(hi) << 16); }

namespace pg8 {
#define PG8_LAS __attribute__((address_space(3)))
typedef unsigned short bf16_t;
typedef short bf16x8 __attribute__((ext_vector_type(8)));
typedef float f32x4 __attribute__((ext_vector_type(4)));
typedef unsigned u32x4 __attribute__((ext_vector_type(4)));
constexpr int BM = 256, BK = 64, HALF = 128, HTB = HALF * BK * 2  , STAGE_BYTES = 8 * HTB, NXCD = 8, WGM = 8;

__host__ __device__ __forceinline__ int lds_byte(int r, int c) { const int st = (r >> 4) * 2 + (c >> 5), rr = r & 15, cc = c & 31, ob = rr * 64 + cc * 2; return st * 1024 + (ob ^ (((ob >> 9) & 1) << 5)); }
__host__ __device__ __forceinline__ void stage_rc(int b, int& R, int& C) { const int st = b / 1024, sb = b % 1024, swz = sb ^ (((sb >> 9) & 1) << 5); R = (st >> 1) * 16 + swz / 64; C = (st & 1) * 32 + (swz % 64) / 2; }
__host__ __device__ __forceinline__ int perm32(int rho) { const int n = rho >> 4, i = rho & 15; return 8 * (i >> 2) + 4 * n + (i & 3); }

struct Unit { const char* a; const char* b; bf16_t* c; const float* aux; const int* gidx; int ldc, row0, col0; };
__device__ __forceinline__ unsigned cvt_pk_bf16(float lo, float hi) { unsigned r; asm volatile("v_cvt_pk_bf16_f32 %0, %1, %2" : "=v"(r) : "v"(lo), "v"(hi)); return r; }

__device__ __forceinline__ void tile_of(int L, int nM, int nN, int& pm, int& pn) {
    const int nwg = nM * nN; int wgid = L;
    { const int q = nwg / NXCD, r = nwg % NXCD, xcd = wgid % NXCD, off = wgid / NXCD; wgid = (xcd < r ? xcd * (q + 1) : r * (q + 1) + (xcd - r) * q) + off; }
    const int nig = WGM * nN, gid = wgid / nig, fm = gid * WGM, gsz = (nM - fm) < WGM ? (nM - fm) : WGM;
    pm = fm + ((wgid % nig) % gsz); pn = (wgid % nig) / gsz;
}

struct EpiStoreBf16 {
    static constexpr bool PERM = true, AFTER_DRAIN = false;
    __device__ __forceinline__ void operator()(const f32x4 (&acc)[2][2][4][2], const Unit& u, int wr, int wc, int fr, int fq) const {
        bf16_t* base = u.c + (size_t)(wr * 64 + fr) * u.ldc + wc * 32 + 8 * fq;
#pragma unroll
        for (int ai = 0; ai < 2; ++ai)
#pragma unroll
            for (int m = 0; m < 4; ++m) { bf16_t* rowp = base + (size_t)(ai * HALF + m * 16) * u.ldc;
#pragma unroll
                for (int bj = 0; bj < 2; ++bj) { const f32x4 v0 = acc[ai][bj][m][0], v1 = acc[ai][bj][m][1];
                    u32x4 w; w.x = cvt_pk_bf16(v0[0], v0[1]); w.y = cvt_pk_bf16(v0[2], v0[3]); w.z = cvt_pk_bf16(v1[0], v1[1]); w.w = cvt_pk_bf16(v1[2], v1[3]);
                    *(u32x4*)(rowp + bj * HALF) = w; } }
    }
};
struct EpiOutProj {
    static constexpr bool PERM = false, AFTER_DRAIN = false;
    const float* x; const float* ada; float* x1;
    __device__ __forceinline__ void operator()(const f32x4 (&acc)[2][2][4][2], const Unit& u, int wr, int wc, int fr, int fq) const {
        const float* g1 = ada + (u.row0 >> 11) * 6144 + 2048;
#pragma unroll
        for (int bj = 0; bj < 2; ++bj)
#pragma unroll
            for (int n = 0; n < 2; ++n) { const int col = u.col0 + bj * HALF + wc * 32 + n * 16 + 4 * fq; const f32x4 g = *(const f32x4*)(g1 + col);
#pragma unroll
                for (int ai = 0; ai < 2; ++ai)
#pragma unroll
                    for (int m = 0; m < 4; ++m) { const size_t off = (size_t)(u.row0 + ai * HALF + wr * 64 + m * 16 + fr) * D + col;
                        const f32x4 xv = *(const f32x4*)(x + off); *(f32x4*)(x1 + off) = xv + g * acc[ai][bj][m][n]; } }
    }
};
__device__ __forceinline__ float silu_fast(float a) { return a * __builtin_amdgcn_rcpf(1.0f + __builtin_amdgcn_exp2f(-1.4426950408889634f * a)); }
struct EpiSwiGLU {
    static constexpr bool PERM = true, AFTER_DRAIN = false;
    __device__ __forceinline__ void operator()(const f32x4 (&acc)[2][2][4][2], const Unit& u, int wr, int wc, int fr, int fq) const {
        bf16_t* base = u.c + (size_t)(wr * 64 + fr) * FF + wc * 32 + 8 * fq;
#pragma unroll
        for (int ai = 0; ai < 2; ++ai)
#pragma unroll
            for (int m = 0; m < 4; ++m) { const f32x4 a0 = acc[ai][0][m][0], a1 = acc[ai][0][m][1], b0 = acc[ai][1][m][0], b1 = acc[ai][1][m][1];
                u32x4 w; w.x = cvt_pk_bf16(silu_fast(a0[0]) * b0[0], silu_fast(a0[1]) * b0[1]); w.y = cvt_pk_bf16(silu_fast(a0[2]) * b0[2], silu_fast(a0[3]) * b0[3]);
                w.z = cvt_pk_bf16(silu_fast(a1[0]) * b1[0], silu_fast(a1[1]) * b1[1]); w.w = cvt_pk_bf16(silu_fast(a1[2]) * b1[2], silu_fast(a1[3]) * b1[3]);
                *(u32x4*)(base + (size_t)(ai * HALF + m * 16) * FF) = w; }
    }
};
struct EpiDown {
    static constexpr bool PERM = true, AFTER_DRAIN = false;
    __device__ __forceinline__ void operator()(const f32x4 (&acc)[2][2][4][2], const Unit& u, int wr, int wc, int fr, int fq) const {
        bf16_t* base = u.c + (size_t)(wr * 64 + fr) * D + wc * 32 + 8 * fq;
#pragma unroll
        for (int ai = 0; ai < 2; ++ai)
#pragma unroll
            for (int m = 0; m < 4; ++m) { const float gt = u.aux[ai * HALF + wr * 64 + m * 16 + fr]; bf16_t* rowp = base + (size_t)(ai * HALF + m * 16) * D;
#pragma unroll
                for (int bj = 0; bj < 2; ++bj) { const f32x4 v0 = acc[ai][bj][m][0] * gt, v1 = acc[ai][bj][m][1] * gt;
                    u32x4 w; w.x = cvt_pk_bf16(v0[0], v0[1]); w.y = cvt_pk_bf16(v0[2], v0[3]); w.z = cvt_pk_bf16(v1[0], v1[1]); w.w = cvt_pk_bf16(v1[2], v1[3]);
                    *(u32x4*)(rowp + bj * HALF) = w; } }
    }
};

template <class Epi, class Sched, bool ALIGN_EPI = false, bool SP2 = false, bool GATHER = false>
__device__ __forceinline__ void gemm_phase(PG8_LAS unsigned char* lds, const int K, const Sched& S, const Epi& E) {
    const int tid = opaque_tid(), wid = __builtin_amdgcn_readfirstlane(tid >> 6), lane = tid & 63, wr = wid >> 2, wc = wid & 3, fr = lane & 15, fq = lane >> 4;
    const int nt = K / BK;
    unsigned voffA[2], voffB[2];
#pragma unroll
    for (int i = 0; i < 2; ++i) { int R, C; stage_rc(tid * 16 + i * 8192, R, C); const int Rb = Epi::PERM ? ((R & ~31) + perm32(R & 31)) : R;
        voffA[i] = (unsigned)(R * K + C) * 2u; voffB[i] = (unsigned)(Rb * K + C) * 2u; }
    const size_t kstep = (size_t)(BK * 2);
    const size_t hstep = (size_t)HALF * K * 2;
    const unsigned ldsw = (unsigned)wid * 1024u;
    const int aoff = lds_byte(wr * 64 + fr, fq * 8), boff = lds_byte(wc * 32 + fr, fq * 8);
#define PG8_SA(b, h) (((b) * 2 + (h)) * HTB)
#define PG8_SB(b, h) ((4 + (b) * 2 + (h)) * HTB)
#define PG8_STAGE(bufoff, gbase, voff) do { _Pragma("unroll") for (int _i = 0; _i < 2; ++_i) \
        __builtin_amdgcn_global_load_lds((const unsigned*)((const char*)(gbase) + (voff)[_i]), (PG8_LAS unsigned*)(lds + (bufoff) + ldsw + _i * 8192), 16, 0, 0); } while (0)
#define PG8_STAGE_A(bufoff, gbase, h) do { _Pragma("unroll") for (int _i = 0; _i < 2; ++_i) \
        __builtin_amdgcn_global_load_lds((const unsigned*)((const char*)(gbase) + voffAh[h][_i]), (PG8_LAS unsigned*)(lds + (bufoff) + ldsw + _i * 8192), 16, 0, 0); } while (0)
#define PG8_LDA(dst, b, h) do { _Pragma("unroll") for (int m = 0; m < 4; ++m) _Pragma("unroll") for (int k = 0; k < 2; ++k) dst[m][k] = *(const PG8_LAS bf16x8*)(lds + PG8_SA(b, h) + aoff + m * 2048 + k * 1024); } while (0)
#define PG8_LDB(dst, b, h) do { _Pragma("unroll") for (int n = 0; n < 2; ++n) _Pragma("unroll") for (int k = 0; k < 2; ++k) dst[n][k] = *(const PG8_LAS bf16x8*)(lds + PG8_SB(b, h) + boff + n * 2048 + k * 1024); } while (0)
#define PG8_MMA(ai, bj, At, Bt) do { __builtin_amdgcn_s_setprio(1); _Pragma("unroll") for (int m = 0; m < 4; ++m) _Pragma("unroll") for (int n = 0; n < 2; ++n) _Pragma("unroll") for (int k = 0; k < 2; ++k) \
        acc[ai][bj][m][n] = __builtin_amdgcn_mfma_f32_16x16x32_bf16(Bt[n][k], At[m][k], acc[ai][bj][m][n], 0, 0, 0); __builtin_amdgcn_s_setprio(0); } while (0)
#define PG8_WAIT_V(n) asm volatile("s_waitcnt vmcnt(" #n ")" ::: "memory")
#define PG8_WAIT_L(n) asm volatile("s_waitcnt lgkmcnt(" #n ")" ::: "memory")
#define PG8_BAR __builtin_amdgcn_s_barrier()
#define PG8_SCHED __builtin_amdgcn_sched_barrier(0)
    Unit cur, nxt; int ui = 0;
    if (!S.next(0, cur)) return;
    unsigned voffAh[2][2];
#pragma unroll
    for (int h = 0; h < 2; ++h)
#pragma unroll
        for (int i = 0; i < 2; ++i) {
            if constexpr (GATHER) { int R, C; stage_rc(tid * 16 + i * 8192, R, C); voffAh[h][i] = ((unsigned)cur.gidx[h * HALF + R] * (unsigned)K + (unsigned)C) * 2u; }
            else voffAh[h][i] = voffA[i] + (unsigned)h * (unsigned)hstep;
        }
    f32x4 acc[2][2][4][2];
#pragma unroll
    for (int a = 0; a < 2; ++a)
#pragma unroll
        for (int b = 0; b < 2; ++b)
#pragma unroll
            for (int m = 0; m < 4; ++m)
#pragma unroll
                for (int n = 0; n < 2; ++n) acc[a][b][m][n] = (f32x4){0.f, 0.f, 0.f, 0.f};
    bf16x8 At[4][2], B0[2][2], B1[2][2];
    const char* cA = cur.a; const char* cB = cur.b;
    S.a_ready(cur);
    if constexpr (SP2) {
        PG8_STAGE(PG8_SB(0, 0), cB, voffB); PG8_STAGE(PG8_SB(0, 1), cB + hstep, voffB); PG8_STAGE_A(PG8_SA(0, 0), cA, 0); PG8_STAGE_A(PG8_SA(0, 1), cA, 1);
        if (wr == 1) PG8_BAR;
        PG8_WAIT_V(2); PG8_BAR;
        PG8_STAGE(PG8_SB(1, 0), cB + kstep, voffB); PG8_STAGE_A(PG8_SA(1, 0), cA + kstep, 0); PG8_STAGE(PG8_SB(1, 1), cB + hstep + kstep, voffB);
        PG8_WAIT_V(6); PG8_BAR;
    } else {
        PG8_STAGE(PG8_SB(0, 0), cB, voffB); PG8_STAGE_A(PG8_SA(0, 0), cA, 0); PG8_STAGE(PG8_SB(0, 1), cB + hstep, voffB); PG8_STAGE_A(PG8_SA(0, 1), cA, 1);
        if (wr == 1) PG8_BAR;
        PG8_WAIT_V(4); PG8_BAR;
        PG8_STAGE(PG8_SB(1, 0), cB + kstep, voffB); PG8_STAGE_A(PG8_SA(1, 0), cA + kstep, 0); PG8_STAGE(PG8_SB(1, 1), cB + hstep + kstep, voffB);
        PG8_WAIT_V(6); PG8_BAR;
    }
    for (;;) {
        const bool has_next = S.next(ui + 1, nxt);
        const char* nA = has_next ? nxt.a : cA; const char* nB = has_next ? nxt.b : cB;
        for (int t = 0; t < nt; t += 2) {
            const bool last = (t == nt - 2);
            const char* a1 = cA + (size_t)(t + 1) * kstep;
            const char* a2 = last ? nA : cA + (size_t)(t + 2) * kstep; const char* b2 = last ? nB : cB + (size_t)(t + 2) * kstep;
            const char* a3 = a2 + kstep; const char* b3 = b2 + kstep;
            if (last && has_next) S.a_ready(nxt);
            if constexpr (SP2) {
            PG8_LDB(B0, 0, 0); PG8_LDB(B1, 0, 1); PG8_SCHED; PG8_LDA(At, 0, 0); PG8_STAGE_A(PG8_SA(1, 1), a1, 1);
            PG8_WAIT_V(8); PG8_WAIT_L(0); PG8_BAR; PG8_MMA(0, 0, At, B0); PG8_MMA(0, 1, At, B1); PG8_BAR; PG8_SCHED;
            PG8_LDA(At, 0, 1); PG8_STAGE(PG8_SB(0, 0), b2, voffB); PG8_STAGE(PG8_SB(0, 1), b2 + hstep, voffB); PG8_STAGE_A(PG8_SA(0, 0), a2, 0);
            PG8_WAIT_V(8); PG8_WAIT_L(0); PG8_BAR; PG8_MMA(1, 0, At, B0); PG8_MMA(1, 1, At, B1); PG8_BAR; PG8_SCHED;
            PG8_LDB(B0, 1, 0); PG8_LDB(B1, 1, 1); PG8_SCHED; PG8_LDA(At, 1, 0); PG8_STAGE_A(PG8_SA(0, 1), a2, 1);
            PG8_WAIT_V(8); PG8_WAIT_L(0); PG8_BAR; PG8_MMA(0, 0, At, B0); PG8_MMA(0, 1, At, B1); PG8_BAR; PG8_SCHED;
            PG8_LDA(At, 1, 1); PG8_STAGE(PG8_SB(1, 0), b3, voffB); PG8_STAGE(PG8_SB(1, 1), b3 + hstep, voffB); PG8_STAGE_A(PG8_SA(1, 0), a3, 0);
            PG8_WAIT_V(8); PG8_WAIT_L(0); PG8_BAR; PG8_MMA(1, 0, At, B0); PG8_MMA(1, 1, At, B1); PG8_BAR; PG8_SCHED;
            } else {
            PG8_LDB(B0, 0, 0); PG8_SCHED; PG8_LDA(At, 0, 0); PG8_STAGE_A(PG8_SA(1, 1), a1, 1);
            PG8_WAIT_L(8); PG8_BAR; PG8_WAIT_L(0); PG8_MMA(0, 0, At, B0); PG8_BAR; PG8_SCHED;
            PG8_LDB(B1, 0, 1); PG8_STAGE(PG8_SB(0, 0), b2, voffB);
            PG8_BAR; PG8_WAIT_L(0); PG8_MMA(0, 1, At, B1); PG8_BAR;
            PG8_LDA(At, 0, 1); PG8_STAGE_A(PG8_SA(0, 0), a2, 0);
            PG8_BAR; PG8_WAIT_L(0); PG8_MMA(1, 0, At, B0); PG8_BAR; PG8_SCHED;
            PG8_STAGE(PG8_SB(0, 1), b2 + hstep, voffB);
            PG8_WAIT_V(6); PG8_BAR; PG8_MMA(1, 1, At, B1); PG8_BAR;
            PG8_LDB(B0, 1, 0); PG8_SCHED; PG8_LDA(At, 1, 0); PG8_STAGE_A(PG8_SA(0, 1), a2, 1);
            PG8_WAIT_L(8); PG8_BAR; PG8_WAIT_L(0); PG8_MMA(0, 0, At, B0); PG8_BAR; PG8_SCHED;
            PG8_LDB(B1, 1, 1); PG8_STAGE(PG8_SB(1, 0), b3, voffB);
            PG8_BAR; PG8_WAIT_L(0); PG8_MMA(0, 1, At, B1); PG8_BAR;
            PG8_LDA(At, 1, 1); PG8_STAGE_A(PG8_SA(1, 0), a3, 0);
            PG8_BAR; PG8_WAIT_L(0); PG8_MMA(1, 0, At, B0); PG8_BAR; PG8_SCHED;
            PG8_STAGE(PG8_SB(1, 1), b3 + hstep, voffB);
            PG8_WAIT_V(6); PG8_BAR; PG8_MMA(1, 1, At, B1); PG8_BAR;
            }
        }
        if constexpr (ALIGN_EPI) { if (wr == 0) PG8_BAR; }
        if constexpr (!Epi::AFTER_DRAIN) { E(acc, cur, wr, wc, fr, fq); S.done(cur); }
        if (!has_next) break;
#pragma unroll
        for (int a = 0; a < 2; ++a)
#pragma unroll
            for (int b = 0; b < 2; ++b)
#pragma unroll
                for (int m = 0; m < 4; ++m)
#pragma unroll
                    for (int n = 0; n < 2; ++n) acc[a][b][m][n] = (f32x4){0.f, 0.f, 0.f, 0.f};
        cur = nxt; cA = nA; cB = nB; ++ui;
        if constexpr (ALIGN_EPI) { if (wr == 1) PG8_BAR; }
    }
    PG8_WAIT_V(0);
    if constexpr (!ALIGN_EPI) { if (wr == 0) PG8_BAR; }
    PG8_BAR;
    if constexpr (Epi::AFTER_DRAIN) { E.fused(acc, cur, wr, wc, fr, fq, lds, wid, lane); S.done(cur); }
#undef PG8_SA
#undef PG8_SB
#undef PG8_STAGE
#undef PG8_LDA
#undef PG8_LDB
#undef PG8_MMA
#undef PG8_WAIT_V
#undef PG8_WAIT_L
#undef PG8_BAR
#undef PG8_SCHED
}
}
using pg8::Unit; using pg8::tile_of;

__device__ __forceinline__ void ph_prep(const P& p, float* lds) {
    const int tid = opaque_tid(), G = gridDim.x;
    float* ADA = (float*)(p.ws + WS_ADA);
    float* LB = (float*)(p.ws + WS_LB);
    float* HID2 = (float*)(p.ws + WS_HID2);
    {
        float* s = lds;
        float* red = lds + 17 * 1024;
        if (blockIdx.x < 192) {
            for (int i = tid; i < 17 * 1024; i += NT) {
                const int r = i >> 10, d = i & 1023;
                const float cv = r < 16 ? p.c[r * 1024 + d] : p.c_ctx[d];
                s[i] = siluf_(cv);
            }
        }
        __syncthreads();
        for (int item = blockIdx.x; item < 192; item += G) {
            const int jj = tid & 31, ks = tid >> 5, j = item * 32 + jj;
            float acc[17];
#pragma unroll
            for (int r = 0; r < 17; ++r) acc[r] = 0.f;
            for (int d0 = ks * 64; d0 < ks * 64 + 64; d0 += 16) {
                float wv[16];
#pragma unroll
                for (int q = 0; q < 16; ++q) wv[q] = p.ada_w[(size_t)(d0 + q) * 6144 + j];
#pragma unroll
                for (int q = 0; q < 16; ++q)
#pragma unroll
                    for (int r = 0; r < 17; ++r) acc[r] += s[r * 1024 + d0 + q] * wv[q];
            }
#pragma unroll
            for (int r = 0; r < 17; ++r) red[(ks * 17 + r) * 32 + jj] = acc[r];
            __syncthreads();
            for (int i = tid; i < 17 * 32; i += NT) {
                const int r = i >> 5, j2 = i & 31;
                float sum = 0.f;
#pragma unroll
                for (int k = 0; k < 16; ++k) sum += red[(k * 17 + r) * 32 + j2];
                ADA[r * 6144 + item * 32 + j2] = sum + p.ada_b[item * 32 + j2];
            }
            __syncthreads();
        }
    }
    if (blockIdx.x == G - 1) {
        for (int i = tid; i < 1024; i += NT) {
            const float a0 = p.hg_lb[i], a1 = p.hg_lb[1024 + i];
            LB[i] = 1.f / (1.f + expf(a1 - a0));
        }
    }
    {
        float* zl = lds;
        float* h1 = lds + 512;
        __syncthreads();
        for (int it = (G - 1 - blockIdx.x); it < SEQ / 8; it += G) {
            const int lt = tid >> 6, j = tid & 63, t = it * 8 + lt;
            const float w = 6.283185307179586f * (float)t / 2048.0f;
            if (j == 0) zl[lt * 64] = (float)t / 2047.0f;
            if (j >= 1 && j < 17) { const float f = 1e-4f + (float)(j - 1) * ((15.0f - 1e-4f) / 15.0f); zl[lt * 64 + j] = cosf(f * w); }
            if (j >= 17 && j < 33) { const float f = 1e-4f + (float)(j - 17) * ((15.0f - 1e-4f) / 15.0f); zl[lt * 64 + j] = -sinf(f * w); }
            __syncthreads();
            float a = p.pos_b1[j];
            for (int i = 0; i < 33; ++i) a += zl[lt * 64 + i] * p.pos_w1[i * 64 + j];
            h1[lt * 64 + j] = sinf(p.freq1[j] * a);
            __syncthreads();
            float b = p.pos_b2[j];
            for (int i = 0; i < 64; ++i) b += h1[lt * 64 + i] * p.pos_w2[i * 64 + j];
            HID2[t * 64 + j] = sinf(p.freq2[j] * b);
            __syncthreads();
        }
    }
}
struct ConvItem { const float* W; bf16_t* dst; int N, KD, k0, n0, which; };
__device__ __forceinline__ ConvItem conv_small_item(const P& p, int it) {
    ConvItem c; c.which = 0; c.KD = D;
    if (it < 256) { c.W = p.w_in; c.N = INC; c.k0 = (it / 16) * 64; c.n0 = (it % 16) * 256; c.dst = (bf16_t*)((unsigned char*)p.out + DO_WINT); }
    else { const int r = it - 256; c.W = p.w_out; c.N = D; c.k0 = (r / 4) * 64; c.n0 = (r % 4) * 256; c.dst = (bf16_t*)(p.ws + WS_WOUTT); }
    return c;
}
constexpr int N_EXPERT_ITEMS = 2 * 16 * 16 * 8 + 16 * 32 * 4;
__device__ __forceinline__ ConvItem conv_expert_item(const P& p, int r) {
    ConvItem c; constexpr int I_W1 = 16 * 16 * 8;
    if (r < 2 * I_W1) {
        const int which = r / I_W1; r %= I_W1;
        const int e = r / 128, r2 = r % 128;
        c.W = (which == 0 ? p.exp_w1 : p.exp_w3) + (size_t)e * D * FF; c.N = FF; c.k0 = (r2 / 8) * 64; c.n0 = (r2 % 8) * 256; c.dst = (bf16_t*)(p.ws + WS_W13T) + (size_t)e * 4096 * D; c.KD = D; c.which = 1 + which;
    } else {
        r -= 2 * I_W1; const int e = r / 128, r2 = r % 128;
        c.W = p.exp_w2 + (size_t)e * FF * D; c.N = D; c.k0 = (r2 / 4) * 64; c.n0 = (r2 % 4) * 256; c.dst = (bf16_t*)(p.ws + WS_W2T) + (size_t)e * 1024 * FF; c.KD = FF; c.which = 0;
    }
    return c;
}
__device__ __forceinline__ void conv_load(const ConvItem& c, f32x4_t (&v)[8], int tid) {
#pragma unroll
    for (int q = 0; q < 8; ++q) { const int i = tid + NT * q, k = i >> 6, n4 = i & 63; v[q] = *(const f32x4_t*)(c.W + (size_t)(c.k0 + k) * c.N + c.n0 + 4 * n4); }
}
__device__ __forceinline__ void conv_tile_write(const f32x4_t (&v)[8], float* T, int tid) {
#pragma unroll
    for (int q = 0; q < 8; ++q) { const int i = tid + NT * q, k = i >> 6, n4 = i & 63; *(f32x4_t*)&T[k * 260 + 4 * (n4 ^ ((k >> 3) & 7))] = v[q]; }
}
__device__ __forceinline__ void conv_tile_store(const ConvItem& c, const float* T, int tid) {
#pragma unroll
    for (int q = 0; q < 4; ++q) { const int i = tid + NT * q, nl = i >> 3, ch = i & 7, n = c.n0 + nl;
        float a[8];
#pragma unroll
        for (int e = 0; e < 8; ++e) a[e] = T[(8 * ch + e) * 260 + (nl ^ (ch << 2))];
        const int row = c.which == 0 ? n : ((n >> 7) * 256 + (c.which - 1) * 128 + (n & 127));
        *(uint4*)(c.dst + (size_t)row * c.KD + c.k0 + 8 * ch) = make_uint4(cvtpk(a[0], a[1]), cvtpk(a[2], a[3]), cvtpk(a[4], a[5]), cvtpk(a[6], a[7])); }
}
constexpr int CONV_DEPTH = 4;
template <class ITEMF>
__device__ __forceinline__ void conv_run(ITEMF item, int first, int count, float* T) {
    const int tid = opaque_tid();
    f32x4_t ring[CONV_DEPTH][8];
#pragma unroll
    for (int d = 0; d < CONV_DEPTH; ++d) { const ConvItem c = item(first + d); conv_load(c, ring[d], tid); }
    for (int i0 = 0; i0 < count; i0 += CONV_DEPTH) {
#pragma unroll
        for (int d = 0; d < CONV_DEPTH; ++d) {
            const int i = i0 + d;
            const ConvItem c = item(first + i);
            lds_barrier();
            conv_tile_write(ring[d], T, tid);
            lds_barrier();
            if (i + CONV_DEPTH < count) { const ConvItem cn = item(first + i + CONV_DEPTH); conv_load(cn, ring[d], tid); }
            conv_tile_store(c, T, tid);
        }
    }
}
__device__ __forceinline__ void ph_convert_small(const P& p, float* lds) {
    __syncthreads();
    if (blockIdx.x >= 96 && blockIdx.x < 96 + 80) conv_run([&](int it) { return conv_small_item(p, it); }, (blockIdx.x - 96) * 4, 4, lds);
}

__device__ __forceinline__ void ph_norm1(const P& p) {
    const int tid = opaque_tid(), lane = tid & 63, wv = tid >> 6, G = gridDim.x;
    const float* ADA = (const float*)(p.ws + WS_ADA);
    bf16_t* H = (bf16_t*)(p.ws + WS_H);
    bf16_t* HC = (bf16_t*)(p.ws + WS_HC);
    const int gw = blockIdx.x * 8 + wv, NGW = G * 8;
    auto rowsrc = [&](int r) { return r < NTOK ? p.x + (size_t)r * D : p.ctx + (size_t)(r - NTOK) * D; };
    f32x4_t v[4], vn[4];
    if (gw < NTOK + NCTX) {
#pragma unroll
        for (int j = 0; j < 4; ++j) v[j] = ((const f32x4_t*)rowsrc(gw))[lane + 64 * j];
    }
    for (int r = gw; r < NTOK + NCTX; r += NGW) {
        const bool more = r + NGW < NTOK + NCTX;
        if (more) {
#pragma unroll
            for (int j = 0; j < 4; ++j) vn[j] = ((const f32x4_t*)rowsrc(r + NGW))[lane + 64 * j];
        }
        bf16_t* dst = r < NTOK ? H + (size_t)r * D : HC + (size_t)(r - NTOK) * D;
        const int ar = r < NTOK ? r / SEQ : 16;
        float ss = 0.f;
#pragma unroll
        for (int j = 0; j < 4; ++j) ss += v[j].x * v[j].x + v[j].y * v[j].y + v[j].z * v[j].z + v[j].w * v[j].w;
        ss = wave_sum(ss);
        const float rstd = rsqrtf(ss * (1.f / D) + EPS);
        const float* sh = ADA + ar * 6144, *sc = sh + 1024;
#pragma unroll
        for (int j = 0; j < 4; ++j) {
            const int d4 = lane + 64 * j;
            const float4 g = ((const float4*)p.norm1_g)[d4], s1 = ((const float4*)sc)[d4], h1 = ((const float4*)sh)[d4];
            float4 o;
            o.x = v[j].x * rstd * g.x * (1.f + s1.x) + h1.x; o.y = v[j].y * rstd * g.y * (1.f + s1.y) + h1.y;
            o.z = v[j].z * rstd * g.z * (1.f + s1.z) + h1.z; o.w = v[j].w * rstd * g.w * (1.f + s1.w) + h1.w;
            ((uint2*)dst)[d4] = make_uint2(cvtpk(o.x, o.y), cvtpk(o.z, o.w));
        }
#pragma unroll
        for (int j = 0; j < 4; ++j) v[j] = vn[j];
    }
}
__device__ __forceinline__ void ph_filter(const P& p, float* lds) {
    const int tid = opaque_tid(), G = gridDim.x;
    const float* HID2 = (const float*)(p.ws + WS_HID2);
    float* HF = (float*)((unsigned char*)p.out + DO_HF);
    float* w3c = lds;
    float* red = lds + 512;
    const float min_decay = logf(1e-2f) / 1.5f, max_decay = logf(1e-2f) / 0.3f;
    for (int grp = blockIdx.x; grp < 256; grp += G) {
        const int item0 = grp * 4, o = item0 >> 9, c0 = item0 & 511;
        __syncthreads();
        { const int q = tid >> 7, dir = (tid >> 6) & 1, i = tid & 63; w3c[tid] = p.pos_w3[i * 2048 + o * 1024 + dir * 512 + c0 + q]; }
        __syncthreads();
        float hv[4][4][2]; float asum[4] = {0.f, 0.f, 0.f, 0.f};
#pragma unroll
        for (int j = 0; j < 4; ++j) {
            const int t = tid + NT * j;
            float r[4][2];
#pragma unroll
            for (int q = 0; q < 4; ++q) { r[q][0] = 0.f; r[q][1] = 0.f; }
            const float4* hp = (const float4*)(HID2 + t * 64);
#pragma unroll 4
            for (int i4 = 0; i4 < 16; ++i4) {
                const float4 h = hp[i4];
#pragma unroll
                for (int q = 0; q < 4; ++q)
#pragma unroll
                    for (int d = 0; d < 2; ++d) { const float* w = w3c + (q * 2 + d) * 64 + i4 * 4; r[q][d] += h.x * w[0] + h.y * w[1] + h.z * w[2] + h.w * w[3]; }
            }
            const float tl = (float)t / 2047.0f;
#pragma unroll
            for (int q = 0; q < 4; ++q) {
                const float delta = fabsf(min_decay + (float)(c0 + q) * ((max_decay - min_decay) / 511.0f));
                const float win = expf(-tl * delta) + 0.05f;
                hv[j][q][0] = r[q][0] * win; hv[j][q][1] = r[q][1] * win;
                asum[q] += fabsf(hv[j][q][0]) + (t >= 1 ? fabsf(hv[j][q][1]) : 0.f);
            }
        }
#pragma unroll
        for (int q = 0; q < 4; ++q) asum[q] = wave_sum(asum[q]);
        if ((tid & 63) == 0) { red[(tid >> 6) * 4 + 0] = asum[0]; red[(tid >> 6) * 4 + 1] = asum[1]; red[(tid >> 6) * 4 + 2] = asum[2]; red[(tid >> 6) * 4 + 3] = asum[3]; }
        __syncthreads();
#pragma unroll
        for (int q = 0; q < 4; ++q) {
            float tot = 0.f;
#pragma unroll
            for (int k = 0; k < 8; ++k) tot += red[k * 4 + q];
            const float inv = 1.f / (tot + EPS);
            float* dst = HF + (size_t)(item0 + q) * 4096;
#pragma unroll
            for (int j = 0; j < 4; ++j) {
                const int t = tid + NT * j;
                dst[2047 + t] = hv[j][q][0] * inv;
                if (t >= 1) dst[2047 - t] = hv[j][q][1] * inv;
            }
            if (tid == 0) dst[4095] = 0.f;
        }
    }
}

struct InprojSched {
    int G, c; const bf16_t *WinT, *H, *HC; bf16_t *PHYT, *PHG, *PC;
    __device__ __forceinline__ bool next(int i, Unit& u) const {
        int L = i * G + c; int pm, pn;
        u.aux = nullptr; u.gidx = nullptr; u.row0 = 0; u.col0 = 0;
        if (L < 768) { tile_of(L, 6, 128, pm, pn); u.a = (const char*)(WinT + (size_t)pm * 256 * D); u.b = (const char*)(H + (size_t)pn * 256 * D); u.c = PHYT + (size_t)pm * 256 * NTOK + pn * 256; u.ldc = NTOK; return true; }
        L -= 768;
        if (L < 1280) { tile_of(L, 128, 10, pm, pn); u.a = (const char*)(H + (size_t)pm * 256 * D); u.b = (const char*)(WinT + (size_t)(1536 + pn * 256) * D); u.c = PHG + (size_t)pm * 256 * 2560 + pn * 256; u.ldc = 2560; return true; }
        L -= 1280;
        if (L < 96) { tile_of(L, 16, 6, pm, pn); u.a = (const char*)(HC + (size_t)pm * 256 * D); u.b = (const char*)(WinT + (size_t)(2048 + pn * 256) * D); u.c = PC + (size_t)pm * 256 * 1536 + pn * 256; u.ldc = 1536; return true; }
        return false;
    }
    __device__ __forceinline__ void a_ready(const Unit&) const {}
    __device__ __forceinline__ void done(const Unit&) const {}
};
__device__ __forceinline__ void ph_inproj(const P& p, unsigned char* lds) {
    InprojSched S{(int)gridDim.x, (int)blockIdx.x, (const bf16_t*)((unsigned char*)p.out + DO_WINT), (const bf16_t*)(p.ws + WS_H), (const bf16_t*)(p.ws + WS_HC),
                  (bf16_t*)((unsigned char*)p.out + DO_PHYT), (bf16_t*)(p.ws + WS_PHG), (bf16_t*)(p.ws + WS_PC)};
    pg8::EpiStoreBf16 E;
    pg8::gemm_phase<pg8::EpiStoreBf16, InprojSched, true, true, false>((PG8_LAS unsigned char*)lds, D, S, E);
}

namespace hy {
#define HY_LAS __attribute__((address_space(3)))
typedef short bf16x8 __attribute__((ext_vector_type(8)));
typedef float f32x4 __attribute__((ext_vector_type(4)));
typedef unsigned u32x4 __attribute__((ext_vector_type(4)));
typedef unsigned u32x2 __attribute__((ext_vector_type(2)));
constexpr int U_STRIDE = 4112, UIMG = 0, U_BYTES = 16 * U_STRIDE;
constexpr int FILT = U_BYTES, F_STRIDE = 8288, F_BYTES = 8 * F_STRIDE;
constexpr int SCR = FILT + F_BYTES;
static_assert(SCR + 8192 <= LDS_BYTES, "hyena LDS map");

__device__ __forceinline__ float uni(float v) { return __uint_as_float(__builtin_amdgcn_readfirstlane(__float_as_uint(v))); }
struct ConvW { float w0, w1, w2, b; };
__device__ __forceinline__ ConvW load_convw(const P& p, int ch) { ConvW c; c.w0 = uni(p.hy_conv_w[ch]); c.w1 = uni(p.hy_conv_w[1536 + ch]); c.w2 = uni(p.hy_conv_w[3072 + ch]); c.b = uni(p.hy_conv_b[ch]); return c; }
__device__ __forceinline__ void load_u_image(const ConvW cw, HY_LAS unsigned char* L, const bf16_t* row, int tid) {
    const float cw0 = cw.w0, cw1 = cw.w1, cw2 = cw.w2, cb = cw.b;
#pragma unroll 2
    for (int k = 0; k < 8; ++k) {
        const int idx = tid + NT * k, b = idx >> 8, t8 = (idx & 255) * 8;
        const bf16_t* src = row + b * SEQ + t8;
        const u32x4 raw = *(const u32x4*)src;
        float x[10];
        x[0] = (t8 & 63) ? bf2f(src[-1]) : 0.f;
        x[9] = ((t8 + 8) & 63) ? bf2f(src[8]) : 0.f;
        x[1] = __uint_as_float(raw.x << 16); x[2] = __uint_as_float(raw.x & 0xffff0000u); x[3] = __uint_as_float(raw.y << 16); x[4] = __uint_as_float(raw.y & 0xffff0000u);
        x[5] = __uint_as_float(raw.z << 16); x[6] = __uint_as_float(raw.z & 0xffff0000u); x[7] = __uint_as_float(raw.w << 16); x[8] = __uint_as_float(raw.w & 0xffff0000u);
        float o[8];
#pragma unroll
        for (int e = 0; e < 8; ++e) o[e] = cb + cw1 * x[e + 1] + cw0 * x[e] + cw2 * x[e + 2];
        *(HY_LAS u32x4*)(L + UIMG + b * U_STRIDE + t8 * 2) = (u32x4){pk2(o[0], o[1]), pk2(o[2], o[3]), pk2(o[4], o[5]), pk2(o[6], o[7])};
    }
}
__device__ __forceinline__ void stage_raw_rows(HY_LAS unsigned char* L, const bf16_t* row, int tid) {
#pragma unroll 2
    for (int k = 0; k < 8; ++k) {
        const int idx = tid + NT * k, b = idx >> 8, t8 = (idx & 255) * 8;
        const u32x4 raw = *(const u32x4*)(row + b * SEQ + t8);
        HY_LAS unsigned char* d = L + FILT + b * U_STRIDE + 8 + t8 * 2;
        *(HY_LAS u32x2*)d = (u32x2){raw.x, raw.y}; *(HY_LAS u32x2*)(d + 8) = (u32x2){raw.z, raw.w};
    }
}
__device__ __forceinline__ void load_filter_scr(HY_LAS unsigned char* L, const float* hf, int tid) {
    const float4 a = ((const float4*)hf)[tid * 2], b = ((const float4*)hf)[tid * 2 + 1];
    *(HY_LAS u32x4*)(L + SCR + tid * 16) = (u32x4){pk2(a.x, a.y), pk2(a.z, a.w), pk2(b.x, b.y), pk2(b.z, b.w)};
}
__device__ __forceinline__ void build_filter_copies(HY_LAS unsigned char* L, int tid) {
    const HY_LAS bf16_t* sc = (const HY_LAS bf16_t*)(L + SCR);
    for (int gi = tid; gi < 8 * 518; gi += NT) {
        const int d = gi / 518, qg = gi - d * 518;
        const int top = 4095 + d - 8 * qg;
        unsigned v[8];
#pragma unroll
        for (int e = 0; e < 8; ++e) { const int ix = top - e; v[e] = (ix >= 0 && ix <= 4094) ? (unsigned)sc[ix] : 0u; }
        *(HY_LAS u32x4*)(L + FILT + d * F_STRIDE + qg * 16) = (u32x4){v[0] | (v[1] << 16), v[2] | (v[3] << 16), v[4] | (v[5] << 16), v[6] | (v[7] << 16)};
    }
}
__device__ __forceinline__ void conv_loop(HY_LAS unsigned char* L, f32x4 (&acc)[16], int w, int lane) {
    const int i = lane & 15, g = lane >> 4;
    const HY_LAS unsigned char* aBase = L + FILT + (i & 7) * F_STRIDE + 2 * (2048 + 8 * g - (i & ~7)) - 32 * (16 * w);
    const HY_LAS unsigned char* bBase = L + UIMG + i * U_STRIDE + 16 * g;
    bf16x8 ring[16];
#pragma unroll
    for (int s = 0; s < 16; ++s) ring[s] = *(const HY_LAS bf16x8*)(aBase - 32 * s);
#pragma unroll
    for (int m = 0; m < 16; ++m) acc[m] = (f32x4){0.f, 0.f, 0.f, 0.f};
    bf16x8 bfrag = *(const HY_LAS bf16x8*)(bBase);
    for (int k8 = 0; k8 < 8; ++k8) {
        const HY_LAS unsigned char* aK = aBase + 512 * k8;
        const HY_LAS unsigned char* bK = bBase + 512 * k8;
#pragma unroll
        for (int u = 0; u < 8; ++u) {
            bf16x8 bnext = bfrag;
            if (u < 7 || k8 < 7) bnext = *(const HY_LAS bf16x8*)(bK + 64 * (u + 1));
            acc[14] = __builtin_amdgcn_mfma_f32_16x16x32_bf16(ring[(14 - 2 * u) & 15], bfrag, acc[14], 0, 0, 0);
            acc[15] = __builtin_amdgcn_mfma_f32_16x16x32_bf16(ring[(15 - 2 * u) & 15], bfrag, acc[15], 0, 0, 0);
            if (u < 7 || k8 < 7) {
                ring[(14 - 2 * u) & 15] = *(const HY_LAS bf16x8*)(aK + 64 * u + 64);
                ring[(15 - 2 * u) & 15] = *(const HY_LAS bf16x8*)(aK + 64 * u + 32);
            }
#pragma unroll
            for (int m = 0; m < 14; ++m) acc[m] = __builtin_amdgcn_mfma_f32_16x16x32_bf16(ring[(m - 2 * u) & 15], bfrag, acc[m], 0, 0, 0);
            bfrag = bnext;
            __builtin_amdgcn_sched_barrier(0);
        }
    }
}
__device__ __forceinline__ void gate_acc(const ConvW cw, HY_LAS unsigned char* L, f32x4 (&acc)[16], float bias, int w, int lane) {
    const int j = lane & 15, g = lane >> 4;
    const float cw0 = cw.w0, cw1 = cw.w1, cw2 = cw.w2, cb = cw.b;
#pragma unroll
    for (int m = 0; m < 16; ++m) {
        const int t4 = 256 * w + 16 * m + 4 * g, tt0 = t4 & 63;
        const u32x2 uu = *(const HY_LAS u32x2*)(L + UIMG + j * U_STRIDE + t4 * 2);
        const HY_LAS unsigned char* xb = L + FILT + j * U_STRIDE + 8 + t4 * 2;
        const u32x2 xx = *(const HY_LAS u32x2*)xb;
        const float xl = tt0 > 0 ? bf2f(*(const HY_LAS bf16_t*)(xb - 2)) : 0.f;
        const float xr = tt0 < 60 ? bf2f(*(const HY_LAS bf16_t*)(xb + 8)) : 0.f;
        const float x0 = __uint_as_float(xx.x << 16), x1 = __uint_as_float(xx.x & 0xffff0000u), x2 = __uint_as_float(xx.y << 16), x3 = __uint_as_float(xx.y & 0xffff0000u);
        const float u0 = __uint_as_float(uu.x << 16), u1 = __uint_as_float(uu.x & 0xffff0000u), u2 = __uint_as_float(uu.y << 16), u3 = __uint_as_float(uu.y & 0xffff0000u);
        const float g0 = cb + cw1 * x0 + cw0 * xl + cw2 * x1, g1 = cb + cw1 * x1 + cw0 * x0 + cw2 * x2, g2 = cb + cw1 * x2 + cw0 * x1 + cw2 * x3, g3 = cb + cw1 * x3 + cw0 * x2 + cw2 * xr;
        acc[m][0] = g0 * (acc[m][0] + bias * u0); acc[m][1] = g1 * (acc[m][1] + bias * u1); acc[m][2] = g2 * (acc[m][2] + bias * u2); acc[m][3] = g3 * (acc[m][3] + bias * u3);
        if ((m & 3) == 3) __builtin_amdgcn_sched_barrier(0);
    }
}
__device__ __forceinline__ void store_acc_uimg(HY_LAS unsigned char* L, const f32x4 (&acc)[16], int w, int lane) {
    const int j = lane & 15, g = lane >> 4;
#pragma unroll
    for (int m = 0; m < 16; ++m) {
        const int t4 = 256 * w + 16 * m + 4 * g;
        *(HY_LAS u32x2*)(L + UIMG + j * U_STRIDE + t4 * 2) = (u32x2){pk2(acc[m][0], acc[m][1]), pk2(acc[m][2], acc[m][3])};
    }
}
}

__device__ __forceinline__ void ph_hyena_task(const P& p, unsigned char* ldsb, int c) {
    const int w = __builtin_amdgcn_readfirstlane(threadIdx.x >> 6);
    const bf16_t* PHYT = (const bf16_t*)((unsigned char*)p.out + DO_PHYT);
    bf16_t* YT = (bf16_t*)(p.ws + WS_YT);
    const float* HF = (const float*)((unsigned char*)p.out + DO_HF);
    HY_LAS unsigned char* L = (HY_LAS unsigned char*)ldsb;
    {
        const int tid = opaque_tid();
        const int lane = tid & 63;
        hy::f32x4 acc[16];
        const hy::ConvW cwv = hy::load_convw(p, c), cwx1 = hy::load_convw(p, 512 + c), cwx2 = hy::load_convw(p, 1024 + c);
        const float bias0 = hy::uni(p.hy_bias[c]), bias1 = hy::uni(p.hy_bias[512 + c]);
        __syncthreads();
        hy::load_u_image(cwv, L, PHYT + (size_t)c * NTOK, tid);
        hy::load_filter_scr(L, HF + (size_t)c * 4096, tid);
        __syncthreads();
        hy::build_filter_copies(L, tid);
        __syncthreads();
        hy::conv_loop(L, acc, w, lane);
        __syncthreads();
        hy::stage_raw_rows(L, PHYT + (size_t)(512 + c) * NTOK, tid);
        hy::load_filter_scr(L, HF + (size_t)(512 + c) * 4096, tid);
        __syncthreads();
        hy::gate_acc(cwx1, L, acc, bias0, w, lane);
        __syncthreads();
        hy::store_acc_uimg(L, acc, w, lane);
        hy::build_filter_copies(L, tid);
        __syncthreads();
        hy::conv_loop(L, acc, w, lane);
        __syncthreads();
        hy::stage_raw_rows(L, PHYT + (size_t)(1024 + c) * NTOK, tid);
        __syncthreads();
        hy::gate_acc(cwx2, L, acc, bias1, w, lane);
        hy::store_acc_uimg(L, acc, w, lane);
        __syncthreads();
#pragma unroll 2
        for (int k = 0; k < 8; ++k) {
            const int idx = tid + NT * k, b = idx >> 8, t8 = (idx & 255) * 8;
            *(hy::u32x4*)(YT + (size_t)c * NTOK + b * SEQ + t8) = *(const HY_LAS hy::u32x4*)(L + hy::UIMG + b * hy::U_STRIDE + t8 * 2);
        }
    }
}


namespace hg {
#define HG_LAS __attribute__((address_space(3)))
typedef short bf16x8 __attribute__((ext_vector_type(8)));
typedef float f32x4 __attribute__((ext_vector_type(4)));
typedef unsigned u32x4 __attribute__((ext_vector_type(4)));
typedef unsigned u32x2 __attribute__((ext_vector_type(2)));
constexpr int QROW = 272, KROW = 40;
constexpr int O_QT = 0, O_KBAR = 16 * QROW, O_KHAT = 2 * 16 * QROW, O_VT = O_KHAT + 128 * KROW, O_BDEC = O_VT + 128 * KROW, SET_BYTES = O_BDEC + 512;
constexpr int NCH_CTX = CTXL / 16, NCH = NCH_CTX + SEQ / 16;
template <int CTRL> __device__ __forceinline__ float dpp_mul(float x) {
    return x * __uint_as_float(__builtin_amdgcn_update_dpp(0x3f800000u, __float_as_uint(x), CTRL, 0xf, 0xf, false));
}
struct Raw { unsigned short q[4], v[4], z[4]; };
}

__device__ __forceinline__ void ph_hgrn_task(const P& p, unsigned char* ldsb, int item) {
    using namespace hg;
    const int tid = opaque_tid();
    const int lane = tid & 63, w = __builtin_amdgcn_readfirstlane(tid >> 6), j = lane & 15, g = lane >> 4;
    const int dir = item & 1, h = (item >> 1) & 3, b = item >> 3;
    const float* LB = (const float*)(p.ws + WS_LB);
    const bf16_t* PC = (const bf16_t*)(p.ws + WS_PC);
    const bf16_t* PHG = (const bf16_t*)(p.ws + WS_PHG);
    bf16_t* OFB = (bf16_t*)(p.ws + WS_OFB) + (size_t)dir * NTOK * 512;
    HG_LAS unsigned char* L = (HG_LAS unsigned char*)ldsb;
    float lb0[2], lb1[2];
#pragma unroll
    for (int pp = 0; pp < 2; ++pp) { const float2 t = *(const float2*)(LB + dir * 512 + h * 128 + 16 * w + 8 * pp + 2 * g); lb0[pp] = t.x; lb1[pp] = t.y; }
    const int zoff_c = dir == 0 ? 512 : 1024, zoff_l = dir == 0 ? 1024 : 1536;
    const bf16_t* rowc = PC + (size_t)b * CTXL * 1536 + h * 128 + 16 * w + 2 * g;
    const bf16_t* rowl = PHG + (size_t)b * SEQ * 2560 + h * 128 + 16 * w + 2 * g;
    struct Raw2 { unsigned q[2], v[2], z[2]; };
    auto load_raw = [&](int n, Raw2& r) {
        if (n < NCH_CTX) {
            const int tt = 16 * n + j, t = dir == 0 ? tt : (CTXL - 1 - tt);
            const bf16_t* row = rowc + (size_t)t * 1536;
#pragma unroll
            for (int pp = 0; pp < 2; ++pp) { r.q[pp] = 0u; r.v[pp] = *(const unsigned*)(row + 8 * pp); r.z[pp] = *(const unsigned*)(row + zoff_c + 8 * pp); }
        } else {
            const int tt = 16 * (n - NCH_CTX) + j, t = dir == 0 ? tt : (SEQ - 1 - tt);
            const bf16_t* row = rowl + (size_t)t * 2560;
#pragma unroll
            for (int pp = 0; pp < 2; ++pp) { r.q[pp] = *(const unsigned*)(row + 8 * pp); r.v[pp] = *(const unsigned*)(row + 512 + 8 * pp); r.z[pp] = *(const unsigned*)(row + zoff_l + 8 * pp); }
        }
    };
    const int qoff = j * QROW + 2 * (16 * w + 2 * g), koff = (16 * w + 2 * g) * KROW + 2 * j;
    auto prep = [&](const Raw2& r, HG_LAS unsigned char* S0) {
#pragma unroll
        for (int pp = 0; pp < 2; ++pp) {
            const float za = __uint_as_float(r.z[pp] << 16), zb = __uint_as_float(r.z[pp] & 0xffff0000u);
            const float qa = __uint_as_float(r.q[pp] << 16), qb = __uint_as_float(r.q[pp] & 0xffff0000u);
            const float fa = lb0[pp] + (1.0f - lb0[pp]) * __builtin_amdgcn_rcpf(1.0f + __builtin_amdgcn_exp2f(-1.4426950408889634f * za));
            const float fb = lb1[pp] + (1.0f - lb1[pp]) * __builtin_amdgcn_rcpf(1.0f + __builtin_amdgcn_exp2f(-1.4426950408889634f * zb));
            float Pa = dpp_mul<0x111>(fa), Pb = dpp_mul<0x111>(fb);
            Pa = dpp_mul<0x112>(Pa); Pb = dpp_mul<0x112>(Pb); Pa = dpp_mul<0x114>(Pa); Pb = dpp_mul<0x114>(Pb); Pa = dpp_mul<0x118>(Pa); Pb = dpp_mul<0x118>(Pb);
            const float Ca = __uint_as_float(__builtin_amdgcn_ds_bpermute(4 * (lane | 15), __float_as_uint(Pa)));
            const float Cb = __uint_as_float(__builtin_amdgcn_ds_bpermute(4 * (lane | 15), __float_as_uint(Pb)));
            const float ia = __builtin_amdgcn_rcpf(fmaxf(Pa, 1e-30f)), ib = __builtin_amdgcn_rcpf(fmaxf(Pb, 1e-30f));
            const float ka = (1.0f - fa) * ia, kb = (1.0f - fb) * ib;
            const float qva = qa * __builtin_amdgcn_rcpf(1.0f + __builtin_amdgcn_exp2f(-1.4426950408889634f * qa)) * (0.08838834764831845f * Pa);
            const float qvb = qb * __builtin_amdgcn_rcpf(1.0f + __builtin_amdgcn_exp2f(-1.4426950408889634f * qb)) * (0.08838834764831845f * Pb);
            *(HG_LAS unsigned*)(S0 + O_QT + qoff + 16 * pp) = cvtpk(qva, qvb);
            *(HG_LAS unsigned*)(S0 + O_KBAR + qoff + 16 * pp) = cvtpk(ka, kb);
            const unsigned kh = cvtpk(ka * Ca, kb * Cb);
            *(HG_LAS bf16_t*)(S0 + O_KHAT + koff + 8 * pp * KROW) = (bf16_t)(kh & 0xffffu);
            *(HG_LAS bf16_t*)(S0 + O_KHAT + koff + (8 * pp + 1) * KROW) = (bf16_t)(kh >> 16);
            *(HG_LAS bf16_t*)(S0 + O_VT + koff + 8 * pp * KROW) = (bf16_t)(r.v[pp] & 0xffffu);
            *(HG_LAS bf16_t*)(S0 + O_VT + koff + (8 * pp + 1) * KROW) = (bf16_t)(r.v[pp] >> 16);
            if (j == 15) { typedef float f32x2_t __attribute__((ext_vector_type(2))); *(HG_LAS f32x2_t*)(S0 + O_BDEC + 4 * (16 * w + 8 * pp + 2 * g)) = (f32x2_t){Pa, Pb}; }
        }
    };
    const float mk0 = (4 * g + 0) <= j ? 1.f : 0.f, mk1 = (4 * g + 1) <= j ? 1.f : 0.f, mk2 = (4 * g + 2) <= j ? 1.f : 0.f, mk3 = (4 * g + 3) <= j ? 1.f : 0.f;
    const int sc_off = j * QROW + 16 * g, vt_off = (16 * w + j) * KROW + 8 * g, qt8_off = j * QROW + 8 * g, kh_off = j * KROW + 8 * g;
    bf16_t* orow = OFB + (size_t)b * SEQ * 512 + h * 128 + 16 * w + 4 * g;
    f32x4 S[8];
#pragma unroll
    for (int t = 0; t < 8; ++t) S[t] = (f32x4){0.f, 0.f, 0.f, 0.f};
    constexpr int RDEPTH = 4;
    static_assert(NCH % RDEPTH == 0, "chunk loop is unrolled by the prefetch depth");
    Raw2 ring[RDEPTH];
    load_raw(0, ring[0]);
    __syncthreads();
    prep(ring[0], L);
#pragma unroll
    for (int c = 1; c <= RDEPTH; ++c) load_raw(c, ring[c % RDEPTH]);
    __syncthreads();
    auto chunk = [&](int n, int phase, Raw2& slot) {
        HG_LAS unsigned char* Sc = L + (n & 1) * SET_BYTES;
        HG_LAS unsigned char* Sn = L + ((n + 1) & 1) * SET_BYTES;
        bf16x8 kaf[4], qaf[4]; u32x2 qb0[4], qb1[4], krf[8]; f32x4 bdf[8];
#pragma unroll
        for (int kp = 0; kp < 4; ++kp) { kaf[kp] = *(const HG_LAS bf16x8*)(Sc + O_KBAR + sc_off + 64 * kp); qaf[kp] = *(const HG_LAS bf16x8*)(Sc + O_QT + sc_off + 64 * kp); }
        const u32x2 vraw = *(const HG_LAS u32x2*)(Sc + O_VT + vt_off);
#pragma unroll
        for (int pq = 0; pq < 4; ++pq) { qb0[pq] = *(const HG_LAS u32x2*)(Sc + O_QT + qt8_off + 64 * pq); qb1[pq] = *(const HG_LAS u32x2*)(Sc + O_QT + qt8_off + 64 * pq + 32); }
#pragma unroll
        for (int t = 0; t < 8; ++t) { bdf[t] = *(const HG_LAS f32x4*)(Sc + O_BDEC + 64 * t + 16 * g); krf[t] = *(const HG_LAS u32x2*)(Sc + O_KHAT + kh_off + 16 * KROW * t); }
        __builtin_amdgcn_sched_barrier(0);
        const u32x4 vf = (u32x4){vraw.x, vraw.y, 0u, 0u};
        f32x4 sc = (f32x4){0.f, 0.f, 0.f, 0.f};
#pragma unroll
        for (int kp = 0; kp < 4; ++kp) sc = __builtin_amdgcn_mfma_f32_16x16x32_bf16(kaf[kp], qaf[kp], sc, 0, 0, 0);
        f32x4 oT = (f32x4){0.f, 0.f, 0.f, 0.f};
#pragma unroll
        for (int pq = 0; pq < 4; ++pq) {
            u32x4 a; a.x = cvtpk(S[2 * pq][0], S[2 * pq][1]); a.y = cvtpk(S[2 * pq][2], S[2 * pq][3]); a.z = cvtpk(S[2 * pq + 1][0], S[2 * pq + 1][1]); a.w = cvtpk(S[2 * pq + 1][2], S[2 * pq + 1][3]);
            const u32x4 bb = (u32x4){qb0[pq].x, qb0[pq].y, qb1[pq].x, qb1[pq].y};
            oT = __builtin_amdgcn_mfma_f32_16x16x32_bf16(__builtin_bit_cast(bf16x8, a), __builtin_bit_cast(bf16x8, bb), oT, 0, 0, 0);
        }
#pragma unroll
        for (int t = 0; t < 8; ++t) {
            const u32x4 ka = (u32x4){krf[t].x, krf[t].y, 0u, 0u};
            S[t] = __builtin_amdgcn_mfma_f32_16x16x32_bf16(__builtin_bit_cast(bf16x8, ka), __builtin_bit_cast(bf16x8, vf), S[t] * bdf[t], 0, 0, 0);
        }
        u32x4 pf;
        pf.x = cvtpk(sc[0] * mk0, sc[1] * mk1); pf.y = cvtpk(sc[2] * mk2, sc[3] * mk3); pf.z = 0u; pf.w = 0u;
        oT = __builtin_amdgcn_mfma_f32_16x16x32_bf16(__builtin_bit_cast(bf16x8, vf), __builtin_bit_cast(bf16x8, pf), oT, 0, 0, 0);
        if (n + 1 < NCH) prep(slot, Sn);
        if (n + 1 + RDEPTH < NCH) load_raw(n + 1 + RDEPTH, slot);
        if (n >= NCH_CTX) {
            const int tt = 16 * (n - NCH_CTX) + j, t = dir == 0 ? tt : (SEQ - 1 - tt);
            *(u32x2*)(orow + (size_t)t * 512) = (u32x2){cvtpk(oT[0], oT[1]), cvtpk(oT[2], oT[3])};
        }
        lds_barrier();
    };
    for (int n0 = 0; n0 < NCH; n0 += RDEPTH) {
#pragma unroll
        for (int u = 0; u < RDEPTH; ++u) chunk(n0 + u, u % 3, ring[(u + 1) % RDEPTH]);
    }
}

template <int QW = 0, bool DO_HGRN = true, bool DO_QUEUE = true, bool DO_HY = true, bool DO_CV = true>
__device__ __forceinline__ void ph_mixers(const P& p, unsigned char* ldsb) {
    unsigned* qhead = (unsigned*)(p.ws + WS_CTL) + CW_QHEAD + QW;
    HG_LAS unsigned* bc = (HG_LAS unsigned*)(ldsb + LDS_BYTES - 16);
    if (DO_HGRN && blockIdx.x < NB * HEADS * 2) ph_hgrn_task(p, ldsb, blockIdx.x);
    if (!DO_QUEUE) return;
    for (;;) {
        __syncthreads();
        if (threadIdx.x == 0) *bc = atomicAdd(qhead, 1u);
        __syncthreads();
        const int c = (int)*bc;
        if (c >= 512 + N_EXPERT_ITEMS / 8) break;
        const int grp = c / 5, pos = c - 5 * grp;
        if (pos == 0 || pos == 2) { if (DO_HY) ph_hyena_task(p, ldsb, 2 * grp + (pos >> 1)); }
        else if (DO_CV) conv_run([&](int r) { return conv_expert_item(p, r); }, (3 * grp + (pos == 1 ? 0 : pos - 2)) * 8, 8, (float*)ldsb);
    }
}

__device__ __forceinline__ void ph_mixprep(const P& p, float* lds) {
    const int tid = opaque_tid(), lane = tid & 63, wv = tid >> 6;
    const bf16_t* YT = (const bf16_t*)(p.ws + WS_YT);
    bf16_t* MIXA = (bf16_t*)(p.ws + WS_MIXA);
    bf16_t* yl = (bf16_t*)lds;
    float* part = lds + (512 * 72 * 2) / 4;
    for (int tile = blockIdx.x; tile < NTOK / 64; tile += gridDim.x) {
        const int tok0 = tile * 64;
        __syncthreads();
        for (int i = tid; i < 512 * 8; i += NT) { const int row = i >> 3, ch = i & 7; *(uint4*)(yl + row * 72 + ch * 8) = *(const uint4*)(YT + (size_t)row * NTOK + tok0 + ch * 8); }
        __syncthreads();
        const int tok = tid & 63, pt = tid >> 6;
        float ss = 0.f;
        for (int c = pt * 64; c < pt * 64 + 64; ++c) { const float v = bf2f(yl[c * 72 + tok]); ss += v * v; }
        part[pt * 64 + tok] = ss;
        __syncthreads();
        float tot = 0.f;
#pragma unroll
        for (int k = 0; k < 8; ++k) tot += part[k * 64 + tok];
        const float rstd = rsqrtf(tot * (1.f / 512.f) + EPS);
        bf16_t* dst = MIXA + (size_t)(tok0 + tok) * D + pt * 64;
#pragma unroll
        for (int j = 0; j < 8; ++j) {
            float o[8];
#pragma unroll
            for (int q = 0; q < 8; ++q) { const int c = pt * 64 + j * 8 + q; o[q] = bf2f(yl[c * 72 + tok]) * rstd * p.hy_norm_g[c]; }
            *(uint4*)(dst + j * 8) = make_uint4(pk2(o[0], o[1]), pk2(o[2], o[3]), pk2(o[4], o[5]), pk2(o[6], o[7]));
        }
    }
    const bf16_t* OFB = (const bf16_t*)(p.ws + WS_OFB);
    const bf16_t* PHG = (const bf16_t*)(p.ws + WS_PHG);
    for (int r = blockIdx.x * 8 + wv; r < NTOK; r += gridDim.x * 8) {
#pragma unroll
        for (int h = 0; h < HEADS; ++h) {
            const int k = lane * 2;
            const unsigned a = *(const unsigned*)(OFB + (size_t)r * 512 + h * 128 + k);
            const unsigned bq = *(const unsigned*)(OFB + (size_t)NTOK * 512 + (size_t)r * 512 + h * 128 + k);
            const float o0 = __uint_as_float(a << 16) + __uint_as_float(bq << 16), o1 = __uint_as_float(a & 0xffff0000u) + __uint_as_float(bq & 0xffff0000u);
            const float ss = wave_sum(o0 * o0 + o1 * o1);
            const float rstd = rsqrtf(ss * (1.f / 128.f) + EPS);
            const unsigned g = *(const unsigned*)(PHG + (size_t)r * 2560 + 2048 + h * 128 + k);
            const float2 ng = *(const float2*)(p.hg_norm_g + k);
            *(unsigned*)(MIXA + (size_t)r * D + 512 + h * 128 + k) = pk2(o0 * rstd * ng.x * siluf_(__uint_as_float(g << 16)), o1 * rstd * ng.y * siluf_(__uint_as_float(g & 0xffff0000u)));
        }
    }
}

struct OutprojSched {
    int G, c; const bf16_t *A, *Bt;
    __device__ __forceinline__ bool next(int i, Unit& u) const {
        const int L = i * G + c; if (L >= 512) return false; int pm, pn; tile_of(L, 128, 4, pm, pn);
        u.a = (const char*)(A + (size_t)pm * 256 * D); u.b = (const char*)(Bt + (size_t)pn * 256 * D); u.c = nullptr; u.aux = nullptr; u.gidx = nullptr; u.ldc = D; u.row0 = pm * 256; u.col0 = pn * 256; return true;
    }
    __device__ __forceinline__ void a_ready(const Unit&) const {}
    __device__ __forceinline__ void done(const Unit&) const {}
};
__device__ __forceinline__ void ph_outproj(const P& p, unsigned char* lds) {
    OutprojSched S{(int)gridDim.x, (int)blockIdx.x, (const bf16_t*)(p.ws + WS_MIXA), (const bf16_t*)(p.ws + WS_WOUTT)};
    pg8::EpiOutProj E{p.x, (const float*)(p.ws + WS_ADA), p.out};
    pg8::gemm_phase<pg8::EpiOutProj, OutprojSched, true, true, false>((PG8_LAS unsigned char*)lds, D, S, E);
}

__device__ __forceinline__ void ph_norm2_router(const P& p, float* lds) {
    const int tid = opaque_tid(), lane = tid & 63, wv = tid >> 6;
    const float* ADA = (const float*)(p.ws + WS_ADA);
    const float* X1 = p.out;
    bf16_t* H2 = (bf16_t*)(p.ws + WS_H2);
    float* AFF = (float*)(p.ws + WS_AFF);
    __syncthreads();
    for (int i = tid; i < D * 4; i += NT) { const int d = i >> 2, e4 = i & 3; const float4 w = ((const float4*)p.router_w)[i];
        lds[(e4 * 4 + 0) * D + d] = w.x; lds[(e4 * 4 + 1) * D + d] = w.y; lds[(e4 * 4 + 2) * D + d] = w.z; lds[(e4 * 4 + 3) * D + d] = w.w; }
    __syncthreads();
    f32x4_t v[4], vn[4];
    const int rfirst = blockIdx.x * 8 + wv, rstep = gridDim.x * 8;
    if (rfirst < NTOK) {
#pragma unroll
        for (int j = 0; j < 4; ++j) v[j] = ((const f32x4_t*)(X1 + (size_t)rfirst * D))[lane + 64 * j];
    }
    for (int r = rfirst; r < NTOK; r += rstep) {
        const int b = r / SEQ, t = r % SEQ;
        if (r + rstep < NTOK) {
#pragma unroll
            for (int j = 0; j < 4; ++j) vn[j] = ((const f32x4_t*)(X1 + (size_t)(r + rstep) * D))[lane + 64 * j];
        }
        float ss = 0.f;
#pragma unroll
        for (int j = 0; j < 4; ++j) ss += v[j].x * v[j].x + v[j].y * v[j].y + v[j].z * v[j].z + v[j].w * v[j].w;
        const float rstd = rsqrtf(wave_sum(ss) * (1.f / D) + EPS);
        const float* sh = ADA + b * 6144 + 3072, *sc = ADA + b * 6144 + 4096;
        float lg[16];
#pragma unroll
        for (int e = 0; e < 16; ++e) lg[e] = 0.f;
#pragma unroll
        for (int j = 0; j < 4; ++j) {
            const int d4 = lane + 64 * j;
            const float4 g = ((const float4*)p.norm2_g)[d4], s1 = ((const float4*)sc)[d4], h1 = ((const float4*)sh)[d4];
            float4 o;
            o.x = v[j].x * rstd * g.x * (1.f + s1.x) + h1.x; o.y = v[j].y * rstd * g.y * (1.f + s1.y) + h1.y;
            o.z = v[j].z * rstd * g.z * (1.f + s1.z) + h1.z; o.w = v[j].w * rstd * g.w * (1.f + s1.w) + h1.w;
            ((uint2*)(H2 + (size_t)r * D))[d4] = make_uint2(cvtpk(o.x, o.y), cvtpk(o.z, o.w));
#pragma unroll
            for (int e = 0; e < 16; ++e) {
                const float4 w = *(const float4*)&lds[e * D + d4 * 4];
                lg[e] += o.x * w.x + o.y * w.y + o.z * w.z + o.w * w.w;
            }
            __builtin_amdgcn_sched_barrier(0);
        }
#pragma unroll
        for (int i = 0; i < 8; ++i) { const bool hi = lane & 1; const float keep = hi ? lg[2 * i + 1] : lg[2 * i], send = hi ? lg[2 * i] : lg[2 * i + 1]; lg[i] = keep + __shfl_xor(send, 1); }
#pragma unroll
        for (int i = 0; i < 4; ++i) { const bool hi = lane & 2; const float keep = hi ? lg[2 * i + 1] : lg[2 * i], send = hi ? lg[2 * i] : lg[2 * i + 1]; lg[i] = keep + __shfl_xor(send, 2); }
#pragma unroll
        for (int i = 0; i < 2; ++i) { const bool hi = lane & 4; const float keep = hi ? lg[2 * i + 1] : lg[2 * i], send = hi ? lg[2 * i] : lg[2 * i + 1]; lg[i] = keep + __shfl_xor(send, 4); }
        { const bool hi = lane & 8; const float keep = hi ? lg[1] : lg[0], send = hi ? lg[0] : lg[1]; lg[0] = keep + __shfl_xor(send, 8); }
        float lgt = lg[0];
        lgt += __shfl_xor(lgt, 16); lgt += __shfl_xor(lgt, 32);
        float mx = lgt;
        mx = fmaxf(mx, __shfl_xor(mx, 1)); mx = fmaxf(mx, __shfl_xor(mx, 2)); mx = fmaxf(mx, __shfl_xor(mx, 4)); mx = fmaxf(mx, __shfl_xor(mx, 8));
        const float ex = expf(lgt - mx);
        float den = ex;
        den += __shfl_xor(den, 1); den += __shfl_xor(den, 2); den += __shfl_xor(den, 4); den += __shfl_xor(den, 8);
        if (lane < 16) AFF[((size_t)b * 16 + lane) * SEQ + t] = ex / den;
#pragma unroll
        for (int j = 0; j < 4; ++j) v[j] = vn[j];
    }
}

__device__ __forceinline__ void ph_topk(const P& p, float* lds) {
    const int tid = opaque_tid(), lane = tid & 63, wv = tid >> 6;
    const float* AFF = (const float*)(p.ws + WS_AFF);
    int* IDX = (int*)(p.ws + WS_IDX);
    float* GATE = (float*)(p.ws + WS_GATE);
    int* INV = (int*)(p.ws + WS_INV);
    unsigned* hist = (unsigned*)lds;
    unsigned* ctl = hist + 256;
    unsigned* wtot = hist + 272;
    for (int item = blockIdx.x; item < NB * NE; item += gridDim.x) {
        const int b = item >> 4, e = item & 15;
        const uint4 kk = ((const uint4*)(AFF + (size_t)item * SEQ))[tid];
        const unsigned key[4] = {kk.x, kk.y, kk.z, kk.w};
        unsigned prefix = 0u, need = CAP;
#pragma unroll
        for (int pass = 3; pass >= 0; --pass) {
            __syncthreads();
            if (tid < 256) hist[tid] = 0u;
            __syncthreads();
#pragma unroll
            for (int q = 0; q < 4; ++q) {
                const bool in = (pass == 3) || ((key[q] >> (8 * (pass + 1))) == prefix);
                if (in) atomicAdd(&hist[(key[q] >> (8 * pass)) & 255u], 1u);
            }
            __syncthreads();
            if (wv == 0) {
                const uint4 h4 = ((const uint4*)hist)[lane];
                const unsigned loc = h4.x + h4.y + h4.z + h4.w;
                unsigned suf = loc;
#pragma unroll
                for (int o = 1; o < 64; o <<= 1) { const unsigned y = __shfl_down(suf, o); if (lane + o < 64) suf += y; }
                const unsigned above = suf - loc;
                unsigned c3 = above + h4.w, c2 = c3 + h4.z, c1 = c2 + h4.y, c0 = c1 + h4.x;
                int bin = -1; unsigned nneed = 0u;
                if (above < need && c0 >= need) {
                    if (c3 >= need) { bin = 4 * lane + 3; nneed = need - above; }
                    else if (c2 >= need) { bin = 4 * lane + 2; nneed = need - c3; }
                    else if (c1 >= need) { bin = 4 * lane + 1; nneed = need - c2; }
                    else { bin = 4 * lane; nneed = need - c1; }
                    ctl[0] = (prefix << 8) | (unsigned)bin; ctl[1] = nneed;
                }
            }
            __syncthreads();
            prefix = ctl[0]; need = ctl[1];
        }
        unsigned cgt = 0u, ceq = 0u;
#pragma unroll
        for (int q = 0; q < 4; ++q) { cgt += key[q] > prefix ? 1u : 0u; ceq += key[q] == prefix ? 1u : 0u; }
        unsigned sgt = cgt, seq = ceq;
#pragma unroll
        for (int o = 1; o < 64; o <<= 1) { const unsigned y1 = __shfl_up(sgt, o), y2 = __shfl_up(seq, o); if (lane >= o) { sgt += y1; seq += y2; } }
        if (lane == 63) { wtot[wv] = sgt; wtot[8 + wv] = seq; }
        __syncthreads();
        unsigned bgt = 0u, beq = 0u, ngt = 0u;
#pragma unroll
        for (int k = 0; k < 8; ++k) { const unsigned a = wtot[k], c = wtot[8 + k]; if (k < wv) { bgt += a; beq += c; } ngt += a; }
        unsigned rgt = bgt + sgt - cgt, req = beq + seq - ceq;
#pragma unroll
        for (int q = 0; q < 4; ++q) {
            const int t = 4 * tid + q; int slot = -1;
            if (key[q] > prefix) { slot = (int)rgt; ++rgt; }
            else if (key[q] == prefix) { if (req < need) slot = (int)(ngt + req); ++req; }
            if (slot >= 0) { IDX[item * CAP + slot] = t; GATE[item * CAP + slot] = __uint_as_float(key[q]); }
            INV[((size_t)b * SEQ + t) * 16 + e] = slot;
        }
    }
}

struct MoeUpSched {
    int G, c; const bf16_t *H2, *W13T; bf16_t* HMID; const int* IDX;
    __device__ __forceinline__ bool next(int i, Unit& u) const {
        if (i >= 16 || c >= 256) return false;
        const int item = c, b = item >> 4, e = item & 15, nt = i;
        u.a = (const char*)(H2 + (size_t)b * SEQ * D); u.b = (const char*)(W13T + ((size_t)e * 4096 + nt * 256) * D); u.c = HMID + (size_t)item * CAP * FF + nt * 128;
        u.aux = nullptr; u.gidx = IDX + item * CAP; u.ldc = FF; u.row0 = 0; u.col0 = 0; return true;
    }
    __device__ __forceinline__ void a_ready(const Unit&) const {}
    __device__ __forceinline__ void done(const Unit&) const {}
};
struct MoeDownSched {
    int G, c; const bf16_t *HMID, *W2T; bf16_t* YS; const float* GATE;
    __device__ __forceinline__ bool next(int i, Unit& u) const {
        if (i >= 4 || c >= 256) return false;
        const int item = c, e = item & 15, nt = i;
        u.a = (const char*)(HMID + (size_t)item * CAP * FF); u.b = (const char*)(W2T + ((size_t)e * 1024 + nt * 256) * FF); u.c = YS + (size_t)item * CAP * D + nt * 256;
        u.aux = GATE + item * CAP; u.gidx = nullptr; u.ldc = D; u.row0 = 0; u.col0 = 0; return true;
    }
    __device__ __forceinline__ void a_ready(const Unit&) const {}
    __device__ __forceinline__ void done(const Unit&) const {}
};
__device__ __forceinline__ void ph_moe_up(const P& p, unsigned char* lds) {
    MoeUpSched S{(int)gridDim.x, (int)blockIdx.x, (const bf16_t*)(p.ws + WS_H2), (const bf16_t*)(p.ws + WS_W13T), (bf16_t*)(p.ws + WS_HMID), (const int*)(p.ws + WS_IDX)};
    pg8::EpiSwiGLU E;
    pg8::gemm_phase<pg8::EpiSwiGLU, MoeUpSched, true, true, true>((PG8_LAS unsigned char*)lds, D, S, E);
}
__device__ __forceinline__ void ph_moe_down(const P& p, unsigned char* lds) {
    MoeDownSched S{(int)gridDim.x, (int)blockIdx.x, (const bf16_t*)(p.ws + WS_HMID), (const bf16_t*)(p.ws + WS_W2T), (bf16_t*)(p.ws + WS_YS), (const float*)(p.ws + WS_GATE)};
    pg8::EpiDown E;
    pg8::gemm_phase<pg8::EpiDown, MoeDownSched, true, true, false>((PG8_LAS unsigned char*)lds, FF, S, E);
}

__device__ __forceinline__ void ph_final(const P& p) {
    const int tid = opaque_tid(), lane = tid & 63, wv = tid >> 6;
    const float* ADA = (const float*)(p.ws + WS_ADA);
    const bf16_t* YS = (const bf16_t*)(p.ws + WS_YS);
    const int* INV = (const int*)(p.ws + WS_INV);
    float* X = p.out;
    for (int r0 = (blockIdx.x * 8 + wv) * 2; r0 < NTOK; r0 += gridDim.x * 16) {
        const int b = r0 / SEQ;
        const float* g2 = ADA + b * 6144 + 5120;
        int myinv[2]; f32x4_t xv[2][4]; f32x4_t acc[2][4];
#pragma unroll
        for (int rr = 0; rr < 2; ++rr) {
            myinv[rr] = INV[(size_t)(r0 + rr) * 16 + (lane & 15)];
#pragma unroll
            for (int j = 0; j < 4; ++j) { xv[rr][j] = ((const f32x4_t*)(X + (size_t)(r0 + rr) * D))[lane + 64 * j]; acc[rr][j] = (f32x4_t){0.f, 0.f, 0.f, 0.f}; }
        }
#pragma unroll
        for (int rr = 0; rr < 2; ++rr) {
            unsigned m = (unsigned)(__ballot(myinv[rr] >= 0) & 0xffffull);
            while (m) {
                uint2 w[4][4]; int ne = 0;
#pragma unroll
                for (int k = 0; k < 4; ++k) {
                    if (m) {
                        const int e = __builtin_ctz(m); m &= m - 1u; ne = k + 1;
                        const int slot = __shfl(myinv[rr], e);
                        const uint2* yr = (const uint2*)(YS + ((size_t)(b * 16 + e) * CAP + slot) * D);
#pragma unroll
                        for (int j = 0; j < 4; ++j) w[k][j] = yr[lane + 64 * j];
                    }
                }
#pragma unroll
                for (int k = 0; k < 4; ++k) {
                    if (k < ne) {
#pragma unroll
                        for (int j = 0; j < 4; ++j) { acc[rr][j].x += __uint_as_float(w[k][j].x << 16); acc[rr][j].y += __uint_as_float(w[k][j].x & 0xffff0000u); acc[rr][j].z += __uint_as_float(w[k][j].y << 16); acc[rr][j].w += __uint_as_float(w[k][j].y & 0xffff0000u); }
                    }
                }
            }
        }
#pragma unroll
        for (int rr = 0; rr < 2; ++rr) {
            f32x4_t v[4]; float ss = 0.f;
#pragma unroll
            for (int j = 0; j < 4; ++j) {
                const f32x4_t g = ((const f32x4_t*)g2)[lane + 64 * j];
                v[j] = xv[rr][j] + g * acc[rr][j];
                ss += v[j].x * v[j].x + v[j].y * v[j].y + v[j].z * v[j].z + v[j].w * v[j].w;
            }
            ss = wave_sum(ss);
            const float rstd = rsqrtf(ss * (1.f / D) + EPS);
#pragma unroll
            for (int j = 0; j < 4; ++j) {
                const f32x4_t g = ((const f32x4_t*)p.final_g)[lane + 64 * j];
                ((f32x4_t*)(X + (size_t)(r0 + rr) * D))[lane + 64 * j] = v[j] * rstd * g;
            }
        }
    }
}

#define LAS __attribute__((address_space(3)))
#define XB_TMO      128
#define XB_XCNT(j)  (256  + 64 * (j))
#define XB_XSUB(j)  (1280 + 64 * (j))
#define XB_XGEN(j)  (2304 + 64 * (j))
#define XB_TOP      3328
#define XB_TOPGEN   3392
#define XCD_BAR_WORDS 3456
#define XB_SPIN_CAP (1u << 18)

__device__ __forceinline__ unsigned xb_ld(unsigned* p)              { return __hip_atomic_load(p, __ATOMIC_RELAXED, __HIP_MEMORY_SCOPE_AGENT); }
__device__ __forceinline__ unsigned xb_add(unsigned* p, unsigned v) { return __hip_atomic_fetch_add(p, v, __ATOMIC_RELAXED, __HIP_MEMORY_SCOPE_AGENT); }
__device__ __forceinline__ unsigned xb_xcc_id() { return (unsigned)__builtin_amdgcn_s_getreg((3 << 11) | 20) & 0xFu; }
#define XB_SPIN(cond, bar) do { unsigned _sp = 0; while (cond) { __builtin_amdgcn_s_sleep(1); \
    if ((++_sp & 255u) == 0u) { if (xb_ld(&(bar)[XB_TMO])) break; if (_sp > XB_SPIN_CAP) { atomicAdd(&(bar)[XB_TMO], 1u); break; } } } } while (0)

struct XcdBarrier {
    unsigned* bar; unsigned x;
    volatile LAS unsigned* st;
};

__device__ __forceinline__ XcdBarrier xcd_barrier_post(unsigned* bar, volatile LAS unsigned* st) {
    XcdBarrier b; b.bar = bar; b.x = xb_xcc_id(); b.st = st;
    if (threadIdx.x == 0) (void)xb_add(&bar[XB_XCNT(b.x)], 1u);
    return b;
}
__device__ __forceinline__ void xcd_barrier_complete(unsigned* bar, unsigned x, unsigned& nloc, unsigned& nx) {
    const unsigned G = gridDim.x * gridDim.y * gridDim.z;
    unsigned sum, cnt, mine, sp = 0u;
    for (;;) {
        sum = 0u; cnt = 0u; mine = 0u;
#pragma unroll
        for (unsigned j = 0; j < 16; ++j) { const unsigned c = xb_ld(&bar[XB_XCNT(j)]); sum += c; cnt += (c > 0u) ? 1u : 0u; mine = (j == x) ? c : mine; }
        if (sum == G) break;
        __builtin_amdgcn_s_sleep(1);
        if ((++sp & 255u) == 0u) { if (xb_ld(&bar[XB_TMO])) break; if (sp > XB_SPIN_CAP) { atomicAdd(&bar[XB_TMO], 1u); break; } }
    }
    nloc = mine > 0u ? mine : 1u; nx = cnt > 0u ? cnt : 1u;
}

__device__ __forceinline__ void xcd_barrier(const XcdBarrier& b) {
    asm volatile("s_waitcnt vmcnt(0)" ::: "memory");
    __syncthreads();
    if (threadIdx.x == 0) {
        unsigned* bar = b.bar;
        __builtin_amdgcn_s_waitcnt(0);
        unsigned nloc = b.st[0], nx = b.st[1];
        if (nloc == 0u) { xcd_barrier_complete(bar, b.x, nloc, nx); b.st[0] = nloc; b.st[1] = nx; }
        const unsigned old = xb_add(&bar[XB_XSUB(b.x)], 1u);
        const unsigned gen = old / nloc;
        if (old + 1u == (gen + 1u) * nloc) {
            __builtin_amdgcn_fence(__ATOMIC_RELEASE, "agent");
            asm volatile("s_waitcnt vmcnt(0)" ::: "memory");
            const unsigned og = xb_add(&bar[XB_TOP], 1u);
            const unsigned tg = og / nx;
            if (og + 1u == (tg + 1u) * nx) xb_add(&bar[XB_TOPGEN], 1u);
            else XB_SPIN(xb_ld(&bar[XB_TOPGEN]) == tg, bar);
            __builtin_amdgcn_fence(__ATOMIC_ACQUIRE, "agent");
            xb_add(&bar[XB_XGEN(b.x)], 1u);
            asm volatile("s_waitcnt vmcnt(0)" ::: "memory");
        } else {
            XB_SPIN(xb_ld(&bar[XB_XGEN(b.x)]) == gen, bar);
            __builtin_amdgcn_fence(__ATOMIC_ACQUIRE, "agent");
            asm volatile("s_waitcnt vmcnt(0)" ::: "memory");
        }
    }
    __syncthreads();
}

constexpr int N_PHASES = 11;
template <int PH>
__device__ __forceinline__ void run_phase(const P& p, unsigned char* ldsb) {
    float* lds = (float*)ldsb;
    if constexpr (PH == 0) { ph_prep(p, lds); ph_convert_small(p, lds); }
    else if constexpr (PH == 1) { ph_norm1(p); ph_filter(p, lds); }
    else if constexpr (PH == 2) ph_inproj(p, ldsb);
    else if constexpr (PH == 3) ph_mixers<0>(p, ldsb);
    else if constexpr (PH == 4) ph_mixprep(p, lds);
    else if constexpr (PH == 5) ph_outproj(p, ldsb);
    else if constexpr (PH == 6) ph_norm2_router(p, lds);
    else if constexpr (PH == 7) ph_topk(p, lds);
    else if constexpr (PH == 8) ph_moe_up(p, ldsb);
    else if constexpr (PH == 9) ph_moe_down(p, ldsb);
    else if constexpr (PH == 10) ph_final(p);
}
template <int PH>
__device__ __forceinline__ void run_from(const P& p, unsigned char* lds, const XcdBarrier& bar) {
    if constexpr (PH < N_PHASES) {
        run_phase<PH>(p, lds);
        if constexpr (PH + 1 < N_PHASES) xcd_barrier(bar);
        run_from<PH + 1>(p, lds, bar);
    }
}
__global__ void __launch_bounds__(NT, 2) fwd_all(P p) {
    extern __shared__ __attribute__((aligned(16))) unsigned char lds_raw[];
    volatile LAS unsigned* st = (volatile LAS unsigned*)(lds_raw + LDS_BYTES - 32);
    if (threadIdx.x < 2) st[threadIdx.x] = 0u;
    __syncthreads();
    const XcdBarrier bar = xcd_barrier_post((unsigned*)(p.ws + WS_CTL) + CW_BAR, st);
    run_from<0>(p, lds_raw, bar);
}

extern "C" void kernel_launch(void* const* d_in, const int* in_sizes, int n_in, void* d_out, int out_size, void* d_ws, size_t ws_size, hipStream_t stream) {
    static int grid = 0;
    if (grid == 0) {
        int dev = 0, cus = 0, per_cu = 0;
        (void)hipGetDevice(&dev);
        (void)hipDeviceGetAttribute(&cus, hipDeviceAttributeMultiprocessorCount, dev);
        (void)hipFuncSetAttribute((const void*)fwd_all, hipFuncAttributeMaxDynamicSharedMemorySize, LDS_BYTES);
        (void)hipOccupancyMaxActiveBlocksPerMultiprocessor(&per_cu, (const void*)fwd_all, NT, LDS_BYTES);
        if (per_cu < 1) fprintf(stderr, "kernel_launch: occupancy query says %d blocks/CU\n", per_cu);
        grid = (cus > 0 ? cus : 256);
        if (ws_size < WS_END) fprintf(stderr, "kernel_launch: workspace too small: %zu < %zu\n", ws_size, (size_t)WS_END);
    }
    P p{};
    const float** f = (const float**)&p;
    for (int i = 0; i < 28; ++i) f[i] = (const float*)d_in[i];
    p.out = (float*)d_out;
    p.ws = (unsigned char*)d_ws;
    p.ph_lo = 0; p.ph_hi = N_PHASES;
    (void)hipMemsetAsync((unsigned char*)d_ws + WS_CTL, 0, CTL_ZERO_BYTES, stream);
    hipLaunchKernelGGL(fwd_all, dim3(grid), dim3(NT), LDS_BYTES, stream, p);
}
```

```cpp
#include <hip/hip_runtime.h>
#include <cstdio>
#include <cstdint>

constexpr int D = 1024, NB = 16, SEQ = 2048, CTXL = 256;
constexpr int NTOK = NB * SEQ;
constexpr int NCTX = NB * CTXL;
constexpr int HEADS = 4;
constexpr int INC = 4096;
constexpr int NE = 16, CAP = 256, FF = 2048;
constexpr int NT = 512;
constexpr int LDS_BYTES = 147456;
constexpr float EPS = 1e-6f;
typedef unsigned short bf16_t;

constexpr size_t MiB = 1u << 20;
constexpr size_t WS_CTL = 0;
constexpr size_t WS_ADA = 1 * MiB;
constexpr size_t WS_LB = WS_ADA + 512 * 1024;
constexpr size_t WS_HID2 = 2 * MiB;
constexpr size_t WS_AFF = 3 * MiB;
constexpr size_t WS_IDX = 5 * MiB;
constexpr size_t WS_GATE = 5 * MiB + 512 * 1024;
constexpr size_t WS_INV = 6 * MiB;
constexpr size_t WS_W13T = 8 * MiB;
constexpr size_t WS_YS = WS_W13T;
constexpr size_t WS_W2T = 136 * MiB;
constexpr size_t WS_R = 200 * MiB;
constexpr size_t WS_H = WS_R;
constexpr size_t WS_MIXA = WS_R;
constexpr size_t WS_HC = WS_R + 64 * MiB;
constexpr size_t WS_PC = WS_R + 72 * MiB;
constexpr size_t WS_OFB = WS_R + 84 * MiB;
constexpr size_t WS_WOUTT = WS_R + 148 * MiB;
constexpr size_t WS_PHG = WS_R + 152 * MiB;
constexpr size_t WS_HMID = WS_R;
constexpr size_t WS_H2 = WS_R + 256 * MiB;
constexpr size_t WS_YT = WS_R + 320 * MiB;
constexpr size_t WS_END = WS_YT + 32 * MiB;
constexpr int CW_QHEAD = 64;
constexpr int CW_BAR = 4096;
constexpr size_t CTL_ZERO_BYTES = 65536;
constexpr size_t DO_PHYT = 0;
constexpr size_t DO_HF = 96 * MiB;
constexpr size_t DO_SCTX = 112 * MiB;
constexpr size_t DO_WINT = 120 * MiB;

struct P {
    const float *x, *c, *ctx, *c_ctx, *ada_w, *ada_b, *norm1_g, *w_in, *hy_conv_w, *hy_conv_b, *pos_w1, *pos_b1, *freq1, *pos_w2, *pos_b2,
        *freq2, *pos_w3, *hy_bias, *hy_norm_g, *hg_lb, *hg_norm_g, *w_out, *norm2_g, *router_w, *exp_w1, *exp_w3, *exp_w2, *final_g;
    float* out;
    unsigned char* ws;
    int ph_lo, ph_hi;
};

__device__ __forceinline__ int opaque_tid() { int t = threadIdx.x; asm volatile("" : "+v"(t)); return t; }
__device__ __forceinline__ void lds_barrier() { asm volatile("s_waitcnt lgkmcnt(0)" ::: "memory"); __builtin_amdgcn_s_barrier(); asm volatile("" ::: "memory"); }
typedef float f32x4_t __attribute__((ext_vector_type(4)));
__device__ __forceinline__ float wave_sum(float v) {
#pragma unroll
    for (int o = 1; o < 64; o <<= 1) v += __shfl_xor(v, o);
    return v;
}
__device__ __forceinline__ float sigmoidf_(float z) { return 1.f / (1.f + expf(-z)); }
__device__ __forceinline__ float siluf_(float z) { return z / (1.f + expf(-z)); }
__device__ __forceinline__ float bf2f(bf16_t h) { return __uint_as_float((unsigned)h << 16); }
__device__ __forceinline__ unsigned f2bf(float f) { unsigned u = __float_as_uint(f); return (u + 0x7fffu + ((u >> 16) & 1u)) >> 16; }
typedef float f32x2_cv __attribute__((ext_vector_type(2))); typedef __bf16 bf16x2_cv __attribute__((ext_vector_type(2)));
__device__ __forceinline__ unsigned cvtpk(float lo, float hi) { const f32x2_cv v = {lo, hi}; const bf16x2_cv b = __builtin_convertvector(v, bf16x2_cv); return __builtin_bit_cast(unsigned, b); }
__device__ __forceinline__ unsigned pk2(float lo, float hi) { return f2bf(lo) | (f2bf(hi) << 16); }

namespace pg8 {
#define PG8_LAS __attribute__((address_space(3)))
typedef unsigned short bf16_t;
typedef short bf16x8 __attribute__((ext_vector_type(8)));
typedef float f32x4 __attribute__((ext_vector_type(4)));
typedef unsigned u32x4 __attribute__((ext_vector_type(4)));
constexpr int BM = 256, BK = 64, HALF = 128, HTB = HALF * BK * 2  , STAGE_BYTES = 8 * HTB, NXCD = 8, WGM = 8;

__host__ __device__ __forceinline__ int lds_byte(int r, int c) { const int st = (r >> 4) * 2 + (c >> 5), rr = r & 15, cc = c & 31, ob = rr * 64 + cc * 2; return st * 1024 + (ob ^ (((ob >> 9) & 1) << 5)); }
__host__ __device__ __forceinline__ void stage_rc(int b, int& R, int& C) { const int st = b / 1024, sb = b % 1024, swz = sb ^ (((sb >> 9) & 1) << 5); R = (st >> 1) * 16 + swz / 64; C = (st & 1) * 32 + (swz % 64) / 2; }
__host__ __device__ __forceinline__ int perm32(int rho) { const int n = rho >> 4, i = rho & 15; return 8 * (i >> 2) + 4 * n + (i & 3); }

struct Unit { const char* a; const char* b; bf16_t* c; const float* aux; const int* gidx; int ldc, row0, col0; };
__device__ __forceinline__ unsigned cvt_pk_bf16(float lo, float hi) { unsigned r; asm volatile("v_cvt_pk_bf16_f32 %0, %1, %2" : "=v"(r) : "v"(lo), "v"(hi)); return r; }

__device__ __forceinline__ void tile_of(int L, int nM, int nN, int& pm, int& pn) {
    const int nwg = nM * nN; int wgid = L;
    { const int q = nwg / NXCD, r = nwg % NXCD, xcd = wgid % NXCD, off = wgid / NXCD; wgid = (xcd < r ? xcd * (q + 1) : r * (q + 1) + (xcd - r) * q) + off; }
    const int nig = WGM * nN, gid = wgid / nig, fm = gid * WGM, gsz = (nM - fm) < WGM ? (nM - fm) : WGM;
    pm = fm + ((wgid % nig) % gsz); pn = (wgid % nig) / gsz;
}

struct EpiStoreBf16 {
    static constexpr bool PERM = true, AFTER_DRAIN = false;
    __device__ __forceinline__ void operator()(const f32x4 (&acc)[2][2][4][2], const Unit& u, int wr, int wc, int fr, int fq) const {
        bf16_t* base = u.c + (size_t)(wr * 64 + fr) * u.ldc + wc * 32 + 8 * fq;
#pragma unroll
        for (int ai = 0; ai < 2; ++ai)
#pragma unroll
            for (int m = 0; m < 4; ++m) { bf16_t* rowp = base + (size_t)(ai * HALF + m * 16) * u.ldc;
#pragma unroll
                for (int bj = 0; bj < 2; ++bj) { const f32x4 v0 = acc[ai][bj][m][0], v1 = acc[ai][bj][m][1];
                    u32x4 w; w.x = cvt_pk_bf16(v0[0], v0[1]); w.y = cvt_pk_bf16(v0[2], v0[3]); w.z = cvt_pk_bf16(v1[0], v1[1]); w.w = cvt_pk_bf16(v1[2], v1[3]);
                    *(u32x4*)(rowp + bj * HALF) = w; } }
    }
};
struct EpiOutProj {
    static constexpr bool PERM = true, AFTER_DRAIN = false;
    const float* x; const float* ada; bf16_t* x1;
    __device__ __forceinline__ void operator()(const f32x4 (&acc)[2][2][4][2], const Unit& u, int wr, int wc, int fr, int fq) const {
        const float* g1 = ada + (u.row0 >> 11) * 6144 + 2048;
#pragma unroll
        for (int bj = 0; bj < 2; ++bj) { const int col = u.col0 + bj * HALF + wc * 32 + 8 * fq; const f32x4 g0 = *(const f32x4*)(g1 + col), gB = *(const f32x4*)(g1 + col + 4);
#pragma unroll
            for (int ai = 0; ai < 2; ++ai)
#pragma unroll
                for (int m = 0; m < 4; ++m) { const size_t row = (size_t)(u.row0 + ai * HALF + wr * 64 + m * 16 + fr);
                    const f32x4 v0 = *(const f32x4*)(x + row * D + col) + g0 * acc[ai][bj][m][0], v1 = *(const f32x4*)(x + row * D + col + 4) + gB * acc[ai][bj][m][1];
                    u32x4 w; w.x = cvt_pk_bf16(v0[0], v0[1]); w.y = cvt_pk_bf16(v0[2], v0[3]); w.z = cvt_pk_bf16(v1[0], v1[1]); w.w = cvt_pk_bf16(v1[2], v1[3]);
                    *(u32x4*)(x1 + row * (2 * D) + col) = w; } }
    }
};
__device__ __forceinline__ float silu_fast(float a) { return a * __builtin_amdgcn_rcpf(1.0f + __builtin_amdgcn_exp2f(-1.4426950408889634f * a)); }
struct EpiSwiGLU {
    static constexpr bool PERM = true, AFTER_DRAIN = false;
    __device__ __forceinline__ void operator()(const f32x4 (&acc)[2][2][4][2], const Unit& u, int wr, int wc, int fr, int fq) const {
        bf16_t* base = u.c + (size_t)(wr * 64 + fr) * FF + wc * 32 + 8 * fq;
#pragma unroll
        for (int ai = 0; ai < 2; ++ai)
#pragma unroll
            for (int m = 0; m < 4; ++m) { const f32x4 a0 = acc[ai][0][m][0], a1 = acc[ai][0][m][1], b0 = acc[ai][1][m][0], b1 = acc[ai][1][m][1];
                u32x4 w; w.x = cvt_pk_bf16(silu_fast(a0[0]) * b0[0], silu_fast(a0[1]) * b0[1]); w.y = cvt_pk_bf16(silu_fast(a0[2]) * b0[2], silu_fast(a0[3]) * b0[3]);
                w.z = cvt_pk_bf16(silu_fast(a1[0]) * b1[0], silu_fast(a1[1]) * b1[1]); w.w = cvt_pk_bf16(silu_fast(a1[2]) * b1[2], silu_fast(a1[3]) * b1[3]);
                *(u32x4*)(base + (size_t)(ai * HALF + m * 16) * FF) = w; }
    }
};
struct EpiDown {
    static constexpr bool PERM = true, AFTER_DRAIN = false;
    __device__ __forceinline__ void operator()(const f32x4 (&acc)[2][2][4][2], const Unit& u, int wr, int wc, int fr, int fq) const {
        bf16_t* base = u.c + (size_t)(wr * 64 + fr) * D + wc * 32 + 8 * fq;
#pragma unroll
        for (int ai = 0; ai < 2; ++ai)
#pragma unroll
            for (int m = 0; m < 4; ++m) { const float gt = u.aux[ai * HALF + wr * 64 + m * 16 + fr]; bf16_t* rowp = base + (size_t)(ai * HALF + m * 16) * D;
#pragma unroll
                for (int bj = 0; bj < 2; ++bj) { const f32x4 v0 = acc[ai][bj][m][0] * gt, v1 = acc[ai][bj][m][1] * gt;
                    u32x4 w; w.x = cvt_pk_bf16(v0[0], v0[1]); w.y = cvt_pk_bf16(v0[2], v0[3]); w.z = cvt_pk_bf16(v1[0], v1[1]); w.w = cvt_pk_bf16(v1[2], v1[3]);
                    *(u32x4*)(rowp + bj * HALF) = w; } }
    }
};

template <class Epi, class Sched, bool ALIGN_EPI = false, bool SP2 = false, bool GATHER = false>
__device__ __forceinline__ void gemm_phase(PG8_LAS unsigned char* lds, const int K, const Sched& S, const Epi& E) {
    const int tid = opaque_tid(), wid = __builtin_amdgcn_readfirstlane(tid >> 6), lane = tid & 63, wr = wid >> 2, wc = wid & 3, fr = lane & 15, fq = lane >> 4;
    const int nt = K / BK;
    unsigned voffA[2], voffB[2];
#pragma unroll
    for (int i = 0; i < 2; ++i) { int R, C; stage_rc(tid * 16 + i * 8192, R, C); const int Rb = Epi::PERM ? ((R & ~31) + perm32(R & 31)) : R;
        voffA[i] = (unsigned)(R * K + C) * 2u; voffB[i] = (unsigned)(Rb * K + C) * 2u; }
    const size_t kstep = (size_t)(BK * 2);
    const size_t hstep = (size_t)HALF * K * 2;
    const unsigned ldsw = (unsigned)wid * 1024u;
    const int aoff = lds_byte(wr * 64 + fr, fq * 8), boff = lds_byte(wc * 32 + fr, fq * 8);
#define PG8_SA(b, h) (((b) * 2 + (h)) * HTB)
#define PG8_SB(b, h) ((4 + (b) * 2 + (h)) * HTB)
#define PG8_STAGE(bufoff, gbase, voff) do { _Pragma("unroll") for (int _i = 0; _i < 2; ++_i) \
        __builtin_amdgcn_global_load_lds((const unsigned*)((const char*)(gbase) + (voff)[_i]), (PG8_LAS unsigned*)(lds + (bufoff) + ldsw + _i * 8192), 16, 0, 0); } while (0)
#define PG8_STAGE_A(bufoff, gbase, h) do { _Pragma("unroll") for (int _i = 0; _i < 2; ++_i) \
        __builtin_amdgcn_global_load_lds((const unsigned*)((const char*)(gbase) + voffAh[h][_i]), (PG8_LAS unsigned*)(lds + (bufoff) + ldsw + _i * 8192), 16, 0, 0); } while (0)
#define PG8_LDA(dst, b, h) do { _Pragma("unroll") for (int m = 0; m < 4; ++m) _Pragma("unroll") for (int k = 0; k < 2; ++k) dst[m][k] = *(const PG8_LAS bf16x8*)(lds + PG8_SA(b, h) + aoff + m * 2048 + k * 1024); } while (0)
#define PG8_LDB(dst, b, h) do { _Pragma("unroll") for (int n = 0; n < 2; ++n) _Pragma("unroll") for (int k = 0; k < 2; ++k) dst[n][k] = *(const PG8_LAS bf16x8*)(lds + PG8_SB(b, h) + boff + n * 2048 + k * 1024); } while (0)
#define PG8_MMA(ai, bj, At, Bt) do { __builtin_amdgcn_s_setprio(1); _Pragma("unroll") for (int m = 0; m < 4; ++m) _Pragma("unroll") for (int n = 0; n < 2; ++n) _Pragma("unroll") for (int k = 0; k < 2; ++k) \
        acc[ai][bj][m][n] = __builtin_amdgcn_mfma_f32_16x16x32_bf16(Bt[n][k], At[m][k], acc[ai][bj][m][n], 0, 0, 0); __builtin_amdgcn_s_setprio(0); } while (0)
#define PG8_WAIT_V(n) asm volatile("s_waitcnt vmcnt(" #n ")" ::: "memory")
#define PG8_WAIT_L(n) asm volatile("s_waitcnt lgkmcnt(" #n ")" ::: "memory")
#define PG8_BAR __builtin_amdgcn_s_barrier()
#define PG8_SCHED __builtin_amdgcn_sched_barrier(0)
    Unit cur, nxt; int ui = 0;
    if (!S.next(0, cur)) return;
    unsigned voffAh[2][2];
#pragma unroll
    for (int h = 0; h < 2; ++h)
#pragma unroll
        for (int i = 0; i < 2; ++i) {
            if constexpr (GATHER) { int R, C; stage_rc(tid * 16 + i * 8192, R, C); voffAh[h][i] = ((unsigned)cur.gidx[h * HALF + R] * (unsigned)K + (unsigned)C) * 2u; }
            else voffAh[h][i] = voffA[i] + (unsigned)h * (unsigned)hstep;
        }
    f32x4 acc[2][2][4][2];
#pragma unroll
    for (int a = 0; a < 2; ++a)
#pragma unroll
        for (int b = 0; b < 2; ++b)
#pragma unroll
            for (int m = 0; m < 4; ++m)
#pragma unroll
                for (int n = 0; n < 2; ++n) acc[a][b][m][n] = (f32x4){0.f, 0.f, 0.f, 0.f};
    bf16x8 At[4][2], B0[2][2], B1[2][2];
    const char* cA = cur.a; const char* cB = cur.b;
    S.a_ready(cur);
    if constexpr (SP2) {
        PG8_STAGE(PG8_SB(0, 0), cB, voffB); PG8_STAGE(PG8_SB(0, 1), cB + hstep, voffB); PG8_STAGE_A(PG8_SA(0, 0), cA, 0); PG8_STAGE_A(PG8_SA(0, 1), cA, 1);
        if (wr == 1) PG8_BAR;
        PG8_WAIT_V(2); PG8_BAR;
        PG8_STAGE(PG8_SB(1, 0), cB + kstep, voffB); PG8_STAGE_A(PG8_SA(1, 0), cA + kstep, 0); PG8_STAGE(PG8_SB(1, 1), cB + hstep + kstep, voffB);
        PG8_WAIT_V(6); PG8_BAR;
    } else {
        PG8_STAGE(PG8_SB(0, 0), cB, voffB); PG8_STAGE_A(PG8_SA(0, 0), cA, 0); PG8_STAGE(PG8_SB(0, 1), cB + hstep, voffB); PG8_STAGE_A(PG8_SA(0, 1), cA, 1);
        if (wr == 1) PG8_BAR;
        PG8_WAIT_V(4); PG8_BAR;
        PG8_STAGE(PG8_SB(1, 0), cB + kstep, voffB); PG8_STAGE_A(PG8_SA(1, 0), cA + kstep, 0); PG8_STAGE(PG8_SB(1, 1), cB + hstep + kstep, voffB);
        PG8_WAIT_V(6); PG8_BAR;
    }
    for (;;) {
        const bool has_next = S.next(ui + 1, nxt);
        const char* nA = has_next ? nxt.a : cA; const char* nB = has_next ? nxt.b : cB;
        for (int t = 0; t < nt; t += 2) {
            const bool last = (t == nt - 2);
            const char* a1 = cA + (size_t)(t + 1) * kstep;
            const char* a2 = last ? nA : cA + (size_t)(t + 2) * kstep; const char* b2 = last ? nB : cB + (size_t)(t + 2) * kstep;
            const char* a3 = a2 + kstep; const char* b3 = b2 + kstep;
            if (last && has_next) S.a_ready(nxt);
            if constexpr (SP2) {
            PG8_LDB(B0, 0, 0); PG8_LDB(B1, 0, 1); PG8_SCHED; PG8_LDA(At, 0, 0); PG8_STAGE_A(PG8_SA(1, 1), a1, 1);
            PG8_WAIT_V(8); PG8_WAIT_L(0); PG8_BAR; PG8_MMA(0, 0, At, B0); PG8_MMA(0, 1, At, B1); PG8_BAR; PG8_SCHED;
            PG8_LDA(At, 0, 1); PG8_STAGE(PG8_SB(0, 0), b2, voffB); PG8_STAGE(PG8_SB(0, 1), b2 + hstep, voffB); PG8_STAGE_A(PG8_SA(0, 0), a2, 0);
            PG8_WAIT_V(8); PG8_WAIT_L(0); PG8_BAR; PG8_MMA(1, 0, At, B0); PG8_MMA(1, 1, At, B1); PG8_BAR; PG8_SCHED;
            PG8_LDB(B0, 1, 0); PG8_LDB(B1, 1, 1); PG8_SCHED; PG8_LDA(At, 1, 0); PG8_STAGE_A(PG8_SA(0, 1), a2, 1);
            PG8_WAIT_V(8); PG8_WAIT_L(0); PG8_BAR; PG8_MMA(0, 0, At, B0); PG8_MMA(0, 1, At, B1); PG8_BAR; PG8_SCHED;
            PG8_LDA(At, 1, 1); PG8_STAGE(PG8_SB(1, 0), b3, voffB); PG8_STAGE(PG8_SB(1, 1), b3 + hstep, voffB); PG8_STAGE_A(PG8_SA(1, 0), a3, 0);
            PG8_WAIT_V(8); PG8_WAIT_L(0); PG8_BAR; PG8_MMA(1, 0, At, B0); PG8_MMA(1, 1, At, B1); PG8_BAR; PG8_SCHED;
            } else {
            PG8_LDB(B0, 0, 0); PG8_SCHED; PG8_LDA(At, 0, 0); PG8_STAGE_A(PG8_SA(1, 1), a1, 1);
            PG8_WAIT_L(8); PG8_BAR; PG8_WAIT_L(0); PG8_MMA(0, 0, At, B0); PG8_BAR; PG8_SCHED;
            PG8_LDB(B1, 0, 1); PG8_STAGE(PG8_SB(0, 0), b2, voffB);
            PG8_BAR; PG8_WAIT_L(0); PG8_MMA(0, 1, At, B1); PG8_BAR;
            PG8_LDA(At, 0, 1); PG8_STAGE_A(PG8_SA(0, 0), a2, 0);
            PG8_BAR; PG8_WAIT_L(0); PG8_MMA(1, 0, At, B0); PG8_BAR; PG8_SCHED;
            PG8_STAGE(PG8_SB(0, 1), b2 + hstep, voffB);
            PG8_WAIT_V(6); PG8_BAR; PG8_MMA(1, 1, At, B1); PG8_BAR;
            PG8_LDB(B0, 1, 0); PG8_SCHED; PG8_LDA(At, 1, 0); PG8_STAGE_A(PG8_SA(0, 1), a2, 1);
            PG8_WAIT_L(8); PG8_BAR; PG8_WAIT_L(0); PG8_MMA(0, 0, At, B0); PG8_BAR; PG8_SCHED;
            PG8_LDB(B1, 1, 1); PG8_STAGE(PG8_SB(1, 0), b3, voffB);
            PG8_BAR; PG8_WAIT_L(0); PG8_MMA(0, 1, At, B1); PG8_BAR;
            PG8_LDA(At, 1, 1); PG8_STAGE_A(PG8_SA(1, 0), a3, 0);
            PG8_BAR; PG8_WAIT_L(0); PG8_MMA(1, 0, At, B0); PG8_BAR; PG8_SCHED;
            PG8_STAGE(PG8_SB(1, 1), b3 + hstep, voffB);
            PG8_WAIT_V(6); PG8_BAR; PG8_MMA(1, 1, At, B1); PG8_BAR;
            }
        }
        if constexpr (ALIGN_EPI) { if (wr == 0) PG8_BAR; }
        if constexpr (!Epi::AFTER_DRAIN) { E(acc, cur, wr, wc, fr, fq); S.done(cur); }
        if (!has_next) break;
#pragma unroll
        for (int a = 0; a < 2; ++a)
#pragma unroll
            for (int b = 0; b < 2; ++b)
#pragma unroll
                for (int m = 0; m < 4; ++m)
#pragma unroll
                    for (int n = 0; n < 2; ++n) acc[a][b][m][n] = (f32x4){0.f, 0.f, 0.f, 0.f};
        cur = nxt; cA = nA; cB = nB; ++ui;
        if constexpr (ALIGN_EPI) { if (wr == 1) PG8_BAR; }
    }
    PG8_WAIT_V(0);
    if constexpr (!ALIGN_EPI) { if (wr == 0) PG8_BAR; }
    PG8_BAR;
    if constexpr (Epi::AFTER_DRAIN) { E.fused(acc, cur, wr, wc, fr, fq, lds, wid, lane); S.done(cur); }
#undef PG8_SA
#undef PG8_SB
#undef PG8_STAGE
#undef PG8_LDA
#undef PG8_LDB
#undef PG8_MMA
#undef PG8_WAIT_V
#undef PG8_WAIT_L
#undef PG8_BAR
#undef PG8_SCHED
}
}
using pg8::Unit; using pg8::tile_of;

__device__ __forceinline__ void ph_prep(const P& p, float* lds) {
    const int tid = opaque_tid(), G = gridDim.x;
    float* ADA = (float*)(p.ws + WS_ADA);
    float* LB = (float*)(p.ws + WS_LB);
    float* HID2 = (float*)(p.ws + WS_HID2);
    {
        float* s = lds;
        float* red = lds + 17 * 1024;
        if (blockIdx.x < 192) {
            for (int i = tid; i < 17 * 1024; i += NT) {
                const int r = i >> 10, d = i & 1023;
                const float cv = r < 16 ? p.c[r * 1024 + d] : p.c_ctx[d];
                s[i] = siluf_(cv);
            }
        }
        __syncthreads();
        for (int item = blockIdx.x; item < 192; item += G) {
            const int jj = tid & 31, ks = tid >> 5, j = item * 32 + jj;
            float acc[17];
#pragma unroll
            for (int r = 0; r < 17; ++r) acc[r] = 0.f;
            for (int d0 = ks * 64; d0 < ks * 64 + 64; d0 += 16) {
                float wv[16];
#pragma unroll
                for (int q = 0; q < 16; ++q) wv[q] = p.ada_w[(size_t)(d0 + q) * 6144 + j];
#pragma unroll
                for (int q = 0; q < 16; ++q)
#pragma unroll
                    for (int r = 0; r < 17; ++r) acc[r] += s[r * 1024 + d0 + q] * wv[q];
            }
#pragma unroll
            for (int r = 0; r < 17; ++r) red[(ks * 17 + r) * 32 + jj] = acc[r];
            __syncthreads();
            for (int i = tid; i < 17 * 32; i += NT) {
                const int r = i >> 5, j2 = i & 31;
                float sum = 0.f;
#pragma unroll
                for (int k = 0; k < 16; ++k) sum += red[(k * 17 + r) * 32 + j2];
                ADA[r * 6144 + item * 32 + j2] = sum + p.ada_b[item * 32 + j2];
            }
            __syncthreads();
        }
    }
    if (blockIdx.x == G - 1) {
        for (int i = tid; i < 1024; i += NT) {
            const float a0 = p.hg_lb[i], a1 = p.hg_lb[1024 + i];
            LB[i] = 1.f / (1.f + expf(a1 - a0));
        }
    }
    {
        float* zl = lds;
        float* h1 = lds + 512;
        __syncthreads();
        for (int it = (G - 1 - blockIdx.x); it < SEQ / 8; it += G) {
            const int lt = tid >> 6, j = tid & 63, t = it * 8 + lt;
            const float w = 6.283185307179586f * (float)t / 2048.0f;
            if (j == 0) zl[lt * 64] = (float)t / 2047.0f;
            if (j >= 1 && j < 17) { const float f = 1e-4f + (float)(j - 1) * ((15.0f - 1e-4f) / 15.0f); zl[lt * 64 + j] = cosf(f * w); }
            if (j >= 17 && j < 33) { const float f = 1e-4f + (float)(j - 17) * ((15.0f - 1e-4f) / 15.0f); zl[lt * 64 + j] = -sinf(f * w); }
            __syncthreads();
            float a = p.pos_b1[j];
            for (int i = 0; i < 33; ++i) a += zl[lt * 64 + i] * p.pos_w1[i * 64 + j];
            h1[lt * 64 + j] = sinf(p.freq1[j] * a);
            __syncthreads();
            float b = p.pos_b2[j];
            for (int i = 0; i < 64; ++i) b += h1[lt * 64 + i] * p.pos_w2[i * 64 + j];
            HID2[t * 64 + j] = sinf(p.freq2[j] * b);
            __syncthreads();
        }
    }
}
struct ConvItem { const float* W; bf16_t* dst; int N, KD, k0, n0, which; };
__device__ __forceinline__ ConvItem conv_small_item(const P& p, int it) {
    ConvItem c; c.which = 0; c.KD = D;
    if (it < 256) { c.W = p.w_in; c.N = INC; c.k0 = (it / 16) * 64; c.n0 = (it % 16) * 256; c.dst = (bf16_t*)((unsigned char*)p.out + DO_WINT); }
    else { const int r = it - 256; c.W = p.w_out; c.N = D; c.k0 = (r / 4) * 64; c.n0 = (r % 4) * 256; c.dst = (bf16_t*)(p.ws + WS_WOUTT); }
    return c;
}
constexpr int N_EXPERT_ITEMS = 2 * 16 * 16 * 8 + 16 * 32 * 4;
__device__ __forceinline__ ConvItem conv_expert_item(const P& p, int r) {
    ConvItem c; constexpr int I_W1 = 16 * 16 * 8;
    if (r < 2 * I_W1) {
        const int which = r / I_W1; r %= I_W1;
        const int e = r / 128, r2 = r % 128;
        c.W = (which == 0 ? p.exp_w1 : p.exp_w3) + (size_t)e * D * FF; c.N = FF; c.k0 = (r2 / 8) * 64; c.n0 = (r2 % 8) * 256; c.dst = (bf16_t*)(p.ws + WS_W13T) + (size_t)e * 4096 * D; c.KD = D; c.which = 1 + which;
    } else {
        r -= 2 * I_W1; const int e = r / 128, r2 = r % 128;
        c.W = p.exp_w2 + (size_t)e * FF * D; c.N = D; c.k0 = (r2 / 4) * 64; c.n0 = (r2 % 4) * 256; c.dst = (bf16_t*)(p.ws + WS_W2T) + (size_t)e * 1024 * FF; c.KD = FF; c.which = 0;
    }
    return c;
}
__device__ __forceinline__ void conv_load(const ConvItem& c, f32x4_t (&v)[8], int tid) {
#pragma unroll
    for (int q = 0; q < 8; ++q) { const int i = tid + NT * q, k = i >> 6, n4 = i & 63; v[q] = *(const f32x4_t*)(c.W + (size_t)(c.k0 + k) * c.N + c.n0 + 4 * n4); }
}
__device__ __forceinline__ void conv_tile_write(const f32x4_t (&v)[8], float* T, int tid) {
#pragma unroll
    for (int q = 0; q < 8; ++q) { const int i = tid + NT * q, k = i >> 6, n4 = i & 63; *(f32x4_t*)&T[k * 260 + 4 * (n4 ^ ((k >> 3) & 7))] = v[q]; }
}
__device__ __forceinline__ void conv_tile_store(const ConvItem& c, const float* T, int tid) {
#pragma unroll
    for (int q = 0; q < 4; ++q) { const int i = tid + NT * q, nl = i >> 3, ch = i & 7, n = c.n0 + nl;
        float a[8];
#pragma unroll
        for (int e = 0; e < 8; ++e) a[e] = T[(8 * ch + e) * 260 + (nl ^ (ch << 2))];
        const int row = c.which == 0 ? n : ((n >> 7) * 256 + (c.which - 1) * 128 + (n & 127));
        *(uint4*)(c.dst + (size_t)row * c.KD + c.k0 + 8 * ch) = make_uint4(cvtpk(a[0], a[1]), cvtpk(a[2], a[3]), cvtpk(a[4], a[5]), cvtpk(a[6], a[7])); }
}
constexpr int CONV_DEPTH = 4;
template <class ITEMF>
__device__ __forceinline__ void conv_run(ITEMF item, int first, int count, float* T) {
    const int tid = opaque_tid();
    f32x4_t ring[CONV_DEPTH][8];
#pragma unroll
    for (int d = 0; d < CONV_DEPTH; ++d) { const ConvItem c = item(first + d); conv_load(c, ring[d], tid); }
    for (int i0 = 0; i0 < count; i0 += CONV_DEPTH) {
#pragma unroll
        for (int d = 0; d < CONV_DEPTH; ++d) {
            const int i = i0 + d;
            const ConvItem c = item(first + i);
            lds_barrier();
            conv_tile_write(ring[d], T, tid);
            lds_barrier();
            if (i + CONV_DEPTH < count) { const ConvItem cn = item(first + i + CONV_DEPTH); conv_load(cn, ring[d], tid); }
            conv_tile_store(c, T, tid);
        }
    }
}
__device__ __forceinline__ void ph_convert_small(const P& p, float* lds) {
    __syncthreads();
    if (blockIdx.x >= 96 && blockIdx.x < 96 + 80) conv_run([&](int it) { return conv_small_item(p, it); }, (blockIdx.x - 96) * 4, 4, lds);
}

__device__ __forceinline__ void ph_norm1(const P& p) {
    const int tid = opaque_tid(), lane = tid & 63, wv = tid >> 6, G = gridDim.x;
    const float* ADA = (const float*)(p.ws + WS_ADA);
    bf16_t* H = (bf16_t*)(p.ws + WS_H);
    bf16_t* HC = (bf16_t*)(p.ws + WS_HC);
    const int gw = blockIdx.x * 8 + wv, NGW = G * 8;
    auto rowsrc = [&](int r) { return r < NTOK ? p.x + (size_t)r * D : p.ctx + (size_t)(r - NTOK) * D; };
    f32x4_t v[4], vn[4];
    if (gw < NTOK + NCTX) {
#pragma unroll
        for (int j = 0; j < 4; ++j) v[j] = ((const f32x4_t*)rowsrc(gw))[lane + 64 * j];
    }
    for (int r = gw; r < NTOK + NCTX; r += NGW) {
        const bool more = r + NGW < NTOK + NCTX;
        if (more) {
#pragma unroll
            for (int j = 0; j < 4; ++j) vn[j] = ((const f32x4_t*)rowsrc(r + NGW))[lane + 64 * j];
        }
        bf16_t* dst = r < NTOK ? H + (size_t)r * D : HC + (size_t)(r - NTOK) * D;
        const int ar = r < NTOK ? r / SEQ : 16;
        float ss = 0.f;
#pragma unroll
        for (int j = 0; j < 4; ++j) ss += v[j].x * v[j].x + v[j].y * v[j].y + v[j].z * v[j].z + v[j].w * v[j].w;
        ss = wave_sum(ss);
        const float rstd = rsqrtf(ss * (1.f / D) + EPS);
        const float* sh = ADA + ar * 6144, *sc = sh + 1024;
#pragma unroll
        for (int j = 0; j < 4; ++j) {
            const int d4 = lane + 64 * j;
            const float4 g = ((const float4*)p.norm1_g)[d4], s1 = ((const float4*)sc)[d4], h1 = ((const float4*)sh)[d4];
            float4 o;
            o.x = v[j].x * rstd * g.x * (1.f + s1.x) + h1.x; o.y = v[j].y * rstd * g.y * (1.f + s1.y) + h1.y;
            o.z = v[j].z * rstd * g.z * (1.f + s1.z) + h1.z; o.w = v[j].w * rstd * g.w * (1.f + s1.w) + h1.w;
            ((uint2*)dst)[d4] = make_uint2(cvtpk(o.x, o.y), cvtpk(o.z, o.w));
        }
#pragma unroll
        for (int j = 0; j < 4; ++j) v[j] = vn[j];
    }
}
__device__ __forceinline__ void ph_filter(const P& p, float* lds) {
    const int tid = opaque_tid(), G = gridDim.x;
    const float* HID2 = (const float*)(p.ws + WS_HID2);
    float* HF = (float*)((unsigned char*)p.out + DO_HF);
    float* w3c = lds;
    float* red = lds + 512;
    const float min_decay = logf(1e-2f) / 1.5f, max_decay = logf(1e-2f) / 0.3f;
    for (int grp = blockIdx.x; grp < 256; grp += G) {
        const int item0 = grp * 4, o = item0 >> 9, c0 = item0 & 511;
        __syncthreads();
        { const int q = tid >> 7, dir = (tid >> 6) & 1, i = tid & 63; w3c[tid] = p.pos_w3[i * 2048 + o * 1024 + dir * 512 + c0 + q]; }
        __syncthreads();
        float hv[4][4][2]; float asum[4] = {0.f, 0.f, 0.f, 0.f};
#pragma unroll
        for (int j = 0; j < 4; ++j) {
            const int t = tid + NT * j;
            float r[4][2];
#pragma unroll
            for (int q = 0; q < 4; ++q) { r[q][0] = 0.f; r[q][1] = 0.f; }
            const float4* hp = (const float4*)(HID2 + t * 64);
#pragma unroll 4
            for (int i4 = 0; i4 < 16; ++i4) {
                const float4 h = hp[i4];
#pragma unroll
                for (int q = 0; q < 4; ++q)
#pragma unroll
                    for (int d = 0; d < 2; ++d) { const float* w = w3c + (q * 2 + d) * 64 + i4 * 4; r[q][d] += h.x * w[0] + h.y * w[1] + h.z * w[2] + h.w * w[3]; }
            }
            const float tl = (float)t / 2047.0f;
#pragma unroll
            for (int q = 0; q < 4; ++q) {
                const float delta = fabsf(min_decay + (float)(c0 + q) * ((max_decay - min_decay) / 511.0f));
                const float win = expf(-tl * delta) + 0.05f;
                hv[j][q][0] = r[q][0] * win; hv[j][q][1] = r[q][1] * win;
                asum[q] += fabsf(hv[j][q][0]) + (t >= 1 ? fabsf(hv[j][q][1]) : 0.f);
            }
        }
#pragma unroll
        for (int q = 0; q < 4; ++q) asum[q] = wave_sum(asum[q]);
        if ((tid & 63) == 0) { red[(tid >> 6) * 4 + 0] = asum[0]; red[(tid >> 6) * 4 + 1] = asum[1]; red[(tid >> 6) * 4 + 2] = asum[2]; red[(tid >> 6) * 4 + 3] = asum[3]; }
        __syncthreads();
#pragma unroll
        for (int q = 0; q < 4; ++q) {
            float tot = 0.f;
#pragma unroll
            for (int k = 0; k < 8; ++k) tot += red[k * 4 + q];
            const float inv = 1.f / (tot + EPS);
            float* dst = HF + (size_t)(item0 + q) * 4096;
#pragma unroll
            for (int j = 0; j < 4; ++j) {
                const int t = tid + NT * j;
                dst[2047 + t] = hv[j][q][0] * inv;
                if (t >= 1) dst[2047 - t] = hv[j][q][1] * inv;
            }
            if (tid == 0) dst[4095] = 0.f;
        }
    }
}

struct InprojSched {
    int G, c; const bf16_t *WinT, *H, *HC; bf16_t *PHYT, *PHG, *PC;
    __device__ __forceinline__ bool next(int i, Unit& u) const {
        int L = i * G + c; int pm, pn;
        u.aux = nullptr; u.gidx = nullptr; u.row0 = 0; u.col0 = 0;
        if (L < 768) { tile_of(L, 6, 128, pm, pn); u.a = (const char*)(WinT + (size_t)pm * 256 * D); u.b = (const char*)(H + (size_t)pn * 256 * D); u.c = PHYT + (size_t)pm * 256 * NTOK + pn * 256; u.ldc = NTOK; return true; }
        L -= 768;
        if (L < 1280) { tile_of(L, 128, 10, pm, pn); u.a = (const char*)(H + (size_t)pm * 256 * D); u.b = (const char*)(WinT + (size_t)(1536 + pn * 256) * D); u.c = PHG + (size_t)pm * 256 * 2560 + pn * 256; u.ldc = 2560; return true; }
        L -= 1280;
        if (L < 96) { tile_of(L, 16, 6, pm, pn); u.a = (const char*)(HC + (size_t)pm * 256 * D); u.b = (const char*)(WinT + (size_t)(2048 + pn * 256) * D); u.c = PC + (size_t)pm * 256 * 1536 + pn * 256; u.ldc = 1536; return true; }
        return false;
    }
    __device__ __forceinline__ void a_ready(const Unit&) const {}
    __device__ __forceinline__ void done(const Unit&) const {}
};
__device__ __forceinline__ void ph_inproj(const P& p, unsigned char* lds) {
    InprojSched S{(int)gridDim.x, (int)blockIdx.x, (const bf16_t*)((unsigned char*)p.out + DO_WINT), (const bf16_t*)(p.ws + WS_H), (const bf16_t*)(p.ws + WS_HC),
                  (bf16_t*)((unsigned char*)p.out + DO_PHYT), (bf16_t*)(p.ws + WS_PHG), (bf16_t*)(p.ws + WS_PC)};
    pg8::EpiStoreBf16 E;
    pg8::gemm_phase<pg8::EpiStoreBf16, InprojSched, true, true, false>((PG8_LAS unsigned char*)lds, D, S, E);
}

namespace hy {
#define HY_LAS __attribute__((address_space(3)))
typedef short bf16x8 __attribute__((ext_vector_type(8)));
typedef float f32x4 __attribute__((ext_vector_type(4)));
typedef unsigned u32x4 __attribute__((ext_vector_type(4)));
typedef unsigned u32x2 __attribute__((ext_vector_type(2)));
constexpr int U_STRIDE = 4112, UIMG = 0, U_BYTES = 16 * U_STRIDE;
constexpr int FILT = U_BYTES, F_STRIDE = 8288, F_BYTES = 8 * F_STRIDE;
constexpr int SCR = FILT + F_BYTES;
static_assert(SCR + 8192 <= LDS_BYTES, "hyena LDS map");

__device__ __forceinline__ float uni(float v) { return __uint_as_float(__builtin_amdgcn_readfirstlane(__float_as_uint(v))); }
struct ConvW { float w0, w1, w2, b; };
__device__ __forceinline__ ConvW load_convw(const P& p, int ch) { ConvW c; c.w0 = uni(p.hy_conv_w[ch]); c.w1 = uni(p.hy_conv_w[1536 + ch]); c.w2 = uni(p.hy_conv_w[3072 + ch]); c.b = uni(p.hy_conv_b[ch]); return c; }
__device__ __forceinline__ void load_u_image(const ConvW cw, HY_LAS unsigned char* L, const bf16_t* row, int tid) {
    const float cw0 = cw.w0, cw1 = cw.w1, cw2 = cw.w2, cb = cw.b;
#pragma unroll 2
    for (int k = 0; k < 8; ++k) {
        const int idx = tid + NT * k, b = idx >> 8, t8 = (idx & 255) * 8;
        const bf16_t* src = row + b * SEQ + t8;
        const u32x4 raw = *(const u32x4*)src;
        float x[10];
        x[0] = (t8 & 63) ? bf2f(src[-1]) : 0.f;
        x[9] = ((t8 + 8) & 63) ? bf2f(src[8]) : 0.f;
        x[1] = __uint_as_float(raw.x << 16); x[2] = __uint_as_float(raw.x & 0xffff0000u); x[3] = __uint_as_float(raw.y << 16); x[4] = __uint_as_float(raw.y & 0xffff0000u);
        x[5] = __uint_as_float(raw.z << 16); x[6] = __uint_as_float(raw.z & 0xffff0000u); x[7] = __uint_as_float(raw.w << 16); x[8] = __uint_as_float(raw.w & 0xffff0000u);
        float o[8];
#pragma unroll
        for (int e = 0; e < 8; ++e) o[e] = cb + cw1 * x[e + 1] + cw0 * x[e] + cw2 * x[e + 2];
        *(HY_LAS u32x4*)(L + UIMG + b * U_STRIDE + t8 * 2) = (u32x4){pk2(o[0], o[1]), pk2(o[2], o[3]), pk2(o[4], o[5]), pk2(o[6], o[7])};
    }
}
__device__ __forceinline__ void stage_raw_rows(HY_LAS unsigned char* L, const bf16_t* row, int tid) {
#pragma unroll 2
    for (int k = 0; k < 8; ++k) {
        const int idx = tid + NT * k, b = idx >> 8, t8 = (idx & 255) * 8;
        const u32x4 raw = *(const u32x4*)(row + b * SEQ + t8);
        HY_LAS unsigned char* d = L + FILT + b * U_STRIDE + 8 + t8 * 2;
        *(HY_LAS u32x2*)d = (u32x2){raw.x, raw.y}; *(HY_LAS u32x2*)(d + 8) = (u32x2){raw.z, raw.w};
    }
}
__device__ __forceinline__ void load_filter_scr(HY_LAS unsigned char* L, const float* hf, int tid) {
    const float4 a = ((const float4*)hf)[tid * 2], b = ((const float4*)hf)[tid * 2 + 1];
    *(HY_LAS u32x4*)(L + SCR + tid * 16) = (u32x4){pk2(a.x, a.y), pk2(a.z, a.w), pk2(b.x, b.y), pk2(b.z, b.w)};
}
__device__ __forceinline__ void build_filter_copies(HY_LAS unsigned char* L, int tid) {
    const HY_LAS bf16_t* sc = (const HY_LAS bf16_t*)(L + SCR);
    for (int gi = tid; gi < 8 * 518; gi += NT) {
        const int d = gi / 518, qg = gi - d * 518;
        const int top = 4095 + d - 8 * qg;
        unsigned v[8];
#pragma unroll
        for (int e = 0; e < 8; ++e) { const int ix = top - e; v[e] = (ix >= 0 && ix <= 4094) ? (unsigned)sc[ix] : 0u; }
        *(HY_LAS u32x4*)(L + FILT + d * F_STRIDE + qg * 16) = (u32x4){v[0] | (v[1] << 16), v[2] | (v[3] << 16), v[4] | (v[5] << 16), v[6] | (v[7] << 16)};
    }
}
__device__ __forceinline__ void conv_loop(HY_LAS unsigned char* L, f32x4 (&acc)[16], int w, int lane) {
    const int i = lane & 15, g = lane >> 4;
    const HY_LAS unsigned char* aBase = L + FILT + (i & 7) * F_STRIDE + 2 * (2048 + 8 * g - (i & ~7)) - 32 * (16 * w);
    const HY_LAS unsigned char* bBase = L + UIMG + i * U_STRIDE + 16 * g;
    bf16x8 ring[16];
#pragma unroll
    for (int s = 0; s < 16; ++s) ring[s] = *(const HY_LAS bf16x8*)(aBase - 32 * s);
#pragma unroll
    for (int m = 0; m < 16; ++m) acc[m] = (f32x4){0.f, 0.f, 0.f, 0.f};
    bf16x8 bfrag = *(const HY_LAS bf16x8*)(bBase);
    for (int k8 = 0; k8 < 8; ++k8) {
        const HY_LAS unsigned char* aK = aBase + 512 * k8;
        const HY_LAS unsigned char* bK = bBase + 512 * k8;
#pragma unroll
        for (int u = 0; u < 8; ++u) {
            bf16x8 bnext = bfrag;
            if (u < 7 || k8 < 7) bnext = *(const HY_LAS bf16x8*)(bK + 64 * (u + 1));
            acc[14] = __builtin_amdgcn_mfma_f32_16x16x32_bf16(ring[(14 - 2 * u) & 15], bfrag, acc[14], 0, 0, 0);
            acc[15] = __builtin_amdgcn_mfma_f32_16x16x32_bf16(ring[(15 - 2 * u) & 15], bfrag, acc[15], 0, 0, 0);
            if (u < 7 || k8 < 7) {
                ring[(14 - 2 * u) & 15] = *(const HY_LAS bf16x8*)(aK + 64 * u + 64);
                ring[(15 - 2 * u) & 15] = *(const HY_LAS bf16x8*)(aK + 64 * u + 32);
            }
#pragma unroll
            for (int m = 0; m < 14; ++m) acc[m] = __builtin_amdgcn_mfma_f32_16x16x32_bf16(ring[(m - 2 * u) & 15], bfrag, acc[m], 0, 0, 0);
            bfrag = bnext;
            __builtin_amdgcn_sched_barrier(0);
        }
    }
}
__device__ __forceinline__ void gate_acc(const ConvW cw, HY_LAS unsigned char* L, f32x4 (&acc)[16], float bias, int w, int lane) {
    const int j = lane & 15, g = lane >> 4;
    const float cw0 = cw.w0, cw1 = cw.w1, cw2 = cw.w2, cb = cw.b;
#pragma unroll
    for (int m = 0; m < 16; ++m) {
        const int t4 = 256 * w + 16 * m + 4 * g, tt0 = t4 & 63;
        const u32x2 uu = *(const HY_LAS u32x2*)(L + UIMG + j * U_STRIDE + t4 * 2);
        const HY_LAS unsigned char* xb = L + FILT + j * U_STRIDE + 8 + t4 * 2;
        const u32x2 xx = *(const HY_LAS u32x2*)xb;
        const float xl = tt0 > 0 ? bf2f(*(const HY_LAS bf16_t*)(xb - 2)) : 0.f;
        const float xr = tt0 < 60 ? bf2f(*(const HY_LAS bf16_t*)(xb + 8)) : 0.f;
        const float x0 = __uint_as_float(xx.x << 16), x1 = __uint_as_float(xx.x & 0xffff0000u), x2 = __uint_as_float(xx.y << 16), x3 = __uint_as_float(xx.y & 0xffff0000u);
        const float u0 = __uint_as_float(uu.x << 16), u1 = __uint_as_float(uu.x & 0xffff0000u), u2 = __uint_as_float(uu.y << 16), u3 = __uint_as_float(uu.y & 0xffff0000u);
        const float g0 = cb + cw1 * x0 + cw0 * xl + cw2 * x1, g1 = cb + cw1 * x1 + cw0 * x0 + cw2 * x2, g2 = cb + cw1 * x2 + cw0 * x1 + cw2 * x3, g3 = cb + cw1 * x3 + cw0 * x2 + cw2 * xr;
        acc[m][0] = g0 * (acc[m][0] + bias * u0); acc[m][1] = g1 * (acc[m][1] + bias * u1); acc[m][2] = g2 * (acc[m][2] + bias * u2); acc[m][3] = g3 * (acc[m][3] + bias * u3);
        if ((m & 3) == 3) __builtin_amdgcn_sched_barrier(0);
    }
}
__device__ __forceinline__ void store_acc_uimg(HY_LAS unsigned char* L, const f32x4 (&acc)[16], int w, int lane) {
    const int j = lane & 15, g = lane >> 4;
#pragma unroll
    for (int m = 0; m < 16; ++m) {
        const int t4 = 256 * w + 16 * m + 4 * g;
        *(HY_LAS u32x2*)(L + UIMG + j * U_STRIDE + t4 * 2) = (u32x2){pk2(acc[m][0], acc[m][1]), pk2(acc[m][2], acc[m][3])};
    }
}
}

__device__ __forceinline__ void ph_hyena_task(const P& p, unsigned char* ldsb, int c) {
    const int w = __builtin_amdgcn_readfirstlane(threadIdx.x >> 6);
    const bf16_t* PHYT = (const bf16_t*)((unsigned char*)p.out + DO_PHYT);
    bf16_t* YT = (bf16_t*)(p.ws + WS_YT);
    const float* HF = (const float*)((unsigned char*)p.out + DO_HF);
    HY_LAS unsigned char* L = (HY_LAS unsigned char*)ldsb;
    {
        const int tid = opaque_tid();
        const int lane = tid & 63;
        hy::f32x4 acc[16];
        const hy::ConvW cwv = hy::load_convw(p, c), cwx1 = hy::load_convw(p, 512 + c), cwx2 = hy::load_convw(p, 1024 + c);
        const float bias0 = hy::uni(p.hy_bias[c]), bias1 = hy::uni(p.hy_bias[512 + c]);
        __syncthreads();
        hy::load_u_image(cwv, L, PHYT + (size_t)c * NTOK, tid);
        hy::load_filter_scr(L, HF + (size_t)c * 4096, tid);
        __syncthreads();
        hy::build_filter_copies(L, tid);
        __syncthreads();
        hy::conv_loop(L, acc, w, lane);
        __syncthreads();
        hy::stage_raw_rows(L, PHYT + (size_t)(512 + c) * NTOK, tid);
        hy::load_filter_scr(L, HF + (size_t)(512 + c) * 4096, tid);
        __syncthreads();
        hy::gate_acc(cwx1, L, acc, bias0, w, lane);
        __syncthreads();
        hy::store_acc_uimg(L, acc, w, lane);
        hy::build_filter_copies(L, tid);
        __syncthreads();
        hy::conv_loop(L, acc, w, lane);
        __syncthreads();
        hy::stage_raw_rows(L, PHYT + (size_t)(1024 + c) * NTOK, tid);
        __syncthreads();
        hy::gate_acc(cwx2, L, acc, bias1, w, lane);
        hy::store_acc_uimg(L, acc, w, lane);
        __syncthreads();
#pragma unroll 2
        for (int k = 0; k < 8; ++k) {
            const int idx = tid + NT * k, b = idx >> 8, t8 = (idx & 255) * 8;
            *(hy::u32x4*)(YT + (size_t)c * NTOK + b * SEQ + t8) = *(const HY_LAS hy::u32x4*)(L + hy::UIMG + b * hy::U_STRIDE + t8 * 2);
        }
    }
}


namespace hg {
#define HG_LAS __attribute__((address_space(3)))
typedef short bf16x8 __attribute__((ext_vector_type(8)));
typedef float f32x4 __attribute__((ext_vector_type(4)));
typedef unsigned u32x4 __attribute__((ext_vector_type(4)));
typedef unsigned u32x2 __attribute__((ext_vector_type(2)));
constexpr int QROW = 272, KROW = 40;
constexpr int O_QT = 0, O_KBAR = 16 * QROW, O_KHAT = 2 * 16 * QROW, O_VT = O_KHAT + 128 * KROW, O_BDEC = O_VT + 128 * KROW, SET_BYTES = O_BDEC + 512;
constexpr int NCH_CTX = CTXL / 16, NCH = NCH_CTX + SEQ / 16;
template <int CTRL> __device__ __forceinline__ float dpp_mul(float x) {
    return x * __uint_as_float(__builtin_amdgcn_update_dpp(0x3f800000u, __float_as_uint(x), CTRL, 0xf, 0xf, false));
}
struct Raw { unsigned short q[4], v[4], z[4]; };
}

__device__ __forceinline__ void ph_hgrn_task(const P& p, unsigned char* ldsb, int item) {
    using namespace hg;
    const int tid = opaque_tid();
    const int lane = tid & 63, w = __builtin_amdgcn_readfirstlane(tid >> 6), j = lane & 15, g = lane >> 4;
    const int dir = item & 1, h = (item >> 1) & 3, b = item >> 3;
    const float* LB = (const float*)(p.ws + WS_LB);
    const bf16_t* PC = (const bf16_t*)(p.ws + WS_PC);
    const bf16_t* PHG = (const bf16_t*)(p.ws + WS_PHG);
    bf16_t* OFB = (bf16_t*)(p.ws + WS_OFB) + (size_t)dir * NTOK * 512;
    HG_LAS unsigned char* L = (HG_LAS unsigned char*)ldsb;
    float lb0[2], lb1[2];
#pragma unroll
    for (int pp = 0; pp < 2; ++pp) { const float2 t = *(const float2*)(LB + dir * 512 + h * 128 + 16 * w + 8 * pp + 2 * g); lb0[pp] = t.x; lb1[pp] = t.y; }
    const int zoff_c = dir == 0 ? 512 : 1024, zoff_l = dir == 0 ? 1024 : 1536;
    const bf16_t* rowc = PC + (size_t)b * CTXL * 1536 + h * 128 + 16 * w + 2 * g;
    const bf16_t* rowl = PHG + (size_t)b * SEQ * 2560 + h * 128 + 16 * w + 2 * g;
    struct Raw2 { unsigned q[2], v[2], z[2]; };
    auto load_raw = [&](int n, Raw2& r) {
        if (n < NCH_CTX) {
            const int tt = 16 * n + j, t = dir == 0 ? tt : (CTXL - 1 - tt);
            const bf16_t* row = rowc + (size_t)t * 1536;
#pragma unroll
            for (int pp = 0; pp < 2; ++pp) { r.q[pp] = 0u; r.v[pp] = *(const unsigned*)(row + 8 * pp); r.z[pp] = *(const unsigned*)(row + zoff_c + 8 * pp); }
        } else {
            const int tt = 16 * (n - NCH_CTX) + j, t = dir == 0 ? tt : (SEQ - 1 - tt);
            const bf16_t* row = rowl + (size_t)t * 2560;
#pragma unroll
            for (int pp = 0; pp < 2; ++pp) { r.q[pp] = *(const unsigned*)(row + 8 * pp); r.v[pp] = *(const unsigned*)(row + 512 + 8 * pp); r.z[pp] = *(const unsigned*)(row + zoff_l + 8 * pp); }
        }
    };
    const int qoff = j * QROW + 2 * (16 * w + 2 * g), koff = (16 * w + 2 * g) * KROW + 2 * j;
    auto prep_pass = [&](const Raw2& r, HG_LAS unsigned char* S0, const int pp) {
        {
            const float za = __uint_as_float(r.z[pp] << 16), zb = __uint_as_float(r.z[pp] & 0xffff0000u);
            const float qa = __uint_as_float(r.q[pp] << 16), qb = __uint_as_float(r.q[pp] & 0xffff0000u);
            const float fa = lb0[pp] + (1.0f - lb0[pp]) * __builtin_amdgcn_rcpf(1.0f + __builtin_amdgcn_exp2f(-1.4426950408889634f * za));
            const float fb = lb1[pp] + (1.0f - lb1[pp]) * __builtin_amdgcn_rcpf(1.0f + __builtin_amdgcn_exp2f(-1.4426950408889634f * zb));
            float Pa = dpp_mul<0x111>(fa), Pb = dpp_mul<0x111>(fb);
            Pa = dpp_mul<0x112>(Pa); Pb = dpp_mul<0x112>(Pb); Pa = dpp_mul<0x114>(Pa); Pb = dpp_mul<0x114>(Pb); Pa = dpp_mul<0x118>(Pa); Pb = dpp_mul<0x118>(Pb);
            const float Ca = __uint_as_float(__builtin_amdgcn_ds_bpermute(4 * (lane | 15), __float_as_uint(Pa)));
            const float Cb = __uint_as_float(__builtin_amdgcn_ds_bpermute(4 * (lane | 15), __float_as_uint(Pb)));
            const float ia = __builtin_amdgcn_rcpf(fmaxf(Pa, 1e-30f)), ib = __builtin_amdgcn_rcpf(fmaxf(Pb, 1e-30f));
            const float ka = (1.0f - fa) * ia, kb = (1.0f - fb) * ib;
            const float qva = qa * __builtin_amdgcn_rcpf(1.0f + __builtin_amdgcn_exp2f(-1.4426950408889634f * qa)) * (0.08838834764831845f * Pa);
            const float qvb = qb * __builtin_amdgcn_rcpf(1.0f + __builtin_amdgcn_exp2f(-1.4426950408889634f * qb)) * (0.08838834764831845f * Pb);
            *(HG_LAS unsigned*)(S0 + O_QT + qoff + 16 * pp) = cvtpk(qva, qvb);
            *(HG_LAS unsigned*)(S0 + O_KBAR + qoff + 16 * pp) = cvtpk(ka, kb);
            const unsigned kh = cvtpk(ka * Ca, kb * Cb);
            *(HG_LAS bf16_t*)(S0 + O_KHAT + koff + 8 * pp * KROW) = (bf16_t)(kh & 0xffffu);
            *(HG_LAS bf16_t*)(S0 + O_KHAT + koff + (8 * pp + 1) * KROW) = (bf16_t)(kh >> 16);
            *(HG_LAS bf16_t*)(S0 + O_VT + koff + 8 * pp * KROW) = (bf16_t)(r.v[pp] & 0xffffu);
            *(HG_LAS bf16_t*)(S0 + O_VT + koff + (8 * pp + 1) * KROW) = (bf16_t)(r.v[pp] >> 16);
            if (j == 15) { typedef float f32x2_t __attribute__((ext_vector_type(2))); *(HG_LAS f32x2_t*)(S0 + O_BDEC + 4 * (16 * w + 8 * pp + 2 * g)) = (f32x2_t){Pa, Pb}; }
        }
    };
    auto prep = [&](const Raw2& r, HG_LAS unsigned char* S0) { prep_pass(r, S0, 0); prep_pass(r, S0, 1); };
    const float mk0 = (4 * g + 0) <= j ? 1.f : 0.f, mk1 = (4 * g + 1) <= j ? 1.f : 0.f, mk2 = (4 * g + 2) <= j ? 1.f : 0.f, mk3 = (4 * g + 3) <= j ? 1.f : 0.f;
    const int sc_off = j * QROW + 16 * g, vt_off = (16 * w + j) * KROW + 8 * g, qt8_off = j * QROW + 8 * g, kh_off = j * KROW + 8 * g;
    bf16_t* orow = OFB + (size_t)b * SEQ * 512 + h * 128 + 16 * w + 4 * g;
    f32x4 S[8];
#pragma unroll
    for (int t = 0; t < 8; ++t) S[t] = (f32x4){0.f, 0.f, 0.f, 0.f};
    constexpr int RDEPTH = 4;
    static_assert(NCH % RDEPTH == 0, "chunk loop is unrolled by the prefetch depth");
    Raw2 ring[RDEPTH];
    load_raw(0, ring[0]);
    __syncthreads();
    prep(ring[0], L);
#pragma unroll
    for (int c = 1; c <= RDEPTH; ++c) load_raw(c, ring[c % RDEPTH]);
    __syncthreads();
    auto chunk = [&](int n, int phase, Raw2& slot) {
        HG_LAS unsigned char* Sc = L + (n & 1) * SET_BYTES;
        HG_LAS unsigned char* Sn = L + ((n + 1) & 1) * SET_BYTES;
        bf16x8 kaf[4], qaf[4]; u32x2 qb0[4], qb1[4], krf[8]; f32x4 bdf[8];
#pragma unroll
        for (int kp = 0; kp < 4; ++kp) { kaf[kp] = *(const HG_LAS bf16x8*)(Sc + O_KBAR + sc_off + 64 * kp); qaf[kp] = *(const HG_LAS bf16x8*)(Sc + O_QT + sc_off + 64 * kp); }
        const u32x2 vraw = *(const HG_LAS u32x2*)(Sc + O_VT + vt_off);
#pragma unroll
        for (int pq = 0; pq < 4; ++pq) { qb0[pq] = *(const HG_LAS u32x2*)(Sc + O_QT + qt8_off + 64 * pq); qb1[pq] = *(const HG_LAS u32x2*)(Sc + O_QT + qt8_off + 64 * pq + 32); }
#pragma unroll
        for (int t = 0; t < 8; ++t) { bdf[t] = *(const HG_LAS f32x4*)(Sc + O_BDEC + 64 * t + 16 * g); krf[t] = *(const HG_LAS u32x2*)(Sc + O_KHAT + kh_off + 16 * KROW * t); }
        __builtin_amdgcn_sched_barrier(0);
        if (n + 1 < NCH) prep_pass(slot, Sn, 0);
        __builtin_amdgcn_sched_barrier(0);
        const u32x4 vf = (u32x4){vraw.x, vraw.y, 0u, 0u};
        f32x4 sc = (f32x4){0.f, 0.f, 0.f, 0.f};
#pragma unroll
        for (int kp = 0; kp < 4; ++kp) sc = __builtin_amdgcn_mfma_f32_16x16x32_bf16(kaf[kp], qaf[kp], sc, 0, 0, 0);
        f32x4 oT = (f32x4){0.f, 0.f, 0.f, 0.f};
#pragma unroll
        for (int pq = 0; pq < 4; ++pq) {
            u32x4 a; a.x = cvtpk(S[2 * pq][0], S[2 * pq][1]); a.y = cvtpk(S[2 * pq][2], S[2 * pq][3]); a.z = cvtpk(S[2 * pq + 1][0], S[2 * pq + 1][1]); a.w = cvtpk(S[2 * pq + 1][2], S[2 * pq + 1][3]);
            const u32x4 bb = (u32x4){qb0[pq].x, qb0[pq].y, qb1[pq].x, qb1[pq].y};
            oT = __builtin_amdgcn_mfma_f32_16x16x32_bf16(__builtin_bit_cast(bf16x8, a), __builtin_bit_cast(bf16x8, bb), oT, 0, 0, 0);
        }
#pragma unroll
        for (int t = 0; t < 8; ++t) {
            const u32x4 ka = (u32x4){krf[t].x, krf[t].y, 0u, 0u};
            S[t] = __builtin_amdgcn_mfma_f32_16x16x32_bf16(__builtin_bit_cast(bf16x8, ka), __builtin_bit_cast(bf16x8, vf), S[t] * bdf[t], 0, 0, 0);
        }
        __builtin_amdgcn_sched_barrier(0);
        if (n + 1 < NCH) prep_pass(slot, Sn, 1);
        if (n + 1 + RDEPTH < NCH) load_raw(n + 1 + RDEPTH, slot);
        __builtin_amdgcn_sched_barrier(0);
        u32x4 pf;
        pf.x = cvtpk(sc[0] * mk0, sc[1] * mk1); pf.y = cvtpk(sc[2] * mk2, sc[3] * mk3); pf.z = 0u; pf.w = 0u;
        oT = __builtin_amdgcn_mfma_f32_16x16x32_bf16(__builtin_bit_cast(bf16x8, vf), __builtin_bit_cast(bf16x8, pf), oT, 0, 0, 0);
        if (n >= NCH_CTX) {
            const int tt = 16 * (n - NCH_CTX) + j, t = dir == 0 ? tt : (SEQ - 1 - tt);
            *(u32x2*)(orow + (size_t)t * 512) = (u32x2){cvtpk(oT[0], oT[1]), cvtpk(oT[2], oT[3])};
        }
        lds_barrier();
    };
    for (int n0 = 0; n0 < NCH; n0 += RDEPTH) {
#pragma unroll
        for (int u = 0; u < RDEPTH; ++u) chunk(n0 + u, u % 3, ring[(u + 1) % RDEPTH]);
    }
}

template <int QW = 0, bool DO_HGRN = true, bool DO_QUEUE = true, bool DO_HY = true, bool DO_CV = true>
__device__ __forceinline__ void ph_mixers(const P& p, unsigned char* ldsb) {
    unsigned* qhead = (unsigned*)(p.ws + WS_CTL) + CW_QHEAD + QW;
    HG_LAS unsigned* bc = (HG_LAS unsigned*)(ldsb + LDS_BYTES - 16);
    if (DO_HGRN && blockIdx.x < NB * HEADS * 2) ph_hgrn_task(p, ldsb, blockIdx.x);
    constexpr int N_CONV_WG = 48, ITEMS_PER_WG = N_EXPERT_ITEMS / N_CONV_WG;
    static_assert(N_EXPERT_ITEMS % N_CONV_WG == 0 && ITEMS_PER_WG % CONV_DEPTH == 0, "conversion split");
    if (DO_CV && blockIdx.x >= NB * HEADS * 2 && blockIdx.x < NB * HEADS * 2 + N_CONV_WG)
        conv_run([&](int r) { return conv_expert_item(p, r); }, (blockIdx.x - NB * HEADS * 2) * ITEMS_PER_WG, ITEMS_PER_WG, (float*)ldsb);
    if (!DO_QUEUE) return;
    for (;;) {
        __syncthreads();
        if (threadIdx.x == 0) *bc = atomicAdd(qhead, 1u);
        __syncthreads();
        const int c = (int)*bc;
        if (c >= 512) break;
        if (DO_HY) ph_hyena_task(p, ldsb, c);
    }
}

__device__ __forceinline__ void ph_mixprep(const P& p, float* lds) {
    const int tid = opaque_tid(), lane = tid & 63, wv = tid >> 6;
    const bf16_t* YT = (const bf16_t*)(p.ws + WS_YT);
    bf16_t* MIXA = (bf16_t*)(p.ws + WS_MIXA);
    bf16_t* yl = (bf16_t*)lds;
    float* part = lds + (512 * 72 * 2) / 4;
    for (int tile = blockIdx.x; tile < NTOK / 64; tile += gridDim.x) {
        const int tok0 = tile * 64;
        __syncthreads();
        for (int i = tid; i < 512 * 8; i += NT) { const int row = i >> 3, ch = i & 7; *(uint4*)(yl + row * 72 + ch * 8) = *(const uint4*)(YT + (size_t)row * NTOK + tok0 + ch * 8); }
        __syncthreads();
        const int tok = tid & 63, pt = tid >> 6;
        float ss = 0.f;
        for (int c = pt * 64; c < pt * 64 + 64; ++c) { const float v = bf2f(yl[c * 72 + tok]); ss += v * v; }
        part[pt * 64 + tok] = ss;
        __syncthreads();
        float tot = 0.f;
#pragma unroll
        for (int k = 0; k < 8; ++k) tot += part[k * 64 + tok];
        const float rstd = rsqrtf(tot * (1.f / 512.f) + EPS);
        bf16_t* dst = MIXA + (size_t)(tok0 + tok) * D + pt * 64;
#pragma unroll
        for (int j = 0; j < 8; ++j) {
            float o[8];
#pragma unroll
            for (int q = 0; q < 8; ++q) { const int c = pt * 64 + j * 8 + q; o[q] = bf2f(yl[c * 72 + tok]) * rstd * p.hy_norm_g[c]; }
            *(uint4*)(dst + j * 8) = make_uint4(pk2(o[0], o[1]), pk2(o[2], o[3]), pk2(o[4], o[5]), pk2(o[6], o[7]));
        }
    }
    const bf16_t* OFB = (const bf16_t*)(p.ws + WS_OFB);
    const bf16_t* PHG = (const bf16_t*)(p.ws + WS_PHG);
    for (int r = blockIdx.x * 8 + wv; r < NTOK; r += gridDim.x * 8) {
#pragma unroll
        for (int h = 0; h < HEADS; ++h) {
            const int k = lane * 2;
            const unsigned a = *(const unsigned*)(OFB + (size_t)r * 512 + h * 128 + k);
            const unsigned bq = *(const unsigned*)(OFB + (size_t)NTOK * 512 + (size_t)r * 512 + h * 128 + k);
            const float o0 = __uint_as_float(a << 16) + __uint_as_float(bq << 16), o1 = __uint_as_float(a & 0xffff0000u) + __uint_as_float(bq & 0xffff0000u);
            const float ss = wave_sum(o0 * o0 + o1 * o1);
            const float rstd = rsqrtf(ss * (1.f / 128.f) + EPS);
            const unsigned g = *(const unsigned*)(PHG + (size_t)r * 2560 + 2048 + h * 128 + k);
            const float2 ng = *(const float2*)(p.hg_norm_g + k);
            *(unsigned*)(MIXA + (size_t)r * D + 512 + h * 128 + k) = pk2(o0 * rstd * ng.x * siluf_(__uint_as_float(g << 16)), o1 * rstd * ng.y * siluf_(__uint_as_float(g & 0xffff0000u)));
        }
    }
}

struct OutprojSched {
    int G, c; const bf16_t *A, *Bt;
    __device__ __forceinline__ bool next(int i, Unit& u) const {
        const int L = i * G + c; if (L >= 512) return false; int pm, pn; tile_of(L, 128, 4, pm, pn);
        u.a = (const char*)(A + (size_t)pm * 256 * D); u.b = (const char*)(Bt + (size_t)pn * 256 * D); u.c = nullptr; u.aux = nullptr; u.gidx = nullptr; u.ldc = D; u.row0 = pm * 256; u.col0 = pn * 256; return true;
    }
    __device__ __forceinline__ void a_ready(const Unit&) const {}
    __device__ __forceinline__ void done(const Unit&) const {}
};
__device__ __forceinline__ void ph_outproj(const P& p, unsigned char* lds) {
    OutprojSched S{(int)gridDim.x, (int)blockIdx.x, (const bf16_t*)(p.ws + WS_MIXA), (const bf16_t*)(p.ws + WS_WOUTT)};
    pg8::EpiOutProj E{p.x, (const float*)(p.ws + WS_ADA), (bf16_t*)p.out};
    pg8::gemm_phase<pg8::EpiOutProj, OutprojSched, true, true, false>((PG8_LAS unsigned char*)lds, D, S, E);
}

__device__ __forceinline__ void ph_norm2_router(const P& p, float* lds) {
    const int tid = opaque_tid(), lane = tid & 63, wv = tid >> 6;
    const float* ADA = (const float*)(p.ws + WS_ADA);
    const bf16_t* X1 = (const bf16_t*)p.out;
    bf16_t* H2 = (bf16_t*)(p.ws + WS_H2);
    float* AFF = (float*)(p.ws + WS_AFF);
    __syncthreads();
    for (int i = tid; i < D * 4; i += NT) { const int d = i >> 2, e4 = i & 3; const float4 w = ((const float4*)p.router_w)[i];
        lds[(e4 * 4 + 0) * D + d] = w.x; lds[(e4 * 4 + 1) * D + d] = w.y; lds[(e4 * 4 + 2) * D + d] = w.z; lds[(e4 * 4 + 3) * D + d] = w.w; }
    __syncthreads();
    f32x4_t v[4], vn[4];
    const int rfirst = blockIdx.x * 8 + wv, rstep = gridDim.x * 8;
    if (rfirst < NTOK) {
#pragma unroll
        for (int j = 0; j < 4; ++j) { const uint2 w = ((const uint2*)(X1 + (size_t)rfirst * (2 * D)))[lane + 64 * j]; v[j] = (f32x4_t){__uint_as_float(w.x << 16), __uint_as_float(w.x & 0xffff0000u), __uint_as_float(w.y << 16), __uint_as_float(w.y & 0xffff0000u)}; }
    }
    for (int r = rfirst; r < NTOK; r += rstep) {
        const int b = r / SEQ, t = r % SEQ;
        if (r + rstep < NTOK) {
#pragma unroll
            for (int j = 0; j < 4; ++j) { const uint2 w = ((const uint2*)(X1 + (size_t)(r + rstep) * (2 * D)))[lane + 64 * j]; vn[j] = (f32x4_t){__uint_as_float(w.x << 16), __uint_as_float(w.x & 0xffff0000u), __uint_as_float(w.y << 16), __uint_as_float(w.y & 0xffff0000u)}; }
        }
        float ss = 0.f;
#pragma unroll
        for (int j = 0; j < 4; ++j) ss += v[j].x * v[j].x + v[j].y * v[j].y + v[j].z * v[j].z + v[j].w * v[j].w;
        const float rstd = rsqrtf(wave_sum(ss) * (1.f / D) + EPS);
        const float* sh = ADA + b * 6144 + 3072, *sc = ADA + b * 6144 + 4096;
        float lg[16];
#pragma unroll
        for (int e = 0; e < 16; ++e) lg[e] = 0.f;
#pragma unroll
        for (int j = 0; j < 4; ++j) {
            const int d4 = lane + 64 * j;
            const float4 g = ((const float4*)p.norm2_g)[d4], s1 = ((const float4*)sc)[d4], h1 = ((const float4*)sh)[d4];
            float4 o;
            o.x = v[j].x * rstd * g.x * (1.f + s1.x) + h1.x; o.y = v[j].y * rstd * g.y * (1.f + s1.y) + h1.y;
            o.z = v[j].z * rstd * g.z * (1.f + s1.z) + h1.z; o.w = v[j].w * rstd * g.w * (1.f + s1.w) + h1.w;
            ((uint2*)(H2 + (size_t)r * D))[d4] = make_uint2(cvtpk(o.x, o.y), cvtpk(o.z, o.w));
#pragma unroll
            for (int e = 0; e < 16; ++e) {
                const float4 w = *(const float4*)&lds[e * D + d4 * 4];
                lg[e] += o.x * w.x + o.y * w.y + o.z * w.z + o.w * w.w;
            }
            __builtin_amdgcn_sched_barrier(0);
        }
#pragma unroll
        for (int i = 0; i < 8; ++i) { const bool hi = lane & 1; const float keep = hi ? lg[2 * i + 1] : lg[2 * i], send = hi ? lg[2 * i] : lg[2 * i + 1]; lg[i] = keep + __shfl_xor(send, 1); }
#pragma unroll
        for (int i = 0; i < 4; ++i) { const bool hi = lane & 2; const float keep = hi ? lg[2 * i + 1] : lg[2 * i], send = hi ? lg[2 * i] : lg[2 * i + 1]; lg[i] = keep + __shfl_xor(send, 2); }
#pragma unroll
        for (int i = 0; i < 2; ++i) { const bool hi = lane & 4; const float keep = hi ? lg[2 * i + 1] : lg[2 * i], send = hi ? lg[2 * i] : lg[2 * i + 1]; lg[i] = keep + __shfl_xor(send, 4); }
        { const bool hi = lane & 8; const float keep = hi ? lg[1] : lg[0], send = hi ? lg[0] : lg[1]; lg[0] = keep + __shfl_xor(send, 8); }
        float lgt = lg[0];
        lgt += __shfl_xor(lgt, 16); lgt += __shfl_xor(lgt, 32);
        float mx = lgt;
        mx = fmaxf(mx, __shfl_xor(mx, 1)); mx = fmaxf(mx, __shfl_xor(mx, 2)); mx = fmaxf(mx, __shfl_xor(mx, 4)); mx = fmaxf(mx, __shfl_xor(mx, 8));
        const float ex = expf(lgt - mx);
        float den = ex;
        den += __shfl_xor(den, 1); den += __shfl_xor(den, 2); den += __shfl_xor(den, 4); den += __shfl_xor(den, 8);
        if (lane < 16) AFF[((size_t)b * 16 + lane) * SEQ + t] = ex / den;
#pragma unroll
        for (int j = 0; j < 4; ++j) v[j] = vn[j];
    }
}

__device__ __forceinline__ void ph_topk(const P& p, float* lds) {
    const int tid = opaque_tid(), lane = tid & 63, wv = tid >> 6;
    const float* AFF = (const float*)(p.ws + WS_AFF);
    int* IDX = (int*)(p.ws + WS_IDX);
    float* GATE = (float*)(p.ws + WS_GATE);
    int* INV = (int*)(p.ws + WS_INV);
    unsigned* hist = (unsigned*)lds;
    unsigned* ctl = hist + 256;
    unsigned* wtot = hist + 272;
    for (int item = blockIdx.x; item < NB * NE; item += gridDim.x) {
        const int b = item >> 4, e = item & 15;
        const uint4 kk = ((const uint4*)(AFF + (size_t)item * SEQ))[tid];
        const unsigned key[4] = {kk.x, kk.y, kk.z, kk.w};
        unsigned prefix = 0u, need = CAP;
#pragma unroll
        for (int pass = 3; pass >= 0; --pass) {
            __syncthreads();
            if (tid < 256) hist[tid] = 0u;
            __syncthreads();
#pragma unroll
            for (int q = 0; q < 4; ++q) {
                const bool in = (pass == 3) || ((key[q] >> (8 * (pass + 1))) == prefix);
                if (in) atomicAdd(&hist[(key[q] >> (8 * pass)) & 255u], 1u);
            }
            __syncthreads();
            if (wv == 0) {
                const uint4 h4 = ((const uint4*)hist)[lane];
                const unsigned loc = h4.x + h4.y + h4.z + h4.w;
                unsigned suf = loc;
#pragma unroll
                for (int o = 1; o < 64; o <<= 1) { const unsigned y = __shfl_down(suf, o); if (lane + o < 64) suf += y; }
                const unsigned above = suf - loc;
                unsigned c3 = above + h4.w, c2 = c3 + h4.z, c1 = c2 + h4.y, c0 = c1 + h4.x;
                int bin = -1; unsigned nneed = 0u;
                if (above < need && c0 >= need) {
                    if (c3 >= need) { bin = 4 * lane + 3; nneed = need - above; }
                    else if (c2 >= need) { bin = 4 * lane + 2; nneed = need - c3; }
                    else if (c1 >= need) { bin = 4 * lane + 1; nneed = need - c2; }
                    else { bin = 4 * lane; nneed = need - c1; }
                    ctl[0] = (prefix << 8) | (unsigned)bin; ctl[1] = nneed;
                }
            }
            __syncthreads();
            prefix = ctl[0]; need = ctl[1];
        }
        unsigned cgt = 0u, ceq = 0u;
#pragma unroll
        for (int q = 0; q < 4; ++q) { cgt += key[q] > prefix ? 1u : 0u; ceq += key[q] == prefix ? 1u : 0u; }
        unsigned sgt = cgt, seq = ceq;
#pragma unroll
        for (int o = 1; o < 64; o <<= 1) { const unsigned y1 = __shfl_up(sgt, o), y2 = __shfl_up(seq, o); if (lane >= o) { sgt += y1; seq += y2; } }
        if (lane == 63) { wtot[wv] = sgt; wtot[8 + wv] = seq; }
        __syncthreads();
        unsigned bgt = 0u, beq = 0u, ngt = 0u;
#pragma unroll
        for (int k = 0; k < 8; ++k) { const unsigned a = wtot[k], c = wtot[8 + k]; if (k < wv) { bgt += a; beq += c; } ngt += a; }
        unsigned rgt = bgt + sgt - cgt, req = beq + seq - ceq;
#pragma unroll
        for (int q = 0; q < 4; ++q) {
            const int t = 4 * tid + q; int slot = -1;
            if (key[q] > prefix) { slot = (int)rgt; ++rgt; }
            else if (key[q] == prefix) { if (req < need) slot = (int)(ngt + req); ++req; }
            if (slot >= 0) { IDX[item * CAP + slot] = t; GATE[item * CAP + slot] = __uint_as_float(key[q]); }
            INV[((size_t)b * SEQ + t) * 16 + e] = slot;
        }
    }
}

struct MoeUpSched {
    int G, c, round; const bf16_t *H2, *W13T; bf16_t* HMID; const int* IDX;
    __device__ __forceinline__ bool next(int i, Unit& u) const {
        if (i >= 4 || c >= 256) return false;
        const int x = c & 7, q = c >> 3, Q = q >> 2, mth = q & 3, item = (Q * 4 + round) * 8 + x, b = item >> 4, e = item & 15, nt = 4 * i + mth;
        u.a = (const char*)(H2 + (size_t)b * SEQ * D); u.b = (const char*)(W13T + ((size_t)e * 4096 + nt * 256) * D); u.c = HMID + (size_t)item * CAP * FF + nt * 128;
        u.aux = nullptr; u.gidx = IDX + item * CAP; u.ldc = FF; u.row0 = 0; u.col0 = 0; return true;
    }
    __device__ __forceinline__ void a_ready(const Unit&) const {}
    __device__ __forceinline__ void done(const Unit&) const {}
};
struct MoeDownSched {
    int G, c; const bf16_t *HMID, *W2T; bf16_t* YS; const float* GATE;
    __device__ __forceinline__ bool next(int i, Unit& u) const {
        if (i >= 4 || c >= 256) return false;
        const int x = c & 7, q = c >> 3, Q = q >> 2, nt = q & 3, item = (Q * 4 + i) * 8 + x, e = item & 15;
        u.a = (const char*)(HMID + (size_t)item * CAP * FF); u.b = (const char*)(W2T + ((size_t)e * 1024 + nt * 256) * FF); u.c = YS + (size_t)item * CAP * D + nt * 256;
        u.aux = GATE + item * CAP; u.gidx = nullptr; u.ldc = D; u.row0 = 0; u.col0 = 0; return true;
    }
    __device__ __forceinline__ void a_ready(const Unit&) const {}
    __device__ __forceinline__ void done(const Unit&) const {}
};
__device__ __forceinline__ void ph_moe_up(const P& p, unsigned char* lds) {
    pg8::EpiSwiGLU E;
    for (int round = 0; round < 4; ++round) {
        MoeUpSched S{(int)gridDim.x, (int)blockIdx.x, round, (const bf16_t*)(p.ws + WS_H2), (const bf16_t*)(p.ws + WS_W13T), (bf16_t*)(p.ws + WS_HMID), (const int*)(p.ws + WS_IDX)};
        pg8::gemm_phase<pg8::EpiSwiGLU, MoeUpSched, true, true, true>((PG8_LAS unsigned char*)lds, D, S, E);
    }
}
__device__ __forceinline__ void ph_moe_down(const P& p, unsigned char* lds) {
    MoeDownSched S{(int)gridDim.x, (int)blockIdx.x, (const bf16_t*)(p.ws + WS_HMID), (const bf16_t*)(p.ws + WS_W2T), (bf16_t*)(p.ws + WS_YS), (const float*)(p.ws + WS_GATE)};
    pg8::EpiDown E;
    pg8::gemm_phase<pg8::EpiDown, MoeDownSched, true, true, false>((PG8_LAS unsigned char*)lds, FF, S, E);
}

__device__ __forceinline__ void ph_final(const P& p) {
    const int tid = opaque_tid(), lane = tid & 63, wv = tid >> 6;
    const float* ADA = (const float*)(p.ws + WS_ADA);
    const bf16_t* YS = (const bf16_t*)(p.ws + WS_YS);
    const int* INV = (const int*)(p.ws + WS_INV);
    float* X = p.out;
    for (int r0 = (blockIdx.x * 8 + wv) * 2; r0 < NTOK; r0 += gridDim.x * 16) {
        const int b = r0 / SEQ;
        const float* g2 = ADA + b * 6144 + 5120;
        int myinv[2]; f32x4_t xv[2][4]; f32x4_t acc[2][4];
#pragma unroll
        for (int rr = 0; rr < 2; ++rr) {
            myinv[rr] = INV[(size_t)(r0 + rr) * 16 + (lane & 15)];
#pragma unroll
            for (int j = 0; j < 4; ++j) { const uint2 w = ((const uint2*)(X + (size_t)(r0 + rr) * D))[lane + 64 * j];
                xv[rr][j] = (f32x4_t){__uint_as_float(w.x << 16), __uint_as_float(w.x & 0xffff0000u), __uint_as_float(w.y << 16), __uint_as_float(w.y & 0xffff0000u)}; acc[rr][j] = (f32x4_t){0.f, 0.f, 0.f, 0.f}; }
        }
#pragma unroll
        for (int rr = 0; rr < 2; ++rr) {
            unsigned m = (unsigned)(__ballot(myinv[rr] >= 0) & 0xffffull);
            while (m) {
                uint2 w[4][4]; int ne = 0;
#pragma unroll
                for (int k = 0; k < 4; ++k) {
                    if (m) {
                        const int e = __builtin_ctz(m); m &= m - 1u; ne = k + 1;
                        const int slot = __shfl(myinv[rr], e);
                        const uint2* yr = (const uint2*)(YS + ((size_t)(b * 16 + e) * CAP + slot) * D);
#pragma unroll
                        for (int j = 0; j < 4; ++j) w[k][j] = yr[lane + 64 * j];
                    }
                }
#pragma unroll
                for (int k = 0; k < 4; ++k) {
                    if (k < ne) {
#pragma unroll
                        for (int j = 0; j < 4; ++j) { acc[rr][j].x += __uint_as_float(w[k][j].x << 16); acc[rr][j].y += __uint_as_float(w[k][j].x & 0xffff0000u); acc[rr][j].z += __uint_as_float(w[k][j].y << 16); acc[rr][j].w += __uint_as_float(w[k][j].y & 0xffff0000u); }
                    }
                }
            }
        }
#pragma unroll
        for (int rr = 0; rr < 2; ++rr) {
            f32x4_t v[4]; float ss = 0.f;
#pragma unroll
            for (int j = 0; j < 4; ++j) {
                const f32x4_t g = ((const f32x4_t*)g2)[lane + 64 * j];
                v[j] = xv[rr][j] + g * acc[rr][j];
                ss += v[j].x * v[j].x + v[j].y * v[j].y + v[j].z * v[j].z + v[j].w * v[j].w;
            }
            ss = wave_sum(ss);
            const float rstd = rsqrtf(ss * (1.f / D) + EPS);
#pragma unroll
            for (int j = 0; j < 4; ++j) {
                const f32x4_t g = ((const f32x4_t*)p.final_g)[lane + 64 * j];
                ((f32x4_t*)(X + (size_t)(r0 + rr) * D))[lane + 64 * j] = v[j] * rstd * g;
            }
        }
    }
}

#define LAS __attribute__((address_space(3)))
#define XB_TMO      128
#define XB_XCNT(j)  (256  + 64 * (j))
#define XB_XSUB(j)  (1280 + 64 * (j))
#define XB_XGEN(j)  (2304 + 64 * (j))
#define XB_TOP      3328
#define XB_TOPGEN   3392
#define XCD_BAR_WORDS 3456
#define XB_SPIN_CAP (1u << 18)

__device__ __forceinline__ unsigned xb_ld(unsigned* p)              { return __hip_atomic_load(p, __ATOMIC_RELAXED, __HIP_MEMORY_SCOPE_AGENT); }
__device__ __forceinline__ unsigned xb_add(unsigned* p, unsigned v) { return __hip_atomic_fetch_add(p, v, __ATOMIC_RELAXED, __HIP_MEMORY_SCOPE_AGENT); }
__device__ __forceinline__ unsigned xb_xcc_id() { return (unsigned)__builtin_amdgcn_s_getreg((3 << 11) | 20) & 0xFu; }
#define XB_SPIN(cond, bar) do { unsigned _sp = 0; while (cond) { __builtin_amdgcn_s_sleep(1); \
    if ((++_sp & 255u) == 0u) { if (xb_ld(&(bar)[XB_TMO])) break; if (_sp > XB_SPIN_CAP) { atomicAdd(&(bar)[XB_TMO], 1u); break; } } } } while (0)

struct XcdBarrier {
    unsigned* bar; unsigned x;
    volatile LAS unsigned* st;
};

__device__ __forceinline__ XcdBarrier xcd_barrier_post(unsigned* bar, volatile LAS unsigned* st) {
    XcdBarrier b; b.bar = bar; b.x = xb_xcc_id(); b.st = st;
    if (threadIdx.x == 0) (void)xb_add(&bar[XB_XCNT(b.x)], 1u);
    return b;
}
__device__ __forceinline__ void xcd_barrier_complete(unsigned* bar, unsigned x, unsigned& nloc, unsigned& nx) {
    const unsigned G = gridDim.x * gridDim.y * gridDim.z;
    unsigned sum, cnt, mine, sp = 0u;
    for (;;) {
        sum = 0u; cnt = 0u; mine = 0u;
#pragma unroll
        for (unsigned j = 0; j < 16; ++j) { const unsigned c = xb_ld(&bar[XB_XCNT(j)]); sum += c; cnt += (c > 0u) ? 1u : 0u; mine = (j == x) ? c : mine; }
        if (sum == G) break;
        __builtin_amdgcn_s_sleep(1);
        if ((++sp & 255u) == 0u) { if (xb_ld(&bar[XB_TMO])) break; if (sp > XB_SPIN_CAP) { atomicAdd(&bar[XB_TMO], 1u); break; } }
    }
    nloc = mine > 0u ? mine : 1u; nx = cnt > 0u ? cnt : 1u;
}

__device__ __forceinline__ void xcd_barrier(const XcdBarrier& b) {
    asm volatile("s_waitcnt vmcnt(0)" ::: "memory");
    __syncthreads();
    if (threadIdx.x == 0) {
        unsigned* bar = b.bar;
        __builtin_amdgcn_s_waitcnt(0);
        unsigned nloc = b.st[0], nx = b.st[1];
        if (nloc == 0u) { xcd_barrier_complete(bar, b.x, nloc, nx); b.st[0] = nloc; b.st[1] = nx; }
        const unsigned old = xb_add(&bar[XB_XSUB(b.x)], 1u);
        const unsigned gen = old / nloc;
        if (old + 1u == (gen + 1u) * nloc) {
            __builtin_amdgcn_fence(__ATOMIC_RELEASE, "agent");
            asm volatile("s_waitcnt vmcnt(0)" ::: "memory");
            const unsigned og = xb_add(&bar[XB_TOP], 1u);
            const unsigned tg = og / nx;
            if (og + 1u == (tg + 1u) * nx) xb_add(&bar[XB_TOPGEN], 1u);
            else XB_SPIN(xb_ld(&bar[XB_TOPGEN]) == tg, bar);
            __builtin_amdgcn_fence(__ATOMIC_ACQUIRE, "agent");
            xb_add(&bar[XB_XGEN(b.x)], 1u);
            asm volatile("s_waitcnt vmcnt(0)" ::: "memory");
        } else {
            XB_SPIN(xb_ld(&bar[XB_XGEN(b.x)]) == gen, bar);
            __builtin_amdgcn_fence(__ATOMIC_ACQUIRE, "agent");
            asm volatile("s_waitcnt vmcnt(0)" ::: "memory");
        }
    }
    __syncthreads();
}

constexpr int N_PHASES = 11;
template <int PH>
__device__ __forceinline__ void run_phase(const P& p, unsigned char* ldsb) {
    float* lds = (float*)ldsb;
    if constexpr (PH == 0) { ph_prep(p, lds); ph_convert_small(p, lds); }
    else if constexpr (PH == 1) { ph_norm1(p); ph_filter(p, lds); }
    else if constexpr (PH == 2) ph_inproj(p, ldsb);
    else if constexpr (PH == 3) ph_mixers<0>(p, ldsb);
    else if constexpr (PH == 4) ph_mixprep(p, lds);
    else if constexpr (PH == 5) ph_outproj(p, ldsb);
    else if constexpr (PH == 6) ph_norm2_router(p, lds);
    else if constexpr (PH == 7) ph_topk(p, lds);
    else if constexpr (PH == 8) ph_moe_up(p, ldsb);
    else if constexpr (PH == 9) ph_moe_down(p, ldsb);
    else if constexpr (PH == 10) ph_final(p);
}
template <int PH>
__device__ __forceinline__ void run_from(const P& p, unsigned char* lds, const XcdBarrier& bar) {
    if constexpr (PH < N_PHASES) {
        run_phase<PH>(p, lds);
        if constexpr (PH + 1 < N_PHASES) xcd_barrier(bar);
        run_from<PH + 1>(p, lds, bar);
    }
}
__global__ void __launch_bounds__(NT, 2) fwd_all(P p) {
    extern __shared__ __attribute__((aligned(16))) unsigned char lds_raw[];
    volatile LAS unsigned* st = (volatile LAS unsigned*)(lds_raw + LDS_BYTES - 32);
    if (threadIdx.x < 2) st[threadIdx.x] = 0u;
    __syncthreads();
    const XcdBarrier bar = xcd_barrier_post((unsigned*)(p.ws + WS_CTL) + CW_BAR, st);
    run_from<0>(p, lds_raw, bar);
}

extern "C" void kernel_launch(void* const* d_in, const int* in_sizes, int n_in, void* d_out, int out_size, void* d_ws, size_t ws_size, hipStream_t stream) {
    static int grid = 0;
    if (grid == 0) {
        int dev = 0, cus = 0, per_cu = 0;
        (void)hipGetDevice(&dev);
        (void)hipDeviceGetAttribute(&cus, hipDeviceAttributeMultiprocessorCount, dev);
        (void)hipFuncSetAttribute((const void*)fwd_all, hipFuncAttributeMaxDynamicSharedMemorySize, LDS_BYTES);
        (void)hipOccupancyMaxActiveBlocksPerMultiprocessor(&per_cu, (const void*)fwd_all, NT, LDS_BYTES);
        if (per_cu < 1) fprintf(stderr, "kernel_launch: occupancy query says %d blocks/CU\n", per_cu);
        grid = (cus > 0 ? cus : 256);
        if (ws_size < WS_END) fprintf(stderr, "kernel_launch: workspace too small: %zu < %zu\n", ws_size, (size_t)WS_END);
    }
    P p{};
    const float** f = (const float**)&p;
    for (int i = 0; i < 28; ++i) f[i] = (const float*)d_in[i];
    p.out = (float*)d_out;
    p.ws = (unsigned char*)d_ws;
    p.ph_lo = 0; p.ph_hi = N_PHASES;
    (void)hipMemsetAsync((unsigned char*)d_ws + WS_CTL, 0, CTL_ZERO_BYTES, stream);
    hipLaunchKernelGGL(fwd_all, dim3(grid), dim3(NT), LDS_BYTES, stream, p);
}
```

```cpp
#include <hip/hip_runtime.h>
#include <cstdio>
#include <cstdint>

constexpr int D = 1024, NB = 16, SEQ = 2048, CTXL = 256;
constexpr int NTOK = NB * SEQ;
constexpr int NCTX = NB * CTXL;
constexpr int HEADS = 4;
constexpr int INC = 4096;
constexpr int NE = 16, CAP = 256, FF = 2048;
constexpr int NT = 512;
constexpr int LDS_BYTES = 147456;
constexpr float EPS = 1e-6f;
typedef unsigned short bf16_t;

constexpr size_t MiB = 1u << 20;
constexpr size_t WS_CTL = 0;
constexpr size_t WS_ADA = 1 * MiB;
constexpr size_t WS_LB = WS_ADA + 512 * 1024;
constexpr size_t WS_HID2 = 2 * MiB;
constexpr size_t WS_AFF = 3 * MiB;
constexpr size_t WS_IDX = 5 * MiB;
constexpr size_t WS_GATE = 5 * MiB + 512 * 1024;
constexpr size_t WS_INV = 6 * MiB;
constexpr size_t WS_W13T = 8 * MiB;
constexpr size_t WS_YS = WS_W13T;
constexpr size_t WS_W2T = 136 * MiB;
constexpr size_t WS_R = 200 * MiB;
constexpr size_t WS_H = WS_R;
constexpr size_t WS_MIXA = WS_R;
constexpr size_t WS_HC = WS_R + 64 * MiB;
constexpr size_t WS_PC = WS_R + 72 * MiB;
constexpr size_t WS_OFB = WS_R + 84 * MiB;
constexpr size_t WS_WOUTT = WS_R + 148 * MiB;
constexpr size_t WS_PHG = WS_R + 152 * MiB;
constexpr size_t WS_HMID = WS_R;
constexpr size_t WS_H2 = WS_R + 256 * MiB;
constexpr size_t WS_YT = WS_R + 320 * MiB;
constexpr size_t WS_END = WS_YT + 32 * MiB;
constexpr int CW_QHEAD = 64;
constexpr int CW_BAR = 4096;
constexpr size_t CTL_ZERO_BYTES = 65536;
constexpr size_t DO_PHYT = 0;
constexpr size_t DO_HF = 96 * MiB;
constexpr size_t DO_SCTX = 112 * MiB;
constexpr size_t DO_WINT = 120 * MiB;

struct P {
    const float *x, *c, *ctx, *c_ctx, *ada_w, *ada_b, *norm1_g, *w_in, *hy_conv_w, *hy_conv_b, *pos_w1, *pos_b1, *freq1, *pos_w2, *pos_b2,
        *freq2, *pos_w3, *hy_bias, *hy_norm_g, *hg_lb, *hg_norm_g, *w_out, *norm2_g, *router_w, *exp_w1, *exp_w3, *exp_w2, *final_g;
    float* out;
    unsigned char* ws;
    int ph_lo, ph_hi;
};

__device__ __forceinline__ int opaque_tid() { int t = threadIdx.x; asm volatile("" : "+v"(t)); return t; }
__device__ __forceinline__ void lds_barrier() { asm volatile("s_waitcnt lgkmcnt(0)" ::: "memory"); __builtin_amdgcn_s_barrier(); asm volatile("" ::: "memory"); }
typedef float f32x4_t __attribute__((ext_vector_type(4)));
__device__ __forceinline__ float wave_sum(float v) {
#pragma unroll
    for (int o = 1; o < 64; o <<= 1) v += __shfl_xor(v, o);
    return v;
}
__device__ __forceinline__ float sigmoidf_(float z) { return 1.f / (1.f + expf(-z)); }
__device__ __forceinline__ float siluf_(float z) { return z / (1.f + expf(-z)); }
__device__ __forceinline__ float bf2f(bf16_t h) { return __uint_as_float((unsigned)h << 16); }
__device__ __forceinline__ unsigned f2bf(float f) { unsigned u = __float_as_uint(f); return (u + 0x7fffu + ((u >> 16) & 1u)) >> 16; }
typedef float f32x2_cv __attribute__((ext_vector_type(2))); typedef __bf16 bf16x2_cv __attribute__((ext_vector_type(2)));
__device__ __forceinline__ unsigned cvtpk(float lo, float hi) { const f32x2_cv v = {lo, hi}; const bf16x2_cv b = __builtin_convertvector(v, bf16x2_cv); return __builtin_bit_cast(unsigned, b); }
__device__ __forceinline__ unsigned pk2(float lo, float hi) { return f2bf(lo) | (f2bf(hi) << 16); }

namespace pg8 {
#define PG8_LAS __attribute__((address_space(3)))
typedef unsigned short bf16_t;
typedef short bf16x8 __attribute__((ext_vector_type(8)));
typedef float f32x4 __attribute__((ext_vector_type(4)));
typedef unsigned u32x4 __attribute__((ext_vector_type(4)));
constexpr int BM = 256, BK = 64, HALF = 128, HTB = HALF * BK * 2  , STAGE_BYTES = 8 * HTB, NXCD = 8, WGM = 8;

__host__ __device__ __forceinline__ int lds_byte(int r, int c) { const int st = (r >> 4) * 2 + (c >> 5), rr = r & 15, cc = c & 31, ob = rr * 64 + cc * 2; return st * 1024 + (ob ^ (((ob >> 9) & 1) << 5)); }
__host__ __device__ __forceinline__ void stage_rc(int b, int& R, int& C) { const int st = b / 1024, sb = b % 1024, swz = sb ^ (((sb >> 9) & 1) << 5); R = (st >> 1) * 16 + swz / 64; C = (st & 1) * 32 + (swz % 64) / 2; }
__host__ __device__ __forceinline__ int perm32(int rho) { const int n = rho >> 4, i = rho & 15; return 8 * (i >> 2) + 4 * n + (i & 3); }

struct Unit { const char* a; const char* b; bf16_t* c; const float* aux; const int* gidx; int ldc, row0, col0; };
__device__ __forceinline__ unsigned cvt_pk_bf16(float lo, float hi) { unsigned r; asm volatile("v_cvt_pk_bf16_f32 %0, %1, %2" : "=v"(r) : "v"(lo), "v"(hi)); return r; }

__device__ __forceinline__ void tile_of(int L, int nM, int nN, int& pm, int& pn) {
    const int nwg = nM * nN; int wgid = L;
    { const int q = nwg / NXCD, r = nwg % NXCD, xcd = wgid % NXCD, off = wgid / NXCD; wgid = (xcd < r ? xcd * (q + 1) : r * (q + 1) + (xcd - r) * q) + off; }
    const int nig = WGM * nN, gid = wgid / nig, fm = gid * WGM, gsz = (nM - fm) < WGM ? (nM - fm) : WGM;
    pm = fm + ((wgid % nig) % gsz); pn = (wgid % nig) / gsz;
}

struct EpiStoreBf16 {
    static constexpr bool PERM = true, AFTER_DRAIN = false;
    __device__ __forceinline__ void operator()(const f32x4 (&acc)[2][2][4][2], const Unit& u, int wr, int wc, int fr, int fq) const {
        bf16_t* base = u.c + (size_t)(wr * 64 + fr) * u.ldc + wc * 32 + 8 * fq;
#pragma unroll
        for (int ai = 0; ai < 2; ++ai)
#pragma unroll
            for (int m = 0; m < 4; ++m) { bf16_t* rowp = base + (size_t)(ai * HALF + m * 16) * u.ldc;
#pragma unroll
                for (int bj = 0; bj < 2; ++bj) { const f32x4 v0 = acc[ai][bj][m][0], v1 = acc[ai][bj][m][1];
                    u32x4 w; w.x = cvt_pk_bf16(v0[0], v0[1]); w.y = cvt_pk_bf16(v0[2], v0[3]); w.z = cvt_pk_bf16(v1[0], v1[1]); w.w = cvt_pk_bf16(v1[2], v1[3]);
                    *(u32x4*)(rowp + bj * HALF) = w; } }
    }
};
struct EpiOutProj {
    static constexpr bool PERM = true, AFTER_DRAIN = false;
    const float* x; const float* ada; bf16_t* x1;
    __device__ __forceinline__ void operator()(const f32x4 (&acc)[2][2][4][2], const Unit& u, int wr, int wc, int fr, int fq) const {
        const float* g1 = ada + (u.row0 >> 11) * 6144 + 2048;
#pragma unroll
        for (int bj = 0; bj < 2; ++bj) { const int col = u.col0 + bj * HALF + wc * 32 + 8 * fq; const f32x4 g0 = *(const f32x4*)(g1 + col), gB = *(const f32x4*)(g1 + col + 4);
#pragma unroll
            for (int ai = 0; ai < 2; ++ai)
#pragma unroll
                for (int m = 0; m < 4; ++m) { const size_t row = (size_t)(u.row0 + ai * HALF + wr * 64 + m * 16 + fr);
                    const f32x4 v0 = *(const f32x4*)(x + row * D + col) + g0 * acc[ai][bj][m][0], v1 = *(const f32x4*)(x + row * D + col + 4) + gB * acc[ai][bj][m][1];
                    u32x4 w; w.x = cvt_pk_bf16(v0[0], v0[1]); w.y = cvt_pk_bf16(v0[2], v0[3]); w.z = cvt_pk_bf16(v1[0], v1[1]); w.w = cvt_pk_bf16(v1[2], v1[3]);
                    *(u32x4*)(x1 + row * (2 * D) + col) = w; } }
    }
};
__device__ __forceinline__ float silu_fast(float a) { return a * __builtin_amdgcn_rcpf(1.0f + __builtin_amdgcn_exp2f(-1.4426950408889634f * a)); }
struct EpiSwiGLU {
    static constexpr bool PERM = true, AFTER_DRAIN = false;
    __device__ __forceinline__ void operator()(const f32x4 (&acc)[2][2][4][2], const Unit& u, int wr, int wc, int fr, int fq) const {
        bf16_t* base = u.c + (size_t)(wr * 64 + fr) * FF + wc * 32 + 8 * fq;
#pragma unroll
        for (int ai = 0; ai < 2; ++ai)
#pragma unroll
            for (int m = 0; m < 4; ++m) { const f32x4 a0 = acc[ai][0][m][0], a1 = acc[ai][0][m][1], b0 = acc[ai][1][m][0], b1 = acc[ai][1][m][1];
                u32x4 w; w.x = cvt_pk_bf16(silu_fast(a0[0]) * b0[0], silu_fast(a0[1]) * b0[1]); w.y = cvt_pk_bf16(silu_fast(a0[2]) * b0[2], silu_fast(a0[3]) * b0[3]);
                w.z = cvt_pk_bf16(silu_fast(a1[0]) * b1[0], silu_fast(a1[1]) * b1[1]); w.w = cvt_pk_bf16(silu_fast(a1[2]) * b1[2], silu_fast(a1[3]) * b1[3]);
                *(u32x4*)(base + (size_t)(ai * HALF + m * 16) * FF) = w; }
    }
};
struct EpiDown {
    static constexpr bool PERM = true, AFTER_DRAIN = false;
    __device__ __forceinline__ void operator()(const f32x4 (&acc)[2][2][4][2], const Unit& u, int wr, int wc, int fr, int fq) const {
        bf16_t* base = u.c + (size_t)(wr * 64 + fr) * D + wc * 32 + 8 * fq;
#pragma unroll
        for (int ai = 0; ai < 2; ++ai)
#pragma unroll
            for (int m = 0; m < 4; ++m) { const float gt = u.aux[ai * HALF + wr * 64 + m * 16 + fr]; bf16_t* rowp = base + (size_t)(ai * HALF + m * 16) * D;
#pragma unroll
                for (int bj = 0; bj < 2; ++bj) { const f32x4 v0 = acc[ai][bj][m][0] * gt, v1 = acc[ai][bj][m][1] * gt;
                    u32x4 w; w.x = cvt_pk_bf16(v0[0], v0[1]); w.y = cvt_pk_bf16(v0[2], v0[3]); w.z = cvt_pk_bf16(v1[0], v1[1]); w.w = cvt_pk_bf16(v1[2], v1[3]);
                    *(u32x4*)(rowp + bj * HALF) = w; } }
    }
};

template <class Epi, class Sched, bool ALIGN_EPI = false, bool SP2 = false, bool GATHER = false>
__device__ __forceinline__ void gemm_phase(PG8_LAS unsigned char* lds, const int K, const Sched& S, const Epi& E) {
    const int tid = opaque_tid(), wid = __builtin_amdgcn_readfirstlane(tid >> 6), lane = tid & 63, wr = wid >> 2, wc = wid & 3, fr = lane & 15, fq = lane >> 4;
    const int nt = K / BK;
    unsigned voffA[2], voffB[2];
#pragma unroll
    for (int i = 0; i < 2; ++i) { int R, C; stage_rc(tid * 16 + i * 8192, R, C); const int Rb = Epi::PERM ? ((R & ~31) + perm32(R & 31)) : R;
        voffA[i] = (unsigned)(R * K + C) * 2u; voffB[i] = (unsigned)(Rb * K + C) * 2u; }
    const size_t kstep = (size_t)(BK * 2);
    const size_t hstep = (size_t)HALF * K * 2;
    const unsigned ldsw = (unsigned)wid * 1024u;
    const int aoff = lds_byte(wr * 64 + fr, fq * 8), boff = lds_byte(wc * 32 + fr, fq * 8);
#define PG8_SA(b, h) (((b) * 2 + (h)) * HTB)
#define PG8_SB(b, h) ((4 + (b) * 2 + (h)) * HTB)
#define PG8_STAGE(bufoff, gbase, voff) do { _Pragma("unroll") for (int _i = 0; _i < 2; ++_i) \
        __builtin_amdgcn_global_load_lds((const unsigned*)((const char*)(gbase) + (voff)[_i]), (PG8_LAS unsigned*)(lds + (bufoff) + ldsw + _i * 8192), 16, 0, 0); } while (0)
#define PG8_STAGE_A(bufoff, gbase, h) do { _Pragma("unroll") for (int _i = 0; _i < 2; ++_i) \
        __builtin_amdgcn_global_load_lds((const unsigned*)((const char*)(gbase) + voffAh[h][_i]), (PG8_LAS unsigned*)(lds + (bufoff) + ldsw + _i * 8192), 16, 0, 0); } while (0)
#define PG8_LDA(dst, b, h) do { _Pragma("unroll") for (int m = 0; m < 4; ++m) _Pragma("unroll") for (int k = 0; k < 2; ++k) dst[m][k] = *(const PG8_LAS bf16x8*)(lds + PG8_SA(b, h) + aoff + m * 2048 + k * 1024); } while (0)
#define PG8_LDB(dst, b, h) do { _Pragma("unroll") for (int n = 0; n < 2; ++n) _Pragma("unroll") for (int k = 0; k < 2; ++k) dst[n][k] = *(const PG8_LAS bf16x8*)(lds + PG8_SB(b, h) + boff + n * 2048 + k * 1024); } while (0)
#define PG8_MMA(ai, bj, At, Bt) do { __builtin_amdgcn_s_setprio(1); _Pragma("unroll") for (int m = 0; m < 4; ++m) _Pragma("unroll") for (int n = 0; n < 2; ++n) _Pragma("unroll") for (int k = 0; k < 2; ++k) \
        acc[ai][bj][m][n] = __builtin_amdgcn_mfma_f32_16x16x32_bf16(Bt[n][k], At[m][k], acc[ai][bj][m][n], 0, 0, 0); __builtin_amdgcn_s_setprio(0); } while (0)
#define PG8_WAIT_V(n) asm volatile("s_waitcnt vmcnt(" #n ")" ::: "memory")
#define PG8_WAIT_L(n) asm volatile("s_waitcnt lgkmcnt(" #n ")" ::: "memory")
#define PG8_BAR __builtin_amdgcn_s_barrier()
#define PG8_SCHED __builtin_amdgcn_sched_barrier(0)
    Unit cur, nxt; int ui = 0;
    if (!S.next(0, cur)) return;
    unsigned voffAh[2][2];
#pragma unroll
    for (int h = 0; h < 2; ++h)
#pragma unroll
        for (int i = 0; i < 2; ++i) {
            if constexpr (GATHER) { int R, C; stage_rc(tid * 16 + i * 8192, R, C); voffAh[h][i] = ((unsigned)cur.gidx[h * HALF + R] * (unsigned)K + (unsigned)C) * 2u; }
            else voffAh[h][i] = voffA[i] + (unsigned)h * (unsigned)hstep;
        }
    f32x4 acc[2][2][4][2];
#pragma unroll
    for (int a = 0; a < 2; ++a)
#pragma unroll
        for (int b = 0; b < 2; ++b)
#pragma unroll
            for (int m = 0; m < 4; ++m)
#pragma unroll
                for (int n = 0; n < 2; ++n) acc[a][b][m][n] = (f32x4){0.f, 0.f, 0.f, 0.f};
    bf16x8 At[4][2], B0[2][2], B1[2][2];
    const char* cA = cur.a; const char* cB = cur.b;
    S.a_ready(cur);
    if constexpr (SP2) {
        PG8_STAGE(PG8_SB(0, 0), cB, voffB); PG8_STAGE(PG8_SB(0, 1), cB + hstep, voffB); PG8_STAGE_A(PG8_SA(0, 0), cA, 0); PG8_STAGE_A(PG8_SA(0, 1), cA, 1);
        if (wr == 1) PG8_BAR;
        PG8_WAIT_V(2); PG8_BAR;
        PG8_STAGE(PG8_SB(1, 0), cB + kstep, voffB); PG8_STAGE_A(PG8_SA(1, 0), cA + kstep, 0); PG8_STAGE(PG8_SB(1, 1), cB + hstep + kstep, voffB);
        PG8_WAIT_V(6); PG8_BAR;
    } else {
        PG8_STAGE(PG8_SB(0, 0), cB, voffB); PG8_STAGE_A(PG8_SA(0, 0), cA, 0); PG8_STAGE(PG8_SB(0, 1), cB + hstep, voffB); PG8_STAGE_A(PG8_SA(0, 1), cA, 1);
        if (wr == 1) PG8_BAR;
        PG8_WAIT_V(4); PG8_BAR;
        PG8_STAGE(PG8_SB(1, 0), cB + kstep, voffB); PG8_STAGE_A(PG8_SA(1, 0), cA + kstep, 0); PG8_STAGE(PG8_SB(1, 1), cB + hstep + kstep, voffB);
        PG8_WAIT_V(6); PG8_BAR;
    }
    for (;;) {
        const bool has_next = S.next(ui + 1, nxt);
        const char* nA = has_next ? nxt.a : cA; const char* nB = has_next ? nxt.b : cB;
        for (int t = 0; t < nt; t += 2) {
            const bool last = (t == nt - 2);
            const char* a1 = cA + (size_t)(t + 1) * kstep;
            const char* a2 = last ? nA : cA + (size_t)(t + 2) * kstep; const char* b2 = last ? nB : cB + (size_t)(t + 2) * kstep;
            const char* a3 = a2 + kstep; const char* b3 = b2 + kstep;
            if (last && has_next) S.a_ready(nxt);
            if constexpr (SP2) {
            PG8_LDB(B0, 0, 0); PG8_LDB(B1, 0, 1); PG8_SCHED; PG8_LDA(At, 0, 0); PG8_STAGE_A(PG8_SA(1, 1), a1, 1);
            PG8_WAIT_V(8); PG8_WAIT_L(0); PG8_BAR; PG8_MMA(0, 0, At, B0); PG8_MMA(0, 1, At, B1); PG8_BAR; PG8_SCHED;
            PG8_LDA(At, 0, 1); PG8_STAGE(PG8_SB(0, 0), b2, voffB); PG8_STAGE(PG8_SB(0, 1), b2 + hstep, voffB); PG8_STAGE_A(PG8_SA(0, 0), a2, 0);
            PG8_WAIT_V(8); PG8_WAIT_L(0); PG8_BAR; PG8_MMA(1, 0, At, B0); PG8_MMA(1, 1, At, B1); PG8_BAR; PG8_SCHED;
            PG8_LDB(B0, 1, 0); PG8_LDB(B1, 1, 1); PG8_SCHED; PG8_LDA(At, 1, 0); PG8_STAGE_A(PG8_SA(0, 1), a2, 1);
            PG8_WAIT_V(8); PG8_WAIT_L(0); PG8_BAR; PG8_MMA(0, 0, At, B0); PG8_MMA(0, 1, At, B1); PG8_BAR; PG8_SCHED;
            PG8_LDA(At, 1, 1); PG8_STAGE(PG8_SB(1, 0), b3, voffB); PG8_STAGE(PG8_SB(1, 1), b3 + hstep, voffB); PG8_STAGE_A(PG8_SA(1, 0), a3, 0);
            PG8_WAIT_V(8); PG8_WAIT_L(0); PG8_BAR; PG8_MMA(1, 0, At, B0); PG8_MMA(1, 1, At, B1); PG8_BAR; PG8_SCHED;
            } else {
            PG8_LDB(B0, 0, 0); PG8_SCHED; PG8_LDA(At, 0, 0); PG8_STAGE_A(PG8_SA(1, 1), a1, 1);
            PG8_WAIT_L(8); PG8_BAR; PG8_WAIT_L(0); PG8_MMA(0, 0, At, B0); PG8_BAR; PG8_SCHED;
            PG8_LDB(B1, 0, 1); PG8_STAGE(PG8_SB(0, 0), b2, voffB);
            PG8_BAR; PG8_WAIT_L(0); PG8_MMA(0, 1, At, B1); PG8_BAR;
            PG8_LDA(At, 0, 1); PG8_STAGE_A(PG8_SA(0, 0), a2, 0);
            PG8_BAR; PG8_WAIT_L(0); PG8_MMA(1, 0, At, B0); PG8_BAR; PG8_SCHED;
            PG8_STAGE(PG8_SB(0, 1), b2 + hstep, voffB);
            PG8_WAIT_V(6); PG8_BAR; PG8_MMA(1, 1, At, B1); PG8_BAR;
            PG8_LDB(B0, 1, 0); PG8_SCHED; PG8_LDA(At, 1, 0); PG8_STAGE_A(PG8_SA(0, 1), a2, 1);
            PG8_WAIT_L(8); PG8_BAR; PG8_WAIT_L(0); PG8_MMA(0, 0, At, B0); PG8_BAR; PG8_SCHED;
            PG8_LDB(B1, 1, 1); PG8_STAGE(PG8_SB(1, 0), b3, voffB);
            PG8_BAR; PG8_WAIT_L(0); PG8_MMA(0, 1, At, B1); PG8_BAR;
            PG8_LDA(At, 1, 1); PG8_STAGE_A(PG8_SA(1, 0), a3, 0);
            PG8_BAR; PG8_WAIT_L(0); PG8_MMA(1, 0, At, B0); PG8_BAR; PG8_SCHED;
            PG8_STAGE(PG8_SB(1, 1), b3 + hstep, voffB);
            PG8_WAIT_V(6); PG8_BAR; PG8_MMA(1, 1, At, B1); PG8_BAR;
            }
        }
        if constexpr (ALIGN_EPI) { if (wr == 0) PG8_BAR; }
        if constexpr (!Epi::AFTER_DRAIN) { E(acc, cur, wr, wc, fr, fq); S.done(cur); }
        if (!has_next) break;
#pragma unroll
        for (int a = 0; a < 2; ++a)
#pragma unroll
            for (int b = 0; b < 2; ++b)
#pragma unroll
                for (int m = 0; m < 4; ++m)
#pragma unroll
                    for (int n = 0; n < 2; ++n) acc[a][b][m][n] = (f32x4){0.f, 0.f, 0.f, 0.f};
        cur = nxt; cA = nA; cB = nB; ++ui;
        if constexpr (ALIGN_EPI) { if (wr == 1) PG8_BAR; }
    }
    PG8_WAIT_V(0);
    if constexpr (!ALIGN_EPI) { if (wr == 0) PG8_BAR; }
    PG8_BAR;
    if constexpr (Epi::AFTER_DRAIN) { E.fused(acc, cur, wr, wc, fr, fq, lds, wid, lane); S.done(cur); }
#undef PG8_SA
#undef PG8_SB
#undef PG8_STAGE
#undef PG8_LDA
#undef PG8_LDB
#undef PG8_MMA
#undef PG8_WAIT_V
#undef PG8_WAIT_L
#undef PG8_BAR
#undef PG8_SCHED
}
}
using pg8::Unit; using pg8::tile_of;

__device__ __forceinline__ void ph_prep(const P& p, float* lds) {
    const int tid = opaque_tid(), G = gridDim.x;
    float* ADA = (float*)(p.ws + WS_ADA);
    float* LB = (float*)(p.ws + WS_LB);
    float* HID2 = (float*)(p.ws + WS_HID2);
    {
        float* s = lds;
        float* red = lds + 17 * 1024;
        if (blockIdx.x < 192) {
            for (int i = tid; i < 17 * 1024; i += NT) {
                const int r = i >> 10, d = i & 1023;
                const float cv = r < 16 ? p.c[r * 1024 + d] : p.c_ctx[d];
                s[i] = siluf_(cv);
            }
        }
        __syncthreads();
        for (int item = blockIdx.x; item < 192; item += G) {
            const int jj = tid & 31, ks = tid >> 5, j = item * 32 + jj;
            float acc[17];
#pragma unroll
            for (int r = 0; r < 17; ++r) acc[r] = 0.f;
            for (int d0 = ks * 64; d0 < ks * 64 + 64; d0 += 16) {
                float wv[16];
#pragma unroll
                for (int q = 0; q < 16; ++q) wv[q] = p.ada_w[(size_t)(d0 + q) * 6144 + j];
#pragma unroll
                for (int q = 0; q < 16; ++q)
#pragma unroll
                    for (int r = 0; r < 17; ++r) acc[r] += s[r * 1024 + d0 + q] * wv[q];
            }
#pragma unroll
            for (int r = 0; r < 17; ++r) red[(ks * 17 + r) * 32 + jj] = acc[r];
            __syncthreads();
            for (int i = tid; i < 17 * 32; i += NT) {
                const int r = i >> 5, j2 = i & 31;
                float sum = 0.f;
#pragma unroll
                for (int k = 0; k < 16; ++k) sum += red[(k * 17 + r) * 32 + j2];
                ADA[r * 6144 + item * 32 + j2] = sum + p.ada_b[item * 32 + j2];
            }
            __syncthreads();
        }
    }
    if (blockIdx.x == G - 1) {
        for (int i = tid; i < 1024; i += NT) {
            const float a0 = p.hg_lb[i], a1 = p.hg_lb[1024 + i];
            LB[i] = 1.f / (1.f + expf(a1 - a0));
        }
    }
    {
        float* zl = lds;
        float* h1 = lds + 512;
        __syncthreads();
        for (int it = (G - 1 - blockIdx.x); it < SEQ / 8; it += G) {
            const int lt = tid >> 6, j = tid & 63, t = it * 8 + lt;
            const float w = 6.283185307179586f * (float)t / 2048.0f;
            if (j == 0) zl[lt * 64] = (float)t / 2047.0f;
            if (j >= 1 && j < 17) { const float f = 1e-4f + (float)(j - 1) * ((15.0f - 1e-4f) / 15.0f); zl[lt * 64 + j] = cosf(f * w); }
            if (j >= 17 && j < 33) { const float f = 1e-4f + (float)(j - 17) * ((15.0f - 1e-4f) / 15.0f); zl[lt * 64 + j] = -sinf(f * w); }
            __syncthreads();
            float a = p.pos_b1[j];
            for (int i = 0; i < 33; ++i) a += zl[lt * 64 + i] * p.pos_w1[i * 64 + j];
            h1[lt * 64 + j] = sinf(p.freq1[j] * a);
            __syncthreads();
            float b = p.pos_b2[j];
            for (int i = 0; i < 64; ++i) b += h1[lt * 64 + i] * p.pos_w2[i * 64 + j];
            HID2[t * 64 + j] = sinf(p.freq2[j] * b);
            __syncthreads();
        }
    }
}
struct ConvItem { const float* W; bf16_t* dst; int N, KD, k0, n0, which; };
__device__ __forceinline__ ConvItem conv_small_item(const P& p, int it) {
    ConvItem c; c.which = 0; c.KD = D;
    if (it < 256) { c.W = p.w_in; c.N = INC; c.k0 = (it / 16) * 64; c.n0 = (it % 16) * 256; c.dst = (bf16_t*)((unsigned char*)p.out + DO_WINT); }
    else { const int r = it - 256; c.W = p.w_out; c.N = D; c.k0 = (r / 4) * 64; c.n0 = (r % 4) * 256; c.dst = (bf16_t*)(p.ws + WS_WOUTT); }
    return c;
}
constexpr int N_EXPERT_ITEMS = 2 * 16 * 16 * 8 + 16 * 32 * 4;
__device__ __forceinline__ ConvItem conv_expert_item(const P& p, int r) {
    ConvItem c; constexpr int I_W1 = 16 * 16 * 8;
    if (r < 2 * I_W1) {
        const int which = r / I_W1; r %= I_W1;
        const int e = r / 128, r2 = r % 128;
        c.W = (which == 0 ? p.exp_w1 : p.exp_w3) + (size_t)e * D * FF; c.N = FF; c.k0 = (r2 / 8) * 64; c.n0 = (r2 % 8) * 256; c.dst = (bf16_t*)(p.ws + WS_W13T) + (size_t)e * 4096 * D; c.KD = D; c.which = 1 + which;
    } else {
        r -= 2 * I_W1; const int e = r / 128, r2 = r % 128;
        c.W = p.exp_w2 + (size_t)e * FF * D; c.N = D; c.k0 = (r2 / 4) * 64; c.n0 = (r2 % 4) * 256; c.dst = (bf16_t*)(p.ws + WS_W2T) + (size_t)e * 1024 * FF; c.KD = FF; c.which = 0;
    }
    return c;
}
__device__ __forceinline__ void conv_load(const ConvItem& c, f32x4_t (&v)[8], int tid) {
#pragma unroll
    for (int q = 0; q < 8; ++q) { const int i = tid + NT * q, k = i >> 6, n4 = i & 63; v[q] = *(const f32x4_t*)(c.W + (size_t)(c.k0 + k) * c.N + c.n0 + 4 * n4); }
}
__device__ __forceinline__ void conv_tile_write(const f32x4_t (&v)[8], float* T, int tid) {
#pragma unroll
    for (int q = 0; q < 8; ++q) { const int i = tid + NT * q, k = i >> 6, n4 = i & 63; *(f32x4_t*)&T[k * 260 + 4 * (n4 ^ ((k >> 3) & 7))] = v[q]; }
}
__device__ __forceinline__ void conv_tile_store(const ConvItem& c, const float* T, int tid) {
#pragma unroll
    for (int q = 0; q < 4; ++q) { const int i = tid + NT * q, nl = i >> 3, ch = i & 7, n = c.n0 + nl;
        float a[8];
#pragma unroll
        for (int e = 0; e < 8; ++e) a[e] = T[(8 * ch + e) * 260 + (nl ^ (ch << 2))];
        const int row = c.which == 0 ? n : ((n >> 7) * 256 + (c.which - 1) * 128 + (n & 127));
        *(uint4*)(c.dst + (size_t)row * c.KD + c.k0 + 8 * ch) = make_uint4(cvtpk(a[0], a[1]), cvtpk(a[2], a[3]), cvtpk(a[4], a[5]), cvtpk(a[6], a[7])); }
}
constexpr int CONV_DEPTH = 4;
template <class ITEMF>
__device__ __forceinline__ void conv_run(ITEMF item, int first, int count, float* T) {
    const int tid = opaque_tid();
    f32x4_t ring[CONV_DEPTH][8];
#pragma unroll
    for (int d = 0; d < CONV_DEPTH; ++d) { const ConvItem c = item(first + d); conv_load(c, ring[d], tid); }
    for (int i0 = 0; i0 < count; i0 += CONV_DEPTH) {
#pragma unroll
        for (int d = 0; d < CONV_DEPTH; ++d) {
            const int i = i0 + d;
            const ConvItem c = item(first + i);
            lds_barrier();
            conv_tile_write(ring[d], T, tid);
            lds_barrier();
            if (i + CONV_DEPTH < count) { const ConvItem cn = item(first + i + CONV_DEPTH); conv_load(cn, ring[d], tid); }
            conv_tile_store(c, T, tid);
        }
    }
}
__device__ __forceinline__ void ph_convert_small(const P& p, float* lds) {
    __syncthreads();
    if (blockIdx.x >= 96 && blockIdx.x < 96 + 80) conv_run([&](int it) { return conv_small_item(p, it); }, (blockIdx.x - 96) * 4, 4, lds);
}

__device__ __forceinline__ void ph_norm1(const P& p) {
    const int tid = opaque_tid(), lane = tid & 63, wv = tid >> 6;
    const float* ADA = (const float*)(p.ws + WS_ADA);
    bf16_t* H = (bf16_t*)(p.ws + WS_H);
    bf16_t* HC = (bf16_t*)(p.ws + WS_HC);
    auto rowsrc = [&](int r) { return r < NTOK ? p.x + (size_t)r * D : p.ctx + (size_t)(r - NTOK) * D; };
    for (int rc = blockIdx.x * 8 + wv; rc < (NTOK + NCTX) / 16; rc += gridDim.x * 8) {
        const int rbase = rc * 16, ar = rbase < NTOK ? rbase / SEQ : 16;
        f32x4_t gm[4], hs[4];
#pragma unroll
        for (int j = 0; j < 4; ++j) { const int d4 = lane + 64 * j; const f32x4_t g = ((const f32x4_t*)p.norm1_g)[d4], s1 = ((const f32x4_t*)(ADA + ar * 6144 + 1024))[d4]; gm[j] = g * (1.f + s1); hs[j] = ((const f32x4_t*)(ADA + ar * 6144))[d4]; }
        f32x4_t v[4], vn[4];
#pragma unroll
        for (int j = 0; j < 4; ++j) v[j] = ((const f32x4_t*)rowsrc(rbase))[lane + 64 * j];
        for (int ri = 0; ri < 16; ++ri) {
            const int r = rbase + ri;
            if (ri + 1 < 16) {
#pragma unroll
                for (int j = 0; j < 4; ++j) vn[j] = ((const f32x4_t*)rowsrc(r + 1))[lane + 64 * j];
            }
            bf16_t* dst = r < NTOK ? H + (size_t)r * D : HC + (size_t)(r - NTOK) * D;
            float ss = 0.f;
#pragma unroll
            for (int j = 0; j < 4; ++j) ss += v[j].x * v[j].x + v[j].y * v[j].y + v[j].z * v[j].z + v[j].w * v[j].w;
            const float rstd = rsqrtf(wave_sum(ss) * (1.f / D) + EPS);
#pragma unroll
            for (int j = 0; j < 4; ++j) { const f32x4_t o = v[j] * rstd * gm[j] + hs[j]; ((uint2*)dst)[lane + 64 * j] = make_uint2(cvtpk(o.x, o.y), cvtpk(o.z, o.w)); }
#pragma unroll
            for (int j = 0; j < 4; ++j) v[j] = vn[j];
        }
    }
}
__device__ __forceinline__ void ph_filter(const P& p, float* lds) {
    const int tid = opaque_tid(), G = gridDim.x;
    const float* HID2 = (const float*)(p.ws + WS_HID2);
    float* HF = (float*)((unsigned char*)p.out + DO_HF);
    float* w3c = lds;
    float* red = lds + 512;
    const float min_decay = logf(1e-2f) / 1.5f, max_decay = logf(1e-2f) / 0.3f;
    for (int grp = blockIdx.x; grp < 256; grp += G) {
        const int item0 = grp * 4, o = item0 >> 9, c0 = item0 & 511;
        __syncthreads();
        { const int q = tid >> 7, dir = (tid >> 6) & 1, i = tid & 63; w3c[tid] = p.pos_w3[i * 2048 + o * 1024 + dir * 512 + c0 + q]; }
        __syncthreads();
        float hv[4][4][2]; float asum[4] = {0.f, 0.f, 0.f, 0.f};
#pragma unroll
        for (int j = 0; j < 4; ++j) {
            const int t = tid + NT * j;
            float r[4][2];
#pragma unroll
            for (int q = 0; q < 4; ++q) { r[q][0] = 0.f; r[q][1] = 0.f; }
            const float4* hp = (const float4*)(HID2 + t * 64);
#pragma unroll 4
            for (int i4 = 0; i4 < 16; ++i4) {
                const float4 h = hp[i4];
#pragma unroll
                for (int q = 0; q < 4; ++q)
#pragma unroll
                    for (int d = 0; d < 2; ++d) { const float* w = w3c + (q * 2 + d) * 64 + i4 * 4; r[q][d] += h.x * w[0] + h.y * w[1] + h.z * w[2] + h.w * w[3]; }
            }
            const float tl = (float)t / 2047.0f;
#pragma unroll
            for (int q = 0; q < 4; ++q) {
                const float delta = fabsf(min_decay + (float)(c0 + q) * ((max_decay - min_decay) / 511.0f));
                const float win = expf(-tl * delta) + 0.05f;
                hv[j][q][0] = r[q][0] * win; hv[j][q][1] = r[q][1] * win;
                asum[q] += fabsf(hv[j][q][0]) + (t >= 1 ? fabsf(hv[j][q][1]) : 0.f);
            }
        }
#pragma unroll
        for (int q = 0; q < 4; ++q) asum[q] = wave_sum(asum[q]);
        if ((tid & 63) == 0) { red[(tid >> 6) * 4 + 0] = asum[0]; red[(tid >> 6) * 4 + 1] = asum[1]; red[(tid >> 6) * 4 + 2] = asum[2]; red[(tid >> 6) * 4 + 3] = asum[3]; }
        __syncthreads();
#pragma unroll
        for (int q = 0; q < 4; ++q) {
            float tot = 0.f;
#pragma unroll
            for (int k = 0; k < 8; ++k) tot += red[k * 4 + q];
            const float inv = 1.f / (tot + EPS);
            float* dst = HF + (size_t)(item0 + q) * 4096;
#pragma unroll
            for (int j = 0; j < 4; ++j) {
                const int t = tid + NT * j;
                dst[2047 + t] = hv[j][q][0] * inv;
                if (t >= 1) dst[2047 - t] = hv[j][q][1] * inv;
            }
            if (tid == 0) dst[4095] = 0.f;
        }
    }
}

struct InprojSched {
    int G, c; const bf16_t *WinT, *H, *HC; bf16_t *PHYT, *PHG, *PC;
    __device__ __forceinline__ bool next(int i, Unit& u) const {
        int L = i * G + c; int pm, pn;
        u.aux = nullptr; u.gidx = nullptr; u.row0 = 0; u.col0 = 0;
        if (L < 768) { tile_of(L, 6, 128, pm, pn); u.a = (const char*)(WinT + (size_t)pm * 256 * D); u.b = (const char*)(H + (size_t)pn * 256 * D); u.c = PHYT + (size_t)pm * 256 * NTOK + pn * 256; u.ldc = NTOK; return true; }
        L -= 768;
        if (L < 1280) { tile_of(L, 128, 10, pm, pn); u.a = (const char*)(H + (size_t)pm * 256 * D); u.b = (const char*)(WinT + (size_t)(1536 + pn * 256) * D); u.c = PHG + (size_t)pm * 256 * 2560 + pn * 256; u.ldc = 2560; return true; }
        L -= 1280;
        if (L < 96) { tile_of(L, 16, 6, pm, pn); u.a = (const char*)(HC + (size_t)pm * 256 * D); u.b = (const char*)(WinT + (size_t)(2048 + pn * 256) * D); u.c = PC + (size_t)pm * 256 * 1536 + pn * 256; u.ldc = 1536; return true; }
        return false;
    }
    __device__ __forceinline__ void a_ready(const Unit&) const {}
    __device__ __forceinline__ void done(const Unit&) const {}
};
__device__ __forceinline__ void ph_inproj(const P& p, unsigned char* lds) {
    InprojSched S{(int)gridDim.x, (int)blockIdx.x, (const bf16_t*)((unsigned char*)p.out + DO_WINT), (const bf16_t*)(p.ws + WS_H), (const bf16_t*)(p.ws + WS_HC),
                  (bf16_t*)((unsigned char*)p.out + DO_PHYT), (bf16_t*)(p.ws + WS_PHG), (bf16_t*)(p.ws + WS_PC)};
    pg8::EpiStoreBf16 E;
    pg8::gemm_phase<pg8::EpiStoreBf16, InprojSched, true, true, false>((PG8_LAS unsigned char*)lds, D, S, E);
}

namespace hy {
#define HY_LAS __attribute__((address_space(3)))
typedef short bf16x8 __attribute__((ext_vector_type(8)));
typedef float f32x4 __attribute__((ext_vector_type(4)));
typedef unsigned u32x4 __attribute__((ext_vector_type(4)));
typedef unsigned u32x2 __attribute__((ext_vector_type(2)));
constexpr int U_STRIDE = 4112, UIMG = 0, U_BYTES = 16 * U_STRIDE;
constexpr int FILT = U_BYTES, F_STRIDE = 8288, F_BYTES = 8 * F_STRIDE;
constexpr int SCR = FILT + F_BYTES;
static_assert(SCR + 8192 <= LDS_BYTES, "hyena LDS map");

__device__ __forceinline__ float uni(float v) { return __uint_as_float(__builtin_amdgcn_readfirstlane(__float_as_uint(v))); }
struct ConvW { float w0, w1, w2, b; };
__device__ __forceinline__ ConvW load_convw(const P& p, int ch) { ConvW c; c.w0 = uni(p.hy_conv_w[ch]); c.w1 = uni(p.hy_conv_w[1536 + ch]); c.w2 = uni(p.hy_conv_w[3072 + ch]); c.b = uni(p.hy_conv_b[ch]); return c; }
__device__ __forceinline__ void load_u_image(const ConvW cw, HY_LAS unsigned char* L, const bf16_t* row, int tid) {
    const float cw0 = cw.w0, cw1 = cw.w1, cw2 = cw.w2, cb = cw.b;
#pragma unroll 2
    for (int k = 0; k < 8; ++k) {
        const int idx = tid + NT * k, b = idx >> 8, t8 = (idx & 255) * 8;
        const bf16_t* src = row + b * SEQ + t8;
        const u32x4 raw = *(const u32x4*)src;
        float x[10];
        x[0] = (t8 & 63) ? bf2f(src[-1]) : 0.f;
        x[9] = ((t8 + 8) & 63) ? bf2f(src[8]) : 0.f;
        x[1] = __uint_as_float(raw.x << 16); x[2] = __uint_as_float(raw.x & 0xffff0000u); x[3] = __uint_as_float(raw.y << 16); x[4] = __uint_as_float(raw.y & 0xffff0000u);
        x[5] = __uint_as_float(raw.z << 16); x[6] = __uint_as_float(raw.z & 0xffff0000u); x[7] = __uint_as_float(raw.w << 16); x[8] = __uint_as_float(raw.w & 0xffff0000u);
        float o[8];
#pragma unroll
        for (int e = 0; e < 8; ++e) o[e] = cb + cw1 * x[e + 1] + cw0 * x[e] + cw2 * x[e + 2];
        *(HY_LAS u32x4*)(L + UIMG + b * U_STRIDE + t8 * 2) = (u32x4){pk2(o[0], o[1]), pk2(o[2], o[3]), pk2(o[4], o[5]), pk2(o[6], o[7])};
    }
}
__device__ __forceinline__ void raw_rows_load(u32x4 (&r)[8], const bf16_t* row, int tid) {
#pragma unroll
    for (int k = 0; k < 8; ++k) { const int idx = tid + NT * k, b = idx >> 8, t8 = (idx & 255) * 8; r[k] = *(const u32x4*)(row + b * SEQ + t8); }
}
__device__ __forceinline__ void raw_rows_store(HY_LAS unsigned char* L, const u32x4 (&r)[8], int tid) {
#pragma unroll
    for (int k = 0; k < 8; ++k) {
        const int idx = tid + NT * k, b = idx >> 8, t8 = (idx & 255) * 8;
        HY_LAS unsigned char* d = L + FILT + b * U_STRIDE + 8 + t8 * 2;
        *(HY_LAS u32x2*)d = (u32x2){r[k].x, r[k].y}; *(HY_LAS u32x2*)(d + 8) = (u32x2){r[k].z, r[k].w};
    }
}
__device__ __forceinline__ void load_filter_scr(HY_LAS unsigned char* L, const float* hf, int tid) {
    const float4 a = ((const float4*)hf)[tid * 2], b = ((const float4*)hf)[tid * 2 + 1];
    *(HY_LAS u32x4*)(L + SCR + tid * 16) = (u32x4){pk2(a.x, a.y), pk2(a.z, a.w), pk2(b.x, b.y), pk2(b.z, b.w)};
}
__device__ __forceinline__ void build_filter_copies(HY_LAS unsigned char* L, int tid) {
    const HY_LAS bf16_t* sc = (const HY_LAS bf16_t*)(L + SCR);
    for (int gi = tid; gi < 8 * 518; gi += NT) {
        const int d = gi / 518, qg = gi - d * 518;
        const int top = 4095 + d - 8 * qg;
        unsigned v[8];
#pragma unroll
        for (int e = 0; e < 8; ++e) { const int ix = top - e; v[e] = (ix >= 0 && ix <= 4094) ? (unsigned)sc[ix] : 0u; }
        *(HY_LAS u32x4*)(L + FILT + d * F_STRIDE + qg * 16) = (u32x4){v[0] | (v[1] << 16), v[2] | (v[3] << 16), v[4] | (v[5] << 16), v[6] | (v[7] << 16)};
    }
}
__device__ __forceinline__ void conv_loop(HY_LAS unsigned char* L, f32x4 (&acc)[16], int w, int lane) {
    const int i = lane & 15, g = lane >> 4;
    const HY_LAS unsigned char* aBase = L + FILT + (i & 7) * F_STRIDE + 2 * (2048 + 8 * g - (i & ~7)) - 32 * (16 * w);
    const HY_LAS unsigned char* bBase = L + UIMG + i * U_STRIDE + 16 * g;
    bf16x8 ring[16];
#pragma unroll
    for (int s = 0; s < 16; ++s) ring[s] = *(const HY_LAS bf16x8*)(aBase - 32 * s);
#pragma unroll
    for (int m = 0; m < 16; ++m) acc[m] = (f32x4){0.f, 0.f, 0.f, 0.f};
    bf16x8 bfrag = *(const HY_LAS bf16x8*)(bBase);
    for (int k8 = 0; k8 < 8; ++k8) {
        const HY_LAS unsigned char* aK = aBase + 512 * k8;
        const HY_LAS unsigned char* bK = bBase + 512 * k8;
#pragma unroll
        for (int u = 0; u < 8; ++u) {
            bf16x8 bnext = bfrag;
            if (u < 7 || k8 < 7) bnext = *(const HY_LAS bf16x8*)(bK + 64 * (u + 1));
            acc[14] = __builtin_amdgcn_mfma_f32_16x16x32_bf16(ring[(14 - 2 * u) & 15], bfrag, acc[14], 0, 0, 0);
            acc[15] = __builtin_amdgcn_mfma_f32_16x16x32_bf16(ring[(15 - 2 * u) & 15], bfrag, acc[15], 0, 0, 0);
            if (u < 7 || k8 < 7) {
                ring[(14 - 2 * u) & 15] = *(const HY_LAS bf16x8*)(aK + 64 * u + 64);
                ring[(15 - 2 * u) & 15] = *(const HY_LAS bf16x8*)(aK + 64 * u + 32);
            }
#pragma unroll
            for (int m = 0; m < 14; ++m) acc[m] = __builtin_amdgcn_mfma_f32_16x16x32_bf16(ring[(m - 2 * u) & 15], bfrag, acc[m], 0, 0, 0);
            bfrag = bnext;
            __builtin_amdgcn_sched_barrier(0);
        }
    }
}
__device__ __forceinline__ void gate_acc(const ConvW cw, HY_LAS unsigned char* L, f32x4 (&acc)[16], float bias, int w, int lane) {
    const int j = lane & 15, g = lane >> 4;
    const float cw0 = cw.w0, cw1 = cw.w1, cw2 = cw.w2, cb = cw.b;
#pragma unroll
    for (int m = 0; m < 16; ++m) {
        const int t4 = 256 * w + 16 * m + 4 * g, tt0 = t4 & 63;
        const u32x2 uu = *(const HY_LAS u32x2*)(L + UIMG + j * U_STRIDE + t4 * 2);
        const HY_LAS unsigned char* xb = L + FILT + j * U_STRIDE + 8 + t4 * 2;
        const u32x2 xx = *(const HY_LAS u32x2*)xb;
        const float xl = tt0 > 0 ? bf2f(*(const HY_LAS bf16_t*)(xb - 2)) : 0.f;
        const float xr = tt0 < 60 ? bf2f(*(const HY_LAS bf16_t*)(xb + 8)) : 0.f;
        const float x0 = __uint_as_float(xx.x << 16), x1 = __uint_as_float(xx.x & 0xffff0000u), x2 = __uint_as_float(xx.y << 16), x3 = __uint_as_float(xx.y & 0xffff0000u);
        const float u0 = __uint_as_float(uu.x << 16), u1 = __uint_as_float(uu.x & 0xffff0000u), u2 = __uint_as_float(uu.y << 16), u3 = __uint_as_float(uu.y & 0xffff0000u);
        const float g0 = cb + cw1 * x0 + cw0 * xl + cw2 * x1, g1 = cb + cw1 * x1 + cw0 * x0 + cw2 * x2, g2 = cb + cw1 * x2 + cw0 * x1 + cw2 * x3, g3 = cb + cw1 * x3 + cw0 * x2 + cw2 * xr;
        acc[m][0] = g0 * (acc[m][0] + bias * u0); acc[m][1] = g1 * (acc[m][1] + bias * u1); acc[m][2] = g2 * (acc[m][2] + bias * u2); acc[m][3] = g3 * (acc[m][3] + bias * u3);
        if ((m & 3) == 3) __builtin_amdgcn_sched_barrier(0);
    }
}
__device__ __forceinline__ void store_acc_uimg(HY_LAS unsigned char* L, const f32x4 (&acc)[16], int w, int lane) {
    const int j = lane & 15, g = lane >> 4;
#pragma unroll
    for (int m = 0; m < 16; ++m) {
        const int t4 = 256 * w + 16 * m + 4 * g;
        *(HY_LAS u32x2*)(L + UIMG + j * U_STRIDE + t4 * 2) = (u32x2){pk2(acc[m][0], acc[m][1]), pk2(acc[m][2], acc[m][3])};
    }
}
}

__device__ __forceinline__ void ph_hyena_task(const P& p, unsigned char* ldsb, int c) {
    const int w = __builtin_amdgcn_readfirstlane(threadIdx.x >> 6);
    const bf16_t* PHYT = (const bf16_t*)((unsigned char*)p.out + DO_PHYT);
    bf16_t* YT = (bf16_t*)(p.ws + WS_YT);
    const float* HF = (const float*)((unsigned char*)p.out + DO_HF);
    HY_LAS unsigned char* L = (HY_LAS unsigned char*)ldsb;
    {
        const int tid = opaque_tid();
        const int lane = tid & 63;
        hy::f32x4 acc[16];
        const hy::ConvW cwv = hy::load_convw(p, c), cwx1 = hy::load_convw(p, 512 + c), cwx2 = hy::load_convw(p, 1024 + c);
        const float bias0 = hy::uni(p.hy_bias[c]), bias1 = hy::uni(p.hy_bias[512 + c]);
        __syncthreads();
        hy::load_u_image(cwv, L, PHYT + (size_t)c * NTOK, tid);
        hy::load_filter_scr(L, HF + (size_t)c * 4096, tid);
        __syncthreads();
        hy::build_filter_copies(L, tid);
        __syncthreads();
        hy::u32x4 rawx[8];
        hy::raw_rows_load(rawx, PHYT + (size_t)(512 + c) * NTOK, tid);
        hy::load_filter_scr(L, HF + (size_t)(512 + c) * 4096, tid);
        hy::conv_loop(L, acc, w, lane);
        __syncthreads();
        hy::raw_rows_store(L, rawx, tid);
        __syncthreads();
        hy::gate_acc(cwx1, L, acc, bias0, w, lane);
        __syncthreads();
        hy::store_acc_uimg(L, acc, w, lane);
        hy::build_filter_copies(L, tid);
        __syncthreads();
        hy::raw_rows_load(rawx, PHYT + (size_t)(1024 + c) * NTOK, tid);
        hy::conv_loop(L, acc, w, lane);
        __syncthreads();
        hy::raw_rows_store(L, rawx, tid);
        __syncthreads();
        hy::gate_acc(cwx2, L, acc, bias1, w, lane);
        hy::store_acc_uimg(L, acc, w, lane);
        __syncthreads();
#pragma unroll 2
        for (int k = 0; k < 8; ++k) {
            const int idx = tid + NT * k, b = idx >> 8, t8 = (idx & 255) * 8;
            *(hy::u32x4*)(YT + (size_t)c * NTOK + b * SEQ + t8) = *(const HY_LAS hy::u32x4*)(L + hy::UIMG + b * hy::U_STRIDE + t8 * 2);
        }
    }
}


namespace hg {
#define HG_LAS __attribute__((address_space(3)))
typedef short bf16x8 __attribute__((ext_vector_type(8)));
typedef float f32x4 __attribute__((ext_vector_type(4)));
typedef unsigned u32x4 __attribute__((ext_vector_type(4)));
typedef unsigned u32x2 __attribute__((ext_vector_type(2)));
constexpr int QROW = 272, KROW = 40;
constexpr int O_QT = 0, O_KBAR = 16 * QROW, O_KHAT = 2 * 16 * QROW, O_VT = O_KHAT + 128 * KROW, O_BDEC = O_VT + 128 * KROW, SET_BYTES = O_BDEC + 512;
constexpr int NCH_CTX = CTXL / 16, NCH = NCH_CTX + SEQ / 16;
template <int CTRL> __device__ __forceinline__ float dpp_mul(float x) {
    return x * __uint_as_float(__builtin_amdgcn_update_dpp(0x3f800000u, __float_as_uint(x), CTRL, 0xf, 0xf, false));
}
struct Raw { unsigned short q[4], v[4], z[4]; };
}

__device__ __forceinline__ void ph_hgrn_task(const P& p, unsigned char* ldsb, int item) {
    using namespace hg;
    const int tid = opaque_tid();
    const int lane = tid & 63, w = __builtin_amdgcn_readfirstlane(tid >> 6), j = lane & 15, g = lane >> 4;
    const int dir = item & 1, h = (item >> 1) & 3, b = item >> 3;
    const float* LB = (const float*)(p.ws + WS_LB);
    const bf16_t* PC = (const bf16_t*)(p.ws + WS_PC);
    const bf16_t* PHG = (const bf16_t*)(p.ws + WS_PHG);
    bf16_t* OFB = (bf16_t*)(p.ws + WS_OFB) + (size_t)dir * NTOK * 512;
    HG_LAS unsigned char* L = (HG_LAS unsigned char*)ldsb;
    float lb0[2], lb1[2];
#pragma unroll
    for (int pp = 0; pp < 2; ++pp) { const float2 t = *(const float2*)(LB + dir * 512 + h * 128 + 16 * w + 8 * pp + 2 * g); lb0[pp] = t.x; lb1[pp] = t.y; }
    const int zoff_c = dir == 0 ? 512 : 1024, zoff_l = dir == 0 ? 1024 : 1536;
    const bf16_t* rowc = PC + (size_t)b * CTXL * 1536 + h * 128 + 16 * w + 2 * g;
    const bf16_t* rowl = PHG + (size_t)b * SEQ * 2560 + h * 128 + 16 * w + 2 * g;
    struct Raw2 { unsigned q[2], v[2], z[2]; };
    auto load_raw = [&](int n, Raw2& r) {
        if (n < NCH_CTX) {
            const int tt = 16 * n + j, t = dir == 0 ? tt : (CTXL - 1 - tt);
            const bf16_t* row = rowc + (size_t)t * 1536;
#pragma unroll
            for (int pp = 0; pp < 2; ++pp) { r.q[pp] = 0u; r.v[pp] = *(const unsigned*)(row + 8 * pp); r.z[pp] = *(const unsigned*)(row + zoff_c + 8 * pp); }
        } else {
            const int tt = 16 * (n - NCH_CTX) + j, t = dir == 0 ? tt : (SEQ - 1 - tt);
            const bf16_t* row = rowl + (size_t)t * 2560;
#pragma unroll
            for (int pp = 0; pp < 2; ++pp) { r.q[pp] = *(const unsigned*)(row + 8 * pp); r.v[pp] = *(const unsigned*)(row + 512 + 8 * pp); r.z[pp] = *(const unsigned*)(row + zoff_l + 8 * pp); }
        }
    };
    const int qoff = j * QROW + 2 * (16 * w + 2 * g), koff = (16 * w + 2 * g) * KROW + 2 * j;
    auto prep_pass = [&](const Raw2& r, HG_LAS unsigned char* S0, const int pp) {
        {
            const float za = __uint_as_float(r.z[pp] << 16), zb = __uint_as_float(r.z[pp] & 0xffff0000u);
            const float qa = __uint_as_float(r.q[pp] << 16), qb = __uint_as_float(r.q[pp] & 0xffff0000u);
            const float fa = lb0[pp] + (1.0f - lb0[pp]) * __builtin_amdgcn_rcpf(1.0f + __builtin_amdgcn_exp2f(-1.4426950408889634f * za));
            const float fb = lb1[pp] + (1.0f - lb1[pp]) * __builtin_amdgcn_rcpf(1.0f + __builtin_amdgcn_exp2f(-1.4426950408889634f * zb));
            float Pa = dpp_mul<0x111>(fa), Pb = dpp_mul<0x111>(fb);
            Pa = dpp_mul<0x112>(Pa); Pb = dpp_mul<0x112>(Pb); Pa = dpp_mul<0x114>(Pa); Pb = dpp_mul<0x114>(Pb); Pa = dpp_mul<0x118>(Pa); Pb = dpp_mul<0x118>(Pb);
            const float Ca = __uint_as_float(__builtin_amdgcn_ds_bpermute(4 * (lane | 15), __float_as_uint(Pa)));
            const float Cb = __uint_as_float(__builtin_amdgcn_ds_bpermute(4 * (lane | 15), __float_as_uint(Pb)));
            const float ia = __builtin_amdgcn_rcpf(fmaxf(Pa, 1e-30f)), ib = __builtin_amdgcn_rcpf(fmaxf(Pb, 1e-30f));
            const float ka = (1.0f - fa) * ia, kb = (1.0f - fb) * ib;
            const float qva = qa * __builtin_amdgcn_rcpf(1.0f + __builtin_amdgcn_exp2f(-1.4426950408889634f * qa)) * (0.08838834764831845f * Pa);
            const float qvb = qb * __builtin_amdgcn_rcpf(1.0f + __builtin_amdgcn_exp2f(-1.4426950408889634f * qb)) * (0.08838834764831845f * Pb);
            *(HG_LAS unsigned*)(S0 + O_QT + qoff + 16 * pp) = cvtpk(qva, qvb);
            *(HG_LAS unsigned*)(S0 + O_KBAR + qoff + 16 * pp) = cvtpk(ka, kb);
            const unsigned kh = cvtpk(ka * Ca, kb * Cb);
            *(HG_LAS bf16_t*)(S0 + O_KHAT + koff + 8 * pp * KROW) = (bf16_t)(kh & 0xffffu);
            *(HG_LAS bf16_t*)(S0 + O_KHAT + koff + (8 * pp + 1) * KROW) = (bf16_t)(kh >> 16);
            *(HG_LAS bf16_t*)(S0 + O_VT + koff + 8 * pp * KROW) = (bf16_t)(r.v[pp] & 0xffffu);
            *(HG_LAS bf16_t*)(S0 + O_VT + koff + (8 * pp + 1) * KROW) = (bf16_t)(r.v[pp] >> 16);
            if (j == 15) { typedef float f32x2_t __attribute__((ext_vector_type(2))); *(HG_LAS f32x2_t*)(S0 + O_BDEC + 4 * (16 * w + 8 * pp + 2 * g)) = (f32x2_t){Pa, Pb}; }
        }
    };
    auto prep = [&](const Raw2& r, HG_LAS unsigned char* S0) { prep_pass(r, S0, 0); prep_pass(r, S0, 1); };
    const float mk0 = (4 * g + 0) <= j ? 1.f : 0.f, mk1 = (4 * g + 1) <= j ? 1.f : 0.f, mk2 = (4 * g + 2) <= j ? 1.f : 0.f, mk3 = (4 * g + 3) <= j ? 1.f : 0.f;
    const int sc_off = j * QROW + 16 * g, vt_off = (16 * w + j) * KROW + 8 * g, qt8_off = j * QROW + 8 * g, kh_off = j * KROW + 8 * g;
    bf16_t* orow = OFB + (size_t)b * SEQ * 512 + h * 128 + 16 * w + 4 * g;
    f32x4 S[8];
#pragma unroll
    for (int t = 0; t < 8; ++t) S[t] = (f32x4){0.f, 0.f, 0.f, 0.f};
    constexpr int RDEPTH = 4;
    static_assert(NCH % RDEPTH == 0, "chunk loop is unrolled by the prefetch depth");
    Raw2 ring[RDEPTH];
    load_raw(0, ring[0]);
    __syncthreads();
    prep(ring[0], L);
#pragma unroll
    for (int c = 1; c <= RDEPTH; ++c) load_raw(c, ring[c % RDEPTH]);
    __syncthreads();
    auto chunk = [&](int n, int phase, Raw2& slot) {
        HG_LAS unsigned char* Sc = L + (n & 1) * SET_BYTES;
        HG_LAS unsigned char* Sn = L + ((n + 1) & 1) * SET_BYTES;
        bf16x8 kaf[4], qaf[4]; u32x2 qb0[4], qb1[4], krf[8]; f32x4 bdf[8];
#pragma unroll
        for (int kp = 0; kp < 4; ++kp) { kaf[kp] = *(const HG_LAS bf16x8*)(Sc + O_KBAR + sc_off + 64 * kp); qaf[kp] = *(const HG_LAS bf16x8*)(Sc + O_QT + sc_off + 64 * kp); }
        const u32x2 vraw = *(const HG_LAS u32x2*)(Sc + O_VT + vt_off);
#pragma unroll
        for (int pq = 0; pq < 4; ++pq) { qb0[pq] = *(const HG_LAS u32x2*)(Sc + O_QT + qt8_off + 64 * pq); qb1[pq] = *(const HG_LAS u32x2*)(Sc + O_QT + qt8_off + 64 * pq + 32); }
#pragma unroll
        for (int t = 0; t < 8; ++t) { bdf[t] = *(const HG_LAS f32x4*)(Sc + O_BDEC + 64 * t + 16 * g); krf[t] = *(const HG_LAS u32x2*)(Sc + O_KHAT + kh_off + 16 * KROW * t); }
        __builtin_amdgcn_sched_barrier(0);
        const u32x4 vf = (u32x4){vraw.x, vraw.y, 0u, 0u};
        f32x4 sc = (f32x4){0.f, 0.f, 0.f, 0.f};
#pragma unroll
        for (int kp = 0; kp < 4; ++kp) sc = __builtin_amdgcn_mfma_f32_16x16x32_bf16(kaf[kp], qaf[kp], sc, 0, 0, 0);
        f32x4 oT = (f32x4){0.f, 0.f, 0.f, 0.f};
#pragma unroll
        for (int pq = 0; pq < 4; ++pq) {
            u32x4 a; a.x = cvtpk(S[2 * pq][0], S[2 * pq][1]); a.y = cvtpk(S[2 * pq][2], S[2 * pq][3]); a.z = cvtpk(S[2 * pq + 1][0], S[2 * pq + 1][1]); a.w = cvtpk(S[2 * pq + 1][2], S[2 * pq + 1][3]);
            const u32x4 bb = (u32x4){qb0[pq].x, qb0[pq].y, qb1[pq].x, qb1[pq].y};
            oT = __builtin_amdgcn_mfma_f32_16x16x32_bf16(__builtin_bit_cast(bf16x8, a), __builtin_bit_cast(bf16x8, bb), oT, 0, 0, 0);
        }
#pragma unroll
        for (int t = 0; t < 8; ++t) {
            const u32x4 ka = (u32x4){krf[t].x, krf[t].y, 0u, 0u};
            S[t] = __builtin_amdgcn_mfma_f32_16x16x32_bf16(__builtin_bit_cast(bf16x8, ka), __builtin_bit_cast(bf16x8, vf), S[t] * bdf[t], 0, 0, 0);
        }
        u32x4 pf;
        pf.x = cvtpk(sc[0] * mk0, sc[1] * mk1); pf.y = cvtpk(sc[2] * mk2, sc[3] * mk3); pf.z = 0u; pf.w = 0u;
        oT = __builtin_amdgcn_mfma_f32_16x16x32_bf16(__builtin_bit_cast(bf16x8, vf), __builtin_bit_cast(bf16x8, pf), oT, 0, 0, 0);
        if (n + 1 < NCH) prep(slot, Sn);
        if (n + 1 + RDEPTH < NCH) load_raw(n + 1 + RDEPTH, slot);
        if (n >= NCH_CTX) {
            const int tt = 16 * (n - NCH_CTX) + j, t = dir == 0 ? tt : (SEQ - 1 - tt);
            *(u32x2*)(orow + (size_t)t * 512) = (u32x2){cvtpk(oT[0], oT[1]), cvtpk(oT[2], oT[3])};
        }
        lds_barrier();
    };
    for (int n0 = 0; n0 < NCH; n0 += RDEPTH) {
#pragma unroll
        for (int u = 0; u < RDEPTH; ++u) chunk(n0 + u, u % 3, ring[(u + 1) % RDEPTH]);
    }
}

template <int QW = 0, bool DO_HGRN = true, bool DO_QUEUE = true, bool DO_HY = true, bool DO_CV = true>
__device__ __forceinline__ void ph_mixers(const P& p, unsigned char* ldsb) {
    unsigned* qhead = (unsigned*)(p.ws + WS_CTL) + CW_QHEAD + QW;
    HG_LAS unsigned* bc = (HG_LAS unsigned*)(ldsb + LDS_BYTES - 16);
    if (DO_HGRN && blockIdx.x < NB * HEADS * 2) ph_hgrn_task(p, ldsb, blockIdx.x);
    constexpr int N_CONV_WG = 48, ITEMS_PER_WG = N_EXPERT_ITEMS / N_CONV_WG;
    static_assert(N_EXPERT_ITEMS % N_CONV_WG == 0 && ITEMS_PER_WG % CONV_DEPTH == 0, "conversion split");
    if (DO_CV && blockIdx.x >= NB * HEADS * 2 && blockIdx.x < NB * HEADS * 2 + N_CONV_WG)
        conv_run([&](int r) { return conv_expert_item(p, r); }, (blockIdx.x - NB * HEADS * 2) * ITEMS_PER_WG, ITEMS_PER_WG, (float*)ldsb);
    if (!DO_QUEUE) return;
    for (;;) {
        __syncthreads();
        if (threadIdx.x == 0) *bc = atomicAdd(qhead, 1u);
        __syncthreads();
        const int c = (int)*bc;
        if (c >= 512) break;
        if (DO_HY) ph_hyena_task(p, ldsb, c);
    }
}

__device__ __forceinline__ void ph_mixprep(const P& p, float* lds) {
    const int tid = opaque_tid(), lane = tid & 63, wv = tid >> 6;
    const bf16_t* YT = (const bf16_t*)(p.ws + WS_YT);
    bf16_t* MIXA = (bf16_t*)(p.ws + WS_MIXA);
    bf16_t* yl = (bf16_t*)lds;
    float* part = lds + (512 * 72 * 2) / 4;
    for (int tile = blockIdx.x; tile < NTOK / 64; tile += gridDim.x) {
        const int tok0 = tile * 64;
        __syncthreads();
        for (int i = tid; i < 512 * 8; i += NT) { const int row = i >> 3, ch = i & 7; *(uint4*)(yl + row * 72 + ch * 8) = *(const uint4*)(YT + (size_t)row * NTOK + tok0 + ch * 8); }
        __syncthreads();
        const int tok = tid & 63, pt = tid >> 6;
        float ss = 0.f;
        for (int c = pt * 64; c < pt * 64 + 64; ++c) { const float v = bf2f(yl[c * 72 + tok]); ss += v * v; }
        part[pt * 64 + tok] = ss;
        __syncthreads();
        float tot = 0.f;
#pragma unroll
        for (int k = 0; k < 8; ++k) tot += part[k * 64 + tok];
        const float rstd = rsqrtf(tot * (1.f / 512.f) + EPS);
        bf16_t* dst = MIXA + (size_t)(tok0 + tok) * D + pt * 64;
#pragma unroll
        for (int j = 0; j < 8; ++j) {
            float o[8];
#pragma unroll
            for (int q = 0; q < 8; ++q) { const int c = pt * 64 + j * 8 + q; o[q] = bf2f(yl[c * 72 + tok]) * rstd * p.hy_norm_g[c]; }
            *(uint4*)(dst + j * 8) = make_uint4(pk2(o[0], o[1]), pk2(o[2], o[3]), pk2(o[4], o[5]), pk2(o[6], o[7]));
        }
    }
    const bf16_t* OFB = (const bf16_t*)(p.ws + WS_OFB);
    const bf16_t* PHG = (const bf16_t*)(p.ws + WS_PHG);
    for (int r = blockIdx.x * 8 + wv; r < NTOK; r += gridDim.x * 8) {
#pragma unroll
        for (int h = 0; h < HEADS; ++h) {
            const int k = lane * 2;
            const unsigned a = *(const unsigned*)(OFB + (size_t)r * 512 + h * 128 + k);
            const unsigned bq = *(const unsigned*)(OFB + (size_t)NTOK * 512 + (size_t)r * 512 + h * 128 + k);
            const float o0 = __uint_as_float(a << 16) + __uint_as_float(bq << 16), o1 = __uint_as_float(a & 0xffff0000u) + __uint_as_float(bq & 0xffff0000u);
            const float ss = wave_sum(o0 * o0 + o1 * o1);
            const float rstd = rsqrtf(ss * (1.f / 128.f) + EPS);
            const unsigned g = *(const unsigned*)(PHG + (size_t)r * 2560 + 2048 + h * 128 + k);
            const float2 ng = *(const float2*)(p.hg_norm_g + k);
            *(unsigned*)(MIXA + (size_t)r * D + 512 + h * 128 + k) = pk2(o0 * rstd * ng.x * siluf_(__uint_as_float(g << 16)), o1 * rstd * ng.y * siluf_(__uint_as_float(g & 0xffff0000u)));
        }
    }
}

struct OutprojSched {
    int G, c; const bf16_t *A, *Bt;
    __device__ __forceinline__ bool next(int i, Unit& u) const {
        const int L = i * G + c; if (L >= 512) return false; int pm, pn; tile_of(L, 128, 4, pm, pn);
        u.a = (const char*)(A + (size_t)pm * 256 * D); u.b = (const char*)(Bt + (size_t)pn * 256 * D); u.c = nullptr; u.aux = nullptr; u.gidx = nullptr; u.ldc = D; u.row0 = pm * 256; u.col0 = pn * 256; return true;
    }
    __device__ __forceinline__ void a_ready(const Unit&) const {}
    __device__ __forceinline__ void done(const Unit&) const {}
};
__device__ __forceinline__ void ph_outproj(const P& p, unsigned char* lds) {
    OutprojSched S{(int)gridDim.x, (int)blockIdx.x, (const bf16_t*)(p.ws + WS_MIXA), (const bf16_t*)(p.ws + WS_WOUTT)};
    pg8::EpiOutProj E{p.x, (const float*)(p.ws + WS_ADA), (bf16_t*)p.out};
    pg8::gemm_phase<pg8::EpiOutProj, OutprojSched, true, true, false>((PG8_LAS unsigned char*)lds, D, S, E);
}

__device__ __forceinline__ void ph_norm2_router(const P& p, float* lds) {
    const int tid = opaque_tid(), lane = tid & 63, wv = tid >> 6;
    const float* ADA = (const float*)(p.ws + WS_ADA);
    const bf16_t* X1 = (const bf16_t*)p.out;
    bf16_t* H2 = (bf16_t*)(p.ws + WS_H2);
    float* AFF = (float*)(p.ws + WS_AFF);
    __syncthreads();
    for (int i = tid; i < D * 4; i += NT) { const int d = i >> 2, e4 = i & 3; const float4 w = ((const float4*)p.router_w)[i];
        lds[(e4 * 4 + 0) * D + d] = w.x; lds[(e4 * 4 + 1) * D + d] = w.y; lds[(e4 * 4 + 2) * D + d] = w.z; lds[(e4 * 4 + 3) * D + d] = w.w; }
    __syncthreads();
    auto ldrow = [&](int r, f32x4_t (&d)[4]) {
#pragma unroll
        for (int j = 0; j < 4; ++j) { const uint2 w = ((const uint2*)(X1 + (size_t)r * (2 * D)))[lane + 64 * j]; d[j] = (f32x4_t){__uint_as_float(w.x << 16), __uint_as_float(w.x & 0xffff0000u), __uint_as_float(w.y << 16), __uint_as_float(w.y & 0xffff0000u)}; }
    };
    for (int rc = blockIdx.x * 8 + wv; rc < NTOK / 16; rc += gridDim.x * 8) {
      const int rbase = rc * 16, b = rbase / SEQ;
      f32x4_t gm[4], hs[4];
#pragma unroll
      for (int j = 0; j < 4; ++j) { const int d4 = lane + 64 * j; const f32x4_t g = ((const f32x4_t*)p.norm2_g)[d4], s1 = ((const f32x4_t*)(ADA + b * 6144 + 4096))[d4]; gm[j] = g * (1.f + s1); hs[j] = ((const f32x4_t*)(ADA + b * 6144 + 3072))[d4]; }
      f32x4_t v[4], vn[4];
      ldrow(rbase, v);
      for (int ri = 0; ri < 16; ++ri) {
        const int r = rbase + ri, t = r % SEQ;
        if (ri + 1 < 16) ldrow(r + 1, vn);
        float ss = 0.f;
#pragma unroll
        for (int j = 0; j < 4; ++j) ss += v[j].x * v[j].x + v[j].y * v[j].y + v[j].z * v[j].z + v[j].w * v[j].w;
        const float rstd = rsqrtf(wave_sum(ss) * (1.f / D) + EPS);
        float lg[16];
#pragma unroll
        for (int e = 0; e < 16; ++e) lg[e] = 0.f;
#pragma unroll
        for (int j = 0; j < 4; ++j) {
            const int d4 = lane + 64 * j;
            const f32x4_t o = v[j] * rstd * gm[j] + hs[j];
            ((uint2*)(H2 + (size_t)r * D))[d4] = make_uint2(cvtpk(o.x, o.y), cvtpk(o.z, o.w));
#pragma unroll
            for (int e = 0; e < 16; ++e) {
                const float4 w = *(const float4*)&lds[e * D + d4 * 4];
                lg[e] += o.x * w.x + o.y * w.y + o.z * w.z + o.w * w.w;
            }
            __builtin_amdgcn_sched_barrier(0);
        }
#pragma unroll
        for (int i = 0; i < 8; ++i) { const bool hi = lane & 1; const float keep = hi ? lg[2 * i + 1] : lg[2 * i], send = hi ? lg[2 * i] : lg[2 * i + 1]; lg[i] = keep + __shfl_xor(send, 1); }
#pragma unroll
        for (int i = 0; i < 4; ++i) { const bool hi = lane & 2; const float keep = hi ? lg[2 * i + 1] : lg[2 * i], send = hi ? lg[2 * i] : lg[2 * i + 1]; lg[i] = keep + __shfl_xor(send, 2); }
#pragma unroll
        for (int i = 0; i < 2; ++i) { const bool hi = lane & 4; const float keep = hi ? lg[2 * i + 1] : lg[2 * i], send = hi ? lg[2 * i] : lg[2 * i + 1]; lg[i] = keep + __shfl_xor(send, 4); }
        { const bool hi = lane & 8; const float keep = hi ? lg[1] : lg[0], send = hi ? lg[0] : lg[1]; lg[0] = keep + __shfl_xor(send, 8); }
        float lgt = lg[0];
        lgt += __shfl_xor(lgt, 16); lgt += __shfl_xor(lgt, 32);
        float mx = lgt;
        mx = fmaxf(mx, __shfl_xor(mx, 1)); mx = fmaxf(mx, __shfl_xor(mx, 2)); mx = fmaxf(mx, __shfl_xor(mx, 4)); mx = fmaxf(mx, __shfl_xor(mx, 8));
        const float ex = expf(lgt - mx);
        float den = ex;
        den += __shfl_xor(den, 1); den += __shfl_xor(den, 2); den += __shfl_xor(den, 4); den += __shfl_xor(den, 8);
        if (lane < 16) AFF[((size_t)b * 16 + lane) * SEQ + t] = ex / den;
#pragma unroll
        for (int j = 0; j < 4; ++j) v[j] = vn[j];
      }
    }
}

__device__ __forceinline__ void ph_topk(const P& p, float* lds) {
    const int tid = opaque_tid(), lane = tid & 63, wv = tid >> 6;
    const float* AFF = (const float*)(p.ws + WS_AFF);
    int* IDX = (int*)(p.ws + WS_IDX);
    float* GATE = (float*)(p.ws + WS_GATE);
    int* INV = (int*)(p.ws + WS_INV);
    unsigned* hist = (unsigned*)lds;
    unsigned* ctl = hist + 256;
    unsigned* wtot = hist + 272;
    for (int item = blockIdx.x; item < NB * NE; item += gridDim.x) {
        const int b = item >> 4, e = item & 15;
        const uint4 kk = ((const uint4*)(AFF + (size_t)item * SEQ))[tid];
        const unsigned key[4] = {kk.x, kk.y, kk.z, kk.w};
        unsigned prefix = 0u, need = CAP;
#pragma unroll
        for (int pass = 3; pass >= 0; --pass) {
            __syncthreads();
            if (tid < 256) hist[tid] = 0u;
            __syncthreads();
#pragma unroll
            for (int q = 0; q < 4; ++q) {
                const bool in = (pass == 3) || ((key[q] >> (8 * (pass + 1))) == prefix);
                if (in) atomicAdd(&hist[(key[q] >> (8 * pass)) & 255u], 1u);
            }
            __syncthreads();
            if (wv == 0) {
                const uint4 h4 = ((const uint4*)hist)[lane];
                const unsigned loc = h4.x + h4.y + h4.z + h4.w;
                unsigned suf = loc;
#pragma unroll
                for (int o = 1; o < 64; o <<= 1) { const unsigned y = __shfl_down(suf, o); if (lane + o < 64) suf += y; }
                const unsigned above = suf - loc;
                unsigned c3 = above + h4.w, c2 = c3 + h4.z, c1 = c2 + h4.y, c0 = c1 + h4.x;
                int bin = -1; unsigned nneed = 0u;
                if (above < need && c0 >= need) {
                    if (c3 >= need) { bin = 4 * lane + 3; nneed = need - above; }
                    else if (c2 >= need) { bin = 4 * lane + 2; nneed = need - c3; }
                    else if (c1 >= need) { bin = 4 * lane + 1; nneed = need - c2; }
                    else { bin = 4 * lane; nneed = need - c1; }
                    ctl[0] = (prefix << 8) | (unsigned)bin; ctl[1] = nneed;
                }
            }
            __syncthreads();
            prefix = ctl[0]; need = ctl[1];
        }
        unsigned cgt = 0u, ceq = 0u;
#pragma unroll
        for (int q = 0; q < 4; ++q) { cgt += key[q] > prefix ? 1u : 0u; ceq += key[q] == prefix ? 1u : 0u; }
        unsigned sgt = cgt, seq = ceq;
#pragma unroll
        for (int o = 1; o < 64; o <<= 1) { const unsigned y1 = __shfl_up(sgt, o), y2 = __shfl_up(seq, o); if (lane >= o) { sgt += y1; seq += y2; } }
        if (lane == 63) { wtot[wv] = sgt; wtot[8 + wv] = seq; }
        __syncthreads();
        unsigned bgt = 0u, beq = 0u, ngt = 0u;
#pragma unroll
        for (int k = 0; k < 8; ++k) { const unsigned a = wtot[k], c = wtot[8 + k]; if (k < wv) { bgt += a; beq += c; } ngt += a; }
        unsigned rgt = bgt + sgt - cgt, req = beq + seq - ceq;
#pragma unroll
        for (int q = 0; q < 4; ++q) {
            const int t = 4 * tid + q; int slot = -1;
            if (key[q] > prefix) { slot = (int)rgt; ++rgt; }
            else if (key[q] == prefix) { if (req < need) slot = (int)(ngt + req); ++req; }
            if (slot >= 0) { IDX[item * CAP + slot] = t; GATE[item * CAP + slot] = __uint_as_float(key[q]); }
            INV[((size_t)b * SEQ + t) * 16 + e] = slot;
        }
    }
}

struct MoeUpSched {
    int G, c, round; const bf16_t *H2, *W13T; bf16_t* HMID; const int* IDX;
    __device__ __forceinline__ bool next(int i, Unit& u) const {
        if (i >= 4 || c >= 256) return false;
        const int x = c & 7, q = c >> 3, Q = q >> 2, mth = q & 3, item = (Q * 4 + round) * 8 + x, b = item >> 4, e = item & 15, nt = 4 * i + mth;
        u.a = (const char*)(H2 + (size_t)b * SEQ * D); u.b = (const char*)(W13T + ((size_t)e * 4096 + nt * 256) * D); u.c = HMID + (size_t)item * CAP * FF + nt * 128;
        u.aux = nullptr; u.gidx = IDX + item * CAP; u.ldc = FF; u.row0 = 0; u.col0 = 0; return true;
    }
    __device__ __forceinline__ void a_ready(const Unit&) const {}
    __device__ __forceinline__ void done(const Unit&) const {}
};
struct MoeDownSched {
    int G, c; const bf16_t *HMID, *W2T; bf16_t* YS; const float* GATE;
    __device__ __forceinline__ bool next(int i, Unit& u) const {
        if (i >= 4 || c >= 256) return false;
        const int x = c & 7, q = c >> 3, Q = q >> 2, nt = q & 3, item = (Q * 4 + i) * 8 + x, e = item & 15;
        u.a = (const char*)(HMID + (size_t)item * CAP * FF); u.b = (const char*)(W2T + ((size_t)e * 1024 + nt * 256) * FF); u.c = YS + (size_t)item * CAP * D + nt * 256;
        u.aux = GATE + item * CAP; u.gidx = nullptr; u.ldc = D; u.row0 = 0; u.col0 = 0; return true;
    }
    __device__ __forceinline__ void a_ready(const Unit&) const {}
    __device__ __forceinline__ void done(const Unit&) const {}
};
__device__ __forceinline__ void ph_moe_up(const P& p, unsigned char* lds) {
    pg8::EpiSwiGLU E;
    for (int round = 0; round < 4; ++round) {
        MoeUpSched S{(int)gridDim.x, (int)blockIdx.x, round, (const bf16_t*)(p.ws + WS_H2), (const bf16_t*)(p.ws + WS_W13T), (bf16_t*)(p.ws + WS_HMID), (const int*)(p.ws + WS_IDX)};
        pg8::gemm_phase<pg8::EpiSwiGLU, MoeUpSched, true, true, true>((PG8_LAS unsigned char*)lds, D, S, E);
    }
}
__device__ __forceinline__ void ph_moe_down(const P& p, unsigned char* lds) {
    MoeDownSched S{(int)gridDim.x, (int)blockIdx.x, (const bf16_t*)(p.ws + WS_HMID), (const bf16_t*)(p.ws + WS_W2T), (bf16_t*)(p.ws + WS_YS), (const float*)(p.ws + WS_GATE)};
    pg8::EpiDown E;
    pg8::gemm_phase<pg8::EpiDown, MoeDownSched, true, true, false>((PG8_LAS unsigned char*)lds, FF, S, E);
}

__device__ __forceinline__ void ph_final(const P& p) {
    const int tid = opaque_tid(), lane = tid & 63, wv = tid >> 6;
    const float* ADA = (const float*)(p.ws + WS_ADA);
    const bf16_t* YS = (const bf16_t*)(p.ws + WS_YS);
    const int* INV = (const int*)(p.ws + WS_INV);
    float* X = p.out;
    constexpr int NR = 4;
    for (int rc = blockIdx.x * 8 + wv; rc < NTOK / 16; rc += gridDim.x * 8)
    for (int r0 = rc * 16; r0 < rc * 16 + 16; r0 += NR) {
        const int b = r0 / SEQ;
        const float* g2 = ADA + b * 6144 + 5120;
        int myinv[NR]; f32x4_t xv[NR][4]; f32x4_t acc[NR][4];
#pragma unroll
        for (int rr = 0; rr < NR; ++rr) {
            myinv[rr] = INV[(size_t)(r0 + rr) * 16 + (lane & 15)];
#pragma unroll
            for (int j = 0; j < 4; ++j) { const uint2 w = ((const uint2*)(X + (size_t)(r0 + rr) * D))[lane + 64 * j];
                xv[rr][j] = (f32x4_t){__uint_as_float(w.x << 16), __uint_as_float(w.x & 0xffff0000u), __uint_as_float(w.y << 16), __uint_as_float(w.y & 0xffff0000u)}; acc[rr][j] = (f32x4_t){0.f, 0.f, 0.f, 0.f}; }
        }
#pragma unroll
        for (int rr = 0; rr < NR; ++rr) {
            unsigned m = (unsigned)(__ballot(myinv[rr] >= 0) & 0xffffull);
            while (m) {
                uint2 w[4][4]; int ne = 0;
#pragma unroll
                for (int k = 0; k < 4; ++k) {
                    if (m) {
                        const int e = __builtin_ctz(m); m &= m - 1u; ne = k + 1;
                        const int slot = __shfl(myinv[rr], e);
                        const uint2* yr = (const uint2*)(YS + ((size_t)(b * 16 + e) * CAP + slot) * D);
#pragma unroll
                        for (int j = 0; j < 4; ++j) w[k][j] = yr[lane + 64 * j];
                    }
                }
#pragma unroll
                for (int k = 0; k < 4; ++k) {
                    if (k < ne) {
#pragma unroll
                        for (int j = 0; j < 4; ++j) { acc[rr][j].x += __uint_as_float(w[k][j].x << 16); acc[rr][j].y += __uint_as_float(w[k][j].x & 0xffff0000u); acc[rr][j].z += __uint_as_float(w[k][j].y << 16); acc[rr][j].w += __uint_as_float(w[k][j].y & 0xffff0000u); }
                    }
                }
            }
        }
#pragma unroll
        for (int rr = 0; rr < NR; ++rr) {
            f32x4_t v[4]; float ss = 0.f;
#pragma unroll
            for (int j = 0; j < 4; ++j) {
                const f32x4_t g = ((const f32x4_t*)g2)[lane + 64 * j];
                v[j] = xv[rr][j] + g * acc[rr][j];
                ss += v[j].x * v[j].x + v[j].y * v[j].y + v[j].z * v[j].z + v[j].w * v[j].w;
            }
            ss = wave_sum(ss);
            const float rstd = rsqrtf(ss * (1.f / D) + EPS);
#pragma unroll
            for (int j = 0; j < 4; ++j) {
                const f32x4_t g = ((const f32x4_t*)p.final_g)[lane + 64 * j];
                ((f32x4_t*)(X + (size_t)(r0 + rr) * D))[lane + 64 * j] = v[j] * rstd * g;
            }
        }
    }
}

#define LAS __attribute__((address_space(3)))
#define XB_TMO      128
#define XB_XCNT(j)  (256  + 64 * (j))
#define XB_XSUB(j)  (1280 + 64 * (j))
#define XB_XGEN(j)  (2304 + 64 * (j))
#define XB_TOP      3328
#define XB_TOPGEN   3392
#define XCD_BAR_WORDS 3456
#define XB_SPIN_CAP (1u << 18)

__device__ __forceinline__ unsigned xb_ld(unsigned* p)              { return __hip_atomic_load(p, __ATOMIC_RELAXED, __HIP_MEMORY_SCOPE_AGENT); }
__device__ __forceinline__ unsigned xb_add(unsigned* p, unsigned v) { return __hip_atomic_fetch_add(p, v, __ATOMIC_RELAXED, __HIP_MEMORY_SCOPE_AGENT); }
__device__ __forceinline__ unsigned xb_xcc_id() { return (unsigned)__builtin_amdgcn_s_getreg((3 << 11) | 20) & 0xFu; }
#define XB_SPIN(cond, bar) do { unsigned _sp = 0; while (cond) { __builtin_amdgcn_s_sleep(1); \
    if ((++_sp & 255u) == 0u) { if (xb_ld(&(bar)[XB_TMO])) break; if (_sp > XB_SPIN_CAP) { atomicAdd(&(bar)[XB_TMO], 1u); break; } } } } while (0)

struct XcdBarrier {
    unsigned* bar; unsigned x;
    volatile LAS unsigned* st;
};

__device__ __forceinline__ XcdBarrier xcd_barrier_post(unsigned* bar, volatile LAS unsigned* st) {
    XcdBarrier b; b.bar = bar; b.x = xb_xcc_id(); b.st = st;
    if (threadIdx.x == 0) (void)xb_add(&bar[XB_XCNT(b.x)], 1u);
    return b;
}
__device__ __forceinline__ void xcd_barrier_complete(unsigned* bar, unsigned x, unsigned& nloc, unsigned& nx) {
    const unsigned G = gridDim.x * gridDim.y * gridDim.z;
    unsigned sum, cnt, mine, sp = 0u;
    for (;;) {
        sum = 0u; cnt = 0u; mine = 0u;
#pragma unroll
        for (unsigned j = 0; j < 16; ++j) { const unsigned c = xb_ld(&bar[XB_XCNT(j)]); sum += c; cnt += (c > 0u) ? 1u : 0u; mine = (j == x) ? c : mine; }
        if (sum == G) break;
        __builtin_amdgcn_s_sleep(1);
        if ((++sp & 255u) == 0u) { if (xb_ld(&bar[XB_TMO])) break; if (sp > XB_SPIN_CAP) { atomicAdd(&bar[XB_TMO], 1u); break; } }
    }
    nloc = mine > 0u ? mine : 1u; nx = cnt > 0u ? cnt : 1u;
}

__device__ __forceinline__ void xcd_barrier(const XcdBarrier& b) {
    asm volatile("s_waitcnt vmcnt(0)" ::: "memory");
    __syncthreads();
    if (threadIdx.x == 0) {
        unsigned* bar = b.bar;
        __builtin_amdgcn_s_waitcnt(0);
        unsigned nloc = b.st[0], nx = b.st[1];
        if (nloc == 0u) { xcd_barrier_complete(bar, b.x, nloc, nx); b.st[0] = nloc; b.st[1] = nx; }
        const unsigned old = xb_add(&bar[XB_XSUB(b.x)], 1u);
        const unsigned gen = old / nloc;
        if (old + 1u == (gen + 1u) * nloc) {
            __builtin_amdgcn_fence(__ATOMIC_RELEASE, "agent");
            asm volatile("s_waitcnt vmcnt(0)" ::: "memory");
            const unsigned og = xb_add(&bar[XB_TOP], 1u);
            const unsigned tg = og / nx;
            if (og + 1u == (tg + 1u) * nx) xb_add(&bar[XB_TOPGEN], 1u);
            else XB_SPIN(xb_ld(&bar[XB_TOPGEN]) == tg, bar);
            __builtin_amdgcn_fence(__ATOMIC_ACQUIRE, "agent");
            xb_add(&bar[XB_XGEN(b.x)], 1u);
            asm volatile("s_waitcnt vmcnt(0)" ::: "memory");
        } else {
            XB_SPIN(xb_ld(&bar[XB_XGEN(b.x)]) == gen, bar);
            __builtin_amdgcn_fence(__ATOMIC_ACQUIRE, "agent");
            asm volatile("s_waitcnt vmcnt(0)" ::: "memory");
        }
    }
    __syncthreads();
}

constexpr int N_PHASES = 11;
template <int PH>
__device__ __forceinline__ void run_phase(const P& p, unsigned char* ldsb) {
    float* lds = (float*)ldsb;
    if constexpr (PH == 0) { ph_prep(p, lds); ph_convert_small(p, lds); }
    else if constexpr (PH == 1) { ph_norm1(p); ph_filter(p, lds); }
    else if constexpr (PH == 2) ph_inproj(p, ldsb);
    else if constexpr (PH == 3) ph_mixers<0>(p, ldsb);
    else if constexpr (PH == 4) ph_mixprep(p, lds);
    else if constexpr (PH == 5) ph_outproj(p, ldsb);
    else if constexpr (PH == 6) ph_norm2_router(p, lds);
    else if constexpr (PH == 7) ph_topk(p, lds);
    else if constexpr (PH == 8) ph_moe_up(p, ldsb);
    else if constexpr (PH == 9) ph_moe_down(p, ldsb);
    else if constexpr (PH == 10) ph_final(p);
}
template <int PH>
__device__ __forceinline__ void run_from(const P& p, unsigned char* lds, const XcdBarrier& bar) {
    if constexpr (PH < N_PHASES) {
        run_phase<PH>(p, lds);
        if constexpr (PH + 1 < N_PHASES) xcd_barrier(bar);
        run_from<PH + 1>(p, lds, bar);
    }
}
__global__ void __launch_bounds__(NT, 2) fwd_all(P p) {
    extern __shared__ __attribute__((aligned(16))) unsigned char lds_raw[];
    volatile LAS unsigned* st = (volatile LAS unsigned*)(lds_raw + LDS_BYTES - 32);
    if (threadIdx.x < 2) st[threadIdx.x] = 0u;
    __syncthreads();
    const XcdBarrier bar = xcd_barrier_post((unsigned*)(p.ws + WS_CTL) + CW_BAR, st);
    run_from<0>(p, lds_raw, bar);
}

extern "C" void kernel_launch(void* const* d_in, const int* in_sizes, int n_in, void* d_out, int out_size, void* d_ws, size_t ws_size, hipStream_t stream) {
    static int grid = 0;
    if (grid == 0) {
        int dev = 0, cus = 0, per_cu = 0;
        (void)hipGetDevice(&dev);
        (void)hipDeviceGetAttribute(&cus, hipDeviceAttributeMultiprocessorCount, dev);
        (void)hipFuncSetAttribute((const void*)fwd_all, hipFuncAttributeMaxDynamicSharedMemorySize, LDS_BYTES);
        (void)hipOccupancyMaxActiveBlocksPerMultiprocessor(&per_cu, (const void*)fwd_all, NT, LDS_BYTES);
        if (per_cu < 1) fprintf(stderr, "kernel_launch: occupancy query says %d blocks/CU\n", per_cu);
        grid = (cus > 0 ? cus : 256);
        if (ws_size < WS_END) fprintf(stderr, "kernel_launch: workspace too small: %zu < %zu\n", ws_size, (size_t)WS_END);
    }
    P p{};
    const float** f = (const float**)&p;
    for (int i = 0; i < 28; ++i) f[i] = (const float*)d_in[i];
    p.out = (float*)d_out;
    p.ws = (unsigned char*)d_ws;
    p.ph_lo = 0; p.ph_hi = N_PHASES;
    (void)hipMemsetAsync((unsigned char*)d_ws + WS_CTL, 0, CTL_ZERO_BYTES, stream);
    hipLaunchKernelGGL(fwd_all, dim3(grid), dim3(NT), LDS_BYTES, stream, p);
}
```

```cpp
#include <hip/hip_runtime.h>
#include <cstdio>
#include <cstdint>

constexpr int D = 1024, NB = 16, SEQ = 2048, CTXL = 256;
constexpr int NTOK = NB * SEQ;
constexpr int NCTX = NB * CTXL;
constexpr int HEADS = 4;
constexpr int INC = 4096;
constexpr int NE = 16, CAP = 256, FF = 2048;
constexpr int NT = 512;
constexpr int LDS_BYTES = 147456;
constexpr float EPS = 1e-6f;
typedef unsigned short bf16_t;

constexpr size_t MiB = 1u << 20;
constexpr size_t WS_CTL = 0;
constexpr size_t WS_ADA = 1 * MiB;
constexpr size_t WS_LB = WS_ADA + 512 * 1024;
constexpr size_t WS_HID2 = 2 * MiB;
constexpr size_t WS_AFF = 3 * MiB;
constexpr size_t WS_IDX = 5 * MiB;
constexpr size_t WS_GATE = 5 * MiB + 512 * 1024;
constexpr size_t WS_INV = 6 * MiB;
constexpr size_t WS_W13T = 8 * MiB;
constexpr size_t WS_YS = WS_W13T;
constexpr size_t WS_W2T = 136 * MiB;
constexpr size_t WS_R = 200 * MiB;
constexpr size_t WS_H = WS_R;
constexpr size_t WS_MIXA = WS_R;
constexpr size_t WS_HC = WS_R + 64 * MiB;
constexpr size_t WS_PC = WS_R + 72 * MiB;
constexpr size_t WS_OFB = WS_R + 84 * MiB;
constexpr size_t WS_WOUTT = WS_R + 148 * MiB;
constexpr size_t WS_PHG = WS_R + 152 * MiB;
constexpr size_t WS_HMID = WS_R;
constexpr size_t WS_H2 = WS_R + 256 * MiB;
constexpr size_t WS_YT = WS_R + 320 * MiB;
constexpr size_t WS_END = WS_YT + 32 * MiB;
constexpr int CW_QHEAD = 64;
constexpr int CW_BAR = 4096;
constexpr size_t CTL_ZERO_BYTES = 65536;
constexpr size_t DO_PHYT = 0;
constexpr size_t DO_HF = 96 * MiB;
constexpr size_t DO_SCTX = 112 * MiB;
constexpr size_t DO_WINT = 120 * MiB;

struct P {
    const float *x, *c, *ctx, *c_ctx, *ada_w, *ada_b, *norm1_g, *w_in, *hy_conv_w, *hy_conv_b, *pos_w1, *pos_b1, *freq1, *pos_w2, *pos_b2,
        *freq2, *pos_w3, *hy_bias, *hy_norm_g, *hg_lb, *hg_norm_g, *w_out, *norm2_g, *router_w, *exp_w1, *exp_w3, *exp_w2, *final_g;
    float* out;
    unsigned char* ws;
    int ph_lo, ph_hi;
};

__device__ __forceinline__ int opaque_tid() { int t = threadIdx.x; asm volatile("" : "+v"(t)); return t; }
__device__ __forceinline__ void lds_barrier() { asm volatile("s_waitcnt lgkmcnt(0)" ::: "memory"); __builtin_amdgcn_s_barrier(); asm volatile("" ::: "memory"); }
typedef float f32x4_t __attribute__((ext_vector_type(4)));
__device__ __forceinline__ float wave_sum(float v) {
#pragma unroll
    for (int o = 1; o < 64; o <<= 1) v += __shfl_xor(v, o);
    return v;
}
__device__ __forceinline__ float sigmoidf_(float z) { return 1.f / (1.f + expf(-z)); }
__device__ __forceinline__ float siluf_(float z) { return z / (1.f + expf(-z)); }
__device__ __forceinline__ float silu_f(float z) { return z * __builtin_amdgcn_rcpf(1.0f + __builtin_amdgcn_exp2f(-1.4426950408889634f * z)); }
__device__ __forceinline__ float bf2f(bf16_t h) { return __uint_as_float((unsigned)h << 16); }
__device__ __forceinline__ unsigned f2bf(float f) { unsigned u = __float_as_uint(f); return (u + 0x7fffu + ((u >> 16) & 1u)) >> 16; }
typedef float f32x2_cv __attribute__((ext_vector_type(2))); typedef __bf16 bf16x2_cv __attribute__((ext_vector_type(2)));
__device__ __forceinline__ unsigned cvtpk(float lo, float hi) { const f32x2_cv v = {lo, hi}; const bf16x2_cv b = __builtin_convertvector(v, bf16x2_cv); return __builtin_bit_cast(unsigned, b); }
__device__ __forceinline__ unsigned pk2(float lo, float hi) { return f2bf(lo) | (f2bf(hi) << 16); }

namespace pg8 {
#define PG8_LAS __attribute__((address_space(3)))
typedef unsigned short bf16_t;
typedef short bf16x8 __attribute__((ext_vector_type(8)));
typedef float f32x4 __attribute__((ext_vector_type(4)));
typedef unsigned u32x4 __attribute__((ext_vector_type(4)));
constexpr int BM = 256, BK = 64, HALF = 128, HTB = HALF * BK * 2  , STAGE_BYTES = 8 * HTB, NXCD = 8, WGM = 8;

__host__ __device__ __forceinline__ int lds_byte(int r, int c) { const int st = (r >> 4) * 2 + (c >> 5), rr = r & 15, cc = c & 31, ob = rr * 64 + cc * 2; return st * 1024 + (ob ^ (((ob >> 9) & 1) << 5)); }
__host__ __device__ __forceinline__ void stage_rc(int b, int& R, int& C) { const int st = b / 1024, sb = b % 1024, swz = sb ^ (((sb >> 9) & 1) << 5); R = (st >> 1) * 16 + swz / 64; C = (st & 1) * 32 + (swz % 64) / 2; }
__host__ __device__ __forceinline__ int perm32(int rho) { const int n = rho >> 4, i = rho & 15; return 8 * (i >> 2) + 4 * n + (i & 3); }

struct Unit { const char* a; const char* b; bf16_t* c; const float* aux; const int* gidx; int ldc, row0, col0; };
__device__ __forceinline__ unsigned cvt_pk_bf16(float lo, float hi) { unsigned r; asm volatile("v_cvt_pk_bf16_f32 %0, %1, %2" : "=v"(r) : "v"(lo), "v"(hi)); return r; }

__device__ __forceinline__ void tile_of(int L, int nM, int nN, int& pm, int& pn) {
    const int nwg = nM * nN; int wgid = L;
    { const int q = nwg / NXCD, r = nwg % NXCD, xcd = wgid % NXCD, off = wgid / NXCD; wgid = (xcd < r ? xcd * (q + 1) : r * (q + 1) + (xcd - r) * q) + off; }
    const int nig = WGM * nN, gid = wgid / nig, fm = gid * WGM, gsz = (nM - fm) < WGM ? (nM - fm) : WGM;
    pm = fm + ((wgid % nig) % gsz); pn = (wgid % nig) / gsz;
}

struct EpiStoreBf16 {
    static constexpr bool PERM = true, AFTER_DRAIN = false;
    __device__ __forceinline__ void operator()(const f32x4 (&acc)[2][2][4][2], const Unit& u, int wr, int wc, int fr, int fq) const {
        bf16_t* base = u.c + (size_t)(wr * 64 + fr) * u.ldc + wc * 32 + 8 * fq;
#pragma unroll
        for (int ai = 0; ai < 2; ++ai)
#pragma unroll
            for (int m = 0; m < 4; ++m) { bf16_t* rowp = base + (size_t)(ai * HALF + m * 16) * u.ldc;
#pragma unroll
                for (int bj = 0; bj < 2; ++bj) { const f32x4 v0 = acc[ai][bj][m][0], v1 = acc[ai][bj][m][1];
                    u32x4 w; w.x = cvt_pk_bf16(v0[0], v0[1]); w.y = cvt_pk_bf16(v0[2], v0[3]); w.z = cvt_pk_bf16(v1[0], v1[1]); w.w = cvt_pk_bf16(v1[2], v1[3]);
                    *(u32x4*)(rowp + bj * HALF) = w; } }
    }
};
struct EpiOutProj {
    static constexpr bool PERM = true, AFTER_DRAIN = false;
    const float* x; const float* ada; bf16_t* x1;
    __device__ __forceinline__ void operator()(const f32x4 (&acc)[2][2][4][2], const Unit& u, int wr, int wc, int fr, int fq) const {
        const float* g1 = ada + (u.row0 >> 11) * 6144 + 2048;
#pragma unroll
        for (int bj = 0; bj < 2; ++bj) { const int col = u.col0 + bj * HALF + wc * 32 + 8 * fq; const f32x4 g0 = *(const f32x4*)(g1 + col), gB = *(const f32x4*)(g1 + col + 4);
#pragma unroll
            for (int ai = 0; ai < 2; ++ai)
#pragma unroll
                for (int m = 0; m < 4; ++m) { const size_t row = (size_t)(u.row0 + ai * HALF + wr * 64 + m * 16 + fr);
                    const f32x4 v0 = *(const f32x4*)(x + row * D + col) + g0 * acc[ai][bj][m][0], v1 = *(const f32x4*)(x + row * D + col + 4) + gB * acc[ai][bj][m][1];
                    u32x4 w; w.x = cvt_pk_bf16(v0[0], v0[1]); w.y = cvt_pk_bf16(v0[2], v0[3]); w.z = cvt_pk_bf16(v1[0], v1[1]); w.w = cvt_pk_bf16(v1[2], v1[3]);
                    *(u32x4*)(x1 + row * (2 * D) + col) = w; } }
    }
};
__device__ __forceinline__ float silu_fast(float a) { return a * __builtin_amdgcn_rcpf(1.0f + __builtin_amdgcn_exp2f(-1.4426950408889634f * a)); }
struct EpiSwiGLU {
    static constexpr bool PERM = true, AFTER_DRAIN = false;
    __device__ __forceinline__ void operator()(const f32x4 (&acc)[2][2][4][2], const Unit& u, int wr, int wc, int fr, int fq) const {
        bf16_t* base = u.c + (size_t)(wr * 64 + fr) * FF + wc * 32 + 8 * fq;
#pragma unroll
        for (int ai = 0; ai < 2; ++ai)
#pragma unroll
            for (int m = 0; m < 4; ++m) { const f32x4 a0 = acc[ai][0][m][0], a1 = acc[ai][0][m][1], b0 = acc[ai][1][m][0], b1 = acc[ai][1][m][1];
                u32x4 w; w.x = cvt_pk_bf16(silu_fast(a0[0]) * b0[0], silu_fast(a0[1]) * b0[1]); w.y = cvt_pk_bf16(silu_fast(a0[2]) * b0[2], silu_fast(a0[3]) * b0[3]);
                w.z = cvt_pk_bf16(silu_fast(a1[0]) * b1[0], silu_fast(a1[1]) * b1[1]); w.w = cvt_pk_bf16(silu_fast(a1[2]) * b1[2], silu_fast(a1[3]) * b1[3]);
                *(u32x4*)(base + (size_t)(ai * HALF + m * 16) * FF) = w; }
    }
};
struct EpiDown {
    static constexpr bool PERM = true, AFTER_DRAIN = false;
    __device__ __forceinline__ void operator()(const f32x4 (&acc)[2][2][4][2], const Unit& u, int wr, int wc, int fr, int fq) const {
        bf16_t* base = u.c + (size_t)(wr * 64 + fr) * D + wc * 32 + 8 * fq;
#pragma unroll
        for (int ai = 0; ai < 2; ++ai)
#pragma unroll
            for (int m = 0; m < 4; ++m) { const float gt = u.aux[ai * HALF + wr * 64 + m * 16 + fr]; bf16_t* rowp = base + (size_t)(ai * HALF + m * 16) * D;
#pragma unroll
                for (int bj = 0; bj < 2; ++bj) { const f32x4 v0 = acc[ai][bj][m][0] * gt, v1 = acc[ai][bj][m][1] * gt;
                    u32x4 w; w.x = cvt_pk_bf16(v0[0], v0[1]); w.y = cvt_pk_bf16(v0[2], v0[3]); w.z = cvt_pk_bf16(v1[0], v1[1]); w.w = cvt_pk_bf16(v1[2], v1[3]);
                    *(u32x4*)(rowp + bj * HALF) = w; } }
    }
};

template <class Epi, class Sched, bool ALIGN_EPI = false, bool SP2 = false, bool GATHER = false>
__device__ __forceinline__ void gemm_phase(PG8_LAS unsigned char* lds, const int K, const Sched& S, const Epi& E) {
    const int tid = opaque_tid(), wid = __builtin_amdgcn_readfirstlane(tid >> 6), lane = tid & 63, wr = wid >> 2, wc = wid & 3, fr = lane & 15, fq = lane >> 4;
    const int nt = K / BK;
    unsigned voffA[2], voffB[2];
#pragma unroll
    for (int i = 0; i < 2; ++i) { int R, C; stage_rc(tid * 16 + i * 8192, R, C); const int Rb = Epi::PERM ? ((R & ~31) + perm32(R & 31)) : R;
        voffA[i] = (unsigned)(R * K + C) * 2u; voffB[i] = (unsigned)(Rb * K + C) * 2u; }
    const size_t kstep = (size_t)(BK * 2);
    const size_t hstep = (size_t)HALF * K * 2;
    const unsigned ldsw = (unsigned)wid * 1024u;
    const int aoff = lds_byte(wr * 64 + fr, fq * 8), boff = lds_byte(wc * 32 + fr, fq * 8);
#define PG8_SA(b, h) (((b) * 2 + (h)) * HTB)
#define PG8_SB(b, h) ((4 + (b) * 2 + (h)) * HTB)
#define PG8_STAGE(bufoff, gbase, voff) do { _Pragma("unroll") for (int _i = 0; _i < 2; ++_i) \
        __builtin_amdgcn_global_load_lds((const unsigned*)((const char*)(gbase) + (voff)[_i]), (PG8_LAS unsigned*)(lds + (bufoff) + ldsw + _i * 8192), 16, 0, 0); } while (0)
#define PG8_STAGE_A(bufoff, gbase, h) do { _Pragma("unroll") for (int _i = 0; _i < 2; ++_i) \
        __builtin_amdgcn_global_load_lds((const unsigned*)((const char*)(gbase) + voffAh[h][_i]), (PG8_LAS unsigned*)(lds + (bufoff) + ldsw + _i * 8192), 16, 0, 0); } while (0)
#define PG8_LDA(dst, b, h) do { _Pragma("unroll") for (int m = 0; m < 4; ++m) _Pragma("unroll") for (int k = 0; k < 2; ++k) dst[m][k] = *(const PG8_LAS bf16x8*)(lds + PG8_SA(b, h) + aoff + m * 2048 + k * 1024); } while (0)
#define PG8_LDB(dst, b, h) do { _Pragma("unroll") for (int n = 0; n < 2; ++n) _Pragma("unroll") for (int k = 0; k < 2; ++k) dst[n][k] = *(const PG8_LAS bf16x8*)(lds + PG8_SB(b, h) + boff + n * 2048 + k * 1024); } while (0)
#define PG8_MMA(ai, bj, At, Bt) do { __builtin_amdgcn_s_setprio(1); _Pragma("unroll") for (int m = 0; m < 4; ++m) _Pragma("unroll") for (int n = 0; n < 2; ++n) _Pragma("unroll") for (int k = 0; k < 2; ++k) \
        acc[ai][bj][m][n] = __builtin_amdgcn_mfma_f32_16x16x32_bf16(Bt[n][k], At[m][k], acc[ai][bj][m][n], 0, 0, 0); __builtin_amdgcn_s_setprio(0); } while (0)
#define PG8_WAIT_V(n) asm volatile("s_waitcnt vmcnt(" #n ")" ::: "memory")
#define PG8_WAIT_L(n) asm volatile("s_waitcnt lgkmcnt(" #n ")" ::: "memory")
#define PG8_BAR __builtin_amdgcn_s_barrier()
#define PG8_SCHED __builtin_amdgcn_sched_barrier(0)
    Unit cur, nxt; int ui = 0;
    if (!S.next(0, cur)) return;
    unsigned voffAh[2][2];
#pragma unroll
    for (int h = 0; h < 2; ++h)
#pragma unroll
        for (int i = 0; i < 2; ++i) {
            if constexpr (GATHER) { int R, C; stage_rc(tid * 16 + i * 8192, R, C); voffAh[h][i] = ((unsigned)cur.gidx[h * HALF + R] * (unsigned)K + (unsigned)C) * 2u; }
            else voffAh[h][i] = voffA[i] + (unsigned)h * (unsigned)hstep;
        }
    f32x4 acc[2][2][4][2];
#pragma unroll
    for (int a = 0; a < 2; ++a)
#pragma unroll
        for (int b = 0; b < 2; ++b)
#pragma unroll
            for (int m = 0; m < 4; ++m)
#pragma unroll
                for (int n = 0; n < 2; ++n) acc[a][b][m][n] = (f32x4){0.f, 0.f, 0.f, 0.f};
    bf16x8 At[4][2], B0[2][2], B1[2][2];
    const char* cA = cur.a; const char* cB = cur.b;
    S.a_ready(cur);
    if constexpr (SP2) {
        PG8_STAGE(PG8_SB(0, 0), cB, voffB); PG8_STAGE(PG8_SB(0, 1), cB + hstep, voffB); PG8_STAGE_A(PG8_SA(0, 0), cA, 0); PG8_STAGE_A(PG8_SA(0, 1), cA, 1);
        if (wr == 1) PG8_BAR;
        PG8_WAIT_V(2); PG8_BAR;
        PG8_STAGE(PG8_SB(1, 0), cB + kstep, voffB); PG8_STAGE_A(PG8_SA(1, 0), cA + kstep, 0); PG8_STAGE(PG8_SB(1, 1), cB + hstep + kstep, voffB);
        PG8_WAIT_V(6); PG8_BAR;
    } else {
        PG8_STAGE(PG8_SB(0, 0), cB, voffB); PG8_STAGE_A(PG8_SA(0, 0), cA, 0); PG8_STAGE(PG8_SB(0, 1), cB + hstep, voffB); PG8_STAGE_A(PG8_SA(0, 1), cA, 1);
        if (wr == 1) PG8_BAR;
        PG8_WAIT_V(4); PG8_BAR;
        PG8_STAGE(PG8_SB(1, 0), cB + kstep, voffB); PG8_STAGE_A(PG8_SA(1, 0), cA + kstep, 0); PG8_STAGE(PG8_SB(1, 1), cB + hstep + kstep, voffB);
        PG8_WAIT_V(6); PG8_BAR;
    }
    for (;;) {
        const bool has_next = S.next(ui + 1, nxt);
        const char* nA = has_next ? nxt.a : cA; const char* nB = has_next ? nxt.b : cB;
        for (int t = 0; t < nt; t += 2) {
            const bool last = (t == nt - 2);
            const char* a1 = cA + (size_t)(t + 1) * kstep;
            const char* a2 = last ? nA : cA + (size_t)(t + 2) * kstep; const char* b2 = last ? nB : cB + (size_t)(t + 2) * kstep;
            const char* a3 = a2 + kstep; const char* b3 = b2 + kstep;
            if (last && has_next) S.a_ready(nxt);
            if constexpr (SP2) {
            PG8_LDB(B0, 0, 0); PG8_LDB(B1, 0, 1); PG8_SCHED; PG8_LDA(At, 0, 0); PG8_STAGE_A(PG8_SA(1, 1), a1, 1);
            PG8_WAIT_V(8); PG8_WAIT_L(0); PG8_BAR; PG8_MMA(0, 0, At, B0); PG8_MMA(0, 1, At, B1); PG8_BAR; PG8_SCHED;
            PG8_LDA(At, 0, 1); PG8_STAGE(PG8_SB(0, 0), b2, voffB); PG8_STAGE(PG8_SB(0, 1), b2 + hstep, voffB); PG8_STAGE_A(PG8_SA(0, 0), a2, 0);
            PG8_WAIT_V(8); PG8_WAIT_L(0); PG8_BAR; PG8_MMA(1, 0, At, B0); PG8_MMA(1, 1, At, B1); PG8_BAR; PG8_SCHED;
            PG8_LDB(B0, 1, 0); PG8_LDB(B1, 1, 1); PG8_SCHED; PG8_LDA(At, 1, 0); PG8_STAGE_A(PG8_SA(0, 1), a2, 1);
            PG8_WAIT_V(8); PG8_WAIT_L(0); PG8_BAR; PG8_MMA(0, 0, At, B0); PG8_MMA(0, 1, At, B1); PG8_BAR; PG8_SCHED;
            PG8_LDA(At, 1, 1); PG8_STAGE(PG8_SB(1, 0), b3, voffB); PG8_STAGE(PG8_SB(1, 1), b3 + hstep, voffB); PG8_STAGE_A(PG8_SA(1, 0), a3, 0);
            PG8_WAIT_V(8); PG8_WAIT_L(0); PG8_BAR; PG8_MMA(1, 0, At, B0); PG8_MMA(1, 1, At, B1); PG8_BAR; PG8_SCHED;
            } else {
            PG8_LDB(B0, 0, 0); PG8_SCHED; PG8_LDA(At, 0, 0); PG8_STAGE_A(PG8_SA(1, 1), a1, 1);
            PG8_WAIT_L(8); PG8_BAR; PG8_WAIT_L(0); PG8_MMA(0, 0, At, B0); PG8_BAR; PG8_SCHED;
            PG8_LDB(B1, 0, 1); PG8_STAGE(PG8_SB(0, 0), b2, voffB);
            PG8_BAR; PG8_WAIT_L(0); PG8_MMA(0, 1, At, B1); PG8_BAR;
            PG8_LDA(At, 0, 1); PG8_STAGE_A(PG8_SA(0, 0), a2, 0);
            PG8_BAR; PG8_WAIT_L(0); PG8_MMA(1, 0, At, B0); PG8_BAR; PG8_SCHED;
            PG8_STAGE(PG8_SB(0, 1), b2 + hstep, voffB);
            PG8_WAIT_V(6); PG8_BAR; PG8_MMA(1, 1, At, B1); PG8_BAR;
            PG8_LDB(B0, 1, 0); PG8_SCHED; PG8_LDA(At, 1, 0); PG8_STAGE_A(PG8_SA(0, 1), a2, 1);
            PG8_WAIT_L(8); PG8_BAR; PG8_WAIT_L(0); PG8_MMA(0, 0, At, B0); PG8_BAR; PG8_SCHED;
            PG8_LDB(B1, 1, 1); PG8_STAGE(PG8_SB(1, 0), b3, voffB);
            PG8_BAR; PG8_WAIT_L(0); PG8_MMA(0, 1, At, B1); PG8_BAR;
            PG8_LDA(At, 1, 1); PG8_STAGE_A(PG8_SA(1, 0), a3, 0);
            PG8_BAR; PG8_WAIT_L(0); PG8_MMA(1, 0, At, B0); PG8_BAR; PG8_SCHED;
            PG8_STAGE(PG8_SB(1, 1), b3 + hstep, voffB);
            PG8_WAIT_V(6); PG8_BAR; PG8_MMA(1, 1, At, B1); PG8_BAR;
            }
        }
        if constexpr (ALIGN_EPI) { if (wr == 0) PG8_BAR; }
        if constexpr (!Epi::AFTER_DRAIN) { E(acc, cur, wr, wc, fr, fq); S.done(cur); }
        if (!has_next) break;
#pragma unroll
        for (int a = 0; a < 2; ++a)
#pragma unroll
            for (int b = 0; b < 2; ++b)
#pragma unroll
                for (int m = 0; m < 4; ++m)
#pragma unroll
                    for (int n = 0; n < 2; ++n) acc[a][b][m][n] = (f32x4){0.f, 0.f, 0.f, 0.f};
        cur = nxt; cA = nA; cB = nB; ++ui;
        if constexpr (ALIGN_EPI) { if (wr == 1) PG8_BAR; }
    }
    PG8_WAIT_V(0);
    if constexpr (!ALIGN_EPI) { if (wr == 0) PG8_BAR; }
    PG8_BAR;
    if constexpr (Epi::AFTER_DRAIN) { E.fused(acc, cur, wr, wc, fr, fq, lds, wid, lane); S.done(cur); }
#undef PG8_SA
#undef PG8_SB
#undef PG8_STAGE
#undef PG8_LDA
#undef PG8_LDB
#undef PG8_MMA
#undef PG8_WAIT_V
#undef PG8_WAIT_L
#undef PG8_BAR
#undef PG8_SCHED
}
}
using pg8::Unit; using pg8::tile_of;

__device__ __forceinline__ void ph_prep(const P& p, float* lds) {
    const int tid = opaque_tid(), G = gridDim.x;
    float* ADA = (float*)(p.ws + WS_ADA);
    float* LB = (float*)(p.ws + WS_LB);
    float* HID2 = (float*)(p.ws + WS_HID2);
    {
        float* s = lds;
        float* red = lds + 17 * 1024;
        if (blockIdx.x < 192) {
            for (int i = tid; i < 17 * 1024; i += NT) {
                const int r = i >> 10, d = i & 1023;
                const float cv = r < 16 ? p.c[r * 1024 + d] : p.c_ctx[d];
                s[i] = siluf_(cv);
            }
        }
        __syncthreads();
        for (int item = blockIdx.x; item < 192; item += G) {
            const int jj = tid & 31, ks = tid >> 5, j = item * 32 + jj;
            float acc[17];
#pragma unroll
            for (int r = 0; r < 17; ++r) acc[r] = 0.f;
            for (int d0 = ks * 64; d0 < ks * 64 + 64; d0 += 16) {
                float wv[16];
#pragma unroll
                for (int q = 0; q < 16; ++q) wv[q] = p.ada_w[(size_t)(d0 + q) * 6144 + j];
#pragma unroll
                for (int q = 0; q < 16; ++q)
#pragma unroll
                    for (int r = 0; r < 17; ++r) acc[r] += s[r * 1024 + d0 + q] * wv[q];
            }
#pragma unroll
            for (int r = 0; r < 17; ++r) red[(ks * 17 + r) * 32 + jj] = acc[r];
            __syncthreads();
            for (int i = tid; i < 17 * 32; i += NT) {
                const int r = i >> 5, j2 = i & 31;
                float sum = 0.f;
#pragma unroll
                for (int k = 0; k < 16; ++k) sum += red[(k * 17 + r) * 32 + j2];
                ADA[r * 6144 + item * 32 + j2] = sum + p.ada_b[item * 32 + j2];
            }
            __syncthreads();
        }
    }
    if (blockIdx.x == G - 1) {
        for (int i = tid; i < 1024; i += NT) {
            const float a0 = p.hg_lb[i], a1 = p.hg_lb[1024 + i];
            LB[i] = 1.f / (1.f + expf(a1 - a0));
        }
    }
    {
        float* zl = lds;
        float* h1 = lds + 512;
        __syncthreads();
        for (int it = (G - 1 - blockIdx.x); it < SEQ / 8; it += G) {
            const int lt = tid >> 6, j = tid & 63, t = it * 8 + lt;
            const float w = 6.283185307179586f * (float)t / 2048.0f;
            if (j == 0) zl[lt * 64] = (float)t / 2047.0f;
            if (j >= 1 && j < 17) { const float f = 1e-4f + (float)(j - 1) * ((15.0f - 1e-4f) / 15.0f); zl[lt * 64 + j] = cosf(f * w); }
            if (j >= 17 && j < 33) { const float f = 1e-4f + (float)(j - 17) * ((15.0f - 1e-4f) / 15.0f); zl[lt * 64 + j] = -sinf(f * w); }
            __syncthreads();
            float a = p.pos_b1[j];
            for (int i = 0; i < 33; ++i) a += zl[lt * 64 + i] * p.pos_w1[i * 64 + j];
            h1[lt * 64 + j] = sinf(p.freq1[j] * a);
            __syncthreads();
            float b = p.pos_b2[j];
            for (int i = 0; i < 64; ++i) b += h1[lt * 64 + i] * p.pos_w2[i * 64 + j];
            HID2[t * 64 + j] = sinf(p.freq2[j] * b);
            __syncthreads();
        }
    }
}
struct ConvItem { const float* W; bf16_t* dst; int N, KD, k0, n0, which; };
__device__ __forceinline__ ConvItem conv_small_item(const P& p, int it) {
    ConvItem c; c.which = 0; c.KD = D;
    if (it < 256) { c.W = p.w_in; c.N = INC; c.k0 = (it / 16) * 64; c.n0 = (it % 16) * 256; c.dst = (bf16_t*)((unsigned char*)p.out + DO_WINT); }
    else { const int r = it - 256; c.W = p.w_out; c.N = D; c.k0 = (r / 4) * 64; c.n0 = (r % 4) * 256; c.dst = (bf16_t*)(p.ws + WS_WOUTT); }
    return c;
}
constexpr int N_EXPERT_ITEMS = 2 * 16 * 16 * 8 + 16 * 32 * 4;
__device__ __forceinline__ ConvItem conv_expert_item(const P& p, int r) {
    ConvItem c; constexpr int I_W1 = 16 * 16 * 8;
    if (r < 2 * I_W1) {
        const int which = r / I_W1; r %= I_W1;
        const int e = r / 128, r2 = r % 128;
        c.W = (which == 0 ? p.exp_w1 : p.exp_w3) + (size_t)e * D * FF; c.N = FF; c.k0 = (r2 / 8) * 64; c.n0 = (r2 % 8) * 256; c.dst = (bf16_t*)(p.ws + WS_W13T) + (size_t)e * 4096 * D; c.KD = D; c.which = 1 + which;
    } else {
        r -= 2 * I_W1; const int e = r / 128, r2 = r % 128;
        c.W = p.exp_w2 + (size_t)e * FF * D; c.N = D; c.k0 = (r2 / 4) * 64; c.n0 = (r2 % 4) * 256; c.dst = (bf16_t*)(p.ws + WS_W2T) + (size_t)e * 1024 * FF; c.KD = FF; c.which = 0;
    }
    return c;
}
__device__ __forceinline__ void conv_load(const ConvItem& c, f32x4_t (&v)[8], int tid) {
#pragma unroll
    for (int q = 0; q < 8; ++q) { const int i = tid + NT * q, k = i >> 6, n4 = i & 63; v[q] = *(const f32x4_t*)(c.W + (size_t)(c.k0 + k) * c.N + c.n0 + 4 * n4); }
}
__device__ __forceinline__ void conv_tile_write(const f32x4_t (&v)[8], float* T, int tid) {
#pragma unroll
    for (int q = 0; q < 8; ++q) { const int i = tid + NT * q, k = i >> 6, n4 = i & 63; *(f32x4_t*)&T[k * 260 + 4 * (n4 ^ ((k >> 3) & 7))] = v[q]; }
}
__device__ __forceinline__ void conv_tile_store(const ConvItem& c, const float* T, int tid) {
#pragma unroll
    for (int q = 0; q < 4; ++q) { const int i = tid + NT * q, nl = i >> 3, ch = i & 7, n = c.n0 + nl;
        float a[8];
#pragma unroll
        for (int e = 0; e < 8; ++e) a[e] = T[(8 * ch + e) * 260 + (nl ^ (ch << 2))];
        const int row = c.which == 0 ? n : ((n >> 7) * 256 + (c.which - 1) * 128 + (n & 127));
        *(uint4*)(c.dst + (size_t)row * c.KD + c.k0 + 8 * ch) = make_uint4(cvtpk(a[0], a[1]), cvtpk(a[2], a[3]), cvtpk(a[4], a[5]), cvtpk(a[6], a[7])); }
}
constexpr int CONV_DEPTH = 4;
template <class ITEMF>
__device__ __forceinline__ void conv_run(ITEMF item, int first, int count, float* T) {
    const int tid = opaque_tid();
    f32x4_t ring[CONV_DEPTH][8];
#pragma unroll
    for (int d = 0; d < CONV_DEPTH; ++d) { const ConvItem c = item(first + d); conv_load(c, ring[d], tid); }
    for (int i0 = 0; i0 < count; i0 += CONV_DEPTH) {
#pragma unroll
        for (int d = 0; d < CONV_DEPTH; ++d) {
            const int i = i0 + d;
            const ConvItem c = item(first + i);
            lds_barrier();
            conv_tile_write(ring[d], T, tid);
            lds_barrier();
            if (i + CONV_DEPTH < count) { const ConvItem cn = item(first + i + CONV_DEPTH); conv_load(cn, ring[d], tid); }
            conv_tile_store(c, T, tid);
        }
    }
}
__device__ __forceinline__ void ph_convert_small(const P& p, float* lds) {
    __syncthreads();
    if (blockIdx.x >= 96 && blockIdx.x < 96 + 80) conv_run([&](int it) { return conv_small_item(p, it); }, (blockIdx.x - 96) * 4, 4, lds);
}

__device__ __forceinline__ void ph_norm1(const P& p) {
    const int tid = opaque_tid(), lane = tid & 63, wv = tid >> 6;
    const float* ADA = (const float*)(p.ws + WS_ADA);
    bf16_t* H = (bf16_t*)(p.ws + WS_H);
    bf16_t* HC = (bf16_t*)(p.ws + WS_HC);
    auto run = [&](const float* src, bf16_t* dst, int ar, int nrows) {
        f32x4_t gm[4], hs[4];
#pragma unroll
        for (int j = 0; j < 4; ++j) { const int d4 = lane + 64 * j; const f32x4_t g = ((const f32x4_t*)p.norm1_g)[d4], s1 = ((const f32x4_t*)(ADA + ar * 6144 + 1024))[d4]; gm[j] = g * (1.f + s1); hs[j] = ((const f32x4_t*)(ADA + ar * 6144))[d4]; }
        f32x4_t v[4], vn[4];
#pragma unroll
        for (int j = 0; j < 4; ++j) v[j] = ((const f32x4_t*)src)[lane + 64 * j];
        for (int ri = 0; ri < nrows; ++ri) {
            if (ri + 1 < nrows) {
#pragma unroll
                for (int j = 0; j < 4; ++j) vn[j] = ((const f32x4_t*)(src + (size_t)(ri + 1) * D))[lane + 64 * j];
            }
            float ss = 0.f;
#pragma unroll
            for (int j = 0; j < 4; ++j) ss += v[j].x * v[j].x + v[j].y * v[j].y + v[j].z * v[j].z + v[j].w * v[j].w;
            const float rstd = rsqrtf(wave_sum(ss) * (1.f / D) + EPS);
#pragma unroll
            for (int j = 0; j < 4; ++j) { const f32x4_t o = v[j] * rstd * gm[j] + hs[j]; ((uint2*)(dst + (size_t)ri * D))[lane + 64 * j] = make_uint2(cvtpk(o.x, o.y), cvtpk(o.z, o.w)); }
#pragma unroll
            for (int j = 0; j < 4; ++j) v[j] = vn[j];
        }
    };
    for (int rc = blockIdx.x * 8 + wv; rc < NTOK / 16; rc += gridDim.x * 8) {
        run(p.x + (size_t)rc * 16 * D, H + (size_t)rc * 16 * D, (rc * 16) / SEQ, 16);
        run(p.ctx + (size_t)rc * 2 * D, HC + (size_t)rc * 2 * D, 16, 2);
    }
}
__device__ __forceinline__ void ph_filter(const P& p, float* lds) {
    const int tid = opaque_tid(), G = gridDim.x;
    const float* HID2 = (const float*)(p.ws + WS_HID2);
    float* HF = (float*)((unsigned char*)p.out + DO_HF);
    float* w3c = lds;
    float* red = lds + 512;
    const float min_decay = logf(1e-2f) / 1.5f, max_decay = logf(1e-2f) / 0.3f;
    for (int grp = blockIdx.x; grp < 256; grp += G) {
        const int item0 = grp * 4, o = item0 >> 9, c0 = item0 & 511;
        __syncthreads();
        { const int q = tid >> 7, dir = (tid >> 6) & 1, i = tid & 63; w3c[tid] = p.pos_w3[i * 2048 + o * 1024 + dir * 512 + c0 + q]; }
        __syncthreads();
        float hv[4][4][2]; float asum[4] = {0.f, 0.f, 0.f, 0.f};
#pragma unroll
        for (int j = 0; j < 4; ++j) {
            const int t = tid + NT * j;
            float r[4][2];
#pragma unroll
            for (int q = 0; q < 4; ++q) { r[q][0] = 0.f; r[q][1] = 0.f; }
            const float4* hp = (const float4*)(HID2 + t * 64);
#pragma unroll 4
            for (int i4 = 0; i4 < 16; ++i4) {
                const float4 h = hp[i4];
#pragma unroll
                for (int q = 0; q < 4; ++q)
#pragma unroll
                    for (int d = 0; d < 2; ++d) { const float* w = w3c + (q * 2 + d) * 64 + i4 * 4; r[q][d] += h.x * w[0] + h.y * w[1] + h.z * w[2] + h.w * w[3]; }
            }
            const float tl = (float)t / 2047.0f;
#pragma unroll
            for (int q = 0; q < 4; ++q) {
                const float delta = fabsf(min_decay + (float)(c0 + q) * ((max_decay - min_decay) / 511.0f));
                const float win = expf(-tl * delta) + 0.05f;
                hv[j][q][0] = r[q][0] * win; hv[j][q][1] = r[q][1] * win;
                asum[q] += fabsf(hv[j][q][0]) + (t >= 1 ? fabsf(hv[j][q][1]) : 0.f);
            }
        }
#pragma unroll
        for (int q = 0; q < 4; ++q) asum[q] = wave_sum(asum[q]);
        if ((tid & 63) == 0) { red[(tid >> 6) * 4 + 0] = asum[0]; red[(tid >> 6) * 4 + 1] = asum[1]; red[(tid >> 6) * 4 + 2] = asum[2]; red[(tid >> 6) * 4 + 3] = asum[3]; }
        __syncthreads();
#pragma unroll
        for (int q = 0; q < 4; ++q) {
            float tot = 0.f;
#pragma unroll
            for (int k = 0; k < 8; ++k) tot += red[k * 4 + q];
            const float inv = 1.f / (tot + EPS);
            float* dst = HF + (size_t)(item0 + q) * 4096;
#pragma unroll
            for (int j = 0; j < 4; ++j) {
                const int t = tid + NT * j;
                dst[2047 + t] = hv[j][q][0] * inv;
                if (t >= 1) dst[2047 - t] = hv[j][q][1] * inv;
            }
            if (tid == 0) dst[4095] = 0.f;
        }
    }
}

struct InprojSched {
    int G, c; const bf16_t *WinT, *H, *HC; bf16_t *PHYT, *PHG, *PC;
    __device__ __forceinline__ bool next(int i, Unit& u) const {
        int L = i * G + c; int pm, pn;
        u.aux = nullptr; u.gidx = nullptr; u.row0 = 0; u.col0 = 0;
        if (L < 768) { tile_of(L, 6, 128, pm, pn); u.a = (const char*)(WinT + (size_t)pm * 256 * D); u.b = (const char*)(H + (size_t)pn * 256 * D); u.c = PHYT + (size_t)pm * 256 * NTOK + pn * 256; u.ldc = NTOK; return true; }
        L -= 768;
        if (L < 1280) { tile_of(L, 128, 10, pm, pn); u.a = (const char*)(H + (size_t)pm * 256 * D); u.b = (const char*)(WinT + (size_t)(1536 + pn * 256) * D); u.c = PHG + (size_t)pm * 256 * 2560 + pn * 256; u.ldc = 2560; return true; }
        L -= 1280;
        if (L < 96) { tile_of(L, 16, 6, pm, pn); u.a = (const char*)(HC + (size_t)pm * 256 * D); u.b = (const char*)(WinT + (size_t)(2048 + pn * 256) * D); u.c = PC + (size_t)pm * 256 * 1536 + pn * 256; u.ldc = 1536; return true; }
        return false;
    }
    __device__ __forceinline__ void a_ready(const Unit&) const {}
    __device__ __forceinline__ void done(const Unit&) const {}
};
__device__ __forceinline__ void ph_inproj(const P& p, unsigned char* lds) {
    InprojSched S{(int)gridDim.x, (int)blockIdx.x, (const bf16_t*)((unsigned char*)p.out + DO_WINT), (const bf16_t*)(p.ws + WS_H), (const bf16_t*)(p.ws + WS_HC),
                  (bf16_t*)((unsigned char*)p.out + DO_PHYT), (bf16_t*)(p.ws + WS_PHG), (bf16_t*)(p.ws + WS_PC)};
    pg8::EpiStoreBf16 E;
    pg8::gemm_phase<pg8::EpiStoreBf16, InprojSched, true, true, false>((PG8_LAS unsigned char*)lds, D, S, E);
}

namespace hy {
#define HY_LAS __attribute__((address_space(3)))
typedef short bf16x8 __attribute__((ext_vector_type(8)));
typedef float f32x4 __attribute__((ext_vector_type(4)));
typedef unsigned u32x4 __attribute__((ext_vector_type(4)));
typedef unsigned u32x2 __attribute__((ext_vector_type(2)));
constexpr int U_STRIDE = 4112, UIMG = 0, U_BYTES = 16 * U_STRIDE;
constexpr int FILT = U_BYTES, F_STRIDE = 8288, F_BYTES = 8 * F_STRIDE;
constexpr int SCR = FILT + F_BYTES;
static_assert(SCR + 8192 <= LDS_BYTES, "hyena LDS map");

__device__ __forceinline__ float uni(float v) { return __uint_as_float(__builtin_amdgcn_readfirstlane(__float_as_uint(v))); }
struct ConvW { float w0, w1, w2, b; };
__device__ __forceinline__ ConvW load_convw(const P& p, int ch) { ConvW c; c.w0 = uni(p.hy_conv_w[ch]); c.w1 = uni(p.hy_conv_w[1536 + ch]); c.w2 = uni(p.hy_conv_w[3072 + ch]); c.b = uni(p.hy_conv_b[ch]); return c; }
__device__ __forceinline__ void load_u_image(const ConvW cw, HY_LAS unsigned char* L, const bf16_t* row, int tid) {
    const float cw0 = cw.w0, cw1 = cw.w1, cw2 = cw.w2, cb = cw.b;
#pragma unroll 2
    for (int k = 0; k < 8; ++k) {
        const int idx = tid + NT * k, b = idx >> 8, t8 = (idx & 255) * 8;
        const bf16_t* src = row + b * SEQ + t8;
        const u32x4 raw = *(const u32x4*)src;
        float x[10];
        x[0] = (t8 & 63) ? bf2f(src[-1]) : 0.f;
        x[9] = ((t8 + 8) & 63) ? bf2f(src[8]) : 0.f;
        x[1] = __uint_as_float(raw.x << 16); x[2] = __uint_as_float(raw.x & 0xffff0000u); x[3] = __uint_as_float(raw.y << 16); x[4] = __uint_as_float(raw.y & 0xffff0000u);
        x[5] = __uint_as_float(raw.z << 16); x[6] = __uint_as_float(raw.z & 0xffff0000u); x[7] = __uint_as_float(raw.w << 16); x[8] = __uint_as_float(raw.w & 0xffff0000u);
        float o[8];
#pragma unroll
        for (int e = 0; e < 8; ++e) o[e] = cb + cw1 * x[e + 1] + cw0 * x[e] + cw2 * x[e + 2];
        *(HY_LAS u32x4*)(L + UIMG + b * U_STRIDE + t8 * 2) = (u32x4){pk2(o[0], o[1]), pk2(o[2], o[3]), pk2(o[4], o[5]), pk2(o[6], o[7])};
    }
}
__device__ __forceinline__ void raw_rows_load(u32x4 (&r)[8], const bf16_t* row, int tid) {
#pragma unroll
    for (int k = 0; k < 8; ++k) { const int idx = tid + NT * k, b = idx >> 8, t8 = (idx & 255) * 8; r[k] = *(const u32x4*)(row + b * SEQ + t8); }
}
__device__ __forceinline__ void raw_rows_store(HY_LAS unsigned char* L, const u32x4 (&r)[8], int tid) {
#pragma unroll
    for (int k = 0; k < 8; ++k) {
        const int idx = tid + NT * k, b = idx >> 8, t8 = (idx & 255) * 8;
        HY_LAS unsigned char* d = L + FILT + b * U_STRIDE + 8 + t8 * 2;
        *(HY_LAS u32x2*)d = (u32x2){r[k].x, r[k].y}; *(HY_LAS u32x2*)(d + 8) = (u32x2){r[k].z, r[k].w};
    }
}
__device__ __forceinline__ void load_filter_scr(HY_LAS unsigned char* L, const float* hf, int tid) {
    const float4 a = ((const float4*)hf)[tid * 2], b = ((const float4*)hf)[tid * 2 + 1];
    *(HY_LAS u32x4*)(L + SCR + tid * 16) = (u32x4){pk2(a.x, a.y), pk2(a.z, a.w), pk2(b.x, b.y), pk2(b.z, b.w)};
}
__device__ __forceinline__ void build_filter_copies(HY_LAS unsigned char* L, int tid) {
    const HY_LAS bf16_t* sc = (const HY_LAS bf16_t*)(L + SCR);
    for (int gi = tid; gi < 8 * 518; gi += NT) {
        const int d = gi / 518, qg = gi - d * 518;
        const int top = 4095 + d - 8 * qg;
        unsigned v[8];
#pragma unroll
        for (int e = 0; e < 8; ++e) { const int ix = top - e; v[e] = (ix >= 0 && ix <= 4094) ? (unsigned)sc[ix] : 0u; }
        *(HY_LAS u32x4*)(L + FILT + d * F_STRIDE + qg * 16) = (u32x4){v[0] | (v[1] << 16), v[2] | (v[3] << 16), v[4] | (v[5] << 16), v[6] | (v[7] << 16)};
    }
}
__device__ __forceinline__ void conv_loop(HY_LAS unsigned char* L, f32x4 (&acc)[16], int w, int lane) {
    const int i = lane & 15, g = lane >> 4;
    const HY_LAS unsigned char* aBase = L + FILT + (i & 7) * F_STRIDE + 2 * (2048 + 8 * g - (i & ~7)) - 32 * (16 * w);
    const HY_LAS unsigned char* bBase = L + UIMG + i * U_STRIDE + 16 * g;
    bf16x8 ring[16];
#pragma unroll
    for (int s = 0; s < 16; ++s) ring[s] = *(const HY_LAS bf16x8*)(aBase - 32 * s);
#pragma unroll
    for (int m = 0; m < 16; ++m) acc[m] = (f32x4){0.f, 0.f, 0.f, 0.f};
    bf16x8 bfrag = *(const HY_LAS bf16x8*)(bBase);
    for (int k8 = 0; k8 < 8; ++k8) {
        const HY_LAS unsigned char* aK = aBase + 512 * k8;
        const HY_LAS unsigned char* bK = bBase + 512 * k8;
#pragma unroll
        for (int u = 0; u < 8; ++u) {
            bf16x8 bnext = bfrag;
            if (u < 7 || k8 < 7) bnext = *(const HY_LAS bf16x8*)(bK + 64 * (u + 1));
            acc[14] = __builtin_amdgcn_mfma_f32_16x16x32_bf16(ring[(14 - 2 * u) & 15], bfrag, acc[14], 0, 0, 0);
            acc[15] = __builtin_amdgcn_mfma_f32_16x16x32_bf16(ring[(15 - 2 * u) & 15], bfrag, acc[15], 0, 0, 0);
            if (u < 7 || k8 < 7) {
                ring[(14 - 2 * u) & 15] = *(const HY_LAS bf16x8*)(aK + 64 * u + 64);
                ring[(15 - 2 * u) & 15] = *(const HY_LAS bf16x8*)(aK + 64 * u + 32);
            }
#pragma unroll
            for (int m = 0; m < 14; ++m) acc[m] = __builtin_amdgcn_mfma_f32_16x16x32_bf16(ring[(m - 2 * u) & 15], bfrag, acc[m], 0, 0, 0);
            bfrag = bnext;
            __builtin_amdgcn_sched_barrier(0);
        }
    }
}
__device__ __forceinline__ void gate_acc(const ConvW cw, HY_LAS unsigned char* L, f32x4 (&acc)[16], float bias, int w, int lane) {
    const int j = lane & 15, g = lane >> 4;
    const float cw0 = cw.w0, cw1 = cw.w1, cw2 = cw.w2, cb = cw.b;
#pragma unroll
    for (int m = 0; m < 16; ++m) {
        const int t4 = 256 * w + 16 * m + 4 * g, tt0 = t4 & 63;
        const u32x2 uu = *(const HY_LAS u32x2*)(L + UIMG + j * U_STRIDE + t4 * 2);
        const HY_LAS unsigned char* xb = L + FILT + j * U_STRIDE + 8 + t4 * 2;
        const u32x2 xx = *(const HY_LAS u32x2*)xb;
        const float xl = tt0 > 0 ? bf2f(*(const HY_LAS bf16_t*)(xb - 2)) : 0.f;
        const float xr = tt0 < 60 ? bf2f(*(const HY_LAS bf16_t*)(xb + 8)) : 0.f;
        const float x0 = __uint_as_float(xx.x << 16), x1 = __uint_as_float(xx.x & 0xffff0000u), x2 = __uint_as_float(xx.y << 16), x3 = __uint_as_float(xx.y & 0xffff0000u);
        const float u0 = __uint_as_float(uu.x << 16), u1 = __uint_as_float(uu.x & 0xffff0000u), u2 = __uint_as_float(uu.y << 16), u3 = __uint_as_float(uu.y & 0xffff0000u);
        const float g0 = cb + cw1 * x0 + cw0 * xl + cw2 * x1, g1 = cb + cw1 * x1 + cw0 * x0 + cw2 * x2, g2 = cb + cw1 * x2 + cw0 * x1 + cw2 * x3, g3 = cb + cw1 * x3 + cw0 * x2 + cw2 * xr;
        acc[m][0] = g0 * (acc[m][0] + bias * u0); acc[m][1] = g1 * (acc[m][1] + bias * u1); acc[m][2] = g2 * (acc[m][2] + bias * u2); acc[m][3] = g3 * (acc[m][3] + bias * u3);
        if ((m & 3) == 3) __builtin_amdgcn_sched_barrier(0);
    }
}
__device__ __forceinline__ void store_acc_uimg(HY_LAS unsigned char* L, const f32x4 (&acc)[16], int w, int lane) {
    const int j = lane & 15, g = lane >> 4;
#pragma unroll
    for (int m = 0; m < 16; ++m) {
        const int t4 = 256 * w + 16 * m + 4 * g;
        *(HY_LAS u32x2*)(L + UIMG + j * U_STRIDE + t4 * 2) = (u32x2){pk2(acc[m][0], acc[m][1]), pk2(acc[m][2], acc[m][3])};
    }
}
}

__device__ __forceinline__ void ph_hyena_task(const P& p, unsigned char* ldsb, int c) {
    const int w = __builtin_amdgcn_readfirstlane(threadIdx.x >> 6);
    const bf16_t* PHYT = (const bf16_t*)((unsigned char*)p.out + DO_PHYT);
    bf16_t* YT = (bf16_t*)(p.ws + WS_YT);
    const float* HF = (const float*)((unsigned char*)p.out + DO_HF);
    HY_LAS unsigned char* L = (HY_LAS unsigned char*)ldsb;
    {
        const int tid = opaque_tid();
        const int lane = tid & 63;
        hy::f32x4 acc[16];
        const hy::ConvW cwv = hy::load_convw(p, c), cwx1 = hy::load_convw(p, 512 + c), cwx2 = hy::load_convw(p, 1024 + c);
        const float bias0 = hy::uni(p.hy_bias[c]), bias1 = hy::uni(p.hy_bias[512 + c]);
        __syncthreads();
        hy::load_u_image(cwv, L, PHYT + (size_t)c * NTOK, tid);
        hy::load_filter_scr(L, HF + (size_t)c * 4096, tid);
        __syncthreads();
        hy::build_filter_copies(L, tid);
        __syncthreads();
        hy::u32x4 rawx[8];
        hy::raw_rows_load(rawx, PHYT + (size_t)(512 + c) * NTOK, tid);
        hy::load_filter_scr(L, HF + (size_t)(512 + c) * 4096, tid);
        hy::conv_loop(L, acc, w, lane);
        __syncthreads();
        hy::raw_rows_store(L, rawx, tid);
        __syncthreads();
        hy::gate_acc(cwx1, L, acc, bias0, w, lane);
        __syncthreads();
        hy::store_acc_uimg(L, acc, w, lane);
        hy::build_filter_copies(L, tid);
        __syncthreads();
        hy::raw_rows_load(rawx, PHYT + (size_t)(1024 + c) * NTOK, tid);
        hy::conv_loop(L, acc, w, lane);
        __syncthreads();
        hy::raw_rows_store(L, rawx, tid);
        __syncthreads();
        hy::gate_acc(cwx2, L, acc, bias1, w, lane);
        hy::store_acc_uimg(L, acc, w, lane);
        __syncthreads();
#pragma unroll 2
        for (int k = 0; k < 8; ++k) {
            const int idx = tid + NT * k, b = idx >> 8, t8 = (idx & 255) * 8;
            *(hy::u32x4*)(YT + (size_t)c * NTOK + b * SEQ + t8) = *(const HY_LAS hy::u32x4*)(L + hy::UIMG + b * hy::U_STRIDE + t8 * 2);
        }
    }
}


namespace hg {
#define HG_LAS __attribute__((address_space(3)))
typedef short bf16x8 __attribute__((ext_vector_type(8)));
typedef float f32x4 __attribute__((ext_vector_type(4)));
typedef unsigned u32x4 __attribute__((ext_vector_type(4)));
typedef unsigned u32x2 __attribute__((ext_vector_type(2)));
constexpr int QROW = 272, KROW = 40;
constexpr int O_QT = 0, O_KBAR = 16 * QROW, O_KHAT = 2 * 16 * QROW, O_VT = O_KHAT + 128 * KROW, O_BDEC = O_VT + 128 * KROW, SET_BYTES = O_BDEC + 512;
constexpr int NCH_CTX = CTXL / 16, NCH = NCH_CTX + SEQ / 16;
template <int CTRL> __device__ __forceinline__ float dpp_mul(float x) {
    return x * __uint_as_float(__builtin_amdgcn_update_dpp(0x3f800000u, __float_as_uint(x), CTRL, 0xf, 0xf, false));
}
struct Raw { unsigned short q[4], v[4], z[4]; };
}

__device__ __forceinline__ void ph_hgrn_task(const P& p, unsigned char* ldsb, int item) {
    using namespace hg;
    const int tid = opaque_tid();
    const int lane = tid & 63, w = __builtin_amdgcn_readfirstlane(tid >> 6), j = lane & 15, g = lane >> 4;
    const int dir = item & 1, h = (item >> 1) & 3, b = item >> 3;
    const float* LB = (const float*)(p.ws + WS_LB);
    const bf16_t* PC = (const bf16_t*)(p.ws + WS_PC);
    const bf16_t* PHG = (const bf16_t*)(p.ws + WS_PHG);
    bf16_t* OFB = (bf16_t*)(p.ws + WS_OFB) + (size_t)dir * NTOK * 512;
    HG_LAS unsigned char* L = (HG_LAS unsigned char*)ldsb;
    float lb0[2], lb1[2];
#pragma unroll
    for (int pp = 0; pp < 2; ++pp) { const float2 t = *(const float2*)(LB + dir * 512 + h * 128 + 16 * w + 8 * pp + 2 * g); lb0[pp] = t.x; lb1[pp] = t.y; }
    const int zoff_c = dir == 0 ? 512 : 1024, zoff_l = dir == 0 ? 1024 : 1536;
    const bf16_t* rowc = PC + (size_t)b * CTXL * 1536 + h * 128 + 16 * w + 2 * g;
    const bf16_t* rowl = PHG + (size_t)b * SEQ * 2560 + h * 128 + 16 * w + 2 * g;
    struct Raw2 { unsigned q[2], v[2], z[2]; };
    auto load_raw = [&](int n, Raw2& r) {
        if (n < NCH_CTX) {
            const int tt = 16 * n + j, t = dir == 0 ? tt : (CTXL - 1 - tt);
            const bf16_t* row = rowc + (size_t)t * 1536;
#pragma unroll
            for (int pp = 0; pp < 2; ++pp) { r.q[pp] = 0u; r.v[pp] = *(const unsigned*)(row + 8 * pp); r.z[pp] = *(const unsigned*)(row + zoff_c + 8 * pp); }
        } else {
            const int tt = 16 * (n - NCH_CTX) + j, t = dir == 0 ? tt : (SEQ - 1 - tt);
            const bf16_t* row = rowl + (size_t)t * 2560;
#pragma unroll
            for (int pp = 0; pp < 2; ++pp) { r.q[pp] = *(const unsigned*)(row + 8 * pp); r.v[pp] = *(const unsigned*)(row + 512 + 8 * pp); r.z[pp] = *(const unsigned*)(row + zoff_l + 8 * pp); }
        }
    };
    const int qoff = j * QROW + 2 * (16 * w + 2 * g), koff = (16 * w + 2 * g) * KROW + 2 * j;
    auto prep_pass = [&](const Raw2& r, HG_LAS unsigned char* S0, const int pp) {
        {
            const float za = __uint_as_float(r.z[pp] << 16), zb = __uint_as_float(r.z[pp] & 0xffff0000u);
            const float qa = __uint_as_float(r.q[pp] << 16), qb = __uint_as_float(r.q[pp] & 0xffff0000u);
            const float fa = lb0[pp] + (1.0f - lb0[pp]) * __builtin_amdgcn_rcpf(1.0f + __builtin_amdgcn_exp2f(-1.4426950408889634f * za));
            const float fb = lb1[pp] + (1.0f - lb1[pp]) * __builtin_amdgcn_rcpf(1.0f + __builtin_amdgcn_exp2f(-1.4426950408889634f * zb));
            float Pa = dpp_mul<0x111>(fa), Pb = dpp_mul<0x111>(fb);
            Pa = dpp_mul<0x112>(Pa); Pb = dpp_mul<0x112>(Pb); Pa = dpp_mul<0x114>(Pa); Pb = dpp_mul<0x114>(Pb); Pa = dpp_mul<0x118>(Pa); Pb = dpp_mul<0x118>(Pb);
            const float Ca = __uint_as_float(__builtin_amdgcn_ds_bpermute(4 * (lane | 15), __float_as_uint(Pa)));
            const float Cb = __uint_as_float(__builtin_amdgcn_ds_bpermute(4 * (lane | 15), __float_as_uint(Pb)));
            const float ia = __builtin_amdgcn_rcpf(fmaxf(Pa, 1e-30f)), ib = __builtin_amdgcn_rcpf(fmaxf(Pb, 1e-30f));
            const float ka = (1.0f - fa) * ia, kb = (1.0f - fb) * ib;
            const float qva = qa * __builtin_amdgcn_rcpf(1.0f + __builtin_amdgcn_exp2f(-1.4426950408889634f * qa)) * (0.08838834764831845f * Pa);
            const float qvb = qb * __builtin_amdgcn_rcpf(1.0f + __builtin_amdgcn_exp2f(-1.4426950408889634f * qb)) * (0.08838834764831845f * Pb);
            *(HG_LAS unsigned*)(S0 + O_QT + qoff + 16 * pp) = cvtpk(qva, qvb);
            *(HG_LAS unsigned*)(S0 + O_KBAR + qoff + 16 * pp) = cvtpk(ka, kb);
            const unsigned kh = cvtpk(ka * Ca, kb * Cb);
            *(HG_LAS bf16_t*)(S0 + O_KHAT + koff + 8 * pp * KROW) = (bf16_t)(kh & 0xffffu);
            *(HG_LAS bf16_t*)(S0 + O_KHAT + koff + (8 * pp + 1) * KROW) = (bf16_t)(kh >> 16);
            *(HG_LAS bf16_t*)(S0 + O_VT + koff + 8 * pp * KROW) = (bf16_t)(r.v[pp] & 0xffffu);
            *(HG_LAS bf16_t*)(S0 + O_VT + koff + (8 * pp + 1) * KROW) = (bf16_t)(r.v[pp] >> 16);
            if (j == 15) { typedef float f32x2_t __attribute__((ext_vector_type(2))); *(HG_LAS f32x2_t*)(S0 + O_BDEC + 4 * (16 * w + 8 * pp + 2 * g)) = (f32x2_t){Pa, Pb}; }
        }
    };
    auto prep = [&](const Raw2& r, HG_LAS unsigned char* S0) { prep_pass(r, S0, 0); prep_pass(r, S0, 1); };
    const float mk0 = (4 * g + 0) <= j ? 1.f : 0.f, mk1 = (4 * g + 1) <= j ? 1.f : 0.f, mk2 = (4 * g + 2) <= j ? 1.f : 0.f, mk3 = (4 * g + 3) <= j ? 1.f : 0.f;
    const int sc_off = j * QROW + 16 * g, vt_off = (16 * w + j) * KROW + 8 * g, qt8_off = j * QROW + 8 * g, kh_off = j * KROW + 8 * g;
    bf16_t* orow = OFB + (size_t)b * SEQ * 512 + h * 128 + 16 * w + 4 * g;
    f32x4 S[8];
#pragma unroll
    for (int t = 0; t < 8; ++t) S[t] = (f32x4){0.f, 0.f, 0.f, 0.f};
    constexpr int RDEPTH = 4;
    static_assert(NCH % RDEPTH == 0, "chunk loop is unrolled by the prefetch depth");
    Raw2 ring[RDEPTH];
    load_raw(0, ring[0]);
    __syncthreads();
    prep(ring[0], L);
#pragma unroll
    for (int c = 1; c <= RDEPTH; ++c) load_raw(c, ring[c % RDEPTH]);
    __syncthreads();
    auto chunk = [&](int n, int phase, Raw2& slot) {
        HG_LAS unsigned char* Sc = L + (n & 1) * SET_BYTES;
        HG_LAS unsigned char* Sn = L + ((n + 1) & 1) * SET_BYTES;
        bf16x8 kaf[4], qaf[4]; u32x2 qb0[4], qb1[4], krf[8]; f32x4 bdf[8];
#pragma unroll
        for (int kp = 0; kp < 4; ++kp) { kaf[kp] = *(const HG_LAS bf16x8*)(Sc + O_KBAR + sc_off + 64 * kp); qaf[kp] = *(const HG_LAS bf16x8*)(Sc + O_QT + sc_off + 64 * kp); }
        const u32x2 vraw = *(const HG_LAS u32x2*)(Sc + O_VT + vt_off);
#pragma unroll
        for (int pq = 0; pq < 4; ++pq) { qb0[pq] = *(const HG_LAS u32x2*)(Sc + O_QT + qt8_off + 64 * pq); qb1[pq] = *(const HG_LAS u32x2*)(Sc + O_QT + qt8_off + 64 * pq + 32); }
#pragma unroll
        for (int t = 0; t < 8; ++t) { bdf[t] = *(const HG_LAS f32x4*)(Sc + O_BDEC + 64 * t + 16 * g); krf[t] = *(const HG_LAS u32x2*)(Sc + O_KHAT + kh_off + 16 * KROW * t); }
        __builtin_amdgcn_sched_barrier(0);
        const u32x4 vf = (u32x4){vraw.x, vraw.y, 0u, 0u};
        f32x4 sc = (f32x4){0.f, 0.f, 0.f, 0.f};
#pragma unroll
        for (int kp = 0; kp < 4; ++kp) sc = __builtin_amdgcn_mfma_f32_16x16x32_bf16(kaf[kp], qaf[kp], sc, 0, 0, 0);
        f32x4 oT = (f32x4){0.f, 0.f, 0.f, 0.f};
#pragma unroll
        for (int pq = 0; pq < 4; ++pq) {
            u32x4 a; a.x = cvtpk(S[2 * pq][0], S[2 * pq][1]); a.y = cvtpk(S[2 * pq][2], S[2 * pq][3]); a.z = cvtpk(S[2 * pq + 1][0], S[2 * pq + 1][1]); a.w = cvtpk(S[2 * pq + 1][2], S[2 * pq + 1][3]);
            const u32x4 bb = (u32x4){qb0[pq].x, qb0[pq].y, qb1[pq].x, qb1[pq].y};
            oT = __builtin_amdgcn_mfma_f32_16x16x32_bf16(__builtin_bit_cast(bf16x8, a), __builtin_bit_cast(bf16x8, bb), oT, 0, 0, 0);
        }
#pragma unroll
        for (int t = 0; t < 8; ++t) {
            const u32x4 ka = (u32x4){krf[t].x, krf[t].y, 0u, 0u};
            S[t] = __builtin_amdgcn_mfma_f32_16x16x32_bf16(__builtin_bit_cast(bf16x8, ka), __builtin_bit_cast(bf16x8, vf), S[t] * bdf[t], 0, 0, 0);
        }
        u32x4 pf;
        pf.x = cvtpk(sc[0] * mk0, sc[1] * mk1); pf.y = cvtpk(sc[2] * mk2, sc[3] * mk3); pf.z = 0u; pf.w = 0u;
        oT = __builtin_amdgcn_mfma_f32_16x16x32_bf16(__builtin_bit_cast(bf16x8, vf), __builtin_bit_cast(bf16x8, pf), oT, 0, 0, 0);
        if (n + 1 < NCH) prep(slot, Sn);
        if (n + 1 + RDEPTH < NCH) load_raw(n + 1 + RDEPTH, slot);
        if (n >= NCH_CTX) {
            const int tt = 16 * (n - NCH_CTX) + j, t = dir == 0 ? tt : (SEQ - 1 - tt);
            *(u32x2*)(orow + (size_t)t * 512) = (u32x2){cvtpk(oT[0], oT[1]), cvtpk(oT[2], oT[3])};
        }
        lds_barrier();
    };
    for (int n0 = 0; n0 < NCH; n0 += RDEPTH) {
#pragma unroll
        for (int u = 0; u < RDEPTH; ++u) chunk(n0 + u, u % 3, ring[(u + 1) % RDEPTH]);
    }
}

template <int QW = 0, bool DO_HGRN = true, bool DO_QUEUE = true, bool DO_HY = true, bool DO_CV = true>
__device__ __forceinline__ void ph_mixers(const P& p, unsigned char* ldsb) {
    unsigned* qhead = (unsigned*)(p.ws + WS_CTL) + CW_QHEAD + QW;
    HG_LAS unsigned* bc = (HG_LAS unsigned*)(ldsb + LDS_BYTES - 16);
    if (DO_HGRN && blockIdx.x < NB * HEADS * 2) ph_hgrn_task(p, ldsb, blockIdx.x);
    constexpr int N_CONV_WG = 48, ITEMS_PER_WG = N_EXPERT_ITEMS / N_CONV_WG;
    static_assert(N_EXPERT_ITEMS % N_CONV_WG == 0 && ITEMS_PER_WG % CONV_DEPTH == 0, "conversion split");
    if (DO_CV && blockIdx.x >= NB * HEADS * 2 && blockIdx.x < NB * HEADS * 2 + N_CONV_WG)
        conv_run([&](int r) { return conv_expert_item(p, r); }, (blockIdx.x - NB * HEADS * 2) * ITEMS_PER_WG, ITEMS_PER_WG, (float*)ldsb);
    if (!DO_QUEUE) return;
    for (;;) {
        __syncthreads();
        if (threadIdx.x == 0) *bc = atomicAdd(qhead, 1u);
        __syncthreads();
        const int c = (int)*bc;
        if (c >= 512) break;
        if (DO_HY) ph_hyena_task(p, ldsb, c);
    }
}

__device__ __forceinline__ void ph_mixprep(const P& p, float* lds) {
    const int tid = opaque_tid(), lane = tid & 63, wv = tid >> 6;
    const bf16_t* YT = (const bf16_t*)(p.ws + WS_YT);
    bf16_t* MIXA = (bf16_t*)(p.ws + WS_MIXA);
    bf16_t* yl = (bf16_t*)lds;
    float* part = lds + (512 * 72 * 2) / 4;
    typedef unsigned u32x4_t __attribute__((ext_vector_type(4)));
    u32x4_t tl[8];
    auto tload = [&](int tile) {
#pragma unroll
        for (int q = 0; q < 8; ++q) { const int i = tid + NT * q, row = i >> 3, ch = i & 7; tl[q] = *(const u32x4_t*)(YT + (size_t)row * NTOK + tile * 64 + ch * 8); }
    };
    if (blockIdx.x < NTOK / 64) tload(blockIdx.x);
    for (int tile = blockIdx.x; tile < NTOK / 64; tile += gridDim.x) {
        const int tok0 = tile * 64;
        __syncthreads();
#pragma unroll
        for (int q = 0; q < 8; ++q) { const int i = tid + NT * q, row = i >> 3, ch = i & 7; *(u32x4_t*)(yl + row * 72 + ch * 8) = tl[q]; }
        __syncthreads();
        if (tile + (int)gridDim.x < NTOK / 64) tload(tile + gridDim.x);
        const int tok = tid & 63, pt = tid >> 6;
        float ss = 0.f;
        for (int c = pt * 64; c < pt * 64 + 64; ++c) { const float v = bf2f(yl[c * 72 + tok]); ss += v * v; }
        part[pt * 64 + tok] = ss;
        __syncthreads();
        float tot = 0.f;
#pragma unroll
        for (int k = 0; k < 8; ++k) tot += part[k * 64 + tok];
        const float rstd = rsqrtf(tot * (1.f / 512.f) + EPS);
        bf16_t* dst = MIXA + (size_t)(tok0 + tok) * D + pt * 64;
#pragma unroll
        for (int j = 0; j < 8; ++j) {
            const f32x4_t ga = *(const f32x4_t*)(p.hy_norm_g + pt * 64 + j * 8), gb = *(const f32x4_t*)(p.hy_norm_g + pt * 64 + j * 8 + 4);
            const float gv[8] = {ga.x, ga.y, ga.z, ga.w, gb.x, gb.y, gb.z, gb.w};
            float o[8];
#pragma unroll
            for (int q = 0; q < 8; ++q) { const int c = pt * 64 + j * 8 + q; o[q] = bf2f(yl[c * 72 + tok]) * rstd * gv[q]; }
            *(uint4*)(dst + j * 8) = make_uint4(cvtpk(o[0], o[1]), cvtpk(o[2], o[3]), cvtpk(o[4], o[5]), cvtpk(o[6], o[7]));
        }
    }
    const bf16_t* OFB = (const bf16_t*)(p.ws + WS_OFB);
    const bf16_t* PHG = (const bf16_t*)(p.ws + WS_PHG);
    {
        const int hh = lane >> 4, k8 = (lane & 15) * 8, col = hh * 128 + k8;
        const f32x4_t ng0 = *(const f32x4_t*)(p.hg_norm_g + k8), ng1 = *(const f32x4_t*)(p.hg_norm_g + k8 + 4);
        struct Row3 { uint4 a, b, g; };
        auto ld = [&](int r) { Row3 x; x.a = *(const uint4*)(OFB + (size_t)r * 512 + col); x.b = *(const uint4*)(OFB + (size_t)NTOK * 512 + (size_t)r * 512 + col); x.g = *(const uint4*)(PHG + (size_t)r * 2560 + 2048 + col); return x; };
        for (int rc = blockIdx.x * 8 + wv; rc < NTOK / 16; rc += gridDim.x * 8) {
            Row3 cur = ld(rc * 16), nxt = cur;
            for (int ri = 0; ri < 16; ++ri) {
                const int r = rc * 16 + ri;
                if (ri + 1 < 16) nxt = ld(r + 1);
                const unsigned aw[4] = {cur.a.x, cur.a.y, cur.a.z, cur.a.w}, bw[4] = {cur.b.x, cur.b.y, cur.b.z, cur.b.w}, gw[4] = {cur.g.x, cur.g.y, cur.g.z, cur.g.w};
                float o[8]; float ss = 0.f;
#pragma unroll
                for (int q = 0; q < 4; ++q) { o[2 * q] = __uint_as_float(aw[q] << 16) + __uint_as_float(bw[q] << 16); o[2 * q + 1] = __uint_as_float(aw[q] & 0xffff0000u) + __uint_as_float(bw[q] & 0xffff0000u); ss += o[2 * q] * o[2 * q] + o[2 * q + 1] * o[2 * q + 1]; }
                ss += __shfl_xor(ss, 1); ss += __shfl_xor(ss, 2); ss += __shfl_xor(ss, 4); ss += __shfl_xor(ss, 8);
                const float rstd = rsqrtf(ss * (1.f / 128.f) + EPS);
                const float ngv[8] = {ng0.x, ng0.y, ng0.z, ng0.w, ng1.x, ng1.y, ng1.z, ng1.w};
                unsigned w[4];
#pragma unroll
                for (int q = 0; q < 4; ++q) { const float g0 = __uint_as_float(gw[q] << 16), g1 = __uint_as_float(gw[q] & 0xffff0000u);
                    w[q] = cvtpk(o[2 * q] * rstd * ngv[2 * q] * silu_f(g0), o[2 * q + 1] * rstd * ngv[2 * q + 1] * silu_f(g1)); }
                *(uint4*)(MIXA + (size_t)r * D + 512 + col) = make_uint4(w[0], w[1], w[2], w[3]);
                cur = nxt;
            }
        }
    }
}

struct OutprojSched {
    int G, c; const bf16_t *A, *Bt;
    __device__ __forceinline__ bool next(int i, Unit& u) const {
        const int L = i * G + c; if (L >= 512) return false; int pm, pn; tile_of(L, 128, 4, pm, pn);
        u.a = (const char*)(A + (size_t)pm * 256 * D); u.b = (const char*)(Bt + (size_t)pn * 256 * D); u.c = nullptr; u.aux = nullptr; u.gidx = nullptr; u.ldc = D; u.row0 = pm * 256; u.col0 = pn * 256; return true;
    }
    __device__ __forceinline__ void a_ready(const Unit&) const {}
    __device__ __forceinline__ void done(const Unit&) const {}
};
__device__ __forceinline__ void ph_outproj(const P& p, unsigned char* lds) {
    OutprojSched S{(int)gridDim.x, (int)blockIdx.x, (const bf16_t*)(p.ws + WS_MIXA), (const bf16_t*)(p.ws + WS_WOUTT)};
    pg8::EpiOutProj E{p.x, (const float*)(p.ws + WS_ADA), (bf16_t*)p.out};
    pg8::gemm_phase<pg8::EpiOutProj, OutprojSched, true, true, false>((PG8_LAS unsigned char*)lds, D, S, E);
}

__device__ __forceinline__ void ph_norm2_router(const P& p, float* lds) {
    const int tid = opaque_tid(), lane = tid & 63, wv = tid >> 6;
    const float* ADA = (const float*)(p.ws + WS_ADA);
    const bf16_t* X1 = (const bf16_t*)p.out;
    bf16_t* H2 = (bf16_t*)(p.ws + WS_H2);
    float* AFF = (float*)(p.ws + WS_AFF);
    __syncthreads();
    for (int i = tid; i < D * 4; i += NT) { const int d = i >> 2, e4 = i & 3; const float4 w = ((const float4*)p.router_w)[i];
        lds[(e4 * 4 + 0) * D + d] = w.x; lds[(e4 * 4 + 1) * D + d] = w.y; lds[(e4 * 4 + 2) * D + d] = w.z; lds[(e4 * 4 + 3) * D + d] = w.w; }
    __syncthreads();
    auto ldrow = [&](int r, f32x4_t (&d)[4]) {
#pragma unroll
        for (int j = 0; j < 4; ++j) { const uint2 w = ((const uint2*)(X1 + (size_t)r * (2 * D)))[lane + 64 * j]; d[j] = (f32x4_t){__uint_as_float(w.x << 16), __uint_as_float(w.x & 0xffff0000u), __uint_as_float(w.y << 16), __uint_as_float(w.y & 0xffff0000u)}; }
    };
    for (int rc = blockIdx.x * 8 + wv; rc < NTOK / 16; rc += gridDim.x * 8) {
      const int rbase = rc * 16, b = rbase / SEQ;
      f32x4_t gm[4], hs[4];
#pragma unroll
      for (int j = 0; j < 4; ++j) { const int d4 = lane + 64 * j; const f32x4_t g = ((const f32x4_t*)p.norm2_g)[d4], s1 = ((const f32x4_t*)(ADA + b * 6144 + 4096))[d4]; gm[j] = g * (1.f + s1); hs[j] = ((const f32x4_t*)(ADA + b * 6144 + 3072))[d4]; }
      f32x4_t v[4], vn[4];
      ldrow(rbase, v);
      for (int ri = 0; ri < 16; ++ri) {
        const int r = rbase + ri, t = r % SEQ;
        if (ri + 1 < 16) ldrow(r + 1, vn);
        float ss = 0.f;
#pragma unroll
        for (int j = 0; j < 4; ++j) ss += v[j].x * v[j].x + v[j].y * v[j].y + v[j].z * v[j].z + v[j].w * v[j].w;
        const float rstd = rsqrtf(wave_sum(ss) * (1.f / D) + EPS);
        float lg[16];
#pragma unroll
        for (int e = 0; e < 16; ++e) lg[e] = 0.f;
#pragma unroll
        for (int j = 0; j < 4; ++j) {
            const int d4 = lane + 64 * j;
            const f32x4_t o = v[j] * rstd * gm[j] + hs[j];
            ((uint2*)(H2 + (size_t)r * D))[d4] = make_uint2(cvtpk(o.x, o.y), cvtpk(o.z, o.w));
#pragma unroll
            for (int e = 0; e < 16; ++e) {
                const float4 w = *(const float4*)&lds[e * D + d4 * 4];
                lg[e] += o.x * w.x + o.y * w.y + o.z * w.z + o.w * w.w;
            }
            __builtin_amdgcn_sched_barrier(0);
        }
#pragma unroll
        for (int i = 0; i < 8; ++i) { const bool hi = lane & 1; const float keep = hi ? lg[2 * i + 1] : lg[2 * i], send = hi ? lg[2 * i] : lg[2 * i + 1]; lg[i] = keep + __shfl_xor(send, 1); }
#pragma unroll
        for (int i = 0; i < 4; ++i) { const bool hi = lane & 2; const float keep = hi ? lg[2 * i + 1] : lg[2 * i], send = hi ? lg[2 * i] : lg[2 * i + 1]; lg[i] = keep + __shfl_xor(send, 2); }
#pragma unroll
        for (int i = 0; i < 2; ++i) { const bool hi = lane & 4; const float keep = hi ? lg[2 * i + 1] : lg[2 * i], send = hi ? lg[2 * i] : lg[2 * i + 1]; lg[i] = keep + __shfl_xor(send, 4); }
        { const bool hi = lane & 8; const float keep = hi ? lg[1] : lg[0], send = hi ? lg[0] : lg[1]; lg[0] = keep + __shfl_xor(send, 8); }
        float lgt = lg[0];
        lgt += __shfl_xor(lgt, 16); lgt += __shfl_xor(lgt, 32);
        float mx = lgt;
        mx = fmaxf(mx, __shfl_xor(mx, 1)); mx = fmaxf(mx, __shfl_xor(mx, 2)); mx = fmaxf(mx, __shfl_xor(mx, 4)); mx = fmaxf(mx, __shfl_xor(mx, 8));
        const float ex = expf(lgt - mx);
        float den = ex;
        den += __shfl_xor(den, 1); den += __shfl_xor(den, 2); den += __shfl_xor(den, 4); den += __shfl_xor(den, 8);
        if (lane < 16) AFF[((size_t)b * 16 + lane) * SEQ + t] = ex / den;
#pragma unroll
        for (int j = 0; j < 4; ++j) v[j] = vn[j];
      }
    }
}

__device__ __forceinline__ void ph_topk(const P& p, float* lds) {
    const int tid = opaque_tid(), lane = tid & 63, wv = tid >> 6;
    const float* AFF = (const float*)(p.ws + WS_AFF);
    int* IDX = (int*)(p.ws + WS_IDX);
    float* GATE = (float*)(p.ws + WS_GATE);
    int* INV = (int*)(p.ws + WS_INV);
    unsigned* hist = (unsigned*)lds;
    unsigned* ctl = hist + 256;
    unsigned* wtot = hist + 272;
    for (int item = blockIdx.x; item < NB * NE; item += gridDim.x) {
        const int b = item >> 4, e = item & 15;
        const uint4 kk = ((const uint4*)(AFF + (size_t)item * SEQ))[tid];
        const unsigned key[4] = {kk.x, kk.y, kk.z, kk.w};
        unsigned prefix = 0u, need = CAP;
#pragma unroll
        for (int pass = 3; pass >= 0; --pass) {
            __syncthreads();
            if (tid < 256) hist[tid] = 0u;
            __syncthreads();
#pragma unroll
            for (int q = 0; q < 4; ++q) {
                const bool in = (pass == 3) || ((key[q] >> (8 * (pass + 1))) == prefix);
                if (in) atomicAdd(&hist[(key[q] >> (8 * pass)) & 255u], 1u);
            }
            __syncthreads();
            if (wv == 0) {
                const uint4 h4 = ((const uint4*)hist)[lane];
                const unsigned loc = h4.x + h4.y + h4.z + h4.w;
                unsigned suf = loc;
#pragma unroll
                for (int o = 1; o < 64; o <<= 1) { const unsigned y = __shfl_down(suf, o); if (lane + o < 64) suf += y; }
                const unsigned above = suf - loc;
                unsigned c3 = above + h4.w, c2 = c3 + h4.z, c1 = c2 + h4.y, c0 = c1 + h4.x;
                int bin = -1; unsigned nneed = 0u;
                if (above < need && c0 >= need) {
                    if (c3 >= need) { bin = 4 * lane + 3; nneed = need - above; }
                    else if (c2 >= need) { bin = 4 * lane + 2; nneed = need - c3; }
                    else if (c1 >= need) { bin = 4 * lane + 1; nneed = need - c2; }
                    else { bin = 4 * lane; nneed = need - c1; }
                    ctl[0] = (prefix << 8) | (unsigned)bin; ctl[1] = nneed;
                }
            }
            __syncthreads();
            prefix = ctl[0]; need = ctl[1];
        }
        unsigned cgt = 0u, ceq = 0u;
#pragma unroll
        for (int q = 0; q < 4; ++q) { cgt += key[q] > prefix ? 1u : 0u; ceq += key[q] == prefix ? 1u : 0u; }
        unsigned sgt = cgt, seq = ceq;
#pragma unroll
        for (int o = 1; o < 64; o <<= 1) { const unsigned y1 = __shfl_up(sgt, o), y2 = __shfl_up(seq, o); if (lane >= o) { sgt += y1; seq += y2; } }
        if (lane == 63) { wtot[wv] = sgt; wtot[8 + wv] = seq; }
        __syncthreads();
        unsigned bgt = 0u, beq = 0u, ngt = 0u;
#pragma unroll
        for (int k = 0; k < 8; ++k) { const unsigned a = wtot[k], c = wtot[8 + k]; if (k < wv) { bgt += a; beq += c; } ngt += a; }
        unsigned rgt = bgt + sgt - cgt, req = beq + seq - ceq;
#pragma unroll
        for (int q = 0; q < 4; ++q) {
            const int t = 4 * tid + q; int slot = -1;
            if (key[q] > prefix) { slot = (int)rgt; ++rgt; }
            else if (key[q] == prefix) { if (req < need) slot = (int)(ngt + req); ++req; }
            if (slot >= 0) { IDX[item * CAP + slot] = t; GATE[item * CAP + slot] = __uint_as_float(key[q]); }
            INV[((size_t)b * SEQ + t) * 16 + e] = slot;
        }
    }
}

struct MoeUpSched {
    int G, c, round; const bf16_t *H2, *W13T; bf16_t* HMID; const int* IDX;
    __device__ __forceinline__ bool next(int i, Unit& u) const {
        if (i >= 4 || c >= 256) return false;
        const int x = c & 7, q = c >> 3, Q = q >> 2, mth = q & 3, item = (Q * 4 + round) * 8 + x, b = item >> 4, e = item & 15, nt = 4 * i + mth;
        u.a = (const char*)(H2 + (size_t)b * SEQ * D); u.b = (const char*)(W13T + ((size_t)e * 4096 + nt * 256) * D); u.c = HMID + (size_t)item * CAP * FF + nt * 128;
        u.aux = nullptr; u.gidx = IDX + item * CAP; u.ldc = FF; u.row0 = 0; u.col0 = 0; return true;
    }
    __device__ __forceinline__ void a_ready(const Unit&) const {}
    __device__ __forceinline__ void done(const Unit&) const {}
};
struct MoeDownSched {
    int G, c; const bf16_t *HMID, *W2T; bf16_t* YS; const float* GATE;
    __device__ __forceinline__ bool next(int i, Unit& u) const {
        if (i >= 4 || c >= 256) return false;
        const int x = c & 7, q = c >> 3, Q = q >> 2, nt = q & 3, item = (Q * 4 + i) * 8 + x, e = item & 15;
        u.a = (const char*)(HMID + (size_t)item * CAP * FF); u.b = (const char*)(W2T + ((size_t)e * 1024 + nt * 256) * FF); u.c = YS + (size_t)item * CAP * D + nt * 256;
        u.aux = GATE + item * CAP; u.gidx = nullptr; u.ldc = D; u.row0 = 0; u.col0 = 0; return true;
    }
    __device__ __forceinline__ void a_ready(const Unit&) const {}
    __device__ __forceinline__ void done(const Unit&) const {}
};
__device__ __forceinline__ void ph_moe_up(const P& p, unsigned char* lds) {
    pg8::EpiSwiGLU E;
    for (int round = 0; round < 4; ++round) {
        MoeUpSched S{(int)gridDim.x, (int)blockIdx.x, round, (const bf16_t*)(p.ws + WS_H2), (const bf16_t*)(p.ws + WS_W13T), (bf16_t*)(p.ws + WS_HMID), (const int*)(p.ws + WS_IDX)};
        pg8::gemm_phase<pg8::EpiSwiGLU, MoeUpSched, true, true, true>((PG8_LAS unsigned char*)lds, D, S, E);
    }
}
__device__ __forceinline__ void ph_moe_down(const P& p, unsigned char* lds) {
    MoeDownSched S{(int)gridDim.x, (int)blockIdx.x, (const bf16_t*)(p.ws + WS_HMID), (const bf16_t*)(p.ws + WS_W2T), (bf16_t*)(p.ws + WS_YS), (const float*)(p.ws + WS_GATE)};
    pg8::EpiDown E;
    pg8::gemm_phase<pg8::EpiDown, MoeDownSched, true, true, false>((PG8_LAS unsigned char*)lds, FF, S, E);
}

__device__ __forceinline__ void ph_final(const P& p) {
    const int tid = opaque_tid(), lane = tid & 63, wv = tid >> 6;
    const float* ADA = (const float*)(p.ws + WS_ADA);
    const bf16_t* YS = (const bf16_t*)(p.ws + WS_YS);
    const int* INV = (const int*)(p.ws + WS_INV);
    float* X = p.out;
    constexpr int NR = 4;
    for (int rc = blockIdx.x * 8 + wv; rc < NTOK / 16; rc += gridDim.x * 8)
    for (int r0 = rc * 16; r0 < rc * 16 + 16; r0 += NR) {
        const int b = r0 / SEQ;
        const float* g2 = ADA + b * 6144 + 5120;
        int myinv[NR]; f32x4_t xv[NR][4]; f32x4_t acc[NR][4];
#pragma unroll
        for (int rr = 0; rr < NR; ++rr) {
            myinv[rr] = INV[(size_t)(r0 + rr) * 16 + (lane & 15)];
#pragma unroll
            for (int j = 0; j < 4; ++j) { const uint2 w = ((const uint2*)(X + (size_t)(r0 + rr) * D))[lane + 64 * j];
                xv[rr][j] = (f32x4_t){__uint_as_float(w.x << 16), __uint_as_float(w.x & 0xffff0000u), __uint_as_float(w.y << 16), __uint_as_float(w.y & 0xffff0000u)}; acc[rr][j] = (f32x4_t){0.f, 0.f, 0.f, 0.f}; }
        }
#pragma unroll
        for (int rr = 0; rr < NR; ++rr) {
            unsigned m = (unsigned)(__ballot(myinv[rr] >= 0) & 0xffffull);
            while (m) {
                uint2 w[4][4]; int ne = 0;
#pragma unroll
                for (int k = 0; k < 4; ++k) {
                    if (m) {
                        const int e = __builtin_ctz(m); m &= m - 1u; ne = k + 1;
                        const int slot = __shfl(myinv[rr], e);
                        const uint2* yr = (const uint2*)(YS + ((size_t)(b * 16 + e) * CAP + slot) * D);
#pragma unroll
                        for (int j = 0; j < 4; ++j) w[k][j] = yr[lane + 64 * j];
                    }
                }
#pragma unroll
                for (int k = 0; k < 4; ++k) {
                    if (k < ne) {
#pragma unroll
                        for (int j = 0; j < 4; ++j) { acc[rr][j].x += __uint_as_float(w[k][j].x << 16); acc[rr][j].y += __uint_as_float(w[k][j].x & 0xffff0000u); acc[rr][j].z += __uint_as_float(w[k][j].y << 16); acc[rr][j].w += __uint_as_float(w[k][j].y & 0xffff0000u); }
                    }
                }
            }
        }
#pragma unroll
        for (int rr = 0; rr < NR; ++rr) {
            f32x4_t v[4]; float ss = 0.f;
#pragma unroll
            for (int j = 0; j < 4; ++j) {
                const f32x4_t g = ((const f32x4_t*)g2)[lane + 64 * j];
                v[j] = xv[rr][j] + g * acc[rr][j];
                ss += v[j].x * v[j].x + v[j].y * v[j].y + v[j].z * v[j].z + v[j].w * v[j].w;
            }
            ss = wave_sum(ss);
            const float rstd = rsqrtf(ss * (1.f / D) + EPS);
#pragma unroll
            for (int j = 0; j < 4; ++j) {
                const f32x4_t g = ((const f32x4_t*)p.final_g)[lane + 64 * j];
                ((f32x4_t*)(X + (size_t)(r0 + rr) * D))[lane + 64 * j] = v[j] * rstd * g;
            }
        }
    }
}

#define LAS __attribute__((address_space(3)))
#define XB_TMO      128
#define XB_XCNT(j)  (256  + 64 * (j))
#define XB_XSUB(j)  (1280 + 64 * (j))
#define XB_XGEN(j)  (2304 + 64 * (j))
#define XB_TOP      3328
#define XB_TOPGEN   3392
#define XCD_BAR_WORDS 3456
#define XB_SPIN_CAP (1u << 18)

__device__ __forceinline__ unsigned xb_ld(unsigned* p)              { return __hip_atomic_load(p, __ATOMIC_RELAXED, __HIP_MEMORY_SCOPE_AGENT); }
__device__ __forceinline__ unsigned xb_add(unsigned* p, unsigned v) { return __hip_atomic_fetch_add(p, v, __ATOMIC_RELAXED, __HIP_MEMORY_SCOPE_AGENT); }
__device__ __forceinline__ unsigned xb_xcc_id() { return (unsigned)__builtin_amdgcn_s_getreg((3 << 11) | 20) & 0xFu; }
#define XB_SPIN(cond, bar) do { unsigned _sp = 0; while (cond) { __builtin_amdgcn_s_sleep(1); \
    if ((++_sp & 255u) == 0u) { if (xb_ld(&(bar)[XB_TMO])) break; if (_sp > XB_SPIN_CAP) { atomicAdd(&(bar)[XB_TMO], 1u); break; } } } } while (0)

struct XcdBarrier {
    unsigned* bar; unsigned x;
    volatile LAS unsigned* st;
};

__device__ __forceinline__ XcdBarrier xcd_barrier_post(unsigned* bar, volatile LAS unsigned* st) {
    XcdBarrier b; b.bar = bar; b.x = xb_xcc_id(); b.st = st;
    if (threadIdx.x == 0) (void)xb_add(&bar[XB_XCNT(b.x)], 1u);
    return b;
}
__device__ __forceinline__ void xcd_barrier_complete(unsigned* bar, unsigned x, unsigned& nloc, unsigned& nx) {
    const unsigned G = gridDim.x * gridDim.y * gridDim.z;
    unsigned sum, cnt, mine, sp = 0u;
    for (;;) {
        sum = 0u; cnt = 0u; mine = 0u;
#pragma unroll
        for (unsigned j = 0; j < 16; ++j) { const unsigned c = xb_ld(&bar[XB_XCNT(j)]); sum += c; cnt += (c > 0u) ? 1u : 0u; mine = (j == x) ? c : mine; }
        if (sum == G) break;
        __builtin_amdgcn_s_sleep(1);
        if ((++sp & 255u) == 0u) { if (xb_ld(&bar[XB_TMO])) break; if (sp > XB_SPIN_CAP) { atomicAdd(&bar[XB_TMO], 1u); break; } }
    }
    nloc = mine > 0u ? mine : 1u; nx = cnt > 0u ? cnt : 1u;
}

__device__ __forceinline__ void xcd_barrier(const XcdBarrier& b) {
    asm volatile("s_waitcnt vmcnt(0)" ::: "memory");
    __syncthreads();
    if (threadIdx.x == 0) {
        unsigned* bar = b.bar;
        __builtin_amdgcn_s_waitcnt(0);
        unsigned nloc = b.st[0], nx = b.st[1];
        if (nloc == 0u) { xcd_barrier_complete(bar, b.x, nloc, nx); b.st[0] = nloc; b.st[1] = nx; }
        const unsigned old = xb_add(&bar[XB_XSUB(b.x)], 1u);
        const unsigned gen = old / nloc;
        if (old + 1u == (gen + 1u) * nloc) {
            __builtin_amdgcn_fence(__ATOMIC_RELEASE, "agent");
            asm volatile("s_waitcnt vmcnt(0)" ::: "memory");
            const unsigned og = xb_add(&bar[XB_TOP], 1u);
            const unsigned tg = og / nx;
            if (og + 1u == (tg + 1u) * nx) xb_add(&bar[XB_TOPGEN], 1u);
            else XB_SPIN(xb_ld(&bar[XB_TOPGEN]) == tg, bar);
            __builtin_amdgcn_fence(__ATOMIC_ACQUIRE, "agent");
            xb_add(&bar[XB_XGEN(b.x)], 1u);
            asm volatile("s_waitcnt vmcnt(0)" ::: "memory");
        } else {
            XB_SPIN(xb_ld(&bar[XB_XGEN(b.x)]) == gen, bar);
            __builtin_amdgcn_fence(__ATOMIC_ACQUIRE, "agent");
            asm volatile("s_waitcnt vmcnt(0)" ::: "memory");
        }
    }
    __syncthreads();
}

constexpr int N_PHASES = 11;
template <int PH>
__device__ __forceinline__ void run_phase(const P& p, unsigned char* ldsb) {
    float* lds = (float*)ldsb;
    if constexpr (PH == 0) { ph_prep(p, lds); ph_convert_small(p, lds); }
    else if constexpr (PH == 1) { ph_norm1(p); ph_filter(p, lds); }
    else if constexpr (PH == 2) ph_inproj(p, ldsb);
    else if constexpr (PH == 3) ph_mixers<0>(p, ldsb);
    else if constexpr (PH == 4) ph_mixprep(p, lds);
    else if constexpr (PH == 5) ph_outproj(p, ldsb);
    else if constexpr (PH == 6) ph_norm2_router(p, lds);
    else if constexpr (PH == 7) ph_topk(p, lds);
    else if constexpr (PH == 8) ph_moe_up(p, ldsb);
    else if constexpr (PH == 9) ph_moe_down(p, ldsb);
    else if constexpr (PH == 10) ph_final(p);
}
template <int PH>
__device__ __forceinline__ void run_from(const P& p, unsigned char* lds, const XcdBarrier& bar) {
    if constexpr (PH < N_PHASES) {
        run_phase<PH>(p, lds);
        if constexpr (PH + 1 < N_PHASES) xcd_barrier(bar);
        run_from<PH + 1>(p, lds, bar);
    }
}
__global__ void __launch_bounds__(NT, 2) fwd_all(P p) {
    extern __shared__ __attribute__((aligned(16))) unsigned char lds_raw[];
    volatile LAS unsigned* st = (volatile LAS unsigned*)(lds_raw + LDS_BYTES - 32);
    if (threadIdx.x < 2) st[threadIdx.x] = 0u;
    __syncthreads();
    const XcdBarrier bar = xcd_barrier_post((unsigned*)(p.ws + WS_CTL) + CW_BAR, st);
    run_from<0>(p, lds_raw, bar);
}

extern "C" void kernel_launch(void* const* d_in, const int* in_sizes, int n_in, void* d_out, int out_size, void* d_ws, size_t ws_size, hipStream_t stream) {
    static int grid = 0;
    if (grid == 0) {
        int dev = 0, cus = 0, per_cu = 0;
        (void)hipGetDevice(&dev);
        (void)hipDeviceGetAttribute(&cus, hipDeviceAttributeMultiprocessorCount, dev);
        (void)hipFuncSetAttribute((const void*)fwd_all, hipFuncAttributeMaxDynamicSharedMemorySize, LDS_BYTES);
        (void)hipOccupancyMaxActiveBlocksPerMultiprocessor(&per_cu, (const void*)fwd_all, NT, LDS_BYTES);
        if (per_cu < 1) fprintf(stderr, "kernel_launch: occupancy query says %d blocks/CU\n", per_cu);
        grid = (cus > 0 ? cus : 256);
        if (ws_size < WS_END) fprintf(stderr, "kernel_launch: workspace too small: %zu < %zu\n", ws_size, (size_t)WS_END);
    }
    P p{};
    const float** f = (const float**)&p;
    for (int i = 0; i < 28; ++i) f[i] = (const float*)d_in[i];
    p.out = (float*)d_out;
    p.ws = (unsigned char*)d_ws;
    p.ph_lo = 0; p.ph_hi = N_PHASES;
    (void)hipMemsetAsync((unsigned char*)d_ws + WS_CTL, 0, CTL_ZERO_BYTES, stream);
    hipLaunchKernelGGL(fwd_all, dim3(grid), dim3(NT), LDS_BYTES, stream, p);
}
```

```cpp
#include <hip/hip_runtime.h>
#include <cstdio>
#include <cstdint>

constexpr int D = 1024, NB = 16, SEQ = 2048, CTXL = 256;
constexpr int NTOK = NB * SEQ;
constexpr int NCTX = NB * CTXL;
constexpr int HEADS = 4;
constexpr int INC = 4096;
constexpr int NE = 16, CAP = 256, FF = 2048;
constexpr int NT = 512;
constexpr int LDS_BYTES = 147456;
constexpr float EPS = 1e-6f;
typedef unsigned short bf16_t;

constexpr size_t MiB = 1u << 20;
constexpr size_t WS_CTL = 0;
constexpr size_t WS_ADA = 1 * MiB;
constexpr size_t WS_LB = WS_ADA + 512 * 1024;
constexpr size_t WS_HID2 = 2 * MiB;
constexpr size_t WS_AFF = 3 * MiB;
constexpr size_t WS_IDX = 5 * MiB;
constexpr size_t WS_GATE = 5 * MiB + 512 * 1024;
constexpr size_t WS_INV = 6 * MiB;
constexpr size_t WS_W13T = 8 * MiB;
constexpr size_t WS_YS = WS_W13T;
constexpr size_t WS_W2T = 136 * MiB;
constexpr size_t WS_R = 200 * MiB;
constexpr size_t WS_H = WS_R;
constexpr size_t WS_MIXA = WS_R;
constexpr size_t WS_HC = WS_R + 64 * MiB;
constexpr size_t WS_PC = WS_R + 72 * MiB;
constexpr size_t WS_OFB = WS_R + 84 * MiB;
constexpr size_t WS_WOUTT = WS_R + 148 * MiB;
constexpr size_t WS_PHG = WS_R + 152 * MiB;
constexpr size_t WS_HMID = WS_R;
constexpr size_t WS_H2 = WS_R + 256 * MiB;
constexpr size_t WS_YT = WS_R + 320 * MiB;
constexpr size_t WS_END = WS_YT + 32 * MiB;
constexpr int CW_QHEAD = 64;
constexpr int CW_BAR = 4096;
constexpr size_t CTL_ZERO_BYTES = 65536;
constexpr size_t DO_PHYT = 0;
constexpr size_t DO_HF = 96 * MiB;
constexpr size_t DO_SCTX = 112 * MiB;
constexpr size_t DO_WINT = 120 * MiB;

struct P {
    const float *x, *c, *ctx, *c_ctx, *ada_w, *ada_b, *norm1_g, *w_in, *hy_conv_w, *hy_conv_b, *pos_w1, *pos_b1, *freq1, *pos_w2, *pos_b2,
        *freq2, *pos_w3, *hy_bias, *hy_norm_g, *hg_lb, *hg_norm_g, *w_out, *norm2_g, *router_w, *exp_w1, *exp_w3, *exp_w2, *final_g;
    float* out;
    unsigned char* ws;
    int ph_lo, ph_hi;
};

__device__ __forceinline__ int opaque_tid() { int t = threadIdx.x; asm volatile("" : "+v"(t)); return t; }
__device__ __forceinline__ void lds_barrier() { asm volatile("s_waitcnt lgkmcnt(0)" ::: "memory"); __builtin_amdgcn_s_barrier(); asm volatile("" ::: "memory"); }
typedef float f32x4_t __attribute__((ext_vector_type(4)));
__device__ __forceinline__ float wave_sum(float v) {
#pragma unroll
    for (int o = 1; o < 64; o <<= 1) v += __shfl_xor(v, o);
    return v;
}
__device__ __forceinline__ float sigmoidf_(float z) { return 1.f / (1.f + expf(-z)); }
__device__ __forceinline__ float siluf_(float z) { return z / (1.f + expf(-z)); }
__device__ __forceinline__ float silu_f(float z) { return z * __builtin_amdgcn_rcpf(1.0f + __builtin_amdgcn_exp2f(-1.4426950408889634f * z)); }
__device__ __forceinline__ float bf2f(bf16_t h) { return __uint_as_float((unsigned)h << 16); }
__device__ __forceinline__ unsigned f2bf(float f) { unsigned u = __float_as_uint(f); return (u + 0x7fffu + ((u >> 16) & 1u)) >> 16; }
typedef float f32x2_cv __attribute__((ext_vector_type(2))); typedef __bf16 bf16x2_cv __attribute__((ext_vector_type(2)));
__device__ __forceinline__ unsigned cvtpk(float lo, float hi) { const f32x2_cv v = {lo, hi}; const bf16x2_cv b = __builtin_convertvector(v, bf16x2_cv); return __builtin_bit_cast(unsigned, b); }
__device__ __forceinline__ unsigned pk2(float lo, float hi) { return f2bf(lo) | (f2bf(hi) << 16); }

namespace pg8 {
#define PG8_LAS __attribute__((address_space(3)))
typedef unsigned short bf16_t;
typedef short bf16x8 __attribute__((ext_vector_type(8)));
typedef float f32x4 __attribute__((ext_vector_type(4)));
typedef unsigned u32x4 __attribute__((ext_vector_type(4)));
constexpr int BM = 256, BK = 64, HALF = 128, HTB = HALF * BK * 2  , STAGE_BYTES = 8 * HTB, NXCD = 8, WGM = 8;

__host__ __device__ __forceinline__ int lds_byte(int r, int c) { const int st = (r >> 4) * 2 + (c >> 5), rr = r & 15, cc = c & 31, ob = rr * 64 + cc * 2; return st * 1024 + (ob ^ (((ob >> 9) & 1) << 5)); }
__host__ __device__ __forceinline__ void stage_rc(int b, int& R, int& C) { const int st = b / 1024, sb = b % 1024, swz = sb ^ (((sb >> 9) & 1) << 5); R = (st >> 1) * 16 + swz / 64; C = (st & 1) * 32 + (swz % 64) / 2; }
__host__ __device__ __forceinline__ int perm32(int rho) { const int n = rho >> 4, i = rho & 15; return 8 * (i >> 2) + 4 * n + (i & 3); }

struct Unit { const char* a; const char* b; bf16_t* c; const float* aux; const int* gidx; int ldc, row0, col0; };
__device__ __forceinline__ unsigned cvt_pk_bf16(float lo, float hi) { unsigned r; asm volatile("v_cvt_pk_bf16_f32 %0, %1, %2" : "=v"(r) : "v"(lo), "v"(hi)); return r; }

__device__ __forceinline__ void tile_of(int L, int nM, int nN, int& pm, int& pn) {
    const int nwg = nM * nN; int wgid = L;
    { const int q = nwg / NXCD, r = nwg % NXCD, xcd = wgid % NXCD, off = wgid / NXCD; wgid = (xcd < r ? xcd * (q + 1) : r * (q + 1) + (xcd - r) * q) + off; }
    const int nig = WGM * nN, gid = wgid / nig, fm = gid * WGM, gsz = (nM - fm) < WGM ? (nM - fm) : WGM;
    pm = fm + ((wgid % nig) % gsz); pn = (wgid % nig) / gsz;
}

struct EpiStoreBf16 {
    static constexpr bool PERM = true, AFTER_DRAIN = false;
    __device__ __forceinline__ void operator()(const f32x4 (&acc)[2][2][4][2], const Unit& u, int wr, int wc, int fr, int fq) const {
        bf16_t* base = u.c + (size_t)(wr * 64 + fr) * u.ldc + wc * 32 + 8 * fq;
#pragma unroll
        for (int ai = 0; ai < 2; ++ai)
#pragma unroll
            for (int m = 0; m < 4; ++m) { bf16_t* rowp = base + (size_t)(ai * HALF + m * 16) * u.ldc;
#pragma unroll
                for (int bj = 0; bj < 2; ++bj) { const f32x4 v0 = acc[ai][bj][m][0], v1 = acc[ai][bj][m][1];
                    u32x4 w; w.x = cvt_pk_bf16(v0[0], v0[1]); w.y = cvt_pk_bf16(v0[2], v0[3]); w.z = cvt_pk_bf16(v1[0], v1[1]); w.w = cvt_pk_bf16(v1[2], v1[3]);
                    *(u32x4*)(rowp + bj * HALF) = w; } }
    }
};
struct EpiOutProj {
    static constexpr bool PERM = true, AFTER_DRAIN = false;
    const float* x; const float* ada; bf16_t* x1;
    __device__ __forceinline__ void operator()(const f32x4 (&acc)[2][2][4][2], const Unit& u, int wr, int wc, int fr, int fq) const {
        const float* g1 = ada + (u.row0 >> 11) * 6144 + 2048;
#pragma unroll
        for (int bj = 0; bj < 2; ++bj) { const int col = u.col0 + bj * HALF + wc * 32 + 8 * fq; const f32x4 g0 = *(const f32x4*)(g1 + col), gB = *(const f32x4*)(g1 + col + 4);
#pragma unroll
            for (int ai = 0; ai < 2; ++ai)
#pragma unroll
                for (int m = 0; m < 4; ++m) { const size_t row = (size_t)(u.row0 + ai * HALF + wr * 64 + m * 16 + fr);
                    const f32x4 v0 = *(const f32x4*)(x + row * D + col) + g0 * acc[ai][bj][m][0], v1 = *(const f32x4*)(x + row * D + col + 4) + gB * acc[ai][bj][m][1];
                    u32x4 w; w.x = cvt_pk_bf16(v0[0], v0[1]); w.y = cvt_pk_bf16(v0[2], v0[3]); w.z = cvt_pk_bf16(v1[0], v1[1]); w.w = cvt_pk_bf16(v1[2], v1[3]);
                    *(u32x4*)(x1 + row * (2 * D) + col) = w; } }
    }
};
__device__ __forceinline__ float silu_fast(float a) { return a * __builtin_amdgcn_rcpf(1.0f + __builtin_amdgcn_exp2f(-1.4426950408889634f * a)); }
struct EpiSwiGLU {
    static constexpr bool PERM = true, AFTER_DRAIN = false;
    __device__ __forceinline__ void operator()(const f32x4 (&acc)[2][2][4][2], const Unit& u, int wr, int wc, int fr, int fq) const {
        bf16_t* base = u.c + (size_t)(wr * 64 + fr) * FF + wc * 32 + 8 * fq;
#pragma unroll
        for (int ai = 0; ai < 2; ++ai)
#pragma unroll
            for (int m = 0; m < 4; ++m) { const f32x4 a0 = acc[ai][0][m][0], a1 = acc[ai][0][m][1], b0 = acc[ai][1][m][0], b1 = acc[ai][1][m][1];
                u32x4 w; w.x = cvt_pk_bf16(silu_fast(a0[0]) * b0[0], silu_fast(a0[1]) * b0[1]); w.y = cvt_pk_bf16(silu_fast(a0[2]) * b0[2], silu_fast(a0[3]) * b0[3]);
                w.z = cvt_pk_bf16(silu_fast(a1[0]) * b1[0], silu_fast(a1[1]) * b1[1]); w.w = cvt_pk_bf16(silu_fast(a1[2]) * b1[2], silu_fast(a1[3]) * b1[3]);
                *(u32x4*)(base + (size_t)(ai * HALF + m * 16) * FF) = w; }
    }
};
struct EpiDown {
    static constexpr bool PERM = true, AFTER_DRAIN = false;
    __device__ __forceinline__ void operator()(const f32x4 (&acc)[2][2][4][2], const Unit& u, int wr, int wc, int fr, int fq) const {
        bf16_t* base = u.c + (size_t)(wr * 64 + fr) * D + wc * 32 + 8 * fq;
#pragma unroll
        for (int ai = 0; ai < 2; ++ai)
#pragma unroll
            for (int m = 0; m < 4; ++m) { const float gt = u.aux[ai * HALF + wr * 64 + m * 16 + fr]; bf16_t* rowp = base + (size_t)(ai * HALF + m * 16) * D;
#pragma unroll
                for (int bj = 0; bj < 2; ++bj) { const f32x4 v0 = acc[ai][bj][m][0] * gt, v1 = acc[ai][bj][m][1] * gt;
                    u32x4 w; w.x = cvt_pk_bf16(v0[0], v0[1]); w.y = cvt_pk_bf16(v0[2], v0[3]); w.z = cvt_pk_bf16(v1[0], v1[1]); w.w = cvt_pk_bf16(v1[2], v1[3]);
                    *(u32x4*)(rowp + bj * HALF) = w; } }
    }
};

template <class Epi, class Sched, bool ALIGN_EPI = false, bool SP2 = false, bool GATHER = false>
__device__ __forceinline__ void gemm_phase(PG8_LAS unsigned char* lds, const int K, const Sched& S, const Epi& E) {
    const int tid = opaque_tid(), wid = __builtin_amdgcn_readfirstlane(tid >> 6), lane = tid & 63, wr = wid >> 2, wc = wid & 3, fr = lane & 15, fq = lane >> 4;
    const int nt = K / BK;
    unsigned voffA[2], voffB[2];
#pragma unroll
    for (int i = 0; i < 2; ++i) { int R, C; stage_rc(tid * 16 + i * 8192, R, C); const int Rb = Epi::PERM ? ((R & ~31) + perm32(R & 31)) : R;
        voffA[i] = (unsigned)(R * K + C) * 2u; voffB[i] = (unsigned)(Rb * K + C) * 2u; }
    const size_t kstep = (size_t)(BK * 2);
    const size_t hstep = (size_t)HALF * K * 2;
    const unsigned ldsw = (unsigned)wid * 1024u;
    const int aoff = lds_byte(wr * 64 + fr, fq * 8), boff = lds_byte(wc * 32 + fr, fq * 8);
#define PG8_SA(b, h) (((b) * 2 + (h)) * HTB)
#define PG8_SB(b, h) ((4 + (b) * 2 + (h)) * HTB)
#define PG8_STAGE(bufoff, gbase, voff) do { _Pragma("unroll") for (int _i = 0; _i < 2; ++_i) \
        __builtin_amdgcn_global_load_lds((const unsigned*)((const char*)(gbase) + (voff)[_i]), (PG8_LAS unsigned*)(lds + (bufoff) + ldsw + _i * 8192), 16, 0, 0); } while (0)
#define PG8_STAGE_A(bufoff, gbase, h) do { _Pragma("unroll") for (int _i = 0; _i < 2; ++_i) \
        __builtin_amdgcn_global_load_lds((const unsigned*)((const char*)(gbase) + voffAh[h][_i]), (PG8_LAS unsigned*)(lds + (bufoff) + ldsw + _i * 8192), 16, 0, 0); } while (0)
#define PG8_LDA(dst, b, h) do { _Pragma("unroll") for (int m = 0; m < 4; ++m) _Pragma("unroll") for (int k = 0; k < 2; ++k) dst[m][k] = *(const PG8_LAS bf16x8*)(lds + PG8_SA(b, h) + aoff + m * 2048 + k * 1024); } while (0)
#define PG8_LDB(dst, b, h) do { _Pragma("unroll") for (int n = 0; n < 2; ++n) _Pragma("unroll") for (int k = 0; k < 2; ++k) dst[n][k] = *(const PG8_LAS bf16x8*)(lds + PG8_SB(b, h) + boff + n * 2048 + k * 1024); } while (0)
#define PG8_MMA(ai, bj, At, Bt) do { __builtin_amdgcn_s_setprio(1); _Pragma("unroll") for (int m = 0; m < 4; ++m) _Pragma("unroll") for (int n = 0; n < 2; ++n) _Pragma("unroll") for (int k = 0; k < 2; ++k) \
        acc[ai][bj][m][n] = __builtin_amdgcn_mfma_f32_16x16x32_bf16(Bt[n][k], At[m][k], acc[ai][bj][m][n], 0, 0, 0); __builtin_amdgcn_s_setprio(0); } while (0)
#define PG8_WAIT_V(n) asm volatile("s_waitcnt vmcnt(" #n ")" ::: "memory")
#define PG8_WAIT_L(n) asm volatile("s_waitcnt lgkmcnt(" #n ")" ::: "memory")
#define PG8_BAR __builtin_amdgcn_s_barrier()
#define PG8_SCHED __builtin_amdgcn_sched_barrier(0)
    Unit cur, nxt; int ui = 0;
    if (!S.next(0, cur)) return;
    unsigned voffAh[2][2];
#pragma unroll
    for (int h = 0; h < 2; ++h)
#pragma unroll
        for (int i = 0; i < 2; ++i) {
            if constexpr (GATHER) { int R, C; stage_rc(tid * 16 + i * 8192, R, C); voffAh[h][i] = ((unsigned)cur.gidx[h * HALF + R] * (unsigned)K + (unsigned)C) * 2u; }
            else voffAh[h][i] = voffA[i] + (unsigned)h * (unsigned)hstep;
        }
    f32x4 acc[2][2][4][2];
#pragma unroll
    for (int a = 0; a < 2; ++a)
#pragma unroll
        for (int b = 0; b < 2; ++b)
#pragma unroll
            for (int m = 0; m < 4; ++m)
#pragma unroll
                for (int n = 0; n < 2; ++n) acc[a][b][m][n] = (f32x4){0.f, 0.f, 0.f, 0.f};
    bf16x8 At[4][2], B0[2][2], B1[2][2];
    const char* cA = cur.a; const char* cB = cur.b;
    S.a_ready(cur);
    if constexpr (SP2) {
        PG8_STAGE(PG8_SB(0, 0), cB, voffB); PG8_STAGE(PG8_SB(0, 1), cB + hstep, voffB); PG8_STAGE_A(PG8_SA(0, 0), cA, 0); PG8_STAGE_A(PG8_SA(0, 1), cA, 1);
        if (wr == 1) PG8_BAR;
        PG8_WAIT_V(2); PG8_BAR;
        PG8_STAGE(PG8_SB(1, 0), cB + kstep, voffB); PG8_STAGE_A(PG8_SA(1, 0), cA + kstep, 0); PG8_STAGE(PG8_SB(1, 1), cB + hstep + kstep, voffB);
        PG8_WAIT_V(6); PG8_BAR;
    } else {
        PG8_STAGE(PG8_SB(0, 0), cB, voffB); PG8_STAGE_A(PG8_SA(0, 0), cA, 0); PG8_STAGE(PG8_SB(0, 1), cB + hstep, voffB); PG8_STAGE_A(PG8_SA(0, 1), cA, 1);
        if (wr == 1) PG8_BAR;
        PG8_WAIT_V(4); PG8_BAR;
        PG8_STAGE(PG8_SB(1, 0), cB + kstep, voffB); PG8_STAGE_A(PG8_SA(1, 0), cA + kstep, 0); PG8_STAGE(PG8_SB(1, 1), cB + hstep + kstep, voffB);
        PG8_WAIT_V(6); PG8_BAR;
    }
    for (;;) {
        const bool has_next = S.next(ui + 1, nxt);
        const char* nA = has_next ? nxt.a : cA; const char* nB = has_next ? nxt.b : cB;
        for (int t = 0; t < nt; t += 2) {
            const bool last = (t == nt - 2);
            const char* a1 = cA + (size_t)(t + 1) * kstep;
            const char* a2 = last ? nA : cA + (size_t)(t + 2) * kstep; const char* b2 = last ? nB : cB + (size_t)(t + 2) * kstep;
            const char* a3 = a2 + kstep; const char* b3 = b2 + kstep;
            if (last && has_next) S.a_ready(nxt);
            if constexpr (SP2) {
            PG8_LDB(B0, 0, 0); PG8_LDB(B1, 0, 1); PG8_SCHED; PG8_LDA(At, 0, 0); PG8_STAGE_A(PG8_SA(1, 1), a1, 1);
            PG8_WAIT_V(8); PG8_WAIT_L(0); PG8_BAR; PG8_MMA(0, 0, At, B0); PG8_MMA(0, 1, At, B1); PG8_BAR; PG8_SCHED;
            PG8_LDA(At, 0, 1); PG8_STAGE(PG8_SB(0, 0), b2, voffB); PG8_STAGE(PG8_SB(0, 1), b2 + hstep, voffB); PG8_STAGE_A(PG8_SA(0, 0), a2, 0);
            PG8_WAIT_V(8); PG8_WAIT_L(0); PG8_BAR; PG8_MMA(1, 0, At, B0); PG8_MMA(1, 1, At, B1); PG8_BAR; PG8_SCHED;
            PG8_LDB(B0, 1, 0); PG8_LDB(B1, 1, 1); PG8_SCHED; PG8_LDA(At, 1, 0); PG8_STAGE_A(PG8_SA(0, 1), a2, 1);
            PG8_WAIT_V(8); PG8_WAIT_L(0); PG8_BAR; PG8_MMA(0, 0, At, B0); PG8_MMA(0, 1, At, B1); PG8_BAR; PG8_SCHED;
            PG8_LDA(At, 1, 1); PG8_STAGE(PG8_SB(1, 0), b3, voffB); PG8_STAGE(PG8_SB(1, 1), b3 + hstep, voffB); PG8_STAGE_A(PG8_SA(1, 0), a3, 0);
            PG8_WAIT_V(8); PG8_WAIT_L(0); PG8_BAR; PG8_MMA(1, 0, At, B0); PG8_MMA(1, 1, At, B1); PG8_BAR; PG8_SCHED;
            } else {
            PG8_LDB(B0, 0, 0); PG8_SCHED; PG8_LDA(At, 0, 0); PG8_STAGE_A(PG8_SA(1, 1), a1, 1);
            PG8_WAIT_L(8); PG8_BAR; PG8_WAIT_L(0); PG8_MMA(0, 0, At, B0); PG8_BAR; PG8_SCHED;
            PG8_LDB(B1, 0, 1); PG8_STAGE(PG8_SB(0, 0), b2, voffB);
            PG8_BAR; PG8_WAIT_L(0); PG8_MMA(0, 1, At, B1); PG8_BAR;
            PG8_LDA(At, 0, 1); PG8_STAGE_A(PG8_SA(0, 0), a2, 0);
            PG8_BAR; PG8_WAIT_L(0); PG8_MMA(1, 0, At, B0); PG8_BAR; PG8_SCHED;
            PG8_STAGE(PG8_SB(0, 1), b2 + hstep, voffB);
            PG8_WAIT_V(6); PG8_BAR; PG8_MMA(1, 1, At, B1); PG8_BAR;
            PG8_LDB(B0, 1, 0); PG8_SCHED; PG8_LDA(At, 1, 0); PG8_STAGE_A(PG8_SA(0, 1), a2, 1);
            PG8_WAIT_L(8); PG8_BAR; PG8_WAIT_L(0); PG8_MMA(0, 0, At, B0); PG8_BAR; PG8_SCHED;
            PG8_LDB(B1, 1, 1); PG8_STAGE(PG8_SB(1, 0), b3, voffB);
            PG8_BAR; PG8_WAIT_L(0); PG8_MMA(0, 1, At, B1); PG8_BAR;
            PG8_LDA(At, 1, 1); PG8_STAGE_A(PG8_SA(1, 0), a3, 0);
            PG8_BAR; PG8_WAIT_L(0); PG8_MMA(1, 0, At, B0); PG8_BAR; PG8_SCHED;
            PG8_STAGE(PG8_SB(1, 1), b3 + hstep, voffB);
            PG8_WAIT_V(6); PG8_BAR; PG8_MMA(1, 1, At, B1); PG8_BAR;
            }
        }
        if constexpr (ALIGN_EPI) { if (wr == 0) PG8_BAR; }
        if constexpr (!Epi::AFTER_DRAIN) { E(acc, cur, wr, wc, fr, fq); S.done(cur); }
        if (!has_next) break;
#pragma unroll
        for (int a = 0; a < 2; ++a)
#pragma unroll
            for (int b = 0; b < 2; ++b)
#pragma unroll
                for (int m = 0; m < 4; ++m)
#pragma unroll
                    for (int n = 0; n < 2; ++n) acc[a][b][m][n] = (f32x4){0.f, 0.f, 0.f, 0.f};
        cur = nxt; cA = nA; cB = nB; ++ui;
        if constexpr (ALIGN_EPI) { if (wr == 1) PG8_BAR; }
    }
    PG8_WAIT_V(0);
    if constexpr (!ALIGN_EPI) { if (wr == 0) PG8_BAR; }
    PG8_BAR;
    if constexpr (Epi::AFTER_DRAIN) { E.fused(acc, cur, wr, wc, fr, fq, lds, wid, lane); S.done(cur); }
#undef PG8_SA
#undef PG8_SB
#undef PG8_STAGE
#undef PG8_LDA
#undef PG8_LDB
#undef PG8_MMA
#undef PG8_WAIT_V
#undef PG8_WAIT_L
#undef PG8_BAR
#undef PG8_SCHED
}
}
using pg8::Unit; using pg8::tile_of;

__device__ __forceinline__ void ph_prep(const P& p, float* lds) {
    const int tid = opaque_tid(), G = gridDim.x;
    float* ADA = (float*)(p.ws + WS_ADA);
    float* LB = (float*)(p.ws + WS_LB);
    float* HID2 = (float*)(p.ws + WS_HID2);
    {
        float* s = lds;
        float* red = lds + 17 * 1024;
        if (blockIdx.x < 192) {
            for (int i = tid; i < 17 * 1024; i += NT) {
                const int r = i >> 10, d = i & 1023;
                const float cv = r < 16 ? p.c[r * 1024 + d] : p.c_ctx[d];
                s[i] = siluf_(cv);
            }
        }
        __syncthreads();
        for (int item = blockIdx.x; item < 192; item += G) {
            const int jj = tid & 31, ks = tid >> 5, j = item * 32 + jj;
            float acc[17];
#pragma unroll
            for (int r = 0; r < 17; ++r) acc[r] = 0.f;
            for (int d0 = ks * 64; d0 < ks * 64 + 64; d0 += 16) {
                float wv[16];
#pragma unroll
                for (int q = 0; q < 16; ++q) wv[q] = p.ada_w[(size_t)(d0 + q) * 6144 + j];
#pragma unroll
                for (int q = 0; q < 16; ++q)
#pragma unroll
                    for (int r = 0; r < 17; ++r) acc[r] += s[r * 1024 + d0 + q] * wv[q];
            }
#pragma unroll
            for (int r = 0; r < 17; ++r) red[(ks * 17 + r) * 32 + jj] = acc[r];
            __syncthreads();
            for (int i = tid; i < 17 * 32; i += NT) {
                const int r = i >> 5, j2 = i & 31;
                float sum = 0.f;
#pragma unroll
                for (int k = 0; k < 16; ++k) sum += red[(k * 17 + r) * 32 + j2];
                ADA[r * 6144 + item * 32 + j2] = sum + p.ada_b[item * 32 + j2];
            }
            __syncthreads();
        }
    }
    if (blockIdx.x == G - 1) {
        for (int i = tid; i < 1024; i += NT) {
            const float a0 = p.hg_lb[i], a1 = p.hg_lb[1024 + i];
            LB[i] = 1.f / (1.f + expf(a1 - a0));
        }
    }
    {
        float* zl = lds;
        float* h1 = lds + 512;
        __syncthreads();
        for (int it = (G - 1 - blockIdx.x); it < SEQ / 8; it += G) {
            const int lt = tid >> 6, j = tid & 63, t = it * 8 + lt;
            const float w = 6.283185307179586f * (float)t / 2048.0f;
            if (j == 0) zl[lt * 64] = (float)t / 2047.0f;
            if (j >= 1 && j < 17) { const float f = 1e-4f + (float)(j - 1) * ((15.0f - 1e-4f) / 15.0f); zl[lt * 64 + j] = cosf(f * w); }
            if (j >= 17 && j < 33) { const float f = 1e-4f + (float)(j - 17) * ((15.0f - 1e-4f) / 15.0f); zl[lt * 64 + j] = -sinf(f * w); }
            __syncthreads();
            float a = p.pos_b1[j];
            for (int i = 0; i < 33; ++i) a += zl[lt * 64 + i] * p.pos_w1[i * 64 + j];
            h1[lt * 64 + j] = sinf(p.freq1[j] * a);
            __syncthreads();
            float b = p.pos_b2[j];
            for (int i = 0; i < 64; ++i) b += h1[lt * 64 + i] * p.pos_w2[i * 64 + j];
            HID2[t * 64 + j] = sinf(p.freq2[j] * b);
            __syncthreads();
        }
    }
}
struct ConvItem { const float* W; bf16_t* dst; int N, KD, k0, n0, which; };
__device__ __forceinline__ ConvItem conv_small_item(const P& p, int it) {
    ConvItem c; c.which = 0; c.KD = D;
    if (it < 256) { c.W = p.w_in; c.N = INC; c.k0 = (it / 16) * 64; c.n0 = (it % 16) * 256; c.dst = (bf16_t*)((unsigned char*)p.out + DO_WINT); }
    else { const int r = it - 256; c.W = p.w_out; c.N = D; c.k0 = (r / 4) * 64; c.n0 = (r % 4) * 256; c.dst = (bf16_t*)(p.ws + WS_WOUTT); }
    return c;
}
constexpr int N_EXPERT_ITEMS = 2 * 16 * 16 * 8 + 16 * 32 * 4;
__device__ __forceinline__ ConvItem conv_expert_item(const P& p, int r) {
    ConvItem c; constexpr int I_W1 = 16 * 16 * 8;
    if (r < 2 * I_W1) {
        const int which = r / I_W1; r %= I_W1;
        const int e = r / 128, r2 = r % 128;
        c.W = (which == 0 ? p.exp_w1 : p.exp_w3) + (size_t)e * D * FF; c.N = FF; c.k0 = (r2 / 8) * 64; c.n0 = (r2 % 8) * 256; c.dst = (bf16_t*)(p.ws + WS_W13T) + (size_t)e * 4096 * D; c.KD = D; c.which = 1 + which;
    } else {
        r -= 2 * I_W1; const int e = r / 128, r2 = r % 128;
        c.W = p.exp_w2 + (size_t)e * FF * D; c.N = D; c.k0 = (r2 / 4) * 64; c.n0 = (r2 % 4) * 256; c.dst = (bf16_t*)(p.ws + WS_W2T) + (size_t)e * 1024 * FF; c.KD = FF; c.which = 0;
    }
    return c;
}
__device__ __forceinline__ void conv_load(const ConvItem& c, f32x4_t (&v)[8], int tid) {
#pragma unroll
    for (int q = 0; q < 8; ++q) { const int i = tid + NT * q, k = i >> 6, n4 = i & 63; v[q] = *(const f32x4_t*)(c.W + (size_t)(c.k0 + k) * c.N + c.n0 + 4 * n4); }
}
__device__ __forceinline__ void conv_tile_write(const f32x4_t (&v)[8], float* T, int tid) {
#pragma unroll
    for (int q = 0; q < 8; ++q) { const int i = tid + NT * q, k = i >> 6, n4 = i & 63; *(f32x4_t*)&T[k * 260 + 4 * (n4 ^ ((k >> 3) & 7))] = v[q]; }
}
__device__ __forceinline__ void conv_tile_store(const ConvItem& c, const float* T, int tid) {
#pragma unroll
    for (int q = 0; q < 4; ++q) { const int i = tid + NT * q, nl = i >> 3, ch = i & 7, n = c.n0 + nl;
        float a[8];
#pragma unroll
        for (int e = 0; e < 8; ++e) a[e] = T[(8 * ch + e) * 260 + (nl ^ (ch << 2))];
        const int row = c.which == 0 ? n : ((n >> 7) * 256 + (c.which - 1) * 128 + (n & 127));
        *(uint4*)(c.dst + (size_t)row * c.KD + c.k0 + 8 * ch) = make_uint4(cvtpk(a[0], a[1]), cvtpk(a[2], a[3]), cvtpk(a[4], a[5]), cvtpk(a[6], a[7])); }
}
constexpr int CONV_DEPTH = 4;
template <class ITEMF>
__device__ __forceinline__ void conv_run(ITEMF item, int first, int count, float* T) {
    const int tid = opaque_tid();
    f32x4_t ring[CONV_DEPTH][8];
#pragma unroll
    for (int d = 0; d < CONV_DEPTH; ++d) { const ConvItem c = item(first + d); conv_load(c, ring[d], tid); }
    for (int i0 = 0; i0 < count; i0 += CONV_DEPTH) {
#pragma unroll
        for (int d = 0; d < CONV_DEPTH; ++d) {
            const int i = i0 + d;
            const ConvItem c = item(first + i);
            lds_barrier();
            conv_tile_write(ring[d], T, tid);
            lds_barrier();
            if (i + CONV_DEPTH < count) { const ConvItem cn = item(first + i + CONV_DEPTH); conv_load(cn, ring[d], tid); }
            conv_tile_store(c, T, tid);
        }
    }
}
__device__ __forceinline__ void ph_convert_small(const P& p, float* lds) {
    __syncthreads();
    if (blockIdx.x >= 96 && blockIdx.x < 96 + 80) conv_run([&](int it) { return conv_small_item(p, it); }, (blockIdx.x - 96) * 4, 4, lds);
}

__device__ __forceinline__ void ph_norm1(const P& p) {
    const int tid = opaque_tid(), lane = tid & 63, wv = tid >> 6;
    const float* ADA = (const float*)(p.ws + WS_ADA);
    bf16_t* H = (bf16_t*)(p.ws + WS_H);
    bf16_t* HC = (bf16_t*)(p.ws + WS_HC);
    auto run = [&](const float* src, bf16_t* dst, int ar, int nrows) {
        f32x4_t gm[4], hs[4];
#pragma unroll
        for (int j = 0; j < 4; ++j) { const int d4 = lane + 64 * j; const f32x4_t g = ((const f32x4_t*)p.norm1_g)[d4], s1 = ((const f32x4_t*)(ADA + ar * 6144 + 1024))[d4]; gm[j] = g * (1.f + s1); hs[j] = ((const f32x4_t*)(ADA + ar * 6144))[d4]; }
        f32x4_t v[4], vn[4];
#pragma unroll
        for (int j = 0; j < 4; ++j) v[j] = ((const f32x4_t*)src)[lane + 64 * j];
        for (int ri = 0; ri < nrows; ++ri) {
            if (ri + 1 < nrows) {
#pragma unroll
                for (int j = 0; j < 4; ++j) vn[j] = ((const f32x4_t*)(src + (size_t)(ri + 1) * D))[lane + 64 * j];
            }
            float ss = 0.f;
#pragma unroll
            for (int j = 0; j < 4; ++j) ss += v[j].x * v[j].x + v[j].y * v[j].y + v[j].z * v[j].z + v[j].w * v[j].w;
            const float rstd = rsqrtf(wave_sum(ss) * (1.f / D) + EPS);
#pragma unroll
            for (int j = 0; j < 4; ++j) { const f32x4_t o = v[j] * rstd * gm[j] + hs[j]; ((uint2*)(dst + (size_t)ri * D))[lane + 64 * j] = make_uint2(cvtpk(o.x, o.y), cvtpk(o.z, o.w)); }
#pragma unroll
            for (int j = 0; j < 4; ++j) v[j] = vn[j];
        }
    };
    for (int rc = blockIdx.x * 8 + wv; rc < NTOK / 16; rc += gridDim.x * 8) {
        run(p.x + (size_t)rc * 16 * D, H + (size_t)rc * 16 * D, (rc * 16) / SEQ, 16);
        run(p.ctx + (size_t)rc * 2 * D, HC + (size_t)rc * 2 * D, 16, 2);
    }
}
__device__ __forceinline__ void ph_filter(const P& p, float* lds) {
    const int tid = opaque_tid(), G = gridDim.x;
    const float* HID2 = (const float*)(p.ws + WS_HID2);
    float* HF = (float*)((unsigned char*)p.out + DO_HF);
    float* w3c = lds;
    float* red = lds + 512;
    const float min_decay = logf(1e-2f) / 1.5f, max_decay = logf(1e-2f) / 0.3f;
    for (int grp = blockIdx.x; grp < 256; grp += G) {
        const int item0 = grp * 4, o = item0 >> 9, c0 = item0 & 511;
        __syncthreads();
        { const int q = tid >> 7, dir = (tid >> 6) & 1, i = tid & 63; w3c[tid] = p.pos_w3[i * 2048 + o * 1024 + dir * 512 + c0 + q]; }
        __syncthreads();
        float hv[4][4][2]; float asum[4] = {0.f, 0.f, 0.f, 0.f};
#pragma unroll
        for (int j = 0; j < 4; ++j) {
            const int t = tid + NT * j;
            float r[4][2];
#pragma unroll
            for (int q = 0; q < 4; ++q) { r[q][0] = 0.f; r[q][1] = 0.f; }
            const float4* hp = (const float4*)(HID2 + t * 64);
#pragma unroll 4
            for (int i4 = 0; i4 < 16; ++i4) {
                const float4 h = hp[i4];
#pragma unroll
                for (int q = 0; q < 4; ++q)
#pragma unroll
                    for (int d = 0; d < 2; ++d) { const float* w = w3c + (q * 2 + d) * 64 + i4 * 4; r[q][d] += h.x * w[0] + h.y * w[1] + h.z * w[2] + h.w * w[3]; }
            }
            const float tl = (float)t / 2047.0f;
#pragma unroll
            for (int q = 0; q < 4; ++q) {
                const float delta = fabsf(min_decay + (float)(c0 + q) * ((max_decay - min_decay) / 511.0f));
                const float win = expf(-tl * delta) + 0.05f;
                hv[j][q][0] = r[q][0] * win; hv[j][q][1] = r[q][1] * win;
                asum[q] += fabsf(hv[j][q][0]) + (t >= 1 ? fabsf(hv[j][q][1]) : 0.f);
            }
        }
#pragma unroll
        for (int q = 0; q < 4; ++q) asum[q] = wave_sum(asum[q]);
        if ((tid & 63) == 0) { red[(tid >> 6) * 4 + 0] = asum[0]; red[(tid >> 6) * 4 + 1] = asum[1]; red[(tid >> 6) * 4 + 2] = asum[2]; red[(tid >> 6) * 4 + 3] = asum[3]; }
        __syncthreads();
#pragma unroll
        for (int q = 0; q < 4; ++q) {
            float tot = 0.f;
#pragma unroll
            for (int k = 0; k < 8; ++k) tot += red[k * 4 + q];
            const float inv = 1.f / (tot + EPS);
            float* dst = HF + (size_t)(item0 + q) * 4096;
#pragma unroll
            for (int j = 0; j < 4; ++j) {
                const int t = tid + NT * j;
                dst[2047 + t] = hv[j][q][0] * inv;
                if (t >= 1) dst[2047 - t] = hv[j][q][1] * inv;
            }
            if (tid == 0) dst[4095] = 0.f;
        }
    }
}

struct InprojSched {
    int G, c; const bf16_t *WinT, *H, *HC; bf16_t *PHYT, *PHG, *PC;
    __device__ __forceinline__ bool next(int i, Unit& u) const {
        int L = i * G + c; int pm, pn;
        u.aux = nullptr; u.gidx = nullptr; u.row0 = 0; u.col0 = 0;
        if (L < 768) { tile_of(L, 6, 128, pm, pn); u.a = (const char*)(WinT + (size_t)pm * 256 * D); u.b = (const char*)(H + (size_t)pn * 256 * D); u.c = PHYT + (size_t)pm * 256 * NTOK + pn * 256; u.ldc = NTOK; return true; }
        L -= 768;
        if (L < 1280) { tile_of(L, 128, 10, pm, pn); u.a = (const char*)(H + (size_t)pm * 256 * D); u.b = (const char*)(WinT + (size_t)(1536 + pn * 256) * D); u.c = PHG + (size_t)pm * 256 * 2560 + pn * 256; u.ldc = 2560; return true; }
        L -= 1280;
        if (L < 96) { tile_of(L, 16, 6, pm, pn); u.a = (const char*)(HC + (size_t)pm * 256 * D); u.b = (const char*)(WinT + (size_t)(2048 + pn * 256) * D); u.c = PC + (size_t)pm * 256 * 1536 + pn * 256; u.ldc = 1536; return true; }
        return false;
    }
    __device__ __forceinline__ void a_ready(const Unit&) const {}
    __device__ __forceinline__ void done(const Unit&) const {}
};
__device__ __forceinline__ void ph_inproj(const P& p, unsigned char* lds) {
    InprojSched S{(int)gridDim.x, (int)blockIdx.x, (const bf16_t*)((unsigned char*)p.out + DO_WINT), (const bf16_t*)(p.ws + WS_H), (const bf16_t*)(p.ws + WS_HC),
                  (bf16_t*)((unsigned char*)p.out + DO_PHYT), (bf16_t*)(p.ws + WS_PHG), (bf16_t*)(p.ws + WS_PC)};
    pg8::EpiStoreBf16 E;
    pg8::gemm_phase<pg8::EpiStoreBf16, InprojSched, true, true, false>((PG8_LAS unsigned char*)lds, D, S, E);
}

namespace hy {
#define HY_LAS __attribute__((address_space(3)))
typedef short bf16x8 __attribute__((ext_vector_type(8)));
typedef float f32x4 __attribute__((ext_vector_type(4)));
typedef unsigned u32x4 __attribute__((ext_vector_type(4)));
typedef unsigned u32x2 __attribute__((ext_vector_type(2)));
constexpr int U_STRIDE = 4112, UIMG = 0, U_BYTES = 16 * U_STRIDE;
constexpr int FILT = U_BYTES, F_STRIDE = 8288, F_BYTES = 8 * F_STRIDE;
constexpr int SCR = FILT + F_BYTES;
static_assert(SCR + 8192 <= LDS_BYTES, "hyena LDS map");

__device__ __forceinline__ float uni(float v) { return __uint_as_float(__builtin_amdgcn_readfirstlane(__float_as_uint(v))); }
struct ConvW { float w0, w1, w2, b; };
__device__ __forceinline__ ConvW load_convw(const P& p, int ch) { ConvW c; c.w0 = uni(p.hy_conv_w[ch]); c.w1 = uni(p.hy_conv_w[1536 + ch]); c.w2 = uni(p.hy_conv_w[3072 + ch]); c.b = uni(p.hy_conv_b[ch]); return c; }
__device__ __forceinline__ void load_u_image(const ConvW cw, HY_LAS unsigned char* L, const bf16_t* row, int tid) {
    const float cw0 = cw.w0, cw1 = cw.w1, cw2 = cw.w2, cb = cw.b;
#pragma unroll 2
    for (int k = 0; k < 8; ++k) {
        const int idx = tid + NT * k, b = idx >> 8, t8 = (idx & 255) * 8;
        const bf16_t* src = row + b * SEQ + t8;
        const u32x4 raw = *(const u32x4*)src;
        float x[10];
        x[0] = (t8 & 63) ? bf2f(src[-1]) : 0.f;
        x[9] = ((t8 + 8) & 63) ? bf2f(src[8]) : 0.f;
        x[1] = __uint_as_float(raw.x << 16); x[2] = __uint_as_float(raw.x & 0xffff0000u); x[3] = __uint_as_float(raw.y << 16); x[4] = __uint_as_float(raw.y & 0xffff0000u);
        x[5] = __uint_as_float(raw.z << 16); x[6] = __uint_as_float(raw.z & 0xffff0000u); x[7] = __uint_as_float(raw.w << 16); x[8] = __uint_as_float(raw.w & 0xffff0000u);
        float o[8];
#pragma unroll
        for (int e = 0; e < 8; ++e) o[e] = cb + cw1 * x[e + 1] + cw0 * x[e] + cw2 * x[e + 2];
        *(HY_LAS u32x4*)(L + UIMG + b * U_STRIDE + t8 * 2) = (u32x4){pk2(o[0], o[1]), pk2(o[2], o[3]), pk2(o[4], o[5]), pk2(o[6], o[7])};
    }
}
__device__ __forceinline__ void raw_rows_load(u32x4 (&r)[8], const bf16_t* row, int tid) {
#pragma unroll
    for (int k = 0; k < 8; ++k) { const int idx = tid + NT * k, b = idx >> 8, t8 = (idx & 255) * 8; r[k] = *(const u32x4*)(row + b * SEQ + t8); }
}
__device__ __forceinline__ void raw_rows_store(HY_LAS unsigned char* L, const u32x4 (&r)[8], int tid) {
#pragma unroll
    for (int k = 0; k < 8; ++k) {
        const int idx = tid + NT * k, b = idx >> 8, t8 = (idx & 255) * 8;
        HY_LAS unsigned char* d = L + FILT + b * U_STRIDE + 8 + t8 * 2;
        *(HY_LAS u32x2*)d = (u32x2){r[k].x, r[k].y}; *(HY_LAS u32x2*)(d + 8) = (u32x2){r[k].z, r[k].w};
    }
}
__device__ __forceinline__ void load_filter_scr(HY_LAS unsigned char* L, const float* hf, int tid) {
    const float4 a = ((const float4*)hf)[tid * 2], b = ((const float4*)hf)[tid * 2 + 1];
    *(HY_LAS u32x4*)(L + SCR + tid * 16) = (u32x4){pk2(a.x, a.y), pk2(a.z, a.w), pk2(b.x, b.y), pk2(b.z, b.w)};
}
__device__ __forceinline__ void build_filter_copies(HY_LAS unsigned char* L, int tid) {
    const HY_LAS bf16_t* sc = (const HY_LAS bf16_t*)(L + SCR);
    for (int gi = tid; gi < 8 * 518; gi += NT) {
        const int d = gi / 518, qg = gi - d * 518;
        const int top = 4095 + d - 8 * qg;
        unsigned v[8];
#pragma unroll
        for (int e = 0; e < 8; ++e) { const int ix = top - e; v[e] = (ix >= 0 && ix <= 4094) ? (unsigned)sc[ix] : 0u; }
        *(HY_LAS u32x4*)(L + FILT + d * F_STRIDE + qg * 16) = (u32x4){v[0] | (v[1] << 16), v[2] | (v[3] << 16), v[4] | (v[5] << 16), v[6] | (v[7] << 16)};
    }
}
__device__ __forceinline__ void conv_loop(HY_LAS unsigned char* L, f32x4 (&acc)[16], int w, int lane) {
    const int i = lane & 15, g = lane >> 4;
    const HY_LAS unsigned char* aBase = L + FILT + (i & 7) * F_STRIDE + 2 * (2048 + 8 * g - (i & ~7)) - 32 * (16 * w);
    const HY_LAS unsigned char* bBase = L + UIMG + i * U_STRIDE + 16 * g;
    bf16x8 ring[16];
#pragma unroll
    for (int s = 0; s < 16; ++s) ring[s] = *(const HY_LAS bf16x8*)(aBase - 32 * s);
#pragma unroll
    for (int m = 0; m < 16; ++m) acc[m] = (f32x4){0.f, 0.f, 0.f, 0.f};
    bf16x8 bfrag = *(const HY_LAS bf16x8*)(bBase);
    for (int k8 = 0; k8 < 8; ++k8) {
        const HY_LAS unsigned char* aK = aBase + 512 * k8;
        const HY_LAS unsigned char* bK = bBase + 512 * k8;
#pragma unroll
        for (int u = 0; u < 8; ++u) {
            bf16x8 bnext = bfrag;
            if (u < 7 || k8 < 7) bnext = *(const HY_LAS bf16x8*)(bK + 64 * (u + 1));
            acc[14] = __builtin_amdgcn_mfma_f32_16x16x32_bf16(ring[(14 - 2 * u) & 15], bfrag, acc[14], 0, 0, 0);
            acc[15] = __builtin_amdgcn_mfma_f32_16x16x32_bf16(ring[(15 - 2 * u) & 15], bfrag, acc[15], 0, 0, 0);
            if (u < 7 || k8 < 7) {
                ring[(14 - 2 * u) & 15] = *(const HY_LAS bf16x8*)(aK + 64 * u + 64);
                ring[(15 - 2 * u) & 15] = *(const HY_LAS bf16x8*)(aK + 64 * u + 32);
            }
#pragma unroll
            for (int m = 0; m < 14; ++m) acc[m] = __builtin_amdgcn_mfma_f32_16x16x32_bf16(ring[(m - 2 * u) & 15], bfrag, acc[m], 0, 0, 0);
            bfrag = bnext;
            __builtin_amdgcn_sched_barrier(0);
        }
    }
}
__device__ __forceinline__ void gate_acc(const ConvW cw, HY_LAS unsigned char* L, f32x4 (&acc)[16], float bias, int w, int lane) {
    const int j = lane & 15, g = lane >> 4;
    const float cw0 = cw.w0, cw1 = cw.w1, cw2 = cw.w2, cb = cw.b;
#pragma unroll
    for (int m = 0; m < 16; ++m) {
        const int t4 = 256 * w + 16 * m + 4 * g, tt0 = t4 & 63;
        const u32x2 uu = *(const HY_LAS u32x2*)(L + UIMG + j * U_STRIDE + t4 * 2);
        const HY_LAS unsigned char* xb = L + FILT + j * U_STRIDE + 8 + t4 * 2;
        const u32x2 xx = *(const HY_LAS u32x2*)xb;
        const float xl = tt0 > 0 ? bf2f(*(const HY_LAS bf16_t*)(xb - 2)) : 0.f;
        const float xr = tt0 < 60 ? bf2f(*(const HY_LAS bf16_t*)(xb + 8)) : 0.f;
        const float x0 = __uint_as_float(xx.x << 16), x1 = __uint_as_float(xx.x & 0xffff0000u), x2 = __uint_as_float(xx.y << 16), x3 = __uint_as_float(xx.y & 0xffff0000u);
        const float u0 = __uint_as_float(uu.x << 16), u1 = __uint_as_float(uu.x & 0xffff0000u), u2 = __uint_as_float(uu.y << 16), u3 = __uint_as_float(uu.y & 0xffff0000u);
        const float g0 = cb + cw1 * x0 + cw0 * xl + cw2 * x1, g1 = cb + cw1 * x1 + cw0 * x0 + cw2 * x2, g2 = cb + cw1 * x2 + cw0 * x1 + cw2 * x3, g3 = cb + cw1 * x3 + cw0 * x2 + cw2 * xr;
        acc[m][0] = g0 * (acc[m][0] + bias * u0); acc[m][1] = g1 * (acc[m][1] + bias * u1); acc[m][2] = g2 * (acc[m][2] + bias * u2); acc[m][3] = g3 * (acc[m][3] + bias * u3);
        if ((m & 3) == 3) __builtin_amdgcn_sched_barrier(0);
    }
}
__device__ __forceinline__ void store_acc_uimg(HY_LAS unsigned char* L, const f32x4 (&acc)[16], int w, int lane) {
    const int j = lane & 15, g = lane >> 4;
#pragma unroll
    for (int m = 0; m < 16; ++m) {
        const int t4 = 256 * w + 16 * m + 4 * g;
        *(HY_LAS u32x2*)(L + UIMG + j * U_STRIDE + t4 * 2) = (u32x2){pk2(acc[m][0], acc[m][1]), pk2(acc[m][2], acc[m][3])};
    }
}
}

__device__ __forceinline__ void ph_hyena_task(const P& p, unsigned char* ldsb, int c) {
    const int w = __builtin_amdgcn_readfirstlane(threadIdx.x >> 6);
    const bf16_t* PHYT = (const bf16_t*)((unsigned char*)p.out + DO_PHYT);
    bf16_t* YT = (bf16_t*)(p.ws + WS_YT);
    const float* HF = (const float*)((unsigned char*)p.out + DO_HF);
    HY_LAS unsigned char* L = (HY_LAS unsigned char*)ldsb;
    {
        const int tid = opaque_tid();
        const int lane = tid & 63;
        hy::f32x4 acc[16];
        const hy::ConvW cwv = hy::load_convw(p, c), cwx1 = hy::load_convw(p, 512 + c), cwx2 = hy::load_convw(p, 1024 + c);
        const float bias0 = hy::uni(p.hy_bias[c]), bias1 = hy::uni(p.hy_bias[512 + c]);
        __syncthreads();
        hy::load_u_image(cwv, L, PHYT + (size_t)c * NTOK, tid);
        hy::load_filter_scr(L, HF + (size_t)c * 4096, tid);
        __syncthreads();
        hy::build_filter_copies(L, tid);
        __syncthreads();
        hy::u32x4 rawx[8];
        hy::raw_rows_load(rawx, PHYT + (size_t)(512 + c) * NTOK, tid);
        hy::load_filter_scr(L, HF + (size_t)(512 + c) * 4096, tid);
        hy::conv_loop(L, acc, w, lane);
        __syncthreads();
        hy::raw_rows_store(L, rawx, tid);
        __syncthreads();
        hy::gate_acc(cwx1, L, acc, bias0, w, lane);
        __syncthreads();
        hy::store_acc_uimg(L, acc, w, lane);
        hy::build_filter_copies(L, tid);
        __syncthreads();
        hy::raw_rows_load(rawx, PHYT + (size_t)(1024 + c) * NTOK, tid);
        hy::conv_loop(L, acc, w, lane);
        __syncthreads();
        hy::raw_rows_store(L, rawx, tid);
        __syncthreads();
        hy::gate_acc(cwx2, L, acc, bias1, w, lane);
        hy::store_acc_uimg(L, acc, w, lane);
        __syncthreads();
#pragma unroll 2
        for (int k = 0; k < 8; ++k) {
            const int idx = tid + NT * k, b = idx >> 8, t8 = (idx & 255) * 8;
            *(hy::u32x4*)(YT + (size_t)c * NTOK + b * SEQ + t8) = *(const HY_LAS hy::u32x4*)(L + hy::UIMG + b * hy::U_STRIDE + t8 * 2);
        }
    }
}


namespace hg {
#define HG_LAS __attribute__((address_space(3)))
typedef short bf16x8 __attribute__((ext_vector_type(8)));
typedef float f32x4 __attribute__((ext_vector_type(4)));
typedef unsigned u32x4 __attribute__((ext_vector_type(4)));
typedef unsigned u32x2 __attribute__((ext_vector_type(2)));
constexpr int QROW = 272, KROW = 40;
constexpr int O_QT = 0, O_KBAR = 16 * QROW, O_KHAT = 2 * 16 * QROW, O_VT = O_KHAT + 128 * KROW, O_BDEC = O_VT + 128 * KROW, SET_BYTES = O_BDEC + 512;
constexpr int NCH_CTX = CTXL / 16, NCH = NCH_CTX + SEQ / 16;
template <int CTRL> __device__ __forceinline__ float dpp_mul(float x) {
    return x * __uint_as_float(__builtin_amdgcn_update_dpp(0x3f800000u, __float_as_uint(x), CTRL, 0xf, 0xf, false));
}
struct Raw { unsigned short q[4], v[4], z[4]; };
}

__device__ __forceinline__ void ph_hgrn_task(const P& p, unsigned char* ldsb, int item) {
    using namespace hg;
    const int tid = opaque_tid();
    const int lane = tid & 63, w = __builtin_amdgcn_readfirstlane(tid >> 6), j = lane & 15, g = lane >> 4;
    const int dir = item & 1, h = (item >> 1) & 3, b = item >> 3;
    const float* LB = (const float*)(p.ws + WS_LB);
    const bf16_t* PC = (const bf16_t*)(p.ws + WS_PC);
    const bf16_t* PHG = (const bf16_t*)(p.ws + WS_PHG);
    bf16_t* OFB = (bf16_t*)(p.ws + WS_OFB) + (size_t)dir * NTOK * 512;
    HG_LAS unsigned char* L = (HG_LAS unsigned char*)ldsb;
    float lb0[2], lb1[2];
#pragma unroll
    for (int pp = 0; pp < 2; ++pp) { const float2 t = *(const float2*)(LB + dir * 512 + h * 128 + 16 * w + 8 * pp + 2 * g); lb0[pp] = t.x; lb1[pp] = t.y; }
    const int zoff_c = dir == 0 ? 512 : 1024, zoff_l = dir == 0 ? 1024 : 1536;
    const bf16_t* rowc = PC + (size_t)b * CTXL * 1536 + h * 128 + 16 * w + 2 * g;
    const bf16_t* rowl = PHG + (size_t)b * SEQ * 2560 + h * 128 + 16 * w + 2 * g;
    struct Raw2 { unsigned q[2], v[2], z[2]; };
    auto load_raw = [&](int n, Raw2& r) {
        if (n < NCH_CTX) {
            const int tt = 16 * n + j, t = dir == 0 ? tt : (CTXL - 1 - tt);
            const bf16_t* row = rowc + (size_t)t * 1536;
#pragma unroll
            for (int pp = 0; pp < 2; ++pp) { r.q[pp] = 0u; r.v[pp] = *(const unsigned*)(row + 8 * pp); r.z[pp] = *(const unsigned*)(row + zoff_c + 8 * pp); }
        } else {
            const int tt = 16 * (n - NCH_CTX) + j, t = dir == 0 ? tt : (SEQ - 1 - tt);
            const bf16_t* row = rowl + (size_t)t * 2560;
#pragma unroll
            for (int pp = 0; pp < 2; ++pp) { r.q[pp] = *(const unsigned*)(row + 8 * pp); r.v[pp] = *(const unsigned*)(row + 512 + 8 * pp); r.z[pp] = *(const unsigned*)(row + zoff_l + 8 * pp); }
        }
    };
    const int qoff = j * QROW + 2 * (16 * w + 2 * g), koff = (16 * w + 2 * g) * KROW + 2 * j;
    auto prep_pass = [&](const Raw2& r, HG_LAS unsigned char* S0, const int pp) {
        {
            const float za = __uint_as_float(r.z[pp] << 16), zb = __uint_as_float(r.z[pp] & 0xffff0000u);
            const float qa = __uint_as_float(r.q[pp] << 16), qb = __uint_as_float(r.q[pp] & 0xffff0000u);
            const float fa = lb0[pp] + (1.0f - lb0[pp]) * __builtin_amdgcn_rcpf(1.0f + __builtin_amdgcn_exp2f(-1.4426950408889634f * za));
            const float fb = lb1[pp] + (1.0f - lb1[pp]) * __builtin_amdgcn_rcpf(1.0f + __builtin_amdgcn_exp2f(-1.4426950408889634f * zb));
            float Pa = dpp_mul<0x111>(fa), Pb = dpp_mul<0x111>(fb);
            Pa = dpp_mul<0x112>(Pa); Pb = dpp_mul<0x112>(Pb); Pa = dpp_mul<0x114>(Pa); Pb = dpp_mul<0x114>(Pb); Pa = dpp_mul<0x118>(Pa); Pb = dpp_mul<0x118>(Pb);
            const float Ca = __uint_as_float(__builtin_amdgcn_ds_bpermute(4 * (lane | 15), __float_as_uint(Pa)));
            const float Cb = __uint_as_float(__builtin_amdgcn_ds_bpermute(4 * (lane | 15), __float_as_uint(Pb)));
            const float ia = __builtin_amdgcn_rcpf(fmaxf(Pa, 1e-30f)), ib = __builtin_amdgcn_rcpf(fmaxf(Pb, 1e-30f));
            const float ka = (1.0f - fa) * ia, kb = (1.0f - fb) * ib;
            const float qva = qa * __builtin_amdgcn_rcpf(1.0f + __builtin_amdgcn_exp2f(-1.4426950408889634f * qa)) * (0.08838834764831845f * Pa);
            const float qvb = qb * __builtin_amdgcn_rcpf(1.0f + __builtin_amdgcn_exp2f(-1.4426950408889634f * qb)) * (0.08838834764831845f * Pb);
            *(HG_LAS unsigned*)(S0 + O_QT + qoff + 16 * pp) = cvtpk(qva, qvb);
            *(HG_LAS unsigned*)(S0 + O_KBAR + qoff + 16 * pp) = cvtpk(ka, kb);
            const unsigned kh = cvtpk(ka * Ca, kb * Cb);
            *(HG_LAS bf16_t*)(S0 + O_KHAT + koff + 8 * pp * KROW) = (bf16_t)(kh & 0xffffu);
            *(HG_LAS bf16_t*)(S0 + O_KHAT + koff + (8 * pp + 1) * KROW) = (bf16_t)(kh >> 16);
            *(HG_LAS bf16_t*)(S0 + O_VT + koff + 8 * pp * KROW) = (bf16_t)(r.v[pp] & 0xffffu);
            *(HG_LAS bf16_t*)(S0 + O_VT + koff + (8 * pp + 1) * KROW) = (bf16_t)(r.v[pp] >> 16);
            if (j == 15) { typedef float f32x2_t __attribute__((ext_vector_type(2))); *(HG_LAS f32x2_t*)(S0 + O_BDEC + 4 * (16 * w + 8 * pp + 2 * g)) = (f32x2_t){Pa, Pb}; }
        }
    };
    auto prep = [&](const Raw2& r, HG_LAS unsigned char* S0) { prep_pass(r, S0, 0); prep_pass(r, S0, 1); };
    const float mk0 = (4 * g + 0) <= j ? 1.f : 0.f, mk1 = (4 * g + 1) <= j ? 1.f : 0.f, mk2 = (4 * g + 2) <= j ? 1.f : 0.f, mk3 = (4 * g + 3) <= j ? 1.f : 0.f;
    const int sc_off = j * QROW + 16 * g, vt_off = (16 * w + j) * KROW + 8 * g, qt8_off = j * QROW + 8 * g, kh_off = j * KROW + 8 * g;
    bf16_t* orow = OFB + (size_t)b * SEQ * 512 + h * 128 + 16 * w + 4 * g;
    f32x4 S[8];
#pragma unroll
    for (int t = 0; t < 8; ++t) S[t] = (f32x4){0.f, 0.f, 0.f, 0.f};
    constexpr int RDEPTH = 4;
    static_assert(NCH % RDEPTH == 0, "chunk loop is unrolled by the prefetch depth");
    Raw2 ring[RDEPTH];
    load_raw(0, ring[0]);
    __syncthreads();
    prep(ring[0], L);
#pragma unroll
    for (int c = 1; c <= RDEPTH; ++c) load_raw(c, ring[c % RDEPTH]);
    __syncthreads();
    auto chunk = [&](int n, int phase, Raw2& slot) {
        HG_LAS unsigned char* Sc = L + (n & 1) * SET_BYTES;
        HG_LAS unsigned char* Sn = L + ((n + 1) & 1) * SET_BYTES;
        bf16x8 kaf[4], qaf[4]; u32x2 qb0[4], qb1[4], krf[8]; f32x4 bdf[8];
#pragma unroll
        for (int kp = 0; kp < 4; ++kp) { kaf[kp] = *(const HG_LAS bf16x8*)(Sc + O_KBAR + sc_off + 64 * kp); qaf[kp] = *(const HG_LAS bf16x8*)(Sc + O_QT + sc_off + 64 * kp); }
        const u32x2 vraw = *(const HG_LAS u32x2*)(Sc + O_VT + vt_off);
#pragma unroll
        for (int pq = 0; pq < 4; ++pq) { qb0[pq] = *(const HG_LAS u32x2*)(Sc + O_QT + qt8_off + 64 * pq); qb1[pq] = *(const HG_LAS u32x2*)(Sc + O_QT + qt8_off + 64 * pq + 32); }
#pragma unroll
        for (int t = 0; t < 8; ++t) { bdf[t] = *(const HG_LAS f32x4*)(Sc + O_BDEC + 64 * t + 16 * g); krf[t] = *(const HG_LAS u32x2*)(Sc + O_KHAT + kh_off + 16 * KROW * t); }
        __builtin_amdgcn_sched_barrier(0);
        const u32x4 vf = (u32x4){vraw.x, vraw.y, 0u, 0u};
        f32x4 sc = (f32x4){0.f, 0.f, 0.f, 0.f};
#pragma unroll
        for (int kp = 0; kp < 4; ++kp) sc = __builtin_amdgcn_mfma_f32_16x16x32_bf16(kaf[kp], qaf[kp], sc, 0, 0, 0);
        f32x4 oT = (f32x4){0.f, 0.f, 0.f, 0.f};
#pragma unroll
        for (int pq = 0; pq < 4; ++pq) {
            u32x4 a; a.x = cvtpk(S[2 * pq][0], S[2 * pq][1]); a.y = cvtpk(S[2 * pq][2], S[2 * pq][3]); a.z = cvtpk(S[2 * pq + 1][0], S[2 * pq + 1][1]); a.w = cvtpk(S[2 * pq + 1][2], S[2 * pq + 1][3]);
            const u32x4 bb = (u32x4){qb0[pq].x, qb0[pq].y, qb1[pq].x, qb1[pq].y};
            oT = __builtin_amdgcn_mfma_f32_16x16x32_bf16(__builtin_bit_cast(bf16x8, a), __builtin_bit_cast(bf16x8, bb), oT, 0, 0, 0);
        }
#pragma unroll
        for (int t = 0; t < 8; ++t) {
            const u32x4 ka = (u32x4){krf[t].x, krf[t].y, 0u, 0u};
            S[t] = __builtin_amdgcn_mfma_f32_16x16x32_bf16(__builtin_bit_cast(bf16x8, ka), __builtin_bit_cast(bf16x8, vf), S[t] * bdf[t], 0, 0, 0);
        }
        u32x4 pf;
        pf.x = cvtpk(sc[0] * mk0, sc[1] * mk1); pf.y = cvtpk(sc[2] * mk2, sc[3] * mk3); pf.z = 0u; pf.w = 0u;
        oT = __builtin_amdgcn_mfma_f32_16x16x32_bf16(__builtin_bit_cast(bf16x8, vf), __builtin_bit_cast(bf16x8, pf), oT, 0, 0, 0);
        if (n + 1 < NCH) prep(slot, Sn);
        if (n + 1 + RDEPTH < NCH) load_raw(n + 1 + RDEPTH, slot);
        if (n >= NCH_CTX) {
            const int tt = 16 * (n - NCH_CTX) + j, t = dir == 0 ? tt : (SEQ - 1 - tt);
            *(u32x2*)(orow + (size_t)t * 512) = (u32x2){cvtpk(oT[0], oT[1]), cvtpk(oT[2], oT[3])};
        }
        lds_barrier();
    };
    for (int n0 = 0; n0 < NCH; n0 += RDEPTH) {
#pragma unroll
        for (int u = 0; u < RDEPTH; ++u) chunk(n0 + u, u % 3, ring[(u + 1) % RDEPTH]);
    }
}

template <int QW = 0, bool DO_HGRN = true, bool DO_QUEUE = true, bool DO_HY = true, bool DO_CV = true>
__device__ __forceinline__ void ph_mixers(const P& p, unsigned char* ldsb) {
    unsigned* qhead = (unsigned*)(p.ws + WS_CTL) + CW_QHEAD + QW;
    HG_LAS unsigned* bc = (HG_LAS unsigned*)(ldsb + LDS_BYTES - 16);
    if (DO_HGRN && blockIdx.x < NB * HEADS * 2) ph_hgrn_task(p, ldsb, blockIdx.x);
    constexpr int N_CONV_WG = 48, ITEMS_PER_WG = N_EXPERT_ITEMS / N_CONV_WG;
    static_assert(N_EXPERT_ITEMS % N_CONV_WG == 0 && ITEMS_PER_WG % CONV_DEPTH == 0, "conversion split");
    if (DO_CV && blockIdx.x >= NB * HEADS * 2 && blockIdx.x < NB * HEADS * 2 + N_CONV_WG)
        conv_run([&](int r) { return conv_expert_item(p, r); }, (blockIdx.x - NB * HEADS * 2) * ITEMS_PER_WG, ITEMS_PER_WG, (float*)ldsb);
    if (!DO_QUEUE) return;
    for (;;) {
        __syncthreads();
        if (threadIdx.x == 0) *bc = atomicAdd(qhead, 1u);
        __syncthreads();
        const int c = (int)*bc;
        if (c >= 512) break;
        if (DO_HY) ph_hyena_task(p, ldsb, c);
    }
}

__device__ __forceinline__ void ph_mixprep(const P& p, float* lds) {
    const int tid = opaque_tid(), lane = tid & 63, wv = tid >> 6;
    const bf16_t* YT = (const bf16_t*)(p.ws + WS_YT);
    bf16_t* MIXA = (bf16_t*)(p.ws + WS_MIXA);
    bf16_t* yl = (bf16_t*)lds;
    float* part = lds + (512 * 72 * 2) / 4;
    typedef unsigned u32x4_t __attribute__((ext_vector_type(4)));
    u32x4_t tl[8];
    auto tload = [&](int tile) {
#pragma unroll
        for (int q = 0; q < 8; ++q) { const int i = tid + NT * q, row = i >> 3, ch = i & 7; tl[q] = *(const u32x4_t*)(YT + (size_t)row * NTOK + tile * 64 + ch * 8); }
    };
    if (blockIdx.x < NTOK / 64) tload(blockIdx.x);
    for (int tile = blockIdx.x; tile < NTOK / 64; tile += gridDim.x) {
        const int tok0 = tile * 64;
        __syncthreads();
#pragma unroll
        for (int q = 0; q < 8; ++q) { const int i = tid + NT * q, row = i >> 3, ch = i & 7; *(u32x4_t*)(yl + row * 72 + ch * 8) = tl[q]; }
        __syncthreads();
        if (tile + (int)gridDim.x < NTOK / 64) tload(tile + gridDim.x);
        const int tok = tid & 63, pt = tid >> 6;
        float ss = 0.f;
        for (int c = pt * 64; c < pt * 64 + 64; ++c) { const float v = bf2f(yl[c * 72 + tok]); ss += v * v; }
        part[pt * 64 + tok] = ss;
        __syncthreads();
        float tot = 0.f;
#pragma unroll
        for (int k = 0; k < 8; ++k) tot += part[k * 64 + tok];
        const float rstd = rsqrtf(tot * (1.f / 512.f) + EPS);
        bf16_t* dst = MIXA + (size_t)(tok0 + tok) * D + pt * 64;
#pragma unroll
        for (int j = 0; j < 8; ++j) {
            const f32x4_t ga = *(const f32x4_t*)(p.hy_norm_g + pt * 64 + j * 8), gb = *(const f32x4_t*)(p.hy_norm_g + pt * 64 + j * 8 + 4);
            const float gv[8] = {ga.x, ga.y, ga.z, ga.w, gb.x, gb.y, gb.z, gb.w};
            float o[8];
#pragma unroll
            for (int q = 0; q < 8; ++q) { const int c = pt * 64 + j * 8 + q; o[q] = bf2f(yl[c * 72 + tok]) * rstd * gv[q]; }
            *(uint4*)(dst + j * 8) = make_uint4(cvtpk(o[0], o[1]), cvtpk(o[2], o[3]), cvtpk(o[4], o[5]), cvtpk(o[6], o[7]));
        }
    }
    const bf16_t* OFB = (const bf16_t*)(p.ws + WS_OFB);
    const bf16_t* PHG = (const bf16_t*)(p.ws + WS_PHG);
    {
        const int hh = lane >> 4, k8 = (lane & 15) * 8, col = hh * 128 + k8;
        const f32x4_t ng0 = *(const f32x4_t*)(p.hg_norm_g + k8), ng1 = *(const f32x4_t*)(p.hg_norm_g + k8 + 4);
        struct Row3 { uint4 a, b, g; };
        auto ld = [&](int r) { Row3 x; x.a = *(const uint4*)(OFB + (size_t)r * 512 + col); x.b = *(const uint4*)(OFB + (size_t)NTOK * 512 + (size_t)r * 512 + col); x.g = *(const uint4*)(PHG + (size_t)r * 2560 + 2048 + col); return x; };
        for (int rc = blockIdx.x * 8 + wv; rc < NTOK / 16; rc += gridDim.x * 8) {
            Row3 cur = ld(rc * 16), nxt = cur;
            for (int ri = 0; ri < 16; ++ri) {
                const int r = rc * 16 + ri;
                if (ri + 1 < 16) nxt = ld(r + 1);
                const unsigned aw[4] = {cur.a.x, cur.a.y, cur.a.z, cur.a.w}, bw[4] = {cur.b.x, cur.b.y, cur.b.z, cur.b.w}, gw[4] = {cur.g.x, cur.g.y, cur.g.z, cur.g.w};
                float o[8]; float ss = 0.f;
#pragma unroll
                for (int q = 0; q < 4; ++q) { o[2 * q] = __uint_as_float(aw[q] << 16) + __uint_as_float(bw[q] << 16); o[2 * q + 1] = __uint_as_float(aw[q] & 0xffff0000u) + __uint_as_float(bw[q] & 0xffff0000u); ss += o[2 * q] * o[2 * q] + o[2 * q + 1] * o[2 * q + 1]; }
                ss += __shfl_xor(ss, 1); ss += __shfl_xor(ss, 2); ss += __shfl_xor(ss, 4); ss += __shfl_xor(ss, 8);
                const float rstd = rsqrtf(ss * (1.f / 128.f) + EPS);
                const float ngv[8] = {ng0.x, ng0.y, ng0.z, ng0.w, ng1.x, ng1.y, ng1.z, ng1.w};
                unsigned w[4];
#pragma unroll
                for (int q = 0; q < 4; ++q) { const float g0 = __uint_as_float(gw[q] << 16), g1 = __uint_as_float(gw[q] & 0xffff0000u);
                    w[q] = cvtpk(o[2 * q] * rstd * ngv[2 * q] * silu_f(g0), o[2 * q + 1] * rstd * ngv[2 * q + 1] * silu_f(g1)); }
                *(uint4*)(MIXA + (size_t)r * D + 512 + col) = make_uint4(w[0], w[1], w[2], w[3]);
                cur = nxt;
            }
        }
    }
}

struct OutprojSched {
    int G, c; const bf16_t *A, *Bt;
    __device__ __forceinline__ bool next(int i, Unit& u) const {
        const int L = i * G + c; if (L >= 512) return false; int pm, pn; tile_of(L, 128, 4, pm, pn);
        u.a = (const char*)(A + (size_t)pm * 256 * D); u.b = (const char*)(Bt + (size_t)pn * 256 * D); u.c = nullptr; u.aux = nullptr; u.gidx = nullptr; u.ldc = D; u.row0 = pm * 256; u.col0 = pn * 256; return true;
    }
    __device__ __forceinline__ void a_ready(const Unit&) const {}
    __device__ __forceinline__ void done(const Unit&) const {}
};
__device__ __forceinline__ void ph_outproj(const P& p, unsigned char* lds) {
    OutprojSched S{(int)gridDim.x, (int)blockIdx.x, (const bf16_t*)(p.ws + WS_MIXA), (const bf16_t*)(p.ws + WS_WOUTT)};
    pg8::EpiOutProj E{p.x, (const float*)(p.ws + WS_ADA), (bf16_t*)p.out};
    pg8::gemm_phase<pg8::EpiOutProj, OutprojSched, true, true, false>((PG8_LAS unsigned char*)lds, D, S, E);
}

__device__ __forceinline__ void ph_norm2_router(const P& p, float* lds) {
    const int tid = opaque_tid(), lane = tid & 63, wv = tid >> 6;
    const float* ADA = (const float*)(p.ws + WS_ADA);
    const bf16_t* X1 = (const bf16_t*)p.out;
    bf16_t* H2 = (bf16_t*)(p.ws + WS_H2);
    float* AFF = (float*)(p.ws + WS_AFF);
    __syncthreads();
    for (int i = tid; i < D * 4; i += NT) { const int d = i >> 2, e4 = i & 3; const float4 w = ((const float4*)p.router_w)[i];
        lds[(e4 * 4 + 0) * D + d] = w.x; lds[(e4 * 4 + 1) * D + d] = w.y; lds[(e4 * 4 + 2) * D + d] = w.z; lds[(e4 * 4 + 3) * D + d] = w.w; }
    __syncthreads();
    auto ldrow = [&](int r, f32x4_t (&d)[4]) {
#pragma unroll
        for (int j = 0; j < 4; ++j) { const uint2 w = ((const uint2*)(X1 + (size_t)r * (2 * D)))[lane + 64 * j]; d[j] = (f32x4_t){__uint_as_float(w.x << 16), __uint_as_float(w.x & 0xffff0000u), __uint_as_float(w.y << 16), __uint_as_float(w.y & 0xffff0000u)}; }
    };
    for (int rc = blockIdx.x * 8 + wv; rc < NTOK / 16; rc += gridDim.x * 8) {
      const int rbase = rc * 16, b = rbase / SEQ;
      f32x4_t gm[4], hs[4];
#pragma unroll
      for (int j = 0; j < 4; ++j) { const int d4 = lane + 64 * j; const f32x4_t g = ((const f32x4_t*)p.norm2_g)[d4], s1 = ((const f32x4_t*)(ADA + b * 6144 + 4096))[d4]; gm[j] = g * (1.f + s1); hs[j] = ((const f32x4_t*)(ADA + b * 6144 + 3072))[d4]; }
      f32x4_t v[4], vn[4];
      ldrow(rbase, v);
      for (int ri = 0; ri < 16; ++ri) {
        const int r = rbase + ri, t = r % SEQ;
        if (ri + 1 < 16) ldrow(r + 1, vn);
        float ss = 0.f;
#pragma unroll
        for (int j = 0; j < 4; ++j) ss += v[j].x * v[j].x + v[j].y * v[j].y + v[j].z * v[j].z + v[j].w * v[j].w;
        const float rstd = rsqrtf(wave_sum(ss) * (1.f / D) + EPS);
        float lg[16];
#pragma unroll
        for (int e = 0; e < 16; ++e) lg[e] = 0.f;
#pragma unroll
        for (int j = 0; j < 4; ++j) {
            const int d4 = lane + 64 * j;
            const f32x4_t o = v[j] * rstd * gm[j] + hs[j];
            ((uint2*)(H2 + (size_t)r * D))[d4] = make_uint2(cvtpk(o.x, o.y), cvtpk(o.z, o.w));
#pragma unroll
            for (int e = 0; e < 16; ++e) {
                const float4 w = *(const float4*)&lds[e * D + d4 * 4];
                lg[e] += o.x * w.x + o.y * w.y + o.z * w.z + o.w * w.w;
            }
            __builtin_amdgcn_sched_barrier(0);
        }
#pragma unroll
        for (int i = 0; i < 8; ++i) { const bool hi = lane & 1; const float keep = hi ? lg[2 * i + 1] : lg[2 * i], send = hi ? lg[2 * i] : lg[2 * i + 1]; lg[i] = keep + __shfl_xor(send, 1); }
#pragma unroll
        for (int i = 0; i < 4; ++i) { const bool hi = lane & 2; const float keep = hi ? lg[2 * i + 1] : lg[2 * i], send = hi ? lg[2 * i] : lg[2 * i + 1]; lg[i] = keep + __shfl_xor(send, 2); }
#pragma unroll
        for (int i = 0; i < 2; ++i) { const bool hi = lane & 4; const float keep = hi ? lg[2 * i + 1] : lg[2 * i], send = hi ? lg[2 * i] : lg[2 * i + 1]; lg[i] = keep + __shfl_xor(send, 4); }
        { const bool hi = lane & 8; const float keep = hi ? lg[1] : lg[0], send = hi ? lg[0] : lg[1]; lg[0] = keep + __shfl_xor(send, 8); }
        float lgt = lg[0];
        lgt += __shfl_xor(lgt, 16); lgt += __shfl_xor(lgt, 32);
        float mx = lgt;
        mx = fmaxf(mx, __shfl_xor(mx, 1)); mx = fmaxf(mx, __shfl_xor(mx, 2)); mx = fmaxf(mx, __shfl_xor(mx, 4)); mx = fmaxf(mx, __shfl_xor(mx, 8));
        const float ex = expf(lgt - mx);
        float den = ex;
        den += __shfl_xor(den, 1); den += __shfl_xor(den, 2); den += __shfl_xor(den, 4); den += __shfl_xor(den, 8);
        if (lane < 16) AFF[((size_t)b * 16 + lane) * SEQ + t] = ex / den;
#pragma unroll
        for (int j = 0; j < 4; ++j) v[j] = vn[j];
      }
    }
}

__device__ __forceinline__ void ph_topk(const P& p, float* lds) {
    const int tid = opaque_tid(), lane = tid & 63, wv = tid >> 6;
    const float* AFF = (const float*)(p.ws + WS_AFF);
    int* IDX = (int*)(p.ws + WS_IDX);
    float* GATE = (float*)(p.ws + WS_GATE);
    int* INV = (int*)(p.ws + WS_INV);
    unsigned* hist = (unsigned*)lds;
    unsigned* ctl = hist + 256;
    unsigned* wtot = hist + 272;
    for (int item = blockIdx.x; item < NB * NE; item += gridDim.x) {
        const int b = item >> 4, e = item & 15;
        const uint4 kk = ((const uint4*)(AFF + (size_t)item * SEQ))[tid];
        const unsigned key[4] = {kk.x, kk.y, kk.z, kk.w};
        unsigned prefix = 0u, need = CAP;
#pragma unroll
        for (int pass = 3; pass >= 0; --pass) {
            __syncthreads();
            if (tid < 256) hist[tid] = 0u;
            __syncthreads();
#pragma unroll
            for (int q = 0; q < 4; ++q) {
                const bool in = (pass == 3) || ((key[q] >> (8 * (pass + 1))) == prefix);
                if (in) atomicAdd(&hist[(key[q] >> (8 * pass)) & 255u], 1u);
            }
            __syncthreads();
            if (wv == 0) {
                const uint4 h4 = ((const uint4*)hist)[lane];
                const unsigned loc = h4.x + h4.y + h4.z + h4.w;
                unsigned suf = loc;
#pragma unroll
                for (int o = 1; o < 64; o <<= 1) { const unsigned y = __shfl_down(suf, o); if (lane + o < 64) suf += y; }
                const unsigned above = suf - loc;
                unsigned c3 = above + h4.w, c2 = c3 + h4.z, c1 = c2 + h4.y, c0 = c1 + h4.x;
                int bin = -1; unsigned nneed = 0u;
                if (above < need && c0 >= need) {
                    if (c3 >= need) { bin = 4 * lane + 3; nneed = need - above; }
                    else if (c2 >= need) { bin = 4 * lane + 2; nneed = need - c3; }
                    else if (c1 >= need) { bin = 4 * lane + 1; nneed = need - c2; }
                    else { bin = 4 * lane; nneed = need - c1; }
                    ctl[0] = (prefix << 8) | (unsigned)bin; ctl[1] = nneed;
                }
            }
            __syncthreads();
            prefix = ctl[0]; need = ctl[1];
        }
        unsigned cgt = 0u, ceq = 0u;
#pragma unroll
        for (int q = 0; q < 4; ++q) { cgt += key[q] > prefix ? 1u : 0u; ceq += key[q] == prefix ? 1u : 0u; }
        unsigned sgt = cgt, seq = ceq;
#pragma unroll
        for (int o = 1; o < 64; o <<= 1) { const unsigned y1 = __shfl_up(sgt, o), y2 = __shfl_up(seq, o); if (lane >= o) { sgt += y1; seq += y2; } }
        if (lane == 63) { wtot[wv] = sgt; wtot[8 + wv] = seq; }
        __syncthreads();
        unsigned bgt = 0u, beq = 0u, ngt = 0u;
#pragma unroll
        for (int k = 0; k < 8; ++k) { const unsigned a = wtot[k], c = wtot[8 + k]; if (k < wv) { bgt += a; beq += c; } ngt += a; }
        unsigned rgt = bgt + sgt - cgt, req = beq + seq - ceq;
#pragma unroll
        for (int q = 0; q < 4; ++q) {
            const int t = 4 * tid + q; int slot = -1;
            if (key[q] > prefix) { slot = (int)rgt; ++rgt; }
            else if (key[q] == prefix) { if (req < need) slot = (int)(ngt + req); ++req; }
            if (slot >= 0) { IDX[item * CAP + slot] = t; GATE[item * CAP + slot] = __uint_as_float(key[q]); }
            INV[((size_t)b * SEQ + t) * 16 + e] = slot;
        }
    }
}

struct MoeUpSched {
    int G, c, round; const bf16_t *H2, *W13T; bf16_t* HMID; const int* IDX;
    __device__ __forceinline__ bool next(int i, Unit& u) const {
        if (i >= 4 || c >= 256) return false;
        const int x = c & 7, q = c >> 3, Q = q >> 2, mth = q & 3, item = (Q * 4 + ((round & 1) * 2 + (round >> 1))) * 8 + x, b = item >> 4, e = item & 15, nt = 4 * mth + i;
        u.a = (const char*)(H2 + (size_t)b * SEQ * D); u.b = (const char*)(W13T + ((size_t)e * 4096 + nt * 256) * D); u.c = HMID + (size_t)item * CAP * FF + nt * 128;
        u.aux = nullptr; u.gidx = IDX + item * CAP; u.ldc = FF; u.row0 = 0; u.col0 = 0; return true;
    }
    __device__ __forceinline__ void a_ready(const Unit&) const {}
    __device__ __forceinline__ void done(const Unit&) const {}
};
struct MoeDownSched {
    int G, c; const bf16_t *HMID, *W2T; bf16_t* YS; const float* GATE;
    __device__ __forceinline__ bool next(int i, Unit& u) const {
        if (i >= 4 || c >= 256) return false;
        const int x = c & 7, q = c >> 3, Q = q >> 2, nt = q & 3, item = (Q * 4 + i) * 8 + x, e = item & 15;
        u.a = (const char*)(HMID + (size_t)item * CAP * FF); u.b = (const char*)(W2T + ((size_t)e * 1024 + nt * 256) * FF); u.c = YS + (size_t)item * CAP * D + nt * 256;
        u.aux = GATE + item * CAP; u.gidx = nullptr; u.ldc = D; u.row0 = 0; u.col0 = 0; return true;
    }
    __device__ __forceinline__ void a_ready(const Unit&) const {}
    __device__ __forceinline__ void done(const Unit&) const {}
};
__device__ __forceinline__ void ph_moe_up(const P& p, unsigned char* lds) {
    pg8::EpiSwiGLU E;
    for (int round = 0; round < 4; ++round) {
        MoeUpSched S{(int)gridDim.x, (int)blockIdx.x, round, (const bf16_t*)(p.ws + WS_H2), (const bf16_t*)(p.ws + WS_W13T), (bf16_t*)(p.ws + WS_HMID), (const int*)(p.ws + WS_IDX)};
        pg8::gemm_phase<pg8::EpiSwiGLU, MoeUpSched, true, true, true>((PG8_LAS unsigned char*)lds, D, S, E);
    }
}
__device__ __forceinline__ void ph_moe_down(const P& p, unsigned char* lds) {
    MoeDownSched S{(int)gridDim.x, (int)blockIdx.x, (const bf16_t*)(p.ws + WS_HMID), (const bf16_t*)(p.ws + WS_W2T), (bf16_t*)(p.ws + WS_YS), (const float*)(p.ws + WS_GATE)};
    pg8::EpiDown E;
    pg8::gemm_phase<pg8::EpiDown, MoeDownSched, true, true, false>((PG8_LAS unsigned char*)lds, FF, S, E);
}

__device__ __forceinline__ void ph_final(const P& p) {
    const int tid = opaque_tid(), lane = tid & 63, wv = tid >> 6;
    const float* ADA = (const float*)(p.ws + WS_ADA);
    const bf16_t* YS = (const bf16_t*)(p.ws + WS_YS);
    const int* INV = (const int*)(p.ws + WS_INV);
    float* X = p.out;
    constexpr int NR = 4;
    for (int rc = blockIdx.x * 8 + wv; rc < NTOK / 16; rc += gridDim.x * 8)
    for (int r0 = rc * 16; r0 < rc * 16 + 16; r0 += NR) {
        const int b = r0 / SEQ;
        const float* g2 = ADA + b * 6144 + 5120;
        int myinv[NR]; f32x4_t xv[NR][4]; f32x4_t acc[NR][4];
#pragma unroll
        for (int rr = 0; rr < NR; ++rr) {
            myinv[rr] = INV[(size_t)(r0 + rr) * 16 + (lane & 15)];
#pragma unroll
            for (int j = 0; j < 4; ++j) { const uint2 w = ((const uint2*)(X + (size_t)(r0 + rr) * D))[lane + 64 * j];
                xv[rr][j] = (f32x4_t){__uint_as_float(w.x << 16), __uint_as_float(w.x & 0xffff0000u), __uint_as_float(w.y << 16), __uint_as_float(w.y & 0xffff0000u)}; acc[rr][j] = (f32x4_t){0.f, 0.f, 0.f, 0.f}; }
        }
#pragma unroll
        for (int rr = 0; rr < NR; ++rr) {
            unsigned m = (unsigned)(__ballot(myinv[rr] >= 0) & 0xffffull);
            while (m) {
                uint2 w[4][4]; int ne = 0;
#pragma unroll
                for (int k = 0; k < 4; ++k) {
                    if (m) {
                        const int e = __builtin_ctz(m); m &= m - 1u; ne = k + 1;
                        const int slot = __shfl(myinv[rr], e);
                        const uint2* yr = (const uint2*)(YS + ((size_t)(b * 16 + e) * CAP + slot) * D);
#pragma unroll
                        for (int j = 0; j < 4; ++j) w[k][j] = yr[lane + 64 * j];
                    }
                }
#pragma unroll
                for (int k = 0; k < 4; ++k) {
                    if (k < ne) {
#pragma unroll
                        for (int j = 0; j < 4; ++j) { acc[rr][j].x += __uint_as_float(w[k][j].x << 16); acc[rr][j].y += __uint_as_float(w[k][j].x & 0xffff0000u); acc[rr][j].z += __uint_as_float(w[k][j].y << 16); acc[rr][j].w += __uint_as_float(w[k][j].y & 0xffff0000u); }
                    }
                }
            }
        }
#pragma unroll
        for (int rr = 0; rr < NR; ++rr) {
            f32x4_t v[4]; float ss = 0.f;
#pragma unroll
            for (int j = 0; j < 4; ++j) {
                const f32x4_t g = ((const f32x4_t*)g2)[lane + 64 * j];
                v[j] = xv[rr][j] + g * acc[rr][j];
                ss += v[j].x * v[j].x + v[j].y * v[j].y + v[j].z * v[j].z + v[j].w * v[j].w;
            }
            ss = wave_sum(ss);
            const float rstd = rsqrtf(ss * (1.f / D) + EPS);
#pragma unroll
            for (int j = 0; j < 4; ++j) {
                const f32x4_t g = ((const f32x4_t*)p.final_g)[lane + 64 * j];
                ((f32x4_t*)(X + (size_t)(r0 + rr) * D))[lane + 64 * j] = v[j] * rstd * g;
            }
        }
    }
}

#define LAS __attribute__((address_space(3)))
#define XB_TMO      128
#define XB_XCNT(j)  (256  + 64 * (j))
#define XB_XSUB(j)  (1280 + 64 * (j))
#define XB_XGEN(j)  (2304 + 64 * (j))
#define XB_TOP      3328
#define XB_TOPGEN   3392
#define XCD_BAR_WORDS 3456
#define XB_SPIN_CAP (1u << 18)

__device__ __forceinline__ unsigned xb_ld(unsigned* p)              { return __hip_atomic_load(p, __ATOMIC_RELAXED, __HIP_MEMORY_SCOPE_AGENT); }
__device__ __forceinline__ unsigned xb_add(unsigned* p, unsigned v) { return __hip_atomic_fetch_add(p, v, __ATOMIC_RELAXED, __HIP_MEMORY_SCOPE_AGENT); }
__device__ __forceinline__ unsigned xb_xcc_id() { return (unsigned)__builtin_amdgcn_s_getreg((3 << 11) | 20) & 0xFu; }
#define XB_SPIN(cond, bar) do { unsigned _sp = 0; while (cond) { __builtin_amdgcn_s_sleep(1); \
    if ((++_sp & 255u) == 0u) { if (xb_ld(&(bar)[XB_TMO])) break; if (_sp > XB_SPIN_CAP) { atomicAdd(&(bar)[XB_TMO], 1u); break; } } } } while (0)

struct XcdBarrier {
    unsigned* bar; unsigned x;
    volatile LAS unsigned* st;
};

__device__ __forceinline__ XcdBarrier xcd_barrier_post(unsigned* bar, volatile LAS unsigned* st) {
    XcdBarrier b; b.bar = bar; b.x = xb_xcc_id(); b.st = st;
    if (threadIdx.x == 0) (void)xb_add(&bar[XB_XCNT(b.x)], 1u);
    return b;
}
__device__ __forceinline__ void xcd_barrier_complete(unsigned* bar, unsigned x, unsigned& nloc, unsigned& nx) {
    const unsigned G = gridDim.x * gridDim.y * gridDim.z;
    unsigned sum, cnt, mine, sp = 0u;
    for (;;) {
        sum = 0u; cnt = 0u; mine = 0u;
#pragma unroll
        for (unsigned j = 0; j < 16; ++j) { const unsigned c = xb_ld(&bar[XB_XCNT(j)]); sum += c; cnt += (c > 0u) ? 1u : 0u; mine = (j == x) ? c : mine; }
        if (sum == G) break;
        __builtin_amdgcn_s_sleep(1);
        if ((++sp & 255u) == 0u) { if (xb_ld(&bar[XB_TMO])) break; if (sp > XB_SPIN_CAP) { atomicAdd(&bar[XB_TMO], 1u); break; } }
    }
    nloc = mine > 0u ? mine : 1u; nx = cnt > 0u ? cnt : 1u;
}

__device__ __forceinline__ void xcd_barrier(const XcdBarrier& b) {
    asm volatile("s_waitcnt vmcnt(0)" ::: "memory");
    __syncthreads();
    if (threadIdx.x == 0) {
        unsigned* bar = b.bar;
        __builtin_amdgcn_s_waitcnt(0);
        unsigned nloc = b.st[0], nx = b.st[1];
        if (nloc == 0u) { xcd_barrier_complete(bar, b.x, nloc, nx); b.st[0] = nloc; b.st[1] = nx; }
        const unsigned old = xb_add(&bar[XB_XSUB(b.x)], 1u);
        const unsigned gen = old / nloc;
        if (old + 1u == (gen + 1u) * nloc) {
            __builtin_amdgcn_fence(__ATOMIC_RELEASE, "agent");
            asm volatile("s_waitcnt vmcnt(0)" ::: "memory");
            const unsigned og = xb_add(&bar[XB_TOP], 1u);
            const unsigned tg = og / nx;
            if (og + 1u == (tg + 1u) * nx) xb_add(&bar[XB_TOPGEN], 1u);
            else XB_SPIN(xb_ld(&bar[XB_TOPGEN]) == tg, bar);
            __builtin_amdgcn_fence(__ATOMIC_ACQUIRE, "agent");
            xb_add(&bar[XB_XGEN(b.x)], 1u);
            asm volatile("s_waitcnt vmcnt(0)" ::: "memory");
        } else {
            XB_SPIN(xb_ld(&bar[XB_XGEN(b.x)]) == gen, bar);
            __builtin_amdgcn_fence(__ATOMIC_ACQUIRE, "agent");
            asm volatile("s_waitcnt vmcnt(0)" ::: "memory");
        }
    }
    __syncthreads();
}

constexpr int N_PHASES = 11;
template <int PH>
__device__ __forceinline__ void run_phase(const P& p, unsigned char* ldsb) {
    float* lds = (float*)ldsb;
    if constexpr (PH == 0) { ph_prep(p, lds); ph_convert_small(p, lds); }
    else if constexpr (PH == 1) { ph_norm1(p); ph_filter(p, lds); }
    else if constexpr (PH == 2) ph_inproj(p, ldsb);
    else if constexpr (PH == 3) ph_mixers<0>(p, ldsb);
    else if constexpr (PH == 4) ph_mixprep(p, lds);
    else if constexpr (PH == 5) ph_outproj(p, ldsb);
    else if constexpr (PH == 6) ph_norm2_router(p, lds);
    else if constexpr (PH == 7) ph_topk(p, lds);
    else if constexpr (PH == 8) ph_moe_up(p, ldsb);
    else if constexpr (PH == 9) ph_moe_down(p, ldsb);
    else if constexpr (PH == 10) ph_final(p);
}
template <int PH>
__device__ __forceinline__ void run_from(const P& p, unsigned char* lds, const XcdBarrier& bar) {
    if constexpr (PH < N_PHASES) {
        run_phase<PH>(p, lds);
        if constexpr (PH + 1 < N_PHASES) xcd_barrier(bar);
        run_from<PH + 1>(p, lds, bar);
    }
}
__global__ void __launch_bounds__(NT, 2) fwd_all(P p) {
    extern __shared__ __attribute__((aligned(16))) unsigned char lds_raw[];
    volatile LAS unsigned* st = (volatile LAS unsigned*)(lds_raw + LDS_BYTES - 32);
    if (threadIdx.x < 2) st[threadIdx.x] = 0u;
    __syncthreads();
    const XcdBarrier bar = xcd_barrier_post((unsigned*)(p.ws + WS_CTL) + CW_BAR, st);
    run_from<0>(p, lds_raw, bar);
}

extern "C" void kernel_launch(void* const* d_in, const int* in_sizes, int n_in, void* d_out, int out_size, void* d_ws, size_t ws_size, hipStream_t stream) {
    static int grid = 0;
    if (grid == 0) {
        int dev = 0, cus = 0, per_cu = 0;
        (void)hipGetDevice(&dev);
        (void)hipDeviceGetAttribute(&cus, hipDeviceAttributeMultiprocessorCount, dev);
        (void)hipFuncSetAttribute((const void*)fwd_all, hipFuncAttributeMaxDynamicSharedMemorySize, LDS_BYTES);
        (void)hipOccupancyMaxActiveBlocksPerMultiprocessor(&per_cu, (const void*)fwd_all, NT, LDS_BYTES);
        if (per_cu < 1) fprintf(stderr, "kernel_launch: occupancy query says %d blocks/CU\n", per_cu);
        grid = (cus > 0 ? cus : 256);
        if (ws_size < WS_END) fprintf(stderr, "kernel_launch: workspace too small: %zu < %zu\n", ws_size, (size_t)WS_END);
    }
    P p{};
    const float** f = (const float**)&p;
    for (int i = 0; i < 28; ++i) f[i] = (const float*)d_in[i];
    p.out = (float*)d_out;
    p.ws = (unsigned char*)d_ws;
    p.ph_lo = 0; p.ph_hi = N_PHASES;
    (void)hipMemsetAsync((unsigned char*)d_ws + WS_CTL, 0, CTL_ZERO_BYTES, stream);
    hipLaunchKernelGGL(fwd_all, dim3(grid), dim3(NT), LDS_BYTES, stream, p);
}
```

```cpp
#include <hip/hip_runtime.h>
#include <cstdio>
#include <cstdint>

constexpr int D = 1024, NB = 16, SEQ = 2048, CTXL = 256;
constexpr int NTOK = NB * SEQ;
constexpr int NCTX = NB * CTXL;
constexpr int HEADS = 4;
constexpr int INC = 4096;
constexpr int NE = 16, CAP = 256, FF = 2048;
constexpr int NT = 512;
constexpr int LDS_BYTES = 147456;
constexpr float EPS = 1e-6f;
typedef unsigned short bf16_t;

constexpr size_t MiB = 1u << 20;
constexpr size_t WS_CTL = 0;
constexpr size_t WS_ADA = 1 * MiB;
constexpr size_t WS_LB = WS_ADA + 512 * 1024;
constexpr size_t WS_HID2 = 2 * MiB;
constexpr size_t WS_AFF = 3 * MiB;
constexpr size_t WS_IDX = 5 * MiB;
constexpr size_t WS_GATE = 5 * MiB + 512 * 1024;
constexpr size_t WS_INV = 6 * MiB;
constexpr size_t WS_W13T = 8 * MiB;
constexpr size_t WS_YS = WS_W13T;
constexpr size_t WS_W2T = 136 * MiB;
constexpr size_t WS_R = 200 * MiB;
constexpr size_t WS_H = WS_R;
constexpr size_t WS_MIXA = WS_R;
constexpr size_t WS_HC = WS_R + 64 * MiB;
constexpr size_t WS_PC = WS_R + 72 * MiB;
constexpr size_t WS_OFB = WS_R + 84 * MiB;
constexpr size_t WS_WOUTT = WS_R + 148 * MiB;
constexpr size_t WS_PHG = WS_R + 152 * MiB;
constexpr size_t WS_HMID = WS_R;
constexpr size_t WS_H2 = WS_R + 256 * MiB;
constexpr size_t WS_YT = WS_R + 320 * MiB;
constexpr size_t WS_END = WS_YT + 32 * MiB;
constexpr int CW_QHEAD = 64;
constexpr int CW_BAR = 4096;
constexpr size_t CTL_ZERO_BYTES = 65536;
constexpr size_t DO_PHYT = 0;
constexpr size_t DO_HF = 96 * MiB;
constexpr size_t DO_SCTX = 112 * MiB;
constexpr size_t DO_WINT = 120 * MiB;

struct P {
    const float *x, *c, *ctx, *c_ctx, *ada_w, *ada_b, *norm1_g, *w_in, *hy_conv_w, *hy_conv_b, *pos_w1, *pos_b1, *freq1, *pos_w2, *pos_b2,
        *freq2, *pos_w3, *hy_bias, *hy_norm_g, *hg_lb, *hg_norm_g, *w_out, *norm2_g, *router_w, *exp_w1, *exp_w3, *exp_w2, *final_g;
    float* out;
    unsigned char* ws;
    int ph_lo, ph_hi;
};

__device__ __forceinline__ int opaque_tid() { int t = threadIdx.x; asm volatile("" : "+v"(t)); return t; }
__device__ __forceinline__ void lds_barrier() { asm volatile("s_waitcnt lgkmcnt(0)" ::: "memory"); __builtin_amdgcn_s_barrier(); asm volatile("" ::: "memory"); }
typedef float f32x4_t __attribute__((ext_vector_type(4)));
__device__ __forceinline__ float wave_sum(float v) {
#pragma unroll
    for (int o = 1; o < 64; o <<= 1) v += __shfl_xor(v, o);
    return v;
}
__device__ __forceinline__ float sigmoidf_(float z) { return 1.f / (1.f + expf(-z)); }
__device__ __forceinline__ float siluf_(float z) { return z / (1.f + expf(-z)); }
__device__ __forceinline__ float silu_f(float z) { return z * __builtin_amdgcn_rcpf(1.0f + __builtin_amdgcn_exp2f(-1.4426950408889634f * z)); }
__device__ __forceinline__ float bf2f(bf16_t h) { return __uint_as_float((unsigned)h << 16); }
__device__ __forceinline__ unsigned f2bf(float f) { unsigned u = __float_as_uint(f); return (u + 0x7fffu + ((u >> 16) & 1u)) >> 16; }
typedef float f32x2_cv __attribute__((ext_vector_type(2))); typedef __bf16 bf16x2_cv __attribute__((ext_vector_type(2)));
__device__ __forceinline__ unsigned cvtpk(float lo, float hi) { const f32x2_cv v = {lo, hi}; const bf16x2_cv b = __builtin_convertvector(v, bf16x2_cv); return __builtin_bit_cast(unsigned, b); }
__device__ __forceinline__ unsigned pk2(float lo, float hi) { return f2bf(lo) | (f2bf(hi) << 16); }

namespace pg8 {
#define PG8_LAS __attribute__((address_space(3)))
typedef unsigned short bf16_t;
typedef short bf16x8 __attribute__((ext_vector_type(8)));
typedef float f32x4 __attribute__((ext_vector_type(4)));
typedef unsigned u32x4 __attribute__((ext_vector_type(4)));
constexpr int BM = 256, BK = 64, HALF = 128, HTB = HALF * BK * 2  , STAGE_BYTES = 8 * HTB, NXCD = 8, WGM = 8;

__host__ __device__ __forceinline__ int lds_byte(int r, int c) { const int st = (r >> 4) * 2 + (c >> 5), rr = r & 15, cc = c & 31, ob = rr * 64 + cc * 2; return st * 1024 + (ob ^ (((ob >> 9) & 1) << 5)); }
__host__ __device__ __forceinline__ void stage_rc(int b, int& R, int& C) { const int st = b / 1024, sb = b % 1024, swz = sb ^ (((sb >> 9) & 1) << 5); R = (st >> 1) * 16 + swz / 64; C = (st & 1) * 32 + (swz % 64) / 2; }
__host__ __device__ __forceinline__ int perm32(int rho) { const int n = rho >> 4, i = rho & 15; return 8 * (i >> 2) + 4 * n + (i & 3); }

struct Unit { const char* a; const char* b; bf16_t* c; const float* aux; const int* gidx; int ldc, row0, col0; };
__device__ __forceinline__ unsigned cvt_pk_bf16(float lo, float hi) { unsigned r; asm volatile("v_cvt_pk_bf16_f32 %0, %1, %2" : "=v"(r) : "v"(lo), "v"(hi)); return r; }

__device__ __forceinline__ void tile_of(int L, int nM, int nN, int& pm, int& pn) {
    const int nwg = nM * nN; int wgid = L;
    { const int q = nwg / NXCD, r = nwg % NXCD, xcd = wgid % NXCD, off = wgid / NXCD; wgid = (xcd < r ? xcd * (q + 1) : r * (q + 1) + (xcd - r) * q) + off; }
    const int nig = WGM * nN, gid = wgid / nig, fm = gid * WGM, gsz = (nM - fm) < WGM ? (nM - fm) : WGM;
    pm = fm + ((wgid % nig) % gsz); pn = (wgid % nig) / gsz;
}

struct EpiStoreBf16 {
    static constexpr bool PERM = true, AFTER_DRAIN = false;
    __device__ __forceinline__ void operator()(const f32x4 (&acc)[2][2][4][2], const Unit& u, int wr, int wc, int fr, int fq) const {
        bf16_t* base = u.c + (size_t)(wr * 64 + fr) * u.ldc + wc * 32 + 8 * fq;
#pragma unroll
        for (int ai = 0; ai < 2; ++ai)
#pragma unroll
            for (int m = 0; m < 4; ++m) { bf16_t* rowp = base + (size_t)(ai * HALF + m * 16) * u.ldc;
#pragma unroll
                for (int bj = 0; bj < 2; ++bj) { const f32x4 v0 = acc[ai][bj][m][0], v1 = acc[ai][bj][m][1];
                    u32x4 w; w.x = cvt_pk_bf16(v0[0], v0[1]); w.y = cvt_pk_bf16(v0[2], v0[3]); w.z = cvt_pk_bf16(v1[0], v1[1]); w.w = cvt_pk_bf16(v1[2], v1[3]);
                    *(u32x4*)(rowp + bj * HALF) = w; } }
    }
};
struct EpiOutProj {
    static constexpr bool PERM = true, AFTER_DRAIN = false;
    const float* x; const float* ada; bf16_t* x1;
    __device__ __forceinline__ void operator()(const f32x4 (&acc)[2][2][4][2], const Unit& u, int wr, int wc, int fr, int fq) const {
        const float* g1 = ada + (u.row0 >> 11) * 6144 + 2048;
#pragma unroll
        for (int bj = 0; bj < 2; ++bj) { const int col = u.col0 + bj * HALF + wc * 32 + 8 * fq; const f32x4 g0 = *(const f32x4*)(g1 + col), gB = *(const f32x4*)(g1 + col + 4);
#pragma unroll
            for (int ai = 0; ai < 2; ++ai)
#pragma unroll
                for (int m = 0; m < 4; ++m) { const size_t row = (size_t)(u.row0 + ai * HALF + wr * 64 + m * 16 + fr);
                    const f32x4 v0 = *(const f32x4*)(x + row * D + col) + g0 * acc[ai][bj][m][0], v1 = *(const f32x4*)(x + row * D + col + 4) + gB * acc[ai][bj][m][1];
                    u32x4 w; w.x = cvt_pk_bf16(v0[0], v0[1]); w.y = cvt_pk_bf16(v0[2], v0[3]); w.z = cvt_pk_bf16(v1[0], v1[1]); w.w = cvt_pk_bf16(v1[2], v1[3]);
                    *(u32x4*)(x1 + row * (2 * D) + col) = w; } }
    }
};
__device__ __forceinline__ float silu_fast(float a) { return a * __builtin_amdgcn_rcpf(1.0f + __builtin_amdgcn_exp2f(-1.4426950408889634f * a)); }
struct EpiSwiGLU {
    static constexpr bool PERM = true, AFTER_DRAIN = false;
    __device__ __forceinline__ void operator()(const f32x4 (&acc)[2][2][4][2], const Unit& u, int wr, int wc, int fr, int fq) const {
        bf16_t* base = u.c + (size_t)(wr * 64 + fr) * FF + wc * 32 + 8 * fq;
#pragma unroll
        for (int ai = 0; ai < 2; ++ai)
#pragma unroll
            for (int m = 0; m < 4; ++m) { const f32x4 a0 = acc[ai][0][m][0], a1 = acc[ai][0][m][1], b0 = acc[ai][1][m][0], b1 = acc[ai][1][m][1];
                u32x4 w; w.x = cvt_pk_bf16(silu_fast(a0[0]) * b0[0], silu_fast(a0[1]) * b0[1]); w.y = cvt_pk_bf16(silu_fast(a0[2]) * b0[2], silu_fast(a0[3]) * b0[3]);
                w.z = cvt_pk_bf16(silu_fast(a1[0]) * b1[0], silu_fast(a1[1]) * b1[1]); w.w = cvt_pk_bf16(silu_fast(a1[2]) * b1[2], silu_fast(a1[3]) * b1[3]);
                *(u32x4*)(base + (size_t)(ai * HALF + m * 16) * FF) = w; }
    }
};
struct EpiDown {
    static constexpr bool PERM = true, AFTER_DRAIN = false;
    __device__ __forceinline__ void operator()(const f32x4 (&acc)[2][2][4][2], const Unit& u, int wr, int wc, int fr, int fq) const {
        bf16_t* base = u.c + (size_t)(wr * 64 + fr) * D + wc * 32 + 8 * fq;
#pragma unroll
        for (int ai = 0; ai < 2; ++ai)
#pragma unroll
            for (int m = 0; m < 4; ++m) { const float gt = u.aux[ai * HALF + wr * 64 + m * 16 + fr]; bf16_t* rowp = base + (size_t)(ai * HALF + m * 16) * D;
#pragma unroll
                for (int bj = 0; bj < 2; ++bj) { const f32x4 v0 = acc[ai][bj][m][0] * gt, v1 = acc[ai][bj][m][1] * gt;
                    u32x4 w; w.x = cvt_pk_bf16(v0[0], v0[1]); w.y = cvt_pk_bf16(v0[2], v0[3]); w.z = cvt_pk_bf16(v1[0], v1[1]); w.w = cvt_pk_bf16(v1[2], v1[3]);
                    *(u32x4*)(rowp + bj * HALF) = w; } }
    }
};

template <class Epi, class Sched, bool ALIGN_EPI = false, bool SP2 = false, bool GATHER = false>
__device__ __forceinline__ void gemm_phase(PG8_LAS unsigned char* lds, const int K, const Sched& S, const Epi& E) {
    const int tid = opaque_tid(), wid = __builtin_amdgcn_readfirstlane(tid >> 6), lane = tid & 63, wr = wid >> 2, wc = wid & 3, fr = lane & 15, fq = lane >> 4;
    const int nt = K / BK;
    unsigned voffA[2], voffB[2];
#pragma unroll
    for (int i = 0; i < 2; ++i) { int R, C; stage_rc(tid * 16 + i * 8192, R, C); const int Rb = Epi::PERM ? ((R & ~31) + perm32(R & 31)) : R;
        voffA[i] = (unsigned)(R * K + C) * 2u; voffB[i] = (unsigned)(Rb * K + C) * 2u; }
    const size_t kstep = (size_t)(BK * 2);
    const size_t hstep = (size_t)HALF * K * 2;
    const unsigned ldsw = (unsigned)wid * 1024u;
    const int aoff = lds_byte(wr * 64 + fr, fq * 8), boff = lds_byte(wc * 32 + fr, fq * 8);
#define PG8_SA(b, h) (((b) * 2 + (h)) * HTB)
#define PG8_SB(b, h) ((4 + (b) * 2 + (h)) * HTB)
#define PG8_STAGE(bufoff, gbase, voff) do { _Pragma("unroll") for (int _i = 0; _i < 2; ++_i) \
        __builtin_amdgcn_global_load_lds((const unsigned*)((const char*)(gbase) + (voff)[_i]), (PG8_LAS unsigned*)(lds + (bufoff) + ldsw + _i * 8192), 16, 0, 0); } while (0)
#define PG8_STAGE_A(bufoff, gbase, h) do { _Pragma("unroll") for (int _i = 0; _i < 2; ++_i) \
        __builtin_amdgcn_global_load_lds((const unsigned*)((const char*)(gbase) + voffAh[h][_i]), (PG8_LAS unsigned*)(lds + (bufoff) + ldsw + _i * 8192), 16, 0, 0); } while (0)
#define PG8_LDA(dst, b, h) do { _Pragma("unroll") for (int m = 0; m < 4; ++m) _Pragma("unroll") for (int k = 0; k < 2; ++k) dst[m][k] = *(const PG8_LAS bf16x8*)(lds + PG8_SA(b, h) + aoff + m * 2048 + k * 1024); } while (0)
#define PG8_LDB(dst, b, h) do { _Pragma("unroll") for (int n = 0; n < 2; ++n) _Pragma("unroll") for (int k = 0; k < 2; ++k) dst[n][k] = *(const PG8_LAS bf16x8*)(lds + PG8_SB(b, h) + boff + n * 2048 + k * 1024); } while (0)
#define PG8_MMA(ai, bj, At, Bt) do { __builtin_amdgcn_s_setprio(1); _Pragma("unroll") for (int m = 0; m < 4; ++m) _Pragma("unroll") for (int n = 0; n < 2; ++n) _Pragma("unroll") for (int k = 0; k < 2; ++k) \
        acc[ai][bj][m][n] = __builtin_amdgcn_mfma_f32_16x16x32_bf16(Bt[n][k], At[m][k], acc[ai][bj][m][n], 0, 0, 0); __builtin_amdgcn_s_setprio(0); } while (0)
#define PG8_WAIT_V(n) asm volatile("s_waitcnt vmcnt(" #n ")" ::: "memory")
#define PG8_WAIT_L(n) asm volatile("s_waitcnt lgkmcnt(" #n ")" ::: "memory")
#define PG8_BAR __builtin_amdgcn_s_barrier()
#define PG8_SCHED __builtin_amdgcn_sched_barrier(0)
    Unit cur, nxt; int ui = 0;
    if (!S.next(0, cur)) return;
    unsigned voffAh[2][2];
#pragma unroll
    for (int h = 0; h < 2; ++h)
#pragma unroll
        for (int i = 0; i < 2; ++i) {
            if constexpr (GATHER) { int R, C; stage_rc(tid * 16 + i * 8192, R, C); voffAh[h][i] = ((unsigned)cur.gidx[h * HALF + R] * (unsigned)K + (unsigned)C) * 2u; }
            else voffAh[h][i] = voffA[i] + (unsigned)h * (unsigned)hstep;
        }
    f32x4 acc[2][2][4][2];
#pragma unroll
    for (int a = 0; a < 2; ++a)
#pragma unroll
        for (int b = 0; b < 2; ++b)
#pragma unroll
            for (int m = 0; m < 4; ++m)
#pragma unroll
                for (int n = 0; n < 2; ++n) acc[a][b][m][n] = (f32x4){0.f, 0.f, 0.f, 0.f};
    bf16x8 At[4][2], B0[2][2], B1[2][2];
    const char* cA = cur.a; const char* cB = cur.b;
    S.a_ready(cur);
    if constexpr (SP2) {
        PG8_STAGE(PG8_SB(0, 0), cB, voffB); PG8_STAGE(PG8_SB(0, 1), cB + hstep, voffB); PG8_STAGE_A(PG8_SA(0, 0), cA, 0); PG8_STAGE_A(PG8_SA(0, 1), cA, 1);
        if (wr == 1) PG8_BAR;
        PG8_WAIT_V(2); PG8_BAR;
        PG8_STAGE(PG8_SB(1, 0), cB + kstep, voffB); PG8_STAGE_A(PG8_SA(1, 0), cA + kstep, 0); PG8_STAGE(PG8_SB(1, 1), cB + hstep + kstep, voffB);
        PG8_WAIT_V(6); PG8_BAR;
    } else {
        PG8_STAGE(PG8_SB(0, 0), cB, voffB); PG8_STAGE_A(PG8_SA(0, 0), cA, 0); PG8_STAGE(PG8_SB(0, 1), cB + hstep, voffB); PG8_STAGE_A(PG8_SA(0, 1), cA, 1);
        if (wr == 1) PG8_BAR;
        PG8_WAIT_V(4); PG8_BAR;
        PG8_STAGE(PG8_SB(1, 0), cB + kstep, voffB); PG8_STAGE_A(PG8_SA(1, 0), cA + kstep, 0); PG8_STAGE(PG8_SB(1, 1), cB + hstep + kstep, voffB);
        PG8_WAIT_V(6); PG8_BAR;
    }
    for (;;) {
        const bool has_next = S.next(ui + 1, nxt);
        const char* nA = has_next ? nxt.a : cA; const char* nB = has_next ? nxt.b : cB;
        for (int t = 0; t < nt; t += 2) {
            const bool last = (t == nt - 2);
            const char* a1 = cA + (size_t)(t + 1) * kstep;
            const char* a2 = last ? nA : cA + (size_t)(t + 2) * kstep; const char* b2 = last ? nB : cB + (size_t)(t + 2) * kstep;
            const char* a3 = a2 + kstep; const char* b3 = b2 + kstep;
            if (last && has_next) S.a_ready(nxt);
            if constexpr (SP2) {
            PG8_LDB(B0, 0, 0); PG8_LDB(B1, 0, 1); PG8_SCHED; PG8_LDA(At, 0, 0); PG8_STAGE_A(PG8_SA(1, 1), a1, 1);
            PG8_WAIT_V(8); PG8_WAIT_L(0); PG8_BAR; PG8_MMA(0, 0, At, B0); PG8_MMA(0, 1, At, B1); PG8_BAR; PG8_SCHED;
            PG8_LDA(At, 0, 1); PG8_STAGE(PG8_SB(0, 0), b2, voffB); PG8_STAGE(PG8_SB(0, 1), b2 + hstep, voffB); PG8_STAGE_A(PG8_SA(0, 0), a2, 0);
            PG8_WAIT_V(8); PG8_WAIT_L(0); PG8_BAR; PG8_MMA(1, 0, At, B0); PG8_MMA(1, 1, At, B1); PG8_BAR; PG8_SCHED;
            PG8_LDB(B0, 1, 0); PG8_LDB(B1, 1, 1); PG8_SCHED; PG8_LDA(At, 1, 0); PG8_STAGE_A(PG8_SA(0, 1), a2, 1);
            PG8_WAIT_V(8); PG8_WAIT_L(0); PG8_BAR; PG8_MMA(0, 0, At, B0); PG8_MMA(0, 1, At, B1); PG8_BAR; PG8_SCHED;
            PG8_LDA(At, 1, 1); PG8_STAGE(PG8_SB(1, 0), b3, voffB); PG8_STAGE(PG8_SB(1, 1), b3 + hstep, voffB); PG8_STAGE_A(PG8_SA(1, 0), a3, 0);
            PG8_WAIT_V(8); PG8_WAIT_L(0); PG8_BAR; PG8_MMA(1, 0, At, B0); PG8_MMA(1, 1, At, B1); PG8_BAR; PG8_SCHED;
            } else {
            PG8_LDB(B0, 0, 0); PG8_SCHED; PG8_LDA(At, 0, 0); PG8_STAGE_A(PG8_SA(1, 1), a1, 1);
            PG8_WAIT_L(8); PG8_BAR; PG8_WAIT_L(0); PG8_MMA(0, 0, At, B0); PG8_BAR; PG8_SCHED;
            PG8_LDB(B1, 0, 1); PG8_STAGE(PG8_SB(0, 0), b2, voffB);
            PG8_BAR; PG8_WAIT_L(0); PG8_MMA(0, 1, At, B1); PG8_BAR;
            PG8_LDA(At, 0, 1); PG8_STAGE_A(PG8_SA(0, 0), a2, 0);
            PG8_BAR; PG8_WAIT_L(0); PG8_MMA(1, 0, At, B0); PG8_BAR; PG8_SCHED;
            PG8_STAGE(PG8_SB(0, 1), b2 + hstep, voffB);
            PG8_WAIT_V(6); PG8_BAR; PG8_MMA(1, 1, At, B1); PG8_BAR;
            PG8_LDB(B0, 1, 0); PG8_SCHED; PG8_LDA(At, 1, 0); PG8_STAGE_A(PG8_SA(0, 1), a2, 1);
            PG8_WAIT_L(8); PG8_BAR; PG8_WAIT_L(0); PG8_MMA(0, 0, At, B0); PG8_BAR; PG8_SCHED;
            PG8_LDB(B1, 1, 1); PG8_STAGE(PG8_SB(1, 0), b3, voffB);
            PG8_BAR; PG8_WAIT_L(0); PG8_MMA(0, 1, At, B1); PG8_BAR;
            PG8_LDA(At, 1, 1); PG8_STAGE_A(PG8_SA(1, 0), a3, 0);
            PG8_BAR; PG8_WAIT_L(0); PG8_MMA(1, 0, At, B0); PG8_BAR; PG8_SCHED;
            PG8_STAGE(PG8_SB(1, 1), b3 + hstep, voffB);
            PG8_WAIT_V(6); PG8_BAR; PG8_MMA(1, 1, At, B1); PG8_BAR;
            }
        }
        if constexpr (ALIGN_EPI) { if (wr == 0) PG8_BAR; }
        if constexpr (!Epi::AFTER_DRAIN) { E(acc, cur, wr, wc, fr, fq); S.done(cur); }
        if (!has_next) break;
#pragma unroll
        for (int a = 0; a < 2; ++a)
#pragma unroll
            for (int b = 0; b < 2; ++b)
#pragma unroll
                for (int m = 0; m < 4; ++m)
#pragma unroll
                    for (int n = 0; n < 2; ++n) acc[a][b][m][n] = (f32x4){0.f, 0.f, 0.f, 0.f};
        cur = nxt; cA = nA; cB = nB; ++ui;
        if constexpr (ALIGN_EPI) { if (wr == 1) PG8_BAR; }
    }
    PG8_WAIT_V(0);
    if constexpr (!ALIGN_EPI) { if (wr == 0) PG8_BAR; }
    PG8_BAR;
    if constexpr (Epi::AFTER_DRAIN) { E.fused(acc, cur, wr, wc, fr, fq, lds, wid, lane); S.done(cur); }
#undef PG8_SA
#undef PG8_SB
#undef PG8_STAGE
#undef PG8_LDA
#undef PG8_LDB
#undef PG8_MMA
#undef PG8_WAIT_V
#undef PG8_WAIT_L
#undef PG8_BAR
#undef PG8_SCHED
}
}
using pg8::Unit; using pg8::tile_of;

__device__ __forceinline__ void ph_prep(const P& p, float* lds) {
    const int tid = opaque_tid(), G = gridDim.x;
    float* ADA = (float*)(p.ws + WS_ADA);
    float* LB = (float*)(p.ws + WS_LB);
    float* HID2 = (float*)(p.ws + WS_HID2);
    {
        float* s = lds;
        float* red = lds + 17 * 1024;
        if (blockIdx.x < 192) {
            for (int i = tid; i < 17 * 1024; i += NT) {
                const int r = i >> 10, d = i & 1023;
                const float cv = r < 16 ? p.c[r * 1024 + d] : p.c_ctx[d];
                s[i] = siluf_(cv);
            }
        }
        __syncthreads();
        for (int item = blockIdx.x; item < 192; item += G) {
            const int jj = tid & 31, ks = tid >> 5, j = item * 32 + jj;
            float acc[17];
#pragma unroll
            for (int r = 0; r < 17; ++r) acc[r] = 0.f;
            for (int d0 = ks * 64; d0 < ks * 64 + 64; d0 += 16) {
                float wv[16];
#pragma unroll
                for (int q = 0; q < 16; ++q) wv[q] = p.ada_w[(size_t)(d0 + q) * 6144 + j];
#pragma unroll
                for (int q = 0; q < 16; ++q)
#pragma unroll
                    for (int r = 0; r < 17; ++r) acc[r] += s[r * 1024 + d0 + q] * wv[q];
            }
#pragma unroll
            for (int r = 0; r < 17; ++r) red[(ks * 17 + r) * 32 + jj] = acc[r];
            __syncthreads();
            for (int i = tid; i < 17 * 32; i += NT) {
                const int r = i >> 5, j2 = i & 31;
                float sum = 0.f;
#pragma unroll
                for (int k = 0; k < 16; ++k) sum += red[(k * 17 + r) * 32 + j2];
                ADA[r * 6144 + item * 32 + j2] = sum + p.ada_b[item * 32 + j2];
            }
            __syncthreads();
        }
    }
    if (blockIdx.x == G - 1) {
        for (int i = tid; i < 1024; i += NT) {
            const float a0 = p.hg_lb[i], a1 = p.hg_lb[1024 + i];
            LB[i] = 1.f / (1.f + expf(a1 - a0));
        }
    }
    {
        float* zl = lds;
        float* h1 = lds + 512;
        __syncthreads();
        for (int it = (G - 1 - blockIdx.x); it < SEQ / 8; it += G) {
            const int lt = tid >> 6, j = tid & 63, t = it * 8 + lt;
            const float w = 6.283185307179586f * (float)t / 2048.0f;
            if (j == 0) zl[lt * 64] = (float)t / 2047.0f;
            if (j >= 1 && j < 17) { const float f = 1e-4f + (float)(j - 1) * ((15.0f - 1e-4f) / 15.0f); zl[lt * 64 + j] = cosf(f * w); }
            if (j >= 17 && j < 33) { const float f = 1e-4f + (float)(j - 17) * ((15.0f - 1e-4f) / 15.0f); zl[lt * 64 + j] = -sinf(f * w); }
            __syncthreads();
            float a = p.pos_b1[j];
            for (int i = 0; i < 33; ++i) a += zl[lt * 64 + i] * p.pos_w1[i * 64 + j];
            h1[lt * 64 + j] = sinf(p.freq1[j] * a);
            __syncthreads();
            float b = p.pos_b2[j];
            for (int i = 0; i < 64; ++i) b += h1[lt * 64 + i] * p.pos_w2[i * 64 + j];
            HID2[t * 64 + j] = sinf(p.freq2[j] * b);
            __syncthreads();
        }
    }
}
struct ConvItem { const float* W; bf16_t* dst; int N, KD, k0, n0, which; };
__device__ __forceinline__ ConvItem conv_small_item(const P& p, int it) {
    ConvItem c; c.which = 0; c.KD = D;
    if (it < 256) { c.W = p.w_in; c.N = INC; c.k0 = (it / 16) * 64; c.n0 = (it % 16) * 256; c.dst = (bf16_t*)((unsigned char*)p.out + DO_WINT); }
    else { const int r = it - 256; c.W = p.w_out; c.N = D; c.k0 = (r / 4) * 64; c.n0 = (r % 4) * 256; c.dst = (bf16_t*)(p.ws + WS_WOUTT); }
    return c;
}
constexpr int N_EXPERT_ITEMS = 2 * 16 * 16 * 8 + 16 * 32 * 4;
__device__ __forceinline__ ConvItem conv_expert_item(const P& p, int r) {
    ConvItem c; constexpr int I_W1 = 16 * 16 * 8;
    if (r < 2 * I_W1) {
        const int which = r / I_W1; r %= I_W1;
        const int e = r / 128, r2 = r % 128;
        c.W = (which == 0 ? p.exp_w1 : p.exp_w3) + (size_t)e * D * FF; c.N = FF; c.k0 = (r2 / 8) * 64; c.n0 = (r2 % 8) * 256; c.dst = (bf16_t*)(p.ws + WS_W13T) + (size_t)e * 4096 * D; c.KD = D; c.which = 1 + which;
    } else {
        r -= 2 * I_W1; const int e = r / 128, r2 = r % 128;
        c.W = p.exp_w2 + (size_t)e * FF * D; c.N = D; c.k0 = (r2 / 4) * 64; c.n0 = (r2 % 4) * 256; c.dst = (bf16_t*)(p.ws + WS_W2T) + (size_t)e * 1024 * FF; c.KD = FF; c.which = 0;
    }
    return c;
}
__device__ __forceinline__ void conv_load(const ConvItem& c, f32x4_t (&v)[8], int tid) {
#pragma unroll
    for (int q = 0; q < 8; ++q) { const int i = tid + NT * q, k = i >> 6, n4 = i & 63; v[q] = *(const f32x4_t*)(c.W + (size_t)(c.k0 + k) * c.N + c.n0 + 4 * n4); }
}
__device__ __forceinline__ void conv_tile_write(const f32x4_t (&v)[8], float* T, int tid) {
#pragma unroll
    for (int q = 0; q < 8; ++q) { const int i = tid + NT * q, k = i >> 6, n4 = i & 63; *(f32x4_t*)&T[k * 260 + 4 * (n4 ^ ((k >> 3) & 7))] = v[q]; }
}
__device__ __forceinline__ void conv_tile_store(const ConvItem& c, const float* T, int tid) {
#pragma unroll
    for (int q = 0; q < 4; ++q) { const int i = tid + NT * q, nl = i >> 3, ch = i & 7, n = c.n0 + nl;
        float a[8];
#pragma unroll
        for (int e = 0; e < 8; ++e) a[e] = T[(8 * ch + e) * 260 + (nl ^ (ch << 2))];
        const int row = c.which == 0 ? n : ((n >> 7) * 256 + (c.which - 1) * 128 + (n & 127));
        *(uint4*)(c.dst + (size_t)row * c.KD + c.k0 + 8 * ch) = make_uint4(cvtpk(a[0], a[1]), cvtpk(a[2], a[3]), cvtpk(a[4], a[5]), cvtpk(a[6], a[7])); }
}
constexpr int CONV_DEPTH = 4;
template <class ITEMF>
__device__ __forceinline__ void conv_run(ITEMF item, int first, int count, float* T) {
    const int tid = opaque_tid();
    f32x4_t ring[CONV_DEPTH][8];
#pragma unroll
    for (int d = 0; d < CONV_DEPTH; ++d) { const ConvItem c = item(first + d); conv_load(c, ring[d], tid); }
    for (int i0 = 0; i0 < count; i0 += CONV_DEPTH) {
#pragma unroll
        for (int d = 0; d < CONV_DEPTH; ++d) {
            const int i = i0 + d;
            const ConvItem c = item(first + i);
            lds_barrier();
            conv_tile_write(ring[d], T, tid);
            lds_barrier();
            if (i + CONV_DEPTH < count) { const ConvItem cn = item(first + i + CONV_DEPTH); conv_load(cn, ring[d], tid); }
            conv_tile_store(c, T, tid);
        }
    }
}
__device__ __forceinline__ void ph_convert_small(const P& p, float* lds) {
    __syncthreads();
    if (blockIdx.x >= 96 && blockIdx.x < 96 + 80) conv_run([&](int it) { return conv_small_item(p, it); }, (blockIdx.x - 96) * 4, 4, lds);
}

__device__ __forceinline__ void ph_norm1(const P& p) {
    const int tid = opaque_tid(), lane = tid & 63, wv = tid >> 6;
    const float* ADA = (const float*)(p.ws + WS_ADA);
    bf16_t* H = (bf16_t*)(p.ws + WS_H);
    bf16_t* HC = (bf16_t*)(p.ws + WS_HC);
    auto run = [&](const float* src, bf16_t* dst, int ar, int nrows) {
        f32x4_t gm[4], hs[4];
#pragma unroll
        for (int j = 0; j < 4; ++j) { const int d4 = lane + 64 * j; const f32x4_t g = ((const f32x4_t*)p.norm1_g)[d4], s1 = ((const f32x4_t*)(ADA + ar * 6144 + 1024))[d4]; gm[j] = g * (1.f + s1); hs[j] = ((const f32x4_t*)(ADA + ar * 6144))[d4]; }
        f32x4_t v[4], vn[4];
#pragma unroll
        for (int j = 0; j < 4; ++j) v[j] = ((const f32x4_t*)src)[lane + 64 * j];
        for (int ri = 0; ri < nrows; ++ri) {
            if (ri + 1 < nrows) {
#pragma unroll
                for (int j = 0; j < 4; ++j) vn[j] = ((const f32x4_t*)(src + (size_t)(ri + 1) * D))[lane + 64 * j];
            }
            float ss = 0.f;
#pragma unroll
            for (int j = 0; j < 4; ++j) ss += v[j].x * v[j].x + v[j].y * v[j].y + v[j].z * v[j].z + v[j].w * v[j].w;
            const float rstd = rsqrtf(wave_sum(ss) * (1.f / D) + EPS);
#pragma unroll
            for (int j = 0; j < 4; ++j) { const f32x4_t o = v[j] * rstd * gm[j] + hs[j]; ((uint2*)(dst + (size_t)ri * D))[lane + 64 * j] = make_uint2(cvtpk(o.x, o.y), cvtpk(o.z, o.w)); }
#pragma unroll
            for (int j = 0; j < 4; ++j) v[j] = vn[j];
        }
    };
    for (int rc = blockIdx.x * 8 + wv; rc < NTOK / 16; rc += gridDim.x * 8) {
        run(p.x + (size_t)rc * 16 * D, H + (size_t)rc * 16 * D, (rc * 16) / SEQ, 16);
        run(p.ctx + (size_t)rc * 2 * D, HC + (size_t)rc * 2 * D, 16, 2);
    }
}
__device__ __forceinline__ void ph_filter(const P& p, float* lds) {
    const int tid = opaque_tid(), G = gridDim.x;
    const float* HID2 = (const float*)(p.ws + WS_HID2);
    float* HF = (float*)((unsigned char*)p.out + DO_HF);
    float* w3c = lds;
    float* red = lds + 512;
    const float min_decay = logf(1e-2f) / 1.5f, max_decay = logf(1e-2f) / 0.3f;
    for (int grp = blockIdx.x; grp < 256; grp += G) {
        const int item0 = grp * 4, o = item0 >> 9, c0 = item0 & 511;
        __syncthreads();
        { const int q = tid >> 7, dir = (tid >> 6) & 1, i = tid & 63; w3c[tid] = p.pos_w3[i * 2048 + o * 1024 + dir * 512 + c0 + q]; }
        __syncthreads();
        float hv[4][4][2]; float asum[4] = {0.f, 0.f, 0.f, 0.f};
#pragma unroll
        for (int j = 0; j < 4; ++j) {
            const int t = tid + NT * j;
            float r[4][2];
#pragma unroll
            for (int q = 0; q < 4; ++q) { r[q][0] = 0.f; r[q][1] = 0.f; }
            const float4* hp = (const float4*)(HID2 + t * 64);
#pragma unroll 4
            for (int i4 = 0; i4 < 16; ++i4) {
                const float4 h = hp[i4];
#pragma unroll
                for (int q = 0; q < 4; ++q)
#pragma unroll
                    for (int d = 0; d < 2; ++d) { const float* w = w3c + (q * 2 + d) * 64 + i4 * 4; r[q][d] += h.x * w[0] + h.y * w[1] + h.z * w[2] + h.w * w[3]; }
            }
            const float tl = (float)t / 2047.0f;
#pragma unroll
            for (int q = 0; q < 4; ++q) {
                const float delta = fabsf(min_decay + (float)(c0 + q) * ((max_decay - min_decay) / 511.0f));
                const float win = expf(-tl * delta) + 0.05f;
                hv[j][q][0] = r[q][0] * win; hv[j][q][1] = r[q][1] * win;
                asum[q] += fabsf(hv[j][q][0]) + (t >= 1 ? fabsf(hv[j][q][1]) : 0.f);
            }
        }
#pragma unroll
        for (int q = 0; q < 4; ++q) asum[q] = wave_sum(asum[q]);
        if ((tid & 63) == 0) { red[(tid >> 6) * 4 + 0] = asum[0]; red[(tid >> 6) * 4 + 1] = asum[1]; red[(tid >> 6) * 4 + 2] = asum[2]; red[(tid >> 6) * 4 + 3] = asum[3]; }
        __syncthreads();
#pragma unroll
        for (int q = 0; q < 4; ++q) {
            float tot = 0.f;
#pragma unroll
            for (int k = 0; k < 8; ++k) tot += red[k * 4 + q];
            const float inv = 1.f / (tot + EPS);
            float* dst = HF + (size_t)(item0 + q) * 4096;
#pragma unroll
            for (int j = 0; j < 4; ++j) {
                const int t = tid + NT * j;
                dst[2047 + t] = hv[j][q][0] * inv;
                if (t >= 1) dst[2047 - t] = hv[j][q][1] * inv;
            }
            if (tid == 0) dst[4095] = 0.f;
        }
    }
}

struct InprojSched {
    int G, c; const bf16_t *WinT, *H, *HC; bf16_t *PHYT, *PHG, *PC;
    __device__ __forceinline__ bool next(int i, Unit& u) const {
        int L = i * G + c; int pm, pn;
        u.aux = nullptr; u.gidx = nullptr; u.row0 = 0; u.col0 = 0;
        if (L < 768) { tile_of(L, 6, 128, pm, pn); u.a = (const char*)(WinT + (size_t)pm * 256 * D); u.b = (const char*)(H + (size_t)pn * 256 * D); u.c = PHYT + (size_t)pm * 256 * NTOK + pn * 256; u.ldc = NTOK; return true; }
        L -= 768;
        if (L < 1280) { tile_of(L, 128, 10, pm, pn); u.a = (const char*)(H + (size_t)pm * 256 * D); u.b = (const char*)(WinT + (size_t)(1536 + pn * 256) * D); u.c = PHG + (size_t)pm * 256 * 2560 + pn * 256; u.ldc = 2560; return true; }
        L -= 1280;
        if (L < 96) { tile_of(L, 16, 6, pm, pn); u.a = (const char*)(HC + (size_t)pm * 256 * D); u.b = (const char*)(WinT + (size_t)(2048 + pn * 256) * D); u.c = PC + (size_t)pm * 256 * 1536 + pn * 256; u.ldc = 1536; return true; }
        return false;
    }
    __device__ __forceinline__ void a_ready(const Unit&) const {}
    __device__ __forceinline__ void done(const Unit&) const {}
};
__device__ __forceinline__ void ph_inproj(const P& p, unsigned char* lds) {
    InprojSched S{(int)gridDim.x, (int)blockIdx.x, (const bf16_t*)((unsigned char*)p.out + DO_WINT), (const bf16_t*)(p.ws + WS_H), (const bf16_t*)(p.ws + WS_HC),
                  (bf16_t*)((unsigned char*)p.out + DO_PHYT), (bf16_t*)(p.ws + WS_PHG), (bf16_t*)(p.ws + WS_PC)};
    pg8::EpiStoreBf16 E;
    pg8::gemm_phase<pg8::EpiStoreBf16, InprojSched, true, true, false>((PG8_LAS unsigned char*)lds, D, S, E);
}

namespace hy {
#define HY_LAS __attribute__((address_space(3)))
typedef short bf16x8 __attribute__((ext_vector_type(8)));
typedef float f32x4 __attribute__((ext_vector_type(4)));
typedef unsigned u32x4 __attribute__((ext_vector_type(4)));
typedef unsigned u32x2 __attribute__((ext_vector_type(2)));
constexpr int U_STRIDE = 4112, UIMG = 0, U_BYTES = 16 * U_STRIDE;
constexpr int FILT = U_BYTES, F_STRIDE = 8288, F_BYTES = 8 * F_STRIDE;
constexpr int SCR = FILT + F_BYTES;
static_assert(SCR + 8192 <= LDS_BYTES, "hyena LDS map");

__device__ __forceinline__ float uni(float v) { return __uint_as_float(__builtin_amdgcn_readfirstlane(__float_as_uint(v))); }
struct ConvW { float w0, w1, w2, b; };
__device__ __forceinline__ ConvW load_convw(const P& p, int ch) { ConvW c; c.w0 = uni(p.hy_conv_w[ch]); c.w1 = uni(p.hy_conv_w[1536 + ch]); c.w2 = uni(p.hy_conv_w[3072 + ch]); c.b = uni(p.hy_conv_b[ch]); return c; }
__device__ __forceinline__ void load_u_image(const ConvW cw, HY_LAS unsigned char* L, const bf16_t* row, int tid) {
    const float cw0 = cw.w0, cw1 = cw.w1, cw2 = cw.w2, cb = cw.b;
#pragma unroll 2
    for (int k = 0; k < 8; ++k) {
        const int idx = tid + NT * k, b = idx >> 8, t8 = (idx & 255) * 8;
        const bf16_t* src = row + b * SEQ + t8;
        const u32x4 raw = *(const u32x4*)src;
        float x[10];
        x[0] = (t8 & 63) ? bf2f(src[-1]) : 0.f;
        x[9] = ((t8 + 8) & 63) ? bf2f(src[8]) : 0.f;
        x[1] = __uint_as_float(raw.x << 16); x[2] = __uint_as_float(raw.x & 0xffff0000u); x[3] = __uint_as_float(raw.y << 16); x[4] = __uint_as_float(raw.y & 0xffff0000u);
        x[5] = __uint_as_float(raw.z << 16); x[6] = __uint_as_float(raw.z & 0xffff0000u); x[7] = __uint_as_float(raw.w << 16); x[8] = __uint_as_float(raw.w & 0xffff0000u);
        float o[8];
#pragma unroll
        for (int e = 0; e < 8; ++e) o[e] = cb + cw1 * x[e + 1] + cw0 * x[e] + cw2 * x[e + 2];
        *(HY_LAS u32x4*)(L + UIMG + b * U_STRIDE + t8 * 2) = (u32x4){pk2(o[0], o[1]), pk2(o[2], o[3]), pk2(o[4], o[5]), pk2(o[6], o[7])};
    }
}
__device__ __forceinline__ void raw_rows_load(u32x4 (&r)[8], const bf16_t* row, int tid) {
#pragma unroll
    for (int k = 0; k < 8; ++k) { const int idx = tid + NT * k, b = idx >> 8, t8 = (idx & 255) * 8; r[k] = *(const u32x4*)(row + b * SEQ + t8); }
}
__device__ __forceinline__ void raw_rows_store(HY_LAS unsigned char* L, const u32x4 (&r)[8], int tid) {
#pragma unroll
    for (int k = 0; k < 8; ++k) {
        const int idx = tid + NT * k, b = idx >> 8, t8 = (idx & 255) * 8;
        HY_LAS unsigned char* d = L + FILT + b * U_STRIDE + 8 + t8 * 2;
        *(HY_LAS u32x2*)d = (u32x2){r[k].x, r[k].y}; *(HY_LAS u32x2*)(d + 8) = (u32x2){r[k].z, r[k].w};
    }
}
__device__ __forceinline__ void load_filter_scr(HY_LAS unsigned char* L, const float* hf, int tid) {
    const float4 a = ((const float4*)hf)[tid * 2], b = ((const float4*)hf)[tid * 2 + 1];
    *(HY_LAS u32x4*)(L + SCR + tid * 16) = (u32x4){pk2(a.x, a.y), pk2(a.z, a.w), pk2(b.x, b.y), pk2(b.z, b.w)};
}
__device__ __forceinline__ void build_filter_copies(HY_LAS unsigned char* L, int tid) {
    const HY_LAS bf16_t* sc = (const HY_LAS bf16_t*)(L + SCR);
    for (int gi = tid; gi < 8 * 518; gi += NT) {
        const int d = gi / 518, qg = gi - d * 518;
        const int top = 4095 + d - 8 * qg;
        unsigned v[8];
#pragma unroll
        for (int e = 0; e < 8; ++e) { const int ix = top - e; v[e] = (ix >= 0 && ix <= 4094) ? (unsigned)sc[ix] : 0u; }
        *(HY_LAS u32x4*)(L + FILT + d * F_STRIDE + qg * 16) = (u32x4){v[0] | (v[1] << 16), v[2] | (v[3] << 16), v[4] | (v[5] << 16), v[6] | (v[7] << 16)};
    }
}
__device__ __forceinline__ void conv_loop(HY_LAS unsigned char* L, f32x4 (&acc)[16], int w, int lane) {
    const int i = lane & 15, g = lane >> 4;
    const HY_LAS unsigned char* aBase = L + FILT + (i & 7) * F_STRIDE + 2 * (2048 + 8 * g - (i & ~7)) - 32 * (16 * w);
    const HY_LAS unsigned char* bBase = L + UIMG + i * U_STRIDE + 16 * g;
    bf16x8 ring[16];
#pragma unroll
    for (int s = 0; s < 16; ++s) ring[s] = *(const HY_LAS bf16x8*)(aBase - 32 * s);
#pragma unroll
    for (int m = 0; m < 16; ++m) acc[m] = (f32x4){0.f, 0.f, 0.f, 0.f};
    bf16x8 bfrag = *(const HY_LAS bf16x8*)(bBase);
    for (int k8 = 0; k8 < 8; ++k8) {
        const HY_LAS unsigned char* aK = aBase + 512 * k8;
        const HY_LAS unsigned char* bK = bBase + 512 * k8;
#pragma unroll
        for (int u = 0; u < 8; ++u) {
            bf16x8 bnext = bfrag;
            if (u < 7 || k8 < 7) bnext = *(const HY_LAS bf16x8*)(bK + 64 * (u + 1));
            acc[14] = __builtin_amdgcn_mfma_f32_16x16x32_bf16(ring[(14 - 2 * u) & 15], bfrag, acc[14], 0, 0, 0);
            acc[15] = __builtin_amdgcn_mfma_f32_16x16x32_bf16(ring[(15 - 2 * u) & 15], bfrag, acc[15], 0, 0, 0);
            if (u < 7 || k8 < 7) {
                ring[(14 - 2 * u) & 15] = *(const HY_LAS bf16x8*)(aK + 64 * u + 64);
                ring[(15 - 2 * u) & 15] = *(const HY_LAS bf16x8*)(aK + 64 * u + 32);
            }
#pragma unroll
            for (int m = 0; m < 14; ++m) acc[m] = __builtin_amdgcn_mfma_f32_16x16x32_bf16(ring[(m - 2 * u) & 15], bfrag, acc[m], 0, 0, 0);
            bfrag = bnext;
            __builtin_amdgcn_sched_barrier(0);
        }
    }
}
__device__ __forceinline__ void gate_acc(const ConvW cw, HY_LAS unsigned char* L, f32x4 (&acc)[16], float bias, int w, int lane) {
    const int j = lane & 15, g = lane >> 4;
    const float cw0 = cw.w0, cw1 = cw.w1, cw2 = cw.w2, cb = cw.b;
#pragma unroll
    for (int m = 0; m < 16; ++m) {
        const int t4 = 256 * w + 16 * m + 4 * g, tt0 = t4 & 63;
        const u32x2 uu = *(const HY_LAS u32x2*)(L + UIMG + j * U_STRIDE + t4 * 2);
        const HY_LAS unsigned char* xb = L + FILT + j * U_STRIDE + 8 + t4 * 2;
        const u32x2 xx = *(const HY_LAS u32x2*)xb;
        const float xl = tt0 > 0 ? bf2f(*(const HY_LAS bf16_t*)(xb - 2)) : 0.f;
        const float xr = tt0 < 60 ? bf2f(*(const HY_LAS bf16_t*)(xb + 8)) : 0.f;
        const float x0 = __uint_as_float(xx.x << 16), x1 = __uint_as_float(xx.x & 0xffff0000u), x2 = __uint_as_float(xx.y << 16), x3 = __uint_as_float(xx.y & 0xffff0000u);
        const float u0 = __uint_as_float(uu.x << 16), u1 = __uint_as_float(uu.x & 0xffff0000u), u2 = __uint_as_float(uu.y << 16), u3 = __uint_as_float(uu.y & 0xffff0000u);
        const float g0 = cb + cw1 * x0 + cw0 * xl + cw2 * x1, g1 = cb + cw1 * x1 + cw0 * x0 + cw2 * x2, g2 = cb + cw1 * x2 + cw0 * x1 + cw2 * x3, g3 = cb + cw1 * x3 + cw0 * x2 + cw2 * xr;
        acc[m][0] = g0 * (acc[m][0] + bias * u0); acc[m][1] = g1 * (acc[m][1] + bias * u1); acc[m][2] = g2 * (acc[m][2] + bias * u2); acc[m][3] = g3 * (acc[m][3] + bias * u3);
        if ((m & 3) == 3) __builtin_amdgcn_sched_barrier(0);
    }
}
__device__ __forceinline__ void store_acc_uimg(HY_LAS unsigned char* L, const f32x4 (&acc)[16], int w, int lane) {
    const int j = lane & 15, g = lane >> 4;
#pragma unroll
    for (int m = 0; m < 16; ++m) {
        const int t4 = 256 * w + 16 * m + 4 * g;
        *(HY_LAS u32x2*)(L + UIMG + j * U_STRIDE + t4 * 2) = (u32x2){pk2(acc[m][0], acc[m][1]), pk2(acc[m][2], acc[m][3])};
    }
}
}

__device__ __forceinline__ void ph_hyena_task(const P& p, unsigned char* ldsb, int c) {
    const int w = __builtin_amdgcn_readfirstlane(threadIdx.x >> 6);
    const bf16_t* PHYT = (const bf16_t*)((unsigned char*)p.out + DO_PHYT);
    bf16_t* YT = (bf16_t*)(p.ws + WS_YT);
    const float* HF = (const float*)((unsigned char*)p.out + DO_HF);
    HY_LAS unsigned char* L = (HY_LAS unsigned char*)ldsb;
    {
        const int tid = opaque_tid();
        const int lane = tid & 63;
        hy::f32x4 acc[16];
        const hy::ConvW cwv = hy::load_convw(p, c), cwx1 = hy::load_convw(p, 512 + c), cwx2 = hy::load_convw(p, 1024 + c);
        const float bias0 = hy::uni(p.hy_bias[c]), bias1 = hy::uni(p.hy_bias[512 + c]);
        __syncthreads();
        hy::load_u_image(cwv, L, PHYT + (size_t)c * NTOK, tid);
        hy::load_filter_scr(L, HF + (size_t)c * 4096, tid);
        __syncthreads();
        hy::build_filter_copies(L, tid);
        __syncthreads();
        hy::u32x4 rawx[8];
        hy::raw_rows_load(rawx, PHYT + (size_t)(512 + c) * NTOK, tid);
        hy::load_filter_scr(L, HF + (size_t)(512 + c) * 4096, tid);
        hy::conv_loop(L, acc, w, lane);
        __syncthreads();
        hy::raw_rows_store(L, rawx, tid);
        __syncthreads();
        hy::gate_acc(cwx1, L, acc, bias0, w, lane);
        __syncthreads();
        hy::store_acc_uimg(L, acc, w, lane);
        hy::build_filter_copies(L, tid);
        __syncthreads();
        hy::raw_rows_load(rawx, PHYT + (size_t)(1024 + c) * NTOK, tid);
        hy::conv_loop(L, acc, w, lane);
        __syncthreads();
        hy::raw_rows_store(L, rawx, tid);
        __syncthreads();
        hy::gate_acc(cwx2, L, acc, bias1, w, lane);
        hy::store_acc_uimg(L, acc, w, lane);
        __syncthreads();
#pragma unroll 2
        for (int k = 0; k < 8; ++k) {
            const int idx = tid + NT * k, b = idx >> 8, t8 = (idx & 255) * 8;
            *(hy::u32x4*)(YT + (size_t)c * NTOK + b * SEQ + t8) = *(const HY_LAS hy::u32x4*)(L + hy::UIMG + b * hy::U_STRIDE + t8 * 2);
        }
    }
}


namespace hg {
#define HG_LAS __attribute__((address_space(3)))
typedef short bf16x8 __attribute__((ext_vector_type(8)));
typedef float f32x4 __attribute__((ext_vector_type(4)));
typedef unsigned u32x4 __attribute__((ext_vector_type(4)));
typedef unsigned u32x2 __attribute__((ext_vector_type(2)));
constexpr int QROW = 272, KROW = 40;
constexpr int O_QT = 0, O_KBAR = 16 * QROW, O_KHAT = 2 * 16 * QROW, O_VT = O_KHAT + 128 * KROW, O_BDEC = O_VT + 128 * KROW, SET_BYTES = O_BDEC + 512;
constexpr int NCH_CTX = CTXL / 16, NCH = NCH_CTX + SEQ / 16;
template <int CTRL> __device__ __forceinline__ float dpp_mul(float x) {
    return x * __uint_as_float(__builtin_amdgcn_update_dpp(0x3f800000u, __float_as_uint(x), CTRL, 0xf, 0xf, false));
}
struct Raw { unsigned short q[4], v[4], z[4]; };
}

__device__ __forceinline__ void ph_hgrn_task(const P& p, unsigned char* ldsb, int item) {
    using namespace hg;
    const int tid = opaque_tid();
    const int lane = tid & 63, w = __builtin_amdgcn_readfirstlane(tid >> 6), j = lane & 15, g = lane >> 4;
    const int dir = item & 1, h = (item >> 1) & 3, b = item >> 3;
    const float* LB = (const float*)(p.ws + WS_LB);
    const bf16_t* PC = (const bf16_t*)(p.ws + WS_PC);
    const bf16_t* PHG = (const bf16_t*)(p.ws + WS_PHG);
    bf16_t* OFB = (bf16_t*)(p.ws + WS_OFB) + (size_t)dir * NTOK * 512;
    HG_LAS unsigned char* L = (HG_LAS unsigned char*)ldsb;
    float lb0[2], lb1[2];
#pragma unroll
    for (int pp = 0; pp < 2; ++pp) { const float2 t = *(const float2*)(LB + dir * 512 + h * 128 + 16 * w + 8 * pp + 2 * g); lb0[pp] = t.x; lb1[pp] = t.y; }
    const int zoff_c = dir == 0 ? 512 : 1024, zoff_l = dir == 0 ? 1024 : 1536;
    const bf16_t* rowc = PC + (size_t)b * CTXL * 1536 + h * 128 + 16 * w + 2 * g;
    const bf16_t* rowl = PHG + (size_t)b * SEQ * 2560 + h * 128 + 16 * w + 2 * g;
    struct Raw2 { unsigned q[2], v[2], z[2]; };
    auto load_raw = [&](int n, Raw2& r) {
        if (n < NCH_CTX) {
            const int tt = 16 * n + j, t = dir == 0 ? tt : (CTXL - 1 - tt);
            const bf16_t* row = rowc + (size_t)t * 1536;
#pragma unroll
            for (int pp = 0; pp < 2; ++pp) { r.q[pp] = 0u; r.v[pp] = *(const unsigned*)(row + 8 * pp); r.z[pp] = *(const unsigned*)(row + zoff_c + 8 * pp); }
        } else {
            const int tt = 16 * (n - NCH_CTX) + j, t = dir == 0 ? tt : (SEQ - 1 - tt);
            const bf16_t* row = rowl + (size_t)t * 2560;
#pragma unroll
            for (int pp = 0; pp < 2; ++pp) { r.q[pp] = *(const unsigned*)(row + 8 * pp); r.v[pp] = *(const unsigned*)(row + 512 + 8 * pp); r.z[pp] = *(const unsigned*)(row + zoff_l + 8 * pp); }
        }
    };
    const int qoff = j * QROW + 2 * (16 * w + 2 * g), koff = (16 * w + 2 * g) * KROW + 2 * j;
    auto prep_pass = [&](const Raw2& r, HG_LAS unsigned char* S0, const int pp) {
        {
            const float za = __uint_as_float(r.z[pp] << 16), zb = __uint_as_float(r.z[pp] & 0xffff0000u);
            const float qa = __uint_as_float(r.q[pp] << 16), qb = __uint_as_float(r.q[pp] & 0xffff0000u);
            const float fa = lb0[pp] + (1.0f - lb0[pp]) * __builtin_amdgcn_rcpf(1.0f + __builtin_amdgcn_exp2f(-1.4426950408889634f * za));
            const float fb = lb1[pp] + (1.0f - lb1[pp]) * __builtin_amdgcn_rcpf(1.0f + __builtin_amdgcn_exp2f(-1.4426950408889634f * zb));
            float Pa = dpp_mul<0x111>(fa), Pb = dpp_mul<0x111>(fb);
            Pa = dpp_mul<0x112>(Pa); Pb = dpp_mul<0x112>(Pb); Pa = dpp_mul<0x114>(Pa); Pb = dpp_mul<0x114>(Pb); Pa = dpp_mul<0x118>(Pa); Pb = dpp_mul<0x118>(Pb);
            const float Ca = __uint_as_float(__builtin_amdgcn_ds_bpermute(4 * (lane | 15), __float_as_uint(Pa)));
            const float Cb = __uint_as_float(__builtin_amdgcn_ds_bpermute(4 * (lane | 15), __float_as_uint(Pb)));
            const float ia = __builtin_amdgcn_rcpf(fmaxf(Pa, 1e-30f)), ib = __builtin_amdgcn_rcpf(fmaxf(Pb, 1e-30f));
            const float ka = (1.0f - fa) * ia, kb = (1.0f - fb) * ib;
            const float qva = qa * __builtin_amdgcn_rcpf(1.0f + __builtin_amdgcn_exp2f(-1.4426950408889634f * qa)) * (0.08838834764831845f * Pa);
            const float qvb = qb * __builtin_amdgcn_rcpf(1.0f + __builtin_amdgcn_exp2f(-1.4426950408889634f * qb)) * (0.08838834764831845f * Pb);
            *(HG_LAS unsigned*)(S0 + O_QT + qoff + 16 * pp) = cvtpk(qva, qvb);
            *(HG_LAS unsigned*)(S0 + O_KBAR + qoff + 16 * pp) = cvtpk(ka, kb);
            const unsigned kh = cvtpk(ka * Ca, kb * Cb);
            *(HG_LAS bf16_t*)(S0 + O_KHAT + koff + 8 * pp * KROW) = (bf16_t)(kh & 0xffffu);
            *(HG_LAS bf16_t*)(S0 + O_KHAT + koff + (8 * pp + 1) * KROW) = (bf16_t)(kh >> 16);
            *(HG_LAS bf16_t*)(S0 + O_VT + koff + 8 * pp * KROW) = (bf16_t)(r.v[pp] & 0xffffu);
            *(HG_LAS bf16_t*)(S0 + O_VT + koff + (8 * pp + 1) * KROW) = (bf16_t)(r.v[pp] >> 16);
            if (j == 15) { typedef float f32x2_t __attribute__((ext_vector_type(2))); *(HG_LAS f32x2_t*)(S0 + O_BDEC + 4 * (16 * w + 8 * pp + 2 * g)) = (f32x2_t){Pa, Pb}; }
        }
    };
    auto prep = [&](const Raw2& r, HG_LAS unsigned char* S0) { prep_pass(r, S0, 0); prep_pass(r, S0, 1); };
    const float mk0 = (4 * g + 0) <= j ? 1.f : 0.f, mk1 = (4 * g + 1) <= j ? 1.f : 0.f, mk2 = (4 * g + 2) <= j ? 1.f : 0.f, mk3 = (4 * g + 3) <= j ? 1.f : 0.f;
    const int sc_off = j * QROW + 16 * g, vt_off = (16 * w + j) * KROW + 8 * g, qt8_off = j * QROW + 8 * g, kh_off = j * KROW + 8 * g;
    bf16_t* orow = OFB + (size_t)b * SEQ * 512 + h * 128 + 16 * w + 4 * g;
    f32x4 S[8];
#pragma unroll
    for (int t = 0; t < 8; ++t) S[t] = (f32x4){0.f, 0.f, 0.f, 0.f};
    constexpr int RDEPTH = 4;
    static_assert(NCH % RDEPTH == 0, "chunk loop is unrolled by the prefetch depth");
    Raw2 ring[RDEPTH];
    load_raw(0, ring[0]);
    __syncthreads();
    prep(ring[0], L);
#pragma unroll
    for (int c = 1; c <= RDEPTH; ++c) load_raw(c, ring[c % RDEPTH]);
    __syncthreads();
    auto chunk = [&](int n, int phase, Raw2& slot) {
        HG_LAS unsigned char* Sc = L + (n & 1) * SET_BYTES;
        HG_LAS unsigned char* Sn = L + ((n + 1) & 1) * SET_BYTES;
        bf16x8 kaf[4], qaf[4]; u32x2 qb0[4], qb1[4], krf[8]; f32x4 bdf[8];
#pragma unroll
        for (int kp = 0; kp < 4; ++kp) { kaf[kp] = *(const HG_LAS bf16x8*)(Sc + O_KBAR + sc_off + 64 * kp); qaf[kp] = *(const HG_LAS bf16x8*)(Sc + O_QT + sc_off + 64 * kp); }
        const u32x2 vraw = *(const HG_LAS u32x2*)(Sc + O_VT + vt_off);
#pragma unroll
        for (int pq = 0; pq < 4; ++pq) { qb0[pq] = *(const HG_LAS u32x2*)(Sc + O_QT + qt8_off + 64 * pq); qb1[pq] = *(const HG_LAS u32x2*)(Sc + O_QT + qt8_off + 64 * pq + 32); }
#pragma unroll
        for (int t = 0; t < 8; ++t) { bdf[t] = *(const HG_LAS f32x4*)(Sc + O_BDEC + 64 * t + 16 * g); krf[t] = *(const HG_LAS u32x2*)(Sc + O_KHAT + kh_off + 16 * KROW * t); }
        __builtin_amdgcn_sched_barrier(0);
        const u32x4 vf = (u32x4){vraw.x, vraw.y, 0u, 0u};
        f32x4 sc = (f32x4){0.f, 0.f, 0.f, 0.f};
#pragma unroll
        for (int kp = 0; kp < 4; ++kp) sc = __builtin_amdgcn_mfma_f32_16x16x32_bf16(kaf[kp], qaf[kp], sc, 0, 0, 0);
        f32x4 oT = (f32x4){0.f, 0.f, 0.f, 0.f};
#pragma unroll
        for (int pq = 0; pq < 4; ++pq) {
            u32x4 a; a.x = cvtpk(S[2 * pq][0], S[2 * pq][1]); a.y = cvtpk(S[2 * pq][2], S[2 * pq][3]); a.z = cvtpk(S[2 * pq + 1][0], S[2 * pq + 1][1]); a.w = cvtpk(S[2 * pq + 1][2], S[2 * pq + 1][3]);
            const u32x4 bb = (u32x4){qb0[pq].x, qb0[pq].y, qb1[pq].x, qb1[pq].y};
            oT = __builtin_amdgcn_mfma_f32_16x16x32_bf16(__builtin_bit_cast(bf16x8, a), __builtin_bit_cast(bf16x8, bb), oT, 0, 0, 0);
        }
#pragma unroll
        for (int t = 0; t < 8; ++t) {
            const u32x4 ka = (u32x4){krf[t].x, krf[t].y, 0u, 0u};
            S[t] = __builtin_amdgcn_mfma_f32_16x16x32_bf16(__builtin_bit_cast(bf16x8, ka), __builtin_bit_cast(bf16x8, vf), S[t] * bdf[t], 0, 0, 0);
        }
        u32x4 pf;
        pf.x = cvtpk(sc[0] * mk0, sc[1] * mk1); pf.y = cvtpk(sc[2] * mk2, sc[3] * mk3); pf.z = 0u; pf.w = 0u;
        oT = __builtin_amdgcn_mfma_f32_16x16x32_bf16(__builtin_bit_cast(bf16x8, vf), __builtin_bit_cast(bf16x8, pf), oT, 0, 0, 0);
        if (n + 1 < NCH) prep(slot, Sn);
        if (n + 1 + RDEPTH < NCH) load_raw(n + 1 + RDEPTH, slot);
        if (n >= NCH_CTX) {
            const int tt = 16 * (n - NCH_CTX) + j, t = dir == 0 ? tt : (SEQ - 1 - tt);
            *(u32x2*)(orow + (size_t)t * 512) = (u32x2){cvtpk(oT[0], oT[1]), cvtpk(oT[2], oT[3])};
        }
        lds_barrier();
    };
    for (int n0 = 0; n0 < NCH; n0 += RDEPTH) {
#pragma unroll
        for (int u = 0; u < RDEPTH; ++u) chunk(n0 + u, u % 3, ring[(u + 1) % RDEPTH]);
    }
}

template <int QW = 0, bool DO_HGRN = true, bool DO_QUEUE = true, bool DO_HY = true, bool DO_CV = true>
__device__ __forceinline__ void ph_mixers(const P& p, unsigned char* ldsb) {
    unsigned* qhead = (unsigned*)(p.ws + WS_CTL) + CW_QHEAD + QW;
    HG_LAS unsigned* bc = (HG_LAS unsigned*)(ldsb + LDS_BYTES - 16);
    if (DO_HGRN && blockIdx.x < NB * HEADS * 2) ph_hgrn_task(p, ldsb, blockIdx.x);
    constexpr int N_CONV_WG = 48, ITEMS_PER_WG = N_EXPERT_ITEMS / N_CONV_WG;
    static_assert(N_EXPERT_ITEMS % N_CONV_WG == 0 && ITEMS_PER_WG % CONV_DEPTH == 0, "conversion split");
    if (DO_CV && blockIdx.x >= NB * HEADS * 2 && blockIdx.x < NB * HEADS * 2 + N_CONV_WG)
        conv_run([&](int r) { return conv_expert_item(p, r); }, (blockIdx.x - NB * HEADS * 2) * ITEMS_PER_WG, ITEMS_PER_WG, (float*)ldsb);
    if (!DO_QUEUE) return;
    for (;;) {
        __syncthreads();
        if (threadIdx.x == 0) *bc = atomicAdd(qhead, 1u);
        __syncthreads();
        const int c = (int)*bc;
        if (c >= 512) break;
        if (DO_HY) ph_hyena_task(p, ldsb, c);
    }
}

__device__ __forceinline__ void ph_mixprep(const P& p, float* lds) {
    const int tid = opaque_tid(), lane = tid & 63, wv = tid >> 6;
    const bf16_t* YT = (const bf16_t*)(p.ws + WS_YT);
    bf16_t* MIXA = (bf16_t*)(p.ws + WS_MIXA);
    bf16_t* yl = (bf16_t*)lds;
    float* part = lds + (512 * 72 * 2) / 4;
    typedef unsigned u32x4_t __attribute__((ext_vector_type(4)));
    u32x4_t tl[8];
    auto tload = [&](int tile) {
#pragma unroll
        for (int q = 0; q < 8; ++q) { const int i = tid + NT * q, row = i >> 3, ch = i & 7; tl[q] = *(const u32x4_t*)(YT + (size_t)row * NTOK + tile * 64 + ch * 8); }
    };
    if (blockIdx.x < NTOK / 64) tload(blockIdx.x);
    for (int tile = blockIdx.x; tile < NTOK / 64; tile += gridDim.x) {
        const int tok0 = tile * 64;
        __syncthreads();
#pragma unroll
        for (int q = 0; q < 8; ++q) { const int i = tid + NT * q, row = i >> 3, ch = i & 7; *(u32x4_t*)(yl + row * 72 + ch * 8) = tl[q]; }
        __syncthreads();
        if (tile + (int)gridDim.x < NTOK / 64) tload(tile + gridDim.x);
        const int tok = tid & 63, pt = tid >> 6;
        float ss = 0.f;
        for (int c = pt * 64; c < pt * 64 + 64; ++c) { const float v = bf2f(yl[c * 72 + tok]); ss += v * v; }
        part[pt * 64 + tok] = ss;
        __syncthreads();
        float tot = 0.f;
#pragma unroll
        for (int k = 0; k < 8; ++k) tot += part[k * 64 + tok];
        const float rstd = rsqrtf(tot * (1.f / 512.f) + EPS);
        bf16_t* dst = MIXA + (size_t)(tok0 + tok) * D + pt * 64;
#pragma unroll
        for (int j = 0; j < 8; ++j) {
            const f32x4_t ga = *(const f32x4_t*)(p.hy_norm_g + pt * 64 + j * 8), gb = *(const f32x4_t*)(p.hy_norm_g + pt * 64 + j * 8 + 4);
            const float gv[8] = {ga.x, ga.y, ga.z, ga.w, gb.x, gb.y, gb.z, gb.w};
            float o[8];
#pragma unroll
            for (int q = 0; q < 8; ++q) { const int c = pt * 64 + j * 8 + q; o[q] = bf2f(yl[c * 72 + tok]) * rstd * gv[q]; }
            *(uint4*)(dst + j * 8) = make_uint4(cvtpk(o[0], o[1]), cvtpk(o[2], o[3]), cvtpk(o[4], o[5]), cvtpk(o[6], o[7]));
        }
    }
    const bf16_t* OFB = (const bf16_t*)(p.ws + WS_OFB);
    const bf16_t* PHG = (const bf16_t*)(p.ws + WS_PHG);
    {
        const int hh = lane >> 4, k8 = (lane & 15) * 8, col = hh * 128 + k8;
        const f32x4_t ng0 = *(const f32x4_t*)(p.hg_norm_g + k8), ng1 = *(const f32x4_t*)(p.hg_norm_g + k8 + 4);
        struct Row3 { uint4 a, b, g; };
        auto ld = [&](int r) { Row3 x; x.a = *(const uint4*)(OFB + (size_t)r * 512 + col); x.b = *(const uint4*)(OFB + (size_t)NTOK * 512 + (size_t)r * 512 + col); x.g = *(const uint4*)(PHG + (size_t)r * 2560 + 2048 + col); return x; };
        for (int rc = blockIdx.x * 8 + wv; rc < NTOK / 16; rc += gridDim.x * 8) {
            Row3 cur = ld(rc * 16), nxt = cur;
            for (int ri = 0; ri < 16; ++ri) {
                const int r = rc * 16 + ri;
                if (ri + 1 < 16) nxt = ld(r + 1);
                const unsigned aw[4] = {cur.a.x, cur.a.y, cur.a.z, cur.a.w}, bw[4] = {cur.b.x, cur.b.y, cur.b.z, cur.b.w}, gw[4] = {cur.g.x, cur.g.y, cur.g.z, cur.g.w};
                float o[8]; float ss = 0.f;
#pragma unroll
                for (int q = 0; q < 4; ++q) { o[2 * q] = __uint_as_float(aw[q] << 16) + __uint_as_float(bw[q] << 16); o[2 * q + 1] = __uint_as_float(aw[q] & 0xffff0000u) + __uint_as_float(bw[q] & 0xffff0000u); ss += o[2 * q] * o[2 * q] + o[2 * q + 1] * o[2 * q + 1]; }
                ss += __shfl_xor(ss, 1); ss += __shfl_xor(ss, 2); ss += __shfl_xor(ss, 4); ss += __shfl_xor(ss, 8);
                const float rstd = rsqrtf(ss * (1.f / 128.f) + EPS);
                const float ngv[8] = {ng0.x, ng0.y, ng0.z, ng0.w, ng1.x, ng1.y, ng1.z, ng1.w};
                unsigned w[4];
#pragma unroll
                for (int q = 0; q < 4; ++q) { const float g0 = __uint_as_float(gw[q] << 16), g1 = __uint_as_float(gw[q] & 0xffff0000u);
                    w[q] = cvtpk(o[2 * q] * rstd * ngv[2 * q] * silu_f(g0), o[2 * q + 1] * rstd * ngv[2 * q + 1] * silu_f(g1)); }
                *(uint4*)(MIXA + (size_t)r * D + 512 + col) = make_uint4(w[0], w[1], w[2], w[3]);
                cur = nxt;
            }
        }
    }
}

struct OutprojSched {
    int G, c; const bf16_t *A, *Bt;
    __device__ __forceinline__ bool next(int i, Unit& u) const {
        const int L = i * G + c; if (L >= 512) return false; int pm, pn; tile_of(L, 128, 4, pm, pn);
        u.a = (const char*)(A + (size_t)pm * 256 * D); u.b = (const char*)(Bt + (size_t)pn * 256 * D); u.c = nullptr; u.aux = nullptr; u.gidx = nullptr; u.ldc = D; u.row0 = pm * 256; u.col0 = pn * 256; return true;
    }
    __device__ __forceinline__ void a_ready(const Unit&) const {}
    __device__ __forceinline__ void done(const Unit&) const {}
};
__device__ __forceinline__ void ph_outproj(const P& p, unsigned char* lds) {
    OutprojSched S{(int)gridDim.x, (int)blockIdx.x, (const bf16_t*)(p.ws + WS_MIXA), (const bf16_t*)(p.ws + WS_WOUTT)};
    pg8::EpiOutProj E{p.x, (const float*)(p.ws + WS_ADA), (bf16_t*)p.out};
    pg8::gemm_phase<pg8::EpiOutProj, OutprojSched, true, true, false>((PG8_LAS unsigned char*)lds, D, S, E);
}

__device__ __forceinline__ void ph_norm2_router(const P& p, float* ldsf) {
    typedef short bf16x8_t __attribute__((ext_vector_type(8)));
    const int tid = opaque_tid(), lane = tid & 63, wv = tid >> 6, j = lane & 15, g = lane >> 4;
    const float* ADA = (const float*)(p.ws + WS_ADA);
    const bf16_t* X1 = (const bf16_t*)p.out;
    bf16_t* H2 = (bf16_t*)(p.ws + WS_H2);
    float* AFF = (float*)(p.ws + WS_AFF);
    HG_LAS unsigned char* L = (HG_LAS unsigned char*)(unsigned char*)ldsf;
    constexpr int RS = 2064;
    constexpr int O_WH = 0, O_WL = 16 * RS, O_HH = 32 * RS, O_HL = 48 * RS, O_PL = 64 * RS;
    static_assert(O_PL + 8 * 256 * 4 <= LDS_BYTES - 64, "router LDS map");
    __syncthreads();
    for (int i = tid; i < D * 4; i += NT) {
        const int d = i >> 2, e4 = i & 3; const float4 w = ((const float4*)p.router_w)[i]; const float wv4[4] = {w.x, w.y, w.z, w.w};
#pragma unroll
        for (int q = 0; q < 4; ++q) { const unsigned hi = f2bf(wv4[q]); const float rem = wv4[q] - __uint_as_float(hi << 16);
            *(HG_LAS bf16_t*)(L + O_WH + (e4 * 4 + q) * RS + 2 * d) = (bf16_t)hi; *(HG_LAS bf16_t*)(L + O_WL + (e4 * 4 + q) * RS + 2 * d) = (bf16_t)f2bf(rem); }
    }
    auto ldrow = [&](int r, f32x4_t (&dst)[4]) {
#pragma unroll
        for (int q = 0; q < 4; ++q) { const uint2 w = ((const uint2*)(X1 + (size_t)r * (2 * D)))[lane + 64 * q]; dst[q] = (f32x4_t){__uint_as_float(w.x << 16), __uint_as_float(w.x & 0xffff0000u), __uint_as_float(w.y << 16), __uint_as_float(w.y & 0xffff0000u)}; }
    };
    for (int blk = blockIdx.x; blk < NTOK / 128; blk += gridDim.x) {
        const int rblk = blk * 128, b = rblk / SEQ;
        f32x4_t gm[4], hs[4];
#pragma unroll
        for (int q = 0; q < 4; ++q) { const int d4 = lane + 64 * q; const f32x4_t gg = ((const f32x4_t*)p.norm2_g)[d4], s1 = ((const f32x4_t*)(ADA + b * 6144 + 4096))[d4]; gm[q] = gg * (1.f + s1); hs[q] = ((const f32x4_t*)(ADA + b * 6144 + 3072))[d4]; }
        f32x4_t va[4], vb[4], na[4], nb[4];
        ldrow(rblk + 2 * wv, va); ldrow(rblk + 2 * wv + 1, vb);
        for (int grp = 0; grp < 8; ++grp) {
            const int r0 = rblk + grp * 16;
            if (grp + 1 < 8) { ldrow(r0 + 16 + 2 * wv, na); ldrow(r0 + 17 + 2 * wv, nb); }
#pragma unroll
            for (int half = 0; half < 2; ++half) {
                const int lr = 2 * wv + half, r = r0 + lr;
                float ss = 0.f;
#pragma unroll
                for (int q = 0; q < 4; ++q) { const f32x4_t v = half ? vb[q] : va[q]; ss += v.x * v.x + v.y * v.y + v.z * v.z + v.w * v.w; }
                const float rstd = rsqrtf(wave_sum(ss) * (1.f / D) + EPS);
#pragma unroll
                for (int q = 0; q < 4; ++q) {
                    const int d4 = lane + 64 * q;
                    const f32x4_t o = (half ? vb[q] : va[q]) * rstd * gm[q] + hs[q];
                    const unsigned h01 = cvtpk(o.x, o.y), h23 = cvtpk(o.z, o.w);
                    ((uint2*)(H2 + (size_t)r * D))[d4] = make_uint2(h01, h23);
                    const unsigned l01 = cvtpk(o.x - __uint_as_float(h01 << 16), o.y - __uint_as_float(h01 & 0xffff0000u)), l23 = cvtpk(o.z - __uint_as_float(h23 << 16), o.w - __uint_as_float(h23 & 0xffff0000u));
                    typedef unsigned u32x2_t __attribute__((ext_vector_type(2)));
                    *(HG_LAS u32x2_t*)(L + O_HH + lr * RS + 8 * d4) = (u32x2_t){h01, h23};
                    *(HG_LAS u32x2_t*)(L + O_HL + lr * RS + 8 * d4) = (u32x2_t){l01, l23};
                }
            }
            __syncthreads();
            f32x4_t acc = (f32x4_t){0.f, 0.f, 0.f, 0.f};
#pragma unroll
            for (int ks = 0; ks < 4; ++ks) {
                const int kb = 2 * (32 * (4 * wv + ks) + 8 * g);
                const bf16x8_t wh = *(const HG_LAS bf16x8_t*)(L + O_WH + j * RS + kb), wl = *(const HG_LAS bf16x8_t*)(L + O_WL + j * RS + kb);
                const bf16x8_t hh = *(const HG_LAS bf16x8_t*)(L + O_HH + j * RS + kb), hl = *(const HG_LAS bf16x8_t*)(L + O_HL + j * RS + kb);
                acc = __builtin_amdgcn_mfma_f32_16x16x32_bf16(wh, hh, acc, 0, 0, 0);
                acc = __builtin_amdgcn_mfma_f32_16x16x32_bf16(wh, hl, acc, 0, 0, 0);
                acc = __builtin_amdgcn_mfma_f32_16x16x32_bf16(wl, hh, acc, 0, 0, 0);
            }
#pragma unroll
            for (int r = 0; r < 4; ++r) *(HG_LAS float*)(L + O_PL + ((wv * 16 + 4 * g + r) * 16 + j) * 4) = acc[r];
            __syncthreads();
            if (tid < 256) {
                const int row = tid >> 4, e = tid & 15;
                float lgt = 0.f;
#pragma unroll
                for (int k = 0; k < 8; ++k) lgt += *(const HG_LAS float*)(L + O_PL + ((k * 16 + e) * 16 + row) * 4);
                float mx = lgt;
                mx = fmaxf(mx, __shfl_xor(mx, 1)); mx = fmaxf(mx, __shfl_xor(mx, 2)); mx = fmaxf(mx, __shfl_xor(mx, 4)); mx = fmaxf(mx, __shfl_xor(mx, 8));
                const float ex = expf(lgt - mx);
                float den = ex;
                den += __shfl_xor(den, 1); den += __shfl_xor(den, 2); den += __shfl_xor(den, 4); den += __shfl_xor(den, 8);
                const int r = r0 + row;
                AFF[((size_t)b * 16 + e) * SEQ + (r % SEQ)] = ex / den;
            }
            __syncthreads();
#pragma unroll
            for (int q = 0; q < 4; ++q) { va[q] = na[q]; vb[q] = nb[q]; }
        }
    }
}

__device__ __forceinline__ void ph_topk(const P& p, float* lds) {
    const int tid = opaque_tid(), lane = tid & 63, wv = tid >> 6;
    const float* AFF = (const float*)(p.ws + WS_AFF);
    int* IDX = (int*)(p.ws + WS_IDX);
    float* GATE = (float*)(p.ws + WS_GATE);
    int* INV = (int*)(p.ws + WS_INV);
    unsigned* hist = (unsigned*)lds;
    unsigned* ctl = hist + 256;
    unsigned* wtot = hist + 272;
    for (int item = blockIdx.x; item < NB * NE; item += gridDim.x) {
        const int b = item >> 4, e = item & 15;
        const uint4 kk = ((const uint4*)(AFF + (size_t)item * SEQ))[tid];
        const unsigned key[4] = {kk.x, kk.y, kk.z, kk.w};
        unsigned prefix = 0u, need = CAP;
#pragma unroll
        for (int pass = 3; pass >= 0; --pass) {
            __syncthreads();
            if (tid < 256) hist[tid] = 0u;
            __syncthreads();
#pragma unroll
            for (int q = 0; q < 4; ++q) {
                const bool in = (pass == 3) || ((key[q] >> (8 * (pass + 1))) == prefix);
                if (in) atomicAdd(&hist[(key[q] >> (8 * pass)) & 255u], 1u);
            }
            __syncthreads();
            if (wv == 0) {
                const uint4 h4 = ((const uint4*)hist)[lane];
                const unsigned loc = h4.x + h4.y + h4.z + h4.w;
                unsigned suf = loc;
#pragma unroll
                for (int o = 1; o < 64; o <<= 1) { const unsigned y = __shfl_down(suf, o); if (lane + o < 64) suf += y; }
                const unsigned above = suf - loc;
                unsigned c3 = above + h4.w, c2 = c3 + h4.z, c1 = c2 + h4.y, c0 = c1 + h4.x;
                int bin = -1; unsigned nneed = 0u;
                if (above < need && c0 >= need) {
                    if (c3 >= need) { bin = 4 * lane + 3; nneed = need - above; }
                    else if (c2 >= need) { bin = 4 * lane + 2; nneed = need - c3; }
                    else if (c1 >= need) { bin = 4 * lane + 1; nneed = need - c2; }
                    else { bin = 4 * lane; nneed = need - c1; }
                    ctl[0] = (prefix << 8) | (unsigned)bin; ctl[1] = nneed;
                }
            }
            __syncthreads();
            prefix = ctl[0]; need = ctl[1];
        }
        unsigned cgt = 0u, ceq = 0u;
#pragma unroll
        for (int q = 0; q < 4; ++q) { cgt += key[q] > prefix ? 1u : 0u; ceq += key[q] == prefix ? 1u : 0u; }
        unsigned sgt = cgt, seq = ceq;
#pragma unroll
        for (int o = 1; o < 64; o <<= 1) { const unsigned y1 = __shfl_up(sgt, o), y2 = __shfl_up(seq, o); if (lane >= o) { sgt += y1; seq += y2; } }
        if (lane == 63) { wtot[wv] = sgt; wtot[8 + wv] = seq; }
        __syncthreads();
        unsigned bgt = 0u, beq = 0u, ngt = 0u;
#pragma unroll
        for (int k = 0; k < 8; ++k) { const unsigned a = wtot[k], c = wtot[8 + k]; if (k < wv) { bgt += a; beq += c; } ngt += a; }
        unsigned rgt = bgt + sgt - cgt, req = beq + seq - ceq;
#pragma unroll
        for (int q = 0; q < 4; ++q) {
            const int t = 4 * tid + q; int slot = -1;
            if (key[q] > prefix) { slot = (int)rgt; ++rgt; }
            else if (key[q] == prefix) { if (req < need) slot = (int)(ngt + req); ++req; }
            if (slot >= 0) { IDX[item * CAP + slot] = t; GATE[item * CAP + slot] = __uint_as_float(key[q]); }
            INV[((size_t)b * SEQ + t) * 16 + e] = slot;
        }
    }
}

struct MoeUpSched {
    int G, c, round; const bf16_t *H2, *W13T; bf16_t* HMID; const int* IDX;
    __device__ __forceinline__ bool next(int i, Unit& u) const {
        if (i >= 4 || c >= 256) return false;
        const int x = c & 7, q = c >> 3, Q = q >> 2, mth = q & 3, item = (Q * 4 + ((round & 1) * 2 + (round >> 1))) * 8 + x, b = item >> 4, e = item & 15, nt = 4 * mth + i;
        u.a = (const char*)(H2 + (size_t)b * SEQ * D); u.b = (const char*)(W13T + ((size_t)e * 4096 + nt * 256) * D); u.c = HMID + (size_t)item * CAP * FF + nt * 128;
        u.aux = nullptr; u.gidx = IDX + item * CAP; u.ldc = FF; u.row0 = 0; u.col0 = 0; return true;
    }
    __device__ __forceinline__ void a_ready(const Unit&) const {}
    __device__ __forceinline__ void done(const Unit&) const {}
};
struct MoeDownSched {
    int G, c; const bf16_t *HMID, *W2T; bf16_t* YS; const float* GATE;
    __device__ __forceinline__ bool next(int i, Unit& u) const {
        if (i >= 4 || c >= 256) return false;
        const int x = c & 7, q = c >> 3, Q = q >> 2, nt = q & 3, item = (Q * 4 + i) * 8 + x, e = item & 15;
        u.a = (const char*)(HMID + (size_t)item * CAP * FF); u.b = (const char*)(W2T + ((size_t)e * 1024 + nt * 256) * FF); u.c = YS + (size_t)item * CAP * D + nt * 256;
        u.aux = GATE + item * CAP; u.gidx = nullptr; u.ldc = D; u.row0 = 0; u.col0 = 0; return true;
    }
    __device__ __forceinline__ void a_ready(const Unit&) const {}
    __device__ __forceinline__ void done(const Unit&) const {}
};
__device__ __forceinline__ void ph_moe_up(const P& p, unsigned char* lds) {
    pg8::EpiSwiGLU E;
    for (int round = 0; round < 4; ++round) {
        MoeUpSched S{(int)gridDim.x, (int)blockIdx.x, round, (const bf16_t*)(p.ws + WS_H2), (const bf16_t*)(p.ws + WS_W13T), (bf16_t*)(p.ws + WS_HMID), (const int*)(p.ws + WS_IDX)};
        pg8::gemm_phase<pg8::EpiSwiGLU, MoeUpSched, true, true, true>((PG8_LAS unsigned char*)lds, D, S, E);
    }
}
__device__ __forceinline__ void ph_moe_down(const P& p, unsigned char* lds) {
    MoeDownSched S{(int)gridDim.x, (int)blockIdx.x, (const bf16_t*)(p.ws + WS_HMID), (const bf16_t*)(p.ws + WS_W2T), (bf16_t*)(p.ws + WS_YS), (const float*)(p.ws + WS_GATE)};
    pg8::EpiDown E;
    pg8::gemm_phase<pg8::EpiDown, MoeDownSched, true, true, false>((PG8_LAS unsigned char*)lds, FF, S, E);
}

__device__ __forceinline__ void ph_final(const P& p) {
    const int tid = opaque_tid(), lane = tid & 63, wv = tid >> 6;
    const float* ADA = (const float*)(p.ws + WS_ADA);
    const bf16_t* YS = (const bf16_t*)(p.ws + WS_YS);
    const int* INV = (const int*)(p.ws + WS_INV);
    float* X = p.out;
    constexpr int NR = 4;
    for (int rc = blockIdx.x * 8 + wv; rc < NTOK / 16; rc += gridDim.x * 8)
    for (int r0 = rc * 16; r0 < rc * 16 + 16; r0 += NR) {
        const int b = r0 / SEQ;
        const float* g2 = ADA + b * 6144 + 5120;
        int myinv[NR]; f32x4_t xv[NR][4]; f32x4_t acc[NR][4];
#pragma unroll
        for (int rr = 0; rr < NR; ++rr) {
            myinv[rr] = INV[(size_t)(r0 + rr) * 16 + (lane & 15)];
#pragma unroll
            for (int j = 0; j < 4; ++j) { const uint2 w = ((const uint2*)(X + (size_t)(r0 + rr) * D))[lane + 64 * j];
                xv[rr][j] = (f32x4_t){__uint_as_float(w.x << 16), __uint_as_float(w.x & 0xffff0000u), __uint_as_float(w.y << 16), __uint_as_float(w.y & 0xffff0000u)}; acc[rr][j] = (f32x4_t){0.f, 0.f, 0.f, 0.f}; }
        }
#pragma unroll
        for (int rr = 0; rr < NR; ++rr) {
            unsigned m = (unsigned)(__ballot(myinv[rr] >= 0) & 0xffffull);
            while (m) {
                uint2 w[4][4]; int ne = 0;
#pragma unroll
                for (int k = 0; k < 4; ++k) {
                    if (m) {
                        const int e = __builtin_ctz(m); m &= m - 1u; ne = k + 1;
                        const int slot = __shfl(myinv[rr], e);
                        const uint2* yr = (const uint2*)(YS + ((size_t)(b * 16 + e) * CAP + slot) * D);
#pragma unroll
                        for (int j = 0; j < 4; ++j) w[k][j] = yr[lane + 64 * j];
                    }
                }
#pragma unroll
                for (int k = 0; k < 4; ++k) {
                    if (k < ne) {
#pragma unroll
                        for (int j = 0; j < 4; ++j) { acc[rr][j].x += __uint_as_float(w[k][j].x << 16); acc[rr][j].y += __uint_as_float(w[k][j].x & 0xffff0000u); acc[rr][j].z += __uint_as_float(w[k][j].y << 16); acc[rr][j].w += __uint_as_float(w[k][j].y & 0xffff0000u); }
                    }
                }
            }
        }
#pragma unroll
        for (int rr = 0; rr < NR; ++rr) {
            f32x4_t v[4]; float ss = 0.f;
#pragma unroll
            for (int j = 0; j < 4; ++j) {
                const f32x4_t g = ((const f32x4_t*)g2)[lane + 64 * j];
                v[j] = xv[rr][j] + g * acc[rr][j];
                ss += v[j].x * v[j].x + v[j].y * v[j].y + v[j].z * v[j].z + v[j].w * v[j].w;
            }
            ss = wave_sum(ss);
            const float rstd = rsqrtf(ss * (1.f / D) + EPS);
#pragma unroll
            for (int j = 0; j < 4; ++j) {
                const f32x4_t g = ((const f32x4_t*)p.final_g)[lane + 64 * j];
                ((f32x4_t*)(X + (size_t)(r0 + rr) * D))[lane + 64 * j] = v[j] * rstd * g;
            }
        }
    }
}

#define LAS __attribute__((address_space(3)))
#define XB_TMO      128
#define XB_XCNT(j)  (256  + 64 * (j))
#define XB_XSUB(j)  (1280 + 64 * (j))
#define XB_XGEN(j)  (2304 + 64 * (j))
#define XB_TOP      3328
#define XB_TOPGEN   3392
#define XCD_BAR_WORDS 3456
#define XB_SPIN_CAP (1u << 18)

__device__ __forceinline__ unsigned xb_ld(unsigned* p)              { return __hip_atomic_load(p, __ATOMIC_RELAXED, __HIP_MEMORY_SCOPE_AGENT); }
__device__ __forceinline__ unsigned xb_add(unsigned* p, unsigned v) { return __hip_atomic_fetch_add(p, v, __ATOMIC_RELAXED, __HIP_MEMORY_SCOPE_AGENT); }
__device__ __forceinline__ unsigned xb_xcc_id() { return (unsigned)__builtin_amdgcn_s_getreg((3 << 11) | 20) & 0xFu; }
#define XB_SPIN(cond, bar) do { unsigned _sp = 0; while (cond) { __builtin_amdgcn_s_sleep(1); \
    if ((++_sp & 255u) == 0u) { if (xb_ld(&(bar)[XB_TMO])) break; if (_sp > XB_SPIN_CAP) { atomicAdd(&(bar)[XB_TMO], 1u); break; } } } } while (0)

struct XcdBarrier {
    unsigned* bar; unsigned x;
    volatile LAS unsigned* st;
};

__device__ __forceinline__ XcdBarrier xcd_barrier_post(unsigned* bar, volatile LAS unsigned* st) {
    XcdBarrier b; b.bar = bar; b.x = xb_xcc_id(); b.st = st;
    if (threadIdx.x == 0) (void)xb_add(&bar[XB_XCNT(b.x)], 1u);
    return b;
}
__device__ __forceinline__ void xcd_barrier_complete(unsigned* bar, unsigned x, unsigned& nloc, unsigned& nx) {
    const unsigned G = gridDim.x * gridDim.y * gridDim.z;
    unsigned sum, cnt, mine, sp = 0u;
    for (;;) {
        sum = 0u; cnt = 0u; mine = 0u;
#pragma unroll
        for (unsigned j = 0; j < 16; ++j) { const unsigned c = xb_ld(&bar[XB_XCNT(j)]); sum += c; cnt += (c > 0u) ? 1u : 0u; mine = (j == x) ? c : mine; }
        if (sum == G) break;
        __builtin_amdgcn_s_sleep(1);
        if ((++sp & 255u) == 0u) { if (xb_ld(&bar[XB_TMO])) break; if (sp > XB_SPIN_CAP) { atomicAdd(&bar[XB_TMO], 1u); break; } }
    }
    nloc = mine > 0u ? mine : 1u; nx = cnt > 0u ? cnt : 1u;
}

__device__ __forceinline__ void xcd_barrier(const XcdBarrier& b) {
    asm volatile("s_waitcnt vmcnt(0)" ::: "memory");
    __syncthreads();
    if (threadIdx.x == 0) {
        unsigned* bar = b.bar;
        __builtin_amdgcn_s_waitcnt(0);
        unsigned nloc = b.st[0], nx = b.st[1];
        if (nloc == 0u) { xcd_barrier_complete(bar, b.x, nloc, nx); b.st[0] = nloc; b.st[1] = nx; }
        const unsigned old = xb_add(&bar[XB_XSUB(b.x)], 1u);
        const unsigned gen = old / nloc;
        if (old + 1u == (gen + 1u) * nloc) {
            __builtin_amdgcn_fence(__ATOMIC_RELEASE, "agent");
            asm volatile("s_waitcnt vmcnt(0)" ::: "memory");
            const unsigned og = xb_add(&bar[XB_TOP], 1u);
            const unsigned tg = og / nx;
            if (og + 1u == (tg + 1u) * nx) xb_add(&bar[XB_TOPGEN], 1u);
            else XB_SPIN(xb_ld(&bar[XB_TOPGEN]) == tg, bar);
            __builtin_amdgcn_fence(__ATOMIC_ACQUIRE, "agent");
            xb_add(&bar[XB_XGEN(b.x)], 1u);
            asm volatile("s_waitcnt vmcnt(0)" ::: "memory");
        } else {
            XB_SPIN(xb_ld(&bar[XB_XGEN(b.x)]) == gen, bar);
            __builtin_amdgcn_fence(__ATOMIC_ACQUIRE, "agent");
            asm volatile("s_waitcnt vmcnt(0)" ::: "memory");
        }
    }
    __syncthreads();
}

constexpr int N_PHASES = 11;
template <int PH>
__device__ __forceinline__ void run_phase(const P& p, unsigned char* ldsb) {
    float* lds = (float*)ldsb;
    if constexpr (PH == 0) { ph_prep(p, lds); ph_convert_small(p, lds); }
    else if constexpr (PH == 1) { ph_norm1(p); ph_filter(p, lds); }
    else if constexpr (PH == 2) ph_inproj(p, ldsb);
    else if constexpr (PH == 3) ph_mixers<0>(p, ldsb);
    else if constexpr (PH == 4) ph_mixprep(p, lds);
    else if constexpr (PH == 5) ph_outproj(p, ldsb);
    else if constexpr (PH == 6) ph_norm2_router(p, lds);
    else if constexpr (PH == 7) ph_topk(p, lds);
    else if constexpr (PH == 8) ph_moe_up(p, ldsb);
    else if constexpr (PH == 9) ph_moe_down(p, ldsb);
    else if constexpr (PH == 10) ph_final(p);
}
template <int PH>
__device__ __forceinline__ void run_from(const P& p, unsigned char* lds, const XcdBarrier& bar) {
    if constexpr (PH < N_PHASES) {
        run_phase<PH>(p, lds);
        if constexpr (PH + 1 < N_PHASES) xcd_barrier(bar);
        run_from<PH + 1>(p, lds, bar);
    }
}
__global__ void __launch_bounds__(NT, 2) fwd_all(P p) {
    extern __shared__ __attribute__((aligned(16))) unsigned char lds_raw[];
    volatile LAS unsigned* st = (volatile LAS unsigned*)(lds_raw + LDS_BYTES - 32);
    if (threadIdx.x < 2) st[threadIdx.x] = 0u;
    __syncthreads();
    const XcdBarrier bar = xcd_barrier_post((unsigned*)(p.ws + WS_CTL) + CW_BAR, st);
    run_from<0>(p, lds_raw, bar);
}

extern "C" void kernel_launch(void* const* d_in, const int* in_sizes, int n_in, void* d_out, int out_size, void* d_ws, size_t ws_size, hipStream_t stream) {
    static int grid = 0;
    if (grid == 0) {
        int dev = 0, cus = 0, per_cu = 0;
        (void)hipGetDevice(&dev);
        (void)hipDeviceGetAttribute(&cus, hipDeviceAttributeMultiprocessorCount, dev);
        (void)hipFuncSetAttribute((const void*)fwd_all, hipFuncAttributeMaxDynamicSharedMemorySize, LDS_BYTES);
        (void)hipOccupancyMaxActiveBlocksPerMultiprocessor(&per_cu, (const void*)fwd_all, NT, LDS_BYTES);
        if (per_cu < 1) fprintf(stderr, "kernel_launch: occupancy query says %d blocks/CU\n", per_cu);
        grid = (cus > 0 ? cus : 256);
        if (ws_size < WS_END) fprintf(stderr, "kernel_launch: workspace too small: %zu < %zu\n", ws_size, (size_t)WS_END);
    }
    P p{};
    const float** f = (const float**)&p;
    for (int i = 0; i < 28; ++i) f[i] = (const float*)d_in[i];
    p.out = (float*)d_out;
    p.ws = (unsigned char*)d_ws;
    p.ph_lo = 0; p.ph_hi = N_PHASES;
    (void)hipMemsetAsync((unsigned char*)d_ws + WS_CTL, 0, CTL_ZERO_BYTES, stream);
    hipLaunchKernelGGL(fwd_all, dim3(grid), dim3(NT), LDS_BYTES, stream, p);
}
```

```cpp
#include <hip/hip_runtime.h>
#include <cstdio>
#include <cstdint>

constexpr int D = 1024, NB = 16, SEQ = 2048, CTXL = 256;
constexpr int NTOK = NB * SEQ;
constexpr int NCTX = NB * CTXL;
constexpr int HEADS = 4;
constexpr int INC = 4096;
constexpr int NE = 16, CAP = 256, FF = 2048;
constexpr int NT = 512;
constexpr int LDS_BYTES = 147456;
constexpr float EPS = 1e-6f;
typedef unsigned short bf16_t;

constexpr size_t MiB = 1u << 20;
constexpr size_t WS_CTL = 0;
constexpr size_t WS_ADA = 1 * MiB;
constexpr size_t WS_LB = WS_ADA + 512 * 1024;
constexpr size_t WS_HID2 = 2 * MiB;
constexpr size_t WS_AFF = 3 * MiB;
constexpr size_t WS_IDX = 5 * MiB;
constexpr size_t WS_GATE = 5 * MiB + 512 * 1024;
constexpr size_t WS_INV = 6 * MiB;
constexpr size_t WS_W13T = 8 * MiB;
constexpr size_t WS_YS = WS_W13T;
constexpr size_t WS_W2T = 136 * MiB;
constexpr size_t WS_R = 200 * MiB;
constexpr size_t WS_H = WS_R;
constexpr size_t WS_MIXA = WS_R;
constexpr size_t WS_HC = WS_R + 64 * MiB;
constexpr size_t WS_PC = WS_R + 72 * MiB;
constexpr size_t WS_OFB = WS_R + 84 * MiB;
constexpr size_t WS_WOUTT = WS_R + 148 * MiB;
constexpr size_t WS_PHG = WS_R + 152 * MiB;
constexpr size_t WS_HMID = WS_R;
constexpr size_t WS_H2 = WS_R + 256 * MiB;
constexpr size_t WS_YT = WS_R + 320 * MiB;
constexpr size_t WS_END = WS_YT + 32 * MiB;
constexpr int CW_QHEAD = 64;
constexpr int CW_BAR = 4096;
constexpr size_t CTL_ZERO_BYTES = 65536;
constexpr size_t DO_PHYT = 0;
constexpr size_t DO_HF = 96 * MiB;
constexpr size_t DO_SCTX = 112 * MiB;
constexpr size_t DO_WINT = 120 * MiB;

struct P {
    const float *x, *c, *ctx, *c_ctx, *ada_w, *ada_b, *norm1_g, *w_in, *hy_conv_w, *hy_conv_b, *pos_w1, *pos_b1, *freq1, *pos_w2, *pos_b2,
        *freq2, *pos_w3, *hy_bias, *hy_norm_g, *hg_lb, *hg_norm_g, *w_out, *norm2_g, *router_w, *exp_w1, *exp_w3, *exp_w2, *final_g;
    float* out;
    unsigned char* ws;
    int ph_lo, ph_hi;
};

__device__ __forceinline__ int opaque_tid() { int t = threadIdx.x; asm volatile("" : "+v"(t)); return t; }
__device__ __forceinline__ void lds_barrier() { asm volatile("s_waitcnt lgkmcnt(0)" ::: "memory"); __builtin_amdgcn_s_barrier(); asm volatile("" ::: "memory"); }
typedef float f32x4_t __attribute__((ext_vector_type(4)));
__device__ __forceinline__ float wave_sum(float v) {
#pragma unroll
    for (int o = 1; o < 64; o <<= 1) v += __shfl_xor(v, o);
    return v;
}
__device__ __forceinline__ float sigmoidf_(float z) { return 1.f / (1.f + expf(-z)); }
__device__ __forceinline__ float siluf_(float z) { return z / (1.f + expf(-z)); }
__device__ __forceinline__ float silu_f(float z) { return z * __builtin_amdgcn_rcpf(1.0f + __builtin_amdgcn_exp2f(-1.4426950408889634f * z)); }
__device__ __forceinline__ float bf2f(bf16_t h) { return __uint_as_float((unsigned)h << 16); }
__device__ __forceinline__ unsigned f2bf(float f) { unsigned u = __float_as_uint(f); return (u + 0x7fffu + ((u >> 16) & 1u)) >> 16; }
typedef float f32x2_cv __attribute__((ext_vector_type(2))); typedef __bf16 bf16x2_cv __attribute__((ext_vector_type(2)));
__device__ __forceinline__ unsigned cvtpk(float lo, float hi) { const f32x2_cv v = {lo, hi}; const bf16x2_cv b = __builtin_convertvector(v, bf16x2_cv); return __builtin_bit_cast(unsigned, b); }
__device__ __forceinline__ unsigned pk2(float lo, float hi) { return f2bf(lo) | (f2bf(hi) << 16); }

namespace pg8 {
#define PG8_LAS __attribute__((address_space(3)))
typedef unsigned short bf16_t;
typedef short bf16x8 __attribute__((ext_vector_type(8)));
typedef float f32x4 __attribute__((ext_vector_type(4)));
typedef unsigned u32x4 __attribute__((ext_vector_type(4)));
constexpr int BM = 256, BK = 64, HALF = 128, HTB = HALF * BK * 2  , STAGE_BYTES = 8 * HTB, NXCD = 8, WGM = 8;

__host__ __device__ __forceinline__ int lds_byte(int r, int c) { const int st = (r >> 4) * 2 + (c >> 5), rr = r & 15, cc = c & 31, ob = rr * 64 + cc * 2; return st * 1024 + (ob ^ (((ob >> 9) & 1) << 5)); }
__host__ __device__ __forceinline__ void stage_rc(int b, int& R, int& C) { const int st = b / 1024, sb = b % 1024, swz = sb ^ (((sb >> 9) & 1) << 5); R = (st >> 1) * 16 + swz / 64; C = (st & 1) * 32 + (swz % 64) / 2; }
__host__ __device__ __forceinline__ int perm32(int rho) { const int n = rho >> 4, i = rho & 15; return 8 * (i >> 2) + 4 * n + (i & 3); }

struct Unit { const char* a; const char* b; bf16_t* c; const float* aux; const int* gidx; int ldc, row0, col0; };
__device__ __forceinline__ unsigned cvt_pk_bf16(float lo, float hi) { unsigned r; asm volatile("v_cvt_pk_bf16_f32 %0, %1, %2" : "=v"(r) : "v"(lo), "v"(hi)); return r; }

__device__ __forceinline__ void tile_of(int L, int nM, int nN, int& pm, int& pn) {
    const int nwg = nM * nN; int wgid = L;
    { const int q = nwg / NXCD, r = nwg % NXCD, xcd = wgid % NXCD, off = wgid / NXCD; wgid = (xcd < r ? xcd * (q + 1) : r * (q + 1) + (xcd - r) * q) + off; }
    const int nig = WGM * nN, gid = wgid / nig, fm = gid * WGM, gsz = (nM - fm) < WGM ? (nM - fm) : WGM;
    pm = fm + ((wgid % nig) % gsz); pn = (wgid % nig) / gsz;
}

struct EpiStoreBf16 {
    static constexpr bool PERM = true, AFTER_DRAIN = false;
    __device__ __forceinline__ void operator()(const f32x4 (&acc)[2][2][4][2], const Unit& u, int wr, int wc, int fr, int fq) const {
        bf16_t* base = u.c + (size_t)(wr * 64 + fr) * u.ldc + wc * 32 + 8 * fq;
#pragma unroll
        for (int ai = 0; ai < 2; ++ai)
#pragma unroll
            for (int m = 0; m < 4; ++m) { bf16_t* rowp = base + (size_t)(ai * HALF + m * 16) * u.ldc;
#pragma unroll
                for (int bj = 0; bj < 2; ++bj) { const f32x4 v0 = acc[ai][bj][m][0], v1 = acc[ai][bj][m][1];
                    u32x4 w; w.x = cvt_pk_bf16(v0[0], v0[1]); w.y = cvt_pk_bf16(v0[2], v0[3]); w.z = cvt_pk_bf16(v1[0], v1[1]); w.w = cvt_pk_bf16(v1[2], v1[3]);
                    *(u32x4*)(rowp + bj * HALF) = w; } }
    }
};
struct EpiOutProj {
    static constexpr bool PERM = true, AFTER_DRAIN = false;
    const float* x; const float* ada; bf16_t* x1;
    __device__ __forceinline__ void operator()(const f32x4 (&acc)[2][2][4][2], const Unit& u, int wr, int wc, int fr, int fq) const {
        const float* g1 = ada + (u.row0 >> 11) * 6144 + 2048;
#pragma unroll
        for (int bj = 0; bj < 2; ++bj) { const int col = u.col0 + bj * HALF + wc * 32 + 8 * fq; const f32x4 g0 = *(const f32x4*)(g1 + col), gB = *(const f32x4*)(g1 + col + 4);
#pragma unroll
            for (int ai = 0; ai < 2; ++ai)
#pragma unroll
                for (int m = 0; m < 4; ++m) { const size_t row = (size_t)(u.row0 + ai * HALF + wr * 64 + m * 16 + fr);
                    const f32x4 v0 = *(const f32x4*)(x + row * D + col) + g0 * acc[ai][bj][m][0], v1 = *(const f32x4*)(x + row * D + col + 4) + gB * acc[ai][bj][m][1];
                    u32x4 w; w.x = cvt_pk_bf16(v0[0], v0[1]); w.y = cvt_pk_bf16(v0[2], v0[3]); w.z = cvt_pk_bf16(v1[0], v1[1]); w.w = cvt_pk_bf16(v1[2], v1[3]);
                    *(u32x4*)(x1 + row * (2 * D) + col) = w; } }
    }
};
__device__ __forceinline__ float silu_fast(float a) { return a * __builtin_amdgcn_rcpf(1.0f + __builtin_amdgcn_exp2f(-1.4426950408889634f * a)); }
struct EpiSwiGLU {
    static constexpr bool PERM = true, AFTER_DRAIN = false;
    __device__ __forceinline__ void operator()(const f32x4 (&acc)[2][2][4][2], const Unit& u, int wr, int wc, int fr, int fq) const {
        bf16_t* base = u.c + (size_t)(wr * 64 + fr) * FF + wc * 32 + 8 * fq;
#pragma unroll
        for (int ai = 0; ai < 2; ++ai)
#pragma unroll
            for (int m = 0; m < 4; ++m) { const f32x4 a0 = acc[ai][0][m][0], a1 = acc[ai][0][m][1], b0 = acc[ai][1][m][0], b1 = acc[ai][1][m][1];
                u32x4 w; w.x = cvt_pk_bf16(silu_fast(a0[0]) * b0[0], silu_fast(a0[1]) * b0[1]); w.y = cvt_pk_bf16(silu_fast(a0[2]) * b0[2], silu_fast(a0[3]) * b0[3]);
                w.z = cvt_pk_bf16(silu_fast(a1[0]) * b1[0], silu_fast(a1[1]) * b1[1]); w.w = cvt_pk_bf16(silu_fast(a1[2]) * b1[2], silu_fast(a1[3]) * b1[3]);
                *(u32x4*)(base + (size_t)(ai * HALF + m * 16) * FF) = w; }
    }
};
struct EpiDown {
    static constexpr bool PERM = true, AFTER_DRAIN = false;
    __device__ __forceinline__ void operator()(const f32x4 (&acc)[2][2][4][2], const Unit& u, int wr, int wc, int fr, int fq) const {
        bf16_t* base = u.c + (size_t)(wr * 64 + fr) * D + wc * 32 + 8 * fq;
#pragma unroll
        for (int ai = 0; ai < 2; ++ai)
#pragma unroll
            for (int m = 0; m < 4; ++m) { const float gt = u.aux[ai * HALF + wr * 64 + m * 16 + fr]; bf16_t* rowp = base + (size_t)(ai * HALF + m * 16) * D;
#pragma unroll
                for (int bj = 0; bj < 2; ++bj) { const f32x4 v0 = acc[ai][bj][m][0] * gt, v1 = acc[ai][bj][m][1] * gt;
                    u32x4 w; w.x = cvt_pk_bf16(v0[0], v0[1]); w.y = cvt_pk_bf16(v0[2], v0[3]); w.z = cvt_pk_bf16(v1[0], v1[1]); w.w = cvt_pk_bf16(v1[2], v1[3]);
                    *(u32x4*)(rowp + bj * HALF) = w; } }
    }
};

template <class Epi, class Sched, bool ALIGN_EPI = false, bool SP2 = false, bool GATHER = false>
__device__ __forceinline__ void gemm_phase(PG8_LAS unsigned char* lds, const int K, const Sched& S, const Epi& E) {
    const int tid = opaque_tid(), wid = __builtin_amdgcn_readfirstlane(tid >> 6), lane = tid & 63, wr = wid >> 2, wc = wid & 3, fr = lane & 15, fq = lane >> 4;
    const int nt = K / BK;
    unsigned voffA[2], voffB[2];
#pragma unroll
    for (int i = 0; i < 2; ++i) { int R, C; stage_rc(tid * 16 + i * 8192, R, C); const int Rb = Epi::PERM ? ((R & ~31) + perm32(R & 31)) : R;
        voffA[i] = (unsigned)(R * K + C) * 2u; voffB[i] = (unsigned)(Rb * K + C) * 2u; }
    const size_t kstep = (size_t)(BK * 2);
    const size_t hstep = (size_t)HALF * K * 2;
    const unsigned ldsw = (unsigned)wid * 1024u;
    const int aoff = lds_byte(wr * 64 + fr, fq * 8), boff = lds_byte(wc * 32 + fr, fq * 8);
#define PG8_SA(b, h) (((b) * 2 + (h)) * HTB)
#define PG8_SB(b, h) ((4 + (b) * 2 + (h)) * HTB)
#define PG8_STAGE(bufoff, gbase, voff) do { _Pragma("unroll") for (int _i = 0; _i < 2; ++_i) \
        __builtin_amdgcn_global_load_lds((const unsigned*)((const char*)(gbase) + (voff)[_i]), (PG8_LAS unsigned*)(lds + (bufoff) + ldsw + _i * 8192), 16, 0, 0); } while (0)
#define PG8_STAGE_A(bufoff, gbase, h) do { _Pragma("unroll") for (int _i = 0; _i < 2; ++_i) \
        __builtin_amdgcn_global_load_lds((const unsigned*)((const char*)(gbase) + voffAh[h][_i]), (PG8_LAS unsigned*)(lds + (bufoff) + ldsw + _i * 8192), 16, 0, 0); } while (0)
#define PG8_LDA(dst, b, h) do { _Pragma("unroll") for (int m = 0; m < 4; ++m) _Pragma("unroll") for (int k = 0; k < 2; ++k) dst[m][k] = *(const PG8_LAS bf16x8*)(lds + PG8_SA(b, h) + aoff + m * 2048 + k * 1024); } while (0)
#define PG8_LDB(dst, b, h) do { _Pragma("unroll") for (int n = 0; n < 2; ++n) _Pragma("unroll") for (int k = 0; k < 2; ++k) dst[n][k] = *(const PG8_LAS bf16x8*)(lds + PG8_SB(b, h) + boff + n * 2048 + k * 1024); } while (0)
#define PG8_MMA(ai, bj, At, Bt) do { __builtin_amdgcn_s_setprio(1); _Pragma("unroll") for (int m = 0; m < 4; ++m) _Pragma("unroll") for (int n = 0; n < 2; ++n) _Pragma("unroll") for (int k = 0; k < 2; ++k) \
        acc[ai][bj][m][n] = __builtin_amdgcn_mfma_f32_16x16x32_bf16(Bt[n][k], At[m][k], acc[ai][bj][m][n], 0, 0, 0); __builtin_amdgcn_s_setprio(0); } while (0)
#define PG8_WAIT_V(n) asm volatile("s_waitcnt vmcnt(" #n ")" ::: "memory")
#define PG8_WAIT_L(n) asm volatile("s_waitcnt lgkmcnt(" #n ")" ::: "memory")
#define PG8_BAR __builtin_amdgcn_s_barrier()
#define PG8_SCHED __builtin_amdgcn_sched_barrier(0)
    Unit cur, nxt; int ui = 0;
    if (!S.next(0, cur)) return;
    unsigned voffAh[2][2];
#pragma unroll
    for (int h = 0; h < 2; ++h)
#pragma unroll
        for (int i = 0; i < 2; ++i) {
            if constexpr (GATHER) { int R, C; stage_rc(tid * 16 + i * 8192, R, C); voffAh[h][i] = ((unsigned)cur.gidx[h * HALF + R] * (unsigned)K + (unsigned)C) * 2u; }
            else voffAh[h][i] = voffA[i] + (unsigned)h * (unsigned)hstep;
        }
    f32x4 acc[2][2][4][2];
#pragma unroll
    for (int a = 0; a < 2; ++a)
#pragma unroll
        for (int b = 0; b < 2; ++b)
#pragma unroll
            for (int m = 0; m < 4; ++m)
#pragma unroll
                for (int n = 0; n < 2; ++n) acc[a][b][m][n] = (f32x4){0.f, 0.f, 0.f, 0.f};
    bf16x8 At[4][2], B0[2][2], B1[2][2];
    const char* cA = cur.a; const char* cB = cur.b;
    S.a_ready(cur);
    if constexpr (SP2) {
        PG8_STAGE(PG8_SB(0, 0), cB, voffB); PG8_STAGE(PG8_SB(0, 1), cB + hstep, voffB); PG8_STAGE_A(PG8_SA(0, 0), cA, 0); PG8_STAGE_A(PG8_SA(0, 1), cA, 1);
        if (wr == 1) PG8_BAR;
        PG8_WAIT_V(2); PG8_BAR;
        PG8_STAGE(PG8_SB(1, 0), cB + kstep, voffB); PG8_STAGE_A(PG8_SA(1, 0), cA + kstep, 0); PG8_STAGE(PG8_SB(1, 1), cB + hstep + kstep, voffB);
        PG8_WAIT_V(6); PG8_BAR;
    } else {
        PG8_STAGE(PG8_SB(0, 0), cB, voffB); PG8_STAGE_A(PG8_SA(0, 0), cA, 0); PG8_STAGE(PG8_SB(0, 1), cB + hstep, voffB); PG8_STAGE_A(PG8_SA(0, 1), cA, 1);
        if (wr == 1) PG8_BAR;
        PG8_WAIT_V(4); PG8_BAR;
        PG8_STAGE(PG8_SB(1, 0), cB + kstep, voffB); PG8_STAGE_A(PG8_SA(1, 0), cA + kstep, 0); PG8_STAGE(PG8_SB(1, 1), cB + hstep + kstep, voffB);
        PG8_WAIT_V(6); PG8_BAR;
    }
    for (;;) {
        const bool has_next = S.next(ui + 1, nxt);
        const char* nA = has_next ? nxt.a : cA; const char* nB = has_next ? nxt.b : cB;
        for (int t = 0; t < nt; t += 2) {
            const bool last = (t == nt - 2);
            const char* a1 = cA + (size_t)(t + 1) * kstep;
            const char* a2 = last ? nA : cA + (size_t)(t + 2) * kstep; const char* b2 = last ? nB : cB + (size_t)(t + 2) * kstep;
            const char* a3 = a2 + kstep; const char* b3 = b2 + kstep;
            if (last && has_next) S.a_ready(nxt);
            if constexpr (SP2) {
            PG8_LDB(B0, 0, 0); PG8_LDB(B1, 0, 1); PG8_SCHED; PG8_LDA(At, 0, 0); PG8_STAGE_A(PG8_SA(1, 1), a1, 1);
            PG8_WAIT_V(8); PG8_WAIT_L(0); PG8_BAR; PG8_MMA(0, 0, At, B0); PG8_MMA(0, 1, At, B1); PG8_BAR; PG8_SCHED;
            PG8_LDA(At, 0, 1); PG8_STAGE(PG8_SB(0, 0), b2, voffB); PG8_STAGE(PG8_SB(0, 1), b2 + hstep, voffB); PG8_STAGE_A(PG8_SA(0, 0), a2, 0);
            PG8_WAIT_V(8); PG8_WAIT_L(0); PG8_BAR; PG8_MMA(1, 0, At, B0); PG8_MMA(1, 1, At, B1); PG8_BAR; PG8_SCHED;
            PG8_LDB(B0, 1, 0); PG8_LDB(B1, 1, 1); PG8_SCHED; PG8_LDA(At, 1, 0); PG8_STAGE_A(PG8_SA(0, 1), a2, 1);
            PG8_WAIT_V(8); PG8_WAIT_L(0); PG8_BAR; PG8_MMA(0, 0, At, B0); PG8_MMA(0, 1, At, B1); PG8_BAR; PG8_SCHED;
            PG8_LDA(At, 1, 1); PG8_STAGE(PG8_SB(1, 0), b3, voffB); PG8_STAGE(PG8_SB(1, 1), b3 + hstep, voffB); PG8_STAGE_A(PG8_SA(1, 0), a3, 0);
            PG8_WAIT_V(8); PG8_WAIT_L(0); PG8_BAR; PG8_MMA(1, 0, At, B0); PG8_MMA(1, 1, At, B1); PG8_BAR; PG8_SCHED;
            } else {
            PG8_LDB(B0, 0, 0); PG8_SCHED; PG8_LDA(At, 0, 0); PG8_STAGE_A(PG8_SA(1, 1), a1, 1);
            PG8_WAIT_L(8); PG8_BAR; PG8_WAIT_L(0); PG8_MMA(0, 0, At, B0); PG8_BAR; PG8_SCHED;
            PG8_LDB(B1, 0, 1); PG8_STAGE(PG8_SB(0, 0), b2, voffB);
            PG8_BAR; PG8_WAIT_L(0); PG8_MMA(0, 1, At, B1); PG8_BAR;
            PG8_LDA(At, 0, 1); PG8_STAGE_A(PG8_SA(0, 0), a2, 0);
            PG8_BAR; PG8_WAIT_L(0); PG8_MMA(1, 0, At, B0); PG8_BAR; PG8_SCHED;
            PG8_STAGE(PG8_SB(0, 1), b2 + hstep, voffB);
            PG8_WAIT_V(6); PG8_BAR; PG8_MMA(1, 1, At, B1); PG8_BAR;
            PG8_LDB(B0, 1, 0); PG8_SCHED; PG8_LDA(At, 1, 0); PG8_STAGE_A(PG8_SA(0, 1), a2, 1);
            PG8_WAIT_L(8); PG8_BAR; PG8_WAIT_L(0); PG8_MMA(0, 0, At, B0); PG8_BAR; PG8_SCHED;
            PG8_LDB(B1, 1, 1); PG8_STAGE(PG8_SB(1, 0), b3, voffB);
            PG8_BAR; PG8_WAIT_L(0); PG8_MMA(0, 1, At, B1); PG8_BAR;
            PG8_LDA(At, 1, 1); PG8_STAGE_A(PG8_SA(1, 0), a3, 0);
            PG8_BAR; PG8_WAIT_L(0); PG8_MMA(1, 0, At, B0); PG8_BAR; PG8_SCHED;
            PG8_STAGE(PG8_SB(1, 1), b3 + hstep, voffB);
            PG8_WAIT_V(6); PG8_BAR; PG8_MMA(1, 1, At, B1); PG8_BAR;
            }
        }
        if constexpr (ALIGN_EPI) { if (wr == 0) PG8_BAR; }
        if constexpr (!Epi::AFTER_DRAIN) { E(acc, cur, wr, wc, fr, fq); S.done(cur); }
        if (!has_next) break;
#pragma unroll
        for (int a = 0; a < 2; ++a)
#pragma unroll
            for (int b = 0; b < 2; ++b)
#pragma unroll
                for (int m = 0; m < 4; ++m)
#pragma unroll
                    for (int n = 0; n < 2; ++n) acc[a][b][m][n] = (f32x4){0.f, 0.f, 0.f, 0.f};
        cur = nxt; cA = nA; cB = nB; ++ui;
        if constexpr (ALIGN_EPI) { if (wr == 1) PG8_BAR; }
    }
    PG8_WAIT_V(0);
    if constexpr (!ALIGN_EPI) { if (wr == 0) PG8_BAR; }
    PG8_BAR;
    if constexpr (Epi::AFTER_DRAIN) { E.fused(acc, cur, wr, wc, fr, fq, lds, wid, lane); S.done(cur); }
#undef PG8_SA
#undef PG8_SB
#undef PG8_STAGE
#undef PG8_LDA
#undef PG8_LDB
#undef PG8_MMA
#undef PG8_WAIT_V
#undef PG8_WAIT_L
#undef PG8_BAR
#undef PG8_SCHED
}
}
using pg8::Unit; using pg8::tile_of;

__device__ __forceinline__ void ph_prep(const P& p, float* lds) {
    const int tid = opaque_tid(), G = gridDim.x;
    float* ADA = (float*)(p.ws + WS_ADA);
    float* LB = (float*)(p.ws + WS_LB);
    float* HID2 = (float*)(p.ws + WS_HID2);
    {
        float* s = lds;
        float* red = lds + 17 * 1024;
        if (blockIdx.x < 192) {
            for (int i = tid; i < 17 * 1024; i += NT) {
                const int r = i >> 10, d = i & 1023;
                const float cv = r < 16 ? p.c[r * 1024 + d] : p.c_ctx[d];
                s[i] = siluf_(cv);
            }
        }
        __syncthreads();
        for (int item = blockIdx.x; item < 192; item += G) {
            const int jj = tid & 31, ks = tid >> 5, j = item * 32 + jj;
            float acc[17];
#pragma unroll
            for (int r = 0; r < 17; ++r) acc[r] = 0.f;
            for (int d0 = ks * 64; d0 < ks * 64 + 64; d0 += 16) {
                float wv[16];
#pragma unroll
                for (int q = 0; q < 16; ++q) wv[q] = p.ada_w[(size_t)(d0 + q) * 6144 + j];
#pragma unroll
                for (int q = 0; q < 16; ++q)
#pragma unroll
                    for (int r = 0; r < 17; ++r) acc[r] += s[r * 1024 + d0 + q] * wv[q];
            }
#pragma unroll
            for (int r = 0; r < 17; ++r) red[(ks * 17 + r) * 32 + jj] = acc[r];
            __syncthreads();
            for (int i = tid; i < 17 * 32; i += NT) {
                const int r = i >> 5, j2 = i & 31;
                float sum = 0.f;
#pragma unroll
                for (int k = 0; k < 16; ++k) sum += red[(k * 17 + r) * 32 + j2];
                ADA[r * 6144 + item * 32 + j2] = sum + p.ada_b[item * 32 + j2];
            }
            __syncthreads();
        }
    }
    if (blockIdx.x == G - 1) {
        for (int i = tid; i < 1024; i += NT) {
            const float a0 = p.hg_lb[i], a1 = p.hg_lb[1024 + i];
            LB[i] = 1.f / (1.f + expf(a1 - a0));
        }
    }
    {
        float* zl = lds;
        float* h1 = lds + 512;
        __syncthreads();
        for (int it = (G - 1 - blockIdx.x); it < SEQ / 8; it += G) {
            const int lt = tid >> 6, j = tid & 63, t = it * 8 + lt;
            const float w = 6.283185307179586f * (float)t / 2048.0f;
            if (j == 0) zl[lt * 64] = (float)t / 2047.0f;
            if (j >= 1 && j < 17) { const float f = 1e-4f + (float)(j - 1) * ((15.0f - 1e-4f) / 15.0f); zl[lt * 64 + j] = cosf(f * w); }
            if (j >= 17 && j < 33) { const float f = 1e-4f + (float)(j - 17) * ((15.0f - 1e-4f) / 15.0f); zl[lt * 64 + j] = -sinf(f * w); }
            __syncthreads();
            float a = p.pos_b1[j];
            for (int i = 0; i < 33; ++i) a += zl[lt * 64 + i] * p.pos_w1[i * 64 + j];
            h1[lt * 64 + j] = sinf(p.freq1[j] * a);
            __syncthreads();
            float b = p.pos_b2[j];
            for (int i = 0; i < 64; ++i) b += h1[lt * 64 + i] * p.pos_w2[i * 64 + j];
            HID2[t * 64 + j] = sinf(p.freq2[j] * b);
            __syncthreads();
        }
    }
}
struct ConvItem { const float* W; bf16_t* dst; int N, KD, k0, n0, which; };
__device__ __forceinline__ ConvItem conv_small_item(const P& p, int it) {
    ConvItem c; c.which = 0; c.KD = D;
    if (it < 256) { c.W = p.w_in; c.N = INC; c.k0 = (it / 16) * 64; c.n0 = (it % 16) * 256; c.dst = (bf16_t*)((unsigned char*)p.out + DO_WINT); }
    else { const int r = it - 256; c.W = p.w_out; c.N = D; c.k0 = (r / 4) * 64; c.n0 = (r % 4) * 256; c.dst = (bf16_t*)(p.ws + WS_WOUTT); }
    return c;
}
constexpr int N_EXPERT_ITEMS = 2 * 16 * 16 * 8 + 16 * 32 * 4;
__device__ __forceinline__ ConvItem conv_expert_item(const P& p, int r) {
    ConvItem c; constexpr int I_W1 = 16 * 16 * 8;
    if (r < 2 * I_W1) {
        const int which = r / I_W1; r %= I_W1;
        const int e = r / 128, r2 = r % 128;
        c.W = (which == 0 ? p.exp_w1 : p.exp_w3) + (size_t)e * D * FF; c.N = FF; c.k0 = (r2 / 8) * 64; c.n0 = (r2 % 8) * 256; c.dst = (bf16_t*)(p.ws + WS_W13T) + (size_t)e * 4096 * D; c.KD = D; c.which = 1 + which;
    } else {
        r -= 2 * I_W1; const int e = r / 128, r2 = r % 128;
        c.W = p.exp_w2 + (size_t)e * FF * D; c.N = D; c.k0 = (r2 / 4) * 64; c.n0 = (r2 % 4) * 256; c.dst = (bf16_t*)(p.ws + WS_W2T) + (size_t)e * 1024 * FF; c.KD = FF; c.which = 0;
    }
    return c;
}
__device__ __forceinline__ void conv_load(const ConvItem& c, f32x4_t (&v)[8], int tid) {
#pragma unroll
    for (int q = 0; q < 8; ++q) { const int i = tid + NT * q, k = i >> 6, n4 = i & 63; v[q] = *(const f32x4_t*)(c.W + (size_t)(c.k0 + k) * c.N + c.n0 + 4 * n4); }
}
__device__ __forceinline__ void conv_tile_write(const f32x4_t (&v)[8], float* T, int tid) {
#pragma unroll
    for (int q = 0; q < 8; ++q) { const int i = tid + NT * q, k = i >> 6, n4 = i & 63; *(f32x4_t*)&T[k * 260 + 4 * (n4 ^ ((k >> 3) & 7))] = v[q]; }
}
__device__ __forceinline__ void conv_tile_store(const ConvItem& c, const float* T, int tid) {
#pragma unroll
    for (int q = 0; q < 4; ++q) { const int i = tid + NT * q, nl = i >> 3, ch = i & 7, n = c.n0 + nl;
        float a[8];
#pragma unroll
        for (int e = 0; e < 8; ++e) a[e] = T[(8 * ch + e) * 260 + (nl ^ (ch << 2))];
        const int row = c.which == 0 ? n : ((n >> 7) * 256 + (c.which - 1) * 128 + (n & 127));
        *(uint4*)(c.dst + (size_t)row * c.KD + c.k0 + 8 * ch) = make_uint4(cvtpk(a[0], a[1]), cvtpk(a[2], a[3]), cvtpk(a[4], a[5]), cvtpk(a[6], a[7])); }
}
constexpr int CONV_DEPTH = 4;
template <class ITEMF>
__device__ __forceinline__ void conv_run(ITEMF item, int first, int count, float* T) {
    const int tid = opaque_tid();
    f32x4_t ring[CONV_DEPTH][8];
#pragma unroll
    for (int d = 0; d < CONV_DEPTH; ++d) { const ConvItem c = item(first + d); conv_load(c, ring[d], tid); }
    for (int i0 = 0; i0 < count; i0 += CONV_DEPTH) {
#pragma unroll
        for (int d = 0; d < CONV_DEPTH; ++d) {
            const int i = i0 + d;
            const ConvItem c = item(first + i);
            lds_barrier();
            conv_tile_write(ring[d], T, tid);
            lds_barrier();
            if (i + CONV_DEPTH < count) { const ConvItem cn = item(first + i + CONV_DEPTH); conv_load(cn, ring[d], tid); }
            conv_tile_store(c, T, tid);
        }
    }
}
__device__ __forceinline__ void ph_convert_small(const P& p, float* lds) {
    __syncthreads();
    if (blockIdx.x >= 96 && blockIdx.x < 96 + 80) conv_run([&](int it) { return conv_small_item(p, it); }, (blockIdx.x - 96) * 4, 4, lds);
}

__device__ __forceinline__ void ph_norm1(const P& p) {
    const int tid = opaque_tid(), lane = tid & 63, wv = tid >> 6;
    const float* ADA = (const float*)(p.ws + WS_ADA);
    bf16_t* H = (bf16_t*)(p.ws + WS_H);
    bf16_t* HC = (bf16_t*)(p.ws + WS_HC);
    auto run = [&](const float* src, bf16_t* dst, int ar, int nrows) {
        f32x4_t gm[4], hs[4];
#pragma unroll
        for (int j = 0; j < 4; ++j) { const int d4 = lane + 64 * j; const f32x4_t g = ((const f32x4_t*)p.norm1_g)[d4], s1 = ((const f32x4_t*)(ADA + ar * 6144 + 1024))[d4]; gm[j] = g * (1.f + s1); hs[j] = ((const f32x4_t*)(ADA + ar * 6144))[d4]; }
        f32x4_t v[4], vn[4];
#pragma unroll
        for (int j = 0; j < 4; ++j) v[j] = ((const f32x4_t*)src)[lane + 64 * j];
        for (int ri = 0; ri < nrows; ++ri) {
            if (ri + 1 < nrows) {
#pragma unroll
                for (int j = 0; j < 4; ++j) vn[j] = ((const f32x4_t*)(src + (size_t)(ri + 1) * D))[lane + 64 * j];
            }
            float ss = 0.f;
#pragma unroll
            for (int j = 0; j < 4; ++j) ss += v[j].x * v[j].x + v[j].y * v[j].y + v[j].z * v[j].z + v[j].w * v[j].w;
            const float rstd = rsqrtf(wave_sum(ss) * (1.f / D) + EPS);
#pragma unroll
            for (int j = 0; j < 4; ++j) { const f32x4_t o = v[j] * rstd * gm[j] + hs[j]; ((uint2*)(dst + (size_t)ri * D))[lane + 64 * j] = make_uint2(cvtpk(o.x, o.y), cvtpk(o.z, o.w)); }
#pragma unroll
            for (int j = 0; j < 4; ++j) v[j] = vn[j];
        }
    };
    for (int rc = blockIdx.x * 8 + wv; rc < NTOK / 16; rc += gridDim.x * 8) {
        run(p.x + (size_t)rc * 16 * D, H + (size_t)rc * 16 * D, (rc * 16) / SEQ, 16);
        run(p.ctx + (size_t)rc * 2 * D, HC + (size_t)rc * 2 * D, 16, 2);
    }
}
__device__ __forceinline__ void ph_filter(const P& p, float* lds) {
    const int tid = opaque_tid(), G = gridDim.x;
    const float* HID2 = (const float*)(p.ws + WS_HID2);
    float* HF = (float*)((unsigned char*)p.out + DO_HF);
    float* w3c = lds;
    float* red = lds + 512;
    const float min_decay = logf(1e-2f) / 1.5f, max_decay = logf(1e-2f) / 0.3f;
    for (int grp = blockIdx.x; grp < 256; grp += G) {
        const int item0 = grp * 4, o = item0 >> 9, c0 = item0 & 511;
        __syncthreads();
        { const int q = tid >> 7, dir = (tid >> 6) & 1, i = tid & 63; w3c[tid] = p.pos_w3[i * 2048 + o * 1024 + dir * 512 + c0 + q]; }
        __syncthreads();
        float hv[4][4][2]; float asum[4] = {0.f, 0.f, 0.f, 0.f};
#pragma unroll
        for (int j = 0; j < 4; ++j) {
            const int t = tid + NT * j;
            float r[4][2];
#pragma unroll
            for (int q = 0; q < 4; ++q) { r[q][0] = 0.f; r[q][1] = 0.f; }
            const float4* hp = (const float4*)(HID2 + t * 64);
#pragma unroll 4
            for (int i4 = 0; i4 < 16; ++i4) {
                const float4 h = hp[i4];
#pragma unroll
                for (int q = 0; q < 4; ++q)
#pragma unroll
                    for (int d = 0; d < 2; ++d) { const float* w = w3c + (q * 2 + d) * 64 + i4 * 4; r[q][d] += h.x * w[0] + h.y * w[1] + h.z * w[2] + h.w * w[3]; }
            }
            const float tl = (float)t / 2047.0f;
#pragma unroll
            for (int q = 0; q < 4; ++q) {
                const float delta = fabsf(min_decay + (float)(c0 + q) * ((max_decay - min_decay) / 511.0f));
                const float win = expf(-tl * delta) + 0.05f;
                hv[j][q][0] = r[q][0] * win; hv[j][q][1] = r[q][1] * win;
                asum[q] += fabsf(hv[j][q][0]) + (t >= 1 ? fabsf(hv[j][q][1]) : 0.f);
            }
        }
#pragma unroll
        for (int q = 0; q < 4; ++q) asum[q] = wave_sum(asum[q]);
        if ((tid & 63) == 0) { red[(tid >> 6) * 4 + 0] = asum[0]; red[(tid >> 6) * 4 + 1] = asum[1]; red[(tid >> 6) * 4 + 2] = asum[2]; red[(tid >> 6) * 4 + 3] = asum[3]; }
        __syncthreads();
#pragma unroll
        for (int q = 0; q < 4; ++q) {
            float tot = 0.f;
#pragma unroll
            for (int k = 0; k < 8; ++k) tot += red[k * 4 + q];
            const float inv = 1.f / (tot + EPS);
            float* dst = HF + (size_t)(item0 + q) * 4096;
#pragma unroll
            for (int j = 0; j < 4; ++j) {
                const int t = tid + NT * j;
                dst[2047 + t] = hv[j][q][0] * inv;
                if (t >= 1) dst[2047 - t] = hv[j][q][1] * inv;
            }
            if (tid == 0) dst[4095] = 0.f;
        }
    }
}

struct InprojSched {
    int G, c; const bf16_t *WinT, *H, *HC; bf16_t *PHYT, *PHG, *PC;
    __device__ __forceinline__ bool next(int i, Unit& u) const {
        int L = i * G + c; int pm, pn;
        u.aux = nullptr; u.gidx = nullptr; u.row0 = 0; u.col0 = 0;
        if (L < 768) { tile_of(L, 6, 128, pm, pn); u.a = (const char*)(WinT + (size_t)pm * 256 * D); u.b = (const char*)(H + (size_t)pn * 256 * D); u.c = PHYT + (size_t)pm * 256 * NTOK + pn * 256; u.ldc = NTOK; return true; }
        L -= 768;
        if (L < 1280) { tile_of(L, 128, 10, pm, pn); u.a = (const char*)(H + (size_t)pm * 256 * D); u.b = (const char*)(WinT + (size_t)(1536 + pn * 256) * D); u.c = PHG + (size_t)pm * 256 * 2560 + pn * 256; u.ldc = 2560; return true; }
        L -= 1280;
        if (L < 96) { tile_of(L, 16, 6, pm, pn); u.a = (const char*)(HC + (size_t)pm * 256 * D); u.b = (const char*)(WinT + (size_t)(2048 + pn * 256) * D); u.c = PC + (size_t)pm * 256 * 1536 + pn * 256; u.ldc = 1536; return true; }
        return false;
    }
    __device__ __forceinline__ void a_ready(const Unit&) const {}
    __device__ __forceinline__ void done(const Unit&) const {}
};
__device__ __forceinline__ void ph_inproj(const P& p, unsigned char* lds) {
    InprojSched S{(int)gridDim.x, (int)blockIdx.x, (const bf16_t*)((unsigned char*)p.out + DO_WINT), (const bf16_t*)(p.ws + WS_H), (const bf16_t*)(p.ws + WS_HC),
                  (bf16_t*)((unsigned char*)p.out + DO_PHYT), (bf16_t*)(p.ws + WS_PHG), (bf16_t*)(p.ws + WS_PC)};
    pg8::EpiStoreBf16 E;
    pg8::gemm_phase<pg8::EpiStoreBf16, InprojSched, true, true, false>((PG8_LAS unsigned char*)lds, D, S, E);
}

namespace hy {
#define HY_LAS __attribute__((address_space(3)))
typedef short bf16x8 __attribute__((ext_vector_type(8)));
typedef float f32x4 __attribute__((ext_vector_type(4)));
typedef unsigned u32x4 __attribute__((ext_vector_type(4)));
typedef unsigned u32x2 __attribute__((ext_vector_type(2)));
constexpr int U_STRIDE = 4112, UIMG = 0, U_BYTES = 16 * U_STRIDE;
constexpr int FILT = U_BYTES, F_STRIDE = 8288, F_BYTES = 8 * F_STRIDE;
constexpr int SCR = FILT + F_BYTES;
static_assert(SCR + 8192 <= LDS_BYTES, "hyena LDS map");

__device__ __forceinline__ float uni(float v) { return __uint_as_float(__builtin_amdgcn_readfirstlane(__float_as_uint(v))); }
struct ConvW { float w0, w1, w2, b; };
__device__ __forceinline__ ConvW load_convw(const P& p, int ch) { ConvW c; c.w0 = uni(p.hy_conv_w[ch]); c.w1 = uni(p.hy_conv_w[1536 + ch]); c.w2 = uni(p.hy_conv_w[3072 + ch]); c.b = uni(p.hy_conv_b[ch]); return c; }
__device__ __forceinline__ void load_u_image(const ConvW cw, HY_LAS unsigned char* L, const bf16_t* row, int tid) {
    const float cw0 = cw.w0, cw1 = cw.w1, cw2 = cw.w2, cb = cw.b;
#pragma unroll 2
    for (int k = 0; k < 8; ++k) {
        const int idx = tid + NT * k, b = idx >> 8, t8 = (idx & 255) * 8;
        const bf16_t* src = row + b * SEQ + t8;
        const u32x4 raw = *(const u32x4*)src;
        float x[10];
        x[0] = (t8 & 63) ? bf2f(src[-1]) : 0.f;
        x[9] = ((t8 + 8) & 63) ? bf2f(src[8]) : 0.f;
        x[1] = __uint_as_float(raw.x << 16); x[2] = __uint_as_float(raw.x & 0xffff0000u); x[3] = __uint_as_float(raw.y << 16); x[4] = __uint_as_float(raw.y & 0xffff0000u);
        x[5] = __uint_as_float(raw.z << 16); x[6] = __uint_as_float(raw.z & 0xffff0000u); x[7] = __uint_as_float(raw.w << 16); x[8] = __uint_as_float(raw.w & 0xffff0000u);
        float o[8];
#pragma unroll
        for (int e = 0; e < 8; ++e) o[e] = cb + cw1 * x[e + 1] + cw0 * x[e] + cw2 * x[e + 2];
        *(HY_LAS u32x4*)(L + UIMG + b * U_STRIDE + t8 * 2) = (u32x4){pk2(o[0], o[1]), pk2(o[2], o[3]), pk2(o[4], o[5]), pk2(o[6], o[7])};
    }
}
__device__ __forceinline__ void raw_rows_load(u32x4 (&r)[8], const bf16_t* row, int tid) {
#pragma unroll
    for (int k = 0; k < 8; ++k) { const int idx = tid + NT * k, b = idx >> 8, t8 = (idx & 255) * 8; r[k] = *(const u32x4*)(row + b * SEQ + t8); }
}
__device__ __forceinline__ void raw_rows_store(HY_LAS unsigned char* L, const u32x4 (&r)[8], int tid) {
#pragma unroll
    for (int k = 0; k < 8; ++k) {
        const int idx = tid + NT * k, b = idx >> 8, t8 = (idx & 255) * 8;
        HY_LAS unsigned char* d = L + FILT + b * U_STRIDE + 8 + t8 * 2;
        *(HY_LAS u32x2*)d = (u32x2){r[k].x, r[k].y}; *(HY_LAS u32x2*)(d + 8) = (u32x2){r[k].z, r[k].w};
    }
}
__device__ __forceinline__ void load_filter_scr(HY_LAS unsigned char* L, const float* hf, int tid) {
    const float4 a = ((const float4*)hf)[tid * 2], b = ((const float4*)hf)[tid * 2 + 1];
    *(HY_LAS u32x4*)(L + SCR + tid * 16) = (u32x4){pk2(a.x, a.y), pk2(a.z, a.w), pk2(b.x, b.y), pk2(b.z, b.w)};
}
__device__ __forceinline__ void build_filter_copies(HY_LAS unsigned char* L, int tid) {
    const HY_LAS bf16_t* sc = (const HY_LAS bf16_t*)(L + SCR);
    for (int gi = tid; gi < 8 * 518; gi += NT) {
        const int d = gi / 518, qg = gi - d * 518;
        const int top = 4095 + d - 8 * qg;
        unsigned v[8];
#pragma unroll
        for (int e = 0; e < 8; ++e) { const int ix = top - e; v[e] = (ix >= 0 && ix <= 4094) ? (unsigned)sc[ix] : 0u; }
        *(HY_LAS u32x4*)(L + FILT + d * F_STRIDE + qg * 16) = (u32x4){v[0] | (v[1] << 16), v[2] | (v[3] << 16), v[4] | (v[5] << 16), v[6] | (v[7] << 16)};
    }
}
__device__ __forceinline__ void conv_loop(HY_LAS unsigned char* L, f32x4 (&acc)[16], int w, int lane) {
    const int i = lane & 15, g = lane >> 4;
    const HY_LAS unsigned char* aBase = L + FILT + (i & 7) * F_STRIDE + 2 * (2048 + 8 * g - (i & ~7)) - 32 * (16 * w);
    const HY_LAS unsigned char* bBase = L + UIMG + i * U_STRIDE + 16 * g;
    bf16x8 ring[16];
#pragma unroll
    for (int s = 0; s < 16; ++s) ring[s] = *(const HY_LAS bf16x8*)(aBase - 32 * s);
#pragma unroll
    for (int m = 0; m < 16; ++m) acc[m] = (f32x4){0.f, 0.f, 0.f, 0.f};
    bf16x8 bfrag = *(const HY_LAS bf16x8*)(bBase);
    for (int k8 = 0; k8 < 8; ++k8) {
        const HY_LAS unsigned char* aK = aBase + 512 * k8;
        const HY_LAS unsigned char* bK = bBase + 512 * k8;
#pragma unroll
        for (int u = 0; u < 8; ++u) {
            bf16x8 bnext = bfrag;
            if (u < 7 || k8 < 7) bnext = *(const HY_LAS bf16x8*)(bK + 64 * (u + 1));
            acc[14] = __builtin_amdgcn_mfma_f32_16x16x32_bf16(ring[(14 - 2 * u) & 15], bfrag, acc[14], 0, 0, 0);
            acc[15] = __builtin_amdgcn_mfma_f32_16x16x32_bf16(ring[(15 - 2 * u) & 15], bfrag, acc[15], 0, 0, 0);
            if (u < 7 || k8 < 7) {
                ring[(14 - 2 * u) & 15] = *(const HY_LAS bf16x8*)(aK + 64 * u + 64);
                ring[(15 - 2 * u) & 15] = *(const HY_LAS bf16x8*)(aK + 64 * u + 32);
            }
#pragma unroll
            for (int m = 0; m < 14; ++m) acc[m] = __builtin_amdgcn_mfma_f32_16x16x32_bf16(ring[(m - 2 * u) & 15], bfrag, acc[m], 0, 0, 0);
            bfrag = bnext;
            __builtin_amdgcn_sched_barrier(0);
        }
    }
}
__device__ __forceinline__ void gate_acc(const ConvW cw, HY_LAS unsigned char* L, f32x4 (&acc)[16], float bias, int w, int lane) {
    const int j = lane & 15, g = lane >> 4;
    const float cw0 = cw.w0, cw1 = cw.w1, cw2 = cw.w2, cb = cw.b;
#pragma unroll
    for (int m = 0; m < 16; ++m) {
        const int t4 = 256 * w + 16 * m + 4 * g, tt0 = t4 & 63;
        const u32x2 uu = *(const HY_LAS u32x2*)(L + UIMG + j * U_STRIDE + t4 * 2);
        const HY_LAS unsigned char* xb = L + FILT + j * U_STRIDE + 8 + t4 * 2;
        const u32x2 xx = *(const HY_LAS u32x2*)xb;
        const float xl = tt0 > 0 ? bf2f(*(const HY_LAS bf16_t*)(xb - 2)) : 0.f;
        const float xr = tt0 < 60 ? bf2f(*(const HY_LAS bf16_t*)(xb + 8)) : 0.f;
        const float x0 = __uint_as_float(xx.x << 16), x1 = __uint_as_float(xx.x & 0xffff0000u), x2 = __uint_as_float(xx.y << 16), x3 = __uint_as_float(xx.y & 0xffff0000u);
        const float u0 = __uint_as_float(uu.x << 16), u1 = __uint_as_float(uu.x & 0xffff0000u), u2 = __uint_as_float(uu.y << 16), u3 = __uint_as_float(uu.y & 0xffff0000u);
        const float g0 = cb + cw1 * x0 + cw0 * xl + cw2 * x1, g1 = cb + cw1 * x1 + cw0 * x0 + cw2 * x2, g2 = cb + cw1 * x2 + cw0 * x1 + cw2 * x3, g3 = cb + cw1 * x3 + cw0 * x2 + cw2 * xr;
        acc[m][0] = g0 * (acc[m][0] + bias * u0); acc[m][1] = g1 * (acc[m][1] + bias * u1); acc[m][2] = g2 * (acc[m][2] + bias * u2); acc[m][3] = g3 * (acc[m][3] + bias * u3);
        if ((m & 3) == 3) __builtin_amdgcn_sched_barrier(0);
    }
}
__device__ __forceinline__ void store_acc_uimg(HY_LAS unsigned char* L, const f32x4 (&acc)[16], int w, int lane) {
    const int j = lane & 15, g = lane >> 4;
#pragma unroll
    for (int m = 0; m < 16; ++m) {
        const int t4 = 256 * w + 16 * m + 4 * g;
        *(HY_LAS u32x2*)(L + UIMG + j * U_STRIDE + t4 * 2) = (u32x2){pk2(acc[m][0], acc[m][1]), pk2(acc[m][2], acc[m][3])};
    }
}
}

__device__ __forceinline__ void ph_hyena_task(const P& p, unsigned char* ldsb, int c) {
    const int w = __builtin_amdgcn_readfirstlane(threadIdx.x >> 6);
    const bf16_t* PHYT = (const bf16_t*)((unsigned char*)p.out + DO_PHYT);
    bf16_t* YT = (bf16_t*)(p.ws + WS_YT);
    const float* HF = (const float*)((unsigned char*)p.out + DO_HF);
    HY_LAS unsigned char* L = (HY_LAS unsigned char*)ldsb;
    {
        const int tid = opaque_tid();
        const int lane = tid & 63;
        hy::f32x4 acc[16];
        const hy::ConvW cwv = hy::load_convw(p, c), cwx1 = hy::load_convw(p, 512 + c), cwx2 = hy::load_convw(p, 1024 + c);
        const float bias0 = hy::uni(p.hy_bias[c]), bias1 = hy::uni(p.hy_bias[512 + c]);
        __syncthreads();
        hy::load_u_image(cwv, L, PHYT + (size_t)c * NTOK, tid);
        hy::load_filter_scr(L, HF + (size_t)c * 4096, tid);
        __syncthreads();
        hy::build_filter_copies(L, tid);
        __syncthreads();
        hy::u32x4 rawx[8];
        hy::raw_rows_load(rawx, PHYT + (size_t)(512 + c) * NTOK, tid);
        hy::load_filter_scr(L, HF + (size_t)(512 + c) * 4096, tid);
        hy::conv_loop(L, acc, w, lane);
        __syncthreads();
        hy::raw_rows_store(L, rawx, tid);
        __syncthreads();
        hy::gate_acc(cwx1, L, acc, bias0, w, lane);
        __syncthreads();
        hy::store_acc_uimg(L, acc, w, lane);
        hy::build_filter_copies(L, tid);
        __syncthreads();
        hy::raw_rows_load(rawx, PHYT + (size_t)(1024 + c) * NTOK, tid);
        hy::conv_loop(L, acc, w, lane);
        __syncthreads();
        hy::raw_rows_store(L, rawx, tid);
        __syncthreads();
        hy::gate_acc(cwx2, L, acc, bias1, w, lane);
        hy::store_acc_uimg(L, acc, w, lane);
        __syncthreads();
#pragma unroll 2
        for (int k = 0; k < 8; ++k) {
            const int idx = tid + NT * k, b = idx >> 8, t8 = (idx & 255) * 8;
            *(hy::u32x4*)(YT + (size_t)c * NTOK + b * SEQ + t8) = *(const HY_LAS hy::u32x4*)(L + hy::UIMG + b * hy::U_STRIDE + t8 * 2);
        }
    }
}


namespace hg {
#define HG_LAS __attribute__((address_space(3)))
typedef short bf16x8 __attribute__((ext_vector_type(8)));
typedef float f32x4 __attribute__((ext_vector_type(4)));
typedef unsigned u32x4 __attribute__((ext_vector_type(4)));
typedef unsigned u32x2 __attribute__((ext_vector_type(2)));
constexpr int QROW = 272, KROW = 40;
constexpr int O_QT = 0, O_KBAR = 16 * QROW, O_KHAT = 2 * 16 * QROW, O_VT = O_KHAT + 128 * KROW, O_BDEC = O_VT + 128 * KROW, SET_BYTES = O_BDEC + 512;
constexpr int NCH_CTX = CTXL / 16, NCH = NCH_CTX + SEQ / 16;
template <int CTRL> __device__ __forceinline__ float dpp_mul(float x) {
    return x * __uint_as_float(__builtin_amdgcn_update_dpp(0x3f800000u, __float_as_uint(x), CTRL, 0xf, 0xf, false));
}
struct Raw { unsigned short q[4], v[4], z[4]; };
}

__device__ __forceinline__ void ph_hgrn_task(const P& p, unsigned char* ldsb, int item) {
    using namespace hg;
    const int tid = opaque_tid();
    const int lane = tid & 63, w = __builtin_amdgcn_readfirstlane(tid >> 6), j = lane & 15, g = lane >> 4;
    const int dir = item & 1, h = (item >> 1) & 3, b = item >> 3;
    const float* LB = (const float*)(p.ws + WS_LB);
    const bf16_t* PC = (const bf16_t*)(p.ws + WS_PC);
    const bf16_t* PHG = (const bf16_t*)(p.ws + WS_PHG);
    bf16_t* OFB = (bf16_t*)(p.ws + WS_OFB) + (size_t)dir * NTOK * 512;
    HG_LAS unsigned char* L = (HG_LAS unsigned char*)ldsb;
    float lb0[2], lb1[2];
#pragma unroll
    for (int pp = 0; pp < 2; ++pp) { const float2 t = *(const float2*)(LB + dir * 512 + h * 128 + 16 * w + 8 * pp + 2 * g); lb0[pp] = t.x; lb1[pp] = t.y; }
    const int zoff_c = dir == 0 ? 512 : 1024, zoff_l = dir == 0 ? 1024 : 1536;
    const bf16_t* rowc = PC + (size_t)b * CTXL * 1536 + h * 128 + 16 * w + 2 * g;
    const bf16_t* rowl = PHG + (size_t)b * SEQ * 2560 + h * 128 + 16 * w + 2 * g;
    struct Raw2 { unsigned q[2], v[2], z[2]; };
    auto load_raw = [&](int n, Raw2& r) {
        if (n < NCH_CTX) {
            const int tt = 16 * n + j, t = dir == 0 ? tt : (CTXL - 1 - tt);
            const bf16_t* row = rowc + (size_t)t * 1536;
#pragma unroll
            for (int pp = 0; pp < 2; ++pp) { r.q[pp] = 0u; r.v[pp] = *(const unsigned*)(row + 8 * pp); r.z[pp] = *(const unsigned*)(row + zoff_c + 8 * pp); }
        } else {
            const int tt = 16 * (n - NCH_CTX) + j, t = dir == 0 ? tt : (SEQ - 1 - tt);
            const bf16_t* row = rowl + (size_t)t * 2560;
#pragma unroll
            for (int pp = 0; pp < 2; ++pp) { r.q[pp] = *(const unsigned*)(row + 8 * pp); r.v[pp] = *(const unsigned*)(row + 512 + 8 * pp); r.z[pp] = *(const unsigned*)(row + zoff_l + 8 * pp); }
        }
    };
    const int qoff = j * QROW + 2 * (16 * w + 2 * g), koff = (16 * w + 2 * g) * KROW + 2 * j;
    auto prep_pass = [&](const Raw2& r, HG_LAS unsigned char* S0, const int pp) {
        {
            const float za = __uint_as_float(r.z[pp] << 16), zb = __uint_as_float(r.z[pp] & 0xffff0000u);
            const float qa = __uint_as_float(r.q[pp] << 16), qb = __uint_as_float(r.q[pp] & 0xffff0000u);
            const float fa = lb0[pp] + (1.0f - lb0[pp]) * __builtin_amdgcn_rcpf(1.0f + __builtin_amdgcn_exp2f(-1.4426950408889634f * za));
            const float fb = lb1[pp] + (1.0f - lb1[pp]) * __builtin_amdgcn_rcpf(1.0f + __builtin_amdgcn_exp2f(-1.4426950408889634f * zb));
            float Pa = dpp_mul<0x111>(fa), Pb = dpp_mul<0x111>(fb);
            Pa = dpp_mul<0x112>(Pa); Pb = dpp_mul<0x112>(Pb); Pa = dpp_mul<0x114>(Pa); Pb = dpp_mul<0x114>(Pb); Pa = dpp_mul<0x118>(Pa); Pb = dpp_mul<0x118>(Pb);
            const float Ca = __uint_as_float(__builtin_amdgcn_ds_bpermute(4 * (lane | 15), __float_as_uint(Pa)));
            const float Cb = __uint_as_float(__builtin_amdgcn_ds_bpermute(4 * (lane | 15), __float_as_uint(Pb)));
            const float ia = __builtin_amdgcn_rcpf(fmaxf(Pa, 1e-30f)), ib = __builtin_amdgcn_rcpf(fmaxf(Pb, 1e-30f));
            const float ka = (1.0f - fa) * ia, kb = (1.0f - fb) * ib;
            const float qva = qa * __builtin_amdgcn_rcpf(1.0f + __builtin_amdgcn_exp2f(-1.4426950408889634f * qa)) * (0.08838834764831845f * Pa);
            const float qvb = qb * __builtin_amdgcn_rcpf(1.0f + __builtin_amdgcn_exp2f(-1.4426950408889634f * qb)) * (0.08838834764831845f * Pb);
            *(HG_LAS unsigned*)(S0 + O_QT + qoff + 16 * pp) = cvtpk(qva, qvb);
            *(HG_LAS unsigned*)(S0 + O_KBAR + qoff + 16 * pp) = cvtpk(ka, kb);
            const unsigned kh = cvtpk(ka * Ca, kb * Cb);
            *(HG_LAS bf16_t*)(S0 + O_KHAT + koff + 8 * pp * KROW) = (bf16_t)(kh & 0xffffu);
            *(HG_LAS bf16_t*)(S0 + O_KHAT + koff + (8 * pp + 1) * KROW) = (bf16_t)(kh >> 16);
            *(HG_LAS bf16_t*)(S0 + O_VT + koff + 8 * pp * KROW) = (bf16_t)(r.v[pp] & 0xffffu);
            *(HG_LAS bf16_t*)(S0 + O_VT + koff + (8 * pp + 1) * KROW) = (bf16_t)(r.v[pp] >> 16);
            if (j == 15) { typedef float f32x2_t __attribute__((ext_vector_type(2))); *(HG_LAS f32x2_t*)(S0 + O_BDEC + 4 * (16 * w + 8 * pp + 2 * g)) = (f32x2_t){Pa, Pb}; }
        }
    };
    auto prep = [&](const Raw2& r, HG_LAS unsigned char* S0) { prep_pass(r, S0, 0); prep_pass(r, S0, 1); };
    const float mk0 = (4 * g + 0) <= j ? 1.f : 0.f, mk1 = (4 * g + 1) <= j ? 1.f : 0.f, mk2 = (4 * g + 2) <= j ? 1.f : 0.f, mk3 = (4 * g + 3) <= j ? 1.f : 0.f;
    const int sc_off = j * QROW + 16 * g, vt_off = (16 * w + j) * KROW + 8 * g, qt8_off = j * QROW + 8 * g, kh_off = j * KROW + 8 * g;
    bf16_t* orow = OFB + (size_t)b * SEQ * 512 + h * 128 + 16 * w + 4 * g;
    f32x4 S[8];
#pragma unroll
    for (int t = 0; t < 8; ++t) S[t] = (f32x4){0.f, 0.f, 0.f, 0.f};
    constexpr int RDEPTH = 4;
    static_assert(NCH % RDEPTH == 0, "chunk loop is unrolled by the prefetch depth");
    Raw2 ring[RDEPTH];
    load_raw(0, ring[0]);
    __syncthreads();
    prep(ring[0], L);
#pragma unroll
    for (int c = 1; c <= RDEPTH; ++c) load_raw(c, ring[c % RDEPTH]);
    __syncthreads();
    auto chunk = [&](int n, int phase, Raw2& slot) {
        HG_LAS unsigned char* Sc = L + (n & 1) * SET_BYTES;
        HG_LAS unsigned char* Sn = L + ((n + 1) & 1) * SET_BYTES;
        bf16x8 kaf[4], qaf[4]; u32x2 qb0[4], qb1[4], krf[8]; f32x4 bdf[8];
#pragma unroll
        for (int kp = 0; kp < 4; ++kp) { kaf[kp] = *(const HG_LAS bf16x8*)(Sc + O_KBAR + sc_off + 64 * kp); qaf[kp] = *(const HG_LAS bf16x8*)(Sc + O_QT + sc_off + 64 * kp); }
        const u32x2 vraw = *(const HG_LAS u32x2*)(Sc + O_VT + vt_off);
#pragma unroll
        for (int pq = 0; pq < 4; ++pq) { qb0[pq] = *(const HG_LAS u32x2*)(Sc + O_QT + qt8_off + 64 * pq); qb1[pq] = *(const HG_LAS u32x2*)(Sc + O_QT + qt8_off + 64 * pq + 32); }
#pragma unroll
        for (int t = 0; t < 8; ++t) { bdf[t] = *(const HG_LAS f32x4*)(Sc + O_BDEC + 64 * t + 16 * g); krf[t] = *(const HG_LAS u32x2*)(Sc + O_KHAT + kh_off + 16 * KROW * t); }
        __builtin_amdgcn_sched_barrier(0);
        const u32x4 vf = (u32x4){vraw.x, vraw.y, 0u, 0u};
        f32x4 sc = (f32x4){0.f, 0.f, 0.f, 0.f};
#pragma unroll
        for (int kp = 0; kp < 4; ++kp) sc = __builtin_amdgcn_mfma_f32_16x16x32_bf16(kaf[kp], qaf[kp], sc, 0, 0, 0);
        f32x4 oT = (f32x4){0.f, 0.f, 0.f, 0.f};
#pragma unroll
        for (int pq = 0; pq < 4; ++pq) {
            u32x4 a; a.x = cvtpk(S[2 * pq][0], S[2 * pq][1]); a.y = cvtpk(S[2 * pq][2], S[2 * pq][3]); a.z = cvtpk(S[2 * pq + 1][0], S[2 * pq + 1][1]); a.w = cvtpk(S[2 * pq + 1][2], S[2 * pq + 1][3]);
            const u32x4 bb = (u32x4){qb0[pq].x, qb0[pq].y, qb1[pq].x, qb1[pq].y};
            oT = __builtin_amdgcn_mfma_f32_16x16x32_bf16(__builtin_bit_cast(bf16x8, a), __builtin_bit_cast(bf16x8, bb), oT, 0, 0, 0);
        }
#pragma unroll
        for (int t = 0; t < 8; ++t) {
            const u32x4 ka = (u32x4){krf[t].x, krf[t].y, 0u, 0u};
            S[t] = __builtin_amdgcn_mfma_f32_16x16x32_bf16(__builtin_bit_cast(bf16x8, ka), __builtin_bit_cast(bf16x8, vf), S[t] * bdf[t], 0, 0, 0);
        }
        u32x4 pf;
        pf.x = cvtpk(sc[0] * mk0, sc[1] * mk1); pf.y = cvtpk(sc[2] * mk2, sc[3] * mk3); pf.z = 0u; pf.w = 0u;
        oT = __builtin_amdgcn_mfma_f32_16x16x32_bf16(__builtin_bit_cast(bf16x8, vf), __builtin_bit_cast(bf16x8, pf), oT, 0, 0, 0);
        if (n + 1 < NCH) prep(slot, Sn);
        if (n + 1 + RDEPTH < NCH) load_raw(n + 1 + RDEPTH, slot);
        if (n >= NCH_CTX) {
            const int tt = 16 * (n - NCH_CTX) + j, t = dir == 0 ? tt : (SEQ - 1 - tt);
            *(u32x2*)(orow + (size_t)t * 512) = (u32x2){cvtpk(oT[0], oT[1]), cvtpk(oT[2], oT[3])};
        }
        lds_barrier();
    };
    for (int n0 = 0; n0 < NCH; n0 += RDEPTH) {
#pragma unroll
        for (int u = 0; u < RDEPTH; ++u) chunk(n0 + u, u % 3, ring[(u + 1) % RDEPTH]);
    }
}

template <int QW = 0, bool DO_HGRN = true, bool DO_QUEUE = true, bool DO_HY = true, bool DO_CV = true>
__device__ __forceinline__ void ph_mixers(const P& p, unsigned char* ldsb) {
    unsigned* qhead = (unsigned*)(p.ws + WS_CTL) + CW_QHEAD + QW;
    HG_LAS unsigned* bc = (HG_LAS unsigned*)(ldsb + LDS_BYTES - 16);
    if (DO_HGRN && blockIdx.x < NB * HEADS * 2) ph_hgrn_task(p, ldsb, blockIdx.x);
    constexpr int N_CONV_WG = 48, ITEMS_PER_WG = N_EXPERT_ITEMS / N_CONV_WG;
    static_assert(N_EXPERT_ITEMS % N_CONV_WG == 0 && ITEMS_PER_WG % CONV_DEPTH == 0, "conversion split");
    if (DO_CV && blockIdx.x >= NB * HEADS * 2 && blockIdx.x < NB * HEADS * 2 + N_CONV_WG)
        conv_run([&](int r) { return conv_expert_item(p, r); }, (blockIdx.x - NB * HEADS * 2) * ITEMS_PER_WG, ITEMS_PER_WG, (float*)ldsb);
    if (!DO_QUEUE) return;
    for (;;) {
        __syncthreads();
        if (threadIdx.x == 0) *bc = atomicAdd(qhead, 1u);
        __syncthreads();
        const int c = (int)*bc;
        if (c >= 512) break;
        if (DO_HY) ph_hyena_task(p, ldsb, c);
    }
}

__device__ __forceinline__ void ph_mixprep(const P& p, float* lds) {
    const int tid = opaque_tid(), lane = tid & 63, wv = tid >> 6;
    const bf16_t* YT = (const bf16_t*)(p.ws + WS_YT);
    bf16_t* MIXA = (bf16_t*)(p.ws + WS_MIXA);
    bf16_t* yl = (bf16_t*)lds;
    float* part = lds + (512 * 72 * 2) / 4;
    typedef unsigned u32x4_t __attribute__((ext_vector_type(4)));
    u32x4_t tl[8];
    auto tload = [&](int tile) {
#pragma unroll
        for (int q = 0; q < 8; ++q) { const int i = tid + NT * q, row = i >> 3, ch = i & 7; tl[q] = *(const u32x4_t*)(YT + (size_t)row * NTOK + tile * 64 + ch * 8); }
    };
    if (blockIdx.x < NTOK / 64) tload(blockIdx.x);
    for (int tile = blockIdx.x; tile < NTOK / 64; tile += gridDim.x) {
        const int tok0 = tile * 64;
        __syncthreads();
#pragma unroll
        for (int q = 0; q < 8; ++q) { const int i = tid + NT * q, row = i >> 3, ch = i & 7; *(u32x4_t*)(yl + row * 72 + ch * 8) = tl[q]; }
        __syncthreads();
        if (tile + (int)gridDim.x < NTOK / 64) tload(tile + gridDim.x);
        const int tok = tid & 63, pt = tid >> 6;
        float ss = 0.f;
        for (int c = pt * 64; c < pt * 64 + 64; ++c) { const float v = bf2f(yl[c * 72 + tok]); ss += v * v; }
        part[pt * 64 + tok] = ss;
        __syncthreads();
        float tot = 0.f;
#pragma unroll
        for (int k = 0; k < 8; ++k) tot += part[k * 64 + tok];
        const float rstd = rsqrtf(tot * (1.f / 512.f) + EPS);
        bf16_t* dst = MIXA + (size_t)(tok0 + tok) * D + pt * 64;
#pragma unroll
        for (int j = 0; j < 8; ++j) {
            const f32x4_t ga = *(const f32x4_t*)(p.hy_norm_g + pt * 64 + j * 8), gb = *(const f32x4_t*)(p.hy_norm_g + pt * 64 + j * 8 + 4);
            const float gv[8] = {ga.x, ga.y, ga.z, ga.w, gb.x, gb.y, gb.z, gb.w};
            float o[8];
#pragma unroll
            for (int q = 0; q < 8; ++q) { const int c = pt * 64 + j * 8 + q; o[q] = bf2f(yl[c * 72 + tok]) * rstd * gv[q]; }
            *(uint4*)(dst + j * 8) = make_uint4(cvtpk(o[0], o[1]), cvtpk(o[2], o[3]), cvtpk(o[4], o[5]), cvtpk(o[6], o[7]));
        }
    }
    const bf16_t* OFB = (const bf16_t*)(p.ws + WS_OFB);
    const bf16_t* PHG = (const bf16_t*)(p.ws + WS_PHG);
    {
        const int hh = lane >> 4, k8 = (lane & 15) * 8, col = hh * 128 + k8;
        const f32x4_t ng0 = *(const f32x4_t*)(p.hg_norm_g + k8), ng1 = *(const f32x4_t*)(p.hg_norm_g + k8 + 4);
        struct Row3 { uint4 a, b, g; };
        auto ld = [&](int r) { Row3 x; x.a = *(const uint4*)(OFB + (size_t)r * 512 + col); x.b = *(const uint4*)(OFB + (size_t)NTOK * 512 + (size_t)r * 512 + col); x.g = *(const uint4*)(PHG + (size_t)r * 2560 + 2048 + col); return x; };
        for (int rc = blockIdx.x * 8 + wv; rc < NTOK / 16; rc += gridDim.x * 8) {
            Row3 cur = ld(rc * 16), nxt = cur;
            for (int ri = 0; ri < 16; ++ri) {
                const int r = rc * 16 + ri;
                if (ri + 1 < 16) nxt = ld(r + 1);
                const unsigned aw[4] = {cur.a.x, cur.a.y, cur.a.z, cur.a.w}, bw[4] = {cur.b.x, cur.b.y, cur.b.z, cur.b.w}, gw[4] = {cur.g.x, cur.g.y, cur.g.z, cur.g.w};
                float o[8]; float ss = 0.f;
#pragma unroll
                for (int q = 0; q < 4; ++q) { o[2 * q] = __uint_as_float(aw[q] << 16) + __uint_as_float(bw[q] << 16); o[2 * q + 1] = __uint_as_float(aw[q] & 0xffff0000u) + __uint_as_float(bw[q] & 0xffff0000u); ss += o[2 * q] * o[2 * q] + o[2 * q + 1] * o[2 * q + 1]; }
                ss += __shfl_xor(ss, 1); ss += __shfl_xor(ss, 2); ss += __shfl_xor(ss, 4); ss += __shfl_xor(ss, 8);
                const float rstd = rsqrtf(ss * (1.f / 128.f) + EPS);
                const float ngv[8] = {ng0.x, ng0.y, ng0.z, ng0.w, ng1.x, ng1.y, ng1.z, ng1.w};
                unsigned w[4];
#pragma unroll
                for (int q = 0; q < 4; ++q) { const float g0 = __uint_as_float(gw[q] << 16), g1 = __uint_as_float(gw[q] & 0xffff0000u);
                    w[q] = cvtpk(o[2 * q] * rstd * ngv[2 * q] * silu_f(g0), o[2 * q + 1] * rstd * ngv[2 * q + 1] * silu_f(g1)); }
                *(uint4*)(MIXA + (size_t)r * D + 512 + col) = make_uint4(w[0], w[1], w[2], w[3]);
                cur = nxt;
            }
        }
    }
}

struct OutprojSched {
    int G, c; const bf16_t *A, *Bt;
    __device__ __forceinline__ bool next(int i, Unit& u) const {
        const int L = i * G + c; if (L >= 512) return false; int pm, pn; tile_of(L, 128, 4, pm, pn);
        u.a = (const char*)(A + (size_t)pm * 256 * D); u.b = (const char*)(Bt + (size_t)pn * 256 * D); u.c = nullptr; u.aux = nullptr; u.gidx = nullptr; u.ldc = D; u.row0 = pm * 256; u.col0 = pn * 256; return true;
    }
    __device__ __forceinline__ void a_ready(const Unit&) const {}
    __device__ __forceinline__ void done(const Unit&) const {}
};
__device__ __forceinline__ void ph_outproj(const P& p, unsigned char* lds) {
    OutprojSched S{(int)gridDim.x, (int)blockIdx.x, (const bf16_t*)(p.ws + WS_MIXA), (const bf16_t*)(p.ws + WS_WOUTT)};
    pg8::EpiOutProj E{p.x, (const float*)(p.ws + WS_ADA), (bf16_t*)p.out};
    pg8::gemm_phase<pg8::EpiOutProj, OutprojSched, true, true, false>((PG8_LAS unsigned char*)lds, D, S, E);
}

__device__ __forceinline__ void ph_norm2_router(const P& p, float* ldsf) {
    typedef short bf16x8_t __attribute__((ext_vector_type(8)));
    const int tid = opaque_tid(), lane = tid & 63, wv = tid >> 6, j = lane & 15, g = lane >> 4;
    const float* ADA = (const float*)(p.ws + WS_ADA);
    const bf16_t* X1 = (const bf16_t*)p.out;
    bf16_t* H2 = (bf16_t*)(p.ws + WS_H2);
    float* AFF = (float*)(p.ws + WS_AFF);
    HG_LAS unsigned char* L = (HG_LAS unsigned char*)(unsigned char*)ldsf;
    constexpr int RS = 2064;
    constexpr int O_WH = 0, O_WL = 16 * RS, O_HH = 32 * RS, O_HL = 48 * RS, O_PL = 64 * RS;
    static_assert(O_PL + 8 * 256 * 4 <= LDS_BYTES - 64, "router LDS map");
    __syncthreads();
    for (int i = tid; i < D * 4; i += NT) {
        const int d = i >> 2, e4 = i & 3; const float4 w = ((const float4*)p.router_w)[i]; const float wv4[4] = {w.x, w.y, w.z, w.w};
#pragma unroll
        for (int q = 0; q < 4; ++q) { const unsigned hi = f2bf(wv4[q]); const float rem = wv4[q] - __uint_as_float(hi << 16);
            *(HG_LAS bf16_t*)(L + O_WH + (e4 * 4 + q) * RS + 2 * d) = (bf16_t)hi; *(HG_LAS bf16_t*)(L + O_WL + (e4 * 4 + q) * RS + 2 * d) = (bf16_t)f2bf(rem); }
    }
    auto ldrow = [&](int r, f32x4_t (&dst)[4]) {
#pragma unroll
        for (int q = 0; q < 4; ++q) { const uint2 w = ((const uint2*)(X1 + (size_t)r * (2 * D)))[lane + 64 * q]; dst[q] = (f32x4_t){__uint_as_float(w.x << 16), __uint_as_float(w.x & 0xffff0000u), __uint_as_float(w.y << 16), __uint_as_float(w.y & 0xffff0000u)}; }
    };
    for (int blk = blockIdx.x; blk < NTOK / 128; blk += gridDim.x) {
        const int rblk = blk * 128, b = rblk / SEQ;
        f32x4_t gm[4], hs[4];
#pragma unroll
        for (int q = 0; q < 4; ++q) { const int d4 = lane + 64 * q; const f32x4_t gg = ((const f32x4_t*)p.norm2_g)[d4], s1 = ((const f32x4_t*)(ADA + b * 6144 + 4096))[d4]; gm[q] = gg * (1.f + s1); hs[q] = ((const f32x4_t*)(ADA + b * 6144 + 3072))[d4]; }
        f32x4_t va[4], vb[4], na[4], nb[4];
        ldrow(rblk + 2 * wv, va); ldrow(rblk + 2 * wv + 1, vb);
        for (int grp = 0; grp < 8; ++grp) {
            const int r0 = rblk + grp * 16;
            if (grp + 1 < 8) { ldrow(r0 + 16 + 2 * wv, na); ldrow(r0 + 17 + 2 * wv, nb); }
#pragma unroll
            for (int half = 0; half < 2; ++half) {
                const int lr = 2 * wv + half, r = r0 + lr;
                float ss = 0.f;
#pragma unroll
                for (int q = 0; q < 4; ++q) { const f32x4_t v = half ? vb[q] : va[q]; ss += v.x * v.x + v.y * v.y + v.z * v.z + v.w * v.w; }
                const float rstd = rsqrtf(wave_sum(ss) * (1.f / D) + EPS);
#pragma unroll
                for (int q = 0; q < 4; ++q) {
                    const int d4 = lane + 64 * q;
                    const f32x4_t o = (half ? vb[q] : va[q]) * rstd * gm[q] + hs[q];
                    const unsigned h01 = cvtpk(o.x, o.y), h23 = cvtpk(o.z, o.w);
                    ((uint2*)(H2 + (size_t)r * D))[d4] = make_uint2(h01, h23);
                    const unsigned l01 = cvtpk(o.x - __uint_as_float(h01 << 16), o.y - __uint_as_float(h01 & 0xffff0000u)), l23 = cvtpk(o.z - __uint_as_float(h23 << 16), o.w - __uint_as_float(h23 & 0xffff0000u));
                    typedef unsigned u32x2_t __attribute__((ext_vector_type(2)));
                    *(HG_LAS u32x2_t*)(L + O_HH + lr * RS + 8 * d4) = (u32x2_t){h01, h23};
                    *(HG_LAS u32x2_t*)(L + O_HL + lr * RS + 8 * d4) = (u32x2_t){l01, l23};
                }
            }
            __syncthreads();
            f32x4_t acc = (f32x4_t){0.f, 0.f, 0.f, 0.f};
#pragma unroll
            for (int ks = 0; ks < 4; ++ks) {
                const int kb = 2 * (32 * (4 * wv + ks) + 8 * g);
                const bf16x8_t wh = *(const HG_LAS bf16x8_t*)(L + O_WH + j * RS + kb), wl = *(const HG_LAS bf16x8_t*)(L + O_WL + j * RS + kb);
                const bf16x8_t hh = *(const HG_LAS bf16x8_t*)(L + O_HH + j * RS + kb), hl = *(const HG_LAS bf16x8_t*)(L + O_HL + j * RS + kb);
                acc = __builtin_amdgcn_mfma_f32_16x16x32_bf16(wh, hh, acc, 0, 0, 0);
                acc = __builtin_amdgcn_mfma_f32_16x16x32_bf16(wh, hl, acc, 0, 0, 0);
                acc = __builtin_amdgcn_mfma_f32_16x16x32_bf16(wl, hh, acc, 0, 0, 0);
            }
#pragma unroll
            for (int r = 0; r < 4; ++r) *(HG_LAS float*)(L + O_PL + ((wv * 16 + 4 * g + r) * 16 + j) * 4) = acc[r];
            __syncthreads();
            if (tid < 256) {
                const int row = tid >> 4, e = tid & 15;
                float lgt = 0.f;
#pragma unroll
                for (int k = 0; k < 8; ++k) lgt += *(const HG_LAS float*)(L + O_PL + ((k * 16 + e) * 16 + row) * 4);
                float mx = lgt;
                mx = fmaxf(mx, __shfl_xor(mx, 1)); mx = fmaxf(mx, __shfl_xor(mx, 2)); mx = fmaxf(mx, __shfl_xor(mx, 4)); mx = fmaxf(mx, __shfl_xor(mx, 8));
                const float ex = expf(lgt - mx);
                float den = ex;
                den += __shfl_xor(den, 1); den += __shfl_xor(den, 2); den += __shfl_xor(den, 4); den += __shfl_xor(den, 8);
                const int r = r0 + row;
                AFF[((size_t)b * 16 + e) * SEQ + (r % SEQ)] = ex / den;
            }
            __syncthreads();
#pragma unroll
            for (int q = 0; q < 4; ++q) { va[q] = na[q]; vb[q] = nb[q]; }
        }
    }
}

__device__ __forceinline__ void ph_topk(const P& p, float* lds) {
    const int tid = opaque_tid(), lane = tid & 63, wv = tid >> 6;
    const float* AFF = (const float*)(p.ws + WS_AFF);
    int* IDX = (int*)(p.ws + WS_IDX);
    float* GATE = (float*)(p.ws + WS_GATE);
    int* INV = (int*)(p.ws + WS_INV);
    unsigned* hist = (unsigned*)lds;
    unsigned* ctl = hist + 256;
    unsigned* wtot = hist + 272;
    for (int item = blockIdx.x; item < NB * NE; item += gridDim.x) {
        const int b = item >> 4, e = item & 15;
        const uint4 kk = ((const uint4*)(AFF + (size_t)item * SEQ))[tid];
        const unsigned key[4] = {kk.x, kk.y, kk.z, kk.w};
        unsigned prefix = 0u, need = CAP;
#pragma unroll
        for (int pass = 3; pass >= 0; --pass) {
            __syncthreads();
            if (tid < 256) hist[tid] = 0u;
            __syncthreads();
#pragma unroll
            for (int q = 0; q < 4; ++q) {
                const bool in = (pass == 3) || ((key[q] >> (8 * (pass + 1))) == prefix);
                if (in) atomicAdd(&hist[(key[q] >> (8 * pass)) & 255u], 1u);
            }
            __syncthreads();
            if (wv == 0) {
                const uint4 h4 = ((const uint4*)hist)[lane];
                const unsigned loc = h4.x + h4.y + h4.z + h4.w;
                unsigned suf = loc;
#pragma unroll
                for (int o = 1; o < 64; o <<= 1) { const unsigned y = __shfl_down(suf, o); if (lane + o < 64) suf += y; }
                const unsigned above = suf - loc;
                unsigned c3 = above + h4.w, c2 = c3 + h4.z, c1 = c2 + h4.y, c0 = c1 + h4.x;
                int bin = -1; unsigned nneed = 0u;
                if (above < need && c0 >= need) {
                    if (c3 >= need) { bin = 4 * lane + 3; nneed = need - above; }
                    else if (c2 >= need) { bin = 4 * lane + 2; nneed = need - c3; }
                    else if (c1 >= need) { bin = 4 * lane + 1; nneed = need - c2; }
                    else { bin = 4 * lane; nneed = need - c1; }
                    ctl[0] = (prefix << 8) | (unsigned)bin; ctl[1] = nneed;
                }
            }
            __syncthreads();
            prefix = ctl[0]; need = ctl[1];
        }
        unsigned cgt = 0u, ceq = 0u;
#pragma unroll
        for (int q = 0; q < 4; ++q) { cgt += key[q] > prefix ? 1u : 0u; ceq += key[q] == prefix ? 1u : 0u; }
        unsigned sgt = cgt, seq = ceq;
#pragma unroll
        for (int o = 1; o < 64; o <<= 1) { const unsigned y1 = __shfl_up(sgt, o), y2 = __shfl_up(seq, o); if (lane >= o) { sgt += y1; seq += y2; } }
        if (lane == 63) { wtot[wv] = sgt; wtot[8 + wv] = seq; }
        __syncthreads();
        unsigned bgt = 0u, beq = 0u, ngt = 0u;
#pragma unroll
        for (int k = 0; k < 8; ++k) { const unsigned a = wtot[k], c = wtot[8 + k]; if (k < wv) { bgt += a; beq += c; } ngt += a; }
        unsigned rgt = bgt + sgt - cgt, req = beq + seq - ceq;
#pragma unroll
        for (int q = 0; q < 4; ++q) {
            const int t = 4 * tid + q; int slot = -1;
            if (key[q] > prefix) { slot = (int)rgt; ++rgt; }
            else if (key[q] == prefix) { if (req < need) slot = (int)(ngt + req); ++req; }
            if (slot >= 0) { IDX[item * CAP + slot] = t; GATE[item * CAP + slot] = __uint_as_float(key[q]); }
            INV[((size_t)b * SEQ + t) * 16 + e] = slot;
        }
    }
}

struct MoeUpSched {
    int G, c, round; const bf16_t *H2, *W13T; bf16_t* HMID; const int* IDX;
    __device__ __forceinline__ bool next(int i, Unit& u) const {
        if (i >= 4 || c >= 256) return false;
        const int x = c & 7, q = c >> 3, Q = q >> 2, mth = q & 3, item = (Q * 4 + ((round & 1) * 2 + (round >> 1))) * 8 + x, b = item >> 4, e = item & 15, nt = 4 * mth + i;
        u.a = (const char*)(H2 + (size_t)b * SEQ * D); u.b = (const char*)(W13T + ((size_t)e * 4096 + nt * 256) * D); u.c = HMID + (size_t)item * CAP * FF + nt * 128;
        u.aux = nullptr; u.gidx = IDX + item * CAP; u.ldc = FF; u.row0 = 0; u.col0 = 0; return true;
    }
    __device__ __forceinline__ void a_ready(const Unit&) const {}
    __device__ __forceinline__ void done(const Unit&) const {}
};
struct MoeDownSched {
    int G, c; const bf16_t *HMID, *W2T; bf16_t* YS; const float* GATE;
    __device__ __forceinline__ bool next(int i, Unit& u) const {
        if (i >= 4 || c >= 256) return false;
        const int x = c & 7, q = c >> 3, Q = q >> 2, nt = q & 3, item = (Q * 4 + i) * 8 + x, e = item & 15;
        u.a = (const char*)(HMID + (size_t)item * CAP * FF); u.b = (const char*)(W2T + ((size_t)e * 1024 + nt * 256) * FF); u.c = YS + (size_t)item * CAP * D + nt * 256;
        u.aux = GATE + item * CAP; u.gidx = nullptr; u.ldc = D; u.row0 = 0; u.col0 = 0; return true;
    }
    __device__ __forceinline__ void a_ready(const Unit&) const {}
    __device__ __forceinline__ void done(const Unit&) const {}
};
__device__ __forceinline__ void ph_moe_up(const P& p, unsigned char* lds) {
    pg8::EpiSwiGLU E;
    for (int round = 0; round < 4; ++round) {
        MoeUpSched S{(int)gridDim.x, (int)blockIdx.x, round, (const bf16_t*)(p.ws + WS_H2), (const bf16_t*)(p.ws + WS_W13T), (bf16_t*)(p.ws + WS_HMID), (const int*)(p.ws + WS_IDX)};
        pg8::gemm_phase<pg8::EpiSwiGLU, MoeUpSched, true, true, true>((PG8_LAS unsigned char*)lds, D, S, E);
    }
}
__device__ __forceinline__ void ph_moe_down(const P& p, unsigned char* lds) {
    MoeDownSched S{(int)gridDim.x, (int)blockIdx.x, (const bf16_t*)(p.ws + WS_HMID), (const bf16_t*)(p.ws + WS_W2T), (bf16_t*)(p.ws + WS_YS), (const float*)(p.ws + WS_GATE)};
    pg8::EpiDown E;
    pg8::gemm_phase<pg8::EpiDown, MoeDownSched, true, true, false>((PG8_LAS unsigned char*)lds, FF, S, E);
}

constexpr int FIN_KU = 3;
struct FinSet { uint2 x[2][4]; uint2 w[2][FIN_KU][4]; float fl[2][FIN_KU]; unsigned mrest[2]; };
__device__ __forceinline__ void ph_final(const P& p) {
    const int tid = opaque_tid(), lane = tid & 63, wv = tid >> 6;
    const float* ADA = (const float*)(p.ws + WS_ADA);
    const bf16_t* YS = (const bf16_t*)(p.ws + WS_YS);
    const int* INV = (const int*)(p.ws + WS_INV);
    float* X = p.out;
    for (int rc = blockIdx.x * 8 + wv; rc < NTOK / 16; rc += gridDim.x * 8) {
        const int r0 = rc * 16, b = r0 / SEQ;
        const float* g2 = ADA + b * 6144 + 5120;
        f32x4_t G2[4], FG[4];
#pragma unroll
        for (int j = 0; j < 4; ++j) { G2[j] = ((const f32x4_t*)g2)[lane + 64 * j]; FG[j] = ((const f32x4_t*)p.final_g)[lane + 64 * j]; }
        int inv4[4];
#pragma unroll
        for (int i = 0; i < 4; ++i) inv4[i] = INV[(size_t)r0 * 16 + 64 * i + lane];
        auto issue = [&](FinSet& S, const int s) {
#pragma unroll
            for (int rr = 0; rr < 2; ++rr) {
                const int r = 2 * s + rr, sh = 16 * (r & 3);
#pragma unroll
                for (int j = 0; j < 4; ++j) S.x[rr][j] = ((const uint2*)(X + (size_t)(r0 + r) * D))[lane + 64 * j];
                unsigned m = (unsigned)(__ballot(inv4[r >> 2] >= 0) >> sh) & 0xffffu;
#pragma unroll
                for (int k = 0; k < FIN_KU; ++k) {
                    const bool has = m != 0u;
                    const int e = has ? __builtin_ctz(m) : 0; m &= m - 1u;
                    const int sl = __builtin_amdgcn_readlane(inv4[r >> 2], sh + e);
                    const int slot = has ? sl : 0;
                    S.fl[rr][k] = has ? 1.f : 0.f;
                    const uint2* yr = (const uint2*)(YS + ((size_t)(b * 16 + e) * CAP + slot) * D);
#pragma unroll
                    for (int j = 0; j < 4; ++j) S.w[rr][k][j] = yr[lane + 64 * j];
                }
                S.mrest[rr] = m;
            }
        };
        auto consume = [&](FinSet& S, const int s) {
#pragma unroll
            for (int rr = 0; rr < 2; ++rr) {
                const int r = 2 * s + rr, sh = 16 * (r & 3);
                f32x4_t acc[4];
#pragma unroll
                for (int j = 0; j < 4; ++j) acc[j] = (f32x4_t){0.f, 0.f, 0.f, 0.f};
#pragma unroll
                for (int k = 0; k < FIN_KU; ++k) {
                    const float f = S.fl[rr][k];
#pragma unroll
                    for (int j = 0; j < 4; ++j) {
                        const uint2 w = S.w[rr][k][j];
                        acc[j].x = fmaf(f, __uint_as_float(w.x << 16), acc[j].x); acc[j].y = fmaf(f, __uint_as_float(w.x & 0xffff0000u), acc[j].y);
                        acc[j].z = fmaf(f, __uint_as_float(w.y << 16), acc[j].z); acc[j].w = fmaf(f, __uint_as_float(w.y & 0xffff0000u), acc[j].w);
                    }
                }
                unsigned m = S.mrest[rr];
                while (m) {
                    const int e = __builtin_ctz(m); m &= m - 1u;
                    const int slot = __builtin_amdgcn_readlane(inv4[r >> 2], sh + e);
                    const uint2* yr = (const uint2*)(YS + ((size_t)(b * 16 + e) * CAP + slot) * D);
                    uint2 w[4];
#pragma unroll
                    for (int j = 0; j < 4; ++j) w[j] = yr[lane + 64 * j];
#pragma unroll
                    for (int j = 0; j < 4; ++j) { acc[j].x += __uint_as_float(w[j].x << 16); acc[j].y += __uint_as_float(w[j].x & 0xffff0000u); acc[j].z += __uint_as_float(w[j].y << 16); acc[j].w += __uint_as_float(w[j].y & 0xffff0000u); }
                }
                f32x4_t v[4]; float ss = 0.f;
#pragma unroll
                for (int j = 0; j < 4; ++j) {
                    const f32x4_t g = G2[j];
                    const uint2 w = S.x[rr][j];
                    const f32x4_t xv = (f32x4_t){__uint_as_float(w.x << 16), __uint_as_float(w.x & 0xffff0000u), __uint_as_float(w.y << 16), __uint_as_float(w.y & 0xffff0000u)};
                    v[j] = xv + g * acc[j];
                    ss += v[j].x * v[j].x + v[j].y * v[j].y + v[j].z * v[j].z + v[j].w * v[j].w;
                }
                ss = wave_sum(ss);
                const float rstd = rsqrtf(ss * (1.f / D) + EPS);
#pragma unroll
                for (int j = 0; j < 4; ++j) {
                    ((f32x4_t*)(X + (size_t)(r0 + r) * D))[lane + 64 * j] = v[j] * rstd * FG[j];
                }
            }
        };
        FinSet SA, SB;
        issue(SA, 0);
#pragma unroll
        for (int s2 = 0; s2 < 4; ++s2) {
            issue(SB, 2 * s2 + 1);
            __builtin_amdgcn_sched_barrier(0);
            consume(SA, 2 * s2);
            __builtin_amdgcn_sched_barrier(0);
            if (s2 < 3) issue(SA, 2 * s2 + 2);
            __builtin_amdgcn_sched_barrier(0);
            consume(SB, 2 * s2 + 1);
            __builtin_amdgcn_sched_barrier(0);
        }
    }
}

#define LAS __attribute__((address_space(3)))
#define XB_TMO      128
#define XB_XCNT(j)  (256  + 64 * (j))
#define XB_XSUB(j)  (1280 + 64 * (j))
#define XB_XGEN(j)  (2304 + 64 * (j))
#define XB_TOP      3328
#define XB_TOPGEN   3392
#define XCD_BAR_WORDS 3456
#define XB_SPIN_CAP (1u << 18)

__device__ __forceinline__ unsigned xb_ld(unsigned* p)              { return __hip_atomic_load(p, __ATOMIC_RELAXED, __HIP_MEMORY_SCOPE_AGENT); }
__device__ __forceinline__ unsigned xb_add(unsigned* p, unsigned v) { return __hip_atomic_fetch_add(p, v, __ATOMIC_RELAXED, __HIP_MEMORY_SCOPE_AGENT); }
__device__ __forceinline__ unsigned xb_xcc_id() { return (unsigned)__builtin_amdgcn_s_getreg((3 << 11) | 20) & 0xFu; }
#define XB_SPIN(cond, bar) do { unsigned _sp = 0; while (cond) { __builtin_amdgcn_s_sleep(1); \
    if ((++_sp & 255u) == 0u) { if (xb_ld(&(bar)[XB_TMO])) break; if (_sp > XB_SPIN_CAP) { atomicAdd(&(bar)[XB_TMO], 1u); break; } } } } while (0)

struct XcdBarrier {
    unsigned* bar; unsigned x;
    volatile LAS unsigned* st;
};

__device__ __forceinline__ XcdBarrier xcd_barrier_post(unsigned* bar, volatile LAS unsigned* st) {
    XcdBarrier b; b.bar = bar; b.x = xb_xcc_id(); b.st = st;
    if (threadIdx.x == 0) (void)xb_add(&bar[XB_XCNT(b.x)], 1u);
    return b;
}
__device__ __forceinline__ void xcd_barrier_complete(unsigned* bar, unsigned x, unsigned& nloc, unsigned& nx) {
    const unsigned G = gridDim.x * gridDim.y * gridDim.z;
    unsigned sum, cnt, mine, sp = 0u;
    for (;;) {
        sum = 0u; cnt = 0u; mine = 0u;
#pragma unroll
        for (unsigned j = 0; j < 16; ++j) { const unsigned c = xb_ld(&bar[XB_XCNT(j)]); sum += c; cnt += (c > 0u) ? 1u : 0u; mine = (j == x) ? c : mine; }
        if (sum == G) break;
        __builtin_amdgcn_s_sleep(1);
        if ((++sp & 255u) == 0u) { if (xb_ld(&bar[XB_TMO])) break; if (sp > XB_SPIN_CAP) { atomicAdd(&bar[XB_TMO], 1u); break; } }
    }
    nloc = mine > 0u ? mine : 1u; nx = cnt > 0u ? cnt : 1u;
}

__device__ __forceinline__ void xcd_barrier(const XcdBarrier& b) {
    asm volatile("s_waitcnt vmcnt(0)" ::: "memory");
    __syncthreads();
    if (threadIdx.x == 0) {
        unsigned* bar = b.bar;
        __builtin_amdgcn_s_waitcnt(0);
        unsigned nloc = b.st[0], nx = b.st[1];
        if (nloc == 0u) { xcd_barrier_complete(bar, b.x, nloc, nx); b.st[0] = nloc; b.st[1] = nx; }
        const unsigned old = xb_add(&bar[XB_XSUB(b.x)], 1u);
        const unsigned gen = old / nloc;
        if (old + 1u == (gen + 1u) * nloc) {
            __builtin_amdgcn_fence(__ATOMIC_RELEASE, "agent");
            asm volatile("s_waitcnt vmcnt(0)" ::: "memory");
            const unsigned og = xb_add(&bar[XB_TOP], 1u);
            const unsigned tg = og / nx;
            if (og + 1u == (tg + 1u) * nx) xb_add(&bar[XB_TOPGEN], 1u);
            else XB_SPIN(xb_ld(&bar[XB_TOPGEN]) == tg, bar);
            __builtin_amdgcn_fence(__ATOMIC_ACQUIRE, "agent");
            xb_add(&bar[XB_XGEN(b.x)], 1u);
            asm volatile("s_waitcnt vmcnt(0)" ::: "memory");
        } else {
            XB_SPIN(xb_ld(&bar[XB_XGEN(b.x)]) == gen, bar);
            __builtin_amdgcn_fence(__ATOMIC_ACQUIRE, "agent");
            asm volatile("s_waitcnt vmcnt(0)" ::: "memory");
        }
    }
    __syncthreads();
}

constexpr int N_PHASES = 11;
template <int PH>
__device__ __forceinline__ void run_phase(const P& p, unsigned char* ldsb) {
    float* lds = (float*)ldsb;
    if constexpr (PH == 0) { ph_prep(p, lds); ph_convert_small(p, lds); }
    else if constexpr (PH == 1) { ph_norm1(p); ph_filter(p, lds); }
    else if constexpr (PH == 2) ph_inproj(p, ldsb);
    else if constexpr (PH == 3) ph_mixers<0>(p, ldsb);
    else if constexpr (PH == 4) ph_mixprep(p, lds);
    else if constexpr (PH == 5) ph_outproj(p, ldsb);
    else if constexpr (PH == 6) ph_norm2_router(p, lds);
    else if constexpr (PH == 7) ph_topk(p, lds);
    else if constexpr (PH == 8) ph_moe_up(p, ldsb);
    else if constexpr (PH == 9) ph_moe_down(p, ldsb);
    else if constexpr (PH == 10) ph_final(p);
}
template <int PH>
__device__ __forceinline__ void run_from(const P& p, unsigned char* lds, const XcdBarrier& bar) {
    if constexpr (PH < N_PHASES) {
        run_phase<PH>(p, lds);
        if constexpr (PH + 1 < N_PHASES) xcd_barrier(bar);
        run_from<PH + 1>(p, lds, bar);
    }
}
__global__ void __launch_bounds__(NT, 2) fwd_all(P p) {
    extern __shared__ __attribute__((aligned(16))) unsigned char lds_raw[];
    volatile LAS unsigned* st = (volatile LAS unsigned*)(lds_raw + LDS_BYTES - 32);
    if (threadIdx.x < 2) st[threadIdx.x] = 0u;
    __syncthreads();
    const XcdBarrier bar = xcd_barrier_post((unsigned*)(p.ws + WS_CTL) + CW_BAR, st);
    run_from<0>(p, lds_raw, bar);
}

extern "C" void kernel_launch(void* const* d_in, const int* in_sizes, int n_in, void* d_out, int out_size, void* d_ws, size_t ws_size, hipStream_t stream) {
    static int grid = 0;
    if (grid == 0) {
        int dev = 0, cus = 0, per_cu = 0;
        (void)hipGetDevice(&dev);
        (void)hipDeviceGetAttribute(&cus, hipDeviceAttributeMultiprocessorCount, dev);
        (void)hipFuncSetAttribute((const void*)fwd_all, hipFuncAttributeMaxDynamicSharedMemorySize, LDS_BYTES);
        (void)hipOccupancyMaxActiveBlocksPerMultiprocessor(&per_cu, (const void*)fwd_all, NT, LDS_BYTES);
        if (per_cu < 1) fprintf(stderr, "kernel_launch: occupancy query says %d blocks/CU\n", per_cu);
        grid = (cus > 0 ? cus : 256);
        if (ws_size < WS_END) fprintf(stderr, "kernel_launch: workspace too small: %zu < %zu\n", ws_size, (size_t)WS_END);
    }
    P p{};
    const float** f = (const float**)&p;
    for (int i = 0; i < 28; ++i) f[i] = (const float*)d_in[i];
    p.out = (float*)d_out;
    p.ws = (unsigned char*)d_ws;
    p.ph_lo = 0; p.ph_hi = N_PHASES;
    (void)hipMemsetAsync((unsigned char*)d_ws + WS_CTL, 0, CTL_ZERO_BYTES, stream);
    hipLaunchKernelGGL(fwd_all, dim3(grid), dim3(NT), LDS_BYTES, stream, p);
}
```

```cpp
#include <hip/hip_runtime.h>
#include <cstdio>
#include <cstdint>

constexpr int D = 1024, NB = 16, SEQ = 2048, CTXL = 256;
constexpr int NTOK = NB * SEQ;
constexpr int NCTX = NB * CTXL;
constexpr int HEADS = 4;
constexpr int INC = 4096;
constexpr int NE = 16, CAP = 256, FF = 2048;
constexpr int NT = 512;
constexpr int LDS_BYTES = 147456;
constexpr float EPS = 1e-6f;
typedef unsigned short bf16_t;

constexpr size_t MiB = 1u << 20;
constexpr size_t WS_CTL = 0;
constexpr size_t WS_ADA = 1 * MiB;
constexpr size_t WS_LB = WS_ADA + 512 * 1024;
constexpr size_t WS_HID2 = 2 * MiB;
constexpr size_t WS_AFF = 3 * MiB;
constexpr size_t WS_IDX = 5 * MiB;
constexpr size_t WS_GATE = 5 * MiB + 512 * 1024;
constexpr size_t WS_INV = 6 * MiB;
constexpr size_t WS_W13T = 8 * MiB;
constexpr size_t WS_YS = WS_W13T;
constexpr size_t WS_W2T = 136 * MiB;
constexpr size_t WS_R = 200 * MiB;
constexpr size_t WS_H = WS_R;
constexpr size_t WS_MIXA = WS_R;
constexpr size_t WS_HC = WS_R + 64 * MiB;
constexpr size_t WS_PC = WS_R + 72 * MiB;
constexpr size_t WS_OFB = WS_R + 84 * MiB;
constexpr size_t WS_WOUTT = WS_R + 148 * MiB;
constexpr size_t WS_PHG = WS_R + 152 * MiB;
constexpr size_t WS_HMID = WS_R;
constexpr size_t WS_H2 = WS_R + 256 * MiB;
constexpr size_t WS_YT = WS_R + 320 * MiB;
constexpr size_t WS_END = WS_YT + 32 * MiB;
constexpr int CW_QHEAD = 64;
constexpr int CW_BAR = 4096;
constexpr size_t CTL_ZERO_BYTES = 65536;
constexpr size_t DO_PHYT = 0;
constexpr size_t DO_HF = 96 * MiB;
constexpr size_t DO_SCTX = 112 * MiB;
constexpr size_t DO_WINT = 120 * MiB;

struct P {
    const float *x, *c, *ctx, *c_ctx, *ada_w, *ada_b, *norm1_g, *w_in, *hy_conv_w, *hy_conv_b, *pos_w1, *pos_b1, *freq1, *pos_w2, *pos_b2,
        *freq2, *pos_w3, *hy_bias, *hy_norm_g, *hg_lb, *hg_norm_g, *w_out, *norm2_g, *router_w, *exp_w1, *exp_w3, *exp_w2, *final_g;
    float* out;
    unsigned char* ws;
    int ph_lo, ph_hi;
};

__device__ __forceinline__ int opaque_tid() { int t = threadIdx.x; asm volatile("" : "+v"(t)); return t; }
__device__ __forceinline__ void lds_barrier() { asm volatile("s_waitcnt lgkmcnt(0)" ::: "memory"); __builtin_amdgcn_s_barrier(); asm volatile("" ::: "memory"); }
typedef float f32x4_t __attribute__((ext_vector_type(4)));
__device__ __forceinline__ float wave_sum(float v) {
#pragma unroll
    for (int o = 1; o < 64; o <<= 1) v += __shfl_xor(v, o);
    return v;
}
__device__ __forceinline__ float sigmoidf_(float z) { return 1.f / (1.f + expf(-z)); }
__device__ __forceinline__ float siluf_(float z) { return z / (1.f + expf(-z)); }
__device__ __forceinline__ float silu_f(float z) { return z * __builtin_amdgcn_rcpf(1.0f + __builtin_amdgcn_exp2f(-1.4426950408889634f * z)); }
__device__ __forceinline__ float bf2f(bf16_t h) { return __uint_as_float((unsigned)h << 16); }
__device__ __forceinline__ unsigned f2bf(float f) { unsigned u = __float_as_uint(f); return (u + 0x7fffu + ((u >> 16) & 1u)) >> 16; }
typedef float f32x2_cv __attribute__((ext_vector_type(2))); typedef __bf16 bf16x2_cv __attribute__((ext_vector_type(2)));
__device__ __forceinline__ unsigned cvtpk(float lo, float hi) { const f32x2_cv v = {lo, hi}; const bf16x2_cv b = __builtin_convertvector(v, bf16x2_cv); return __builtin_bit_cast(unsigned, b); }
__device__ __forceinline__ unsigned pk2(float lo, float hi) { return f2bf(lo) | (f2bf(hi) << 16); }

namespace pg8 {
#define PG8_LAS __attribute__((address_space(3)))
typedef unsigned short bf16_t;
typedef short bf16x8 __attribute__((ext_vector_type(8)));
typedef float f32x4 __attribute__((ext_vector_type(4)));
typedef unsigned u32x4 __attribute__((ext_vector_type(4)));
constexpr int BM = 256, BK = 64, HALF = 128, HTB = HALF * BK * 2  , STAGE_BYTES = 8 * HTB, NXCD = 8, WGM = 8;

__host__ __device__ __forceinline__ int lds_byte(int r, int c) { const int st = (r >> 4) * 2 + (c >> 5), rr = r & 15, cc = c & 31, ob = rr * 64 + cc * 2; return st * 1024 + (ob ^ (((ob >> 9) & 1) << 5)); }
__host__ __device__ __forceinline__ void stage_rc(int b, int& R, int& C) { const int st = b / 1024, sb = b % 1024, swz = sb ^ (((sb >> 9) & 1) << 5); R = (st >> 1) * 16 + swz / 64; C = (st & 1) * 32 + (swz % 64) / 2; }
__host__ __device__ __forceinline__ int perm32(int rho) { const int n = rho >> 4, i = rho & 15; return 8 * (i >> 2) + 4 * n + (i & 3); }

struct Unit { const char* a; const char* b; bf16_t* c; const float* aux; const int* gidx; int ldc, row0, col0; };
__device__ __forceinline__ unsigned cvt_pk_bf16(float lo, float hi) { unsigned r; asm volatile("v_cvt_pk_bf16_f32 %0, %1, %2" : "=v"(r) : "v"(lo), "v"(hi)); return r; }

__device__ __forceinline__ void tile_of(int L, int nM, int nN, int& pm, int& pn) {
    const int nwg = nM * nN; int wgid = L;
    { const int q = nwg / NXCD, r = nwg % NXCD, xcd = wgid % NXCD, off = wgid / NXCD; wgid = (xcd < r ? xcd * (q + 1) : r * (q + 1) + (xcd - r) * q) + off; }
    const int nig = WGM * nN, gid = wgid / nig, fm = gid * WGM, gsz = (nM - fm) < WGM ? (nM - fm) : WGM;
    pm = fm + ((wgid % nig) % gsz); pn = (wgid % nig) / gsz;
}

struct EpiStoreBf16 {
    static constexpr bool PERM = true, AFTER_DRAIN = false;
    __device__ __forceinline__ void operator()(const f32x4 (&acc)[2][2][4][2], const Unit& u, int wr, int wc, int fr, int fq) const {
        bf16_t* base = u.c + (size_t)(wr * 64 + fr) * u.ldc + wc * 32 + 8 * fq;
#pragma unroll
        for (int ai = 0; ai < 2; ++ai)
#pragma unroll
            for (int m = 0; m < 4; ++m) { bf16_t* rowp = base + (size_t)(ai * HALF + m * 16) * u.ldc;
#pragma unroll
                for (int bj = 0; bj < 2; ++bj) { const f32x4 v0 = acc[ai][bj][m][0], v1 = acc[ai][bj][m][1];
                    u32x4 w; w.x = cvt_pk_bf16(v0[0], v0[1]); w.y = cvt_pk_bf16(v0[2], v0[3]); w.z = cvt_pk_bf16(v1[0], v1[1]); w.w = cvt_pk_bf16(v1[2], v1[3]);
                    *(u32x4*)(rowp + bj * HALF) = w; } }
    }
};
struct EpiOutProj {
    static constexpr bool PERM = true, AFTER_DRAIN = false;
    const float* x; const float* ada; bf16_t* x1;
    __device__ __forceinline__ void operator()(const f32x4 (&acc)[2][2][4][2], const Unit& u, int wr, int wc, int fr, int fq) const {
        const float* g1 = ada + (u.row0 >> 11) * 6144 + 2048;
#pragma unroll
        for (int bj = 0; bj < 2; ++bj) { const int col = u.col0 + bj * HALF + wc * 32 + 8 * fq; const f32x4 g0 = *(const f32x4*)(g1 + col), gB = *(const f32x4*)(g1 + col + 4);
#pragma unroll
            for (int ai = 0; ai < 2; ++ai)
#pragma unroll
                for (int m = 0; m < 4; ++m) { const size_t row = (size_t)(u.row0 + ai * HALF + wr * 64 + m * 16 + fr);
                    const f32x4 v0 = *(const f32x4*)(x + row * D + col) + g0 * acc[ai][bj][m][0], v1 = *(const f32x4*)(x + row * D + col + 4) + gB * acc[ai][bj][m][1];
                    u32x4 w; w.x = cvt_pk_bf16(v0[0], v0[1]); w.y = cvt_pk_bf16(v0[2], v0[3]); w.z = cvt_pk_bf16(v1[0], v1[1]); w.w = cvt_pk_bf16(v1[2], v1[3]);
                    *(u32x4*)(x1 + row * (2 * D) + col) = w; } }
    }
};
__device__ __forceinline__ float silu_fast(float a) { return a * __builtin_amdgcn_rcpf(1.0f + __builtin_amdgcn_exp2f(-1.4426950408889634f * a)); }
struct EpiSwiGLU {
    static constexpr bool PERM = true, AFTER_DRAIN = false;
    __device__ __forceinline__ void operator()(const f32x4 (&acc)[2][2][4][2], const Unit& u, int wr, int wc, int fr, int fq) const {
        bf16_t* base = u.c + (size_t)(wr * 64 + fr) * FF + wc * 32 + 8 * fq;
#pragma unroll
        for (int ai = 0; ai < 2; ++ai)
#pragma unroll
            for (int m = 0; m < 4; ++m) { const f32x4 a0 = acc[ai][0][m][0], a1 = acc[ai][0][m][1], b0 = acc[ai][1][m][0], b1 = acc[ai][1][m][1];
                u32x4 w; w.x = cvt_pk_bf16(silu_fast(a0[0]) * b0[0], silu_fast(a0[1]) * b0[1]); w.y = cvt_pk_bf16(silu_fast(a0[2]) * b0[2], silu_fast(a0[3]) * b0[3]);
                w.z = cvt_pk_bf16(silu_fast(a1[0]) * b1[0], silu_fast(a1[1]) * b1[1]); w.w = cvt_pk_bf16(silu_fast(a1[2]) * b1[2], silu_fast(a1[3]) * b1[3]);
                *(u32x4*)(base + (size_t)(ai * HALF + m * 16) * FF) = w; }
    }
};
struct EpiDown {
    static constexpr bool PERM = true, AFTER_DRAIN = false;
    __device__ __forceinline__ void operator()(const f32x4 (&acc)[2][2][4][2], const Unit& u, int wr, int wc, int fr, int fq) const {
        bf16_t* base = u.c + (size_t)(wr * 64 + fr) * D + wc * 32 + 8 * fq;
#pragma unroll
        for (int ai = 0; ai < 2; ++ai)
#pragma unroll
            for (int m = 0; m < 4; ++m) { const float gt = u.aux[ai * HALF + wr * 64 + m * 16 + fr]; bf16_t* rowp = base + (size_t)(ai * HALF + m * 16) * D;
#pragma unroll
                for (int bj = 0; bj < 2; ++bj) { const f32x4 v0 = acc[ai][bj][m][0] * gt, v1 = acc[ai][bj][m][1] * gt;
                    u32x4 w; w.x = cvt_pk_bf16(v0[0], v0[1]); w.y = cvt_pk_bf16(v0[2], v0[3]); w.z = cvt_pk_bf16(v1[0], v1[1]); w.w = cvt_pk_bf16(v1[2], v1[3]);
                    *(u32x4*)(rowp + bj * HALF) = w; } }
    }
};

template <class Epi, class Sched, bool ALIGN_EPI = false, bool SP2 = false, bool GATHER = false>
__device__ __forceinline__ void gemm_phase(PG8_LAS unsigned char* lds, const int K, const Sched& S, const Epi& E) {
    const int tid = opaque_tid(), wid = __builtin_amdgcn_readfirstlane(tid >> 6), lane = tid & 63, wr = wid >> 2, wc = wid & 3, fr = lane & 15, fq = lane >> 4;
    const int nt = K / BK;
    unsigned voffA[2], voffB[2];
#pragma unroll
    for (int i = 0; i < 2; ++i) { int R, C; stage_rc(tid * 16 + i * 8192, R, C); const int Rb = Epi::PERM ? ((R & ~31) + perm32(R & 31)) : R;
        voffA[i] = (unsigned)(R * K + C) * 2u; voffB[i] = (unsigned)(Rb * K + C) * 2u; }
    const size_t kstep = (size_t)(BK * 2);
    const size_t hstep = (size_t)HALF * K * 2;
    const unsigned ldsw = (unsigned)wid * 1024u;
    const int aoff = lds_byte(wr * 64 + fr, fq * 8), boff = lds_byte(wc * 32 + fr, fq * 8);
#define PG8_SA(b, h) (((b) * 2 + (h)) * HTB)
#define PG8_SB(b, h) ((4 + (b) * 2 + (h)) * HTB)
#define PG8_STAGE(bufoff, gbase, voff) do { _Pragma("unroll") for (int _i = 0; _i < 2; ++_i) \
        __builtin_amdgcn_global_load_lds((const unsigned*)((const char*)(gbase) + (voff)[_i]), (PG8_LAS unsigned*)(lds + (bufoff) + ldsw + _i * 8192), 16, 0, 0); } while (0)
#define PG8_STAGE_A(bufoff, gbase, h) do { _Pragma("unroll") for (int _i = 0; _i < 2; ++_i) \
        __builtin_amdgcn_global_load_lds((const unsigned*)((const char*)(gbase) + voffAh[h][_i]), (PG8_LAS unsigned*)(lds + (bufoff) + ldsw + _i * 8192), 16, 0, 0); } while (0)
#define PG8_LDA(dst, b, h) do { _Pragma("unroll") for (int m = 0; m < 4; ++m) _Pragma("unroll") for (int k = 0; k < 2; ++k) dst[m][k] = *(const PG8_LAS bf16x8*)(lds + PG8_SA(b, h) + aoff + m * 2048 + k * 1024); } while (0)
#define PG8_LDB(dst, b, h) do { _Pragma("unroll") for (int n = 0; n < 2; ++n) _Pragma("unroll") for (int k = 0; k < 2; ++k) dst[n][k] = *(const PG8_LAS bf16x8*)(lds + PG8_SB(b, h) + boff + n * 2048 + k * 1024); } while (0)
#define PG8_MMA(ai, bj, At, Bt) do { __builtin_amdgcn_s_setprio(1); _Pragma("unroll") for (int m = 0; m < 4; ++m) _Pragma("unroll") for (int n = 0; n < 2; ++n) _Pragma("unroll") for (int k = 0; k < 2; ++k) \
        acc[ai][bj][m][n] = __builtin_amdgcn_mfma_f32_16x16x32_bf16(Bt[n][k], At[m][k], acc[ai][bj][m][n], 0, 0, 0); __builtin_amdgcn_s_setprio(0); } while (0)
#define PG8_WAIT_V(n) asm volatile("s_waitcnt vmcnt(" #n ")" ::: "memory")
#define PG8_WAIT_L(n) asm volatile("s_waitcnt lgkmcnt(" #n ")" ::: "memory")
#define PG8_BAR __builtin_amdgcn_s_barrier()
#define PG8_SCHED __builtin_amdgcn_sched_barrier(0)
    Unit cur, nxt; int ui = 0;
    if (!S.next(0, cur)) return;
    unsigned voffAh[2][2];
#pragma unroll
    for (int h = 0; h < 2; ++h)
#pragma unroll
        for (int i = 0; i < 2; ++i) {
            if constexpr (GATHER) { int R, C; stage_rc(tid * 16 + i * 8192, R, C); voffAh[h][i] = ((unsigned)cur.gidx[h * HALF + R] * (unsigned)K + (unsigned)C) * 2u; }
            else voffAh[h][i] = voffA[i] + (unsigned)h * (unsigned)hstep;
        }
    f32x4 acc[2][2][4][2];
#pragma unroll
    for (int a = 0; a < 2; ++a)
#pragma unroll
        for (int b = 0; b < 2; ++b)
#pragma unroll
            for (int m = 0; m < 4; ++m)
#pragma unroll
                for (int n = 0; n < 2; ++n) acc[a][b][m][n] = (f32x4){0.f, 0.f, 0.f, 0.f};
    bf16x8 At[4][2], B0[2][2], B1[2][2];
    const char* cA = cur.a; const char* cB = cur.b;
    S.a_ready(cur);
    if constexpr (SP2) {
        PG8_STAGE(PG8_SB(0, 0), cB, voffB); PG8_STAGE(PG8_SB(0, 1), cB + hstep, voffB); PG8_STAGE_A(PG8_SA(0, 0), cA, 0); PG8_STAGE_A(PG8_SA(0, 1), cA, 1);
        if (wr == 1) PG8_BAR;
        PG8_WAIT_V(2); PG8_BAR;
        PG8_STAGE(PG8_SB(1, 0), cB + kstep, voffB); PG8_STAGE_A(PG8_SA(1, 0), cA + kstep, 0); PG8_STAGE(PG8_SB(1, 1), cB + hstep + kstep, voffB);
        PG8_WAIT_V(6); PG8_BAR;
    } else {
        PG8_STAGE(PG8_SB(0, 0), cB, voffB); PG8_STAGE_A(PG8_SA(0, 0), cA, 0); PG8_STAGE(PG8_SB(0, 1), cB + hstep, voffB); PG8_STAGE_A(PG8_SA(0, 1), cA, 1);
        if (wr == 1) PG8_BAR;
        PG8_WAIT_V(4); PG8_BAR;
        PG8_STAGE(PG8_SB(1, 0), cB + kstep, voffB); PG8_STAGE_A(PG8_SA(1, 0), cA + kstep, 0); PG8_STAGE(PG8_SB(1, 1), cB + hstep + kstep, voffB);
        PG8_WAIT_V(6); PG8_BAR;
    }
    for (;;) {
        const bool has_next = S.next(ui + 1, nxt);
        const char* nA = has_next ? nxt.a : cA; const char* nB = has_next ? nxt.b : cB;
        for (int t = 0; t < nt; t += 2) {
            const bool last = (t == nt - 2);
            const char* a1 = cA + (size_t)(t + 1) * kstep;
            const char* a2 = last ? nA : cA + (size_t)(t + 2) * kstep; const char* b2 = last ? nB : cB + (size_t)(t + 2) * kstep;
            const char* a3 = a2 + kstep; const char* b3 = b2 + kstep;
            if (last && has_next) S.a_ready(nxt);
            if constexpr (SP2) {
            PG8_LDB(B0, 0, 0); PG8_LDB(B1, 0, 1); PG8_SCHED; PG8_LDA(At, 0, 0); PG8_STAGE_A(PG8_SA(1, 1), a1, 1);
            PG8_WAIT_V(8); PG8_WAIT_L(0); PG8_BAR; PG8_MMA(0, 0, At, B0); PG8_MMA(0, 1, At, B1); PG8_BAR; PG8_SCHED;
            PG8_LDA(At, 0, 1); PG8_STAGE(PG8_SB(0, 0), b2, voffB); PG8_STAGE(PG8_SB(0, 1), b2 + hstep, voffB); PG8_STAGE_A(PG8_SA(0, 0), a2, 0);
            PG8_WAIT_V(8); PG8_WAIT_L(0); PG8_BAR; PG8_MMA(1, 0, At, B0); PG8_MMA(1, 1, At, B1); PG8_BAR; PG8_SCHED;
            PG8_LDB(B0, 1, 0); PG8_LDB(B1, 1, 1); PG8_SCHED; PG8_LDA(At, 1, 0); PG8_STAGE_A(PG8_SA(0, 1), a2, 1);
            PG8_WAIT_V(8); PG8_WAIT_L(0); PG8_BAR; PG8_MMA(0, 0, At, B0); PG8_MMA(0, 1, At, B1); PG8_BAR; PG8_SCHED;
            PG8_LDA(At, 1, 1); PG8_STAGE(PG8_SB(1, 0), b3, voffB); PG8_STAGE(PG8_SB(1, 1), b3 + hstep, voffB); PG8_STAGE_A(PG8_SA(1, 0), a3, 0);
            PG8_WAIT_V(8); PG8_WAIT_L(0); PG8_BAR; PG8_MMA(1, 0, At, B0); PG8_MMA(1, 1, At, B1); PG8_BAR; PG8_SCHED;
            } else {
            PG8_LDB(B0, 0, 0); PG8_SCHED; PG8_LDA(At, 0, 0); PG8_STAGE_A(PG8_SA(1, 1), a1, 1);
            PG8_WAIT_L(8); PG8_BAR; PG8_WAIT_L(0); PG8_MMA(0, 0, At, B0); PG8_BAR; PG8_SCHED;
            PG8_LDB(B1, 0, 1); PG8_STAGE(PG8_SB(0, 0), b2, voffB);
            PG8_BAR; PG8_WAIT_L(0); PG8_MMA(0, 1, At, B1); PG8_BAR;
            PG8_LDA(At, 0, 1); PG8_STAGE_A(PG8_SA(0, 0), a2, 0);
            PG8_BAR; PG8_WAIT_L(0); PG8_MMA(1, 0, At, B0); PG8_BAR; PG8_SCHED;
            PG8_STAGE(PG8_SB(0, 1), b2 + hstep, voffB);
            PG8_WAIT_V(6); PG8_BAR; PG8_MMA(1, 1, At, B1); PG8_BAR;
            PG8_LDB(B0, 1, 0); PG8_SCHED; PG8_LDA(At, 1, 0); PG8_STAGE_A(PG8_SA(0, 1), a2, 1);
            PG8_WAIT_L(8); PG8_BAR; PG8_WAIT_L(0); PG8_MMA(0, 0, At, B0); PG8_BAR; PG8_SCHED;
            PG8_LDB(B1, 1, 1); PG8_STAGE(PG8_SB(1, 0), b3, voffB);
            PG8_BAR; PG8_WAIT_L(0); PG8_MMA(0, 1, At, B1); PG8_BAR;
            PG8_LDA(At, 1, 1); PG8_STAGE_A(PG8_SA(1, 0), a3, 0);
            PG8_BAR; PG8_WAIT_L(0); PG8_MMA(1, 0, At, B0); PG8_BAR; PG8_SCHED;
            PG8_STAGE(PG8_SB(1, 1), b3 + hstep, voffB);
            PG8_WAIT_V(6); PG8_BAR; PG8_MMA(1, 1, At, B1); PG8_BAR;
            }
        }
        if constexpr (ALIGN_EPI) { if (wr == 0) PG8_BAR; }
        if constexpr (!Epi::AFTER_DRAIN) { E(acc, cur, wr, wc, fr, fq); S.done(cur); }
        if (!has_next) break;
#pragma unroll
        for (int a = 0; a < 2; ++a)
#pragma unroll
            for (int b = 0; b < 2; ++b)
#pragma unroll
                for (int m = 0; m < 4; ++m)
#pragma unroll
                    for (int n = 0; n < 2; ++n) acc[a][b][m][n] = (f32x4){0.f, 0.f, 0.f, 0.f};
        cur = nxt; cA = nA; cB = nB; ++ui;
        if constexpr (ALIGN_EPI) { if (wr == 1) PG8_BAR; }
    }
    PG8_WAIT_V(0);
    if constexpr (!ALIGN_EPI) { if (wr == 0) PG8_BAR; }
    PG8_BAR;
    if constexpr (Epi::AFTER_DRAIN) { E.fused(acc, cur, wr, wc, fr, fq, lds, wid, lane); S.done(cur); }
#undef PG8_SA
#undef PG8_SB
#undef PG8_STAGE
#undef PG8_LDA
#undef PG8_LDB
#undef PG8_MMA
#undef PG8_WAIT_V
#undef PG8_WAIT_L
#undef PG8_BAR
#undef PG8_SCHED
}
}
using pg8::Unit; using pg8::tile_of;

__device__ __forceinline__ void ph_prep(const P& p, float* lds) {
    const int tid = opaque_tid(), G = gridDim.x;
    float* ADA = (float*)(p.ws + WS_ADA);
    float* LB = (float*)(p.ws + WS_LB);
    float* HID2 = (float*)(p.ws + WS_HID2);
    {
        float* s = lds;
        float* red = lds + 17 * 1024;
        if (blockIdx.x < 192) {
            const int item = blockIdx.x;
            const int jj = tid & 31, ks = tid >> 5, j = item * 32 + jj;
            float wv[64];
#pragma unroll
            for (int q = 0; q < 64; ++q) wv[q] = p.ada_w[(size_t)(ks * 64 + q) * 6144 + j];
            float cv[34];
#pragma unroll
            for (int u = 0; u < 34; ++u) cv[u] = u < 32 ? p.c[(u >> 1) * 1024 + tid + NT * (u & 1)] : p.c_ctx[tid + NT * (u & 1)];
#pragma unroll
            for (int u = 0; u < 34; ++u) s[tid + NT * u] = siluf_(cv[u]);
            __syncthreads();
            float acc[17];
#pragma unroll
            for (int r = 0; r < 17; ++r) acc[r] = 0.f;
#pragma unroll
            for (int q4 = 0; q4 < 16; ++q4) {
#pragma unroll
                for (int r = 0; r < 17; ++r) {
                    const f32x4_t sv = *(const f32x4_t*)&s[r * 1024 + ks * 64 + 4 * q4];
                    acc[r] += sv.x * wv[4 * q4] + sv.y * wv[4 * q4 + 1] + sv.z * wv[4 * q4 + 2] + sv.w * wv[4 * q4 + 3];
                }
            }
#pragma unroll
            for (int r = 0; r < 17; ++r) red[(ks * 17 + r) * 32 + jj] = acc[r];
            __syncthreads();
            for (int i = tid; i < 17 * 32; i += NT) {
                const int r = i >> 5, j2 = i & 31;
                float sum = 0.f;
#pragma unroll
                for (int k = 0; k < 16; ++k) sum += red[(k * 17 + r) * 32 + j2];
                ADA[r * 6144 + item * 32 + j2] = sum + p.ada_b[item * 32 + j2];
            }
            __syncthreads();
        }
    }
    if (blockIdx.x == G - 1) {
        for (int i = tid; i < 1024; i += NT) {
            const float a0 = p.hg_lb[i], a1 = p.hg_lb[1024 + i];
            LB[i] = 1.f / (1.f + expf(a1 - a0));
        }
    }
    {
        float* zl = lds;
        float* h1 = lds + 512;
        __syncthreads();
        for (int it = (G - 1 - blockIdx.x); it < SEQ / 8; it += G) {
            const int lt = tid >> 6, j = tid & 63, t = it * 8 + lt;
            const float w = 6.283185307179586f * (float)t / 2048.0f;
            if (j == 0) zl[lt * 64] = (float)t / 2047.0f;
            if (j >= 1 && j < 17) { const float f = 1e-4f + (float)(j - 1) * ((15.0f - 1e-4f) / 15.0f); zl[lt * 64 + j] = cosf(f * w); }
            if (j >= 17 && j < 33) { const float f = 1e-4f + (float)(j - 17) * ((15.0f - 1e-4f) / 15.0f); zl[lt * 64 + j] = -sinf(f * w); }
            __syncthreads();
            float a = p.pos_b1[j];
            for (int i = 0; i < 33; ++i) a += zl[lt * 64 + i] * p.pos_w1[i * 64 + j];
            h1[lt * 64 + j] = sinf(p.freq1[j] * a);
            __syncthreads();
            float b = p.pos_b2[j];
            for (int i = 0; i < 64; ++i) b += h1[lt * 64 + i] * p.pos_w2[i * 64 + j];
            HID2[t * 64 + j] = sinf(p.freq2[j] * b);
            __syncthreads();
        }
    }
}
struct ConvItem { const float* W; bf16_t* dst; int N, KD, k0, n0, which; };
__device__ __forceinline__ ConvItem conv_small_item(const P& p, int it) {
    ConvItem c; c.which = 0; c.KD = D;
    if (it < 256) { c.W = p.w_in; c.N = INC; c.k0 = (it / 16) * 64; c.n0 = (it % 16) * 256; c.dst = (bf16_t*)((unsigned char*)p.out + DO_WINT); }
    else { const int r = it - 256; c.W = p.w_out; c.N = D; c.k0 = (r / 4) * 64; c.n0 = (r % 4) * 256; c.dst = (bf16_t*)(p.ws + WS_WOUTT); }
    return c;
}
constexpr int N_EXPERT_ITEMS = 2 * 16 * 16 * 8 + 16 * 32 * 4;
__device__ __forceinline__ ConvItem conv_expert_item(const P& p, int r) {
    ConvItem c; constexpr int I_W1 = 16 * 16 * 8;
    if (r < 2 * I_W1) {
        const int which = r / I_W1; r %= I_W1;
        const int e = r / 128, r2 = r % 128;
        c.W = (which == 0 ? p.exp_w1 : p.exp_w3) + (size_t)e * D * FF; c.N = FF; c.k0 = (r2 / 8) * 64; c.n0 = (r2 % 8) * 256; c.dst = (bf16_t*)(p.ws + WS_W13T) + (size_t)e * 4096 * D; c.KD = D; c.which = 1 + which;
    } else {
        r -= 2 * I_W1; const int e = r / 128, r2 = r % 128;
        c.W = p.exp_w2 + (size_t)e * FF * D; c.N = D; c.k0 = (r2 / 4) * 64; c.n0 = (r2 % 4) * 256; c.dst = (bf16_t*)(p.ws + WS_W2T) + (size_t)e * 1024 * FF; c.KD = FF; c.which = 0;
    }
    return c;
}
__device__ __forceinline__ void conv_load(const ConvItem& c, f32x4_t (&v)[8], int tid) {
#pragma unroll
    for (int q = 0; q < 8; ++q) { const int i = tid + NT * q, k = i >> 6, n4 = i & 63; v[q] = *(const f32x4_t*)(c.W + (size_t)(c.k0 + k) * c.N + c.n0 + 4 * n4); }
}
__device__ __forceinline__ void conv_tile_write(const f32x4_t (&v)[8], float* T, int tid) {
#pragma unroll
    for (int q = 0; q < 8; ++q) { const int i = tid + NT * q, k = i >> 6, n4 = i & 63; *(f32x4_t*)&T[k * 260 + 4 * (n4 ^ ((k >> 3) & 7))] = v[q]; }
}
__device__ __forceinline__ void conv_tile_store(const ConvItem& c, const float* T, int tid) {
#pragma unroll
    for (int q = 0; q < 4; ++q) { const int i = tid + NT * q, nl = i >> 3, ch = i & 7, n = c.n0 + nl;
        float a[8];
#pragma unroll
        for (int e = 0; e < 8; ++e) a[e] = T[(8 * ch + e) * 260 + (nl ^ (ch << 2))];
        const int row = c.which == 0 ? n : ((n >> 7) * 256 + (c.which - 1) * 128 + (n & 127));
        *(uint4*)(c.dst + (size_t)row * c.KD + c.k0 + 8 * ch) = make_uint4(cvtpk(a[0], a[1]), cvtpk(a[2], a[3]), cvtpk(a[4], a[5]), cvtpk(a[6], a[7])); }
}
constexpr int CONV_DEPTH = 4;
template <class ITEMF>
__device__ __forceinline__ void conv_run(ITEMF item, int first, int count, float* T) {
    const int tid = opaque_tid();
    f32x4_t ring[CONV_DEPTH][8];
#pragma unroll
    for (int d = 0; d < CONV_DEPTH; ++d) { if (d < count) { const ConvItem c = item(first + d); conv_load(c, ring[d], tid); } }
    for (int i0 = 0; i0 < count; i0 += CONV_DEPTH) {
#pragma unroll
        for (int d = 0; d < CONV_DEPTH; ++d) {
            const int i = i0 + d;
            if (i >= count) break;
            const ConvItem c = item(first + i);
            lds_barrier();
            conv_tile_write(ring[d], T, tid);
            lds_barrier();
            if (i + CONV_DEPTH < count) { const ConvItem cn = item(first + i + CONV_DEPTH); conv_load(cn, ring[d], tid); }
            conv_tile_store(c, T, tid);
        }
    }
}
__device__ __forceinline__ void ph_convert_small(const P& p, float* lds) {
    __syncthreads();
    if (blockIdx.x >= 192 && blockIdx.x < 192 + 64) conv_run([&](int it) { return conv_small_item(p, it); }, (blockIdx.x - 192) * 5, 5, lds);
}

__device__ __forceinline__ void ph_norm1(const P& p) {
    const int tid = opaque_tid(), lane = tid & 63, wv = tid >> 6;
    const float* ADA = (const float*)(p.ws + WS_ADA);
    bf16_t* H = (bf16_t*)(p.ws + WS_H);
    bf16_t* HC = (bf16_t*)(p.ws + WS_HC);
    auto run = [&](const float* src, bf16_t* dst, int ar, int nrows) {
        f32x4_t gm[4], hs[4];
#pragma unroll
        for (int j = 0; j < 4; ++j) { const int d4 = lane + 64 * j; const f32x4_t g = ((const f32x4_t*)p.norm1_g)[d4], s1 = ((const f32x4_t*)(ADA + ar * 6144 + 1024))[d4]; gm[j] = g * (1.f + s1); hs[j] = ((const f32x4_t*)(ADA + ar * 6144))[d4]; }
        f32x4_t v[4], vn[4];
#pragma unroll
        for (int j = 0; j < 4; ++j) v[j] = ((const f32x4_t*)src)[lane + 64 * j];
        for (int ri = 0; ri < nrows; ++ri) {
            if (ri + 1 < nrows) {
#pragma unroll
                for (int j = 0; j < 4; ++j) vn[j] = ((const f32x4_t*)(src + (size_t)(ri + 1) * D))[lane + 64 * j];
            }
            float ss = 0.f;
#pragma unroll
            for (int j = 0; j < 4; ++j) ss += v[j].x * v[j].x + v[j].y * v[j].y + v[j].z * v[j].z + v[j].w * v[j].w;
            const float rstd = rsqrtf(wave_sum(ss) * (1.f / D) + EPS);
#pragma unroll
            for (int j = 0; j < 4; ++j) { const f32x4_t o = v[j] * rstd * gm[j] + hs[j]; ((uint2*)(dst + (size_t)ri * D))[lane + 64 * j] = make_uint2(cvtpk(o.x, o.y), cvtpk(o.z, o.w)); }
#pragma unroll
            for (int j = 0; j < 4; ++j) v[j] = vn[j];
        }
    };
    for (int rc = blockIdx.x * 8 + wv; rc < NTOK / 16; rc += gridDim.x * 8) {
        run(p.x + (size_t)rc * 16 * D, H + (size_t)rc * 16 * D, (rc * 16) / SEQ, 16);
        run(p.ctx + (size_t)rc * 2 * D, HC + (size_t)rc * 2 * D, 16, 2);
    }
}
__device__ __forceinline__ void ph_filter(const P& p, float* lds, const int grp0, const int gstep) {
    typedef short bf16x8 __attribute__((ext_vector_type(8)));
    typedef unsigned u32x4_t __attribute__((ext_vector_type(4)));
    const int tid = opaque_tid(), lane = tid & 63, w = tid >> 6, tt = lane & 15, g = lane >> 4;
    const float* HID2 = (const float*)(p.ws + WS_HID2);
    float* HF = (float*)((unsigned char*)p.out + DO_HF);
    float* red = lds;
    const float min_decay = logf(1e-2f) / 1.5f, max_decay = logf(1e-2f) / 0.3f;
    auto split = [&](const f32x4_t lo4, const f32x4_t hi4, bf16x8& vh, bf16x8& vl) {
        const unsigned h0 = cvtpk(lo4.x, lo4.y), h1 = cvtpk(lo4.z, lo4.w), h2 = cvtpk(hi4.x, hi4.y), h3 = cvtpk(hi4.z, hi4.w);
        const unsigned l0 = cvtpk(lo4.x - __uint_as_float(h0 << 16), lo4.y - __uint_as_float(h0 & 0xffff0000u)), l1 = cvtpk(lo4.z - __uint_as_float(h1 << 16), lo4.w - __uint_as_float(h1 & 0xffff0000u));
        const unsigned l2 = cvtpk(hi4.x - __uint_as_float(h2 << 16), hi4.y - __uint_as_float(h2 & 0xffff0000u)), l3 = cvtpk(hi4.z - __uint_as_float(h3 << 16), hi4.w - __uint_as_float(h3 & 0xffff0000u));
        vh = __builtin_bit_cast(bf16x8, (u32x4_t){h0, h1, h2, h3}); vl = __builtin_bit_cast(bf16x8, (u32x4_t){l0, l1, l2, l3});
    };
    for (int grp = grp0; grp < 128; grp += gstep) {
        const int item0 = grp * 8, o = item0 >> 9, c0 = item0 & 511;
        bf16x8 wh[2], wl[2];
#pragma unroll
        for (int s = 0; s < 2; ++s) {
            float wv[8];
#pragma unroll
            for (int e = 0; e < 8; ++e) wv[e] = p.pos_w3[(32 * s + 8 * g + e) * 2048 + o * 1024 + (tt & 1) * 512 + c0 + (tt >> 1)];
            split((f32x4_t){wv[0], wv[1], wv[2], wv[3]}, (f32x4_t){wv[4], wv[5], wv[6], wv[7]}, wh[s], wl[s]);
        }
        f32x4_t acc[16];
#pragma unroll
        for (int mb = 0; mb < 4; ++mb) {
            f32x4_t raw[4][4];
#pragma unroll
            for (int m8 = 0; m8 < 4; ++m8) {
                const f32x4_t* row = (const f32x4_t*)(HID2 + (size_t)(256 * w + 16 * (4 * mb + m8) + tt) * 64 + 8 * g);
                raw[m8][0] = row[0]; raw[m8][1] = row[1]; raw[m8][2] = row[8]; raw[m8][3] = row[9];
            }
            __builtin_amdgcn_sched_barrier(0);
#pragma unroll
            for (int m8 = 0; m8 < 4; ++m8) {
                bf16x8 hh[2], hl[2];
                split(raw[m8][0], raw[m8][1], hh[0], hl[0]); split(raw[m8][2], raw[m8][3], hh[1], hl[1]);
                f32x4_t c = (f32x4_t){0.f, 0.f, 0.f, 0.f};
#pragma unroll
                for (int s = 0; s < 2; ++s) {
                    c = __builtin_amdgcn_mfma_f32_16x16x32_bf16(wl[s], hh[s], c, 0, 0, 0);
                    c = __builtin_amdgcn_mfma_f32_16x16x32_bf16(wh[s], hl[s], c, 0, 0, 0);
                    c = __builtin_amdgcn_mfma_f32_16x16x32_bf16(wh[s], hh[s], c, 0, 0, 0);
                }
                acc[4 * mb + m8] = c;
            }
            __builtin_amdgcn_sched_barrier(0);
        }
        float asum[2] = {0.f, 0.f};
        const float dl0 = fabsf(min_decay + (float)(c0 + 2 * g) * ((max_decay - min_decay) / 511.0f)), dl1 = fabsf(min_decay + (float)(c0 + 2 * g + 1) * ((max_decay - min_decay) / 511.0f));
#pragma unroll
        for (int m = 0; m < 16; ++m) {
            const int t = 256 * w + 16 * m + tt;
            const float tl = (float)t / 2047.0f;
            const float w0 = expf(-tl * dl0) + 0.05f, w1 = expf(-tl * dl1) + 0.05f;
            acc[m].x *= w0; acc[m].y *= w0; acc[m].z *= w1; acc[m].w *= w1;
            asum[0] += fabsf(acc[m].x) + (t >= 1 ? fabsf(acc[m].y) : 0.f);
            asum[1] += fabsf(acc[m].z) + (t >= 1 ? fabsf(acc[m].w) : 0.f);
        }
#pragma unroll
        for (int ab = 0; ab < 2; ++ab) {
            float v = asum[ab];
            v += __shfl_xor(v, 1); v += __shfl_xor(v, 2); v += __shfl_xor(v, 4); v += __shfl_xor(v, 8);
            asum[ab] = v;
        }
        __syncthreads();
        if (tt == 0) { red[w * 8 + 2 * g] = asum[0]; red[w * 8 + 2 * g + 1] = asum[1]; }
        __syncthreads();
        {
#pragma unroll
            for (int ab = 0; ab < 2; ++ab) {
                const int q = 2 * g + ab;
                float tot = 0.f;
#pragma unroll
                for (int k = 0; k < 8; ++k) tot += red[k * 8 + q];
                const float inv = 1.f / (tot + EPS);
                float* dst = HF + (size_t)(item0 + q) * 4096;
#pragma unroll
                for (int m = 0; m < 16; ++m) {
                    const int t = 256 * w + 16 * m + tt;
                    dst[2047 + t] = (ab == 0 ? acc[m].x : acc[m].z) * inv;
                    if (t >= 1) dst[2047 - t] = (ab == 0 ? acc[m].y : acc[m].w) * inv;
                }
            }
        }
        if (tid < 8) HF[(size_t)(item0 + tid) * 4096 + 4095] = 0.f;
    }
}

struct InprojSched {
    int G, c; const bf16_t *WinT, *H, *HC; bf16_t *PHYT, *PHG, *PC;
    __device__ __forceinline__ bool next(int i, Unit& u) const {
        int L = i * G + c; int pm, pn;
        u.aux = nullptr; u.gidx = nullptr; u.row0 = 0; u.col0 = 0;
        if (L < 768) { tile_of(L, 6, 128, pm, pn); u.a = (const char*)(WinT + (size_t)pm * 256 * D); u.b = (const char*)(H + (size_t)pn * 256 * D); u.c = PHYT + (size_t)pm * 256 * NTOK + pn * 256; u.ldc = NTOK; return true; }
        L -= 768;
        if (L < 1280) { tile_of(L, 128, 10, pm, pn); u.a = (const char*)(H + (size_t)pm * 256 * D); u.b = (const char*)(WinT + (size_t)(1536 + pn * 256) * D); u.c = PHG + (size_t)pm * 256 * 2560 + pn * 256; u.ldc = 2560; return true; }
        L -= 1280;
        if (L < 96) { tile_of(L, 16, 6, pm, pn); u.a = (const char*)(HC + (size_t)pm * 256 * D); u.b = (const char*)(WinT + (size_t)(2048 + pn * 256) * D); u.c = PC + (size_t)pm * 256 * 1536 + pn * 256; u.ldc = 1536; return true; }
        return false;
    }
    __device__ __forceinline__ void a_ready(const Unit&) const {}
    __device__ __forceinline__ void done(const Unit&) const {}
};
__device__ __forceinline__ void ph_inproj(const P& p, unsigned char* lds) {
    constexpr int N_FILT_WG = 16;
    const int G = (int)gridDim.x - N_FILT_WG;
    if ((int)blockIdx.x >= G) { ph_filter(p, (float*)lds, (int)blockIdx.x - G, N_FILT_WG); return; }
    InprojSched S{G, (int)blockIdx.x, (const bf16_t*)((unsigned char*)p.out + DO_WINT), (const bf16_t*)(p.ws + WS_H), (const bf16_t*)(p.ws + WS_HC),
                  (bf16_t*)((unsigned char*)p.out + DO_PHYT), (bf16_t*)(p.ws + WS_PHG), (bf16_t*)(p.ws + WS_PC)};
    pg8::EpiStoreBf16 E;
    pg8::gemm_phase<pg8::EpiStoreBf16, InprojSched, true, true, false>((PG8_LAS unsigned char*)lds, D, S, E);
}

namespace hy {
#define HY_LAS __attribute__((address_space(3)))
typedef short bf16x8 __attribute__((ext_vector_type(8)));
typedef float f32x4 __attribute__((ext_vector_type(4)));
typedef unsigned u32x4 __attribute__((ext_vector_type(4)));
typedef unsigned u32x2 __attribute__((ext_vector_type(2)));
constexpr int U_STRIDE = 4112, UIMG = 0, U_BYTES = 16 * U_STRIDE;
constexpr int FILT = U_BYTES, F_STRIDE = 8288, F_BYTES = 8 * F_STRIDE;
constexpr int SCR = FILT + F_BYTES;
static_assert(SCR + 8192 <= LDS_BYTES, "hyena LDS map");

__device__ __forceinline__ float uni(float v) { return __uint_as_float(__builtin_amdgcn_readfirstlane(__float_as_uint(v))); }
struct ConvW { float w0, w1, w2, b; };
__device__ __forceinline__ ConvW load_convw(const P& p, int ch) { ConvW c; c.w0 = uni(p.hy_conv_w[ch]); c.w1 = uni(p.hy_conv_w[1536 + ch]); c.w2 = uni(p.hy_conv_w[3072 + ch]); c.b = uni(p.hy_conv_b[ch]); return c; }
__device__ __forceinline__ void load_u_image(const ConvW cw, HY_LAS unsigned char* L, const bf16_t* row, int tid) {
    const float cw0 = cw.w0, cw1 = cw.w1, cw2 = cw.w2, cb = cw.b;
#pragma unroll 2
    for (int k = 0; k < 8; ++k) {
        const int idx = tid + NT * k, b = idx >> 8, t8 = (idx & 255) * 8;
        const bf16_t* src = row + b * SEQ + t8;
        const u32x4 raw = *(const u32x4*)src;
        float x[10];
        x[0] = (t8 & 63) ? bf2f(src[-1]) : 0.f;
        x[9] = ((t8 + 8) & 63) ? bf2f(src[8]) : 0.f;
        x[1] = __uint_as_float(raw.x << 16); x[2] = __uint_as_float(raw.x & 0xffff0000u); x[3] = __uint_as_float(raw.y << 16); x[4] = __uint_as_float(raw.y & 0xffff0000u);
        x[5] = __uint_as_float(raw.z << 16); x[6] = __uint_as_float(raw.z & 0xffff0000u); x[7] = __uint_as_float(raw.w << 16); x[8] = __uint_as_float(raw.w & 0xffff0000u);
        float o[8];
#pragma unroll
        for (int e = 0; e < 8; ++e) o[e] = cb + cw1 * x[e + 1] + cw0 * x[e] + cw2 * x[e + 2];
        *(HY_LAS u32x4*)(L + UIMG + b * U_STRIDE + t8 * 2) = (u32x4){pk2(o[0], o[1]), pk2(o[2], o[3]), pk2(o[4], o[5]), pk2(o[6], o[7])};
    }
}
__device__ __forceinline__ void raw_rows_load(u32x4 (&r)[8], const bf16_t* row, int tid) {
#pragma unroll
    for (int k = 0; k < 8; ++k) { const int idx = tid + NT * k, b = idx >> 8, t8 = (idx & 255) * 8; r[k] = *(const u32x4*)(row + b * SEQ + t8); }
}
__device__ __forceinline__ void raw_rows_store(HY_LAS unsigned char* L, const u32x4 (&r)[8], int tid) {
#pragma unroll
    for (int k = 0; k < 8; ++k) {
        const int idx = tid + NT * k, b = idx >> 8, t8 = (idx & 255) * 8;
        HY_LAS unsigned char* d = L + FILT + b * U_STRIDE + 8 + t8 * 2;
        *(HY_LAS u32x2*)d = (u32x2){r[k].x, r[k].y}; *(HY_LAS u32x2*)(d + 8) = (u32x2){r[k].z, r[k].w};
    }
}
__device__ __forceinline__ void load_filter_scr(HY_LAS unsigned char* L, const float* hf, int tid) {
    const float4 a = ((const float4*)hf)[tid * 2], b = ((const float4*)hf)[tid * 2 + 1];
    *(HY_LAS u32x4*)(L + SCR + tid * 16) = (u32x4){pk2(a.x, a.y), pk2(a.z, a.w), pk2(b.x, b.y), pk2(b.z, b.w)};
}
__device__ __forceinline__ void build_filter_copies(HY_LAS unsigned char* L, int tid) {
    const HY_LAS bf16_t* sc = (const HY_LAS bf16_t*)(L + SCR);
    for (int gi = tid; gi < 8 * 518; gi += NT) {
        const int d = gi / 518, qg = gi - d * 518;
        const int top = 4095 + d - 8 * qg;
        unsigned v[8];
#pragma unroll
        for (int e = 0; e < 8; ++e) { const int ix = top - e; v[e] = (ix >= 0 && ix <= 4094) ? (unsigned)sc[ix] : 0u; }
        *(HY_LAS u32x4*)(L + FILT + d * F_STRIDE + qg * 16) = (u32x4){v[0] | (v[1] << 16), v[2] | (v[3] << 16), v[4] | (v[5] << 16), v[6] | (v[7] << 16)};
    }
}
__device__ __forceinline__ void conv_loop(HY_LAS unsigned char* L, f32x4 (&acc)[16], int w, int lane) {
    const int i = lane & 15, g = lane >> 4;
    const HY_LAS unsigned char* aBase = L + FILT + (i & 7) * F_STRIDE + 2 * (2048 + 8 * g - (i & ~7)) - 32 * (16 * w);
    const HY_LAS unsigned char* bBase = L + UIMG + i * U_STRIDE + 16 * g;
    bf16x8 ring[16];
#pragma unroll
    for (int s = 0; s < 16; ++s) ring[s] = *(const HY_LAS bf16x8*)(aBase - 32 * s);
#pragma unroll
    for (int m = 0; m < 16; ++m) acc[m] = (f32x4){0.f, 0.f, 0.f, 0.f};
    bf16x8 bfrag = *(const HY_LAS bf16x8*)(bBase);
    for (int k8 = 0; k8 < 8; ++k8) {
        const HY_LAS unsigned char* aK = aBase + 512 * k8;
        const HY_LAS unsigned char* bK = bBase + 512 * k8;
#pragma unroll
        for (int u = 0; u < 8; ++u) {
            bf16x8 bnext = bfrag;
            if (u < 7 || k8 < 7) bnext = *(const HY_LAS bf16x8*)(bK + 64 * (u + 1));
            acc[14] = __builtin_amdgcn_mfma_f32_16x16x32_bf16(ring[(14 - 2 * u) & 15], bfrag, acc[14], 0, 0, 0);
            acc[15] = __builtin_amdgcn_mfma_f32_16x16x32_bf16(ring[(15 - 2 * u) & 15], bfrag, acc[15], 0, 0, 0);
            if (u < 7 || k8 < 7) {
                ring[(14 - 2 * u) & 15] = *(const HY_LAS bf16x8*)(aK + 64 * u + 64);
                ring[(15 - 2 * u) & 15] = *(const HY_LAS bf16x8*)(aK + 64 * u + 32);
            }
#pragma unroll
            for (int m = 0; m < 14; ++m) acc[m] = __builtin_amdgcn_mfma_f32_16x16x32_bf16(ring[(m - 2 * u) & 15], bfrag, acc[m], 0, 0, 0);
            bfrag = bnext;
            __builtin_amdgcn_sched_barrier(0);
        }
    }
}
__device__ __forceinline__ void gate_acc(const ConvW cw, HY_LAS unsigned char* L, f32x4 (&acc)[16], float bias, int w, int lane) {
    const int j = lane & 15, g = lane >> 4;
    const float cw0 = cw.w0, cw1 = cw.w1, cw2 = cw.w2, cb = cw.b;
#pragma unroll
    for (int m = 0; m < 16; ++m) {
        const int t4 = 256 * w + 16 * m + 4 * g, tt0 = t4 & 63;
        const u32x2 uu = *(const HY_LAS u32x2*)(L + UIMG + j * U_STRIDE + t4 * 2);
        const HY_LAS unsigned char* xb = L + FILT + j * U_STRIDE + 8 + t4 * 2;
        const u32x2 xx = *(const HY_LAS u32x2*)xb;
        const float xl = tt0 > 0 ? bf2f(*(const HY_LAS bf16_t*)(xb - 2)) : 0.f;
        const float xr = tt0 < 60 ? bf2f(*(const HY_LAS bf16_t*)(xb + 8)) : 0.f;
        const float x0 = __uint_as_float(xx.x << 16), x1 = __uint_as_float(xx.x & 0xffff0000u), x2 = __uint_as_float(xx.y << 16), x3 = __uint_as_float(xx.y & 0xffff0000u);
        const float u0 = __uint_as_float(uu.x << 16), u1 = __uint_as_float(uu.x & 0xffff0000u), u2 = __uint_as_float(uu.y << 16), u3 = __uint_as_float(uu.y & 0xffff0000u);
        const float g0 = cb + cw1 * x0 + cw0 * xl + cw2 * x1, g1 = cb + cw1 * x1 + cw0 * x0 + cw2 * x2, g2 = cb + cw1 * x2 + cw0 * x1 + cw2 * x3, g3 = cb + cw1 * x3 + cw0 * x2 + cw2 * xr;
        acc[m][0] = g0 * (acc[m][0] + bias * u0); acc[m][1] = g1 * (acc[m][1] + bias * u1); acc[m][2] = g2 * (acc[m][2] + bias * u2); acc[m][3] = g3 * (acc[m][3] + bias * u3);
        if ((m & 3) == 3) __builtin_amdgcn_sched_barrier(0);
    }
}
__device__ __forceinline__ void store_acc_uimg(HY_LAS unsigned char* L, const f32x4 (&acc)[16], int w, int lane) {
    const int j = lane & 15, g = lane >> 4;
#pragma unroll
    for (int m = 0; m < 16; ++m) {
        const int t4 = 256 * w + 16 * m + 4 * g;
        *(HY_LAS u32x2*)(L + UIMG + j * U_STRIDE + t4 * 2) = (u32x2){pk2(acc[m][0], acc[m][1]), pk2(acc[m][2], acc[m][3])};
    }
}
}

__device__ __forceinline__ void ph_hyena_task(const P& p, unsigned char* ldsb, int c) {
    const int w = __builtin_amdgcn_readfirstlane(threadIdx.x >> 6);
    const bf16_t* PHYT = (const bf16_t*)((unsigned char*)p.out + DO_PHYT);
    bf16_t* YT = (bf16_t*)(p.ws + WS_YT);
    const float* HF = (const float*)((unsigned char*)p.out + DO_HF);
    HY_LAS unsigned char* L = (HY_LAS unsigned char*)ldsb;
    {
        const int tid = opaque_tid();
        const int lane = tid & 63;
        hy::f32x4 acc[16];
        const hy::ConvW cwv = hy::load_convw(p, c), cwx1 = hy::load_convw(p, 512 + c), cwx2 = hy::load_convw(p, 1024 + c);
        const float bias0 = hy::uni(p.hy_bias[c]), bias1 = hy::uni(p.hy_bias[512 + c]);
        __syncthreads();
        hy::load_u_image(cwv, L, PHYT + (size_t)c * NTOK, tid);
        hy::load_filter_scr(L, HF + (size_t)c * 4096, tid);
        __syncthreads();
        hy::build_filter_copies(L, tid);
        __syncthreads();
        hy::u32x4 rawx[8];
        hy::raw_rows_load(rawx, PHYT + (size_t)(512 + c) * NTOK, tid);
        hy::load_filter_scr(L, HF + (size_t)(512 + c) * 4096, tid);
        hy::conv_loop(L, acc, w, lane);
        __syncthreads();
        hy::raw_rows_store(L, rawx, tid);
        __syncthreads();
        hy::gate_acc(cwx1, L, acc, bias0, w, lane);
        __syncthreads();
        hy::store_acc_uimg(L, acc, w, lane);
        hy::build_filter_copies(L, tid);
        __syncthreads();
        hy::raw_rows_load(rawx, PHYT + (size_t)(1024 + c) * NTOK, tid);
        hy::conv_loop(L, acc, w, lane);
        __syncthreads();
        hy::raw_rows_store(L, rawx, tid);
        __syncthreads();
        hy::gate_acc(cwx2, L, acc, bias1, w, lane);
        hy::store_acc_uimg(L, acc, w, lane);
        __syncthreads();
#pragma unroll 2
        for (int k = 0; k < 8; ++k) {
            const int idx = tid + NT * k, b = idx >> 8, t8 = (idx & 255) * 8;
            *(hy::u32x4*)(YT + (size_t)c * NTOK + b * SEQ + t8) = *(const HY_LAS hy::u32x4*)(L + hy::UIMG + b * hy::U_STRIDE + t8 * 2);
        }
    }
}


namespace hg {
#define HG_LAS __attribute__((address_space(3)))
typedef short bf16x8 __attribute__((ext_vector_type(8)));
typedef float f32x4 __attribute__((ext_vector_type(4)));
typedef unsigned u32x4 __attribute__((ext_vector_type(4)));
typedef unsigned u32x2 __attribute__((ext_vector_type(2)));
constexpr int QROW = 272, KROW = 40;
constexpr int O_QT = 0, O_KBAR = 16 * QROW, O_KHAT = 2 * 16 * QROW, O_VT = O_KHAT + 128 * KROW, O_BDEC = O_VT + 128 * KROW, SET_BYTES = O_BDEC + 512;
constexpr int NCH_CTX = CTXL / 16, NCH = NCH_CTX + SEQ / 16;
template <int CTRL> __device__ __forceinline__ float dpp_mul(float x) {
    return x * __uint_as_float(__builtin_amdgcn_update_dpp(0x3f800000u, __float_as_uint(x), CTRL, 0xf, 0xf, false));
}
struct Raw { unsigned short q[4], v[4], z[4]; };
}

__device__ __forceinline__ void ph_hgrn_task(const P& p, unsigned char* ldsb, int item) {
    using namespace hg;
    const int tid = opaque_tid();
    const int lane = tid & 63, w = __builtin_amdgcn_readfirstlane(tid >> 6), j = lane & 15, g = lane >> 4;
    const int dir = item & 1, h = (item >> 1) & 3, b = item >> 3;
    const float* LB = (const float*)(p.ws + WS_LB);
    const bf16_t* PC = (const bf16_t*)(p.ws + WS_PC);
    const bf16_t* PHG = (const bf16_t*)(p.ws + WS_PHG);
    bf16_t* OFB = (bf16_t*)(p.ws + WS_OFB) + (size_t)dir * NTOK * 512;
    HG_LAS unsigned char* L = (HG_LAS unsigned char*)ldsb;
    float lb0[2], lb1[2];
#pragma unroll
    for (int pp = 0; pp < 2; ++pp) { const float2 t = *(const float2*)(LB + dir * 512 + h * 128 + 16 * w + 8 * pp + 2 * g); lb0[pp] = t.x; lb1[pp] = t.y; }
    const int zoff_c = dir == 0 ? 512 : 1024, zoff_l = dir == 0 ? 1024 : 1536;
    const bf16_t* rowc = PC + (size_t)b * CTXL * 1536 + h * 128 + 16 * w + 2 * g;
    const bf16_t* rowl = PHG + (size_t)b * SEQ * 2560 + h * 128 + 16 * w + 2 * g;
    struct Raw2 { unsigned q[2], v[2], z[2]; };
    auto load_raw = [&](int n, Raw2& r) {
        if (n < NCH_CTX) {
            const int tt = 16 * n + j, t = dir == 0 ? tt : (CTXL - 1 - tt);
            const bf16_t* row = rowc + (size_t)t * 1536;
#pragma unroll
            for (int pp = 0; pp < 2; ++pp) { r.q[pp] = 0u; r.v[pp] = *(const unsigned*)(row + 8 * pp); r.z[pp] = *(const unsigned*)(row + zoff_c + 8 * pp); }
        } else {
            const int tt = 16 * (n - NCH_CTX) + j, t = dir == 0 ? tt : (SEQ - 1 - tt);
            const bf16_t* row = rowl + (size_t)t * 2560;
#pragma unroll
            for (int pp = 0; pp < 2; ++pp) { r.q[pp] = *(const unsigned*)(row + 8 * pp); r.v[pp] = *(const unsigned*)(row + 512 + 8 * pp); r.z[pp] = *(const unsigned*)(row + zoff_l + 8 * pp); }
        }
    };
    const int qoff = j * QROW + 2 * (16 * w + 2 * g), koff = (16 * w + 2 * g) * KROW + 2 * j;
    auto prep_pass = [&](const Raw2& r, HG_LAS unsigned char* S0, const int pp) {
        {
            const float za = __uint_as_float(r.z[pp] << 16), zb = __uint_as_float(r.z[pp] & 0xffff0000u);
            const float qa = __uint_as_float(r.q[pp] << 16), qb = __uint_as_float(r.q[pp] & 0xffff0000u);
            const float fa = lb0[pp] + (1.0f - lb0[pp]) * __builtin_amdgcn_rcpf(1.0f + __builtin_amdgcn_exp2f(-1.4426950408889634f * za));
            const float fb = lb1[pp] + (1.0f - lb1[pp]) * __builtin_amdgcn_rcpf(1.0f + __builtin_amdgcn_exp2f(-1.4426950408889634f * zb));
            float Pa = dpp_mul<0x111>(fa), Pb = dpp_mul<0x111>(fb);
            Pa = dpp_mul<0x112>(Pa); Pb = dpp_mul<0x112>(Pb); Pa = dpp_mul<0x114>(Pa); Pb = dpp_mul<0x114>(Pb); Pa = dpp_mul<0x118>(Pa); Pb = dpp_mul<0x118>(Pb);
            const float Ca = __uint_as_float(__builtin_amdgcn_ds_bpermute(4 * (lane | 15), __float_as_uint(Pa)));
            const float Cb = __uint_as_float(__builtin_amdgcn_ds_bpermute(4 * (lane | 15), __float_as_uint(Pb)));
            const float ia = __builtin_amdgcn_rcpf(fmaxf(Pa, 1e-30f)), ib = __builtin_amdgcn_rcpf(fmaxf(Pb, 1e-30f));
            const float ka = (1.0f - fa) * ia, kb = (1.0f - fb) * ib;
            const float qva = qa * __builtin_amdgcn_rcpf(1.0f + __builtin_amdgcn_exp2f(-1.4426950408889634f * qa)) * (0.08838834764831845f * Pa);
            const float qvb = qb * __builtin_amdgcn_rcpf(1.0f + __builtin_amdgcn_exp2f(-1.4426950408889634f * qb)) * (0.08838834764831845f * Pb);
            *(HG_LAS unsigned*)(S0 + O_QT + qoff + 16 * pp) = cvtpk(qva, qvb);
            *(HG_LAS unsigned*)(S0 + O_KBAR + qoff + 16 * pp) = cvtpk(ka, kb);
            const unsigned kh = cvtpk(ka * Ca, kb * Cb);
            *(HG_LAS bf16_t*)(S0 + O_KHAT + koff + 8 * pp * KROW) = (bf16_t)(kh & 0xffffu);
            *(HG_LAS bf16_t*)(S0 + O_KHAT + koff + (8 * pp + 1) * KROW) = (bf16_t)(kh >> 16);
            *(HG_LAS bf16_t*)(S0 + O_VT + koff + 8 * pp * KROW) = (bf16_t)(r.v[pp] & 0xffffu);
            *(HG_LAS bf16_t*)(S0 + O_VT + koff + (8 * pp + 1) * KROW) = (bf16_t)(r.v[pp] >> 16);
            if (j == 15) { typedef float f32x2_t __attribute__((ext_vector_type(2))); *(HG_LAS f32x2_t*)(S0 + O_BDEC + 4 * (16 * w + 8 * pp + 2 * g)) = (f32x2_t){Pa, Pb}; }
        }
    };
    auto prep = [&](const Raw2& r, HG_LAS unsigned char* S0) { prep_pass(r, S0, 0); prep_pass(r, S0, 1); };
    const float mk0 = (4 * g + 0) <= j ? 1.f : 0.f, mk1 = (4 * g + 1) <= j ? 1.f : 0.f, mk2 = (4 * g + 2) <= j ? 1.f : 0.f, mk3 = (4 * g + 3) <= j ? 1.f : 0.f;
    const int sc_off = j * QROW + 16 * g, vt_off = (16 * w + j) * KROW + 8 * g, qt8_off = j * QROW + 8 * g, kh_off = j * KROW + 8 * g;
    bf16_t* orow = OFB + (size_t)b * SEQ * 512 + h * 128 + 16 * w + 4 * g;
    f32x4 S[8];
#pragma unroll
    for (int t = 0; t < 8; ++t) S[t] = (f32x4){0.f, 0.f, 0.f, 0.f};
    constexpr int RDEPTH = 4;
    static_assert(NCH % RDEPTH == 0, "chunk loop is unrolled by the prefetch depth");
    Raw2 ring[RDEPTH];
    load_raw(0, ring[0]);
    __syncthreads();
    prep(ring[0], L);
#pragma unroll
    for (int c = 1; c <= RDEPTH; ++c) load_raw(c, ring[c % RDEPTH]);
    __syncthreads();
    auto chunk = [&](int n, int phase, Raw2& slot) {
        HG_LAS unsigned char* Sc = L + (n & 1) * SET_BYTES;
        HG_LAS unsigned char* Sn = L + ((n + 1) & 1) * SET_BYTES;
        bf16x8 kaf[4], qaf[4]; u32x2 qb0[4], qb1[4], krf[8]; f32x4 bdf[8];
#pragma unroll
        for (int kp = 0; kp < 4; ++kp) { kaf[kp] = *(const HG_LAS bf16x8*)(Sc + O_KBAR + sc_off + 64 * kp); qaf[kp] = *(const HG_LAS bf16x8*)(Sc + O_QT + sc_off + 64 * kp); }
        const u32x2 vraw = *(const HG_LAS u32x2*)(Sc + O_VT + vt_off);
#pragma unroll
        for (int pq = 0; pq < 4; ++pq) { qb0[pq] = *(const HG_LAS u32x2*)(Sc + O_QT + qt8_off + 64 * pq); qb1[pq] = *(const HG_LAS u32x2*)(Sc + O_QT + qt8_off + 64 * pq + 32); }
#pragma unroll
        for (int t = 0; t < 8; ++t) { bdf[t] = *(const HG_LAS f32x4*)(Sc + O_BDEC + 64 * t + 16 * g); krf[t] = *(const HG_LAS u32x2*)(Sc + O_KHAT + kh_off + 16 * KROW * t); }
        __builtin_amdgcn_sched_barrier(0);
        const u32x4 vf = (u32x4){vraw.x, vraw.y, 0u, 0u};
        f32x4 sc = (f32x4){0.f, 0.f, 0.f, 0.f};
#pragma unroll
        for (int kp = 0; kp < 4; ++kp) sc = __builtin_amdgcn_mfma_f32_16x16x32_bf16(kaf[kp], qaf[kp], sc, 0, 0, 0);
        f32x4 oT = (f32x4){0.f, 0.f, 0.f, 0.f};
#pragma unroll
        for (int pq = 0; pq < 4; ++pq) {
            u32x4 a; a.x = cvtpk(S[2 * pq][0], S[2 * pq][1]); a.y = cvtpk(S[2 * pq][2], S[2 * pq][3]); a.z = cvtpk(S[2 * pq + 1][0], S[2 * pq + 1][1]); a.w = cvtpk(S[2 * pq + 1][2], S[2 * pq + 1][3]);
            const u32x4 bb = (u32x4){qb0[pq].x, qb0[pq].y, qb1[pq].x, qb1[pq].y};
            oT = __builtin_amdgcn_mfma_f32_16x16x32_bf16(__builtin_bit_cast(bf16x8, a), __builtin_bit_cast(bf16x8, bb), oT, 0, 0, 0);
        }
#pragma unroll
        for (int t = 0; t < 8; ++t) {
            const u32x4 ka = (u32x4){krf[t].x, krf[t].y, 0u, 0u};
            S[t] = __builtin_amdgcn_mfma_f32_16x16x32_bf16(__builtin_bit_cast(bf16x8, ka), __builtin_bit_cast(bf16x8, vf), S[t] * bdf[t], 0, 0, 0);
        }
        u32x4 pf;
        pf.x = cvtpk(sc[0] * mk0, sc[1] * mk1); pf.y = cvtpk(sc[2] * mk2, sc[3] * mk3); pf.z = 0u; pf.w = 0u;
        oT = __builtin_amdgcn_mfma_f32_16x16x32_bf16(__builtin_bit_cast(bf16x8, vf), __builtin_bit_cast(bf16x8, pf), oT, 0, 0, 0);
        if (n + 1 < NCH) prep(slot, Sn);
        if (n + 1 + RDEPTH < NCH) load_raw(n + 1 + RDEPTH, slot);
        if (n >= NCH_CTX) {
            const int tt = 16 * (n - NCH_CTX) + j, t = dir == 0 ? tt : (SEQ - 1 - tt);
            *(u32x2*)(orow + (size_t)t * 512) = (u32x2){cvtpk(oT[0], oT[1]), cvtpk(oT[2], oT[3])};
        }
        lds_barrier();
    };
    for (int n0 = 0; n0 < NCH; n0 += RDEPTH) {
#pragma unroll
        for (int u = 0; u < RDEPTH; ++u) chunk(n0 + u, u % 3, ring[(u + 1) % RDEPTH]);
    }
}

template <int QW = 0, bool DO_HGRN = true, bool DO_QUEUE = true, bool DO_HY = true, bool DO_CV = true>
__device__ __forceinline__ void ph_mixers(const P& p, unsigned char* ldsb) {
    unsigned* qhead = (unsigned*)(p.ws + WS_CTL) + CW_QHEAD + QW;
    HG_LAS unsigned* bc = (HG_LAS unsigned*)(ldsb + LDS_BYTES - 16);
    if (DO_HGRN && blockIdx.x < NB * HEADS * 2) ph_hgrn_task(p, ldsb, blockIdx.x);
    constexpr int N_CONV_WG = 48, ITEMS_PER_WG = N_EXPERT_ITEMS / N_CONV_WG;
    static_assert(N_EXPERT_ITEMS % N_CONV_WG == 0 && ITEMS_PER_WG % CONV_DEPTH == 0, "conversion split");
    if (DO_CV && blockIdx.x >= NB * HEADS * 2 && blockIdx.x < NB * HEADS * 2 + N_CONV_WG)
        conv_run([&](int r) { return conv_expert_item(p, r); }, (blockIdx.x - NB * HEADS * 2) * ITEMS_PER_WG, ITEMS_PER_WG, (float*)ldsb);
    if (!DO_QUEUE) return;
    for (;;) {
        __syncthreads();
        if (threadIdx.x == 0) *bc = atomicAdd(qhead, 1u);
        __syncthreads();
        const int c = (int)*bc;
        if (c >= 512) break;
        if (DO_HY) ph_hyena_task(p, ldsb, c);
    }
}

__device__ __forceinline__ void ph_mixprep(const P& p, float* lds) {
    const int tid = opaque_tid(), lane = tid & 63, wv = tid >> 6;
    const bf16_t* YT = (const bf16_t*)(p.ws + WS_YT);
    bf16_t* MIXA = (bf16_t*)(p.ws + WS_MIXA);
    bf16_t* yl = (bf16_t*)lds;
    float* part = lds + (512 * 72 * 2) / 4;
    typedef unsigned u32x4_t __attribute__((ext_vector_type(4)));
    u32x4_t tl[8];
    auto tload = [&](int tile) {
#pragma unroll
        for (int q = 0; q < 8; ++q) { const int i = tid + NT * q, row = i >> 3, ch = i & 7; tl[q] = *(const u32x4_t*)(YT + (size_t)row * NTOK + tile * 64 + ch * 8); }
    };
    if (blockIdx.x < NTOK / 64) tload(blockIdx.x);
    for (int tile = blockIdx.x; tile < NTOK / 64; tile += gridDim.x) {
        const int tok0 = tile * 64;
        __syncthreads();
#pragma unroll
        for (int q = 0; q < 8; ++q) { const int i = tid + NT * q, row = i >> 3, ch = i & 7; *(u32x4_t*)(yl + row * 72 + ch * 8) = tl[q]; }
        __syncthreads();
        if (tile + (int)gridDim.x < NTOK / 64) tload(tile + gridDim.x);
        const int tok = tid & 63, pt = tid >> 6;
        float ss = 0.f;
        for (int c = pt * 64; c < pt * 64 + 64; ++c) { const float v = bf2f(yl[c * 72 + tok]); ss += v * v; }
        part[pt * 64 + tok] = ss;
        __syncthreads();
        float tot = 0.f;
#pragma unroll
        for (int k = 0; k < 8; ++k) tot += part[k * 64 + tok];
        const float rstd = rsqrtf(tot * (1.f / 512.f) + EPS);
        bf16_t* dst = MIXA + (size_t)(tok0 + tok) * D + pt * 64;
#pragma unroll
        for (int j = 0; j < 8; ++j) {
            const f32x4_t ga = *(const f32x4_t*)(p.hy_norm_g + pt * 64 + j * 8), gb = *(const f32x4_t*)(p.hy_norm_g + pt * 64 + j * 8 + 4);
            const float gv[8] = {ga.x, ga.y, ga.z, ga.w, gb.x, gb.y, gb.z, gb.w};
            float o[8];
#pragma unroll
            for (int q = 0; q < 8; ++q) { const int c = pt * 64 + j * 8 + q; o[q] = bf2f(yl[c * 72 + tok]) * rstd * gv[q]; }
            *(uint4*)(dst + j * 8) = make_uint4(cvtpk(o[0], o[1]), cvtpk(o[2], o[3]), cvtpk(o[4], o[5]), cvtpk(o[6], o[7]));
        }
    }
    const bf16_t* OFB = (const bf16_t*)(p.ws + WS_OFB);
    const bf16_t* PHG = (const bf16_t*)(p.ws + WS_PHG);
    {
        const int hh = lane >> 4, k8 = (lane & 15) * 8, col = hh * 128 + k8;
        const f32x4_t ng0 = *(const f32x4_t*)(p.hg_norm_g + k8), ng1 = *(const f32x4_t*)(p.hg_norm_g + k8 + 4);
        struct Row3 { uint4 a, b, g; };
        auto ld = [&](int r) { Row3 x; x.a = *(const uint4*)(OFB + (size_t)r * 512 + col); x.b = *(const uint4*)(OFB + (size_t)NTOK * 512 + (size_t)r * 512 + col); x.g = *(const uint4*)(PHG + (size_t)r * 2560 + 2048 + col); return x; };
        for (int rc = blockIdx.x * 8 + wv; rc < NTOK / 16; rc += gridDim.x * 8) {
            Row3 cur = ld(rc * 16), nxt = cur;
            for (int ri = 0; ri < 16; ++ri) {
                const int r = rc * 16 + ri;
                if (ri + 1 < 16) nxt = ld(r + 1);
                const unsigned aw[4] = {cur.a.x, cur.a.y, cur.a.z, cur.a.w}, bw[4] = {cur.b.x, cur.b.y, cur.b.z, cur.b.w}, gw[4] = {cur.g.x, cur.g.y, cur.g.z, cur.g.w};
                float o[8]; float ss = 0.f;
#pragma unroll
                for (int q = 0; q < 4; ++q) { o[2 * q] = __uint_as_float(aw[q] << 16) + __uint_as_float(bw[q] << 16); o[2 * q + 1] = __uint_as_float(aw[q] & 0xffff0000u) + __uint_as_float(bw[q] & 0xffff0000u); ss += o[2 * q] * o[2 * q] + o[2 * q + 1] * o[2 * q + 1]; }
                ss += __shfl_xor(ss, 1); ss += __shfl_xor(ss, 2); ss += __shfl_xor(ss, 4); ss += __shfl_xor(ss, 8);
                const float rstd = rsqrtf(ss * (1.f / 128.f) + EPS);
                const float ngv[8] = {ng0.x, ng0.y, ng0.z, ng0.w, ng1.x, ng1.y, ng1.z, ng1.w};
                unsigned w[4];
#pragma unroll
                for (int q = 0; q < 4; ++q) { const float g0 = __uint_as_float(gw[q] << 16), g1 = __uint_as_float(gw[q] & 0xffff0000u);
                    w[q] = cvtpk(o[2 * q] * rstd * ngv[2 * q] * silu_f(g0), o[2 * q + 1] * rstd * ngv[2 * q + 1] * silu_f(g1)); }
                *(uint4*)(MIXA + (size_t)r * D + 512 + col) = make_uint4(w[0], w[1], w[2], w[3]);
                cur = nxt;
            }
        }
    }
}

struct OutprojSched {
    int G, c; const bf16_t *A, *Bt;
    __device__ __forceinline__ bool next(int i, Unit& u) const {
        const int L = i * G + c; if (L >= 512) return false; int pm, pn; tile_of(L, 128, 4, pm, pn);
        u.a = (const char*)(A + (size_t)pm * 256 * D); u.b = (const char*)(Bt + (size_t)pn * 256 * D); u.c = nullptr; u.aux = nullptr; u.gidx = nullptr; u.ldc = D; u.row0 = pm * 256; u.col0 = pn * 256; return true;
    }
    __device__ __forceinline__ void a_ready(const Unit&) const {}
    __device__ __forceinline__ void done(const Unit&) const {}
};
__device__ __forceinline__ void ph_outproj(const P& p, unsigned char* lds) {
    OutprojSched S{(int)gridDim.x, (int)blockIdx.x, (const bf16_t*)(p.ws + WS_MIXA), (const bf16_t*)(p.ws + WS_WOUTT)};
    pg8::EpiOutProj E{p.x, (const float*)(p.ws + WS_ADA), (bf16_t*)p.out};
    pg8::gemm_phase<pg8::EpiOutProj, OutprojSched, true, true, false>((PG8_LAS unsigned char*)lds, D, S, E);
}

__device__ __forceinline__ void ph_norm2_router(const P& p, float* ldsf) {
    typedef short bf16x8_t __attribute__((ext_vector_type(8)));
    const int tid = opaque_tid(), lane = tid & 63, wv = tid >> 6, j = lane & 15, g = lane >> 4;
    const float* ADA = (const float*)(p.ws + WS_ADA);
    const bf16_t* X1 = (const bf16_t*)p.out;
    bf16_t* H2 = (bf16_t*)(p.ws + WS_H2);
    float* AFF = (float*)(p.ws + WS_AFF);
    HG_LAS unsigned char* L = (HG_LAS unsigned char*)(unsigned char*)ldsf;
    constexpr int RS = 2064;
    constexpr int O_WH = 0, O_WL = 16 * RS, O_HH = 32 * RS, O_HL = 48 * RS, O_PL = 64 * RS;
    static_assert(O_PL + 8 * 256 * 4 <= LDS_BYTES - 64, "router LDS map");
    __syncthreads();
    for (int i = tid; i < D * 4; i += NT) {
        const int d = i >> 2, e4 = i & 3; const float4 w = ((const float4*)p.router_w)[i]; const float wv4[4] = {w.x, w.y, w.z, w.w};
#pragma unroll
        for (int q = 0; q < 4; ++q) { const unsigned hi = f2bf(wv4[q]); const float rem = wv4[q] - __uint_as_float(hi << 16);
            *(HG_LAS bf16_t*)(L + O_WH + (e4 * 4 + q) * RS + 2 * d) = (bf16_t)hi; *(HG_LAS bf16_t*)(L + O_WL + (e4 * 4 + q) * RS + 2 * d) = (bf16_t)f2bf(rem); }
    }
    auto ldrow = [&](int r, f32x4_t (&dst)[4]) {
#pragma unroll
        for (int q = 0; q < 4; ++q) { const uint2 w = ((const uint2*)(X1 + (size_t)r * (2 * D)))[lane + 64 * q]; dst[q] = (f32x4_t){__uint_as_float(w.x << 16), __uint_as_float(w.x & 0xffff0000u), __uint_as_float(w.y << 16), __uint_as_float(w.y & 0xffff0000u)}; }
    };
    for (int blk = blockIdx.x; blk < NTOK / 128; blk += gridDim.x) {
        const int rblk = blk * 128, b = rblk / SEQ;
        f32x4_t gm[4], hs[4];
#pragma unroll
        for (int q = 0; q < 4; ++q) { const int d4 = lane + 64 * q; const f32x4_t gg = ((const f32x4_t*)p.norm2_g)[d4], s1 = ((const f32x4_t*)(ADA + b * 6144 + 4096))[d4]; gm[q] = gg * (1.f + s1); hs[q] = ((const f32x4_t*)(ADA + b * 6144 + 3072))[d4]; }
        f32x4_t va[4], vb[4], na[4], nb[4];
        ldrow(rblk + 2 * wv, va); ldrow(rblk + 2 * wv + 1, vb);
        for (int grp = 0; grp < 8; ++grp) {
            const int r0 = rblk + grp * 16;
            if (grp + 1 < 8) { ldrow(r0 + 16 + 2 * wv, na); ldrow(r0 + 17 + 2 * wv, nb); }
#pragma unroll
            for (int half = 0; half < 2; ++half) {
                const int lr = 2 * wv + half, r = r0 + lr;
                float ss = 0.f;
#pragma unroll
                for (int q = 0; q < 4; ++q) { const f32x4_t v = half ? vb[q] : va[q]; ss += v.x * v.x + v.y * v.y + v.z * v.z + v.w * v.w; }
                const float rstd = rsqrtf(wave_sum(ss) * (1.f / D) + EPS);
#pragma unroll
                for (int q = 0; q < 4; ++q) {
                    const int d4 = lane + 64 * q;
                    const f32x4_t o = (half ? vb[q] : va[q]) * rstd * gm[q] + hs[q];
                    const unsigned h01 = cvtpk(o.x, o.y), h23 = cvtpk(o.z, o.w);
                    ((uint2*)(H2 + (size_t)r * D))[d4] = make_uint2(h01, h23);
                    const unsigned l01 = cvtpk(o.x - __uint_as_float(h01 << 16), o.y - __uint_as_float(h01 & 0xffff0000u)), l23 = cvtpk(o.z - __uint_as_float(h23 << 16), o.w - __uint_as_float(h23 & 0xffff0000u));
                    typedef unsigned u32x2_t __attribute__((ext_vector_type(2)));
                    *(HG_LAS u32x2_t*)(L + O_HH + lr * RS + 8 * d4) = (u32x2_t){h01, h23};
                    *(HG_LAS u32x2_t*)(L + O_HL + lr * RS + 8 * d4) = (u32x2_t){l01, l23};
                }
            }
            __syncthreads();
            f32x4_t acc = (f32x4_t){0.f, 0.f, 0.f, 0.f};
#pragma unroll
            for (int ks = 0; ks < 4; ++ks) {
                const int kb = 2 * (32 * (4 * wv + ks) + 8 * g);
                const bf16x8_t wh = *(const HG_LAS bf16x8_t*)(L + O_WH + j * RS + kb), wl = *(const HG_LAS bf16x8_t*)(L + O_WL + j * RS + kb);
                const bf16x8_t hh = *(const HG_LAS bf16x8_t*)(L + O_HH + j * RS + kb), hl = *(const HG_LAS bf16x8_t*)(L + O_HL + j * RS + kb);
                acc = __builtin_amdgcn_mfma_f32_16x16x32_bf16(wh, hh, acc, 0, 0, 0);
                acc = __builtin_amdgcn_mfma_f32_16x16x32_bf16(wh, hl, acc, 0, 0, 0);
                acc = __builtin_amdgcn_mfma_f32_16x16x32_bf16(wl, hh, acc, 0, 0, 0);
            }
#pragma unroll
            for (int r = 0; r < 4; ++r) *(HG_LAS float*)(L + O_PL + ((wv * 16 + 4 * g + r) * 16 + j) * 4) = acc[r];
            __syncthreads();
            if (tid < 256) {
                const int row = tid >> 4, e = tid & 15;
                float lgt = 0.f;
#pragma unroll
                for (int k = 0; k < 8; ++k) lgt += *(const HG_LAS float*)(L + O_PL + ((k * 16 + e) * 16 + row) * 4);
                float mx = lgt;
                mx = fmaxf(mx, __shfl_xor(mx, 1)); mx = fmaxf(mx, __shfl_xor(mx, 2)); mx = fmaxf(mx, __shfl_xor(mx, 4)); mx = fmaxf(mx, __shfl_xor(mx, 8));
                const float ex = expf(lgt - mx);
                float den = ex;
                den += __shfl_xor(den, 1); den += __shfl_xor(den, 2); den += __shfl_xor(den, 4); den += __shfl_xor(den, 8);
                const int r = r0 + row;
                AFF[((size_t)b * 16 + e) * SEQ + (r % SEQ)] = ex / den;
            }
            __syncthreads();
#pragma unroll
            for (int q = 0; q < 4; ++q) { va[q] = na[q]; vb[q] = nb[q]; }
        }
    }
}

__device__ __forceinline__ void ph_topk(const P& p, float* lds) {
    const int tid = opaque_tid(), lane = tid & 63, wv = tid >> 6;
    const float* AFF = (const float*)(p.ws + WS_AFF);
    int* IDX = (int*)(p.ws + WS_IDX);
    float* GATE = (float*)(p.ws + WS_GATE);
    int* INV = (int*)(p.ws + WS_INV);
    unsigned* hist = (unsigned*)lds;
    unsigned* ctl = hist + 256;
    unsigned* wtot = hist + 272;
    for (int item = blockIdx.x; item < NB * NE; item += gridDim.x) {
        const int b = item >> 4, e = item & 15;
        const uint4 kk = ((const uint4*)(AFF + (size_t)item * SEQ))[tid];
        const unsigned key[4] = {kk.x, kk.y, kk.z, kk.w};
        unsigned prefix = 0u, need = CAP;
#pragma unroll
        for (int pass = 3; pass >= 0; --pass) {
            __syncthreads();
            if (tid < 256) hist[tid] = 0u;
            __syncthreads();
#pragma unroll
            for (int q = 0; q < 4; ++q) {
                const bool in = (pass == 3) || ((key[q] >> (8 * (pass + 1))) == prefix);
                if (in) atomicAdd(&hist[(key[q] >> (8 * pass)) & 255u], 1u);
            }
            __syncthreads();
            if (wv == 0) {
                const uint4 h4 = ((const uint4*)hist)[lane];
                const unsigned loc = h4.x + h4.y + h4.z + h4.w;
                unsigned suf = loc;
#pragma unroll
                for (int o = 1; o < 64; o <<= 1) { const unsigned y = __shfl_down(suf, o); if (lane + o < 64) suf += y; }
                const unsigned above = suf - loc;
                unsigned c3 = above + h4.w, c2 = c3 + h4.z, c1 = c2 + h4.y, c0 = c1 + h4.x;
                int bin = -1; unsigned nneed = 0u;
                if (above < need && c0 >= need) {
                    if (c3 >= need) { bin = 4 * lane + 3; nneed = need - above; }
                    else if (c2 >= need) { bin = 4 * lane + 2; nneed = need - c3; }
                    else if (c1 >= need) { bin = 4 * lane + 1; nneed = need - c2; }
                    else { bin = 4 * lane; nneed = need - c1; }
                    ctl[0] = (prefix << 8) | (unsigned)bin; ctl[1] = nneed;
                }
            }
            __syncthreads();
            prefix = ctl[0]; need = ctl[1];
        }
        unsigned cgt = 0u, ceq = 0u;
#pragma unroll
        for (int q = 0; q < 4; ++q) { cgt += key[q] > prefix ? 1u : 0u; ceq += key[q] == prefix ? 1u : 0u; }
        unsigned sgt = cgt, seq = ceq;
#pragma unroll
        for (int o = 1; o < 64; o <<= 1) { const unsigned y1 = __shfl_up(sgt, o), y2 = __shfl_up(seq, o); if (lane >= o) { sgt += y1; seq += y2; } }
        if (lane == 63) { wtot[wv] = sgt; wtot[8 + wv] = seq; }
        __syncthreads();
        unsigned bgt = 0u, beq = 0u, ngt = 0u;
#pragma unroll
        for (int k = 0; k < 8; ++k) { const unsigned a = wtot[k], c = wtot[8 + k]; if (k < wv) { bgt += a; beq += c; } ngt += a; }
        unsigned rgt = bgt + sgt - cgt, req = beq + seq - ceq;
#pragma unroll
        for (int q = 0; q < 4; ++q) {
            const int t = 4 * tid + q; int slot = -1;
            if (key[q] > prefix) { slot = (int)rgt; ++rgt; }
            else if (key[q] == prefix) { if (req < need) slot = (int)(ngt + req); ++req; }
            if (slot >= 0) { IDX[item * CAP + slot] = t; GATE[item * CAP + slot] = __uint_as_float(key[q]); }
            INV[((size_t)b * SEQ + t) * 16 + e] = slot;
        }
    }
}

struct MoeUpSched {
    int G, c, round; const bf16_t *H2, *W13T; bf16_t* HMID; const int* IDX;
    __device__ __forceinline__ bool next(int i, Unit& u) const {
        if (i >= 4 || c >= 256) return false;
        const int x = c & 7, q = c >> 3, Q = q >> 2, mth = q & 3, item = (Q * 4 + ((round & 1) * 2 + (round >> 1))) * 8 + x, b = item >> 4, e = item & 15, nt = 4 * mth + i;
        u.a = (const char*)(H2 + (size_t)b * SEQ * D); u.b = (const char*)(W13T + ((size_t)e * 4096 + nt * 256) * D); u.c = HMID + (size_t)item * CAP * FF + nt * 128;
        u.aux = nullptr; u.gidx = IDX + item * CAP; u.ldc = FF; u.row0 = 0; u.col0 = 0; return true;
    }
    __device__ __forceinline__ void a_ready(const Unit&) const {}
    __device__ __forceinline__ void done(const Unit&) const {}
};
struct MoeDownSched {
    int G, c; const bf16_t *HMID, *W2T; bf16_t* YS; const float* GATE;
    __device__ __forceinline__ bool next(int i, Unit& u) const {
        if (i >= 4 || c >= 256) return false;
        const int x = c & 7, q = c >> 3, Q = q >> 2, nt = q & 3, item = (Q * 4 + i) * 8 + x, e = item & 15;
        u.a = (const char*)(HMID + (size_t)item * CAP * FF); u.b = (const char*)(W2T + ((size_t)e * 1024 + nt * 256) * FF); u.c = YS + (size_t)item * CAP * D + nt * 256;
        u.aux = GATE + item * CAP; u.gidx = nullptr; u.ldc = D; u.row0 = 0; u.col0 = 0; return true;
    }
    __device__ __forceinline__ void a_ready(const Unit&) const {}
    __device__ __forceinline__ void done(const Unit&) const {}
};
__device__ __forceinline__ void ph_moe_up(const P& p, unsigned char* lds) {
    pg8::EpiSwiGLU E;
    for (int round = 0; round < 4; ++round) {
        MoeUpSched S{(int)gridDim.x, (int)blockIdx.x, round, (const bf16_t*)(p.ws + WS_H2), (const bf16_t*)(p.ws + WS_W13T), (bf16_t*)(p.ws + WS_HMID), (const int*)(p.ws + WS_IDX)};
        pg8::gemm_phase<pg8::EpiSwiGLU, MoeUpSched, true, true, true>((PG8_LAS unsigned char*)lds, D, S, E);
    }
}
__device__ __forceinline__ void ph_moe_down(const P& p, unsigned char* lds) {
    MoeDownSched S{(int)gridDim.x, (int)blockIdx.x, (const bf16_t*)(p.ws + WS_HMID), (const bf16_t*)(p.ws + WS_W2T), (bf16_t*)(p.ws + WS_YS), (const float*)(p.ws + WS_GATE)};
    pg8::EpiDown E;
    pg8::gemm_phase<pg8::EpiDown, MoeDownSched, true, true, false>((PG8_LAS unsigned char*)lds, FF, S, E);
}

constexpr int FIN_KU = 3;
struct FinSet { uint2 x[2][4]; uint2 w[2][FIN_KU][4]; float fl[2][FIN_KU]; unsigned mrest[2]; };
__device__ __forceinline__ void ph_final(const P& p) {
    const int tid = opaque_tid(), lane = tid & 63, wv = tid >> 6;
    const float* ADA = (const float*)(p.ws + WS_ADA);
    const bf16_t* YS = (const bf16_t*)(p.ws + WS_YS);
    const int* INV = (const int*)(p.ws + WS_INV);
    float* X = p.out;
    for (int rc = blockIdx.x * 8 + wv; rc < NTOK / 16; rc += gridDim.x * 8) {
        const int r0 = rc * 16, b = r0 / SEQ;
        const float* g2 = ADA + b * 6144 + 5120;
        f32x4_t G2[4], FG[4];
#pragma unroll
        for (int j = 0; j < 4; ++j) { G2[j] = ((const f32x4_t*)g2)[lane + 64 * j]; FG[j] = ((const f32x4_t*)p.final_g)[lane + 64 * j]; }
        int inv4[4];
#pragma unroll
        for (int i = 0; i < 4; ++i) inv4[i] = INV[(size_t)r0 * 16 + 64 * i + lane];
        auto issue = [&](FinSet& S, const int s) {
#pragma unroll
            for (int rr = 0; rr < 2; ++rr) {
                const int r = 2 * s + rr, sh = 16 * (r & 3);
#pragma unroll
                for (int j = 0; j < 4; ++j) S.x[rr][j] = ((const uint2*)(X + (size_t)(r0 + r) * D))[lane + 64 * j];
                unsigned m = (unsigned)(__ballot(inv4[r >> 2] >= 0) >> sh) & 0xffffu;
#pragma unroll
                for (int k = 0; k < FIN_KU; ++k) {
                    const bool has = m != 0u;
                    const int e = has ? __builtin_ctz(m) : 0; m &= m - 1u;
                    const int sl = __builtin_amdgcn_readlane(inv4[r >> 2], sh + e);
                    const int slot = has ? sl : 0;
                    S.fl[rr][k] = has ? 1.f : 0.f;
                    const uint2* yr = (const uint2*)(YS + ((size_t)(b * 16 + e) * CAP + slot) * D);
#pragma unroll
                    for (int j = 0; j < 4; ++j) S.w[rr][k][j] = yr[lane + 64 * j];
                }
                S.mrest[rr] = m;
            }
        };
        auto consume = [&](FinSet& S, const int s) {
#pragma unroll
            for (int rr = 0; rr < 2; ++rr) {
                const int r = 2 * s + rr, sh = 16 * (r & 3);
                f32x4_t acc[4];
#pragma unroll
                for (int j = 0; j < 4; ++j) acc[j] = (f32x4_t){0.f, 0.f, 0.f, 0.f};
#pragma unroll
                for (int k = 0; k < FIN_KU; ++k) {
                    const float f = S.fl[rr][k];
#pragma unroll
                    for (int j = 0; j < 4; ++j) {
                        const uint2 w = S.w[rr][k][j];
                        acc[j].x = fmaf(f, __uint_as_float(w.x << 16), acc[j].x); acc[j].y = fmaf(f, __uint_as_float(w.x & 0xffff0000u), acc[j].y);
                        acc[j].z = fmaf(f, __uint_as_float(w.y << 16), acc[j].z); acc[j].w = fmaf(f, __uint_as_float(w.y & 0xffff0000u), acc[j].w);
                    }
                }
                unsigned m = S.mrest[rr];
                while (m) {
                    const int e = __builtin_ctz(m); m &= m - 1u;
                    const int slot = __builtin_amdgcn_readlane(inv4[r >> 2], sh + e);
                    const uint2* yr = (const uint2*)(YS + ((size_t)(b * 16 + e) * CAP + slot) * D);
                    uint2 w[4];
#pragma unroll
                    for (int j = 0; j < 4; ++j) w[j] = yr[lane + 64 * j];
#pragma unroll
                    for (int j = 0; j < 4; ++j) { acc[j].x += __uint_as_float(w[j].x << 16); acc[j].y += __uint_as_float(w[j].x & 0xffff0000u); acc[j].z += __uint_as_float(w[j].y << 16); acc[j].w += __uint_as_float(w[j].y & 0xffff0000u); }
                }
                f32x4_t v[4]; float ss = 0.f;
#pragma unroll
                for (int j = 0; j < 4; ++j) {
                    const f32x4_t g = G2[j];
                    const uint2 w = S.x[rr][j];
                    const f32x4_t xv = (f32x4_t){__uint_as_float(w.x << 16), __uint_as_float(w.x & 0xffff0000u), __uint_as_float(w.y << 16), __uint_as_float(w.y & 0xffff0000u)};
                    v[j] = xv + g * acc[j];
                    ss += v[j].x * v[j].x + v[j].y * v[j].y + v[j].z * v[j].z + v[j].w * v[j].w;
                }
                ss = wave_sum(ss);
                const float rstd = rsqrtf(ss * (1.f / D) + EPS);
#pragma unroll
                for (int j = 0; j < 4; ++j) {
                    ((f32x4_t*)(X + (size_t)(r0 + r) * D))[lane + 64 * j] = v[j] * rstd * FG[j];
                }
            }
        };
        FinSet SA, SB;
        issue(SA, 0);
#pragma unroll
        for (int s2 = 0; s2 < 4; ++s2) {
            issue(SB, 2 * s2 + 1);
            __builtin_amdgcn_sched_barrier(0);
            consume(SA, 2 * s2);
            __builtin_amdgcn_sched_barrier(0);
            if (s2 < 3) issue(SA, 2 * s2 + 2);
            __builtin_amdgcn_sched_barrier(0);
            consume(SB, 2 * s2 + 1);
            __builtin_amdgcn_sched_barrier(0);
        }
    }
}

#define LAS __attribute__((address_space(3)))
#define XB_TMO      128
#define XB_XCNT(j)  (256  + 64 * (j))
#define XB_XSUB(j)  (1280 + 64 * (j))
#define XB_XGEN(j)  (2304 + 64 * (j))
#define XB_TOP      3328
#define XB_TOPGEN   3392
#define XCD_BAR_WORDS 3456
#define XB_SPIN_CAP (1u << 18)

__device__ __forceinline__ unsigned xb_ld(unsigned* p)              { return __hip_atomic_load(p, __ATOMIC_RELAXED, __HIP_MEMORY_SCOPE_AGENT); }
__device__ __forceinline__ unsigned xb_add(unsigned* p, unsigned v) { return __hip_atomic_fetch_add(p, v, __ATOMIC_RELAXED, __HIP_MEMORY_SCOPE_AGENT); }
__device__ __forceinline__ unsigned xb_xcc_id() { return (unsigned)__builtin_amdgcn_s_getreg((3 << 11) | 20) & 0xFu; }
#define XB_SPIN(cond, bar) do { unsigned _sp = 0; while (cond) { __builtin_amdgcn_s_sleep(1); \
    if ((++_sp & 255u) == 0u) { if (xb_ld(&(bar)[XB_TMO])) break; if (_sp > XB_SPIN_CAP) { atomicAdd(&(bar)[XB_TMO], 1u); break; } } } } while (0)

struct XcdBarrier {
    unsigned* bar; unsigned x;
    volatile LAS unsigned* st;
};

__device__ __forceinline__ XcdBarrier xcd_barrier_post(unsigned* bar, volatile LAS unsigned* st) {
    XcdBarrier b; b.bar = bar; b.x = xb_xcc_id(); b.st = st;
    if (threadIdx.x == 0) (void)xb_add(&bar[XB_XCNT(b.x)], 1u);
    return b;
}
__device__ __forceinline__ void xcd_barrier_complete(unsigned* bar, unsigned x, unsigned& nloc, unsigned& nx) {
    const unsigned G = gridDim.x * gridDim.y * gridDim.z;
    unsigned sum, cnt, mine, sp = 0u;
    for (;;) {
        sum = 0u; cnt = 0u; mine = 0u;
#pragma unroll
        for (unsigned j = 0; j < 16; ++j) { const unsigned c = xb_ld(&bar[XB_XCNT(j)]); sum += c; cnt += (c > 0u) ? 1u : 0u; mine = (j == x) ? c : mine; }
        if (sum == G) break;
        __builtin_amdgcn_s_sleep(1);
        if ((++sp & 255u) == 0u) { if (xb_ld(&bar[XB_TMO])) break; if (sp > XB_SPIN_CAP) { atomicAdd(&bar[XB_TMO], 1u); break; } }
    }
    nloc = mine > 0u ? mine : 1u; nx = cnt > 0u ? cnt : 1u;
}

__device__ __forceinline__ void xcd_barrier(const XcdBarrier& b) {
    asm volatile("s_waitcnt vmcnt(0)" ::: "memory");
    __syncthreads();
    if (threadIdx.x == 0) {
        unsigned* bar = b.bar;
        __builtin_amdgcn_s_waitcnt(0);
        unsigned nloc = b.st[0], nx = b.st[1];
        if (nloc == 0u) { xcd_barrier_complete(bar, b.x, nloc, nx); b.st[0] = nloc; b.st[1] = nx; }
        const unsigned old = xb_add(&bar[XB_XSUB(b.x)], 1u);
        const unsigned gen = old / nloc;
        if (old + 1u == (gen + 1u) * nloc) {
            __builtin_amdgcn_fence(__ATOMIC_RELEASE, "agent");
            asm volatile("s_waitcnt vmcnt(0)" ::: "memory");
            const unsigned og = xb_add(&bar[XB_TOP], 1u);
            const unsigned tg = og / nx;
            if (og + 1u == (tg + 1u) * nx) xb_add(&bar[XB_TOPGEN], 1u);
            else XB_SPIN(xb_ld(&bar[XB_TOPGEN]) == tg, bar);
            __builtin_amdgcn_fence(__ATOMIC_ACQUIRE, "agent");
            xb_add(&bar[XB_XGEN(b.x)], 1u);
            asm volatile("s_waitcnt vmcnt(0)" ::: "memory");
        } else {
            XB_SPIN(xb_ld(&bar[XB_XGEN(b.x)]) == gen, bar);
            __builtin_amdgcn_fence(__ATOMIC_ACQUIRE, "agent");
            asm volatile("s_waitcnt vmcnt(0)" ::: "memory");
        }
    }
    __syncthreads();
}

constexpr int N_PHASES = 11;
template <int PH>
__device__ __forceinline__ void run_phase(const P& p, unsigned char* ldsb) {
    float* lds = (float*)ldsb;
    if constexpr (PH == 0) { ph_prep(p, lds); ph_convert_small(p, lds); }
    else if constexpr (PH == 1) ph_norm1(p);
    else if constexpr (PH == 2) ph_inproj(p, ldsb);
    else if constexpr (PH == 3) ph_mixers<0>(p, ldsb);
    else if constexpr (PH == 4) ph_mixprep(p, lds);
    else if constexpr (PH == 5) ph_outproj(p, ldsb);
    else if constexpr (PH == 6) ph_norm2_router(p, lds);
    else if constexpr (PH == 7) ph_topk(p, lds);
    else if constexpr (PH == 8) ph_moe_up(p, ldsb);
    else if constexpr (PH == 9) ph_moe_down(p, ldsb);
    else if constexpr (PH == 10) ph_final(p);
}
template <int PH>
__device__ __forceinline__ void run_from(const P& p, unsigned char* lds, const XcdBarrier& bar) {
    if constexpr (PH < N_PHASES) {
        run_phase<PH>(p, lds);
        if constexpr (PH + 1 < N_PHASES) xcd_barrier(bar);
        run_from<PH + 1>(p, lds, bar);
    }
}
__global__ void __launch_bounds__(NT, 2) fwd_all(P p) {
    extern __shared__ __attribute__((aligned(16))) unsigned char lds_raw[];
    volatile LAS unsigned* st = (volatile LAS unsigned*)(lds_raw + LDS_BYTES - 32);
    if (threadIdx.x < 2) st[threadIdx.x] = 0u;
    __syncthreads();
    const XcdBarrier bar = xcd_barrier_post((unsigned*)(p.ws + WS_CTL) + CW_BAR, st);
    run_from<0>(p, lds_raw, bar);
}

extern "C" void kernel_launch(void* const* d_in, const int* in_sizes, int n_in, void* d_out, int out_size, void* d_ws, size_t ws_size, hipStream_t stream) {
    static int grid = 0;
    if (grid == 0) {
        int dev = 0, cus = 0, per_cu = 0;
        (void)hipGetDevice(&dev);
        (void)hipDeviceGetAttribute(&cus, hipDeviceAttributeMultiprocessorCount, dev);
        (void)hipFuncSetAttribute((const void*)fwd_all, hipFuncAttributeMaxDynamicSharedMemorySize, LDS_BYTES);
        (void)hipOccupancyMaxActiveBlocksPerMultiprocessor(&per_cu, (const void*)fwd_all, NT, LDS_BYTES);
        if (per_cu < 1) fprintf(stderr, "kernel_launch: occupancy query says %d blocks/CU\n", per_cu);
        grid = (cus > 0 ? cus : 256);
        if (ws_size < WS_END) fprintf(stderr, "kernel_launch: workspace too small: %zu < %zu\n", ws_size, (size_t)WS_END);
    }
    P p{};
    const float** f = (const float**)&p;
    for (int i = 0; i < 28; ++i) f[i] = (const float*)d_in[i];
    p.out = (float*)d_out;
    p.ws = (unsigned char*)d_ws;
    p.ph_lo = 0; p.ph_hi = N_PHASES;
    (void)hipMemsetAsync((unsigned char*)d_ws + WS_CTL, 0, CTL_ZERO_BYTES, stream);
    hipLaunchKernelGGL(fwd_all, dim3(grid), dim3(NT), LDS_BYTES, stream, p);
}
```

```cpp
#include <hip/hip_runtime.h>
#include <cstdio>
#include <cstdint>

constexpr int D = 1024, NB = 16, SEQ = 2048, CTXL = 256;
constexpr int NTOK = NB * SEQ;
constexpr int NCTX = NB * CTXL;
constexpr int HEADS = 4;
constexpr int INC = 4096;
constexpr int NE = 16, CAP = 256, FF = 2048;
constexpr int NT = 512;
constexpr int LDS_BYTES = 149504;
constexpr float EPS = 1e-6f;
typedef unsigned short bf16_t;

constexpr size_t MiB = 1u << 20;
constexpr size_t WS_CTL = 0;
constexpr size_t WS_ADA = 1 * MiB;
constexpr size_t WS_LB = WS_ADA + 512 * 1024;
constexpr size_t WS_HID2 = 2 * MiB;
constexpr size_t WS_AFF = 3 * MiB;
constexpr size_t WS_IDX = 5 * MiB;
constexpr size_t WS_GATE = 5 * MiB + 512 * 1024;
constexpr size_t WS_INV = 6 * MiB;
constexpr size_t WS_W13T = 8 * MiB;
constexpr size_t WS_YS = WS_W13T;
constexpr size_t WS_W2T = 136 * MiB;
constexpr size_t WS_R = 200 * MiB;
constexpr size_t WS_H = WS_R;
constexpr size_t WS_MIXA = WS_R;
constexpr size_t WS_HC = WS_R + 64 * MiB;
constexpr size_t WS_PC = WS_R + 72 * MiB;
constexpr size_t WS_OFB = WS_R + 84 * MiB;
constexpr size_t WS_WOUTT = WS_R + 148 * MiB;
constexpr size_t WS_PHG = WS_R + 152 * MiB;
constexpr size_t WS_HMID = WS_R;
constexpr size_t WS_H2 = WS_R + 256 * MiB;
constexpr size_t WS_YT = WS_R + 320 * MiB;
constexpr size_t WS_END = WS_YT + 32 * MiB;
constexpr int CW_QHEAD = 64;
constexpr int CW_BAR = 4096;
constexpr size_t CTL_ZERO_BYTES = 65536;
constexpr size_t DO_PHYT = 0;
constexpr size_t DO_HF = 96 * MiB;
constexpr size_t DO_SCTX = 112 * MiB;
constexpr size_t DO_WINT = 120 * MiB;

struct P {
    const float *x, *c, *ctx, *c_ctx, *ada_w, *ada_b, *norm1_g, *w_in, *hy_conv_w, *hy_conv_b, *pos_w1, *pos_b1, *freq1, *pos_w2, *pos_b2,
        *freq2, *pos_w3, *hy_bias, *hy_norm_g, *hg_lb, *hg_norm_g, *w_out, *norm2_g, *router_w, *exp_w1, *exp_w3, *exp_w2, *final_g;
    float* out;
    unsigned char* ws;
    int ph_lo, ph_hi;
};

__device__ __forceinline__ int opaque_tid() { int t = threadIdx.x; asm volatile("" : "+v"(t)); return t; }
__device__ __forceinline__ void lds_barrier() { asm volatile("s_waitcnt lgkmcnt(0)" ::: "memory"); __builtin_amdgcn_s_barrier(); asm volatile("" ::: "memory"); }
typedef float f32x4_t __attribute__((ext_vector_type(4)));
__device__ __forceinline__ float wave_sum(float v) {
#pragma unroll
    for (int o = 1; o < 64; o <<= 1) v += __shfl_xor(v, o);
    return v;
}
__device__ __forceinline__ float sigmoidf_(float z) { return 1.f / (1.f + expf(-z)); }
__device__ __forceinline__ float siluf_(float z) { return z / (1.f + expf(-z)); }
__device__ __forceinline__ float silu_f(float z) { return z * __builtin_amdgcn_rcpf(1.0f + __builtin_amdgcn_exp2f(-1.4426950408889634f * z)); }
__device__ __forceinline__ float bf2f(bf16_t h) { return __uint_as_float((unsigned)h << 16); }
__device__ __forceinline__ unsigned f2bf(float f) { unsigned u = __float_as_uint(f); return (u + 0x7fffu + ((u >> 16) & 1u)) >> 16; }
typedef float f32x2_cv __attribute__((ext_vector_type(2))); typedef __bf16 bf16x2_cv __attribute__((ext_vector_type(2)));
__device__ __forceinline__ unsigned cvtpk(float lo, float hi) { const f32x2_cv v = {lo, hi}; const bf16x2_cv b = __builtin_convertvector(v, bf16x2_cv); return __builtin_bit_cast(unsigned, b); }
__device__ __forceinline__ unsigned pk2(float lo, float hi) { return f2bf(lo) | (f2bf(hi) << 16); }

namespace pg8 {
#define PG8_LAS __attribute__((address_space(3)))
typedef unsigned short bf16_t;
typedef short bf16x8 __attribute__((ext_vector_type(8)));
typedef float f32x4 __attribute__((ext_vector_type(4)));
typedef unsigned u32x4 __attribute__((ext_vector_type(4)));
constexpr int BM = 256, BK = 64, HALF = 128, HTB = HALF * BK * 2  , STAGE_BYTES = 8 * HTB, NXCD = 8, WGM = 8;

__host__ __device__ __forceinline__ int lds_byte(int r, int c) { const int st = (r >> 4) * 2 + (c >> 5), rr = r & 15, cc = c & 31, ob = rr * 64 + cc * 2; return st * 1024 + (ob ^ (((ob >> 9) & 1) << 5)); }
__host__ __device__ __forceinline__ void stage_rc(int b, int& R, int& C) { const int st = b / 1024, sb = b % 1024, swz = sb ^ (((sb >> 9) & 1) << 5); R = (st >> 1) * 16 + swz / 64; C = (st & 1) * 32 + (swz % 64) / 2; }
__host__ __device__ __forceinline__ int perm32(int rho) { const int n = rho >> 4, i = rho & 15; return 8 * (i >> 2) + 4 * n + (i & 3); }

struct Unit { const char* a; const char* b; bf16_t* c; const float* aux; const int* gidx; int ldc, row0, col0; };
__device__ __forceinline__ unsigned cvt_pk_bf16(float lo, float hi) { unsigned r; asm volatile("v_cvt_pk_bf16_f32 %0, %1, %2" : "=v"(r) : "v"(lo), "v"(hi)); return r; }

__device__ __forceinline__ void tile_of(int L, int nM, int nN, int& pm, int& pn) {
    const int nwg = nM * nN; int wgid = L;
    { const int q = nwg / NXCD, r = nwg % NXCD, xcd = wgid % NXCD, off = wgid / NXCD; wgid = (xcd < r ? xcd * (q + 1) : r * (q + 1) + (xcd - r) * q) + off; }
    const int nig = WGM * nN, gid = wgid / nig, fm = gid * WGM, gsz = (nM - fm) < WGM ? (nM - fm) : WGM;
    pm = fm + ((wgid % nig) % gsz); pn = (wgid % nig) / gsz;
}

struct EpiStoreBf16 {
    static constexpr bool PERM = true, AFTER_DRAIN = false;
    __device__ __forceinline__ void operator()(const f32x4 (&acc)[2][2][4][2], const Unit& u, int wr, int wc, int fr, int fq) const {
        bf16_t* base = u.c + (size_t)(wr * 64 + fr) * u.ldc + wc * 32 + 8 * fq;
#pragma unroll
        for (int ai = 0; ai < 2; ++ai)
#pragma unroll
            for (int m = 0; m < 4; ++m) { bf16_t* rowp = base + (size_t)(ai * HALF + m * 16) * u.ldc;
#pragma unroll
                for (int bj = 0; bj < 2; ++bj) { const f32x4 v0 = acc[ai][bj][m][0], v1 = acc[ai][bj][m][1];
                    u32x4 w; w.x = cvt_pk_bf16(v0[0], v0[1]); w.y = cvt_pk_bf16(v0[2], v0[3]); w.z = cvt_pk_bf16(v1[0], v1[1]); w.w = cvt_pk_bf16(v1[2], v1[3]);
                    *(u32x4*)(rowp + bj * HALF) = w; } }
    }
};
struct EpiOutProj {
    static constexpr bool PERM = true, AFTER_DRAIN = false;
    const float* x; const float* ada; bf16_t* x1;
    __device__ __forceinline__ void operator()(const f32x4 (&acc)[2][2][4][2], const Unit& u, int wr, int wc, int fr, int fq) const {
        const float* g1 = ada + (u.row0 >> 11) * 6144 + 2048;
#pragma unroll
        for (int bj = 0; bj < 2; ++bj) { const int col = u.col0 + bj * HALF + wc * 32 + 8 * fq; const f32x4 g0 = *(const f32x4*)(g1 + col), gB = *(const f32x4*)(g1 + col + 4);
            f32x4 xv[2][4][2];
#pragma unroll
            for (int ai = 0; ai < 2; ++ai)
#pragma unroll
                for (int m = 0; m < 4; ++m) { const size_t row = (size_t)(u.row0 + ai * HALF + wr * 64 + m * 16 + fr); xv[ai][m][0] = *(const f32x4*)(x + row * D + col); xv[ai][m][1] = *(const f32x4*)(x + row * D + col + 4); }
#pragma unroll
            for (int ai = 0; ai < 2; ++ai)
#pragma unroll
                for (int m = 0; m < 4; ++m) { const size_t row = (size_t)(u.row0 + ai * HALF + wr * 64 + m * 16 + fr);
                    const f32x4 v0 = xv[ai][m][0] + g0 * acc[ai][bj][m][0], v1 = xv[ai][m][1] + gB * acc[ai][bj][m][1];
                    u32x4 w; w.x = cvt_pk_bf16(v0[0], v0[1]); w.y = cvt_pk_bf16(v0[2], v0[3]); w.z = cvt_pk_bf16(v1[0], v1[1]); w.w = cvt_pk_bf16(v1[2], v1[3]);
                    *(u32x4*)(x1 + row * (2 * D) + col) = w; } }
    }
};
__device__ __forceinline__ float silu_fast(float a) { return a * __builtin_amdgcn_rcpf(1.0f + __builtin_amdgcn_exp2f(-1.4426950408889634f * a)); }
struct EpiSwiGLU {
    static constexpr bool PERM = true, AFTER_DRAIN = false;
    __device__ __forceinline__ void operator()(const f32x4 (&acc)[2][2][4][2], const Unit& u, int wr, int wc, int fr, int fq) const {
        bf16_t* base = u.c + (size_t)(wr * 64 + fr) * FF + wc * 32 + 8 * fq;
#pragma unroll
        for (int ai = 0; ai < 2; ++ai)
#pragma unroll
            for (int m = 0; m < 4; ++m) { const f32x4 a0 = acc[ai][0][m][0], a1 = acc[ai][0][m][1], b0 = acc[ai][1][m][0], b1 = acc[ai][1][m][1];
                u32x4 w; w.x = cvt_pk_bf16(silu_fast(a0[0]) * b0[0], silu_fast(a0[1]) * b0[1]); w.y = cvt_pk_bf16(silu_fast(a0[2]) * b0[2], silu_fast(a0[3]) * b0[3]);
                w.z = cvt_pk_bf16(silu_fast(a1[0]) * b1[0], silu_fast(a1[1]) * b1[1]); w.w = cvt_pk_bf16(silu_fast(a1[2]) * b1[2], silu_fast(a1[3]) * b1[3]);
                *(u32x4*)(base + (size_t)(ai * HALF + m * 16) * FF) = w; }
    }
};
struct EpiDown {
    static constexpr bool PERM = true, AFTER_DRAIN = false;
    __device__ __forceinline__ void operator()(const f32x4 (&acc)[2][2][4][2], const Unit& u, int wr, int wc, int fr, int fq) const {
        bf16_t* base = u.c + (size_t)(wr * 64 + fr) * D + wc * 32 + 8 * fq;
        float gts[2][4];
#pragma unroll
        for (int ai = 0; ai < 2; ++ai)
#pragma unroll
            for (int m = 0; m < 4; ++m) gts[ai][m] = u.aux[ai * HALF + wr * 64 + m * 16 + fr];
#pragma unroll
        for (int ai = 0; ai < 2; ++ai)
#pragma unroll
            for (int m = 0; m < 4; ++m) { const float gt = gts[ai][m]; bf16_t* rowp = base + (size_t)(ai * HALF + m * 16) * D;
#pragma unroll
                for (int bj = 0; bj < 2; ++bj) { const f32x4 v0 = acc[ai][bj][m][0] * gt, v1 = acc[ai][bj][m][1] * gt;
                    u32x4 w; w.x = cvt_pk_bf16(v0[0], v0[1]); w.y = cvt_pk_bf16(v0[2], v0[3]); w.z = cvt_pk_bf16(v1[0], v1[1]); w.w = cvt_pk_bf16(v1[2], v1[3]);
                    *(u32x4*)(rowp + bj * HALF) = w; } }
    }
};

template <class Epi, class Sched, bool ALIGN_EPI = false, bool SP2 = false, bool GATHER = false>
__device__ __forceinline__ void gemm_phase(PG8_LAS unsigned char* lds, const int K, const Sched& S, const Epi& E) {
    const int tid = opaque_tid(), wid = __builtin_amdgcn_readfirstlane(tid >> 6), lane = tid & 63, wr = wid >> 2, wc = wid & 3, fr = lane & 15, fq = lane >> 4;
    const int nt = K / BK;
    unsigned voffA[2], voffB[2];
#pragma unroll
    for (int i = 0; i < 2; ++i) { int R, C; stage_rc(tid * 16 + i * 8192, R, C); const int Rb = Epi::PERM ? ((R & ~31) + perm32(R & 31)) : R;
        voffA[i] = (unsigned)(R * K + C) * 2u; voffB[i] = (unsigned)(Rb * K + C) * 2u; }
    const size_t kstep = (size_t)(BK * 2);
    const size_t hstep = (size_t)HALF * K * 2;
    const unsigned ldsw = (unsigned)wid * 1024u;
    const int aoff = lds_byte(wr * 64 + fr, fq * 8), boff = lds_byte(wc * 32 + fr, fq * 8);
#define PG8_SA(b, h) (((b) * 2 + (h)) * HTB)
#define PG8_SB(b, h) ((4 + (b) * 2 + (h)) * HTB)
#define PG8_STAGE(bufoff, gbase, voff) do { _Pragma("unroll") for (int _i = 0; _i < 2; ++_i) \
        __builtin_amdgcn_global_load_lds((const unsigned*)((const char*)(gbase) + (voff)[_i]), (PG8_LAS unsigned*)(lds + (bufoff) + ldsw + _i * 8192), 16, 0, 0); } while (0)
#define PG8_STAGE_A(bufoff, gbase, h) do { _Pragma("unroll") for (int _i = 0; _i < 2; ++_i) \
        __builtin_amdgcn_global_load_lds((const unsigned*)((const char*)(gbase) + voffAh[h][_i]), (PG8_LAS unsigned*)(lds + (bufoff) + ldsw + _i * 8192), 16, 0, 0); } while (0)
#define PG8_LDA(dst, b, h) do { _Pragma("unroll") for (int m = 0; m < 4; ++m) _Pragma("unroll") for (int k = 0; k < 2; ++k) dst[m][k] = *(const PG8_LAS bf16x8*)(lds + PG8_SA(b, h) + aoff + m * 2048 + k * 1024); } while (0)
#define PG8_LDB(dst, b, h) do { _Pragma("unroll") for (int n = 0; n < 2; ++n) _Pragma("unroll") for (int k = 0; k < 2; ++k) dst[n][k] = *(const PG8_LAS bf16x8*)(lds + PG8_SB(b, h) + boff + n * 2048 + k * 1024); } while (0)
#define PG8_MMA(ai, bj, At, Bt) do { __builtin_amdgcn_s_setprio(1); _Pragma("unroll") for (int m = 0; m < 4; ++m) _Pragma("unroll") for (int n = 0; n < 2; ++n) _Pragma("unroll") for (int k = 0; k < 2; ++k) \
        acc[ai][bj][m][n] = __builtin_amdgcn_mfma_f32_16x16x32_bf16(Bt[n][k], At[m][k], acc[ai][bj][m][n], 0, 0, 0); __builtin_amdgcn_s_setprio(0); } while (0)
#define PG8_WAIT_V(n) asm volatile("s_waitcnt vmcnt(" #n ")" ::: "memory")
#define PG8_WAIT_L(n) asm volatile("s_waitcnt lgkmcnt(" #n ")" ::: "memory")
#define PG8_BAR __builtin_amdgcn_s_barrier()
#define PG8_SCHED __builtin_amdgcn_sched_barrier(0)
    Unit cur, nxt; int ui = 0;
    if (!S.next(0, cur)) return;
    unsigned voffAh[2][2];
#pragma unroll
    for (int h = 0; h < 2; ++h)
#pragma unroll
        for (int i = 0; i < 2; ++i) {
            if constexpr (GATHER) { int R, C; stage_rc(tid * 16 + i * 8192, R, C); voffAh[h][i] = ((unsigned)cur.gidx[h * HALF + R] * (unsigned)K + (unsigned)C) * 2u; }
            else voffAh[h][i] = voffA[i] + (unsigned)h * (unsigned)hstep;
        }
    f32x4 acc[2][2][4][2];
#pragma unroll
    for (int a = 0; a < 2; ++a)
#pragma unroll
        for (int b = 0; b < 2; ++b)
#pragma unroll
            for (int m = 0; m < 4; ++m)
#pragma unroll
                for (int n = 0; n < 2; ++n) acc[a][b][m][n] = (f32x4){0.f, 0.f, 0.f, 0.f};
    bf16x8 At[4][2], B0[2][2], B1[2][2];
    const char* cA = cur.a; const char* cB = cur.b;
    S.a_ready(cur);
    if constexpr (SP2) {
        PG8_STAGE(PG8_SB(0, 0), cB, voffB); PG8_STAGE(PG8_SB(0, 1), cB + hstep, voffB); PG8_STAGE_A(PG8_SA(0, 0), cA, 0); PG8_STAGE_A(PG8_SA(0, 1), cA, 1);
        if (wr == 1) PG8_BAR;
        PG8_WAIT_V(2); PG8_BAR;
        PG8_STAGE(PG8_SB(1, 0), cB + kstep, voffB); PG8_STAGE_A(PG8_SA(1, 0), cA + kstep, 0); PG8_STAGE(PG8_SB(1, 1), cB + hstep + kstep, voffB);
        PG8_WAIT_V(6); PG8_BAR;
    } else {
        PG8_STAGE(PG8_SB(0, 0), cB, voffB); PG8_STAGE_A(PG8_SA(0, 0), cA, 0); PG8_STAGE(PG8_SB(0, 1), cB + hstep, voffB); PG8_STAGE_A(PG8_SA(0, 1), cA, 1);
        if (wr == 1) PG8_BAR;
        PG8_WAIT_V(4); PG8_BAR;
        PG8_STAGE(PG8_SB(1, 0), cB + kstep, voffB); PG8_STAGE_A(PG8_SA(1, 0), cA + kstep, 0); PG8_STAGE(PG8_SB(1, 1), cB + hstep + kstep, voffB);
        PG8_WAIT_V(6); PG8_BAR;
    }
    for (;;) {
        const bool has_next = S.next(ui + 1, nxt);
        const char* nA = has_next ? nxt.a : cA; const char* nB = has_next ? nxt.b : cB;
        for (int t = 0; t < nt; t += 2) {
            const bool last = (t == nt - 2);
            const char* a1 = cA + (size_t)(t + 1) * kstep;
            const char* a2 = last ? nA : cA + (size_t)(t + 2) * kstep; const char* b2 = last ? nB : cB + (size_t)(t + 2) * kstep;
            const char* a3 = a2 + kstep; const char* b3 = b2 + kstep;
            if (last && has_next) S.a_ready(nxt);
            if constexpr (SP2) {
            PG8_LDB(B0, 0, 0); PG8_LDB(B1, 0, 1); PG8_SCHED; PG8_LDA(At, 0, 0); PG8_STAGE_A(PG8_SA(1, 1), a1, 1);
            PG8_WAIT_V(8); PG8_WAIT_L(0); PG8_BAR; PG8_MMA(0, 0, At, B0); PG8_MMA(0, 1, At, B1); PG8_BAR; PG8_SCHED;
            PG8_LDA(At, 0, 1); PG8_STAGE(PG8_SB(0, 0), b2, voffB); PG8_STAGE(PG8_SB(0, 1), b2 + hstep, voffB); PG8_STAGE_A(PG8_SA(0, 0), a2, 0);
            PG8_WAIT_V(8); PG8_WAIT_L(0); PG8_BAR; PG8_MMA(1, 0, At, B0); PG8_MMA(1, 1, At, B1); PG8_BAR; PG8_SCHED;
            PG8_LDB(B0, 1, 0); PG8_LDB(B1, 1, 1); PG8_SCHED; PG8_LDA(At, 1, 0); PG8_STAGE_A(PG8_SA(0, 1), a2, 1);
            PG8_WAIT_V(8); PG8_WAIT_L(0); PG8_BAR; PG8_MMA(0, 0, At, B0); PG8_MMA(0, 1, At, B1); PG8_BAR; PG8_SCHED;
            PG8_LDA(At, 1, 1); PG8_STAGE(PG8_SB(1, 0), b3, voffB); PG8_STAGE(PG8_SB(1, 1), b3 + hstep, voffB); PG8_STAGE_A(PG8_SA(1, 0), a3, 0);
            PG8_WAIT_V(8); PG8_WAIT_L(0); PG8_BAR; PG8_MMA(1, 0, At, B0); PG8_MMA(1, 1, At, B1); PG8_BAR; PG8_SCHED;
            } else {
            PG8_LDB(B0, 0, 0); PG8_SCHED; PG8_LDA(At, 0, 0); PG8_STAGE_A(PG8_SA(1, 1), a1, 1);
            PG8_WAIT_L(8); PG8_BAR; PG8_WAIT_L(0); PG8_MMA(0, 0, At, B0); PG8_BAR; PG8_SCHED;
            PG8_LDB(B1, 0, 1); PG8_STAGE(PG8_SB(0, 0), b2, voffB);
            PG8_BAR; PG8_WAIT_L(0); PG8_MMA(0, 1, At, B1); PG8_BAR;
            PG8_LDA(At, 0, 1); PG8_STAGE_A(PG8_SA(0, 0), a2, 0);
            PG8_BAR; PG8_WAIT_L(0); PG8_MMA(1, 0, At, B0); PG8_BAR; PG8_SCHED;
            PG8_STAGE(PG8_SB(0, 1), b2 + hstep, voffB);
            PG8_WAIT_V(6); PG8_BAR; PG8_MMA(1, 1, At, B1); PG8_BAR;
            PG8_LDB(B0, 1, 0); PG8_SCHED; PG8_LDA(At, 1, 0); PG8_STAGE_A(PG8_SA(0, 1), a2, 1);
            PG8_WAIT_L(8); PG8_BAR; PG8_WAIT_L(0); PG8_MMA(0, 0, At, B0); PG8_BAR; PG8_SCHED;
            PG8_LDB(B1, 1, 1); PG8_STAGE(PG8_SB(1, 0), b3, voffB);
            PG8_BAR; PG8_WAIT_L(0); PG8_MMA(0, 1, At, B1); PG8_BAR;
            PG8_LDA(At, 1, 1); PG8_STAGE_A(PG8_SA(1, 0), a3, 0);
            PG8_BAR; PG8_WAIT_L(0); PG8_MMA(1, 0, At, B0); PG8_BAR; PG8_SCHED;
            PG8_STAGE(PG8_SB(1, 1), b3 + hstep, voffB);
            PG8_WAIT_V(6); PG8_BAR; PG8_MMA(1, 1, At, B1); PG8_BAR;
            }
        }
        if constexpr (ALIGN_EPI) { if (wr == 0) PG8_BAR; }
        if constexpr (!Epi::AFTER_DRAIN) { E(acc, cur, wr, wc, fr, fq); S.done(cur); }
        if (!has_next) break;
#pragma unroll
        for (int a = 0; a < 2; ++a)
#pragma unroll
            for (int b = 0; b < 2; ++b)
#pragma unroll
                for (int m = 0; m < 4; ++m)
#pragma unroll
                    for (int n = 0; n < 2; ++n) acc[a][b][m][n] = (f32x4){0.f, 0.f, 0.f, 0.f};
        cur = nxt; cA = nA; cB = nB; ++ui;
        if constexpr (ALIGN_EPI) { if (wr == 1) PG8_BAR; }
    }
    PG8_WAIT_V(0);
    if constexpr (!ALIGN_EPI) { if (wr == 0) PG8_BAR; }
    PG8_BAR;
    if constexpr (Epi::AFTER_DRAIN) { E.fused(acc, cur, wr, wc, fr, fq, lds, wid, lane); S.done(cur); }
#undef PG8_SA
#undef PG8_SB
#undef PG8_STAGE
#undef PG8_LDA
#undef PG8_LDB
#undef PG8_MMA
#undef PG8_WAIT_V
#undef PG8_WAIT_L
#undef PG8_BAR
#undef PG8_SCHED
}
}
using pg8::Unit; using pg8::tile_of;

__device__ __forceinline__ void ph_prep(const P& p, float* lds) {
    const int tid = opaque_tid(), G = gridDim.x;
    float* ADA = (float*)(p.ws + WS_ADA);
    float* LB = (float*)(p.ws + WS_LB);
    float* HID2 = (float*)(p.ws + WS_HID2);
    {
        float* s = lds;
        float* red = lds + 17 * 1024;
        if (blockIdx.x < 192) {
            const int item = blockIdx.x;
            typedef float f32x2_t __attribute__((ext_vector_type(2)));
            const int jj2 = tid & 15, ks = tid >> 4, j = item * 32 + 2 * jj2;
            f32x2_t wv[32];
#pragma unroll
            for (int q = 0; q < 32; ++q) wv[q] = *(const f32x2_t*)(p.ada_w + (size_t)(ks * 32 + q) * 6144 + j);
            float cv[34];
#pragma unroll
            for (int u = 0; u < 34; ++u) cv[u] = u < 32 ? p.c[(u >> 1) * 1024 + tid + NT * (u & 1)] : p.c_ctx[tid + NT * (u & 1)];
#pragma unroll
            for (int u = 0; u < 34; ++u) s[tid + NT * u] = siluf_(cv[u]);
            __syncthreads();
            f32x2_t acc[17];
#pragma unroll
            for (int r = 0; r < 17; ++r) acc[r] = (f32x2_t){0.f, 0.f};
#pragma unroll
            for (int q4 = 0; q4 < 8; ++q4) {
#pragma unroll
                for (int r = 0; r < 17; ++r) {
                    const f32x4_t sv = *(const f32x4_t*)&s[r * 1024 + ks * 32 + 4 * q4];
                    acc[r] += sv.x * wv[4 * q4] + sv.y * wv[4 * q4 + 1] + sv.z * wv[4 * q4 + 2] + sv.w * wv[4 * q4 + 3];
                }
            }
#pragma unroll
            for (int r = 0; r < 17; ++r) *(f32x2_t*)&red[(ks * 17 + r) * 32 + 2 * jj2] = acc[r];
            __syncthreads();
            for (int i = tid; i < 17 * 32; i += NT) {
                const int r = i >> 5, j2 = i & 31;
                float sum = 0.f;
#pragma unroll
                for (int k = 0; k < 32; ++k) sum += red[(k * 17 + r) * 32 + j2];
                ADA[r * 6144 + item * 32 + j2] = sum + p.ada_b[item * 32 + j2];
            }
            __syncthreads();
        }
    }
    if (blockIdx.x == G - 1) {
        for (int i = tid; i < 1024; i += NT) {
            const float a0 = p.hg_lb[i], a1 = p.hg_lb[1024 + i];
            LB[i] = 1.f / (1.f + expf(a1 - a0));
        }
    }
    {
        float* zl = lds;
        float* h1 = lds + 512;
        __syncthreads();
        for (int it = (G - 1 - blockIdx.x); it < SEQ / 8; it += G) {
            const int lt = tid >> 6, j = tid & 63, t = it * 8 + lt;
            const float w = 6.283185307179586f * (float)t / 2048.0f;
            if (j == 0) zl[lt * 64] = (float)t / 2047.0f;
            if (j >= 1 && j < 17) { const float f = 1e-4f + (float)(j - 1) * ((15.0f - 1e-4f) / 15.0f); zl[lt * 64 + j] = cosf(f * w); }
            if (j >= 17 && j < 33) { const float f = 1e-4f + (float)(j - 17) * ((15.0f - 1e-4f) / 15.0f); zl[lt * 64 + j] = -sinf(f * w); }
            __syncthreads();
            float a = p.pos_b1[j];
            for (int i = 0; i < 33; ++i) a += zl[lt * 64 + i] * p.pos_w1[i * 64 + j];
            h1[lt * 64 + j] = sinf(p.freq1[j] * a);
            __syncthreads();
            float b = p.pos_b2[j];
            for (int i = 0; i < 64; ++i) b += h1[lt * 64 + i] * p.pos_w2[i * 64 + j];
            HID2[t * 64 + j] = sinf(p.freq2[j] * b);
            __syncthreads();
        }
    }
}
struct ConvItem { const float* W; bf16_t* dst; int N, KD, k0, n0, which; };
__device__ __forceinline__ ConvItem conv_small_item(const P& p, int it) {
    ConvItem c; c.which = 0; c.KD = D;
    if (it < 256) { c.W = p.w_in; c.N = INC; c.k0 = (it / 16) * 64; c.n0 = (it % 16) * 256; c.dst = (bf16_t*)((unsigned char*)p.out + DO_WINT); }
    else { const int r = it - 256; c.W = p.w_out; c.N = D; c.k0 = (r / 4) * 64; c.n0 = (r % 4) * 256; c.dst = (bf16_t*)(p.ws + WS_WOUTT); }
    return c;
}
constexpr int N_EXPERT_ITEMS = 2 * 16 * 16 * 8 + 16 * 32 * 4;
__device__ __forceinline__ ConvItem conv_expert_item(const P& p, int r) {
    ConvItem c; constexpr int I_W1 = 16 * 16 * 8;
    if (r < 2 * I_W1) {
        const int which = r / I_W1; r %= I_W1;
        const int e = r / 128, r2 = r % 128;
        c.W = (which == 0 ? p.exp_w1 : p.exp_w3) + (size_t)e * D * FF; c.N = FF; c.k0 = (r2 / 8) * 64; c.n0 = (r2 % 8) * 256; c.dst = (bf16_t*)(p.ws + WS_W13T) + (size_t)e * 4096 * D; c.KD = D; c.which = 1 + which;
    } else {
        r -= 2 * I_W1; const int e = r / 128, r2 = r % 128;
        c.W = p.exp_w2 + (size_t)e * FF * D; c.N = D; c.k0 = (r2 / 4) * 64; c.n0 = (r2 % 4) * 256; c.dst = (bf16_t*)(p.ws + WS_W2T) + (size_t)e * 1024 * FF; c.KD = FF; c.which = 0;
    }
    return c;
}
typedef unsigned cv_u32x4 __attribute__((ext_vector_type(4)));
__device__ __forceinline__ void conv_load(const ConvItem& c, f32x4_t (&v)[8], int tid) {
    const float* src = c.W + (size_t)(c.k0 + 2 * (tid >> 6)) * c.N + c.n0 + 4 * (tid & 63);
#pragma unroll
    for (int qq = 0; qq < 4; ++qq) { v[2 * qq] = *(const f32x4_t*)(src + (size_t)(16 * qq) * c.N); v[2 * qq + 1] = *(const f32x4_t*)(src + (size_t)(16 * qq + 1) * c.N); }
}
__device__ __forceinline__ void conv_tile_write(const f32x4_t (&v)[8], float* T, int tid) {
    unsigned* T2 = (unsigned*)T;
    const int n4 = tid & 63, kw = tid >> 6;
#pragma unroll
    for (int qq = 0; qq < 4; ++qq)
        *(cv_u32x4*)&T2[(8 * qq + kw) * 260 + ((4 * n4) ^ (4 * qq))] = (cv_u32x4){cvtpk(v[2 * qq].x, v[2 * qq + 1].x), cvtpk(v[2 * qq].y, v[2 * qq + 1].y), cvtpk(v[2 * qq].z, v[2 * qq + 1].z), cvtpk(v[2 * qq].w, v[2 * qq + 1].w)};
}
__device__ __forceinline__ void conv_tile_store(const ConvItem& c, const float* T, int tid) {
    const unsigned* T2 = (const unsigned*)T;
#pragma unroll
    for (int q = 0; q < 4; ++q) { const int i = tid + NT * q, nl = i >> 3, ch = i & 7, n = c.n0 + nl;
        unsigned a[4];
#pragma unroll
        for (int e = 0; e < 4; ++e) a[e] = T2[(4 * ch + e) * 260 + (nl ^ ((ch >> 1) << 2))];
        const int row = c.which == 0 ? n : ((n >> 7) * 256 + (c.which - 1) * 128 + (n & 127));
        *(cv_u32x4*)(c.dst + (size_t)row * c.KD + c.k0 + 8 * ch) = (cv_u32x4){a[0], a[1], a[2], a[3]}; }
}
constexpr int CONV_DEPTH = 4;
template <class ITEMF>
__device__ __forceinline__ void conv_run(ITEMF item, int first, int count, float* T) {
    const int tid = opaque_tid();
    f32x4_t ring[CONV_DEPTH][8];
#pragma unroll
    for (int d = 0; d < CONV_DEPTH; ++d) { if (d < count) { const ConvItem c = item(first + d); conv_load(c, ring[d], tid); } }
    for (int i0 = 0; i0 < count; i0 += CONV_DEPTH) {
#pragma unroll
        for (int d = 0; d < CONV_DEPTH; ++d) {
            const int i = i0 + d;
            if (i >= count) break;
            const ConvItem c = item(first + i);
            lds_barrier();
            conv_tile_write(ring[d], T, tid);
            lds_barrier();
            if (i + CONV_DEPTH < count) { const ConvItem cn = item(first + i + CONV_DEPTH); conv_load(cn, ring[d], tid); }
            conv_tile_store(c, T, tid);
        }
    }
}
__device__ __forceinline__ void ph_convert_small(const P& p, float* lds) {
    __syncthreads();
    if (blockIdx.x >= 192 && blockIdx.x < 192 + 64) conv_run([&](int it) { return conv_small_item(p, it); }, (blockIdx.x - 192) * 5, 5, lds);
}

__device__ __forceinline__ void ph_norm1(const P& p) {
    const int tid = opaque_tid(), lane = tid & 63, wv = tid >> 6;
    const float* ADA = (const float*)(p.ws + WS_ADA);
    bf16_t* H = (bf16_t*)(p.ws + WS_H);
    bf16_t* HC = (bf16_t*)(p.ws + WS_HC);
    auto run = [&](const float* src, bf16_t* dst, int ar, int nrows) {
        f32x4_t gm[4], hs[4];
#pragma unroll
        for (int j = 0; j < 4; ++j) { const int d4 = lane + 64 * j; const f32x4_t g = ((const f32x4_t*)p.norm1_g)[d4], s1 = ((const f32x4_t*)(ADA + ar * 6144 + 1024))[d4]; gm[j] = g * (1.f + s1); hs[j] = ((const f32x4_t*)(ADA + ar * 6144))[d4]; }
        constexpr int PF = 3, RING = PF + 1;
        f32x4_t v[RING][4];
#pragma unroll
        for (int q = 0; q < PF; ++q) { if (q < nrows) {
#pragma unroll
            for (int j = 0; j < 4; ++j) v[q][j] = ((const f32x4_t*)(src + (size_t)q * D))[lane + 64 * j]; } }
        for (int r0 = 0; r0 < nrows; r0 += RING) {
#pragma unroll
            for (int u = 0; u < RING; ++u) {
                const int ri = r0 + u;
                if (ri < nrows) {
                    if (ri + PF < nrows) {
#pragma unroll
                        for (int j = 0; j < 4; ++j) v[(u + PF) % RING][j] = ((const f32x4_t*)(src + (size_t)(ri + PF) * D))[lane + 64 * j];
                    }
                    float ss = 0.f;
#pragma unroll
                    for (int j = 0; j < 4; ++j) ss += v[u][j].x * v[u][j].x + v[u][j].y * v[u][j].y + v[u][j].z * v[u][j].z + v[u][j].w * v[u][j].w;
                    const float rstd = rsqrtf(wave_sum(ss) * (1.f / D) + EPS);
#pragma unroll
                    for (int j = 0; j < 4; ++j) { const f32x4_t o = v[u][j] * rstd * gm[j] + hs[j]; ((uint2*)(dst + (size_t)ri * D))[lane + 64 * j] = make_uint2(cvtpk(o.x, o.y), cvtpk(o.z, o.w)); }
                }
            }
        }
    };
    for (int rc = blockIdx.x * 8 + wv; rc < NTOK / 16; rc += gridDim.x * 8) {
        run(p.x + (size_t)rc * 16 * D, H + (size_t)rc * 16 * D, (rc * 16) / SEQ, 16);
        run(p.ctx + (size_t)rc * 2 * D, HC + (size_t)rc * 2 * D, 16, 2);
    }
}
__device__ __forceinline__ void ph_filter(const P& p, float* lds, const int grp0, const int gstep) {
    typedef short bf16x8 __attribute__((ext_vector_type(8)));
    typedef unsigned u32x4_t __attribute__((ext_vector_type(4)));
    const int tid = opaque_tid(), lane = tid & 63, w = tid >> 6, tt = lane & 15, g = lane >> 4;
    const float* HID2 = (const float*)(p.ws + WS_HID2);
    float* HF = (float*)((unsigned char*)p.out + DO_HF);
    float* red = lds;
    const float min_decay = logf(1e-2f) / 1.5f, max_decay = logf(1e-2f) / 0.3f;
    auto split = [&](const f32x4_t lo4, const f32x4_t hi4, bf16x8& vh, bf16x8& vl) {
        const unsigned h0 = cvtpk(lo4.x, lo4.y), h1 = cvtpk(lo4.z, lo4.w), h2 = cvtpk(hi4.x, hi4.y), h3 = cvtpk(hi4.z, hi4.w);
        const unsigned l0 = cvtpk(lo4.x - __uint_as_float(h0 << 16), lo4.y - __uint_as_float(h0 & 0xffff0000u)), l1 = cvtpk(lo4.z - __uint_as_float(h1 << 16), lo4.w - __uint_as_float(h1 & 0xffff0000u));
        const unsigned l2 = cvtpk(hi4.x - __uint_as_float(h2 << 16), hi4.y - __uint_as_float(h2 & 0xffff0000u)), l3 = cvtpk(hi4.z - __uint_as_float(h3 << 16), hi4.w - __uint_as_float(h3 & 0xffff0000u));
        vh = __builtin_bit_cast(bf16x8, (u32x4_t){h0, h1, h2, h3}); vl = __builtin_bit_cast(bf16x8, (u32x4_t){l0, l1, l2, l3});
    };
    for (int grp = grp0; grp < 128; grp += gstep) {
        const int item0 = grp * 8, o = item0 >> 9, c0 = item0 & 511;
        bf16x8 wh[2], wl[2];
#pragma unroll
        for (int s = 0; s < 2; ++s) {
            float wv[8];
#pragma unroll
            for (int e = 0; e < 8; ++e) wv[e] = p.pos_w3[(32 * s + 8 * g + e) * 2048 + o * 1024 + (tt & 1) * 512 + c0 + (tt >> 1)];
            split((f32x4_t){wv[0], wv[1], wv[2], wv[3]}, (f32x4_t){wv[4], wv[5], wv[6], wv[7]}, wh[s], wl[s]);
        }
        f32x4_t acc[16];
#pragma unroll
        for (int mb = 0; mb < 4; ++mb) {
            f32x4_t raw[4][4];
#pragma unroll
            for (int m8 = 0; m8 < 4; ++m8) {
                const f32x4_t* row = (const f32x4_t*)(HID2 + (size_t)(256 * w + 16 * (4 * mb + m8) + tt) * 64 + 8 * g);
                raw[m8][0] = row[0]; raw[m8][1] = row[1]; raw[m8][2] = row[8]; raw[m8][3] = row[9];
            }
            __builtin_amdgcn_sched_barrier(0);
#pragma unroll
            for (int m8 = 0; m8 < 4; ++m8) {
                bf16x8 hh[2], hl[2];
                split(raw[m8][0], raw[m8][1], hh[0], hl[0]); split(raw[m8][2], raw[m8][3], hh[1], hl[1]);
                f32x4_t c = (f32x4_t){0.f, 0.f, 0.f, 0.f};
#pragma unroll
                for (int s = 0; s < 2; ++s) {
                    c = __builtin_amdgcn_mfma_f32_16x16x32_bf16(wl[s], hh[s], c, 0, 0, 0);
                    c = __builtin_amdgcn_mfma_f32_16x16x32_bf16(wh[s], hl[s], c, 0, 0, 0);
                    c = __builtin_amdgcn_mfma_f32_16x16x32_bf16(wh[s], hh[s], c, 0, 0, 0);
                }
                acc[4 * mb + m8] = c;
            }
            __builtin_amdgcn_sched_barrier(0);
        }
        float asum[2] = {0.f, 0.f};
        const float dl0 = fabsf(min_decay + (float)(c0 + 2 * g) * ((max_decay - min_decay) / 511.0f)), dl1 = fabsf(min_decay + (float)(c0 + 2 * g + 1) * ((max_decay - min_decay) / 511.0f));
#pragma unroll
        for (int m = 0; m < 16; ++m) {
            const int t = 256 * w + 16 * m + tt;
            const float tl = (float)t / 2047.0f;
            const float w0 = expf(-tl * dl0) + 0.05f, w1 = expf(-tl * dl1) + 0.05f;
            acc[m].x *= w0; acc[m].y *= w0; acc[m].z *= w1; acc[m].w *= w1;
            asum[0] += fabsf(acc[m].x) + (t >= 1 ? fabsf(acc[m].y) : 0.f);
            asum[1] += fabsf(acc[m].z) + (t >= 1 ? fabsf(acc[m].w) : 0.f);
        }
#pragma unroll
        for (int ab = 0; ab < 2; ++ab) {
            float v = asum[ab];
            v += __shfl_xor(v, 1); v += __shfl_xor(v, 2); v += __shfl_xor(v, 4); v += __shfl_xor(v, 8);
            asum[ab] = v;
        }
        __syncthreads();
        if (tt == 0) { red[w * 8 + 2 * g] = asum[0]; red[w * 8 + 2 * g + 1] = asum[1]; }
        __syncthreads();
        {
#pragma unroll
            for (int ab = 0; ab < 2; ++ab) {
                const int q = 2 * g + ab;
                float tot = 0.f;
#pragma unroll
                for (int k = 0; k < 8; ++k) tot += red[k * 8 + q];
                const float inv = 1.f / (tot + EPS);
                float* dst = HF + (size_t)(item0 + q) * 4096;
#pragma unroll
                for (int m = 0; m < 16; ++m) {
                    const int t = 256 * w + 16 * m + tt;
                    dst[2047 + t] = (ab == 0 ? acc[m].x : acc[m].z) * inv;
                    if (t >= 1) dst[2047 - t] = (ab == 0 ? acc[m].y : acc[m].w) * inv;
                }
            }
        }
        if (tid < 8) HF[(size_t)(item0 + tid) * 4096 + 4095] = 0.f;
    }
}

struct InprojSched {
    int G, c; const bf16_t *WinT, *H, *HC; bf16_t *PHYT, *PHG, *PC;
    __device__ __forceinline__ bool next(int i, Unit& u) const {
        int L = i * G + c; int pm, pn;
        u.aux = nullptr; u.gidx = nullptr; u.row0 = 0; u.col0 = 0;
        if (L < 768) { tile_of(L, 6, 128, pm, pn); u.a = (const char*)(WinT + (size_t)pm * 256 * D); u.b = (const char*)(H + (size_t)pn * 256 * D); u.c = PHYT + (size_t)pm * 256 * NTOK + pn * 256; u.ldc = NTOK; return true; }
        L -= 768;
        if (L < 1280) { tile_of(L, 128, 10, pm, pn); u.a = (const char*)(H + (size_t)pm * 256 * D); u.b = (const char*)(WinT + (size_t)(1536 + pn * 256) * D); u.c = PHG + (size_t)pm * 256 * 2560 + pn * 256; u.ldc = 2560; return true; }
        L -= 1280;
        if (L < 96) { tile_of(L, 16, 6, pm, pn); u.a = (const char*)(HC + (size_t)pm * 256 * D); u.b = (const char*)(WinT + (size_t)(2048 + pn * 256) * D); u.c = PC + (size_t)pm * 256 * 1536 + pn * 256; u.ldc = 1536; return true; }
        return false;
    }
    __device__ __forceinline__ void a_ready(const Unit&) const {}
    __device__ __forceinline__ void done(const Unit&) const {}
};
__device__ __forceinline__ void ph_inproj(const P& p, unsigned char* lds) {
    constexpr int N_FILT_WG = 16;
    const int G = (int)gridDim.x - N_FILT_WG;
    if ((int)blockIdx.x >= G) { ph_filter(p, (float*)lds, (int)blockIdx.x - G, N_FILT_WG); return; }
    InprojSched S{G, (int)blockIdx.x, (const bf16_t*)((unsigned char*)p.out + DO_WINT), (const bf16_t*)(p.ws + WS_H), (const bf16_t*)(p.ws + WS_HC),
                  (bf16_t*)((unsigned char*)p.out + DO_PHYT), (bf16_t*)(p.ws + WS_PHG), (bf16_t*)(p.ws + WS_PC)};
    pg8::EpiStoreBf16 E;
    pg8::gemm_phase<pg8::EpiStoreBf16, InprojSched, true, true, false>((PG8_LAS unsigned char*)lds, D, S, E);
}

namespace hy {
#define HY_LAS __attribute__((address_space(3)))
typedef short bf16x8 __attribute__((ext_vector_type(8)));
typedef float f32x4 __attribute__((ext_vector_type(4)));
typedef unsigned u32x4 __attribute__((ext_vector_type(4)));
typedef unsigned u32x2 __attribute__((ext_vector_type(2)));
constexpr int U_STRIDE = 4112, UIMG = 0, U_BYTES = 16 * U_STRIDE;
constexpr int FILT = U_BYTES, F_STRIDE = 8288, F_BYTES = 8 * F_STRIDE;
constexpr int SCR = FILT + F_BYTES;
constexpr int SCR_PAD = 96, SCRF = SCR + SCR_PAD;
static_assert(SCRF + 8192 + 16 <= LDS_BYTES - 64, "hyena LDS map");

__device__ __forceinline__ float uni(float v) { return __uint_as_float(__builtin_amdgcn_readfirstlane(__float_as_uint(v))); }
struct ConvW { float w0, w1, w2, b; };
__device__ __forceinline__ ConvW load_convw(const P& p, int ch) { ConvW c; c.w0 = uni(p.hy_conv_w[ch]); c.w1 = uni(p.hy_conv_w[1536 + ch]); c.w2 = uni(p.hy_conv_w[3072 + ch]); c.b = uni(p.hy_conv_b[ch]); return c; }
__device__ __forceinline__ void load_u_image(const ConvW cw, HY_LAS unsigned char* L, const bf16_t* row, int tid) {
    const float cw0 = cw.w0, cw1 = cw.w1, cw2 = cw.w2, cb = cw.b;
#pragma unroll 2
    for (int k = 0; k < 8; ++k) {
        const int idx = tid + NT * k, b = idx >> 8, t8 = (idx & 255) * 8;
        const bf16_t* src = row + b * SEQ + t8;
        const u32x4 raw = *(const u32x4*)src;
        float x[10];
        const unsigned left = (unsigned)__shfl_up((int)raw.w, 1), right = (unsigned)__shfl_down((int)raw.x, 1);
        x[0] = (t8 & 63) ? __uint_as_float(left & 0xffff0000u) : 0.f;
        x[9] = ((t8 + 8) & 63) ? __uint_as_float(right << 16) : 0.f;
        x[1] = __uint_as_float(raw.x << 16); x[2] = __uint_as_float(raw.x & 0xffff0000u); x[3] = __uint_as_float(raw.y << 16); x[4] = __uint_as_float(raw.y & 0xffff0000u);
        x[5] = __uint_as_float(raw.z << 16); x[6] = __uint_as_float(raw.z & 0xffff0000u); x[7] = __uint_as_float(raw.w << 16); x[8] = __uint_as_float(raw.w & 0xffff0000u);
        float o[8];
#pragma unroll
        for (int e = 0; e < 8; ++e) o[e] = cb + cw1 * x[e + 1] + cw0 * x[e] + cw2 * x[e + 2];
        *(HY_LAS u32x4*)(L + UIMG + b * U_STRIDE + t8 * 2) = (u32x4){pk2(o[0], o[1]), pk2(o[2], o[3]), pk2(o[4], o[5]), pk2(o[6], o[7])};
    }
}
__device__ __forceinline__ void raw_rows_load(u32x4 (&r)[8], const bf16_t* row, int tid) {
#pragma unroll
    for (int k = 0; k < 8; ++k) { const int idx = tid + NT * k, b = idx >> 8, t8 = (idx & 255) * 8; r[k] = *(const u32x4*)(row + b * SEQ + t8); }
}
__device__ __forceinline__ void raw_rows_store(HY_LAS unsigned char* L, const u32x4 (&r)[8], int tid) {
#pragma unroll
    for (int k = 0; k < 8; ++k) {
        const int idx = tid + NT * k, b = idx >> 8, t8 = (idx & 255) * 8;
        HY_LAS unsigned char* d = L + FILT + b * U_STRIDE + 8 + t8 * 2;
        *(HY_LAS u32x2*)d = (u32x2){r[k].x, r[k].y}; *(HY_LAS u32x2*)(d + 8) = (u32x2){r[k].z, r[k].w};
    }
}
__device__ __forceinline__ void load_filter_scr(HY_LAS unsigned char* L, const float* hf, int tid) {
    const float4 a = ((const float4*)hf)[tid * 2], b = ((const float4*)hf)[tid * 2 + 1];
    *(HY_LAS u32x4*)(L + SCRF + tid * 16) = (u32x4){pk2(a.x, a.y), pk2(a.z, a.w), pk2(b.x, b.y), pk2(b.z, b.w)};
    if (tid < 7) *(HY_LAS u32x4*)(L + (tid < 6 ? SCR + 16 * tid : SCRF + 8192)) = (u32x4){0u, 0u, 0u, 0u};
}
typedef u32x4 u32x4_u2 __attribute__((aligned(2)));
__device__ __forceinline__ void build_filter_copies(HY_LAS unsigned char* L, int tid) {
    const int d = tid >> 6, lane = tid & 63;
#pragma unroll
    for (int it = 0; it < 9; ++it) {
        const int qg = lane + 64 * it;
        if (qg < 518) {
            const u32x4 v = *(const HY_LAS u32x4_u2*)(L + SCRF + 2 * (4088 + d) - 16 * qg);
            *(HY_LAS u32x4*)(L + FILT + d * F_STRIDE + qg * 16) = (u32x4){__builtin_amdgcn_alignbit(v.w, v.w, 16), __builtin_amdgcn_alignbit(v.z, v.z, 16), __builtin_amdgcn_alignbit(v.y, v.y, 16), __builtin_amdgcn_alignbit(v.x, v.x, 16)};
        }
    }
}
__device__ __forceinline__ void conv_loop(HY_LAS unsigned char* L, f32x4 (&acc)[16], int w, int lane) {
    const int i = lane & 15, g = lane >> 4;
    const HY_LAS unsigned char* aBase = L + FILT + (i & 7) * F_STRIDE + 2 * (2048 + 8 * g - (i & ~7)) - 32 * (16 * w);
    const HY_LAS unsigned char* bBase = L + UIMG + i * U_STRIDE + 16 * g;
    bf16x8 ring[16];
#pragma unroll
    for (int s = 0; s < 16; ++s) ring[s] = *(const HY_LAS bf16x8*)(aBase - 32 * s);
#pragma unroll
    for (int m = 0; m < 16; ++m) acc[m] = (f32x4){0.f, 0.f, 0.f, 0.f};
    bf16x8 bfrag = *(const HY_LAS bf16x8*)(bBase);
    for (int k8 = 0; k8 < 8; ++k8) {
        const HY_LAS unsigned char* aK = aBase + 512 * k8;
        const HY_LAS unsigned char* bK = bBase + 512 * k8;
#pragma unroll
        for (int u = 0; u < 8; ++u) {
            bf16x8 bnext = bfrag;
            if (u < 7 || k8 < 7) bnext = *(const HY_LAS bf16x8*)(bK + 64 * (u + 1));
            acc[14] = __builtin_amdgcn_mfma_f32_16x16x32_bf16(ring[(14 - 2 * u) & 15], bfrag, acc[14], 0, 0, 0);
            acc[15] = __builtin_amdgcn_mfma_f32_16x16x32_bf16(ring[(15 - 2 * u) & 15], bfrag, acc[15], 0, 0, 0);
            if (u < 7 || k8 < 7) {
                ring[(14 - 2 * u) & 15] = *(const HY_LAS bf16x8*)(aK + 64 * u + 64);
                ring[(15 - 2 * u) & 15] = *(const HY_LAS bf16x8*)(aK + 64 * u + 32);
            }
#pragma unroll
            for (int m = 0; m < 14; ++m) acc[m] = __builtin_amdgcn_mfma_f32_16x16x32_bf16(ring[(m - 2 * u) & 15], bfrag, acc[m], 0, 0, 0);
            bfrag = bnext;
            __builtin_amdgcn_sched_barrier(0);
        }
    }
}
__device__ __forceinline__ void gate_acc(const ConvW cw, HY_LAS unsigned char* L, f32x4 (&acc)[16], float bias, int w, int lane) {
    const int j = lane & 15, g = lane >> 4;
    const float cw0 = cw.w0, cw1 = cw.w1, cw2 = cw.w2, cb = cw.b;
#pragma unroll
    for (int m = 0; m < 16; ++m) {
        const int t4 = 256 * w + 16 * m + 4 * g, tt0 = t4 & 63;
        const u32x2 uu = *(const HY_LAS u32x2*)(L + UIMG + j * U_STRIDE + t4 * 2);
        const HY_LAS unsigned char* xb = L + FILT + j * U_STRIDE + 8 + t4 * 2;
        const u32x2 xx = *(const HY_LAS u32x2*)xb;
        const float xl = tt0 > 0 ? bf2f(*(const HY_LAS bf16_t*)(xb - 2)) : 0.f;
        const float xr = tt0 < 60 ? bf2f(*(const HY_LAS bf16_t*)(xb + 8)) : 0.f;
        const float x0 = __uint_as_float(xx.x << 16), x1 = __uint_as_float(xx.x & 0xffff0000u), x2 = __uint_as_float(xx.y << 16), x3 = __uint_as_float(xx.y & 0xffff0000u);
        const float u0 = __uint_as_float(uu.x << 16), u1 = __uint_as_float(uu.x & 0xffff0000u), u2 = __uint_as_float(uu.y << 16), u3 = __uint_as_float(uu.y & 0xffff0000u);
        const float g0 = cb + cw1 * x0 + cw0 * xl + cw2 * x1, g1 = cb + cw1 * x1 + cw0 * x0 + cw2 * x2, g2 = cb + cw1 * x2 + cw0 * x1 + cw2 * x3, g3 = cb + cw1 * x3 + cw0 * x2 + cw2 * xr;
        acc[m][0] = g0 * (acc[m][0] + bias * u0); acc[m][1] = g1 * (acc[m][1] + bias * u1); acc[m][2] = g2 * (acc[m][2] + bias * u2); acc[m][3] = g3 * (acc[m][3] + bias * u3);
        if ((m & 3) == 3) __builtin_amdgcn_sched_barrier(0);
    }
}
__device__ __forceinline__ void gate_rows_load(u32x2 (&X)[16], const bf16_t* row, int w, int lane) {
    const bf16_t* src = row + (size_t)(lane & 15) * SEQ + 256 * w + 4 * (lane >> 4);
#pragma unroll
    for (int m = 0; m < 16; ++m) X[m] = *(const u32x2*)(src + 16 * m);
}
__device__ __forceinline__ void gate_acc_reg(const ConvW cw, HY_LAS unsigned char* L, f32x4 (&acc)[16], float bias, int w, int lane, const u32x2 (&X)[16]) {
    const int j = lane & 15, g = lane >> 4;
    const float cw0 = cw.w0, cw1 = cw.w1, cw2 = cw.w2, cb = cw.b;
    const int srcL = 4 * (g > 0 ? lane - 16 : lane + 48), srcR = 4 * (g < 3 ? lane + 16 : lane - 48);
#pragma unroll
    for (int m = 0; m < 16; ++m) {
        const int t4 = 256 * w + 16 * m + 4 * g, tt0 = t4 & 63;
        const u32x2 uu = *(const HY_LAS u32x2*)(L + UIMG + j * U_STRIDE + t4 * 2);
        const u32x2 xx = X[m];
        const unsigned supL = (g == 3) ? X[m > 0 ? m - 1 : 0].y : X[m].y;
        const unsigned supR = (g == 0) ? X[m < 15 ? m + 1 : 15].x : X[m].x;
        const unsigned gl = (unsigned)__builtin_amdgcn_ds_bpermute(srcL, (int)supL), gr = (unsigned)__builtin_amdgcn_ds_bpermute(srcR, (int)supR);
        const float xl = tt0 > 0 ? __uint_as_float(gl & 0xffff0000u) : 0.f;
        const float xr = tt0 < 60 ? __uint_as_float(gr << 16) : 0.f;
        const float x0 = __uint_as_float(xx.x << 16), x1 = __uint_as_float(xx.x & 0xffff0000u), x2 = __uint_as_float(xx.y << 16), x3 = __uint_as_float(xx.y & 0xffff0000u);
        const float u0 = __uint_as_float(uu.x << 16), u1 = __uint_as_float(uu.x & 0xffff0000u), u2 = __uint_as_float(uu.y << 16), u3 = __uint_as_float(uu.y & 0xffff0000u);
        const float g0 = cb + cw1 * x0 + cw0 * xl + cw2 * x1, g1 = cb + cw1 * x1 + cw0 * x0 + cw2 * x2, g2 = cb + cw1 * x2 + cw0 * x1 + cw2 * x3, g3 = cb + cw1 * x3 + cw0 * x2 + cw2 * xr;
        acc[m][0] = g0 * (acc[m][0] + bias * u0); acc[m][1] = g1 * (acc[m][1] + bias * u1); acc[m][2] = g2 * (acc[m][2] + bias * u2); acc[m][3] = g3 * (acc[m][3] + bias * u3);
        if ((m & 3) == 3) __builtin_amdgcn_sched_barrier(0);
    }
}
__device__ __forceinline__ void store_acc_uimg(HY_LAS unsigned char* L, const f32x4 (&acc)[16], int w, int lane) {
    const int j = lane & 15, g = lane >> 4;
#pragma unroll
    for (int m = 0; m < 16; ++m) {
        const int t4 = 256 * w + 16 * m + 4 * g;
        *(HY_LAS u32x2*)(L + UIMG + j * U_STRIDE + t4 * 2) = (u32x2){pk2(acc[m][0], acc[m][1]), pk2(acc[m][2], acc[m][3])};
    }
}
}

__device__ __forceinline__ void ph_hyena_task(const P& p, unsigned char* ldsb, int c) {
    const int w = __builtin_amdgcn_readfirstlane(threadIdx.x >> 6);
    const bf16_t* PHYT = (const bf16_t*)((unsigned char*)p.out + DO_PHYT);
    bf16_t* YT = (bf16_t*)(p.ws + WS_YT);
    const float* HF = (const float*)((unsigned char*)p.out + DO_HF);
    HY_LAS unsigned char* L = (HY_LAS unsigned char*)ldsb;
    {
        const int tid = opaque_tid();
        const int lane = tid & 63;
        hy::f32x4 acc[16];
        const hy::ConvW cwv = hy::load_convw(p, c), cwx1 = hy::load_convw(p, 512 + c), cwx2 = hy::load_convw(p, 1024 + c);
        const float bias0 = hy::uni(p.hy_bias[c]), bias1 = hy::uni(p.hy_bias[512 + c]);
        __syncthreads();
        hy::load_u_image(cwv, L, PHYT + (size_t)c * NTOK, tid);
        hy::load_filter_scr(L, HF + (size_t)c * 4096, tid);
        __syncthreads();
        hy::build_filter_copies(L, tid);
        __syncthreads();
        hy::u32x2 gx[16];
        hy::gate_rows_load(gx, PHYT + (size_t)(512 + c) * NTOK, w, lane);
        hy::load_filter_scr(L, HF + (size_t)(512 + c) * 4096, tid);
        hy::conv_loop(L, acc, w, lane);
        hy::gate_acc_reg(cwx1, L, acc, bias0, w, lane, gx);
        __syncthreads();
        hy::store_acc_uimg(L, acc, w, lane);
        hy::build_filter_copies(L, tid);
        __syncthreads();
        hy::gate_rows_load(gx, PHYT + (size_t)(1024 + c) * NTOK, w, lane);
        hy::conv_loop(L, acc, w, lane);
        hy::gate_acc_reg(cwx2, L, acc, bias1, w, lane, gx);
        __syncthreads();
        hy::store_acc_uimg(L, acc, w, lane);
        __syncthreads();
#pragma unroll 2
        for (int k = 0; k < 8; ++k) {
            const int idx = tid + NT * k, b = idx >> 8, t8 = (idx & 255) * 8;
            *(hy::u32x4*)(YT + (size_t)(b * (SEQ / 64) + (t8 >> 6)) * (512 * 64) + c * 64 + (t8 & 63)) = *(const HY_LAS hy::u32x4*)(L + hy::UIMG + b * hy::U_STRIDE + t8 * 2);
        }
    }
}


namespace hg {
#define HG_LAS __attribute__((address_space(3)))
typedef short bf16x8 __attribute__((ext_vector_type(8)));
typedef float f32x4 __attribute__((ext_vector_type(4)));
typedef unsigned u32x4 __attribute__((ext_vector_type(4)));
typedef unsigned u32x2 __attribute__((ext_vector_type(2)));
constexpr int QROW = 272, KROW = 40;
constexpr int O_QT = 0, O_KBAR = 16 * QROW, O_KHAT = 2 * 16 * QROW, O_VT = O_KHAT + 128 * KROW, O_BDEC = O_VT + 128 * KROW, SET_BYTES = O_BDEC + 512;
constexpr int NCH_CTX = CTXL / 16, NCH = NCH_CTX + SEQ / 16;
template <int CTRL> __device__ __forceinline__ float dpp_mul(float x) {
    return x * __uint_as_float(__builtin_amdgcn_update_dpp(0x3f800000u, __float_as_uint(x), CTRL, 0xf, 0xf, false));
}
struct Raw { unsigned short q[4], v[4], z[4]; };
struct CTrue { static constexpr bool value = true; }; struct CFalse { static constexpr bool value = false; };
}

__device__ __forceinline__ void ph_hgrn_task(const P& p, unsigned char* ldsb, int item) {
    using namespace hg;
    const int tid = opaque_tid();
    const int lane = tid & 63, w = __builtin_amdgcn_readfirstlane(tid >> 6), j = lane & 15, g = lane >> 4;
    const int dir = item & 1, h = (item >> 1) & 3, b = item >> 3;
    const float* LB = (const float*)(p.ws + WS_LB);
    const bf16_t* PC = (const bf16_t*)(p.ws + WS_PC);
    const bf16_t* PHG = (const bf16_t*)(p.ws + WS_PHG);
    bf16_t* OFB = (bf16_t*)(p.ws + WS_OFB) + (size_t)dir * NTOK * 512;
    HG_LAS unsigned char* L = (HG_LAS unsigned char*)ldsb;
    float lb0[2], lb1[2];
#pragma unroll
    for (int pp = 0; pp < 2; ++pp) { const float2 t = *(const float2*)(LB + dir * 512 + h * 128 + 16 * w + 8 * pp + 2 * g); lb0[pp] = t.x; lb1[pp] = t.y; }
    const int zoff_c = dir == 0 ? 512 : 1024, zoff_l = dir == 0 ? 1024 : 1536;
    const bf16_t* rowc = PC + (size_t)b * CTXL * 1536 + h * 128 + 16 * w + 2 * g;
    const bf16_t* rowl = PHG + (size_t)b * SEQ * 2560 + h * 128 + 16 * w + 2 * g;
    struct Raw2 { unsigned q[2], v[2], z[2]; };
    auto load_raw = [&](int n, Raw2& r) {
        if (n < NCH_CTX) {
            const int tt = 16 * n + j, t = dir == 0 ? tt : (CTXL - 1 - tt);
            const bf16_t* row = rowc + (size_t)t * 1536;
#pragma unroll
            for (int pp = 0; pp < 2; ++pp) { r.q[pp] = 0u; r.v[pp] = *(const unsigned*)(row + 8 * pp); r.z[pp] = *(const unsigned*)(row + zoff_c + 8 * pp); }
        } else {
            const int tt = 16 * (n - NCH_CTX) + j, t = dir == 0 ? tt : (SEQ - 1 - tt);
            const bf16_t* row = rowl + (size_t)t * 2560;
#pragma unroll
            for (int pp = 0; pp < 2; ++pp) { r.q[pp] = *(const unsigned*)(row + 8 * pp); r.v[pp] = *(const unsigned*)(row + 512 + 8 * pp); r.z[pp] = *(const unsigned*)(row + zoff_l + 8 * pp); }
        }
    };
    const int qoff = j * QROW + 2 * (16 * w + 2 * g), koff = (16 * w + 2 * g) * KROW + 2 * j;
    auto prep_pass = [&](const Raw2& r, HG_LAS unsigned char* S0, const int pp, auto ctx_c) {
        constexpr bool TCTX = decltype(ctx_c)::value;
        {
            const float za = __uint_as_float(r.z[pp] << 16), zb = __uint_as_float(r.z[pp] & 0xffff0000u);
            const float qa = __uint_as_float(r.q[pp] << 16), qb = __uint_as_float(r.q[pp] & 0xffff0000u);
            const float fa = lb0[pp] + (1.0f - lb0[pp]) * __builtin_amdgcn_rcpf(1.0f + __builtin_amdgcn_exp2f(-1.4426950408889634f * za));
            const float fb = lb1[pp] + (1.0f - lb1[pp]) * __builtin_amdgcn_rcpf(1.0f + __builtin_amdgcn_exp2f(-1.4426950408889634f * zb));
            float Pa = dpp_mul<0x111>(fa), Pb = dpp_mul<0x111>(fb);
            Pa = dpp_mul<0x112>(Pa); Pb = dpp_mul<0x112>(Pb); Pa = dpp_mul<0x114>(Pa); Pb = dpp_mul<0x114>(Pb); Pa = dpp_mul<0x118>(Pa); Pb = dpp_mul<0x118>(Pb);
            const float Ca = __uint_as_float(__builtin_amdgcn_ds_bpermute(4 * (lane | 15), __float_as_uint(Pa)));
            const float Cb = __uint_as_float(__builtin_amdgcn_ds_bpermute(4 * (lane | 15), __float_as_uint(Pb)));
            const float ia = __builtin_amdgcn_rcpf(fmaxf(Pa, 1e-30f)), ib = __builtin_amdgcn_rcpf(fmaxf(Pb, 1e-30f));
            const float ka = (1.0f - fa) * ia, kb = (1.0f - fb) * ib;
            if constexpr (!TCTX) {
                const float qva = qa * __builtin_amdgcn_rcpf(1.0f + __builtin_amdgcn_exp2f(-1.4426950408889634f * qa)) * (0.08838834764831845f * Pa);
                const float qvb = qb * __builtin_amdgcn_rcpf(1.0f + __builtin_amdgcn_exp2f(-1.4426950408889634f * qb)) * (0.08838834764831845f * Pb);
                *(HG_LAS unsigned*)(S0 + O_QT + qoff + 16 * pp) = cvtpk(qva, qvb);
                *(HG_LAS unsigned*)(S0 + O_KBAR + qoff + 16 * pp) = cvtpk(ka, kb);
            }
            const unsigned kh = cvtpk(ka * Ca, kb * Cb);
            *(HG_LAS bf16_t*)(S0 + O_KHAT + koff + 8 * pp * KROW) = (bf16_t)(kh & 0xffffu);
            *(HG_LAS bf16_t*)(S0 + O_KHAT + koff + (8 * pp + 1) * KROW) = (bf16_t)(kh >> 16);
            *(HG_LAS bf16_t*)(S0 + O_VT + koff + 8 * pp * KROW) = (bf16_t)(r.v[pp] & 0xffffu);
            *(HG_LAS bf16_t*)(S0 + O_VT + koff + (8 * pp + 1) * KROW) = (bf16_t)(r.v[pp] >> 16);
            if (j == 15) { typedef float f32x2_t __attribute__((ext_vector_type(2))); *(HG_LAS f32x2_t*)(S0 + O_BDEC + 4 * (16 * w + 8 * pp + 2 * g)) = (f32x2_t){Pa, Pb}; }
        }
    };
    auto prep = [&](const Raw2& r, HG_LAS unsigned char* S0, auto ctx_c) { prep_pass(r, S0, 0, ctx_c); prep_pass(r, S0, 1, ctx_c); };
    const float mk0 = (4 * g + 0) <= j ? 1.f : 0.f, mk1 = (4 * g + 1) <= j ? 1.f : 0.f, mk2 = (4 * g + 2) <= j ? 1.f : 0.f, mk3 = (4 * g + 3) <= j ? 1.f : 0.f;
    const int sc_off = j * QROW + 16 * g, vt_off = (16 * w + j) * KROW + 8 * g, qt8_off = j * QROW + 8 * g, kh_off = j * KROW + 8 * g;
    bf16_t* orow = OFB + (size_t)b * SEQ * 512 + h * 128 + 16 * w + 4 * g;
    f32x4 S[8];
#pragma unroll
    for (int t = 0; t < 8; ++t) S[t] = (f32x4){0.f, 0.f, 0.f, 0.f};
    constexpr int RDEPTH = 4;
    static_assert(NCH % RDEPTH == 0, "chunk loop is unrolled by the prefetch depth");
    Raw2 ring[RDEPTH];
    load_raw(0, ring[0]); load_raw(1, ring[1]);
    __syncthreads();
    prep(ring[0], L, CTrue{}); prep(ring[1], L + SET_BYTES, CTrue{});
#pragma unroll
    for (int c = 2; c < 2 + RDEPTH; ++c) load_raw(c, ring[c % RDEPTH]);
    __syncthreads();
    auto chunk = [&](int n, auto ctx_c, auto nctx_c, auto bar_c, Raw2& slot) {
        constexpr bool CTX = decltype(ctx_c)::value;
        HG_LAS unsigned char* Sc = L + (n & 3) * SET_BYTES;
        HG_LAS unsigned char* Sn = L + ((n + 2) & 3) * SET_BYTES;
        bf16x8 kaf[4], qaf[4]; u32x2 qb0[4], qb1[4], krf[8]; f32x4 bdf[8];
#pragma unroll
        for (int kp = 0; kp < 4; ++kp) { if constexpr (!CTX) { kaf[kp] = *(const HG_LAS bf16x8*)(Sc + O_KBAR + sc_off + 64 * kp); qaf[kp] = *(const HG_LAS bf16x8*)(Sc + O_QT + sc_off + 64 * kp); } }
        const u32x2 vraw = *(const HG_LAS u32x2*)(Sc + O_VT + vt_off);
#pragma unroll
        for (int pq = 0; pq < 4; ++pq) { if constexpr (!CTX) { qb0[pq] = *(const HG_LAS u32x2*)(Sc + O_QT + qt8_off + 64 * pq); qb1[pq] = *(const HG_LAS u32x2*)(Sc + O_QT + qt8_off + 64 * pq + 32); } }
#pragma unroll
        for (int t = 0; t < 8; ++t) { bdf[t] = *(const HG_LAS f32x4*)(Sc + O_BDEC + 64 * t + 16 * g); krf[t] = *(const HG_LAS u32x2*)(Sc + O_KHAT + kh_off + 16 * KROW * t); }
        __builtin_amdgcn_sched_barrier(0);
        const u32x4 vf = (u32x4){vraw.x, vraw.y, 0u, 0u};
        f32x4 sc = (f32x4){0.f, 0.f, 0.f, 0.f};
        if constexpr (!CTX) {
#pragma unroll
        for (int kp = 0; kp < 4; ++kp) sc = __builtin_amdgcn_mfma_f32_16x16x32_bf16(kaf[kp], qaf[kp], sc, 0, 0, 0);
        }
        f32x4 oT = (f32x4){0.f, 0.f, 0.f, 0.f};
#pragma unroll
        for (int pq = 0; pq < (CTX ? 0 : 4); ++pq) {
            u32x4 a; a.x = cvtpk(S[2 * pq][0], S[2 * pq][1]); a.y = cvtpk(S[2 * pq][2], S[2 * pq][3]); a.z = cvtpk(S[2 * pq + 1][0], S[2 * pq + 1][1]); a.w = cvtpk(S[2 * pq + 1][2], S[2 * pq + 1][3]);
            const u32x4 bb = (u32x4){qb0[pq].x, qb0[pq].y, qb1[pq].x, qb1[pq].y};
            oT = __builtin_amdgcn_mfma_f32_16x16x32_bf16(__builtin_bit_cast(bf16x8, a), __builtin_bit_cast(bf16x8, bb), oT, 0, 0, 0);
        }
#pragma unroll
        for (int t = 0; t < 8; ++t) {
            const u32x4 ka = (u32x4){krf[t].x, krf[t].y, 0u, 0u};
            S[t] = __builtin_amdgcn_mfma_f32_16x16x32_bf16(__builtin_bit_cast(bf16x8, ka), __builtin_bit_cast(bf16x8, vf), S[t] * bdf[t], 0, 0, 0);
        }
        if constexpr (!CTX) {
        u32x4 pf;
        pf.x = cvtpk(sc[0] * mk0, sc[1] * mk1); pf.y = cvtpk(sc[2] * mk2, sc[3] * mk3); pf.z = 0u; pf.w = 0u;
        oT = __builtin_amdgcn_mfma_f32_16x16x32_bf16(__builtin_bit_cast(bf16x8, vf), __builtin_bit_cast(bf16x8, pf), oT, 0, 0, 0);
        }
        if (n + 2 < NCH) prep(slot, Sn, nctx_c);
        if (n + 2 + RDEPTH < NCH) load_raw(n + 2 + RDEPTH, slot);
        if constexpr (!CTX) {
            const int tt = 16 * (n - NCH_CTX) + j, t = dir == 0 ? tt : (SEQ - 1 - tt);
            *(u32x2*)(orow + (size_t)t * 512) = (u32x2){cvtpk(oT[0], oT[1]), cvtpk(oT[2], oT[3])};
        }
        if constexpr (decltype(bar_c)::value) lds_barrier();
    };
    static_assert(NCH_CTX % RDEPTH == 0 && RDEPTH == 4 && 4 * SET_BYTES <= LDS_BYTES - 64, "context / latent split of the unrolled chunk loop");
    for (int n0 = 0; n0 < NCH_CTX - RDEPTH; n0 += RDEPTH) {
        chunk(n0, CTrue{}, CTrue{}, CFalse{}, ring[2]); chunk(n0 + 1, CTrue{}, CTrue{}, CTrue{}, ring[3]); chunk(n0 + 2, CTrue{}, CTrue{}, CFalse{}, ring[0]); chunk(n0 + 3, CTrue{}, CTrue{}, CTrue{}, ring[1]);
    }
    chunk(NCH_CTX - 4, CTrue{}, CTrue{}, CFalse{}, ring[2]); chunk(NCH_CTX - 3, CTrue{}, CTrue{}, CTrue{}, ring[3]); chunk(NCH_CTX - 2, CTrue{}, CFalse{}, CFalse{}, ring[0]); chunk(NCH_CTX - 1, CTrue{}, CFalse{}, CTrue{}, ring[1]);
    for (int n0 = NCH_CTX; n0 < NCH; n0 += RDEPTH) {
        chunk(n0, CFalse{}, CFalse{}, CFalse{}, ring[2]); chunk(n0 + 1, CFalse{}, CFalse{}, CTrue{}, ring[3]); chunk(n0 + 2, CFalse{}, CFalse{}, CFalse{}, ring[0]); chunk(n0 + 3, CFalse{}, CFalse{}, CTrue{}, ring[1]);
    }
}

template <int QW = 0, bool DO_HGRN = true, bool DO_QUEUE = true, bool DO_HY = true, bool DO_CV = true>
__device__ __forceinline__ void ph_mixers(const P& p, unsigned char* ldsb) {
    unsigned* qhead = (unsigned*)(p.ws + WS_CTL) + CW_QHEAD + QW;
    HG_LAS unsigned* bc = (HG_LAS unsigned*)(ldsb + LDS_BYTES - 16);
    if (DO_HGRN && blockIdx.x < NB * HEADS * 2) ph_hgrn_task(p, ldsb, blockIdx.x);
    constexpr int N_CONV_WG = 56  , CV_BASE = N_EXPERT_ITEMS / N_CONV_WG, CV_EXTRA = N_EXPERT_ITEMS % N_CONV_WG;
    if (DO_CV && blockIdx.x >= NB * HEADS * 2 && blockIdx.x < NB * HEADS * 2 + N_CONV_WG) {
        const int cj = (int)blockIdx.x - NB * HEADS * 2;
        conv_run([&](int r) { return conv_expert_item(p, r); }, cj * CV_BASE + (cj < CV_EXTRA ? cj : CV_EXTRA), CV_BASE + (cj < CV_EXTRA ? 1 : 0), (float*)ldsb);
    }
    if (!DO_QUEUE) return;
    for (;;) {
        __syncthreads();
        if (threadIdx.x == 0) *bc = atomicAdd(qhead, 1u);
        __syncthreads();
        const int c = (int)*bc;
        if (c >= 512) break;
        if (DO_HY) ph_hyena_task(p, ldsb, c);
    }
}

__device__ __forceinline__ void ph_mixprep(const P& p, float* lds) {
    const int tid = opaque_tid(), lane = tid & 63, wv = tid >> 6;
    const bf16_t* YT = (const bf16_t*)(p.ws + WS_YT);
    bf16_t* MIXA = (bf16_t*)(p.ws + WS_MIXA);
    bf16_t* yl = (bf16_t*)lds;
    float* part = lds + (512 * 72 * 2) / 4;
    typedef unsigned u32x4_t __attribute__((ext_vector_type(4)));
    u32x4_t tl[8];
    auto tload = [&](int tile) {
#pragma unroll
        for (int q = 0; q < 8; ++q) { const int i = tid + NT * q, row = i >> 3, ch = i & 7; tl[q] = *(const u32x4_t*)(YT + (size_t)tile * (512 * 64) + row * 64 + ch * 8); }
    };
    if (blockIdx.x < NTOK / 64) tload(blockIdx.x);
    f32x4_t hg4[8];
#pragma unroll
    for (int j = 0; j < 8; ++j) hg4[j] = *(const f32x4_t*)(p.hy_norm_g + (tid >> 5) * 32 + j * 4);
    for (int tile = blockIdx.x; tile < NTOK / 64; tile += gridDim.x) {
        const int tok0 = tile * 64;
        __syncthreads();
#pragma unroll
        for (int q = 0; q < 8; ++q) { const int i = tid + NT * q, row = i >> 3, ch = i & 7; *(u32x4_t*)(yl + row * 72 + ch * 8) = tl[q]; }
        __syncthreads();
        if (tile + (int)gridDim.x < NTOK / 64) tload(tile + gridDim.x);
        const int tok2 = tid & 31, pt = tid >> 5;
        unsigned wd[32]; float ss0 = 0.f, ss1 = 0.f;
#pragma unroll
        for (int c = 0; c < 32; ++c) { const unsigned w = *(const unsigned*)&yl[(pt * 32 + c) * 72 + 2 * tok2]; wd[c] = w; const float lo = __uint_as_float(w << 16), hi = __uint_as_float(w & 0xffff0000u); ss0 += lo * lo; ss1 += hi * hi; }
        *(float2*)&part[pt * 64 + 2 * tok2] = make_float2(ss0, ss1);
        __syncthreads();
        float tot0 = 0.f, tot1 = 0.f;
#pragma unroll
        for (int k = 0; k < 16; ++k) { const float2 t2 = *(const float2*)&part[k * 64 + 2 * tok2]; tot0 += t2.x; tot1 += t2.y; }
        const float rstd0 = rsqrtf(tot0 * (1.f / 512.f) + EPS), rstd1 = rsqrtf(tot1 * (1.f / 512.f) + EPS);
        bf16_t* dst0 = MIXA + (size_t)(tok0 + 2 * tok2) * D + pt * 32;
#pragma unroll
        for (int j = 0; j < 4; ++j) {
            const f32x4_t ga = hg4[2 * j], gb = hg4[2 * j + 1];
            const float gv[8] = {ga.x, ga.y, ga.z, ga.w, gb.x, gb.y, gb.z, gb.w};
            float o0[8], o1[8];
#pragma unroll
            for (int q = 0; q < 8; ++q) { const unsigned w = wd[8 * j + q]; o0[q] = __uint_as_float(w << 16) * rstd0 * gv[q]; o1[q] = __uint_as_float(w & 0xffff0000u) * rstd1 * gv[q]; }
            *(uint4*)(dst0 + j * 8) = make_uint4(cvtpk(o0[0], o0[1]), cvtpk(o0[2], o0[3]), cvtpk(o0[4], o0[5]), cvtpk(o0[6], o0[7]));
            *(uint4*)(dst0 + D + j * 8) = make_uint4(cvtpk(o1[0], o1[1]), cvtpk(o1[2], o1[3]), cvtpk(o1[4], o1[5]), cvtpk(o1[6], o1[7]));
        }
    }
    const bf16_t* OFB = (const bf16_t*)(p.ws + WS_OFB);
    const bf16_t* PHG = (const bf16_t*)(p.ws + WS_PHG);
    {
        const int hh = lane >> 4, k8 = (lane & 15) * 8, col = hh * 128 + k8;
        const f32x4_t ng0 = *(const f32x4_t*)(p.hg_norm_g + k8), ng1 = *(const f32x4_t*)(p.hg_norm_g + k8 + 4);
        struct Row3 { u32x4_t a, b, g; };
        auto ld4 = [&](Row3 (&x)[4], int r) {
#pragma unroll
            for (int i = 0; i < 4; ++i) { x[i].a = *(const u32x4_t*)(OFB + (size_t)(r + i) * 512 + col); x[i].b = *(const u32x4_t*)(OFB + (size_t)NTOK * 512 + (size_t)(r + i) * 512 + col); x[i].g = *(const u32x4_t*)(PHG + (size_t)(r + i) * 2560 + 2048 + col); }
        };
        const float ngv[8] = {ng0.x, ng0.y, ng0.z, ng0.w, ng1.x, ng1.y, ng1.z, ng1.w};
        auto do4 = [&](const Row3 (&x)[4], int r0) {
#pragma unroll
            for (int i = 0; i < 4; ++i) {
                float o[8]; float ss = 0.f;
#pragma unroll
                for (int q = 0; q < 4; ++q) { o[2 * q] = __uint_as_float(x[i].a[q] << 16) + __uint_as_float(x[i].b[q] << 16); o[2 * q + 1] = __uint_as_float(x[i].a[q] & 0xffff0000u) + __uint_as_float(x[i].b[q] & 0xffff0000u); ss += o[2 * q] * o[2 * q] + o[2 * q + 1] * o[2 * q + 1]; }
                ss += __shfl_xor(ss, 1); ss += __shfl_xor(ss, 2); ss += __shfl_xor(ss, 4); ss += __shfl_xor(ss, 8);
                const float rstd = rsqrtf(ss * (1.f / 128.f) + EPS);
                u32x4_t w;
#pragma unroll
                for (int q = 0; q < 4; ++q) { const float g0 = __uint_as_float(x[i].g[q] << 16), g1 = __uint_as_float(x[i].g[q] & 0xffff0000u);
                    w[q] = cvtpk(o[2 * q] * rstd * ngv[2 * q] * silu_f(g0), o[2 * q + 1] * rstd * ngv[2 * q + 1] * silu_f(g1)); }
                *(u32x4_t*)(MIXA + (size_t)(r0 + i) * D + 512 + col) = w;
            }
        };
        for (int rc = blockIdx.x * 8 + wv; rc < NTOK / 16; rc += gridDim.x * 8) {
            Row3 A[4], B[4];
            ld4(A, rc * 16);
            ld4(B, rc * 16 + 4);
            __builtin_amdgcn_sched_barrier(0);
            do4(A, rc * 16);
            __builtin_amdgcn_sched_barrier(0);
            ld4(A, rc * 16 + 8);
            __builtin_amdgcn_sched_barrier(0);
            do4(B, rc * 16 + 4);
            __builtin_amdgcn_sched_barrier(0);
            ld4(B, rc * 16 + 12);
            __builtin_amdgcn_sched_barrier(0);
            do4(A, rc * 16 + 8);
            __builtin_amdgcn_sched_barrier(0);
            do4(B, rc * 16 + 12);
        }
    }
}

struct OutprojSched {
    int G, c; const bf16_t *A, *Bt;
    __device__ __forceinline__ bool next(int i, Unit& u) const {
        const int L = i * G + c; if (L >= 512) return false; int pm, pn; tile_of(L, 128, 4, pm, pn);
        u.a = (const char*)(A + (size_t)pm * 256 * D); u.b = (const char*)(Bt + (size_t)pn * 256 * D); u.c = nullptr; u.aux = nullptr; u.gidx = nullptr; u.ldc = D; u.row0 = pm * 256; u.col0 = pn * 256; return true;
    }
    __device__ __forceinline__ void a_ready(const Unit&) const {}
    __device__ __forceinline__ void done(const Unit&) const {}
};
__device__ __forceinline__ void ph_outproj(const P& p, unsigned char* lds) {
    OutprojSched S{(int)gridDim.x, (int)blockIdx.x, (const bf16_t*)(p.ws + WS_MIXA), (const bf16_t*)(p.ws + WS_WOUTT)};
    pg8::EpiOutProj E{p.x, (const float*)(p.ws + WS_ADA), (bf16_t*)p.out};
    pg8::gemm_phase<pg8::EpiOutProj, OutprojSched, true, true, false>((PG8_LAS unsigned char*)lds, D, S, E);
}

__device__ __forceinline__ void ph_norm2_router(const P& p, float* ldsf) {
    typedef short bf16x8_t __attribute__((ext_vector_type(8)));
    typedef unsigned u32x4_t __attribute__((ext_vector_type(4)));
    typedef unsigned u32x2_t __attribute__((ext_vector_type(2)));
    const int tid = opaque_tid(), lane = tid & 63, wv = tid >> 6, j = lane & 15, g = lane >> 4;
    const float* ADA = (const float*)(p.ws + WS_ADA);
    const bf16_t* X1 = (const bf16_t*)p.out;
    bf16_t* H2 = (bf16_t*)(p.ws + WS_H2);
    float* AFF = (float*)(p.ws + WS_AFF);
    HG_LAS unsigned char* L = (HG_LAS unsigned char*)(unsigned char*)ldsf;
    constexpr int RS = 2064;
    constexpr int O_PL0 = 64 * RS;
    static_assert(O_PL0 + 2 * 8192 <= LDS_BYTES - 64, "router LDS map");
    bf16x8_t wh[4], wl[4];
    {
        float wr[4][8];
#pragma unroll
        for (int ks = 0; ks < 4; ++ks)
#pragma unroll
            for (int e8 = 0; e8 < 8; ++e8) wr[ks][e8] = p.router_w[(size_t)(32 * (4 * wv + ks) + 8 * g + e8) * 16 + j];
#pragma unroll
        for (int ks = 0; ks < 4; ++ks) {
            unsigned h[4], l[4];
#pragma unroll
            for (int q = 0; q < 4; ++q) { h[q] = cvtpk(wr[ks][2 * q], wr[ks][2 * q + 1]); l[q] = cvtpk(wr[ks][2 * q] - __uint_as_float(h[q] << 16), wr[ks][2 * q + 1] - __uint_as_float(h[q] & 0xffff0000u)); }
            wh[ks] = __builtin_bit_cast(bf16x8_t, (u32x4_t){h[0], h[1], h[2], h[3]}); wl[ks] = __builtin_bit_cast(bf16x8_t, (u32x4_t){l[0], l[1], l[2], l[3]});
        }
    }
    auto ldrow = [&](int r, uint2 (&dst)[4]) {
#pragma unroll
        for (int q = 0; q < 4; ++q) dst[q] = ((const uint2*)(X1 + (size_t)r * (2 * D)))[lane + 64 * q];
    };
    auto unpk = [&](const uint2 w) { return (f32x4_t){__uint_as_float(w.x << 16), __uint_as_float(w.x & 0xffff0000u), __uint_as_float(w.y << 16), __uint_as_float(w.y & 0xffff0000u)}; };
    __syncthreads();
    for (int blk = blockIdx.x; blk < NTOK / 128; blk += gridDim.x) {
        const int rblk = blk * 128, b = rblk / SEQ;
        f32x4_t gm[4], hs[4];
#pragma unroll
        for (int q = 0; q < 4; ++q) { const int d4 = lane + 64 * q; const f32x4_t gg = ((const f32x4_t*)p.norm2_g)[d4], s1 = ((const f32x4_t*)(ADA + b * 6144 + 4096))[d4]; gm[q] = gg * (1.f + s1); hs[q] = ((const f32x4_t*)(ADA + b * 6144 + 3072))[d4]; }
        uint2 rr[3][2][4];
#pragma unroll
        for (int q = 0; q < 3; ++q) { ldrow(rblk + 16 * q + 2 * wv, rr[q][0]); ldrow(rblk + 16 * q + 2 * wv + 1, rr[q][1]); }
        auto norm_group = [&](const int grp) {
            const int hb = (grp & 1) * 32 * RS;
#pragma unroll
            for (int half = 0; half < 2; ++half) {
                const int lr = 2 * wv + half, r = rblk + grp * 16 + lr;
                f32x4_t v[4]; float ss = 0.f;
#pragma unroll
                for (int q = 0; q < 4; ++q) { v[q] = unpk(rr[grp % 3][half][q]); ss += v[q].x * v[q].x + v[q].y * v[q].y + v[q].z * v[q].z + v[q].w * v[q].w; }
                const float rstd = rsqrtf(wave_sum(ss) * (1.f / D) + EPS);
#pragma unroll
                for (int q = 0; q < 4; ++q) {
                    const int d4 = lane + 64 * q;
                    const f32x4_t o = v[q] * rstd * gm[q] + hs[q];
                    const unsigned h01 = cvtpk(o.x, o.y), h23 = cvtpk(o.z, o.w);
                    ((uint2*)(H2 + (size_t)r * D))[d4] = make_uint2(h01, h23);
                    const unsigned l01 = cvtpk(o.x - __uint_as_float(h01 << 16), o.y - __uint_as_float(h01 & 0xffff0000u)), l23 = cvtpk(o.z - __uint_as_float(h23 << 16), o.w - __uint_as_float(h23 & 0xffff0000u));
                    *(HG_LAS u32x2_t*)(L + hb + lr * RS + 8 * d4) = (u32x2_t){h01, h23};
                    *(HG_LAS u32x2_t*)(L + hb + 16 * RS + lr * RS + 8 * d4) = (u32x2_t){l01, l23};
                }
            }
        };
        auto mma_group = [&](const int grp) {
            const int hb = (grp & 1) * 32 * RS, pb = O_PL0 + (grp & 1) * 8192;
            f32x4_t acc = (f32x4_t){0.f, 0.f, 0.f, 0.f};
#pragma unroll
            for (int ks = 0; ks < 4; ++ks) {
                const int kb = 2 * (32 * (4 * wv + ks) + 8 * g);
                const bf16x8_t hh = *(const HG_LAS bf16x8_t*)(L + hb + j * RS + kb), hl = *(const HG_LAS bf16x8_t*)(L + hb + 16 * RS + j * RS + kb);
                acc = __builtin_amdgcn_mfma_f32_16x16x32_bf16(wh[ks], hh, acc, 0, 0, 0);
                acc = __builtin_amdgcn_mfma_f32_16x16x32_bf16(wh[ks], hl, acc, 0, 0, 0);
                acc = __builtin_amdgcn_mfma_f32_16x16x32_bf16(wl[ks], hh, acc, 0, 0, 0);
            }
#pragma unroll
            for (int r = 0; r < 4; ++r) *(HG_LAS float*)(L + pb + ((wv * 16 + 4 * g + r) * 16 + j) * 4) = acc[r];
        };
        auto softmax_group = [&](const int grp) {
            if (tid < 256) {
                const int pb = O_PL0 + (grp & 1) * 8192, row = tid >> 4, e = tid & 15;
                float lgt = 0.f;
#pragma unroll
                for (int k = 0; k < 8; ++k) lgt += *(const HG_LAS float*)(L + pb + ((k * 16 + e) * 16 + row) * 4);
                float mx = lgt;
                mx = fmaxf(mx, __shfl_xor(mx, 1)); mx = fmaxf(mx, __shfl_xor(mx, 2)); mx = fmaxf(mx, __shfl_xor(mx, 4)); mx = fmaxf(mx, __shfl_xor(mx, 8));
                const float ex = expf(lgt - mx);
                float den = ex;
                den += __shfl_xor(den, 1); den += __shfl_xor(den, 2); den += __shfl_xor(den, 4); den += __shfl_xor(den, 8);
                const int r = rblk + grp * 16 + row;
                AFF[((size_t)b * 16 + e) * SEQ + (r % SEQ)] = ex / den;
            }
        };
        norm_group(0);
        lds_barrier();
#pragma unroll
        for (int grp = 0; grp < 8; ++grp) {
            if (grp + 3 < 8) { ldrow(rblk + 16 * (grp + 3) + 2 * wv, rr[grp % 3][0]); ldrow(rblk + 16 * (grp + 3) + 2 * wv + 1, rr[grp % 3][1]); }
            if (grp + 1 < 8) norm_group(grp + 1);
            mma_group(grp);
            if (grp >= 1) softmax_group(grp - 1);
            lds_barrier();
        }
        softmax_group(7);
        lds_barrier();
    }
}

__device__ __forceinline__ void ph_topk(const P& p, float* lds) {
    const int tid = opaque_tid(), lane = tid & 63, wv = tid >> 6;
    const float* AFF = (const float*)(p.ws + WS_AFF);
    int* IDX = (int*)(p.ws + WS_IDX);
    float* GATE = (float*)(p.ws + WS_GATE);
    int* INV = (int*)(p.ws + WS_INV);
    unsigned* hist = (unsigned*)lds;
    unsigned* ctl = hist + 256;
    unsigned* wtot = hist + 272;
    for (int item = blockIdx.x; item < NB * NE; item += gridDim.x) {
        const int b = item >> 4, e = item & 15;
        const uint4 kk = ((const uint4*)(AFF + (size_t)item * SEQ))[tid];
        const unsigned key[4] = {kk.x, kk.y, kk.z, kk.w};
        unsigned prefix = 0u, need = CAP;
#pragma unroll
        for (int pass = 3; pass >= 0; --pass) {
            __syncthreads();
            if (tid < 256) hist[tid] = 0u;
            __syncthreads();
#pragma unroll
            for (int q = 0; q < 4; ++q) {
                const bool in = (pass == 3) || ((key[q] >> (8 * (pass + 1))) == prefix);
                if (in) atomicAdd(&hist[(key[q] >> (8 * pass)) & 255u], 1u);
            }
            __syncthreads();
            if (wv == 0) {
                const uint4 h4 = ((const uint4*)hist)[lane];
                const unsigned loc = h4.x + h4.y + h4.z + h4.w;
                unsigned suf = loc;
#pragma unroll
                for (int o = 1; o < 64; o <<= 1) { const unsigned y = __shfl_down(suf, o); if (lane + o < 64) suf += y; }
                const unsigned above = suf - loc;
                unsigned c3 = above + h4.w, c2 = c3 + h4.z, c1 = c2 + h4.y, c0 = c1 + h4.x;
                int bin = -1; unsigned nneed = 0u;
                if (above < need && c0 >= need) {
                    if (c3 >= need) { bin = 4 * lane + 3; nneed = need - above; }
                    else if (c2 >= need) { bin = 4 * lane + 2; nneed = need - c3; }
                    else if (c1 >= need) { bin = 4 * lane + 1; nneed = need - c2; }
                    else { bin = 4 * lane; nneed = need - c1; }
                    ctl[0] = (prefix << 8) | (unsigned)bin; ctl[1] = nneed;
                }
            }
            __syncthreads();
            prefix = ctl[0]; need = ctl[1];
        }
        unsigned cgt = 0u, ceq = 0u;
#pragma unroll
        for (int q = 0; q < 4; ++q) { cgt += key[q] > prefix ? 1u : 0u; ceq += key[q] == prefix ? 1u : 0u; }
        unsigned sgt = cgt, seq = ceq;
#pragma unroll
        for (int o = 1; o < 64; o <<= 1) { const unsigned y1 = __shfl_up(sgt, o), y2 = __shfl_up(seq, o); if (lane >= o) { sgt += y1; seq += y2; } }
        if (lane == 63) { wtot[wv] = sgt; wtot[8 + wv] = seq; }
        __syncthreads();
        unsigned bgt = 0u, beq = 0u, ngt = 0u;
#pragma unroll
        for (int k = 0; k < 8; ++k) { const unsigned a = wtot[k], c = wtot[8 + k]; if (k < wv) { bgt += a; beq += c; } ngt += a; }
        unsigned rgt = bgt + sgt - cgt, req = beq + seq - ceq;
#pragma unroll
        for (int q = 0; q < 4; ++q) {
            const int t = 4 * tid + q; int slot = -1;
            if (key[q] > prefix) { slot = (int)rgt; ++rgt; }
            else if (key[q] == prefix) { if (req < need) slot = (int)(ngt + req); ++req; }
            if (slot >= 0) { IDX[item * CAP + slot] = t; GATE[item * CAP + slot] = __uint_as_float(key[q]); }
            INV[((size_t)b * SEQ + t) * 16 + e] = slot;
        }
    }
}

struct MoeUpSched {
    int G, c, round; const bf16_t *H2, *W13T; bf16_t* HMID; const int* IDX;
    __device__ __forceinline__ bool next(int i, Unit& u) const {
        if (i >= 4 || c >= 256) return false;
        const int x = c & 7, q = c >> 3, Q = q >> 2, mth = q & 3, item = (Q * 4 + ((round & 1) * 2 + (round >> 1))) * 8 + x, b = item >> 4, e = item & 15, nt = 4 * mth + i;
        u.a = (const char*)(H2 + (size_t)b * SEQ * D); u.b = (const char*)(W13T + ((size_t)e * 4096 + nt * 256) * D); u.c = HMID + (size_t)item * CAP * FF + nt * 128;
        u.aux = nullptr; u.gidx = IDX + item * CAP; u.ldc = FF; u.row0 = 0; u.col0 = 0; return true;
    }
    __device__ __forceinline__ void a_ready(const Unit&) const {}
    __device__ __forceinline__ void done(const Unit&) const {}
};
struct MoeDownSched {
    int G, c; const bf16_t *HMID, *W2T; bf16_t* YS; const float* GATE;
    __device__ __forceinline__ bool next(int i, Unit& u) const {
        if (i >= 4 || c >= 256) return false;
        const int x = c & 7, q = c >> 3, Q = q >> 2, nt = q & 3, item = (Q * 4 + i) * 8 + x, e = item & 15;
        u.a = (const char*)(HMID + (size_t)item * CAP * FF); u.b = (const char*)(W2T + ((size_t)e * 1024 + nt * 256) * FF); u.c = YS + (size_t)item * CAP * D + nt * 256;
        u.aux = GATE + item * CAP; u.gidx = nullptr; u.ldc = D; u.row0 = 0; u.col0 = 0; return true;
    }
    __device__ __forceinline__ void a_ready(const Unit&) const {}
    __device__ __forceinline__ void done(const Unit&) const {}
};
__device__ __forceinline__ void ph_moe_up(const P& p, unsigned char* lds) {
    pg8::EpiSwiGLU E;
    for (int round = 0; round < 4; ++round) {
        MoeUpSched S{(int)gridDim.x, (int)blockIdx.x, round, (const bf16_t*)(p.ws + WS_H2), (const bf16_t*)(p.ws + WS_W13T), (bf16_t*)(p.ws + WS_HMID), (const int*)(p.ws + WS_IDX)};
        pg8::gemm_phase<pg8::EpiSwiGLU, MoeUpSched, true, true, true>((PG8_LAS unsigned char*)lds, D, S, E);
    }
}
__device__ __forceinline__ void ph_moe_down(const P& p, unsigned char* lds) {
    MoeDownSched S{(int)gridDim.x, (int)blockIdx.x, (const bf16_t*)(p.ws + WS_HMID), (const bf16_t*)(p.ws + WS_W2T), (bf16_t*)(p.ws + WS_YS), (const float*)(p.ws + WS_GATE)};
    pg8::EpiDown E;
    pg8::gemm_phase<pg8::EpiDown, MoeDownSched, true, true, false>((PG8_LAS unsigned char*)lds, FF, S, E);
}

constexpr int FIN_KU = 3;
struct FinSet { uint2 x[2][4]; uint2 w[2][FIN_KU][4]; float fl[2][FIN_KU]; unsigned mrest[2]; };
__device__ __forceinline__ void ph_final(const P& p) {
    const int tid = opaque_tid(), lane = tid & 63, wv = tid >> 6;
    const float* ADA = (const float*)(p.ws + WS_ADA);
    const bf16_t* YS = (const bf16_t*)(p.ws + WS_YS);
    const int* INV = (const int*)(p.ws + WS_INV);
    float* X = p.out;
    for (int rc = blockIdx.x * 8 + wv; rc < NTOK / 16; rc += gridDim.x * 8) {
        const int r0 = rc * 16, b = r0 / SEQ;
        const float* g2 = ADA + b * 6144 + 5120;
        f32x4_t G2[4], FG[4];
#pragma unroll
        for (int j = 0; j < 4; ++j) { G2[j] = ((const f32x4_t*)g2)[lane + 64 * j]; FG[j] = ((const f32x4_t*)p.final_g)[lane + 64 * j]; }
        int inv4[4];
#pragma unroll
        for (int i = 0; i < 4; ++i) inv4[i] = INV[(size_t)r0 * 16 + 64 * i + lane];
        auto issue = [&](FinSet& S, const int s) {
#pragma unroll
            for (int rr = 0; rr < 2; ++rr) {
                const int r = 2 * s + rr, sh = 16 * (r & 3);
#pragma unroll
                for (int j = 0; j < 4; ++j) S.x[rr][j] = ((const uint2*)(X + (size_t)(r0 + r) * D))[lane + 64 * j];
                unsigned m = (unsigned)(__ballot(inv4[r >> 2] >= 0) >> sh) & 0xffffu;
#pragma unroll
                for (int k = 0; k < FIN_KU; ++k) {
                    const bool has = m != 0u;
                    const int e = has ? __builtin_ctz(m) : 0; m &= m - 1u;
                    const int sl = __builtin_amdgcn_readlane(inv4[r >> 2], sh + e);
                    const int slot = has ? sl : 0;
                    S.fl[rr][k] = has ? 1.f : 0.f;
                    const uint2* yr = (const uint2*)(YS + ((size_t)(b * 16 + e) * CAP + slot) * D);
#pragma unroll
                    for (int j = 0; j < 4; ++j) S.w[rr][k][j] = yr[lane + 64 * j];
                }
                S.mrest[rr] = m;
            }
        };
        auto consume = [&](FinSet& S, const int s) {
#pragma unroll
            for (int rr = 0; rr < 2; ++rr) {
                const int r = 2 * s + rr, sh = 16 * (r & 3);
                f32x4_t acc[4];
#pragma unroll
                for (int j = 0; j < 4; ++j) acc[j] = (f32x4_t){0.f, 0.f, 0.f, 0.f};
#pragma unroll
                for (int k = 0; k < FIN_KU; ++k) {
                    const float f = S.fl[rr][k];
#pragma unroll
                    for (int j = 0; j < 4; ++j) {
                        const uint2 w = S.w[rr][k][j];
                        acc[j].x = fmaf(f, __uint_as_float(w.x << 16), acc[j].x); acc[j].y = fmaf(f, __uint_as_float(w.x & 0xffff0000u), acc[j].y);
                        acc[j].z = fmaf(f, __uint_as_float(w.y << 16), acc[j].z); acc[j].w = fmaf(f, __uint_as_float(w.y & 0xffff0000u), acc[j].w);
                    }
                }
                unsigned m = S.mrest[rr];
                while (m) {
                    const int e = __builtin_ctz(m); m &= m - 1u;
                    const int slot = __builtin_amdgcn_readlane(inv4[r >> 2], sh + e);
                    const uint2* yr = (const uint2*)(YS + ((size_t)(b * 16 + e) * CAP + slot) * D);
                    uint2 w[4];
#pragma unroll
                    for (int j = 0; j < 4; ++j) w[j] = yr[lane + 64 * j];
#pragma unroll
                    for (int j = 0; j < 4; ++j) { acc[j].x += __uint_as_float(w[j].x << 16); acc[j].y += __uint_as_float(w[j].x & 0xffff0000u); acc[j].z += __uint_as_float(w[j].y << 16); acc[j].w += __uint_as_float(w[j].y & 0xffff0000u); }
                }
                f32x4_t v[4]; float ss = 0.f;
#pragma unroll
                for (int j = 0; j < 4; ++j) {
                    const f32x4_t g = G2[j];
                    const uint2 w = S.x[rr][j];
                    const f32x4_t xv = (f32x4_t){__uint_as_float(w.x << 16), __uint_as_float(w.x & 0xffff0000u), __uint_as_float(w.y << 16), __uint_as_float(w.y & 0xffff0000u)};
                    v[j] = xv + g * acc[j];
                    ss += v[j].x * v[j].x + v[j].y * v[j].y + v[j].z * v[j].z + v[j].w * v[j].w;
                }
                ss = wave_sum(ss);
                const float rstd = rsqrtf(ss * (1.f / D) + EPS);
#pragma unroll
                for (int j = 0; j < 4; ++j) {
                    ((f32x4_t*)(X + (size_t)(r0 + r) * D))[lane + 64 * j] = v[j] * rstd * FG[j];
                }
            }
        };
        FinSet SA, SB;
        issue(SA, 0);
#pragma unroll
        for (int s2 = 0; s2 < 4; ++s2) {
            issue(SB, 2 * s2 + 1);
            __builtin_amdgcn_sched_barrier(0);
            consume(SA, 2 * s2);
            __builtin_amdgcn_sched_barrier(0);
            if (s2 < 3) issue(SA, 2 * s2 + 2);
            __builtin_amdgcn_sched_barrier(0);
            consume(SB, 2 * s2 + 1);
            __builtin_amdgcn_sched_barrier(0);
        }
    }
}

#define LAS __attribute__((address_space(3)))
#define XB_TMO      128
#define XB_XCNT(j)  (256  + 64 * (j))
#define XB_XSUB(j)  (1280 + 64 * (j))
#define XB_XGEN(j)  (2304 + 64 * (j))
#define XB_TOP      3328
#define XB_TOPGEN   3392
#define XCD_BAR_WORDS 3456
#define XB_SPIN_CAP (1u << 18)

__device__ __forceinline__ unsigned xb_ld(unsigned* p)              { return __hip_atomic_load(p, __ATOMIC_RELAXED, __HIP_MEMORY_SCOPE_AGENT); }
__device__ __forceinline__ unsigned xb_add(unsigned* p, unsigned v) { return __hip_atomic_fetch_add(p, v, __ATOMIC_RELAXED, __HIP_MEMORY_SCOPE_AGENT); }
__device__ __forceinline__ unsigned xb_xcc_id() { return (unsigned)__builtin_amdgcn_s_getreg((3 << 11) | 20) & 0xFu; }
#define XB_SPIN(cond, bar) do { unsigned _sp = 0; while (cond) { __builtin_amdgcn_s_sleep(1); \
    if ((++_sp & 255u) == 0u) { if (xb_ld(&(bar)[XB_TMO])) break; if (_sp > XB_SPIN_CAP) { atomicAdd(&(bar)[XB_TMO], 1u); break; } } } } while (0)

struct XcdBarrier {
    unsigned* bar; unsigned x;
    volatile LAS unsigned* st;
};

__device__ __forceinline__ XcdBarrier xcd_barrier_post(unsigned* bar, volatile LAS unsigned* st) {
    XcdBarrier b; b.bar = bar; b.x = xb_xcc_id(); b.st = st;
    if (threadIdx.x == 0) (void)xb_add(&bar[XB_XCNT(b.x)], 1u);
    return b;
}
__device__ __forceinline__ void xcd_barrier_complete(unsigned* bar, unsigned x, unsigned& nloc, unsigned& nx) {
    const unsigned G = gridDim.x * gridDim.y * gridDim.z;
    unsigned sum, cnt, mine, sp = 0u;
    for (;;) {
        sum = 0u; cnt = 0u; mine = 0u;
#pragma unroll
        for (unsigned j = 0; j < 16; ++j) { const unsigned c = xb_ld(&bar[XB_XCNT(j)]); sum += c; cnt += (c > 0u) ? 1u : 0u; mine = (j == x) ? c : mine; }
        if (sum == G) break;
        __builtin_amdgcn_s_sleep(1);
        if ((++sp & 255u) == 0u) { if (xb_ld(&bar[XB_TMO])) break; if (sp > XB_SPIN_CAP) { atomicAdd(&bar[XB_TMO], 1u); break; } }
    }
    nloc = mine > 0u ? mine : 1u; nx = cnt > 0u ? cnt : 1u;
}

__device__ __forceinline__ void xcd_barrier(const XcdBarrier& b) {
    asm volatile("s_waitcnt vmcnt(0)" ::: "memory");
    __syncthreads();
    if (threadIdx.x == 0) {
        unsigned* bar = b.bar;
        __builtin_amdgcn_s_waitcnt(0);
        unsigned nloc = b.st[0], nx = b.st[1];
        if (nloc == 0u) { xcd_barrier_complete(bar, b.x, nloc, nx); b.st[0] = nloc; b.st[1] = nx; }
        const unsigned old = xb_add(&bar[XB_XSUB(b.x)], 1u);
        const unsigned gen = old / nloc;
        if (old + 1u == (gen + 1u) * nloc) {
            __builtin_amdgcn_fence(__ATOMIC_RELEASE, "agent");
            asm volatile("s_waitcnt vmcnt(0)" ::: "memory");
            const unsigned og = xb_add(&bar[XB_TOP], 1u);
            const unsigned tg = og / nx;
            if (og + 1u == (tg + 1u) * nx) xb_add(&bar[XB_TOPGEN], 1u);
            else XB_SPIN(xb_ld(&bar[XB_TOPGEN]) == tg, bar);
            __builtin_amdgcn_fence(__ATOMIC_ACQUIRE, "agent");
            xb_add(&bar[XB_XGEN(b.x)], 1u);
            asm volatile("s_waitcnt vmcnt(0)" ::: "memory");
        } else {
            XB_SPIN(xb_ld(&bar[XB_XGEN(b.x)]) == gen, bar);
            __builtin_amdgcn_fence(__ATOMIC_ACQUIRE, "agent");
            asm volatile("s_waitcnt vmcnt(0)" ::: "memory");
        }
    }
    __syncthreads();
}

constexpr int N_PHASES = 11;
template <int PH>
__device__ __forceinline__ void run_phase(const P& p, unsigned char* ldsb) {
    float* lds = (float*)ldsb;
    if constexpr (PH == 0) { ph_prep(p, lds); ph_convert_small(p, lds); }
    else if constexpr (PH == 1) ph_norm1(p);
    else if constexpr (PH == 2) ph_inproj(p, ldsb);
    else if constexpr (PH == 3) ph_mixers<0>(p, ldsb);
    else if constexpr (PH == 4) ph_mixprep(p, lds);
    else if constexpr (PH == 5) ph_outproj(p, ldsb);
    else if constexpr (PH == 6) ph_norm2_router(p, lds);
    else if constexpr (PH == 7) ph_topk(p, lds);
    else if constexpr (PH == 8) ph_moe_up(p, ldsb);
    else if constexpr (PH == 9) ph_moe_down(p, ldsb);
    else if constexpr (PH == 10) ph_final(p);
}
template <int PH>
__device__ __forceinline__ void run_from(const P& p, unsigned char* lds, const XcdBarrier& bar) {
    if constexpr (PH < N_PHASES) {
        run_phase<PH>(p, lds);
        if constexpr (PH + 1 < N_PHASES) xcd_barrier(bar);
        run_from<PH + 1>(p, lds, bar);
    }
}
__global__ void __launch_bounds__(NT, 2) fwd_all(P p) {
    extern __shared__ __attribute__((aligned(16))) unsigned char lds_raw[];
    volatile LAS unsigned* st = (volatile LAS unsigned*)(lds_raw + LDS_BYTES - 32);
    if (threadIdx.x < 2) st[threadIdx.x] = 0u;
    __syncthreads();
    const XcdBarrier bar = xcd_barrier_post((unsigned*)(p.ws + WS_CTL) + CW_BAR, st);
    run_from<0>(p, lds_raw, bar);
}

extern "C" void kernel_launch(void* const* d_in, const int* in_sizes, int n_in, void* d_out, int out_size, void* d_ws, size_t ws_size, hipStream_t stream) {
    static int grid = 0;
    if (grid == 0) {
        int dev = 0, cus = 0, per_cu = 0;
        (void)hipGetDevice(&dev);
        (void)hipDeviceGetAttribute(&cus, hipDeviceAttributeMultiprocessorCount, dev);
        (void)hipFuncSetAttribute((const void*)fwd_all, hipFuncAttributeMaxDynamicSharedMemorySize, LDS_BYTES);
        (void)hipOccupancyMaxActiveBlocksPerMultiprocessor(&per_cu, (const void*)fwd_all, NT, LDS_BYTES);
        if (per_cu < 1) fprintf(stderr, "kernel_launch: occupancy query says %d blocks/CU\n", per_cu);
        grid = (cus > 0 ? cus : 256);
        if (ws_size < WS_END) fprintf(stderr, "kernel_launch: workspace too small: %zu < %zu\n", ws_size, (size_t)WS_END);
    }
    P p{};
    const float** f = (const float**)&p;
    for (int i = 0; i < 28; ++i) f[i] = (const float*)d_in[i];
    p.out = (float*)d_out;
    p.ws = (unsigned char*)d_ws;
    p.ph_lo = 0; p.ph_hi = N_PHASES;
    (void)hipMemsetAsync((unsigned char*)d_ws + WS_CTL, 0, CTL_ZERO_BYTES, stream);
    hipLaunchKernelGGL(fwd_all, dim3(grid), dim3(NT), LDS_BYTES, stream, p);
}
```
